# Optimizing an MI355X kernel written in HIP

```python
import math
import jax, jax.numpy as jnp
from jax import lax
import numpy as np

D_MODEL = 2048
BATCH = 1
SEQ = 16384
DEPTH = 2

CHUNK = 64
Q_BLOCK = 128
MLA_HEADS = 8
Q_LORA = 512
KV_LORA = 256
NOPE_DIM = 128
ROPE_DIM = 64
QK_HEAD = NOPE_DIM + ROPE_DIM
MLA_V_DIM = 128
MLA_WIDTH = MLA_HEADS * MLA_V_DIM
ROPE_BASE = 10000.0
GLA_HEADS = 4
GLA_DK = 128
GLA_DV = 256
GLA_K_WIDTH = GLA_HEADS * GLA_DK
GLA_WIDTH = GLA_HEADS * GLA_DV
GATE_RANK = 16
GATE_TAU = 16.0
MIX_WIDTH = MLA_WIDTH + GLA_WIDTH
IN_SPLITS = (Q_LORA, KV_LORA, ROPE_DIM, GLA_K_WIDTH, GLA_K_WIDTH, GLA_WIDTH, GATE_RANK, GLA_WIDTH)
IN_DIM = sum(IN_SPLITS)
D_FF = 5632
CONV_W = 3
NORM_EPS = 1e-6

kernel_name = "hybrid_mla_gla_convffn_trunk"


def rms_norm(x, gain):
    x32 = x.astype(jnp.float32)
    y = x32 * lax.rsqrt(jnp.mean(x32 * x32, axis=-1, keepdims=True) + NORM_EPS)
    return (y * gain.astype(jnp.float32)).astype(x.dtype)


def split_cols(z, sizes):
    outs, start = [], 0
    for s in sizes:
        outs.append(z[..., start:start + s])
        start += s
    return outs


def apply_rope(x, cos, sin):
    x1, x2 = x[..., :ROPE_DIM // 2], x[..., ROPE_DIM // 2:]
    return jnp.concatenate([x1 * cos - x2 * sin, x2 * cos + x1 * sin], axis=-1)


def block_causal_attention(q, k, v):
    B, H, S, Dq = q.shape
    nb = S // Q_BLOCK
    scale = 1.0 / math.sqrt(Dq)
    qb = q.reshape(B, H, nb, Q_BLOCK, Dq).transpose(2, 0, 1, 3, 4)
    key_chunk = jnp.arange(S) // CHUNK

    def one_block(args):
        q_blk, b = args
        q_chunk = (b * Q_BLOCK + jnp.arange(Q_BLOCK)) // CHUNK
        s = jnp.einsum('bhqd,bhkd->bhqk', q_blk, k).astype(jnp.float32) * scale
        mask = key_chunk[None, :] <= q_chunk[:, None]
        s = jnp.where(mask[None, None], s, jnp.float32(-1e30))
        p = jax.nn.softmax(s, axis=-1)
        return jnp.einsum('bhqk,bhkd->bhqd', p.astype(v.dtype), v)

    out = lax.map(one_block, (qb, jnp.arange(nb)))
    return out.transpose(1, 2, 0, 3, 4).reshape(B, H, S, v.shape[-1])


def mla_mixer(z_cq, z_ckv, z_kr, cos, sin, cq_norm, w_uq, ckv_norm, w_ukv, q_norm, k_norm):
    B, S, _ = z_cq.shape
    q = (rms_norm(z_cq, cq_norm) @ w_uq).reshape(B, S, MLA_HEADS, QK_HEAD)
    kv = (rms_norm(z_ckv, ckv_norm) @ w_ukv).reshape(B, S, MLA_HEADS, NOPE_DIM + MLA_V_DIM)
    k_nope, v = kv[..., :NOPE_DIM], kv[..., NOPE_DIM:]
    k_rope = jnp.broadcast_to(z_kr[:, :, None, :], (B, S, MLA_HEADS, ROPE_DIM))
    k = jnp.concatenate([k_nope, k_rope], axis=-1)
    q = rms_norm(q, q_norm)
    k = rms_norm(k, k_norm)
    q = jnp.concatenate([q[..., :NOPE_DIM], apply_rope(q[..., NOPE_DIM:], cos, sin)], axis=-1)
    k = jnp.concatenate([k[..., :NOPE_DIM], apply_rope(k[..., NOPE_DIM:], cos, sin)], axis=-1)
    out = block_causal_attention(q.transpose(0, 2, 1, 3), k.transpose(0, 2, 1, 3), v.transpose(0, 2, 1, 3))
    return out.transpose(0, 2, 1, 3).reshape(B, S, MLA_WIDTH)


def gla_mixer(z_q, z_k, z_v, z_a, z_g, w_gate, b_gate, out_norm):
    B, S, _ = z_q.shape
    N = S // CHUNK

    def heads(t, d):
        return t.reshape(B, N, CHUNK, GLA_HEADS, d).transpose(0, 3, 1, 2, 4)

    q = heads(z_q, GLA_DK) * (GLA_DK ** -0.5)
    k = heads(z_k, GLA_DK)
    v = heads(z_v, GLA_DV)
    log_a = jax.nn.log_sigmoid((z_a @ w_gate + b_gate).astype(jnp.float32)) / GATE_TAU
    log_a = heads(log_a, GLA_DK)
    bcum = jnp.cumsum(log_a, axis=3)
    bend = bcum[:, :, :, -1:, :]
    k_dec = (k.astype(jnp.float32) * jnp.exp(bend - bcum)).astype(k.dtype)
    u = jnp.einsum('bhncd,bhnce->nbhde', k_dec, v)
    decay = jnp.exp(bend[:, :, :, 0, :]).transpose(2, 0, 1, 3)
    qn = q.transpose(2, 0, 1, 3, 4)

    def step(state, xs):
        u_c, d_c, q_c = xs
        state = state * d_c[..., None] + u_c.astype(jnp.float32)
        o = jnp.einsum('bhcd,bhde->bhce', q_c.astype(jnp.float32), state)
        return state, o

    init = jnp.zeros((B, GLA_HEADS, GLA_DK, GLA_DV), jnp.float32)
    _, o = lax.scan(step, init, (u, decay, qn))
    o = o.transpose(1, 0, 3, 2, 4).reshape(B, S, GLA_HEADS, GLA_DV).astype(z_v.dtype)
    o = rms_norm(o, out_norm).reshape(B, S, GLA_WIDTH)
    return o * jax.nn.silu(z_g)


def causal_dwconv(u, w, b):
    S = u.shape[1]
    up = jnp.pad(u, ((0, 0), (CONV_W - 1, 0), (0, 0)))
    y = b
    for j in range(CONV_W):
        y = y + up[:, j:j + S, :] * w[j]
    return y


def setup_inputs(seed: int = 0) -> dict:
    key = jax.random.key(seed)
    ks = jax.random.split(key, 24)
    L = DEPTH

    def nrm(k, shape, fan_in):
        return jax.random.normal(k, shape, jnp.float32) * (fan_in ** -0.5)

    def gain(k, shape):
        return 1.0 + 0.02 * jax.random.normal(k, shape, jnp.float32)

    x = jax.random.normal(ks[0], (BATCH, SEQ, D_MODEL), jnp.float32)
    positions = jnp.broadcast_to(jnp.arange(SEQ, dtype=jnp.int32), (BATCH, SEQ))
    return {
        "x": x,
        "positions": positions,
        "attn_norm": gain(ks[1], (L, D_MODEL)),
        "w_in": nrm(ks[2], (L, D_MODEL, IN_DIM), D_MODEL),
        "cq_norm": gain(ks[3], (L, Q_LORA)),
        "w_uq": nrm(ks[4], (L, Q_LORA, MLA_HEADS * QK_HEAD), Q_LORA),
        "ckv_norm": gain(ks[5], (L, KV_LORA)),
        "w_ukv": nrm(ks[6], (L, KV_LORA, MLA_HEADS * (NOPE_DIM + MLA_V_DIM)), KV_LORA),
        "q_norm": gain(ks[7], (L, QK_HEAD)),
        "k_norm": gain(ks[8], (L, QK_HEAD)),
        "w_gate": nrm(ks[9], (L, GATE_RANK, GLA_K_WIDTH), GATE_RANK),
        "b_gate": 0.1 * jax.random.normal(ks[10], (L, GLA_K_WIDTH), jnp.float32),
        "gla_out_norm": gain(ks[11], (L, GLA_DV)),
        "mla_out_norm": gain(ks[12], (L, MLA_WIDTH)),
        "w_out": nrm(ks[13], (L, MIX_WIDTH, D_MODEL), MIX_WIDTH),
        "ffn_norm": gain(ks[14], (L, D_MODEL)),
        "w_up": nrm(ks[15], (L, D_MODEL, 2 * D_FF), D_MODEL),
        "conv_w": nrm(ks[16], (L, CONV_W, 2 * D_FF), CONV_W),
        "conv_b": 0.02 * jax.random.normal(ks[17], (L, 2 * D_FF), jnp.float32),
        "w_down": nrm(ks[18], (L, D_FF, D_MODEL), D_FF),
    }


def reference(x, positions, attn_norm, w_in, cq_norm, w_uq, ckv_norm, w_ukv, q_norm, k_norm,
              w_gate, b_gate, gla_out_norm, mla_out_norm, w_out, ffn_norm, w_up, conv_w, conv_b, w_down):
    inv_freq = ROPE_BASE ** (-jnp.arange(0, ROPE_DIM, 2, dtype=jnp.float32) / ROPE_DIM)
    angle = positions.astype(jnp.float32)[..., None] * inv_freq
    cos = jnp.cos(angle)[:, :, None, :].astype(x.dtype)
    sin = jnp.sin(angle)[:, :, None, :].astype(x.dtype)
    for l in range(DEPTH):
        h = rms_norm(x, attn_norm[l])
        z = h @ w_in[l]
        z_cq, z_ckv, z_kr, z_q, z_k, z_v, z_a, z_g = split_cols(z, IN_SPLITS)
        a_out = mla_mixer(z_cq, z_ckv, z_kr, cos, sin, cq_norm[l], w_uq[l], ckv_norm[l], w_ukv[l],
                          q_norm[l], k_norm[l])
        a_out = rms_norm(a_out, mla_out_norm[l])
        g_out = gla_mixer(z_q, z_k, z_v, z_a, z_g, w_gate[l], b_gate[l], gla_out_norm[l])
        x = x + jnp.concatenate([a_out, g_out], axis=-1) @ w_out[l]
        h = rms_norm(x, ffn_norm[l])
        u = causal_dwconv(h @ w_up[l], conv_w[l], conv_b[l])
        gate, up = u[..., :D_FF], u[..., D_FF:]
        x = x + (jax.nn.silu(gate) * up) @ w_down[l]
    return x
```

```cpp
#include <hip/hip_runtime.h>
#include <hip/hip_cooperative_groups.h>
#include <cstdio>
#include <cstdint>
#include <cmath>
namespace cg = cooperative_groups;

#define LAS __attribute__((address_space(3)))
typedef unsigned short bf16_t;
typedef unsigned long long u64;
typedef short bf16x8 __attribute__((ext_vector_type(8)));
typedef short s16x4 __attribute__((ext_vector_type(4)));
typedef float f32x4 __attribute__((ext_vector_type(4)));
typedef float f32x16 __attribute__((ext_vector_type(16)));
typedef unsigned u32x4 __attribute__((ext_vector_type(4)));
typedef unsigned u32x2 __attribute__((ext_vector_type(2)));
typedef float f32x2_t __attribute__((ext_vector_type(2)));
typedef __bf16 bf16x2_t __attribute__((ext_vector_type(2)));

constexpr int SEQ = 16384, DM = 2048, NLAYER = 2;
constexpr int IN_DIM = 3920, IN_PAD = 4096;
constexpr int C_CQ = 0, C_CKV = 512, C_KR = 768, C_GQ = 832, C_GK = 1344, C_GV = 1856, C_GA = 2880, C_GG = 2896;
constexpr int QLORA = 512, KVLORA = 256, NH = 8, QKD = 192, NOPE = 128, VD = 128, QW = NH * QKD  , KVW = NH * 256  ;
constexpr int GH = 4, GDK = 128, GDV = 256, NCHUNK = SEQ / 64;
constexpr int DFF = 5632, DFF2 = 11264;
constexpr float EPS = 1e-6f;

constexpr size_t MiB = 1u << 20;
constexpr size_t WS_CTL = 0, CTL_BYTES = 2 * MiB;
constexpr size_t WS_SSQ = 65536;
constexpr size_t WS_WIN = 2 * MiB, WS_WUQ = 18 * MiB, WS_WUKV = WS_WUQ + 3 * MiB / 2, WS_WOUT = WS_WUKV + 1 * MiB, WS_WUP = WS_WOUT + 8 * MiB, WS_WDN = WS_WUP + 44 * MiB;
constexpr size_t WS_XB = 95 * MiB;
constexpr size_t WS_R = 159 * MiB;
constexpr size_t WS_Z = WS_R, WS_Q = WS_Z + 128 * MiB, WS_K = WS_Q + 48 * MiB, WS_VT = WS_K + 48 * MiB, WS_ST = WS_VT + 32 * MiB, WS_DEC = WS_ST + 128 * MiB, WS_MIX = WS_DEC + 1 * MiB;
constexpr size_t WS_UP = WS_R, WS_ACT = WS_UP + 352 * MiB, WS_END = WS_ACT + 176 * MiB;
static_assert(WS_MIX + 64 * MiB <= WS_END, "ws map");

#define LAUNDER_V(x) asm volatile("" : "+v"(x))
#define LAUNDER_S(x) asm volatile("" : "+s"(x))
__device__ __forceinline__ unsigned f2bf(float f) { unsigned u = __builtin_bit_cast(unsigned, f); return (u + 0x7fffu + ((u >> 16) & 1u)) >> 16; }
__device__ __forceinline__ unsigned pk2(float lo, float hi) { f32x2_t v = {lo, hi}; bf16x2_t b = __builtin_convertvector(v, bf16x2_t); return __builtin_bit_cast(unsigned, b); }
__device__ __forceinline__ float bf2f(unsigned b) { return __builtin_bit_cast(float, b << 16); }
__device__ __forceinline__ float bflo(unsigned w) { return __builtin_bit_cast(float, w << 16); }
__device__ __forceinline__ float bfhi(unsigned w) { return __builtin_bit_cast(float, w & 0xffff0000u); }
__device__ __forceinline__ float wave_sum(float v) {
#pragma unroll
    for (int o = 1; o < 64; o <<= 1) v += __shfl_xor(v, o);
    return v;
}
constexpr float SSQ_FX = 1048576.0f, SSQ_INV = 1.0f / 1048576.0f;
__device__ __forceinline__ void ssq_add(u64* p, float v) { __hip_atomic_fetch_add(p, (u64)(v * SSQ_FX + 0.5f), __ATOMIC_RELAXED, __HIP_MEMORY_SCOPE_AGENT); }
__device__ __forceinline__ float ssq_get(const u64* p) { return (float)(*p) * SSQ_INV; }
__device__ __forceinline__ float silu_f(float x) { return x * __builtin_amdgcn_rcpf(1.0f + __expf(-x)); }

namespace pg8 {
constexpr int BM = 256, BK = 64, HALF = 128, HTB = HALF * BK * 2, STAGE_BYTES = 8 * HTB, NXCD = 8, WGM = 8;
__host__ __device__ __forceinline__ int lds_byte(int r, int c) { const int st = (r >> 4) * 2 + (c >> 5), rr = r & 15, cc = c & 31, ob = rr * 64 + cc * 2; return st * 1024 + (ob ^ (((ob >> 9) & 1) << 5)); }
__host__ __device__ __forceinline__ void stage_rc(int b, int& R, int& C) { const int st = b / 1024, sb = b % 1024, swz = sb ^ (((sb >> 9) & 1) << 5); R = (st >> 1) * 16 + swz / 64; C = (st & 1) * 32 + (swz % 64) / 2; }
__host__ __device__ __forceinline__ int perm32(int rho) { const int n = rho >> 4, i = rho & 15; return 8 * (i >> 2) + 4 * n + (i & 3); }

struct Unit { int pm, pn; };
struct Gemm { const bf16_t* A; const bf16_t* Bt; int M, N, K, lda; };

struct StaticOrder {
    int nM, nN, nwg, G, c;
    __device__ void init(int M, int N, int G_, int c_) { nM = M / BM; nN = N / BM; nwg = nM * nN; G = G_; c = c_; }
    __device__ bool next(int i, Unit& u) const {
        const long L = (long)i * G + c; if (L >= nwg) return false;
        int wgid = (int)L; { const int q = nwg / NXCD, r = nwg % NXCD, xcd = wgid % NXCD, off = wgid / NXCD; wgid = (xcd < r ? xcd * (q + 1) : r * (q + 1) + (xcd - r) * q) + off; }
        const int nig = WGM * nN, gid = wgid / nig, fm = gid * WGM, gsz = (nM - fm) < WGM ? (nM - fm) : WGM;
        u.pm = fm + ((wgid % nig) % gsz); u.pn = (wgid % nig) / gsz; return true;
    }
};

struct EpiRowScale {
    static constexpr bool PERM = true;
    bf16_t* O; int ldc; const u64* ssq_in; float inv_dim; u64* ssq_a; int a_lo, a_hi; u64* ssq_b; int b_lo, b_hi;
    __device__ __forceinline__ void operator()(const f32x4 (&acc)[2][2][4][2], const Unit& u, int wr, int wc, int fr, int fq) const {
        const int row0 = u.pm * BM + wr * 64 + fr, col0 = u.pn * BM + wc * 32 + 8 * fq;
        u64* sacc = (u.pn >= a_lo && u.pn < a_hi) ? ssq_a : ((u.pn >= b_lo && u.pn < b_hi) ? ssq_b : nullptr);
#pragma unroll
        for (int ai = 0; ai < 2; ++ai)
#pragma unroll
            for (int m = 0; m < 4; ++m) {
                const int row = row0 + ai * HALF + m * 16;
                const float sc = ssq_in ? rsqrtf(ssq_get(ssq_in + row) * inv_dim + EPS) : 1.0f;
                float ss = 0.f;
#pragma unroll
                for (int bj = 0; bj < 2; ++bj) {
                    const f32x4 v0 = acc[ai][bj][m][0] * sc, v1 = acc[ai][bj][m][1] * sc;
                    ss += (v0[0] * v0[0] + v0[1] * v0[1]) + (v0[2] * v0[2] + v0[3] * v0[3]) + (v1[0] * v1[0] + v1[1] * v1[1]) + (v1[2] * v1[2] + v1[3] * v1[3]);
                    u32x4 w; w.x = pk2(v0[0], v0[1]); w.y = pk2(v0[2], v0[3]); w.z = pk2(v1[0], v1[1]); w.w = pk2(v1[2], v1[3]);
                    *(u32x4*)(O + (size_t)row * ldc + col0 + bj * HALF) = w;
                }
                if (sacc) { ss += __shfl_xor(ss, 16); ss += __shfl_xor(ss, 32); if (fq == 0) ssq_add(sacc + row, ss); }
            }
    }
};
struct EpiUkv {
    static constexpr bool PERM = true;
    bf16_t* Kb; bf16_t* Vt; const u64* ssq_in; float inv_dim;
    __device__ __forceinline__ void operator()(const f32x4 (&acc)[2][2][4][2], const Unit& u, int wr, int wc, int fr, int fq) const {
        const int row0 = u.pm * BM + wr * 64 + fr, c0 = wc * 32 + 8 * fq;
#pragma unroll
        for (int ai = 0; ai < 2; ++ai)
#pragma unroll
            for (int m = 0; m < 4; ++m) {
                const int row = row0 + ai * HALF + m * 16;
                const float sc = rsqrtf(ssq_get(ssq_in + row) * inv_dim + EPS);
                { const f32x4 v0 = acc[ai][0][m][0] * sc, v1 = acc[ai][0][m][1] * sc;
                  u32x4 w; w.x = pk2(v0[0], v0[1]); w.y = pk2(v0[2], v0[3]); w.z = pk2(v1[0], v1[1]); w.w = pk2(v1[2], v1[3]);
                  *(u32x4*)(Kb + (size_t)row * QW + u.pn * QKD + c0) = w; }
#pragma unroll
                for (int n = 0; n < 2; ++n)
#pragma unroll
                    for (int j = 0; j < 4; ++j) Vt[(size_t)(u.pn * VD + c0 + 4 * n + j) * SEQ + row] = (bf16_t)f2bf(acc[ai][1][m][n][j] * sc);
            }
    }
};
struct EpiRes {
    static constexpr bool PERM = true;
    const float* base; float* out; bf16_t* xb; u64* ssq_out;
    __device__ __forceinline__ void operator()(const f32x4 (&acc)[2][2][4][2], const Unit& u, int wr, int wc, int fr, int fq) const {
        const int row0 = u.pm * BM + wr * 64 + fr, col0 = u.pn * BM + wc * 32 + 8 * fq;
#pragma unroll
        for (int ai = 0; ai < 2; ++ai)
#pragma unroll
            for (int m = 0; m < 4; ++m) {
                const int row = row0 + ai * HALF + m * 16; float ss = 0.f;
#pragma unroll
                for (int bj = 0; bj < 2; ++bj) {
                    const size_t off = (size_t)row * DM + col0 + bj * HALF;
                    const f32x4 v0 = acc[ai][bj][m][0] + *(const f32x4*)(base + off), v1 = acc[ai][bj][m][1] + *(const f32x4*)(base + off + 4);
                    ss += (v0[0] * v0[0] + v0[1] * v0[1]) + (v0[2] * v0[2] + v0[3] * v0[3]) + (v1[0] * v1[0] + v1[1] * v1[1]) + (v1[2] * v1[2] + v1[3] * v1[3]);
                    *(f32x4*)(out + off) = v0; *(f32x4*)(out + off + 4) = v1;
                    u32x4 w; w.x = pk2(v0[0], v0[1]); w.y = pk2(v0[2], v0[3]); w.z = pk2(v1[0], v1[1]); w.w = pk2(v1[2], v1[3]);
                    *(u32x4*)(xb + off) = w;
                }
                ss += __shfl_xor(ss, 16); ss += __shfl_xor(ss, 32); if (fq == 0) ssq_add(ssq_out + row, ss);
            }
    }
};

template <class Epi>
__device__ __forceinline__ void gemm_phase(LAS unsigned char* lds, const Gemm g, const StaticOrder& S, const Epi& E) {
    int tid_ = threadIdx.x; LAUNDER_V(tid_);
    const int tid = tid_, wid = __builtin_amdgcn_readfirstlane(tid >> 6), lane = tid & 63, wr = wid >> 2, wc = wid & 3, fr = lane & 15, fq = lane >> 4;
    const int K = g.K, nt = K / BK;
    unsigned voffA[2], voffB[2];
#pragma unroll
    for (int i = 0; i < 2; ++i) { int R, C; stage_rc(tid * 16 + i * 8192, R, C); const int Rb = Epi::PERM ? ((R & ~31) + perm32(R & 31)) : R;
        voffA[i] = (unsigned)(R * g.lda + C) * 2u; voffB[i] = (unsigned)(Rb * K + C) * 2u; }
    const size_t kstep = (size_t)(BK * 2);
    const size_t hstepA = (size_t)HALF * g.lda * 2, hstepB = (size_t)HALF * K * 2;
    const size_t tstepA = 2 * hstepA, tstepB = 2 * hstepB;
    const unsigned ldsw = (unsigned)wid * 1024u;
    const int aoff = lds_byte(wr * 64 + fr, fq * 8), boff = lds_byte(wc * 32 + fr, fq * 8);
#define PG8_SA(b, h) (((b) * 2 + (h)) * HTB)
#define PG8_SB(b, h) ((4 + (b) * 2 + (h)) * HTB)
#define PG8_STAGE(bufoff, gbase, voff) do { _Pragma("unroll") for (int _i = 0; _i < 2; ++_i) \
        __builtin_amdgcn_global_load_lds((const unsigned*)((const char*)(gbase) + (voff)[_i]), (LAS unsigned*)(lds + (bufoff) + ldsw + _i * 8192), 16, 0, 0); } while (0)
#define PG8_LDA(dst, b, h) do { _Pragma("unroll") for (int m = 0; m < 4; ++m) _Pragma("unroll") for (int k = 0; k < 2; ++k) dst[m][k] = *(const LAS bf16x8*)(lds + PG8_SA(b, h) + aoff + m * 2048 + k * 1024); } while (0)
#define PG8_LDB(dst, b, h) do { _Pragma("unroll") for (int n = 0; n < 2; ++n) _Pragma("unroll") for (int k = 0; k < 2; ++k) dst[n][k] = *(const LAS bf16x8*)(lds + PG8_SB(b, h) + boff + n * 2048 + k * 1024); } while (0)
#define PG8_MMA(ai, bj, At, Bt) do { __builtin_amdgcn_s_setprio(1); _Pragma("unroll") for (int m = 0; m < 4; ++m) _Pragma("unroll") for (int n = 0; n < 2; ++n) _Pragma("unroll") for (int k = 0; k < 2; ++k) \
        acc[ai][bj][m][n] = __builtin_amdgcn_mfma_f32_16x16x32_bf16(Bt[n][k], At[m][k], acc[ai][bj][m][n], 0, 0, 0); __builtin_amdgcn_s_setprio(0); } while (0)
#define PG8_WAIT_V(n) asm volatile("s_waitcnt vmcnt(" #n ")" ::: "memory")
#define PG8_WAIT_L(n) asm volatile("s_waitcnt lgkmcnt(" #n ")" ::: "memory")
#define PG8_BAR __builtin_amdgcn_s_barrier()
#define PG8_SCHED __builtin_amdgcn_sched_barrier(0)
    Unit cur, nxt; int ui = 0;
    if (!S.next(0, cur)) return;
    f32x4 acc[2][2][4][2];
#pragma unroll
    for (int a = 0; a < 2; ++a)
#pragma unroll
        for (int b = 0; b < 2; ++b)
#pragma unroll
            for (int m = 0; m < 4; ++m)
#pragma unroll
                for (int n = 0; n < 2; ++n) acc[a][b][m][n] = (f32x4){0.f, 0.f, 0.f, 0.f};
    bf16x8 At[4][2], B0[2][2], B1[2][2];
    const char* cA = (const char*)g.A + (size_t)cur.pm * tstepA; const char* cB = (const char*)g.Bt + (size_t)cur.pn * tstepB;
    PG8_STAGE(PG8_SB(0, 0), cB, voffB); PG8_STAGE(PG8_SB(0, 1), cB + hstepB, voffB); PG8_STAGE(PG8_SA(0, 0), cA, voffA); PG8_STAGE(PG8_SA(0, 1), cA + hstepA, voffA);
    if (wr == 1) PG8_BAR;
    PG8_WAIT_V(2); PG8_BAR;
    PG8_STAGE(PG8_SB(1, 0), cB + kstep, voffB); PG8_STAGE(PG8_SA(1, 0), cA + kstep, voffA); PG8_STAGE(PG8_SB(1, 1), cB + hstepB + kstep, voffB);
    PG8_WAIT_V(6); PG8_BAR;
    for (;;) {
        const bool has_next = S.next(ui + 1, nxt);
        const char* nA = has_next ? (const char*)g.A + (size_t)nxt.pm * tstepA : cA; const char* nB = has_next ? (const char*)g.Bt + (size_t)nxt.pn * tstepB : cB;
        for (int t = 0; t < nt; t += 2) {
            const bool last = (t == nt - 2);
            const char* a1 = cA + (size_t)(t + 1) * kstep;
            const char* a2 = last ? nA : cA + (size_t)(t + 2) * kstep; const char* b2 = last ? nB : cB + (size_t)(t + 2) * kstep;
            const char* a3 = a2 + kstep; const char* b3 = b2 + kstep;
            PG8_LDB(B0, 0, 0); PG8_LDB(B1, 0, 1); PG8_SCHED; PG8_LDA(At, 0, 0); PG8_STAGE(PG8_SA(1, 1), a1 + hstepA, voffA);
            PG8_WAIT_V(8); PG8_WAIT_L(0); PG8_BAR; PG8_MMA(0, 0, At, B0); PG8_MMA(0, 1, At, B1); PG8_BAR; PG8_SCHED;
            PG8_LDA(At, 0, 1); PG8_STAGE(PG8_SB(0, 0), b2, voffB); PG8_STAGE(PG8_SB(0, 1), b2 + hstepB, voffB); PG8_STAGE(PG8_SA(0, 0), a2, voffA);
            PG8_WAIT_V(8); PG8_WAIT_L(0); PG8_BAR; PG8_MMA(1, 0, At, B0); PG8_MMA(1, 1, At, B1); PG8_BAR; PG8_SCHED;
            PG8_LDB(B0, 1, 0); PG8_LDB(B1, 1, 1); PG8_SCHED; PG8_LDA(At, 1, 0); PG8_STAGE(PG8_SA(0, 1), a2 + hstepA, voffA);
            PG8_WAIT_V(8); PG8_WAIT_L(0); PG8_BAR; PG8_MMA(0, 0, At, B0); PG8_MMA(0, 1, At, B1); PG8_BAR; PG8_SCHED;
            PG8_LDA(At, 1, 1); PG8_STAGE(PG8_SB(1, 0), b3, voffB); PG8_STAGE(PG8_SB(1, 1), b3 + hstepB, voffB); PG8_STAGE(PG8_SA(1, 0), a3, voffA);
            PG8_WAIT_V(8); PG8_WAIT_L(0); PG8_BAR; PG8_MMA(1, 0, At, B0); PG8_MMA(1, 1, At, B1); PG8_BAR; PG8_SCHED;
        }
        if (wr == 0) PG8_BAR;
        E(acc, cur, wr, wc, fr, fq);
        if (!has_next) break;
#pragma unroll
        for (int a = 0; a < 2; ++a)
#pragma unroll
            for (int b = 0; b < 2; ++b)
#pragma unroll
                for (int m = 0; m < 4; ++m)
#pragma unroll
                    for (int n = 0; n < 2; ++n) acc[a][b][m][n] = (f32x4){0.f, 0.f, 0.f, 0.f};
        cur = nxt; cA = nA; cB = nB; ++ui;
        if (wr == 1) PG8_BAR;
    }
    PG8_WAIT_V(0);
    PG8_BAR;
#undef PG8_SA
#undef PG8_SB
#undef PG8_STAGE
#undef PG8_LDA
#undef PG8_LDB
#undef PG8_MMA
#undef PG8_WAIT_V
#undef PG8_WAIT_L
#undef PG8_BAR
#undef PG8_SCHED
}
}

constexpr int RING_BYTES = 131072;
constexpr int LDS_BYTES = 147456;

struct Args { const float* in[20]; float* out; unsigned char* ws; float inv_freq[32]; };

#define MFMA32(a, b, c) __builtin_amdgcn_mfma_f32_32x32x16_bf16((a), (b), (c), 0, 0, 0)
__device__ __forceinline__ int crow(int r, int hi) { return (r & 3) + 8 * (r >> 2) + 4 * hi; }

__device__ __forceinline__ void wt_item(const float* __restrict__ W, int K, int N, const float* __restrict__ gain, int gainK, bf16_t* WT, LAS float* scr, int item, int nblk, int lane) {
    const int kb = item / nblk, nb = item % nblk, k0 = 64 * kb, n0 = 32 * nb;
    const int n = n0 + (lane & 31);
#pragma unroll 8
    for (int i = 0; i < 32; ++i) { const int kk = 2 * i + (lane >> 5); float w = (n < N) ? W[(size_t)(k0 + kk) * N + n] : 0.f; if ((k0 + kk) < gainK) w *= gain[k0 + kk]; scr[kk * 33 + (lane & 31)] = w; }
    asm volatile("s_waitcnt lgkmcnt(0)" ::: "memory");
    const int c = lane & 7;
#pragma unroll
    for (int j = 0; j < 4; ++j) { const int nn = (lane >> 3) + 8 * j; const LAS float* s = scr + (8 * c) * 33 + nn;
        u32x4 o; o.x = pk2(s[0 * 33], s[1 * 33]); o.y = pk2(s[2 * 33], s[3 * 33]); o.z = pk2(s[4 * 33], s[5 * 33]); o.w = pk2(s[6 * 33], s[7 * 33]);
        *(u32x4*)(WT + (size_t)(n0 + nn) * K + k0 + 8 * c) = o; }
    asm volatile("s_waitcnt lgkmcnt(0)" ::: "memory");
}

constexpr int AT_KSTR = 400, AT_VSTR = 144;
constexpr int AT_KB = 64 * AT_KSTR  , AT_VB = 128 * AT_VSTR  , AT_K0 = 0, AT_V0 = 2 * AT_KB, AT_WSF = AT_V0 + 2 * AT_VB;
static_assert(AT_WSF + 8 * 128 <= RING_BYTES, "attn lds");

__device__ __forceinline__ void attn_unit(LAS unsigned char* L, const bf16_t* __restrict__ Q, const bf16_t* __restrict__ Kg, const bf16_t* __restrict__ Vt, bf16_t* mix, int h, int qb) {
    int tid_ = threadIdx.x; LAUNDER_V(tid_);
    const int tid = tid_, lane = tid & 63, w = __builtin_amdgcn_readfirstlane(tid >> 6), r32 = lane & 31, hh = lane >> 5;
    const int q0 = qb * 256;
    bf16x8 qf[12];
    { const bf16_t* qrow = Q + (size_t)(q0 + 32 * w + r32) * QW + h * QKD + 8 * hh;
#pragma unroll
      for (int ks = 0; ks < 12; ++ks) qf[ks] = *(const bf16x8*)(qrow + 16 * ks); }
    f32x16 o[4];
#pragma unroll
    for (int d = 0; d < 4; ++d)
#pragma unroll
        for (int i = 0; i < 16; ++i) o[d][i] = 0.f;
    float m_run = -1e30f, l_run = 0.f;
    const int NT = 4 * qb + 4, my_last = 4 * qb + (w >> 1);
    volatile LAS float* wsf = (volatile LAS float*)(L + AT_WSF) + w * 32;
    u32x4 kst[3], vst[2];
    int krow_[3], kcc_[3], vrow_[2], vcc_[2];
#pragma unroll
    for (int i = 0; i < 3; ++i) { const int id = tid + 512 * i; krow_[i] = id / 24; kcc_[i] = id % 24; }
#pragma unroll
    for (int i = 0; i < 2; ++i) { const int id = tid + 512 * i; vrow_[i] = id >> 3; vcc_[i] = id & 7; }
#define AT_GLOAD(t) do { const int kv0_ = (t) * 64; \
    _Pragma("unroll") for (int i = 0; i < 3; ++i) kst[i] = *(const u32x4*)(Kg + (size_t)(kv0_ + krow_[i]) * QW + h * QKD + kcc_[i] * 8); \
    _Pragma("unroll") for (int i = 0; i < 2; ++i) vst[i] = *(const u32x4*)(Vt + (size_t)(h * VD + vrow_[i]) * SEQ + kv0_ + vcc_[i] * 8); } while (0)
#define AT_SSTORE(buf) do { \
    _Pragma("unroll") for (int i = 0; i < 3; ++i) *(LAS u32x4*)(L + AT_K0 + (buf) * AT_KB + krow_[i] * AT_KSTR + kcc_[i] * 16) = kst[i]; \
    _Pragma("unroll") for (int i = 0; i < 2; ++i) *(LAS u32x4*)(L + AT_V0 + (buf) * AT_VB + vrow_[i] * AT_VSTR + vcc_[i] * 16) = vst[i]; } while (0)
    AT_GLOAD(0); AT_SSTORE(0); __syncthreads();
    for (int t = 0; t < NT; ++t) {
        const int buf = t & 1;
        if (t + 1 < NT) AT_GLOAD(t + 1);
        if (t <= my_last) {
            const LAS unsigned char* Kt = L + AT_K0 + buf * AT_KB + r32 * AT_KSTR + hh * 16;
            const LAS unsigned char* Vb = L + AT_V0 + buf * AT_VB + r32 * AT_VSTR + hh * 8;
            f32x16 p0, p1;
#pragma unroll
            for (int i = 0; i < 16; ++i) { p0[i] = 0.f; p1[i] = 0.f; }
#pragma unroll
            for (int ks = 0; ks < 12; ++ks) {
                const bf16x8 a0 = *(const LAS bf16x8*)(Kt + ks * 32), a1 = *(const LAS bf16x8*)(Kt + 32 * AT_KSTR + ks * 32);
                p0 = MFMA32(a0, qf[ks], p0); p1 = MFMA32(a1, qf[ks], p1);
            }
            float mx = fmaxf(p0[0], p1[0]);
#pragma unroll
            for (int i = 1; i < 16; ++i) mx = fmaxf(mx, fmaxf(p0[i], p1[i]));
            mx = fmaxf(mx, __shfl_xor(mx, 32));
            const float m_new = fmaxf(m_run, mx), alpha = __builtin_amdgcn_exp2f(m_run - m_new); m_run = m_new;
            float ls = 0.f;
#pragma unroll
            for (int i = 0; i < 16; ++i) { p0[i] = __builtin_amdgcn_exp2f(p0[i] - m_new); p1[i] = __builtin_amdgcn_exp2f(p1[i] - m_new); ls += p0[i] + p1[i]; }
            l_run = l_run * alpha + ls;
            wsf[r32] = alpha;
            asm volatile("s_waitcnt lgkmcnt(0)" ::: "memory");
#pragma unroll
            for (int i = 0; i < 16; ++i) { const float a = wsf[crow(i, hh)];
#pragma unroll
                for (int d = 0; d < 4; ++d) o[d][i] *= a; }
#pragma unroll
            for (int kb = 0; kb < 2; ++kb)
#pragma unroll
                for (int s = 0; s < 2; ++s) {
                    u32x4 pw;
                    if (kb == 0) { pw.x = pk2(p0[8 * s + 0], p0[8 * s + 1]); pw.y = pk2(p0[8 * s + 2], p0[8 * s + 3]); pw.z = pk2(p0[8 * s + 4], p0[8 * s + 5]); pw.w = pk2(p0[8 * s + 6], p0[8 * s + 7]); }
                    else         { pw.x = pk2(p1[8 * s + 0], p1[8 * s + 1]); pw.y = pk2(p1[8 * s + 2], p1[8 * s + 3]); pw.z = pk2(p1[8 * s + 4], p1[8 * s + 5]); pw.w = pk2(p1[8 * s + 6], p1[8 * s + 7]); }
                    const bf16x8 xs = __builtin_bit_cast(bf16x8, pw);
#pragma unroll
                    for (int d = 0; d < 4; ++d) {
                        const LAS unsigned char* vp = Vb + d * 32 * AT_VSTR + (32 * kb + 16 * s) * 2;
                        const s16x4 lo = *(const LAS s16x4*)(vp), hi = *(const LAS s16x4*)(vp + 16);
                        const bf16x8 pb = __builtin_shufflevector(lo, hi, 0, 1, 2, 3, 4, 5, 6, 7);
                        o[d] = MFMA32(xs, pb, o[d]);
                    }
                }
        }
        if (t + 1 < NT) AT_SSTORE(buf ^ 1);
        __syncthreads();
    }
#undef AT_GLOAD
#undef AT_SSTORE
    const float lt = l_run + __shfl_xor(l_run, 32);
    wsf[r32] = 1.0f / lt;
    asm volatile("s_waitcnt lgkmcnt(0)" ::: "memory");
    bf16_t* orow = mix + (size_t)(q0 + 32 * w) * DM + h * VD + r32;
#pragma unroll
    for (int i = 0; i < 16; ++i) { const int qr = crow(i, hh); const float a = wsf[qr];
#pragma unroll
        for (int d = 0; d < 4; ++d) orow[(size_t)qr * DM + 32 * d] = (bf16_t)f2bf(o[d][i] * a); }
    __syncthreads();
}

constexpr int GL_V = 0  , GL_KD = 32768  , GL_TOT = GL_KD + 18432  , GL_ZA = GL_TOT + 2048  ;
__device__ __forceinline__ void gla_chunk_unit(LAS unsigned char* L, const bf16_t* __restrict__ Z, const float* __restrict__ wgate, const float* __restrict__ bgate, float* ST, float* DEC, int c, int h) {
    int tid_ = threadIdx.x; LAUNDER_V(tid_);
    const int tid = tid_, lane = tid & 63, w = __builtin_amdgcn_readfirstlane(tid >> 6), r32 = lane & 31, hh = lane >> 5;
    const size_t row0 = (size_t)c * 64;
#pragma unroll
    for (int i = 0; i < 4; ++i) { const int id = tid + 512 * i, r = id >> 5, cc = id & 31;
        *(LAS u32x4*)(L + GL_V + r * 512 + cc * 16) = *(const u32x4*)(Z + (row0 + r) * IN_PAD + C_GV + h * GDV + cc * 8); }
#pragma unroll
    for (int i = 0; i < 2; ++i) { const int id = tid + 512 * i, r = id >> 4, cc = id & 15;
        ((LAS float*)(L + GL_ZA))[id] = bf2f(Z[(row0 + r) * IN_PAD + C_GA + cc]); }
    __syncthreads();
    const int tq = tid >> 7, col = tid & 127;
    float wg[16];
#pragma unroll
    for (int r = 0; r < 16; ++r) wg[r] = wgate[r * (GH * GDK) + h * GDK + col];
    const float bg = bgate[h * GDK + col];
    float pre[16]; float run = 0.f;
#pragma unroll
    for (int i = 0; i < 16; ++i) {
        const LAS float* za = (const LAS float*)(L + GL_ZA) + (16 * tq + i) * 16;
        float ga = bg;
#pragma unroll
        for (int r = 0; r < 16; ++r) ga += za[r] * wg[r];
        const float ls = fminf(ga, 0.f) - __logf(1.0f + __expf(-fabsf(ga)));
        run += ls * (1.0f / 16.0f); pre[i] = run;
    }
    ((LAS float*)(L + GL_TOT))[tq * 128 + col] = run;
    __syncthreads();
    float off = 0.f, bend = 0.f;
#pragma unroll
    for (int t = 0; t < 4; ++t) { const float v = ((LAS float*)(L + GL_TOT))[t * 128 + col]; bend += v; if (t < tq) off += v; }
    {
        unsigned pkv[8];
#pragma unroll
        for (int i = 0; i < 16; i += 2) {
            const float k0 = bf2f(Z[(row0 + 16 * tq + i) * IN_PAD + C_GK + h * GDK + col]), k1 = bf2f(Z[(row0 + 16 * tq + i + 1) * IN_PAD + C_GK + h * GDK + col]);
            pkv[i >> 1] = pk2(k0 * __expf(bend - off - pre[i]), k1 * __expf(bend - off - pre[i + 1]));
        }
        LAS u32x4* dst = (LAS u32x4*)(L + GL_KD + col * 144 + tq * 32);
        dst[0] = (u32x4){pkv[0], pkv[1], pkv[2], pkv[3]}; dst[1] = (u32x4){pkv[4], pkv[5], pkv[6], pkv[7]};
    }
    if (tq == 0) DEC[(size_t)(c * GH + h) * GDK + col] = __expf(bend);
    __syncthreads();
    f32x16 acc[4];
#pragma unroll
    for (int d = 0; d < 4; ++d)
#pragma unroll
        for (int i = 0; i < 16; ++i) acc[d][i] = 0.f;
#pragma unroll
    for (int ks = 0; ks < 4; ++ks) {
        bf16x8 a;
#pragma unroll
        for (int j = 0; j < 8; ++j) a[j] = (short)*(const LAS unsigned short*)(L + GL_V + (16 * ks + 8 * hh + j) * 512 + (32 * w + r32) * 2);
#pragma unroll
        for (int db = 0; db < 4; ++db) {
            const bf16x8 b = *(const LAS bf16x8*)(L + GL_KD + (32 * db + r32) * 144 + (16 * ks + 8 * hh) * 2);
            acc[db] = MFMA32(a, b, acc[db]);
        }
    }
    float* stp = ST + ((size_t)(c * GH + h) * GDV + 32 * w) * GDK + r32;
#pragma unroll
    for (int db = 0; db < 4; ++db)
#pragma unroll
        for (int i = 0; i < 16; ++i) stp[(size_t)crow(i, hh) * GDK + 32 * db] = acc[db][i];
    __syncthreads();
}

constexpr int GO_STR = 260;
__device__ __forceinline__ void gla_out_unit(LAS unsigned char* L, const bf16_t* __restrict__ Z, const float* __restrict__ ST, const float* __restrict__ gnorm, bf16_t* mix, int c, int h) {
    int tid_ = threadIdx.x; LAUNDER_V(tid_);
    const int tid = tid_, lane = tid & 63, w = __builtin_amdgcn_readfirstlane(tid >> 6), r32 = lane & 31, hh = lane >> 5;
    const size_t row0 = (size_t)c * 64;
    f32x16 acc[2];
#pragma unroll
    for (int d = 0; d < 2; ++d)
#pragma unroll
        for (int i = 0; i < 16; ++i) acc[d][i] = 0.f;
    const float* sp = ST + ((size_t)(c * GH + h) * GDV + 32 * w + r32) * GDK + 8 * hh;
#pragma unroll
    for (int ks = 0; ks < 8; ++ks) {
        const f32x4 s0 = *(const f32x4*)(sp + 16 * ks), s1 = *(const f32x4*)(sp + 16 * ks + 4);
        u32x4 bw; bw.x = pk2(s0[0], s0[1]); bw.y = pk2(s0[2], s0[3]); bw.z = pk2(s1[0], s1[1]); bw.w = pk2(s1[2], s1[3]);
        const bf16x8 b = __builtin_bit_cast(bf16x8, bw);
#pragma unroll
        for (int tb = 0; tb < 2; ++tb) {
            const bf16x8 a = *(const bf16x8*)(Z + (row0 + 32 * tb + r32) * IN_PAD + C_GQ + h * GDK + 16 * ks + 8 * hh);
            acc[tb] = MFMA32(a, b, acc[tb]);
        }
    }
    LAS float* of = (LAS float*)L;
#pragma unroll
    for (int tb = 0; tb < 2; ++tb)
#pragma unroll
        for (int i = 0; i < 16; ++i) of[(32 * tb + crow(i, hh)) * GO_STR + 32 * w + r32] = acc[tb][i] * 0.08838834764831845f;
    __syncthreads();
    const int tok = tid >> 3, part = tid & 7;
    float v[32]; float ss = 0.f;
#pragma unroll
    for (int i = 0; i < 32; ++i) { v[i] = of[tok * GO_STR + i * 8 + part]; ss += v[i] * v[i]; }
    ss += __shfl_xor(ss, 1); ss += __shfl_xor(ss, 2); ss += __shfl_xor(ss, 4);
    const float rstd = rsqrtf(ss * (1.0f / GDV) + EPS);
    const bf16_t* zg = Z + (row0 + tok) * IN_PAD + C_GG + h * GDV;
    bf16_t* op = mix + (row0 + tok) * DM + 1024 + h * GDV;
#pragma unroll
    for (int i = 0; i < 32; ++i) { const int dv = i * 8 + part; const float g = bf2f(zg[dv]); op[dv] = (bf16_t)f2bf(v[i] * rstd * gnorm[dv] * silu_f(g)); }
    __syncthreads();
}

__global__ void __launch_bounds__(512, 2) mk_fwd(Args a) {
    extern __shared__ __attribute__((aligned(16))) unsigned char lds[];
    cg::grid_group grid = cg::this_grid();
    LAS unsigned char* L = (LAS unsigned char*)lds;
    const int G = gridDim.x, bid = blockIdx.x, NGW = G * 8;
#define GRID_SYNC() do { asm volatile("s_waitcnt vmcnt(0) lgkmcnt(0)" ::: "memory"); __syncthreads(); grid.sync(); \
    __builtin_amdgcn_fence(__ATOMIC_ACQUIRE, "agent"); asm volatile("s_waitcnt vmcnt(0)" ::: "memory"); __syncthreads(); } while (0)
#ifndef DBG_STOP
#define DBG_STOP 0
#endif
#define DBG_DUMP(k, EXPR) do { if (DBG_STOP == (k)) { PHASE_BEGIN(); for (int m = gw; m < SEQ; m += NGW) for (int c = lane; c < DM; c += 64) out[(size_t)m * DM + c] = (EXPR); return; } } while (0)
#define PHASE_BEGIN() unsigned char* ws = a.ws; LAUNDER_S(ws); int tid_ = threadIdx.x; LAUNDER_V(tid_); const int tid = tid_, lane = tid & 63, wave = __builtin_amdgcn_readfirstlane(tid >> 6), gw = bid * 8 + wave; \
    u64* ssq = (u64*)(ws + WS_SSQ); (void)lane; (void)gw; (void)ssq; \
    u64* ssq_x = ssq + (size_t)l * SEQ; u64* ssq_xn = ssq + (size_t)(l + 1) * SEQ; u64* ssq_cq = ssq + (size_t)(3 + l) * SEQ; u64* ssq_ckv = ssq + (size_t)(5 + l) * SEQ; u64* ssq_x1 = ssq + (size_t)(7 + l) * SEQ; \
    (void)ssq_x; (void)ssq_xn; (void)ssq_cq; (void)ssq_ckv; (void)ssq_x1; \
    bf16_t* Win = (bf16_t*)(ws + WS_WIN); bf16_t* Wuq = (bf16_t*)(ws + WS_WUQ); bf16_t* Wukv = (bf16_t*)(ws + WS_WUKV); \
    bf16_t* Wout = (bf16_t*)(ws + WS_WOUT); bf16_t* Wup = (bf16_t*)(ws + WS_WUP); bf16_t* Wdn = (bf16_t*)(ws + WS_WDN); \
    bf16_t* XB = (bf16_t*)(ws + WS_XB); bf16_t* Z = (bf16_t*)(ws + WS_Z); bf16_t* Qb = (bf16_t*)(ws + WS_Q); bf16_t* Kb = (bf16_t*)(ws + WS_K); bf16_t* Vt = (bf16_t*)(ws + WS_VT); \
    float* ST = (float*)(ws + WS_ST); float* DEC = (float*)(ws + WS_DEC); bf16_t* MIX = (bf16_t*)(ws + WS_MIX); \
    bf16_t* UP = (bf16_t*)(ws + WS_UP); bf16_t* ACT = (bf16_t*)(ws + WS_ACT); \
    const float* xin = a.in[0]; float* out = a.out; \
    (void)Win; (void)Wuq; (void)Wukv; (void)Wout; (void)Wup; (void)Wdn; (void)XB; (void)Z; (void)Qb; (void)Kb; (void)Vt; (void)ST; (void)DEC; (void)MIX; (void)UP; (void)ACT; (void)xin; (void)out;

    for (int l = 0; l < NLAYER; ++l) {
        {
            PHASE_BEGIN();
            LAS float* scr = (LAS float*)(L + wave * 16384);
            const float* w_in = a.in[3] + (size_t)l * DM * IN_DIM; const float* w_uq = a.in[5] + (size_t)l * QLORA * QW; const float* w_ukv = a.in[7] + (size_t)l * KVLORA * KVW;
            const float* w_out = a.in[14] + (size_t)l * DM * DM; const float* w_up = a.in[16] + (size_t)l * DM * DFF2; const float* w_dn = a.in[19] + (size_t)l * DFF * DM;
            const float* g_attn = a.in[2] + l * DM; const float* g_cq = a.in[4] + l * QLORA; const float* g_ckv = a.in[6] + l * KVLORA; const float* g_mla = a.in[13] + l * 1024; const float* g_ffn = a.in[15] + l * DM;
            constexpr int I_IN = (DM / 64) * (IN_PAD / 32), I_UQ = (QLORA / 64) * (QW / 32), I_UKV = (KVLORA / 64) * (KVW / 32), I_OUT = (DM / 64) * (DM / 32), I_UP = (DM / 64) * (DFF2 / 32), I_DN = (DFF / 64) * (DM / 32);
            constexpr int NITEMS = I_IN + I_UQ + I_UKV + I_OUT + I_UP + I_DN;
            for (int it = gw; it < NITEMS; it += NGW) {
                int r = it;
                if (r < I_IN) { wt_item(w_in, DM, IN_DIM, g_attn, DM, Win, scr, r, IN_PAD / 32, lane); continue; } r -= I_IN;
                if (r < I_UQ) { wt_item(w_uq, QLORA, QW, g_cq, QLORA, Wuq, scr, r, QW / 32, lane); continue; } r -= I_UQ;
                if (r < I_UKV) { wt_item(w_ukv, KVLORA, KVW, g_ckv, KVLORA, Wukv, scr, r, KVW / 32, lane); continue; } r -= I_UKV;
                if (r < I_OUT) { wt_item(w_out, DM, DM, g_mla, 1024, Wout, scr, r, DM / 32, lane); continue; } r -= I_OUT;
                if (r < I_UP) { wt_item(w_up, DM, DFF2, g_ffn, DM, Wup, scr, r, DFF2 / 32, lane); continue; } r -= I_UP;
                wt_item(w_dn, DFF, DM, g_ffn, 0, Wdn, scr, r, DM / 32, lane);
            }
            if (l == 0) {
                for (int m = gw; m < SEQ; m += NGW) {
                    const f32x4* xr = (const f32x4*)(xin + (size_t)m * DM) + lane; float s = 0.f;
                    u32x2* o8 = (u32x2*)(XB + (size_t)m * DM) + lane;
#pragma unroll
                    for (int j = 0; j < 8; ++j) { const f32x4 v = xr[64 * j]; s += (v[0] * v[0] + v[1] * v[1]) + (v[2] * v[2] + v[3] * v[3]); o8[64 * j] = (u32x2){pk2(v[0], v[1]), pk2(v[2], v[3])}; }
                    s = wave_sum(s); if (lane == 0) ssq_x[m] = (u64)(s * SSQ_FX + 0.5f);
                }
            }
        }
        GRID_SYNC();
        {
            PHASE_BEGIN();
            pg8::Gemm g{XB, Win, SEQ, IN_PAD, DM, DM}; pg8::StaticOrder S; S.init(SEQ, IN_PAD, G, bid);
            pg8::EpiRowScale E{Z, IN_PAD, ssq_x, 1.0f / DM, ssq_cq, 0, 2, ssq_ckv, 2, 3};
            pg8::gemm_phase<pg8::EpiRowScale>(L, g, S, E);
        }
        GRID_SYNC();
        DBG_DUMP(1, bf2f(Z[(size_t)m * IN_PAD + c]) + bf2f(Z[(size_t)m * IN_PAD + 2048 + c]));
        {
            PHASE_BEGIN();
            { pg8::Gemm g{Z + C_CQ, Wuq, SEQ, QW, QLORA, IN_PAD}; pg8::StaticOrder S; S.init(SEQ, QW, G, bid);
              pg8::EpiRowScale E{Qb, QW, ssq_cq, 1.0f / QLORA, nullptr, 0, 0, nullptr, 0, 0};
              pg8::gemm_phase<pg8::EpiRowScale>(L, g, S, E); }
            { pg8::Gemm g{Z + C_CKV, Wukv, SEQ, KVW, KVLORA, IN_PAD}; pg8::StaticOrder S; S.init(SEQ, KVW, G, bid);
              pg8::EpiUkv E{Kb, Vt, ssq_ckv, 1.0f / KVLORA};
              pg8::gemm_phase<pg8::EpiUkv>(L, g, S, E); }
            const float* wgate = a.in[10] + (size_t)l * 16 * (GH * GDK); const float* bgate = a.in[11] + (size_t)l * (GH * GDK);
            for (int u = bid; u < NCHUNK * GH; u += G) gla_chunk_unit(L, Z, wgate, bgate, ST, DEC, u >> 2, u & 3);
        }
        GRID_SYNC();
        DBG_DUMP(2, (c < QW ? bf2f(Qb[(size_t)m * QW + c]) + bf2f(Kb[(size_t)m * QW + c]) : bf2f(Vt[(size_t)(c - QW) * SEQ + m])) + ST[(size_t)m * 8192 + c] + ST[(size_t)m * 8192 + 4096 + c]);
        {
            PHASE_BEGIN();
            const int* pos = (const int*)a.in[1];
            const float* qn = a.in[8] + l * QKD; const float* kn = a.in[9] + l * QKD;
            const float qscale = 0.07216878364870322f * 1.4426950408889634f;
            for (int m = gw; m < SEQ; m += NGW) {
                const int i = lane & 31;
                const float ang = (float)pos[m] * a.inv_freq[i];
                double rev = (double)ang * 0.15915494309189535; rev -= __builtin_rint(rev);
                const float sn = __builtin_amdgcn_sinf((float)rev), cs = __builtin_amdgcn_cosf((float)rev);
                const float krv = bf2f(Z[(size_t)m * IN_PAD + C_KR + lane]);
#pragma unroll
                for (int h = 0; h < NH; ++h) {
                    { bf16_t* p = Qb + (size_t)m * QW + h * QKD;
                      const float a0 = bf2f(p[lane]), a1 = bf2f(p[64 + lane]), a2 = bf2f(p[128 + lane]);
                      const float rstd = rsqrtf(wave_sum(a0 * a0 + a1 * a1 + a2 * a2) * (1.0f / QKD) + EPS);
                      const float n2 = a2 * rstd * qn[128 + lane], pr = __shfl_xor(n2, 32);
                      const float r2 = (lane < 32) ? n2 * cs - pr * sn : n2 * cs + pr * sn;
                      p[lane] = (bf16_t)f2bf(a0 * rstd * qn[lane] * qscale); p[64 + lane] = (bf16_t)f2bf(a1 * rstd * qn[64 + lane] * qscale); p[128 + lane] = (bf16_t)f2bf(r2 * qscale); }
                    { bf16_t* p = Kb + (size_t)m * QW + h * QKD;
                      const float a0 = bf2f(p[lane]), a1 = bf2f(p[64 + lane]), a2 = krv;
                      const float rstd = rsqrtf(wave_sum(a0 * a0 + a1 * a1 + a2 * a2) * (1.0f / QKD) + EPS);
                      const float n2 = a2 * rstd * kn[128 + lane], pr = __shfl_xor(n2, 32);
                      const float r2 = (lane < 32) ? n2 * cs - pr * sn : n2 * cs + pr * sn;
                      p[lane] = (bf16_t)f2bf(a0 * rstd * kn[lane]); p[64 + lane] = (bf16_t)f2bf(a1 * rstd * kn[64 + lane]); p[128 + lane] = (bf16_t)f2bf(r2); }
                }
            }
            constexpr int NE = GH * GDV * GDK;
            for (int e = bid * 512 + tid; e < NE; e += G * 512) {
                const int hd = (e >> 15) * GDK + (e & 127);
                float s = 0.f;
                for (int c0 = 0; c0 < NCHUNK; c0 += 8) {
                    float uu[8], dd[8];
#pragma unroll
                    for (int i = 0; i < 8; ++i) { uu[i] = ST[(size_t)(c0 + i) * NE + e]; dd[i] = DEC[(size_t)(c0 + i) * (GH * GDK) + hd]; }
#pragma unroll
                    for (int i = 0; i < 8; ++i) { s = s * dd[i] + uu[i]; ST[(size_t)(c0 + i) * NE + e] = s; }
                }
            }
        }
        GRID_SYNC();
        DBG_DUMP(3, (c < QW ? bf2f(Qb[(size_t)m * QW + c]) + bf2f(Kb[(size_t)m * QW + c]) : 0.f) + ST[(size_t)m * 8192 + c] + ST[(size_t)m * 8192 + 4096 + c]);
        {
            PHASE_BEGIN();
            for (int p = bid; p < 256; p += G) {
                const int h = p >> 5, s = p & 31;
                attn_unit(L, Qb, Kb, Vt, MIX, h, 63 - s);
                attn_unit(L, Qb, Kb, Vt, MIX, h, s);
            }
            const float* gnorm = a.in[12] + l * GDV;
            for (int u = bid; u < NCHUNK * GH; u += G) gla_out_unit(L, Z, ST, gnorm, MIX, u >> 2, u & 3);
        }
        GRID_SYNC();
        DBG_DUMP(4, bf2f(MIX[(size_t)m * DM + c]));
        { PHASE_BEGIN();
        for (int m = gw; m < SEQ; m += NGW) {
            u32x4* p = (u32x4*)(MIX + (size_t)m * DM) + lane;
            u32x4 v0 = p[0], v1 = p[64]; float s = 0.f;
#pragma unroll
            for (int j = 0; j < 4; ++j) { const float a0 = bflo(v0[j]), a1 = bfhi(v0[j]), b0 = bflo(v1[j]), b1 = bfhi(v1[j]); s += a0 * a0 + a1 * a1 + b0 * b0 + b1 * b1; }
            const float rstd = rsqrtf(wave_sum(s) * (1.0f / 1024.0f) + EPS);
#pragma unroll
            for (int j = 0; j < 4; ++j) { v0[j] = pk2(bflo(v0[j]) * rstd, bfhi(v0[j]) * rstd); v1[j] = pk2(bflo(v1[j]) * rstd, bfhi(v1[j]) * rstd); }
            p[0] = v0; p[64] = v1;
        } }
        GRID_SYNC();
        DBG_DUMP(5, bf2f(MIX[(size_t)m * DM + c]));
        {
            PHASE_BEGIN();
            pg8::Gemm g{MIX, Wout, SEQ, DM, DM, DM}; pg8::StaticOrder S; S.init(SEQ, DM, G, bid);
            pg8::EpiRes E{l == 0 ? xin : out, out, XB, ssq_x1};
            pg8::gemm_phase<pg8::EpiRes>(L, g, S, E);
        }
        GRID_SYNC();
        DBG_DUMP(6, out[(size_t)m * DM + c] + bf2f(XB[(size_t)m * DM + c]));
        {
            PHASE_BEGIN();
            pg8::Gemm g{XB, Wup, SEQ, DFF2, DM, DM}; pg8::StaticOrder S; S.init(SEQ, DFF2, G, bid);
            pg8::EpiRowScale E{UP, DFF2, ssq_x1, 1.0f / DM, nullptr, 0, 0, nullptr, 0, 0};
            pg8::gemm_phase<pg8::EpiRowScale>(L, g, S, E);
        }
        GRID_SYNC();
        DBG_DUMP(7, bf2f(UP[(size_t)m * DFF2 + c]) + bf2f(UP[(size_t)m * DFF2 + 5000 + c]));
        {
            PHASE_BEGIN();
            const float* cw = a.in[17] + (size_t)l * 3 * DFF2; const float* cb = a.in[18] + (size_t)l * DFF2;
            constexpr int NCG = DFF / 8, NTASK = NCG * (SEQ / 64);
            for (int task = bid * 512 + tid; task < NTASK; task += G * 512) {
                const int cgp = task % NCG, seg = task / NCG, c0 = cgp * 8, r0 = seg * 64;
                float wg0[8], wg1[8], wg2[8], wu0[8], wu1[8], wu2[8], bgv[8], buv[8];
#pragma unroll
                for (int j = 0; j < 8; ++j) { wg0[j] = cw[c0 + j]; wg1[j] = cw[DFF2 + c0 + j]; wg2[j] = cw[2 * DFF2 + c0 + j]; wu0[j] = cw[DFF + c0 + j]; wu1[j] = cw[DFF2 + DFF + c0 + j]; wu2[j] = cw[2 * DFF2 + DFF + c0 + j]; bgv[j] = cb[c0 + j]; buv[j] = cb[DFF + c0 + j]; }
                u32x4 g2 = (u32x4){0, 0, 0, 0}, g1 = g2, u2 = g2, u1 = g2;
                if (r0 >= 2) { g2 = *(const u32x4*)(UP + (size_t)(r0 - 2) * DFF2 + c0); u2 = *(const u32x4*)(UP + (size_t)(r0 - 2) * DFF2 + DFF + c0);
                               g1 = *(const u32x4*)(UP + (size_t)(r0 - 1) * DFF2 + c0); u1 = *(const u32x4*)(UP + (size_t)(r0 - 1) * DFF2 + DFF + c0); }
                for (int r = r0; r < r0 + 64; ++r) {
                    const u32x4 gc = *(const u32x4*)(UP + (size_t)r * DFF2 + c0), uc = *(const u32x4*)(UP + (size_t)r * DFF2 + DFF + c0);
                    u32x4 o;
#pragma unroll
                    for (int j = 0; j < 4; ++j) {
                        const float ga = bgv[2 * j] + wg0[2 * j] * bflo(g2[j]) + wg1[2 * j] * bflo(g1[j]) + wg2[2 * j] * bflo(gc[j]);
                        const float gb = bgv[2 * j + 1] + wg0[2 * j + 1] * bfhi(g2[j]) + wg1[2 * j + 1] * bfhi(g1[j]) + wg2[2 * j + 1] * bfhi(gc[j]);
                        const float ua = buv[2 * j] + wu0[2 * j] * bflo(u2[j]) + wu1[2 * j] * bflo(u1[j]) + wu2[2 * j] * bflo(uc[j]);
                        const float ub = buv[2 * j + 1] + wu0[2 * j + 1] * bfhi(u2[j]) + wu1[2 * j + 1] * bfhi(u1[j]) + wu2[2 * j + 1] * bfhi(uc[j]);
                        o[j] = pk2(silu_f(ga) * ua, silu_f(gb) * ub);
                    }
                    *(u32x4*)(ACT + (size_t)r * DFF + c0) = o;
                    g2 = g1; g1 = gc; u2 = u1; u1 = uc;
                }
            }
        }
        GRID_SYNC();
        DBG_DUMP(8, bf2f(ACT[(size_t)m * DFF + c]) + bf2f(ACT[(size_t)m * DFF + 3000 + c]));
        {
            PHASE_BEGIN();
            pg8::Gemm g{ACT, Wdn, SEQ, DM, DFF, DFF}; pg8::StaticOrder S; S.init(SEQ, DM, G, bid);
            pg8::EpiRes E{out, out, XB, ssq_xn};
            pg8::gemm_phase<pg8::EpiRes>(L, g, S, E);
        }
        GRID_SYNC();
        if (DBG_STOP == 9) return;
    }
}

extern "C" void kernel_launch(void* const* d_in, const int* in_sizes, int n_in, void* d_out, int out_size, void* d_ws, size_t ws_size, hipStream_t stream) {
    static int grid = 0;
    if (grid == 0) {
        if (n_in != 20 || out_size != SEQ * DM || ws_size < WS_END) { fprintf(stderr, "kernel_launch: unexpected shapes: n_in %d out %d ws %zu (need %zu)\n", n_in, out_size, ws_size, (size_t)WS_END); grid = -1; return; }
        int dev = 0, cus = 0, per_cu = 0;
        hipGetDevice(&dev); hipDeviceGetAttribute(&cus, hipDeviceAttributeMultiprocessorCount, dev);
        hipFuncSetAttribute((const void*)mk_fwd, hipFuncAttributeMaxDynamicSharedMemorySize, LDS_BYTES);
        hipOccupancyMaxActiveBlocksPerMultiprocessor(&per_cu, (const void*)mk_fwd, 512, LDS_BYTES);
        (void)hipGetLastError();
        if (per_cu < 1) per_cu = 1;
        grid = cus * 1;
    }
    if (grid < 0) return;
    hipMemsetAsync((char*)d_ws + WS_CTL, 0, CTL_BYTES, stream);
    Args a{};
    for (int i = 0; i < 20; ++i) a.in[i] = (const float*)d_in[i];
    a.out = (float*)d_out; a.ws = (unsigned char*)d_ws;
    for (int i = 0; i < 32; ++i) a.inv_freq[i] = (float)pow(10000.0, -(double)i / 32.0);
    void* args[] = {&a};
    hipError_t e = hipLaunchCooperativeKernel((const void*)mk_fwd, dim3(grid), dim3(512), args, LDS_BYTES, stream);
    if (e != hipSuccess) fprintf(stderr, "cooperative launch failed: %s (grid %d)\n", hipGetErrorString(e), grid);
}
```

```cpp
#include <hip/hip_runtime.h>
#include <hip/hip_cooperative_groups.h>
#include <cstdio>
#include <cstdint>
#include <cmath>
namespace cg = cooperative_groups;

#define LAS __attribute__((address_space(3)))
typedef unsigned short bf16_t;
typedef unsigned long long u64;
typedef short bf16x8 __attribute__((ext_vector_type(8)));
typedef short s16x4 __attribute__((ext_vector_type(4)));
typedef float f32x4 __attribute__((ext_vector_type(4)));
typedef float f32x16 __attribute__((ext_vector_type(16)));
typedef unsigned u32x4 __attribute__((ext_vector_type(4)));
typedef unsigned u32x2 __attribute__((ext_vector_type(2)));
typedef float f32x2_t __attribute__((ext_vector_type(2)));
typedef __bf16 bf16x2_t __attribute__((ext_vector_type(2)));

constexpr int SEQ = 16384, DM = 2048, NLAYER = 2;
constexpr int IN_DIM = 3920, IN_PAD = 4096;
constexpr int C_CQ = 0, C_CKV = 512, C_KR = 768, C_GQ = 832, C_GK = 1344, C_GV = 1856, C_GA = 2880, C_GG = 2896;
constexpr int QLORA = 512, KVLORA = 256, NH = 8, QKD = 192, NOPE = 128, VD = 128, QW = NH * QKD  , KVW = NH * 256  ;
constexpr int GH = 4, GDK = 128, GDV = 256, NCHUNK = SEQ / 64;
constexpr int DFF = 5632, DFF2 = 11264;
constexpr float EPS = 1e-6f;

constexpr size_t MiB = 1u << 20;
constexpr size_t WS_CTL = 0, CTL_BYTES = 2 * MiB;
constexpr size_t WS_BAR = 0;
constexpr size_t WS_SSQ = 65536;
constexpr size_t WS_WIN = 2 * MiB, WS_WUQ = 18 * MiB, WS_WUKV = WS_WUQ + 3 * MiB / 2, WS_WOUT = WS_WUKV + 1 * MiB, WS_WUP = WS_WOUT + 8 * MiB, WS_WDN = WS_WUP + 44 * MiB;
constexpr size_t WS_XB = 95 * MiB;
constexpr size_t WS_R = 159 * MiB;
constexpr size_t WS_Z = WS_R, WS_Q = WS_Z + 128 * MiB, WS_K = WS_Q + 48 * MiB, WS_VT = WS_K + 48 * MiB, WS_ST = WS_VT + 32 * MiB, WS_DEC = WS_ST + 128 * MiB, WS_MIX = WS_DEC + 1 * MiB;
constexpr size_t WS_UP = WS_R, WS_ACT = WS_UP + 352 * MiB, WS_END = WS_ACT + 176 * MiB;
static_assert(WS_MIX + 64 * MiB <= WS_END, "ws map");

#define LAUNDER_V(x) asm volatile("" : "+v"(x))
#define LAUNDER_S(x) asm volatile("" : "+s"(x))
__device__ __forceinline__ unsigned f2bf(float f) { unsigned u = __builtin_bit_cast(unsigned, f); return (u + 0x7fffu + ((u >> 16) & 1u)) >> 16; }
__device__ __forceinline__ unsigned pk2(float lo, float hi) { f32x2_t v = {lo, hi}; bf16x2_t b = __builtin_convertvector(v, bf16x2_t); return __builtin_bit_cast(unsigned, b); }
__device__ __forceinline__ float bf2f(unsigned b) { return __builtin_bit_cast(float, b << 16); }
__device__ __forceinline__ float bflo(unsigned w) { return __builtin_bit_cast(float, w << 16); }
__device__ __forceinline__ float bfhi(unsigned w) { return __builtin_bit_cast(float, w & 0xffff0000u); }
__device__ __forceinline__ float wave_sum(float v) {
#pragma unroll
    for (int o = 1; o < 64; o <<= 1) v += __shfl_xor(v, o);
    return v;
}
constexpr float SSQ_FX = 1048576.0f, SSQ_INV = 1.0f / 1048576.0f;
__device__ __forceinline__ void ssq_add(u64* p, float v) { __hip_atomic_fetch_add(p, (u64)(v * SSQ_FX + 0.5f), __ATOMIC_RELAXED, __HIP_MEMORY_SCOPE_AGENT); }
__device__ __forceinline__ float ssq_get(const u64* p) { return (float)(*p) * SSQ_INV; }
__device__ __forceinline__ float silu_f(float x) { return x * __builtin_amdgcn_rcpf(1.0f + __expf(-x)); }

namespace pg8 {
constexpr int BM = 256, BK = 64, HALF = 128, HTB = HALF * BK * 2, STAGE_BYTES = 8 * HTB, NXCD = 8, WGM = 8;
__host__ __device__ __forceinline__ int lds_byte(int r, int c) { const int st = (r >> 4) * 2 + (c >> 5), rr = r & 15, cc = c & 31, ob = rr * 64 + cc * 2; return st * 1024 + (ob ^ (((ob >> 9) & 1) << 5)); }
__host__ __device__ __forceinline__ void stage_rc(int b, int& R, int& C) { const int st = b / 1024, sb = b % 1024, swz = sb ^ (((sb >> 9) & 1) << 5); R = (st >> 1) * 16 + swz / 64; C = (st & 1) * 32 + (swz % 64) / 2; }
__host__ __device__ __forceinline__ int perm32(int rho) { const int n = rho >> 4, i = rho & 15; return 8 * (i >> 2) + 4 * n + (i & 3); }

struct Unit { int pm, pn; };
struct Gemm { const bf16_t* A; const bf16_t* Bt; int M, N, K, lda; };

struct StaticOrder {
    int nM, nN, nwg, G, c;
    __device__ void init(int M, int N, int G_, int c_) { nM = M / BM; nN = N / BM; nwg = nM * nN; G = G_; c = c_; }
    __device__ bool next(int i, Unit& u) const {
        const long L = (long)i * G + c; if (L >= nwg) return false;
        int wgid = (int)L; { const int q = nwg / NXCD, r = nwg % NXCD, xcd = wgid % NXCD, off = wgid / NXCD; wgid = (xcd < r ? xcd * (q + 1) : r * (q + 1) + (xcd - r) * q) + off; }
        const int nig = WGM * nN, gid = wgid / nig, fm = gid * WGM, gsz = (nM - fm) < WGM ? (nM - fm) : WGM;
        u.pm = fm + ((wgid % nig) % gsz); u.pn = (wgid % nig) / gsz; return true;
    }
};

struct EpiRowScale {
    static constexpr bool PERM = true;
    bf16_t* O; int ldc; const u64* ssq_in; float inv_dim; u64* ssq_a; int a_lo, a_hi; u64* ssq_b; int b_lo, b_hi;
    __device__ __forceinline__ void operator()(const f32x4 (&acc)[2][2][4][2], const Unit& u, int wr, int wc, int fr, int fq) const {
        const int row0 = u.pm * BM + wr * 64 + fr, col0 = u.pn * BM + wc * 32 + 8 * fq;
        u64* sacc = (u.pn >= a_lo && u.pn < a_hi) ? ssq_a : ((u.pn >= b_lo && u.pn < b_hi) ? ssq_b : nullptr);
#pragma unroll
        for (int ai = 0; ai < 2; ++ai)
#pragma unroll
            for (int m = 0; m < 4; ++m) {
                const int row = row0 + ai * HALF + m * 16;
                const float sc = ssq_in ? rsqrtf(ssq_get(ssq_in + row) * inv_dim + EPS) : 1.0f;
                float ss = 0.f;
#pragma unroll
                for (int bj = 0; bj < 2; ++bj) {
                    const f32x4 v0 = acc[ai][bj][m][0] * sc, v1 = acc[ai][bj][m][1] * sc;
                    ss += (v0[0] * v0[0] + v0[1] * v0[1]) + (v0[2] * v0[2] + v0[3] * v0[3]) + (v1[0] * v1[0] + v1[1] * v1[1]) + (v1[2] * v1[2] + v1[3] * v1[3]);
                    u32x4 w; w.x = pk2(v0[0], v0[1]); w.y = pk2(v0[2], v0[3]); w.z = pk2(v1[0], v1[1]); w.w = pk2(v1[2], v1[3]);
                    *(u32x4*)(O + (size_t)row * ldc + col0 + bj * HALF) = w;
                }
                if (sacc) { ss += __shfl_xor(ss, 16); ss += __shfl_xor(ss, 32); if (fq == 0) ssq_add(sacc + row, ss); }
            }
    }
};
struct EpiUkv {
    static constexpr bool PERM = true;
    bf16_t* Kb; bf16_t* Vt; const u64* ssq_in; float inv_dim;
    __device__ __forceinline__ void operator()(const f32x4 (&acc)[2][2][4][2], const Unit& u, int wr, int wc, int fr, int fq) const {
        const int row0 = u.pm * BM + wr * 64 + fr, c0 = wc * 32 + 8 * fq;
#pragma unroll
        for (int ai = 0; ai < 2; ++ai)
#pragma unroll
            for (int m = 0; m < 4; ++m) {
                const int row = row0 + ai * HALF + m * 16;
                const float sc = rsqrtf(ssq_get(ssq_in + row) * inv_dim + EPS);
                { const f32x4 v0 = acc[ai][0][m][0] * sc, v1 = acc[ai][0][m][1] * sc;
                  u32x4 w; w.x = pk2(v0[0], v0[1]); w.y = pk2(v0[2], v0[3]); w.z = pk2(v1[0], v1[1]); w.w = pk2(v1[2], v1[3]);
                  *(u32x4*)(Kb + (size_t)row * QW + u.pn * QKD + c0) = w; }
#pragma unroll
                for (int n = 0; n < 2; ++n)
#pragma unroll
                    for (int j = 0; j < 4; ++j) Vt[(size_t)(u.pn * VD + c0 + 4 * n + j) * SEQ + row] = (bf16_t)f2bf(acc[ai][1][m][n][j] * sc);
            }
    }
};
struct EpiRes {
    static constexpr bool PERM = true;
    const float* base; float* out; bf16_t* xb; u64* ssq_out;
    __device__ __forceinline__ void operator()(const f32x4 (&acc)[2][2][4][2], const Unit& u, int wr, int wc, int fr, int fq) const {
        const int row0 = u.pm * BM + wr * 64 + fr, col0 = u.pn * BM + wc * 32 + 8 * fq;
#pragma unroll
        for (int ai = 0; ai < 2; ++ai)
#pragma unroll
            for (int m = 0; m < 4; ++m) {
                const int row = row0 + ai * HALF + m * 16; float ss = 0.f;
#pragma unroll
                for (int bj = 0; bj < 2; ++bj) {
                    const size_t off = (size_t)row * DM + col0 + bj * HALF;
                    const f32x4 v0 = acc[ai][bj][m][0] + *(const f32x4*)(base + off), v1 = acc[ai][bj][m][1] + *(const f32x4*)(base + off + 4);
                    ss += (v0[0] * v0[0] + v0[1] * v0[1]) + (v0[2] * v0[2] + v0[3] * v0[3]) + (v1[0] * v1[0] + v1[1] * v1[1]) + (v1[2] * v1[2] + v1[3] * v1[3]);
                    *(f32x4*)(out + off) = v0; *(f32x4*)(out + off + 4) = v1;
                    u32x4 w; w.x = pk2(v0[0], v0[1]); w.y = pk2(v0[2], v0[3]); w.z = pk2(v1[0], v1[1]); w.w = pk2(v1[2], v1[3]);
                    *(u32x4*)(xb + off) = w;
                }
                ss += __shfl_xor(ss, 16); ss += __shfl_xor(ss, 32); if (fq == 0) ssq_add(ssq_out + row, ss);
            }
    }
};

template <class Epi>
__device__ __forceinline__ void gemm_phase(LAS unsigned char* lds, const Gemm g, const StaticOrder& S, const Epi& E) {
    int tid_ = threadIdx.x; LAUNDER_V(tid_);
    const int tid = tid_, wid = __builtin_amdgcn_readfirstlane(tid >> 6), lane = tid & 63, wr = wid >> 2, wc = wid & 3, fr = lane & 15, fq = lane >> 4;
    const int K = g.K, nt = K / BK;
    unsigned voffA[2], voffB[2];
#pragma unroll
    for (int i = 0; i < 2; ++i) { int R, C; stage_rc(tid * 16 + i * 8192, R, C); const int Rb = Epi::PERM ? ((R & ~31) + perm32(R & 31)) : R;
        voffA[i] = (unsigned)(R * g.lda + C) * 2u; voffB[i] = (unsigned)(Rb * K + C) * 2u; }
    const size_t kstep = (size_t)(BK * 2);
    const size_t hstepA = (size_t)HALF * g.lda * 2, hstepB = (size_t)HALF * K * 2;
    const size_t tstepA = 2 * hstepA, tstepB = 2 * hstepB;
    const unsigned ldsw = (unsigned)wid * 1024u;
    const int aoff = lds_byte(wr * 64 + fr, fq * 8), boff = lds_byte(wc * 32 + fr, fq * 8);
#define PG8_SA(b, h) (((b) * 2 + (h)) * HTB)
#define PG8_SB(b, h) ((4 + (b) * 2 + (h)) * HTB)
#define PG8_STAGE(bufoff, gbase, voff) do { _Pragma("unroll") for (int _i = 0; _i < 2; ++_i) \
        __builtin_amdgcn_global_load_lds((const unsigned*)((const char*)(gbase) + (voff)[_i]), (LAS unsigned*)(lds + (bufoff) + ldsw + _i * 8192), 16, 0, 0); } while (0)
#define PG8_LDA(dst, b, h) do { _Pragma("unroll") for (int m = 0; m < 4; ++m) _Pragma("unroll") for (int k = 0; k < 2; ++k) dst[m][k] = *(const LAS bf16x8*)(lds + PG8_SA(b, h) + aoff + m * 2048 + k * 1024); } while (0)
#define PG8_LDB(dst, b, h) do { _Pragma("unroll") for (int n = 0; n < 2; ++n) _Pragma("unroll") for (int k = 0; k < 2; ++k) dst[n][k] = *(const LAS bf16x8*)(lds + PG8_SB(b, h) + boff + n * 2048 + k * 1024); } while (0)
#define PG8_MMA(ai, bj, At, Bt) do { __builtin_amdgcn_s_setprio(1); _Pragma("unroll") for (int m = 0; m < 4; ++m) _Pragma("unroll") for (int n = 0; n < 2; ++n) _Pragma("unroll") for (int k = 0; k < 2; ++k) \
        acc[ai][bj][m][n] = __builtin_amdgcn_mfma_f32_16x16x32_bf16(Bt[n][k], At[m][k], acc[ai][bj][m][n], 0, 0, 0); __builtin_amdgcn_s_setprio(0); } while (0)
#define PG8_WAIT_V(n) asm volatile("s_waitcnt vmcnt(" #n ")" ::: "memory")
#define PG8_WAIT_L(n) asm volatile("s_waitcnt lgkmcnt(" #n ")" ::: "memory")
#define PG8_BAR __builtin_amdgcn_s_barrier()
#define PG8_SCHED __builtin_amdgcn_sched_barrier(0)
    Unit cur, nxt; int ui = 0;
    if (!S.next(0, cur)) return;
    f32x4 acc[2][2][4][2];
#pragma unroll
    for (int a = 0; a < 2; ++a)
#pragma unroll
        for (int b = 0; b < 2; ++b)
#pragma unroll
            for (int m = 0; m < 4; ++m)
#pragma unroll
                for (int n = 0; n < 2; ++n) acc[a][b][m][n] = (f32x4){0.f, 0.f, 0.f, 0.f};
    bf16x8 At[4][2], B0[2][2], B1[2][2];
    const char* cA = (const char*)g.A + (size_t)cur.pm * tstepA; const char* cB = (const char*)g.Bt + (size_t)cur.pn * tstepB;
    PG8_STAGE(PG8_SB(0, 0), cB, voffB); PG8_STAGE(PG8_SB(0, 1), cB + hstepB, voffB); PG8_STAGE(PG8_SA(0, 0), cA, voffA); PG8_STAGE(PG8_SA(0, 1), cA + hstepA, voffA);
    if (wr == 1) PG8_BAR;
    PG8_WAIT_V(2); PG8_BAR;
    PG8_STAGE(PG8_SB(1, 0), cB + kstep, voffB); PG8_STAGE(PG8_SA(1, 0), cA + kstep, voffA); PG8_STAGE(PG8_SB(1, 1), cB + hstepB + kstep, voffB);
    PG8_WAIT_V(6); PG8_BAR;
    for (;;) {
        const bool has_next = S.next(ui + 1, nxt);
        const char* nA = has_next ? (const char*)g.A + (size_t)nxt.pm * tstepA : cA; const char* nB = has_next ? (const char*)g.Bt + (size_t)nxt.pn * tstepB : cB;
        for (int t = 0; t < nt; t += 2) {
            const bool last = (t == nt - 2);
            const char* a1 = cA + (size_t)(t + 1) * kstep;
            const char* a2 = last ? nA : cA + (size_t)(t + 2) * kstep; const char* b2 = last ? nB : cB + (size_t)(t + 2) * kstep;
            const char* a3 = a2 + kstep; const char* b3 = b2 + kstep;
            PG8_LDB(B0, 0, 0); PG8_LDB(B1, 0, 1); PG8_SCHED; PG8_LDA(At, 0, 0); PG8_STAGE(PG8_SA(1, 1), a1 + hstepA, voffA);
            PG8_WAIT_V(8); PG8_WAIT_L(0); PG8_BAR; PG8_MMA(0, 0, At, B0); PG8_MMA(0, 1, At, B1); PG8_BAR; PG8_SCHED;
            PG8_LDA(At, 0, 1); PG8_STAGE(PG8_SB(0, 0), b2, voffB); PG8_STAGE(PG8_SB(0, 1), b2 + hstepB, voffB); PG8_STAGE(PG8_SA(0, 0), a2, voffA);
            PG8_WAIT_V(8); PG8_WAIT_L(0); PG8_BAR; PG8_MMA(1, 0, At, B0); PG8_MMA(1, 1, At, B1); PG8_BAR; PG8_SCHED;
            PG8_LDB(B0, 1, 0); PG8_LDB(B1, 1, 1); PG8_SCHED; PG8_LDA(At, 1, 0); PG8_STAGE(PG8_SA(0, 1), a2 + hstepA, voffA);
            PG8_WAIT_V(8); PG8_WAIT_L(0); PG8_BAR; PG8_MMA(0, 0, At, B0); PG8_MMA(0, 1, At, B1); PG8_BAR; PG8_SCHED;
            PG8_LDA(At, 1, 1); PG8_STAGE(PG8_SB(1, 0), b3, voffB); PG8_STAGE(PG8_SB(1, 1), b3 + hstepB, voffB); PG8_STAGE(PG8_SA(1, 0), a3, voffA);
            PG8_WAIT_V(8); PG8_WAIT_L(0); PG8_BAR; PG8_MMA(1, 0, At, B0); PG8_MMA(1, 1, At, B1); PG8_BAR; PG8_SCHED;
        }
        if (wr == 0) PG8_BAR;
        { int frE = fr, fqE = fq; LAUNDER_V(frE); LAUNDER_V(fqE); E(acc, cur, wr, wc, frE, fqE); }
        if (!has_next) break;
#pragma unroll
        for (int a = 0; a < 2; ++a)
#pragma unroll
            for (int b = 0; b < 2; ++b)
#pragma unroll
                for (int m = 0; m < 4; ++m)
#pragma unroll
                    for (int n = 0; n < 2; ++n) acc[a][b][m][n] = (f32x4){0.f, 0.f, 0.f, 0.f};
        cur = nxt; cA = nA; cB = nB; ++ui;
        if (wr == 1) PG8_BAR;
    }
    PG8_WAIT_V(0);
    PG8_BAR;
#undef PG8_SA
#undef PG8_SB
#undef PG8_STAGE
#undef PG8_LDA
#undef PG8_LDB
#undef PG8_MMA
#undef PG8_WAIT_V
#undef PG8_WAIT_L
#undef PG8_BAR
#undef PG8_SCHED
}
}

constexpr int RING_BYTES = 131072;
constexpr int LDS_BYTES = 147456;

struct Args { const float* in[20]; float* out; unsigned char* ws; float inv_freq[32]; };

#define MFMA32(a, b, c) __builtin_amdgcn_mfma_f32_32x32x16_bf16((a), (b), (c), 0, 0, 0)
__device__ __forceinline__ int crow(int r, int hi) { return (r & 3) + 8 * (r >> 2) + 4 * hi; }

__device__ __forceinline__ void wt_item(const float* __restrict__ W, int K, int N, const float* __restrict__ gain, int gainK, bf16_t* WT, LAS float* scr, int item, int nblk, int lane) {
    const int kb = item / nblk, nb = item % nblk, k0 = 64 * kb, n0 = 32 * nb;
    const int n = n0 + (lane & 31);
#pragma unroll 8
    for (int i = 0; i < 32; ++i) { const int kk = 2 * i + (lane >> 5); float w = (n < N) ? W[(size_t)(k0 + kk) * N + n] : 0.f; if ((k0 + kk) < gainK) w *= gain[k0 + kk]; scr[kk * 33 + (lane & 31)] = w; }
    asm volatile("s_waitcnt lgkmcnt(0)" ::: "memory");
    const int c = lane & 7;
#pragma unroll
    for (int j = 0; j < 4; ++j) { const int nn = (lane >> 3) + 8 * j; const LAS float* s = scr + (8 * c) * 33 + nn;
        u32x4 o; o.x = pk2(s[0 * 33], s[1 * 33]); o.y = pk2(s[2 * 33], s[3 * 33]); o.z = pk2(s[4 * 33], s[5 * 33]); o.w = pk2(s[6 * 33], s[7 * 33]);
        *(u32x4*)(WT + (size_t)(n0 + nn) * K + k0 + 8 * c) = o; }
    asm volatile("s_waitcnt lgkmcnt(0)" ::: "memory");
}

constexpr int AT_KSTR = 400, AT_VSTR = 144;
constexpr int AT_KB = 64 * AT_KSTR  , AT_VB = 128 * AT_VSTR  , AT_K0 = 0, AT_V0 = 2 * AT_KB, AT_WSF = AT_V0 + 2 * AT_VB;
static_assert(AT_WSF + 8 * 128 <= RING_BYTES, "attn lds");

__device__ __forceinline__ void attn_unit(LAS unsigned char* L, const bf16_t* __restrict__ Q, const bf16_t* __restrict__ Kg, const bf16_t* __restrict__ Vt, bf16_t* mix, int h, int qb) {
    int tid_ = threadIdx.x; LAUNDER_V(tid_);
    const int tid = tid_, lane = tid & 63, w = __builtin_amdgcn_readfirstlane(tid >> 6), r32 = lane & 31, hh = lane >> 5;
    const int q0 = qb * 256;
    bf16x8 qf[12];
    { const bf16_t* qrow = Q + (size_t)(q0 + 32 * w + r32) * QW + h * QKD + 8 * hh;
#pragma unroll
      for (int ks = 0; ks < 12; ++ks) qf[ks] = *(const bf16x8*)(qrow + 16 * ks); }
    f32x16 o[4];
#pragma unroll
    for (int d = 0; d < 4; ++d)
#pragma unroll
        for (int i = 0; i < 16; ++i) o[d][i] = 0.f;
    float m_run = -1e30f, l_run = 0.f;
    const int NT = 4 * qb + 4, my_last = 4 * qb + (w >> 1);
    volatile LAS float* wsf = (volatile LAS float*)(L + AT_WSF) + w * 32;
    u32x4 kst[3], vst[2];
    int krow_[3], kcc_[3], vrow_[2], vcc_[2];
#pragma unroll
    for (int i = 0; i < 3; ++i) { const int id = tid + 512 * i; krow_[i] = id / 24; kcc_[i] = id % 24; }
#pragma unroll
    for (int i = 0; i < 2; ++i) { const int id = tid + 512 * i; vrow_[i] = id >> 3; vcc_[i] = id & 7; }
#define AT_GLOAD(t) do { const int kv0_ = (t) * 64; \
    _Pragma("unroll") for (int i = 0; i < 3; ++i) kst[i] = *(const u32x4*)(Kg + (size_t)(kv0_ + krow_[i]) * QW + h * QKD + kcc_[i] * 8); \
    _Pragma("unroll") for (int i = 0; i < 2; ++i) vst[i] = *(const u32x4*)(Vt + (size_t)(h * VD + vrow_[i]) * SEQ + kv0_ + vcc_[i] * 8); } while (0)
#define AT_SSTORE(buf) do { \
    _Pragma("unroll") for (int i = 0; i < 3; ++i) *(LAS u32x4*)(L + AT_K0 + (buf) * AT_KB + krow_[i] * AT_KSTR + kcc_[i] * 16) = kst[i]; \
    _Pragma("unroll") for (int i = 0; i < 2; ++i) *(LAS u32x4*)(L + AT_V0 + (buf) * AT_VB + vrow_[i] * AT_VSTR + vcc_[i] * 16) = vst[i]; } while (0)
    AT_GLOAD(0); AT_SSTORE(0); __syncthreads();
    for (int t = 0; t < NT; ++t) {
        const int buf = t & 1;
        if (t + 1 < NT) AT_GLOAD(t + 1);
        if (t <= my_last) {
            const LAS unsigned char* Kt = L + AT_K0 + buf * AT_KB + r32 * AT_KSTR + hh * 16;
            const LAS unsigned char* Vb = L + AT_V0 + buf * AT_VB + r32 * AT_VSTR + hh * 8;
            f32x16 p0, p1;
#pragma unroll
            for (int i = 0; i < 16; ++i) { p0[i] = 0.f; p1[i] = 0.f; }
#pragma unroll
            for (int ks = 0; ks < 12; ++ks) {
                const bf16x8 a0 = *(const LAS bf16x8*)(Kt + ks * 32), a1 = *(const LAS bf16x8*)(Kt + 32 * AT_KSTR + ks * 32);
                p0 = MFMA32(a0, qf[ks], p0); p1 = MFMA32(a1, qf[ks], p1);
            }
            float mx = fmaxf(p0[0], p1[0]);
#pragma unroll
            for (int i = 1; i < 16; ++i) mx = fmaxf(mx, fmaxf(p0[i], p1[i]));
            mx = fmaxf(mx, __shfl_xor(mx, 32));
            const float m_new = fmaxf(m_run, mx), alpha = __builtin_amdgcn_exp2f(m_run - m_new); m_run = m_new;
            float ls = 0.f;
#pragma unroll
            for (int i = 0; i < 16; ++i) { p0[i] = __builtin_amdgcn_exp2f(p0[i] - m_new); p1[i] = __builtin_amdgcn_exp2f(p1[i] - m_new); ls += p0[i] + p1[i]; }
            l_run = l_run * alpha + ls;
            wsf[r32] = alpha;
            asm volatile("s_waitcnt lgkmcnt(0)" ::: "memory");
#pragma unroll
            for (int i = 0; i < 16; ++i) { const float a = wsf[crow(i, hh)];
#pragma unroll
                for (int d = 0; d < 4; ++d) o[d][i] *= a; }
#pragma unroll
            for (int kb = 0; kb < 2; ++kb)
#pragma unroll
                for (int s = 0; s < 2; ++s) {
                    u32x4 pw;
                    if (kb == 0) { pw.x = pk2(p0[8 * s + 0], p0[8 * s + 1]); pw.y = pk2(p0[8 * s + 2], p0[8 * s + 3]); pw.z = pk2(p0[8 * s + 4], p0[8 * s + 5]); pw.w = pk2(p0[8 * s + 6], p0[8 * s + 7]); }
                    else         { pw.x = pk2(p1[8 * s + 0], p1[8 * s + 1]); pw.y = pk2(p1[8 * s + 2], p1[8 * s + 3]); pw.z = pk2(p1[8 * s + 4], p1[8 * s + 5]); pw.w = pk2(p1[8 * s + 6], p1[8 * s + 7]); }
                    const bf16x8 xs = __builtin_bit_cast(bf16x8, pw);
#pragma unroll
                    for (int d = 0; d < 4; ++d) {
                        const LAS unsigned char* vp = Vb + d * 32 * AT_VSTR + (32 * kb + 16 * s) * 2;
                        const s16x4 lo = *(const LAS s16x4*)(vp), hi = *(const LAS s16x4*)(vp + 16);
                        const bf16x8 pb = __builtin_shufflevector(lo, hi, 0, 1, 2, 3, 4, 5, 6, 7);
                        o[d] = MFMA32(xs, pb, o[d]);
                    }
                }
        }
        if (t + 1 < NT) AT_SSTORE(buf ^ 1);
        __syncthreads();
    }
#undef AT_GLOAD
#undef AT_SSTORE
    const float lt = l_run + __shfl_xor(l_run, 32);
    wsf[r32] = 1.0f / lt;
    asm volatile("s_waitcnt lgkmcnt(0)" ::: "memory");
    bf16_t* orow = mix + (size_t)(q0 + 32 * w) * DM + h * VD + r32;
#pragma unroll
    for (int i = 0; i < 16; ++i) { const int qr = crow(i, hh); const float a = wsf[qr];
#pragma unroll
        for (int d = 0; d < 4; ++d) orow[(size_t)qr * DM + 32 * d] = (bf16_t)f2bf(o[d][i] * a); }
    __syncthreads();
}

constexpr int GL_V = 0  , GL_KD = 32768  , GL_TOT = GL_KD + 18432  , GL_ZA = GL_TOT + 2048  ;
__device__ __forceinline__ void gla_chunk_unit(LAS unsigned char* L, const bf16_t* __restrict__ Z, const float* __restrict__ wgate, const float* __restrict__ bgate, float* ST, float* DEC, int c, int h) {
    int tid_ = threadIdx.x; LAUNDER_V(tid_);
    const int tid = tid_, lane = tid & 63, w = __builtin_amdgcn_readfirstlane(tid >> 6), r32 = lane & 31, hh = lane >> 5;
    const size_t row0 = (size_t)c * 64;
#pragma unroll
    for (int i = 0; i < 4; ++i) { const int id = tid + 512 * i, r = id >> 5, cc = id & 31;
        *(LAS u32x4*)(L + GL_V + r * 512 + cc * 16) = *(const u32x4*)(Z + (row0 + r) * IN_PAD + C_GV + h * GDV + cc * 8); }
#pragma unroll
    for (int i = 0; i < 2; ++i) { const int id = tid + 512 * i, r = id >> 4, cc = id & 15;
        ((LAS float*)(L + GL_ZA))[id] = bf2f(Z[(row0 + r) * IN_PAD + C_GA + cc]); }
    __syncthreads();
    const int tq = tid >> 7, col = tid & 127;
    float wg[16];
#pragma unroll
    for (int r = 0; r < 16; ++r) wg[r] = wgate[r * (GH * GDK) + h * GDK + col];
    const float bg = bgate[h * GDK + col];
    float pre[16]; float run = 0.f;
#pragma unroll
    for (int i = 0; i < 16; ++i) {
        const LAS float* za = (const LAS float*)(L + GL_ZA) + (16 * tq + i) * 16;
        float ga = bg;
#pragma unroll
        for (int r = 0; r < 16; ++r) ga += za[r] * wg[r];
        const float ls = fminf(ga, 0.f) - __logf(1.0f + __expf(-fabsf(ga)));
        run += ls * (1.0f / 16.0f); pre[i] = run;
    }
    ((LAS float*)(L + GL_TOT))[tq * 128 + col] = run;
    __syncthreads();
    float off = 0.f, bend = 0.f;
#pragma unroll
    for (int t = 0; t < 4; ++t) { const float v = ((LAS float*)(L + GL_TOT))[t * 128 + col]; bend += v; if (t < tq) off += v; }
    {
        unsigned pkv[8];
#pragma unroll
        for (int i = 0; i < 16; i += 2) {
            const float k0 = bf2f(Z[(row0 + 16 * tq + i) * IN_PAD + C_GK + h * GDK + col]), k1 = bf2f(Z[(row0 + 16 * tq + i + 1) * IN_PAD + C_GK + h * GDK + col]);
            pkv[i >> 1] = pk2(k0 * __expf(bend - off - pre[i]), k1 * __expf(bend - off - pre[i + 1]));
        }
        LAS u32x4* dst = (LAS u32x4*)(L + GL_KD + col * 144 + tq * 32);
        dst[0] = (u32x4){pkv[0], pkv[1], pkv[2], pkv[3]}; dst[1] = (u32x4){pkv[4], pkv[5], pkv[6], pkv[7]};
    }
    if (tq == 0) DEC[(size_t)(c * GH + h) * GDK + col] = __expf(bend);
    __syncthreads();
    f32x16 acc[4];
#pragma unroll
    for (int d = 0; d < 4; ++d)
#pragma unroll
        for (int i = 0; i < 16; ++i) acc[d][i] = 0.f;
#pragma unroll
    for (int ks = 0; ks < 4; ++ks) {
        bf16x8 a;
#pragma unroll
        for (int j = 0; j < 8; ++j) a[j] = (short)*(const LAS unsigned short*)(L + GL_V + (16 * ks + 8 * hh + j) * 512 + (32 * w + r32) * 2);
#pragma unroll
        for (int db = 0; db < 4; ++db) {
            const bf16x8 b = *(const LAS bf16x8*)(L + GL_KD + (32 * db + r32) * 144 + (16 * ks + 8 * hh) * 2);
            acc[db] = MFMA32(a, b, acc[db]);
        }
    }
    float* stp = ST + ((size_t)(c * GH + h) * GDV + 32 * w) * GDK + r32;
#pragma unroll
    for (int db = 0; db < 4; ++db)
#pragma unroll
        for (int i = 0; i < 16; ++i) stp[(size_t)crow(i, hh) * GDK + 32 * db] = acc[db][i];
    __syncthreads();
}

constexpr int GO_STR = 260;
__device__ __forceinline__ void gla_out_unit(LAS unsigned char* L, const bf16_t* __restrict__ Z, const float* __restrict__ ST, const float* __restrict__ gnorm, bf16_t* mix, int c, int h) {
    int tid_ = threadIdx.x; LAUNDER_V(tid_);
    const int tid = tid_, lane = tid & 63, w = __builtin_amdgcn_readfirstlane(tid >> 6), r32 = lane & 31, hh = lane >> 5;
    const size_t row0 = (size_t)c * 64;
    f32x16 acc[2];
#pragma unroll
    for (int d = 0; d < 2; ++d)
#pragma unroll
        for (int i = 0; i < 16; ++i) acc[d][i] = 0.f;
    const float* sp = ST + ((size_t)(c * GH + h) * GDV + 32 * w + r32) * GDK + 8 * hh;
#pragma unroll
    for (int ks = 0; ks < 8; ++ks) {
        const f32x4 s0 = *(const f32x4*)(sp + 16 * ks), s1 = *(const f32x4*)(sp + 16 * ks + 4);
        u32x4 bw; bw.x = pk2(s0[0], s0[1]); bw.y = pk2(s0[2], s0[3]); bw.z = pk2(s1[0], s1[1]); bw.w = pk2(s1[2], s1[3]);
        const bf16x8 b = __builtin_bit_cast(bf16x8, bw);
#pragma unroll
        for (int tb = 0; tb < 2; ++tb) {
            const bf16x8 a = *(const bf16x8*)(Z + (row0 + 32 * tb + r32) * IN_PAD + C_GQ + h * GDK + 16 * ks + 8 * hh);
            acc[tb] = MFMA32(a, b, acc[tb]);
        }
    }
    LAS float* of = (LAS float*)L;
#pragma unroll
    for (int tb = 0; tb < 2; ++tb)
#pragma unroll
        for (int i = 0; i < 16; ++i) of[(32 * tb + crow(i, hh)) * GO_STR + 32 * w + r32] = acc[tb][i] * 0.08838834764831845f;
    __syncthreads();
    const int tok = tid >> 3, part = tid & 7;
    float v[32]; float ss = 0.f;
#pragma unroll
    for (int i = 0; i < 32; ++i) { v[i] = of[tok * GO_STR + i * 8 + part]; ss += v[i] * v[i]; }
    ss += __shfl_xor(ss, 1); ss += __shfl_xor(ss, 2); ss += __shfl_xor(ss, 4);
    const float rstd = rsqrtf(ss * (1.0f / GDV) + EPS);
    const bf16_t* zg = Z + (row0 + tok) * IN_PAD + C_GG + h * GDV;
    bf16_t* op = mix + (row0 + tok) * DM + 1024 + h * GDV;
#pragma unroll
    for (int i = 0; i < 32; ++i) { const int dv = i * 8 + part; const float g = bf2f(zg[dv]); op[dv] = (bf16_t)f2bf(v[i] * rstd * gnorm[dv] * silu_f(g)); }
    __syncthreads();
}


#define XB_TMO      128
#define XB_XCNT(j)  (256  + 64 * (j))
#define XB_XSUB(j)  (1280 + 64 * (j))
#define XB_XGEN(j)  (2304 + 64 * (j))
#define XB_TOP      3328
#define XB_TOPGEN   3392
#define XCD_BAR_WORDS 3456
#define XB_SPIN_CAP (1u << 22)
__device__ __forceinline__ unsigned xb_ld(unsigned* p)              { return __hip_atomic_load(p, __ATOMIC_RELAXED, __HIP_MEMORY_SCOPE_AGENT); }
__device__ __forceinline__ unsigned xb_add(unsigned* p, unsigned v) { return __hip_atomic_fetch_add(p, v, __ATOMIC_RELAXED, __HIP_MEMORY_SCOPE_AGENT); }
__device__ __forceinline__ unsigned xb_xcc_id() { return (unsigned)__builtin_amdgcn_s_getreg((3 << 11) | 20) & 0xFu; }
#define XB_SPIN(cond, bar) do { unsigned _sp = 0; while (cond) { __builtin_amdgcn_s_sleep(1); \
    if ((++_sp & 255u) == 0u) { if (xb_ld(&(bar)[XB_TMO])) break; if (_sp > XB_SPIN_CAP) { atomicAdd(&(bar)[XB_TMO], 1u); break; } } } } while (0)
struct XcdBarrier { unsigned* bar; unsigned x; volatile LAS unsigned* st; };
__device__ __forceinline__ XcdBarrier xcd_barrier_post(unsigned* bar, volatile LAS unsigned* st) {
    XcdBarrier b; b.bar = bar; b.x = xb_xcc_id(); b.st = st;
    if (threadIdx.x == 0) (void)xb_add(&bar[XB_XCNT(b.x)], 1u);
    return b;
}
__device__ __forceinline__ void xcd_barrier_complete(unsigned* bar, unsigned x, unsigned& nloc, unsigned& nx) {
    const unsigned G = gridDim.x * gridDim.y * gridDim.z;
    unsigned sum, cnt, mine, sp = 0u;
    for (;;) {
        sum = 0u; cnt = 0u; mine = 0u;
#pragma unroll
        for (unsigned j = 0; j < 16; ++j) { const unsigned c = xb_ld(&bar[XB_XCNT(j)]); sum += c; cnt += (c > 0u) ? 1u : 0u; mine = (j == x) ? c : mine; }
        if (sum == G) break;
        __builtin_amdgcn_s_sleep(1);
        if ((++sp & 255u) == 0u) { if (xb_ld(&bar[XB_TMO])) break; if (sp > XB_SPIN_CAP) { atomicAdd(&bar[XB_TMO], 1u); break; } }
    }
    nloc = mine > 0u ? mine : 1u; nx = cnt > 0u ? cnt : 1u;
}
__device__ __forceinline__ void xcd_barrier(const XcdBarrier& b) {
    asm volatile("s_waitcnt vmcnt(0)" ::: "memory");
    __syncthreads();
    if (threadIdx.x == 0) {
        unsigned* bar = b.bar;
        __builtin_amdgcn_s_waitcnt(0);
        unsigned nloc = b.st[0], nx = b.st[1];
        if (nloc == 0u) { xcd_barrier_complete(bar, b.x, nloc, nx); b.st[0] = nloc; b.st[1] = nx; }
        const unsigned old = xb_add(&bar[XB_XSUB(b.x)], 1u);
        const unsigned gen = old / nloc;
        if (old + 1u == (gen + 1u) * nloc) {
            __builtin_amdgcn_fence(__ATOMIC_RELEASE, "agent");
            asm volatile("s_waitcnt vmcnt(0)" ::: "memory");
            const unsigned og = xb_add(&bar[XB_TOP], 1u);
            const unsigned tg = og / nx;
            if (og + 1u == (tg + 1u) * nx) xb_add(&bar[XB_TOPGEN], 1u);
            else XB_SPIN(xb_ld(&bar[XB_TOPGEN]) == tg, bar);
            __builtin_amdgcn_fence(__ATOMIC_ACQUIRE, "agent");
            xb_add(&bar[XB_XGEN(b.x)], 1u);
            asm volatile("s_waitcnt vmcnt(0)" ::: "memory");
        } else {
            XB_SPIN(xb_ld(&bar[XB_XGEN(b.x)]) == gen, bar);
            __builtin_amdgcn_fence(__ATOMIC_ACQUIRE, "agent");
            asm volatile("s_waitcnt vmcnt(0)" ::: "memory");
        }
    }
    __syncthreads();
}

__global__ void __launch_bounds__(512, 2) mk_fwd(Args a) {
    extern __shared__ __attribute__((aligned(16))) unsigned char lds[];
    cg::grid_group grid = cg::this_grid();
    LAS unsigned char* L = (LAS unsigned char*)lds;
    const int G = gridDim.x, bid = blockIdx.x, NGW = G * 8;
    volatile LAS unsigned* MISC = (volatile LAS unsigned*)(L + RING_BYTES + 8192);
    if (threadIdx.x < 4) MISC[threadIdx.x] = 0u;
    __syncthreads();
    (void)xcd_barrier_post((unsigned*)(a.ws + WS_BAR), MISC);
#define XSYNC() do { XcdBarrier xb_; xb_.bar = (unsigned*)(a.ws + WS_BAR); xb_.x = xb_xcc_id(); xb_.st = (volatile LAS unsigned*)(L + RING_BYTES + 8192); xcd_barrier(xb_); } while (0)
#define GRID_SYNC() do { asm volatile("s_waitcnt vmcnt(0) lgkmcnt(0)" ::: "memory"); __syncthreads(); grid.sync(); \
    __builtin_amdgcn_fence(__ATOMIC_ACQUIRE, "agent"); asm volatile("s_waitcnt vmcnt(0)" ::: "memory"); __syncthreads(); } while (0)
#ifndef DBG_STOP
#define DBG_STOP 0
#endif
#define DBG_DUMP(k, EXPR) do { if (DBG_STOP == (k)) { PHASE_BEGIN(); for (int m = gw; m < SEQ; m += NGW) for (int c = lane; c < DM; c += 64) out[(size_t)m * DM + c] = (EXPR); return; } } while (0)
#define PHASE_BEGIN() unsigned char* ws = a.ws; LAUNDER_S(ws); int tid_ = threadIdx.x; LAUNDER_V(tid_); const int tid = tid_, lane = tid & 63, wave = __builtin_amdgcn_readfirstlane(tid >> 6), gw = bid * 8 + wave; \
    u64* ssq = (u64*)(ws + WS_SSQ); (void)lane; (void)gw; (void)ssq; \
    u64* ssq_x = ssq + (size_t)l * SEQ; u64* ssq_xn = ssq + (size_t)(l + 1) * SEQ; u64* ssq_cq = ssq + (size_t)(3 + l) * SEQ; u64* ssq_ckv = ssq + (size_t)(5 + l) * SEQ; u64* ssq_x1 = ssq + (size_t)(7 + l) * SEQ; \
    (void)ssq_x; (void)ssq_xn; (void)ssq_cq; (void)ssq_ckv; (void)ssq_x1; \
    bf16_t* Win = (bf16_t*)(ws + WS_WIN); bf16_t* Wuq = (bf16_t*)(ws + WS_WUQ); bf16_t* Wukv = (bf16_t*)(ws + WS_WUKV); \
    bf16_t* Wout = (bf16_t*)(ws + WS_WOUT); bf16_t* Wup = (bf16_t*)(ws + WS_WUP); bf16_t* Wdn = (bf16_t*)(ws + WS_WDN); \
    bf16_t* XB = (bf16_t*)(ws + WS_XB); bf16_t* Z = (bf16_t*)(ws + WS_Z); bf16_t* Qb = (bf16_t*)(ws + WS_Q); bf16_t* Kb = (bf16_t*)(ws + WS_K); bf16_t* Vt = (bf16_t*)(ws + WS_VT); \
    float* ST = (float*)(ws + WS_ST); float* DEC = (float*)(ws + WS_DEC); bf16_t* MIX = (bf16_t*)(ws + WS_MIX); \
    bf16_t* UP = (bf16_t*)(ws + WS_UP); bf16_t* ACT = (bf16_t*)(ws + WS_ACT); \
    const float* xin = a.in[0]; float* out = a.out; \
    (void)Win; (void)Wuq; (void)Wukv; (void)Wout; (void)Wup; (void)Wdn; (void)XB; (void)Z; (void)Qb; (void)Kb; (void)Vt; (void)ST; (void)DEC; (void)MIX; (void)UP; (void)ACT; (void)xin; (void)out;

    for (int l = 0; l < NLAYER; ++l) {
        {
            PHASE_BEGIN();
            LAS float* scr = (LAS float*)(L + wave * 16384);
            const float* w_in = a.in[3] + (size_t)l * DM * IN_DIM; const float* w_uq = a.in[5] + (size_t)l * QLORA * QW; const float* w_ukv = a.in[7] + (size_t)l * KVLORA * KVW;
            const float* w_out = a.in[14] + (size_t)l * DM * DM; const float* w_up = a.in[16] + (size_t)l * DM * DFF2; const float* w_dn = a.in[19] + (size_t)l * DFF * DM;
            const float* g_attn = a.in[2] + l * DM; const float* g_cq = a.in[4] + l * QLORA; const float* g_ckv = a.in[6] + l * KVLORA; const float* g_mla = a.in[13] + l * 1024; const float* g_ffn = a.in[15] + l * DM;
            constexpr int I_IN = (DM / 64) * (IN_PAD / 32), I_UQ = (QLORA / 64) * (QW / 32), I_UKV = (KVLORA / 64) * (KVW / 32), I_OUT = (DM / 64) * (DM / 32), I_UP = (DM / 64) * (DFF2 / 32), I_DN = (DFF / 64) * (DM / 32);
            constexpr int NITEMS = I_IN + I_UQ + I_UKV + I_OUT + I_UP + I_DN;
            for (int it = gw; it < NITEMS; it += NGW) {
                int r = it;
                if (r < I_IN) { wt_item(w_in, DM, IN_DIM, g_attn, DM, Win, scr, r, IN_PAD / 32, lane); continue; } r -= I_IN;
                if (r < I_UQ) { wt_item(w_uq, QLORA, QW, g_cq, QLORA, Wuq, scr, r, QW / 32, lane); continue; } r -= I_UQ;
                if (r < I_UKV) { wt_item(w_ukv, KVLORA, KVW, g_ckv, KVLORA, Wukv, scr, r, KVW / 32, lane); continue; } r -= I_UKV;
                if (r < I_OUT) { wt_item(w_out, DM, DM, g_mla, 1024, Wout, scr, r, DM / 32, lane); continue; } r -= I_OUT;
                if (r < I_UP) { wt_item(w_up, DM, DFF2, g_ffn, DM, Wup, scr, r, DFF2 / 32, lane); continue; } r -= I_UP;
                wt_item(w_dn, DFF, DM, g_ffn, 0, Wdn, scr, r, DM / 32, lane);
            }
            if (l == 0) {
                for (int m = gw; m < SEQ; m += NGW) {
                    const f32x4* xr = (const f32x4*)(xin + (size_t)m * DM) + lane; float s = 0.f;
                    u32x2* o8 = (u32x2*)(XB + (size_t)m * DM) + lane;
#pragma unroll
                    for (int j = 0; j < 8; ++j) { const f32x4 v = xr[64 * j]; s += (v[0] * v[0] + v[1] * v[1]) + (v[2] * v[2] + v[3] * v[3]); o8[64 * j] = (u32x2){pk2(v[0], v[1]), pk2(v[2], v[3])}; }
                    s = wave_sum(s); if (lane == 0) ssq_x[m] = (u64)(s * SSQ_FX + 0.5f);
                }
            }
        }
        if (l == 0) GRID_SYNC(); else XSYNC();
        {
            PHASE_BEGIN();
            pg8::Gemm g{XB, Win, SEQ, IN_PAD, DM, DM}; pg8::StaticOrder S; S.init(SEQ, IN_PAD, G, bid);
            pg8::EpiRowScale E{Z, IN_PAD, ssq_x, 1.0f / DM, ssq_cq, 0, 2, ssq_ckv, 2, 3};
            pg8::gemm_phase<pg8::EpiRowScale>(L, g, S, E);
        }
        XSYNC();
        DBG_DUMP(1, bf2f(Z[(size_t)m * IN_PAD + c]) + bf2f(Z[(size_t)m * IN_PAD + 2048 + c]));
        {
            PHASE_BEGIN();
            { pg8::Gemm g{Z + C_CQ, Wuq, SEQ, QW, QLORA, IN_PAD}; pg8::StaticOrder S; S.init(SEQ, QW, G, bid);
              pg8::EpiRowScale E{Qb, QW, ssq_cq, 1.0f / QLORA, nullptr, 0, 0, nullptr, 0, 0};
              pg8::gemm_phase<pg8::EpiRowScale>(L, g, S, E); }
            { pg8::Gemm g{Z + C_CKV, Wukv, SEQ, KVW, KVLORA, IN_PAD}; pg8::StaticOrder S; S.init(SEQ, KVW, G, bid);
              pg8::EpiUkv E{Kb, Vt, ssq_ckv, 1.0f / KVLORA};
              pg8::gemm_phase<pg8::EpiUkv>(L, g, S, E); }
            const float* wgate = a.in[10] + (size_t)l * 16 * (GH * GDK); const float* bgate = a.in[11] + (size_t)l * (GH * GDK);
            for (int u = bid; u < NCHUNK * GH; u += G) gla_chunk_unit(L, Z, wgate, bgate, ST, DEC, u >> 2, u & 3);
        }
        XSYNC();
        DBG_DUMP(2, (c < QW ? bf2f(Qb[(size_t)m * QW + c]) + bf2f(Kb[(size_t)m * QW + c]) : bf2f(Vt[(size_t)(c - QW) * SEQ + m])) + ST[(size_t)m * 8192 + c] + ST[(size_t)m * 8192 + 4096 + c]);
        {
            PHASE_BEGIN();
            const int* pos = (const int*)a.in[1];
            const float* qn = a.in[8] + l * QKD; const float* kn = a.in[9] + l * QKD;
            const float qscale = 0.07216878364870322f * 1.4426950408889634f;
            for (int m = gw; m < SEQ; m += NGW) {
                const int i = lane & 31;
                const float ang = (float)pos[m] * a.inv_freq[i];
                double rev = (double)ang * 0.15915494309189535; rev -= __builtin_rint(rev);
                const float sn = __builtin_amdgcn_sinf((float)rev), cs = __builtin_amdgcn_cosf((float)rev);
                const float krv = bf2f(Z[(size_t)m * IN_PAD + C_KR + lane]);
                bf16_t* qp = Qb + (size_t)m * QW; bf16_t* kp = Kb + (size_t)m * QW;
                float qa[NH][3], ka[NH][2], qs[NH], ks[NH];
#pragma unroll
                for (int h = 0; h < NH; ++h) { qa[h][0] = bf2f(qp[h * QKD + lane]); qa[h][1] = bf2f(qp[h * QKD + 64 + lane]); qa[h][2] = bf2f(qp[h * QKD + 128 + lane]);
                                               ka[h][0] = bf2f(kp[h * QKD + lane]); ka[h][1] = bf2f(kp[h * QKD + 64 + lane]); }
#pragma unroll
                for (int h = 0; h < NH; ++h) { qs[h] = qa[h][0] * qa[h][0] + qa[h][1] * qa[h][1] + qa[h][2] * qa[h][2]; ks[h] = ka[h][0] * ka[h][0] + ka[h][1] * ka[h][1] + krv * krv; }
#pragma unroll
                for (int o = 1; o < 64; o <<= 1)
#pragma unroll
                    for (int h = 0; h < NH; ++h) { qs[h] += __shfl_xor(qs[h], o); ks[h] += __shfl_xor(ks[h], o); }
                const float qg0 = qn[lane], qg1 = qn[64 + lane], qg2 = qn[128 + lane], kg0 = kn[lane], kg1 = kn[64 + lane], kg2 = kn[128 + lane];
#pragma unroll
                for (int h = 0; h < NH; ++h) {
                    { const float rstd = rsqrtf(qs[h] * (1.0f / QKD) + EPS);
                      const float n2 = qa[h][2] * rstd * qg2, pr = __shfl_xor(n2, 32);
                      const float r2 = (lane < 32) ? n2 * cs - pr * sn : n2 * cs + pr * sn;
                      qp[h * QKD + lane] = (bf16_t)f2bf(qa[h][0] * rstd * qg0 * qscale); qp[h * QKD + 64 + lane] = (bf16_t)f2bf(qa[h][1] * rstd * qg1 * qscale); qp[h * QKD + 128 + lane] = (bf16_t)f2bf(r2 * qscale); }
                    { const float rstd = rsqrtf(ks[h] * (1.0f / QKD) + EPS);
                      const float n2 = krv * rstd * kg2, pr = __shfl_xor(n2, 32);
                      const float r2 = (lane < 32) ? n2 * cs - pr * sn : n2 * cs + pr * sn;
                      kp[h * QKD + lane] = (bf16_t)f2bf(ka[h][0] * rstd * kg0); kp[h * QKD + 64 + lane] = (bf16_t)f2bf(ka[h][1] * rstd * kg1); kp[h * QKD + 128 + lane] = (bf16_t)f2bf(r2); }
                }
            }
            constexpr int NE = GH * GDV * GDK;
            for (int e = bid * 512 + tid; e < NE; e += G * 512) {
                const int hd = (e >> 15) * GDK + (e & 127);
                float s = 0.f;
                for (int c0 = 0; c0 < NCHUNK; c0 += 8) {
                    float uu[8], dd[8];
#pragma unroll
                    for (int i = 0; i < 8; ++i) { uu[i] = ST[(size_t)(c0 + i) * NE + e]; dd[i] = DEC[(size_t)(c0 + i) * (GH * GDK) + hd]; }
#pragma unroll
                    for (int i = 0; i < 8; ++i) { s = s * dd[i] + uu[i]; ST[(size_t)(c0 + i) * NE + e] = s; }
                }
            }
        }
        XSYNC();
        DBG_DUMP(3, (c < QW ? bf2f(Qb[(size_t)m * QW + c]) + bf2f(Kb[(size_t)m * QW + c]) : 0.f) + ST[(size_t)m * 8192 + c] + ST[(size_t)m * 8192 + 4096 + c]);
        {
            PHASE_BEGIN();
            for (int p = bid; p < 256; p += G) {
                const int h = p >> 5, s = p & 31;
                attn_unit(L, Qb, Kb, Vt, MIX, h, 63 - s);
                attn_unit(L, Qb, Kb, Vt, MIX, h, s);
            }
            const float* gnorm = a.in[12] + l * GDV;
            for (int u = bid; u < NCHUNK * GH; u += G) gla_out_unit(L, Z, ST, gnorm, MIX, u >> 2, u & 3);
        }
        XSYNC();
        DBG_DUMP(4, bf2f(MIX[(size_t)m * DM + c]));
        { PHASE_BEGIN();
        for (int m = gw; m < SEQ; m += NGW) {
            u32x4* p = (u32x4*)(MIX + (size_t)m * DM) + lane;
            u32x4 v0 = p[0], v1 = p[64]; float s = 0.f;
#pragma unroll
            for (int j = 0; j < 4; ++j) { const float a0 = bflo(v0[j]), a1 = bfhi(v0[j]), b0 = bflo(v1[j]), b1 = bfhi(v1[j]); s += a0 * a0 + a1 * a1 + b0 * b0 + b1 * b1; }
            const float rstd = rsqrtf(wave_sum(s) * (1.0f / 1024.0f) + EPS);
#pragma unroll
            for (int j = 0; j < 4; ++j) { v0[j] = pk2(bflo(v0[j]) * rstd, bfhi(v0[j]) * rstd); v1[j] = pk2(bflo(v1[j]) * rstd, bfhi(v1[j]) * rstd); }
            p[0] = v0; p[64] = v1;
        } }
        XSYNC();
        DBG_DUMP(5, bf2f(MIX[(size_t)m * DM + c]));
        {
            PHASE_BEGIN();
            pg8::Gemm g{MIX, Wout, SEQ, DM, DM, DM}; pg8::StaticOrder S; S.init(SEQ, DM, G, bid);
            pg8::EpiRes E{l == 0 ? xin : out, out, XB, ssq_x1};
            pg8::gemm_phase<pg8::EpiRes>(L, g, S, E);
        }
        XSYNC();
        DBG_DUMP(6, out[(size_t)m * DM + c] + bf2f(XB[(size_t)m * DM + c]));
        {
            PHASE_BEGIN();
            pg8::Gemm g{XB, Wup, SEQ, DFF2, DM, DM}; pg8::StaticOrder S; S.init(SEQ, DFF2, G, bid);
            pg8::EpiRowScale E{UP, DFF2, ssq_x1, 1.0f / DM, nullptr, 0, 0, nullptr, 0, 0};
            pg8::gemm_phase<pg8::EpiRowScale>(L, g, S, E);
        }
        XSYNC();
        DBG_DUMP(7, bf2f(UP[(size_t)m * DFF2 + c]) + bf2f(UP[(size_t)m * DFF2 + 5000 + c]));
        {
            PHASE_BEGIN();
            const float* cw = a.in[17] + (size_t)l * 3 * DFF2; const float* cb = a.in[18] + (size_t)l * DFF2;
            constexpr int NCG = DFF / 8, NTASK = NCG * (SEQ / 64);
            for (int task = bid * 512 + tid; task < NTASK; task += G * 512) {
                const int cgp = task % NCG, seg = task / NCG, c0 = cgp * 8, r0 = seg * 64;
                float wg0[8], wg1[8], wg2[8], wu0[8], wu1[8], wu2[8], bgv[8], buv[8];
#pragma unroll
                for (int j = 0; j < 8; ++j) { wg0[j] = cw[c0 + j]; wg1[j] = cw[DFF2 + c0 + j]; wg2[j] = cw[2 * DFF2 + c0 + j]; wu0[j] = cw[DFF + c0 + j]; wu1[j] = cw[DFF2 + DFF + c0 + j]; wu2[j] = cw[2 * DFF2 + DFF + c0 + j]; bgv[j] = cb[c0 + j]; buv[j] = cb[DFF + c0 + j]; }
                u32x4 g2 = (u32x4){0, 0, 0, 0}, g1 = g2, u2 = g2, u1 = g2;
                if (r0 >= 2) { g2 = *(const u32x4*)(UP + (size_t)(r0 - 2) * DFF2 + c0); u2 = *(const u32x4*)(UP + (size_t)(r0 - 2) * DFF2 + DFF + c0);
                               g1 = *(const u32x4*)(UP + (size_t)(r0 - 1) * DFF2 + c0); u1 = *(const u32x4*)(UP + (size_t)(r0 - 1) * DFF2 + DFF + c0); }
                for (int r = r0; r < r0 + 64; ++r) {
                    const u32x4 gc = *(const u32x4*)(UP + (size_t)r * DFF2 + c0), uc = *(const u32x4*)(UP + (size_t)r * DFF2 + DFF + c0);
                    u32x4 o;
#pragma unroll
                    for (int j = 0; j < 4; ++j) {
                        const float ga = bgv[2 * j] + wg0[2 * j] * bflo(g2[j]) + wg1[2 * j] * bflo(g1[j]) + wg2[2 * j] * bflo(gc[j]);
                        const float gb = bgv[2 * j + 1] + wg0[2 * j + 1] * bfhi(g2[j]) + wg1[2 * j + 1] * bfhi(g1[j]) + wg2[2 * j + 1] * bfhi(gc[j]);
                        const float ua = buv[2 * j] + wu0[2 * j] * bflo(u2[j]) + wu1[2 * j] * bflo(u1[j]) + wu2[2 * j] * bflo(uc[j]);
                        const float ub = buv[2 * j + 1] + wu0[2 * j + 1] * bfhi(u2[j]) + wu1[2 * j + 1] * bfhi(u1[j]) + wu2[2 * j + 1] * bfhi(uc[j]);
                        o[j] = pk2(silu_f(ga) * ua, silu_f(gb) * ub);
                    }
                    *(u32x4*)(ACT + (size_t)r * DFF + c0) = o;
                    g2 = g1; g1 = gc; u2 = u1; u1 = uc;
                }
            }
        }
        XSYNC();
        DBG_DUMP(8, bf2f(ACT[(size_t)m * DFF + c]) + bf2f(ACT[(size_t)m * DFF + 3000 + c]));
        {
            PHASE_BEGIN();
            pg8::Gemm g{ACT, Wdn, SEQ, DM, DFF, DFF}; pg8::StaticOrder S; S.init(SEQ, DM, G, bid);
            pg8::EpiRes E{out, out, XB, ssq_xn};
            pg8::gemm_phase<pg8::EpiRes>(L, g, S, E);
        }
        XSYNC();
        if (DBG_STOP == 9) return;
    }
}

extern "C" void kernel_launch(void* const* d_in, const int* in_sizes, int n_in, void* d_out, int out_size, void* d_ws, size_t ws_size, hipStream_t stream) {
    static int grid = 0;
    if (grid == 0) {
        if (n_in != 20 || out_size != SEQ * DM || ws_size < WS_END) { fprintf(stderr, "kernel_launch: unexpected shapes: n_in %d out %d ws %zu (need %zu)\n", n_in, out_size, ws_size, (size_t)WS_END); grid = -1; return; }
        int dev = 0, cus = 0, per_cu = 0;
        hipGetDevice(&dev); hipDeviceGetAttribute(&cus, hipDeviceAttributeMultiprocessorCount, dev);
        hipFuncSetAttribute((const void*)mk_fwd, hipFuncAttributeMaxDynamicSharedMemorySize, LDS_BYTES);
        hipOccupancyMaxActiveBlocksPerMultiprocessor(&per_cu, (const void*)mk_fwd, 512, LDS_BYTES);
        (void)hipGetLastError();
        if (per_cu < 1) per_cu = 1;
        grid = cus * 1;
    }
    if (grid < 0) return;
    hipMemsetAsync((char*)d_ws + WS_CTL, 0, CTL_BYTES, stream);
    Args a{};
    for (int i = 0; i < 20; ++i) a.in[i] = (const float*)d_in[i];
    a.out = (float*)d_out; a.ws = (unsigned char*)d_ws;
    for (int i = 0; i < 32; ++i) a.inv_freq[i] = (float)pow(10000.0, -(double)i / 32.0);
    void* args[] = {&a};
    hipError_t e = hipLaunchCooperativeKernel((const void*)mk_fwd, dim3(grid), dim3(512), args, LDS_BYTES, stream);
    if (e != hipSuccess) fprintf(stderr, "cooperative launch failed: %s (grid %d)\n", hipGetErrorString(e), grid);
}
```

```cpp
#include <hip/hip_runtime.h>
#include <hip/hip_cooperative_groups.h>
#include <cstdio>
#include <cstdint>
#include <cmath>
namespace cg = cooperative_groups;

#define LAS __attribute__((address_space(3)))
typedef unsigned short bf16_t;
typedef unsigned long long u64;
typedef short bf16x8 __attribute__((ext_vector_type(8)));
typedef short s16x4 __attribute__((ext_vector_type(4)));
typedef float f32x4 __attribute__((ext_vector_type(4)));
typedef float f32x16 __attribute__((ext_vector_type(16)));
typedef unsigned u32x4 __attribute__((ext_vector_type(4)));
typedef unsigned u32x2 __attribute__((ext_vector_type(2)));
typedef float f32x2_t __attribute__((ext_vector_type(2)));
typedef __bf16 bf16x2_t __attribute__((ext_vector_type(2)));

constexpr int SEQ = 16384, DM = 2048, NLAYER = 2;
constexpr int IN_DIM = 3920, IN_PAD = 4096;
constexpr int C_CQ = 0, C_CKV = 512, C_KR = 768, C_GQ = 832, C_GK = 1344, C_GV = 1856, C_GA = 2880, C_GG = 2896;
constexpr int QLORA = 512, KVLORA = 256, NH = 8, QKD = 192, NOPE = 128, VD = 128, QW = NH * QKD  , KVW = NH * 256  ;
constexpr int GH = 4, GDK = 128, GDV = 256, NCHUNK = SEQ / 64;
constexpr int DFF = 5632, DFF2 = 11264;
constexpr float EPS = 1e-6f;

constexpr size_t MiB = 1u << 20;
constexpr size_t WS_CTL = 0, CTL_BYTES = 2 * MiB;
constexpr size_t WS_BAR = 0;
constexpr size_t WS_SSQ = 65536;
constexpr size_t WS_WIN = 2 * MiB, WS_WUQ = 18 * MiB, WS_WUKV = WS_WUQ + 3 * MiB / 2, WS_WOUT = WS_WUKV + 1 * MiB, WS_WUP = WS_WOUT + 8 * MiB, WS_WDN = WS_WUP + 44 * MiB;
constexpr size_t WS_XB = 95 * MiB;
constexpr size_t WS_R = 159 * MiB;
constexpr size_t WS_Z = WS_R, WS_Q = WS_Z + 128 * MiB, WS_K = WS_Q + 48 * MiB, WS_VT = WS_K + 48 * MiB, WS_ST = WS_VT + 32 * MiB, WS_DEC = WS_ST + 128 * MiB, WS_MIX = WS_DEC + 1 * MiB;
constexpr size_t WS_ACT = WS_R, WS_EDGE = WS_ACT + 176 * MiB, WS_END = WS_MIX + 64 * MiB;
static_assert(WS_EDGE + 12 * MiB <= WS_END, "ws map");

#define LAUNDER_V(x) asm volatile("" : "+v"(x))
#define LAUNDER_S(x) asm volatile("" : "+s"(x))
__device__ __forceinline__ unsigned f2bf(float f) { unsigned u = __builtin_bit_cast(unsigned, f); return (u + 0x7fffu + ((u >> 16) & 1u)) >> 16; }
__device__ __forceinline__ unsigned pk2(float lo, float hi) { f32x2_t v = {lo, hi}; bf16x2_t b = __builtin_convertvector(v, bf16x2_t); return __builtin_bit_cast(unsigned, b); }
__device__ __forceinline__ float bf2f(unsigned b) { return __builtin_bit_cast(float, b << 16); }
__device__ __forceinline__ float bflo(unsigned w) { return __builtin_bit_cast(float, w << 16); }
__device__ __forceinline__ float bfhi(unsigned w) { return __builtin_bit_cast(float, w & 0xffff0000u); }
__device__ __forceinline__ float wave_sum(float v) {
#pragma unroll
    for (int o = 1; o < 64; o <<= 1) v += __shfl_xor(v, o);
    return v;
}
constexpr float SSQ_FX = 1048576.0f, SSQ_INV = 1.0f / 1048576.0f;
__device__ __forceinline__ void ssq_add(u64* p, float v) { __hip_atomic_fetch_add(p, (u64)(v * SSQ_FX + 0.5f), __ATOMIC_RELAXED, __HIP_MEMORY_SCOPE_AGENT); }
__device__ __forceinline__ float ssq_get(const u64* p) { return (float)(*p) * SSQ_INV; }
__device__ __forceinline__ float silu_f(float x) { return x * __builtin_amdgcn_rcpf(1.0f + __expf(-x)); }

namespace pg8 {
constexpr int BM = 256, BK = 64, HALF = 128, HTB = HALF * BK * 2, STAGE_BYTES = 8 * HTB, NXCD = 8, WGM = 8;
__host__ __device__ __forceinline__ int lds_byte(int r, int c) { const int st = (r >> 4) * 2 + (c >> 5), rr = r & 15, cc = c & 31, ob = rr * 64 + cc * 2; return st * 1024 + (ob ^ (((ob >> 9) & 1) << 5)); }
__host__ __device__ __forceinline__ void stage_rc(int b, int& R, int& C) { const int st = b / 1024, sb = b % 1024, swz = sb ^ (((sb >> 9) & 1) << 5); R = (st >> 1) * 16 + swz / 64; C = (st & 1) * 32 + (swz % 64) / 2; }
__host__ __device__ __forceinline__ int perm32(int rho) { const int n = rho >> 4, i = rho & 15; return 8 * (i >> 2) + 4 * n + (i & 3); }

struct Unit { int pm, pn; };
struct Gemm { const bf16_t* A; const bf16_t* Bt; int M, N, K, lda; };

struct StaticOrder {
    int nM, nN, nwg, G, c;
    __device__ void init(int M, int N, int G_, int c_) { nM = M / BM; nN = N / BM; nwg = nM * nN; G = G_; c = c_; }
    __device__ bool next(int i, Unit& u) const {
        const long L = (long)i * G + c; if (L >= nwg) return false;
        int wgid = (int)L; { const int q = nwg / NXCD, r = nwg % NXCD, xcd = wgid % NXCD, off = wgid / NXCD; wgid = (xcd < r ? xcd * (q + 1) : r * (q + 1) + (xcd - r) * q) + off; }
        const int nig = WGM * nN, gid = wgid / nig, fm = gid * WGM, gsz = (nM - fm) < WGM ? (nM - fm) : WGM;
        u.pm = fm + ((wgid % nig) % gsz); u.pn = (wgid % nig) / gsz; return true;
    }
};

struct EpiRowScale {
    static constexpr bool PERM = true;
    bf16_t* O; int ldc; const u64* ssq_in; float inv_dim; u64* ssq_a; int a_lo, a_hi; u64* ssq_b; int b_lo, b_hi;
    __device__ __forceinline__ void operator()(const f32x4 (&acc)[2][2][4][2], const Unit& u, int wr, int wc, int fr, int fq) const {
        const int row0 = u.pm * BM + wr * 64 + fr, col0 = u.pn * BM + wc * 32 + 8 * fq;
        u64* sacc = (u.pn >= a_lo && u.pn < a_hi) ? ssq_a : ((u.pn >= b_lo && u.pn < b_hi) ? ssq_b : nullptr);
#pragma unroll
        for (int ai = 0; ai < 2; ++ai)
#pragma unroll
            for (int m = 0; m < 4; ++m) {
                const int row = row0 + ai * HALF + m * 16;
                const float sc = ssq_in ? rsqrtf(ssq_get(ssq_in + row) * inv_dim + EPS) : 1.0f;
                float ss = 0.f;
#pragma unroll
                for (int bj = 0; bj < 2; ++bj) {
                    const f32x4 v0 = acc[ai][bj][m][0] * sc, v1 = acc[ai][bj][m][1] * sc;
                    ss += (v0[0] * v0[0] + v0[1] * v0[1]) + (v0[2] * v0[2] + v0[3] * v0[3]) + (v1[0] * v1[0] + v1[1] * v1[1]) + (v1[2] * v1[2] + v1[3] * v1[3]);
                    u32x4 w; w.x = pk2(v0[0], v0[1]); w.y = pk2(v0[2], v0[3]); w.z = pk2(v1[0], v1[1]); w.w = pk2(v1[2], v1[3]);
                    *(u32x4*)(O + (size_t)row * ldc + col0 + bj * HALF) = w;
                }
                if (sacc) { ss += __shfl_xor(ss, 16); ss += __shfl_xor(ss, 32); if (fq == 0) ssq_add(sacc + row, ss); }
            }
    }
};
struct EpiUkv {
    static constexpr bool PERM = true;
    bf16_t* Kb; bf16_t* Vt; const u64* ssq_in; float inv_dim;
    __device__ __forceinline__ void operator()(const f32x4 (&acc)[2][2][4][2], const Unit& u, int wr, int wc, int fr, int fq) const {
        const int row0 = u.pm * BM + wr * 64 + fr, c0 = wc * 32 + 8 * fq;
#pragma unroll
        for (int ai = 0; ai < 2; ++ai)
#pragma unroll
            for (int m = 0; m < 4; ++m) {
                const int row = row0 + ai * HALF + m * 16;
                const float sc = rsqrtf(ssq_get(ssq_in + row) * inv_dim + EPS);
                { const f32x4 v0 = acc[ai][0][m][0] * sc, v1 = acc[ai][0][m][1] * sc;
                  u32x4 w; w.x = pk2(v0[0], v0[1]); w.y = pk2(v0[2], v0[3]); w.z = pk2(v1[0], v1[1]); w.w = pk2(v1[2], v1[3]);
                  *(u32x4*)(Kb + (size_t)row * QW + u.pn * QKD + c0) = w; }
#pragma unroll
                for (int n = 0; n < 2; ++n)
#pragma unroll
                    for (int j = 0; j < 4; ++j) Vt[(size_t)(u.pn * VD + c0 + 4 * n + j) * SEQ + row] = (bf16_t)f2bf(acc[ai][1][m][n][j] * sc);
            }
    }
};
struct EpiRes {
    static constexpr bool PERM = true;
    const float* base; float* out; bf16_t* xb; u64* ssq_out;
    __device__ __forceinline__ void operator()(const f32x4 (&acc)[2][2][4][2], const Unit& u, int wr, int wc, int fr, int fq) const {
        const int row0 = u.pm * BM + wr * 64 + fr, col0 = u.pn * BM + wc * 32 + 8 * fq;
#pragma unroll
        for (int ai = 0; ai < 2; ++ai)
#pragma unroll
            for (int m = 0; m < 4; ++m) {
                const int row = row0 + ai * HALF + m * 16; float ss = 0.f;
#pragma unroll
                for (int bj = 0; bj < 2; ++bj) {
                    const size_t off = (size_t)row * DM + col0 + bj * HALF;
                    const f32x4 v0 = acc[ai][bj][m][0] + *(const f32x4*)(base + off), v1 = acc[ai][bj][m][1] + *(const f32x4*)(base + off + 4);
                    ss += (v0[0] * v0[0] + v0[1] * v0[1]) + (v0[2] * v0[2] + v0[3] * v0[3]) + (v1[0] * v1[0] + v1[1] * v1[1]) + (v1[2] * v1[2] + v1[3] * v1[3]);
                    *(f32x4*)(out + off) = v0; *(f32x4*)(out + off + 4) = v1;
                    u32x4 w; w.x = pk2(v0[0], v0[1]); w.y = pk2(v0[2], v0[3]); w.z = pk2(v1[0], v1[1]); w.w = pk2(v1[2], v1[3]);
                    *(u32x4*)(xb + off) = w;
                }
                ss += __shfl_xor(ss, 16); ss += __shfl_xor(ss, 32); if (fq == 0) ssq_add(ssq_out + row, ss);
            }
    }
};


#define DPP_SHR1(old, src) __builtin_bit_cast(float, __builtin_amdgcn_update_dpp(__builtin_bit_cast(int, (float)(old)), __builtin_bit_cast(int, (float)(src)), 0x111, 0xf, 0xf, false))
#define DPP_SHR2(old, src) __builtin_bit_cast(float, __builtin_amdgcn_update_dpp(__builtin_bit_cast(int, (float)(old)), __builtin_bit_cast(int, (float)(src)), 0x112, 0xf, 0xf, false))
#define DPP_ROR1(src) __builtin_bit_cast(float, __builtin_amdgcn_update_dpp(0, __builtin_bit_cast(int, (float)(src)), 0x121, 0xf, 0xf, false))
#define DPP_ROR2(src) __builtin_bit_cast(float, __builtin_amdgcn_update_dpp(0, __builtin_bit_cast(int, (float)(src)), 0x122, 0xf, 0xf, false))
struct EpiUpConv {
    static constexpr bool PERM = true;
    bf16_t* ACT; float* EDGE; const u64* ssq_in; const float* cw; const float* cb; LAS float* halo;
    __device__ __forceinline__ void operator()(f32x4 (&acc)[2][2][4][2], const Unit& u, int wr, int wc, int fr, int fq) const {
        const int row0 = u.pm * BM + wr * 64 + fr;
        const int g0 = u.pn * 128 + wc * 32 + 8 * fq;
#pragma unroll
        for (int ai = 0; ai < 2; ++ai)
#pragma unroll
            for (int m = 0; m < 4; ++m) {
                const float sc = rsqrtf(ssq_get(ssq_in + row0 + ai * HALF + m * 16) * (1.0f / DM) + EPS);
#pragma unroll
                for (int bj = 0; bj < 2; ++bj)
#pragma unroll
                    for (int n = 0; n < 2; ++n) acc[ai][bj][m][n] = acc[ai][bj][m][n] * sc;
            }
        if (fr >= 14) {
#pragma unroll
            for (int ai = 0; ai < 2; ++ai) { LAS float* hp = halo + ((((2 * ai + wr) * 4 + wc) * 2 + (fr - 14)) * 4 + fq) * 16;
#pragma unroll
                for (int bj = 0; bj < 2; ++bj)
#pragma unroll
                    for (int n = 0; n < 2; ++n) *(LAS f32x4*)(hp + bj * 8 + n * 4) = acc[ai][bj][3][n]; }
            if (wr == 1) { float* ep = EDGE + (size_t)(u.pm * 4 + 2 + fr - 14) * DFF2 + g0;
#pragma unroll
                for (int bj = 0; bj < 2; ++bj)
#pragma unroll
                    for (int n = 0; n < 2; ++n) *(f32x4*)(ep + bj * DFF + 4 * n) = acc[1][bj][3][n]; }
        }
        if (fr < 2 && wr == 0) { float* ep = EDGE + (size_t)(u.pm * 4 + fr) * DFF2 + g0;
#pragma unroll
            for (int bj = 0; bj < 2; ++bj)
#pragma unroll
                for (int n = 0; n < 2; ++n) *(f32x4*)(ep + bj * DFF + 4 * n) = acc[0][bj][0][n]; }
        asm volatile("s_waitcnt lgkmcnt(0)" ::: "memory"); __builtin_amdgcn_s_barrier(); asm volatile("" ::: "memory");
#pragma unroll
        for (int n = 0; n < 2; ++n) {
            const int gc = g0 + 4 * n;
            const f32x4 wg0 = *(const f32x4*)(cw + gc), wg1 = *(const f32x4*)(cw + DFF2 + gc), wg2 = *(const f32x4*)(cw + 2 * DFF2 + gc), bgv = *(const f32x4*)(cb + gc);
            const f32x4 wu0 = *(const f32x4*)(cw + DFF + gc), wu1 = *(const f32x4*)(cw + DFF2 + DFF + gc), wu2 = *(const f32x4*)(cw + 2 * DFF2 + DFF + gc), buv = *(const f32x4*)(cb + DFF + gc);
#pragma unroll
            for (int ai = 0; ai < 2; ++ai) {
                const int band = 2 * ai + wr;
                f32x4 pg = (f32x4){0.f, 0.f, 0.f, 0.f}, pu = pg;
                if (band > 0) { const LAS float* hp = halo + ((((band - 1) * 4 + wc) * 2 + (fr & 1)) * 4 + fq) * 16; pg = *(const LAS f32x4*)(hp + n * 4); pu = *(const LAS f32x4*)(hp + 8 + n * 4); }
#pragma unroll
                for (int m = 0; m < 4; ++m) {
                    const f32x4 cg = acc[ai][0][m][n], cu = acc[ai][1][m][n];
                    float av[4];
#pragma unroll
                    for (int j = 0; j < 4; ++j) {
                        const float g1 = DPP_SHR1(DPP_ROR1(pg[j]), cg[j]), g2 = DPP_SHR2(DPP_ROR2(pg[j]), cg[j]);
                        const float u1 = DPP_SHR1(DPP_ROR1(pu[j]), cu[j]), u2 = DPP_SHR2(DPP_ROR2(pu[j]), cu[j]);
                        const float yg = bgv[j] + wg0[j] * g2 + wg1[j] * g1 + wg2[j] * cg[j];
                        const float yu = buv[j] + wu0[j] * u2 + wu1[j] * u1 + wu2[j] * cu[j];
                        av[j] = silu_f(yg) * yu;
                    }
                    *(u32x2*)(ACT + (size_t)(row0 + ai * HALF + m * 16) * DFF + gc) = (u32x2){pk2(av[0], av[1]), pk2(av[2], av[3])};
                    pg = cg; pu = cu;
                }
            }
        }
    }
};

template <class Epi>
__device__ __forceinline__ void gemm_phase(LAS unsigned char* lds, const Gemm g, const StaticOrder& S, const Epi& E) {
    int tid_ = threadIdx.x; LAUNDER_V(tid_);
    const int tid = tid_, wid = __builtin_amdgcn_readfirstlane(tid >> 6), lane = tid & 63, wr = wid >> 2, wc = wid & 3, fr = lane & 15, fq = lane >> 4;
    const int K = g.K, nt = K / BK;
    unsigned voffA[2], voffB[2];
#pragma unroll
    for (int i = 0; i < 2; ++i) { int R, C; stage_rc(tid * 16 + i * 8192, R, C); const int Rb = Epi::PERM ? ((R & ~31) + perm32(R & 31)) : R;
        voffA[i] = (unsigned)(R * g.lda + C) * 2u; voffB[i] = (unsigned)(Rb * K + C) * 2u; }
    const size_t kstep = (size_t)(BK * 2);
    const size_t hstepA = (size_t)HALF * g.lda * 2, hstepB = (size_t)HALF * K * 2;
    const size_t tstepA = 2 * hstepA, tstepB = 2 * hstepB;
    const unsigned ldsw = (unsigned)wid * 1024u;
    const int aoff = lds_byte(wr * 64 + fr, fq * 8), boff = lds_byte(wc * 32 + fr, fq * 8);
#define PG8_SA(b, h) (((b) * 2 + (h)) * HTB)
#define PG8_SB(b, h) ((4 + (b) * 2 + (h)) * HTB)
#define PG8_STAGE(bufoff, gbase, voff) do { _Pragma("unroll") for (int _i = 0; _i < 2; ++_i) \
        __builtin_amdgcn_global_load_lds((const unsigned*)((const char*)(gbase) + (voff)[_i]), (LAS unsigned*)(lds + (bufoff) + ldsw + _i * 8192), 16, 0, 0); } while (0)
#define PG8_LDA(dst, b, h) do { _Pragma("unroll") for (int m = 0; m < 4; ++m) _Pragma("unroll") for (int k = 0; k < 2; ++k) dst[m][k] = *(const LAS bf16x8*)(lds + PG8_SA(b, h) + aoff + m * 2048 + k * 1024); } while (0)
#define PG8_LDB(dst, b, h) do { _Pragma("unroll") for (int n = 0; n < 2; ++n) _Pragma("unroll") for (int k = 0; k < 2; ++k) dst[n][k] = *(const LAS bf16x8*)(lds + PG8_SB(b, h) + boff + n * 2048 + k * 1024); } while (0)
#define PG8_MMA(ai, bj, At, Bt) do { __builtin_amdgcn_s_setprio(1); _Pragma("unroll") for (int m = 0; m < 4; ++m) _Pragma("unroll") for (int n = 0; n < 2; ++n) _Pragma("unroll") for (int k = 0; k < 2; ++k) \
        acc[ai][bj][m][n] = __builtin_amdgcn_mfma_f32_16x16x32_bf16(Bt[n][k], At[m][k], acc[ai][bj][m][n], 0, 0, 0); __builtin_amdgcn_s_setprio(0); } while (0)
#define PG8_WAIT_V(n) asm volatile("s_waitcnt vmcnt(" #n ")" ::: "memory")
#define PG8_WAIT_L(n) asm volatile("s_waitcnt lgkmcnt(" #n ")" ::: "memory")
#define PG8_BAR __builtin_amdgcn_s_barrier()
#define PG8_SCHED __builtin_amdgcn_sched_barrier(0)
    Unit cur, nxt; int ui = 0;
    if (!S.next(0, cur)) return;
    f32x4 acc[2][2][4][2];
#pragma unroll
    for (int a = 0; a < 2; ++a)
#pragma unroll
        for (int b = 0; b < 2; ++b)
#pragma unroll
            for (int m = 0; m < 4; ++m)
#pragma unroll
                for (int n = 0; n < 2; ++n) acc[a][b][m][n] = (f32x4){0.f, 0.f, 0.f, 0.f};
    bf16x8 At[4][2], B0[2][2], B1[2][2];
    const char* cA = (const char*)g.A + (size_t)cur.pm * tstepA; const char* cB = (const char*)g.Bt + (size_t)cur.pn * tstepB;
    PG8_STAGE(PG8_SB(0, 0), cB, voffB); PG8_STAGE(PG8_SB(0, 1), cB + hstepB, voffB); PG8_STAGE(PG8_SA(0, 0), cA, voffA); PG8_STAGE(PG8_SA(0, 1), cA + hstepA, voffA);
    if (wr == 1) PG8_BAR;
    PG8_WAIT_V(2); PG8_BAR;
    PG8_STAGE(PG8_SB(1, 0), cB + kstep, voffB); PG8_STAGE(PG8_SA(1, 0), cA + kstep, voffA); PG8_STAGE(PG8_SB(1, 1), cB + hstepB + kstep, voffB);
    PG8_WAIT_V(6); PG8_BAR;
    for (;;) {
        const bool has_next = S.next(ui + 1, nxt);
        const char* nA = has_next ? (const char*)g.A + (size_t)nxt.pm * tstepA : cA; const char* nB = has_next ? (const char*)g.Bt + (size_t)nxt.pn * tstepB : cB;
        for (int t = 0; t < nt; t += 2) {
            const bool last = (t == nt - 2);
            const char* a1 = cA + (size_t)(t + 1) * kstep;
            const char* a2 = last ? nA : cA + (size_t)(t + 2) * kstep; const char* b2 = last ? nB : cB + (size_t)(t + 2) * kstep;
            const char* a3 = a2 + kstep; const char* b3 = b2 + kstep;
            PG8_LDB(B0, 0, 0); PG8_LDB(B1, 0, 1); PG8_SCHED; PG8_LDA(At, 0, 0); PG8_STAGE(PG8_SA(1, 1), a1 + hstepA, voffA);
            PG8_WAIT_V(8); PG8_WAIT_L(0); PG8_BAR; PG8_MMA(0, 0, At, B0); PG8_MMA(0, 1, At, B1); PG8_BAR; PG8_SCHED;
            PG8_LDA(At, 0, 1); PG8_STAGE(PG8_SB(0, 0), b2, voffB); PG8_STAGE(PG8_SB(0, 1), b2 + hstepB, voffB); PG8_STAGE(PG8_SA(0, 0), a2, voffA);
            PG8_WAIT_V(8); PG8_WAIT_L(0); PG8_BAR; PG8_MMA(1, 0, At, B0); PG8_MMA(1, 1, At, B1); PG8_BAR; PG8_SCHED;
            PG8_LDB(B0, 1, 0); PG8_LDB(B1, 1, 1); PG8_SCHED; PG8_LDA(At, 1, 0); PG8_STAGE(PG8_SA(0, 1), a2 + hstepA, voffA);
            PG8_WAIT_V(8); PG8_WAIT_L(0); PG8_BAR; PG8_MMA(0, 0, At, B0); PG8_MMA(0, 1, At, B1); PG8_BAR; PG8_SCHED;
            PG8_LDA(At, 1, 1); PG8_STAGE(PG8_SB(1, 0), b3, voffB); PG8_STAGE(PG8_SB(1, 1), b3 + hstepB, voffB); PG8_STAGE(PG8_SA(1, 0), a3, voffA);
            PG8_WAIT_V(8); PG8_WAIT_L(0); PG8_BAR; PG8_MMA(1, 0, At, B0); PG8_MMA(1, 1, At, B1); PG8_BAR; PG8_SCHED;
        }
        if (wr == 0) PG8_BAR;
        { int frE = fr, fqE = fq; LAUNDER_V(frE); LAUNDER_V(fqE); E(acc, cur, wr, wc, frE, fqE); }
        if (!has_next) break;
#pragma unroll
        for (int a = 0; a < 2; ++a)
#pragma unroll
            for (int b = 0; b < 2; ++b)
#pragma unroll
                for (int m = 0; m < 4; ++m)
#pragma unroll
                    for (int n = 0; n < 2; ++n) acc[a][b][m][n] = (f32x4){0.f, 0.f, 0.f, 0.f};
        cur = nxt; cA = nA; cB = nB; ++ui;
        if (wr == 1) PG8_BAR;
    }
    PG8_WAIT_V(0);
    PG8_BAR;
#undef PG8_SA
#undef PG8_SB
#undef PG8_STAGE
#undef PG8_LDA
#undef PG8_LDB
#undef PG8_MMA
#undef PG8_WAIT_V
#undef PG8_WAIT_L
#undef PG8_BAR
#undef PG8_SCHED
}
}

constexpr int RING_BYTES = 131072;
constexpr int LDS_BYTES = 147456;

struct Args { const float* in[20]; float* out; unsigned char* ws; float inv_freq[32]; };

#define MFMA32(a, b, c) __builtin_amdgcn_mfma_f32_32x32x16_bf16((a), (b), (c), 0, 0, 0)
__device__ __forceinline__ int crow(int r, int hi) { return (r & 3) + 8 * (r >> 2) + 4 * hi; }

__device__ __forceinline__ void wt_item(const float* __restrict__ W, int K, int N, const float* __restrict__ gain, int gainK, bf16_t* WT, LAS float* scr, int item, int nblk, int lane, bool remap_up = false) {
    const int kb = item / nblk, nb = item % nblk, k0 = 64 * kb, n0 = 32 * nb;
    const int ns0 = remap_up ? (((n0 & 255) < 128) ? 128 * (n0 >> 8) + (n0 & 255) : DFF + 128 * (n0 >> 8) + (n0 & 255) - 128) : n0;
    const int n = ns0 + (lane & 31);
#pragma unroll 8
    for (int i = 0; i < 32; ++i) { const int kk = 2 * i + (lane >> 5); float w = (n < N) ? W[(size_t)(k0 + kk) * N + n] : 0.f; if ((k0 + kk) < gainK) w *= gain[k0 + kk]; scr[kk * 33 + (lane & 31)] = w; }
    asm volatile("s_waitcnt lgkmcnt(0)" ::: "memory");
    const int c = lane & 7;
#pragma unroll
    for (int j = 0; j < 4; ++j) { const int nn = (lane >> 3) + 8 * j; const LAS float* s = scr + (8 * c) * 33 + nn;
        u32x4 o; o.x = pk2(s[0 * 33], s[1 * 33]); o.y = pk2(s[2 * 33], s[3 * 33]); o.z = pk2(s[4 * 33], s[5 * 33]); o.w = pk2(s[6 * 33], s[7 * 33]);
        *(u32x4*)(WT + (size_t)(n0 + nn) * K + k0 + 8 * c) = o; }
    asm volatile("s_waitcnt lgkmcnt(0)" ::: "memory");
}

constexpr int AT_KSTR = 400, AT_VSTR = 144;
constexpr int AT_KB = 64 * AT_KSTR  , AT_VB = 128 * AT_VSTR  , AT_K0 = 0, AT_V0 = 2 * AT_KB, AT_WSF = AT_V0 + 2 * AT_VB;
static_assert(AT_WSF + 8 * 128 <= RING_BYTES, "attn lds");

__device__ __forceinline__ void attn_unit(LAS unsigned char* L, const bf16_t* __restrict__ Q, const bf16_t* __restrict__ Kg, const bf16_t* __restrict__ Vt, bf16_t* mix, int h, int qb) {
    int tid_ = threadIdx.x; LAUNDER_V(tid_);
    const int tid = tid_, lane = tid & 63, w = __builtin_amdgcn_readfirstlane(tid >> 6), r32 = lane & 31, hh = lane >> 5;
    const int q0 = qb * 256;
    bf16x8 qf[12];
    { const bf16_t* qrow = Q + (size_t)(q0 + 32 * w + r32) * QW + h * QKD + 8 * hh;
#pragma unroll
      for (int ks = 0; ks < 12; ++ks) qf[ks] = *(const bf16x8*)(qrow + 16 * ks); }
    f32x16 o[4];
#pragma unroll
    for (int d = 0; d < 4; ++d)
#pragma unroll
        for (int i = 0; i < 16; ++i) o[d][i] = 0.f;
    float m_run = -1e30f, l_run = 0.f;
    const int NT = 4 * qb + 4, my_last = 4 * qb + (w >> 1);
    volatile LAS float* wsf = (volatile LAS float*)(L + AT_WSF) + w * 32;
    u32x4 kst[3], vst[2];
    int krow_[3], kcc_[3], vrow_[2], vcc_[2];
#pragma unroll
    for (int i = 0; i < 3; ++i) { const int id = tid + 512 * i; krow_[i] = id / 24; kcc_[i] = id % 24; }
#pragma unroll
    for (int i = 0; i < 2; ++i) { const int id = tid + 512 * i; vrow_[i] = id >> 3; vcc_[i] = id & 7; }
#define AT_GLOAD(t) do { const int kv0_ = (t) * 64; \
    _Pragma("unroll") for (int i = 0; i < 3; ++i) kst[i] = *(const u32x4*)(Kg + (size_t)(kv0_ + krow_[i]) * QW + h * QKD + kcc_[i] * 8); \
    _Pragma("unroll") for (int i = 0; i < 2; ++i) vst[i] = *(const u32x4*)(Vt + (size_t)(h * VD + vrow_[i]) * SEQ + kv0_ + vcc_[i] * 8); } while (0)
#define AT_SSTORE(buf) do { \
    _Pragma("unroll") for (int i = 0; i < 3; ++i) *(LAS u32x4*)(L + AT_K0 + (buf) * AT_KB + krow_[i] * AT_KSTR + kcc_[i] * 16) = kst[i]; \
    _Pragma("unroll") for (int i = 0; i < 2; ++i) *(LAS u32x4*)(L + AT_V0 + (buf) * AT_VB + vrow_[i] * AT_VSTR + vcc_[i] * 16) = vst[i]; } while (0)
    AT_GLOAD(0); AT_SSTORE(0); __syncthreads();
    for (int t = 0; t < NT; ++t) {
        const int buf = t & 1;
        if (t + 1 < NT) AT_GLOAD(t + 1);
        if (t <= my_last) {
            const LAS unsigned char* Kt = L + AT_K0 + buf * AT_KB + r32 * AT_KSTR + hh * 16;
            const LAS unsigned char* Vb = L + AT_V0 + buf * AT_VB + r32 * AT_VSTR + hh * 8;
            f32x16 p0, p1;
#pragma unroll
            for (int i = 0; i < 16; ++i) { p0[i] = 0.f; p1[i] = 0.f; }
#pragma unroll
            for (int ks = 0; ks < 12; ++ks) {
                const bf16x8 a0 = *(const LAS bf16x8*)(Kt + ks * 32), a1 = *(const LAS bf16x8*)(Kt + 32 * AT_KSTR + ks * 32);
                p0 = MFMA32(a0, qf[ks], p0); p1 = MFMA32(a1, qf[ks], p1);
            }
            float mx = fmaxf(p0[0], p1[0]);
#pragma unroll
            for (int i = 1; i < 16; ++i) mx = fmaxf(mx, fmaxf(p0[i], p1[i]));
            mx = fmaxf(mx, __shfl_xor(mx, 32));
            const float m_new = fmaxf(m_run, mx), alpha = __builtin_amdgcn_exp2f(m_run - m_new); m_run = m_new;
            float ls = 0.f;
#pragma unroll
            for (int i = 0; i < 16; ++i) { p0[i] = __builtin_amdgcn_exp2f(p0[i] - m_new); p1[i] = __builtin_amdgcn_exp2f(p1[i] - m_new); ls += p0[i] + p1[i]; }
            l_run = l_run * alpha + ls;
            wsf[r32] = alpha;
            asm volatile("s_waitcnt lgkmcnt(0)" ::: "memory");
#pragma unroll
            for (int i = 0; i < 16; ++i) { const float a = wsf[crow(i, hh)];
#pragma unroll
                for (int d = 0; d < 4; ++d) o[d][i] *= a; }
#pragma unroll
            for (int kb = 0; kb < 2; ++kb)
#pragma unroll
                for (int s = 0; s < 2; ++s) {
                    u32x4 pw;
                    if (kb == 0) { pw.x = pk2(p0[8 * s + 0], p0[8 * s + 1]); pw.y = pk2(p0[8 * s + 2], p0[8 * s + 3]); pw.z = pk2(p0[8 * s + 4], p0[8 * s + 5]); pw.w = pk2(p0[8 * s + 6], p0[8 * s + 7]); }
                    else         { pw.x = pk2(p1[8 * s + 0], p1[8 * s + 1]); pw.y = pk2(p1[8 * s + 2], p1[8 * s + 3]); pw.z = pk2(p1[8 * s + 4], p1[8 * s + 5]); pw.w = pk2(p1[8 * s + 6], p1[8 * s + 7]); }
                    const bf16x8 xs = __builtin_bit_cast(bf16x8, pw);
#pragma unroll
                    for (int d = 0; d < 4; ++d) {
                        const LAS unsigned char* vp = Vb + d * 32 * AT_VSTR + (32 * kb + 16 * s) * 2;
                        const s16x4 lo = *(const LAS s16x4*)(vp), hi = *(const LAS s16x4*)(vp + 16);
                        const bf16x8 pb = __builtin_shufflevector(lo, hi, 0, 1, 2, 3, 4, 5, 6, 7);
                        o[d] = MFMA32(xs, pb, o[d]);
                    }
                }
        }
        if (t + 1 < NT) AT_SSTORE(buf ^ 1);
        __syncthreads();
    }
#undef AT_GLOAD
#undef AT_SSTORE
    const float lt = l_run + __shfl_xor(l_run, 32);
    wsf[r32] = 1.0f / lt;
    asm volatile("s_waitcnt lgkmcnt(0)" ::: "memory");
    bf16_t* orow = mix + (size_t)(q0 + 32 * w) * DM + h * VD + r32;
#pragma unroll
    for (int i = 0; i < 16; ++i) { const int qr = crow(i, hh); const float a = wsf[qr];
#pragma unroll
        for (int d = 0; d < 4; ++d) orow[(size_t)qr * DM + 32 * d] = (bf16_t)f2bf(o[d][i] * a); }
    __syncthreads();
}

constexpr int GL_V = 0  , GL_KD = 32768  , GL_TOT = GL_KD + 18432  , GL_ZA = GL_TOT + 2048  ;
__device__ __forceinline__ void gla_chunk_unit(LAS unsigned char* L, const bf16_t* __restrict__ Z, const float* __restrict__ wgate, const float* __restrict__ bgate, float* ST, float* DEC, int c, int h) {
    int tid_ = threadIdx.x; LAUNDER_V(tid_);
    const int tid = tid_, lane = tid & 63, w = __builtin_amdgcn_readfirstlane(tid >> 6), r32 = lane & 31, hh = lane >> 5;
    const size_t row0 = (size_t)c * 64;
#pragma unroll
    for (int i = 0; i < 4; ++i) { const int id = tid + 512 * i, r = id >> 5, cc = id & 31;
        *(LAS u32x4*)(L + GL_V + r * 512 + cc * 16) = *(const u32x4*)(Z + (row0 + r) * IN_PAD + C_GV + h * GDV + cc * 8); }
#pragma unroll
    for (int i = 0; i < 2; ++i) { const int id = tid + 512 * i, r = id >> 4, cc = id & 15;
        ((LAS float*)(L + GL_ZA))[id] = bf2f(Z[(row0 + r) * IN_PAD + C_GA + cc]); }
    __syncthreads();
    const int tq = tid >> 7, col = tid & 127;
    float wg[16];
#pragma unroll
    for (int r = 0; r < 16; ++r) wg[r] = wgate[r * (GH * GDK) + h * GDK + col];
    const float bg = bgate[h * GDK + col];
    float pre[16]; float run = 0.f;
#pragma unroll
    for (int i = 0; i < 16; ++i) {
        const LAS float* za = (const LAS float*)(L + GL_ZA) + (16 * tq + i) * 16;
        float ga = bg;
#pragma unroll
        for (int r = 0; r < 16; ++r) ga += za[r] * wg[r];
        const float ls = fminf(ga, 0.f) - __logf(1.0f + __expf(-fabsf(ga)));
        run += ls * (1.0f / 16.0f); pre[i] = run;
    }
    ((LAS float*)(L + GL_TOT))[tq * 128 + col] = run;
    __syncthreads();
    float off = 0.f, bend = 0.f;
#pragma unroll
    for (int t = 0; t < 4; ++t) { const float v = ((LAS float*)(L + GL_TOT))[t * 128 + col]; bend += v; if (t < tq) off += v; }
    {
        unsigned pkv[8];
#pragma unroll
        for (int i = 0; i < 16; i += 2) {
            const float k0 = bf2f(Z[(row0 + 16 * tq + i) * IN_PAD + C_GK + h * GDK + col]), k1 = bf2f(Z[(row0 + 16 * tq + i + 1) * IN_PAD + C_GK + h * GDK + col]);
            pkv[i >> 1] = pk2(k0 * __expf(bend - off - pre[i]), k1 * __expf(bend - off - pre[i + 1]));
        }
        LAS u32x4* dst = (LAS u32x4*)(L + GL_KD + col * 144 + tq * 32);
        dst[0] = (u32x4){pkv[0], pkv[1], pkv[2], pkv[3]}; dst[1] = (u32x4){pkv[4], pkv[5], pkv[6], pkv[7]};
    }
    if (tq == 0) DEC[(size_t)(c * GH + h) * GDK + col] = __expf(bend);
    __syncthreads();
    f32x16 acc[4];
#pragma unroll
    for (int d = 0; d < 4; ++d)
#pragma unroll
        for (int i = 0; i < 16; ++i) acc[d][i] = 0.f;
#pragma unroll
    for (int ks = 0; ks < 4; ++ks) {
        bf16x8 a;
#pragma unroll
        for (int j = 0; j < 8; ++j) a[j] = (short)*(const LAS unsigned short*)(L + GL_V + (16 * ks + 8 * hh + j) * 512 + (32 * w + r32) * 2);
#pragma unroll
        for (int db = 0; db < 4; ++db) {
            const bf16x8 b = *(const LAS bf16x8*)(L + GL_KD + (32 * db + r32) * 144 + (16 * ks + 8 * hh) * 2);
            acc[db] = MFMA32(a, b, acc[db]);
        }
    }
    float* stp = ST + ((size_t)(c * GH + h) * GDV + 32 * w) * GDK + r32;
#pragma unroll
    for (int db = 0; db < 4; ++db)
#pragma unroll
        for (int i = 0; i < 16; ++i) stp[(size_t)crow(i, hh) * GDK + 32 * db] = acc[db][i];
    __syncthreads();
}

constexpr int GO_STR = 260;
__device__ __forceinline__ void gla_out_unit(LAS unsigned char* L, const bf16_t* __restrict__ Z, const float* __restrict__ ST, const float* __restrict__ gnorm, bf16_t* mix, int c, int h) {
    int tid_ = threadIdx.x; LAUNDER_V(tid_);
    const int tid = tid_, lane = tid & 63, w = __builtin_amdgcn_readfirstlane(tid >> 6), r32 = lane & 31, hh = lane >> 5;
    const size_t row0 = (size_t)c * 64;
    f32x16 acc[2];
#pragma unroll
    for (int d = 0; d < 2; ++d)
#pragma unroll
        for (int i = 0; i < 16; ++i) acc[d][i] = 0.f;
    const float* sp = ST + ((size_t)(c * GH + h) * GDV + 32 * w + r32) * GDK + 8 * hh;
#pragma unroll
    for (int ks = 0; ks < 8; ++ks) {
        const f32x4 s0 = *(const f32x4*)(sp + 16 * ks), s1 = *(const f32x4*)(sp + 16 * ks + 4);
        u32x4 bw; bw.x = pk2(s0[0], s0[1]); bw.y = pk2(s0[2], s0[3]); bw.z = pk2(s1[0], s1[1]); bw.w = pk2(s1[2], s1[3]);
        const bf16x8 b = __builtin_bit_cast(bf16x8, bw);
#pragma unroll
        for (int tb = 0; tb < 2; ++tb) {
            const bf16x8 a = *(const bf16x8*)(Z + (row0 + 32 * tb + r32) * IN_PAD + C_GQ + h * GDK + 16 * ks + 8 * hh);
            acc[tb] = MFMA32(a, b, acc[tb]);
        }
    }
    LAS float* of = (LAS float*)L;
#pragma unroll
    for (int tb = 0; tb < 2; ++tb)
#pragma unroll
        for (int i = 0; i < 16; ++i) of[(32 * tb + crow(i, hh)) * GO_STR + 32 * w + r32] = acc[tb][i] * 0.08838834764831845f;
    __syncthreads();
    const int tok = tid >> 3, part = tid & 7;
    float v[32]; float ss = 0.f;
#pragma unroll
    for (int i = 0; i < 32; ++i) { v[i] = of[tok * GO_STR + i * 8 + part]; ss += v[i] * v[i]; }
    ss += __shfl_xor(ss, 1); ss += __shfl_xor(ss, 2); ss += __shfl_xor(ss, 4);
    const float rstd = rsqrtf(ss * (1.0f / GDV) + EPS);
    const bf16_t* zg = Z + (row0 + tok) * IN_PAD + C_GG + h * GDV;
    bf16_t* op = mix + (row0 + tok) * DM + 1024 + h * GDV;
#pragma unroll
    for (int i = 0; i < 32; ++i) { const int dv = i * 8 + part; const float g = bf2f(zg[dv]); op[dv] = (bf16_t)f2bf(v[i] * rstd * gnorm[dv] * silu_f(g)); }
    __syncthreads();
}


#define XB_TMO      128
#define XB_XCNT(j)  (256  + 64 * (j))
#define XB_XSUB(j)  (1280 + 64 * (j))
#define XB_XGEN(j)  (2304 + 64 * (j))
#define XB_TOP      3328
#define XB_TOPGEN   3392
#define XCD_BAR_WORDS 3456
#define XB_SPIN_CAP (1u << 22)
__device__ __forceinline__ unsigned xb_ld(unsigned* p)              { return __hip_atomic_load(p, __ATOMIC_RELAXED, __HIP_MEMORY_SCOPE_AGENT); }
__device__ __forceinline__ unsigned xb_add(unsigned* p, unsigned v) { return __hip_atomic_fetch_add(p, v, __ATOMIC_RELAXED, __HIP_MEMORY_SCOPE_AGENT); }
__device__ __forceinline__ unsigned xb_xcc_id() { return (unsigned)__builtin_amdgcn_s_getreg((3 << 11) | 20) & 0xFu; }
#define XB_SPIN(cond, bar) do { unsigned _sp = 0; while (cond) { __builtin_amdgcn_s_sleep(1); \
    if ((++_sp & 255u) == 0u) { if (xb_ld(&(bar)[XB_TMO])) break; if (_sp > XB_SPIN_CAP) { atomicAdd(&(bar)[XB_TMO], 1u); break; } } } } while (0)
struct XcdBarrier { unsigned* bar; unsigned x; volatile LAS unsigned* st; };
__device__ __forceinline__ XcdBarrier xcd_barrier_post(unsigned* bar, volatile LAS unsigned* st) {
    XcdBarrier b; b.bar = bar; b.x = xb_xcc_id(); b.st = st;
    if (threadIdx.x == 0) (void)xb_add(&bar[XB_XCNT(b.x)], 1u);
    return b;
}
__device__ __forceinline__ void xcd_barrier_complete(unsigned* bar, unsigned x, unsigned& nloc, unsigned& nx) {
    const unsigned G = gridDim.x * gridDim.y * gridDim.z;
    unsigned sum, cnt, mine, sp = 0u;
    for (;;) {
        sum = 0u; cnt = 0u; mine = 0u;
#pragma unroll
        for (unsigned j = 0; j < 16; ++j) { const unsigned c = xb_ld(&bar[XB_XCNT(j)]); sum += c; cnt += (c > 0u) ? 1u : 0u; mine = (j == x) ? c : mine; }
        if (sum == G) break;
        __builtin_amdgcn_s_sleep(1);
        if ((++sp & 255u) == 0u) { if (xb_ld(&bar[XB_TMO])) break; if (sp > XB_SPIN_CAP) { atomicAdd(&bar[XB_TMO], 1u); break; } }
    }
    nloc = mine > 0u ? mine : 1u; nx = cnt > 0u ? cnt : 1u;
}
__device__ __forceinline__ void xcd_barrier(const XcdBarrier& b) {
    asm volatile("s_waitcnt vmcnt(0)" ::: "memory");
    __syncthreads();
    if (threadIdx.x == 0) {
        unsigned* bar = b.bar;
        __builtin_amdgcn_s_waitcnt(0);
        unsigned nloc = b.st[0], nx = b.st[1];
        if (nloc == 0u) { xcd_barrier_complete(bar, b.x, nloc, nx); b.st[0] = nloc; b.st[1] = nx; }
        const unsigned old = xb_add(&bar[XB_XSUB(b.x)], 1u);
        const unsigned gen = old / nloc;
        if (old + 1u == (gen + 1u) * nloc) {
            __builtin_amdgcn_fence(__ATOMIC_RELEASE, "agent");
            asm volatile("s_waitcnt vmcnt(0)" ::: "memory");
            const unsigned og = xb_add(&bar[XB_TOP], 1u);
            const unsigned tg = og / nx;
            if (og + 1u == (tg + 1u) * nx) xb_add(&bar[XB_TOPGEN], 1u);
            else XB_SPIN(xb_ld(&bar[XB_TOPGEN]) == tg, bar);
            __builtin_amdgcn_fence(__ATOMIC_ACQUIRE, "agent");
            xb_add(&bar[XB_XGEN(b.x)], 1u);
            asm volatile("s_waitcnt vmcnt(0)" ::: "memory");
        } else {
            XB_SPIN(xb_ld(&bar[XB_XGEN(b.x)]) == gen, bar);
            __builtin_amdgcn_fence(__ATOMIC_ACQUIRE, "agent");
            asm volatile("s_waitcnt vmcnt(0)" ::: "memory");
        }
    }
    __syncthreads();
}

__global__ void __launch_bounds__(512, 2) mk_fwd(Args a) {
    extern __shared__ __attribute__((aligned(16))) unsigned char lds[];
    cg::grid_group grid = cg::this_grid();
    LAS unsigned char* L = (LAS unsigned char*)lds;
    const int G = gridDim.x, bid = blockIdx.x, NGW = G * 8;
    volatile LAS unsigned* MISC = (volatile LAS unsigned*)(L + RING_BYTES + 8192);
    if (threadIdx.x < 4) MISC[threadIdx.x] = 0u;
    __syncthreads();
    (void)xcd_barrier_post((unsigned*)(a.ws + WS_BAR), MISC);
#define XSYNC() do { XcdBarrier xb_; xb_.bar = (unsigned*)(a.ws + WS_BAR); xb_.x = xb_xcc_id(); xb_.st = (volatile LAS unsigned*)(L + RING_BYTES + 8192); xcd_barrier(xb_); } while (0)
#define GRID_SYNC() do { asm volatile("s_waitcnt vmcnt(0) lgkmcnt(0)" ::: "memory"); __syncthreads(); grid.sync(); \
    __builtin_amdgcn_fence(__ATOMIC_ACQUIRE, "agent"); asm volatile("s_waitcnt vmcnt(0)" ::: "memory"); __syncthreads(); } while (0)
#ifndef DBG_STOP
#define DBG_STOP 0
#endif
#define DBG_DUMP(k, EXPR) do { if (DBG_STOP == (k)) { PHASE_BEGIN(); for (int m = gw; m < SEQ; m += NGW) for (int c = lane; c < DM; c += 64) out[(size_t)m * DM + c] = (EXPR); return; } } while (0)
#define PHASE_BEGIN() unsigned char* ws = a.ws; LAUNDER_S(ws); int tid_ = threadIdx.x; LAUNDER_V(tid_); const int tid = tid_, lane = tid & 63, wave = __builtin_amdgcn_readfirstlane(tid >> 6), gw = bid * 8 + wave; \
    u64* ssq = (u64*)(ws + WS_SSQ); (void)lane; (void)gw; (void)ssq; \
    u64* ssq_x = ssq + (size_t)l * SEQ; u64* ssq_xn = ssq + (size_t)(l + 1) * SEQ; u64* ssq_cq = ssq + (size_t)(3 + l) * SEQ; u64* ssq_ckv = ssq + (size_t)(5 + l) * SEQ; u64* ssq_x1 = ssq + (size_t)(7 + l) * SEQ; \
    (void)ssq_x; (void)ssq_xn; (void)ssq_cq; (void)ssq_ckv; (void)ssq_x1; \
    bf16_t* Win = (bf16_t*)(ws + WS_WIN); bf16_t* Wuq = (bf16_t*)(ws + WS_WUQ); bf16_t* Wukv = (bf16_t*)(ws + WS_WUKV); \
    bf16_t* Wout = (bf16_t*)(ws + WS_WOUT); bf16_t* Wup = (bf16_t*)(ws + WS_WUP); bf16_t* Wdn = (bf16_t*)(ws + WS_WDN); \
    bf16_t* XB = (bf16_t*)(ws + WS_XB); bf16_t* Z = (bf16_t*)(ws + WS_Z); bf16_t* Qb = (bf16_t*)(ws + WS_Q); bf16_t* Kb = (bf16_t*)(ws + WS_K); bf16_t* Vt = (bf16_t*)(ws + WS_VT); \
    float* ST = (float*)(ws + WS_ST); float* DEC = (float*)(ws + WS_DEC); bf16_t* MIX = (bf16_t*)(ws + WS_MIX); \
    bf16_t* ACT = (bf16_t*)(ws + WS_ACT); float* EDGE = (float*)(ws + WS_EDGE); \
    const float* xin = a.in[0]; float* out = a.out; \
    (void)Win; (void)Wuq; (void)Wukv; (void)Wout; (void)Wup; (void)Wdn; (void)XB; (void)Z; (void)Qb; (void)Kb; (void)Vt; (void)ST; (void)DEC; (void)MIX; (void)EDGE; (void)ACT; (void)xin; (void)out;

    for (int l = 0; l < NLAYER; ++l) {
        {
            PHASE_BEGIN();
            LAS float* scr = (LAS float*)(L + wave * 16384);
            const float* w_in = a.in[3] + (size_t)l * DM * IN_DIM; const float* w_uq = a.in[5] + (size_t)l * QLORA * QW; const float* w_ukv = a.in[7] + (size_t)l * KVLORA * KVW;
            const float* w_out = a.in[14] + (size_t)l * DM * DM; const float* w_up = a.in[16] + (size_t)l * DM * DFF2; const float* w_dn = a.in[19] + (size_t)l * DFF * DM;
            const float* g_attn = a.in[2] + l * DM; const float* g_cq = a.in[4] + l * QLORA; const float* g_ckv = a.in[6] + l * KVLORA; const float* g_mla = a.in[13] + l * 1024; const float* g_ffn = a.in[15] + l * DM;
            constexpr int I_IN = (DM / 64) * (IN_PAD / 32), I_UQ = (QLORA / 64) * (QW / 32), I_UKV = (KVLORA / 64) * (KVW / 32), I_OUT = (DM / 64) * (DM / 32), I_UP = (DM / 64) * (DFF2 / 32), I_DN = (DFF / 64) * (DM / 32);
            constexpr int NITEMS = I_IN + I_UQ + I_UKV + I_OUT + I_UP + I_DN;
            for (int it = gw; it < NITEMS; it += NGW) {
                int r = it;
                if (r < I_IN) { wt_item(w_in, DM, IN_DIM, g_attn, DM, Win, scr, r, IN_PAD / 32, lane); continue; } r -= I_IN;
                if (r < I_UQ) { wt_item(w_uq, QLORA, QW, g_cq, QLORA, Wuq, scr, r, QW / 32, lane); continue; } r -= I_UQ;
                if (r < I_UKV) { wt_item(w_ukv, KVLORA, KVW, g_ckv, KVLORA, Wukv, scr, r, KVW / 32, lane); continue; } r -= I_UKV;
                if (r < I_OUT) { wt_item(w_out, DM, DM, g_mla, 1024, Wout, scr, r, DM / 32, lane); continue; } r -= I_OUT;
                if (r < I_UP) { wt_item(w_up, DM, DFF2, g_ffn, DM, Wup, scr, r, DFF2 / 32, lane, true); continue; } r -= I_UP;
                wt_item(w_dn, DFF, DM, g_ffn, 0, Wdn, scr, r, DM / 32, lane);
            }
            if (l == 0) {
                for (int m = gw; m < SEQ; m += NGW) {
                    const f32x4* xr = (const f32x4*)(xin + (size_t)m * DM) + lane; float s = 0.f;
                    u32x2* o8 = (u32x2*)(XB + (size_t)m * DM) + lane;
#pragma unroll
                    for (int j = 0; j < 8; ++j) { const f32x4 v = xr[64 * j]; s += (v[0] * v[0] + v[1] * v[1]) + (v[2] * v[2] + v[3] * v[3]); o8[64 * j] = (u32x2){pk2(v[0], v[1]), pk2(v[2], v[3])}; }
                    s = wave_sum(s); if (lane == 0) ssq_x[m] = (u64)(s * SSQ_FX + 0.5f);
                }
            }
        }
        if (l == 0) GRID_SYNC(); else XSYNC();
        {
            PHASE_BEGIN();
            pg8::Gemm g{XB, Win, SEQ, IN_PAD, DM, DM}; pg8::StaticOrder S; S.init(SEQ, IN_PAD, G, bid);
            pg8::EpiRowScale E{Z, IN_PAD, ssq_x, 1.0f / DM, ssq_cq, 0, 2, ssq_ckv, 2, 3};
            pg8::gemm_phase<pg8::EpiRowScale>(L, g, S, E);
        }
        XSYNC();
        DBG_DUMP(1, bf2f(Z[(size_t)m * IN_PAD + c]) + bf2f(Z[(size_t)m * IN_PAD + 2048 + c]));
        {
            PHASE_BEGIN();
            { pg8::Gemm g{Z + C_CQ, Wuq, SEQ, QW, QLORA, IN_PAD}; pg8::StaticOrder S; S.init(SEQ, QW, G, bid);
              pg8::EpiRowScale E{Qb, QW, ssq_cq, 1.0f / QLORA, nullptr, 0, 0, nullptr, 0, 0};
              pg8::gemm_phase<pg8::EpiRowScale>(L, g, S, E); }
            { pg8::Gemm g{Z + C_CKV, Wukv, SEQ, KVW, KVLORA, IN_PAD}; pg8::StaticOrder S; S.init(SEQ, KVW, G, bid);
              pg8::EpiUkv E{Kb, Vt, ssq_ckv, 1.0f / KVLORA};
              pg8::gemm_phase<pg8::EpiUkv>(L, g, S, E); }
            const float* wgate = a.in[10] + (size_t)l * 16 * (GH * GDK); const float* bgate = a.in[11] + (size_t)l * (GH * GDK);
            for (int u = bid; u < NCHUNK * GH; u += G) gla_chunk_unit(L, Z, wgate, bgate, ST, DEC, u >> 2, u & 3);
        }
        XSYNC();
        DBG_DUMP(2, (c < QW ? bf2f(Qb[(size_t)m * QW + c]) + bf2f(Kb[(size_t)m * QW + c]) : bf2f(Vt[(size_t)(c - QW) * SEQ + m])) + ST[(size_t)m * 8192 + c] + ST[(size_t)m * 8192 + 4096 + c]);
        {
            PHASE_BEGIN();
            const int* pos = (const int*)a.in[1];
            const float* qn = a.in[8] + l * QKD; const float* kn = a.in[9] + l * QKD;
            const float qscale = 0.07216878364870322f * 1.4426950408889634f;
            for (int m = gw; m < SEQ; m += NGW) {
                const int i = lane & 31;
                const float ang = (float)pos[m] * a.inv_freq[i];
                double rev = (double)ang * 0.15915494309189535; rev -= __builtin_rint(rev);
                const float sn = __builtin_amdgcn_sinf((float)rev), cs = __builtin_amdgcn_cosf((float)rev);
                const float krv = bf2f(Z[(size_t)m * IN_PAD + C_KR + lane]);
                bf16_t* qp = Qb + (size_t)m * QW; bf16_t* kp = Kb + (size_t)m * QW;
                float qa[NH][3], ka[NH][2], qs[NH], ks[NH];
#pragma unroll
                for (int h = 0; h < NH; ++h) { qa[h][0] = bf2f(qp[h * QKD + lane]); qa[h][1] = bf2f(qp[h * QKD + 64 + lane]); qa[h][2] = bf2f(qp[h * QKD + 128 + lane]);
                                               ka[h][0] = bf2f(kp[h * QKD + lane]); ka[h][1] = bf2f(kp[h * QKD + 64 + lane]); }
#pragma unroll
                for (int h = 0; h < NH; ++h) { qs[h] = qa[h][0] * qa[h][0] + qa[h][1] * qa[h][1] + qa[h][2] * qa[h][2]; ks[h] = ka[h][0] * ka[h][0] + ka[h][1] * ka[h][1] + krv * krv; }
#pragma unroll
                for (int o = 1; o < 64; o <<= 1)
#pragma unroll
                    for (int h = 0; h < NH; ++h) { qs[h] += __shfl_xor(qs[h], o); ks[h] += __shfl_xor(ks[h], o); }
                const float qg0 = qn[lane], qg1 = qn[64 + lane], qg2 = qn[128 + lane], kg0 = kn[lane], kg1 = kn[64 + lane], kg2 = kn[128 + lane];
#pragma unroll
                for (int h = 0; h < NH; ++h) {
                    { const float rstd = rsqrtf(qs[h] * (1.0f / QKD) + EPS);
                      const float n2 = qa[h][2] * rstd * qg2, pr = __shfl_xor(n2, 32);
                      const float r2 = (lane < 32) ? n2 * cs - pr * sn : n2 * cs + pr * sn;
                      qp[h * QKD + lane] = (bf16_t)f2bf(qa[h][0] * rstd * qg0 * qscale); qp[h * QKD + 64 + lane] = (bf16_t)f2bf(qa[h][1] * rstd * qg1 * qscale); qp[h * QKD + 128 + lane] = (bf16_t)f2bf(r2 * qscale); }
                    { const float rstd = rsqrtf(ks[h] * (1.0f / QKD) + EPS);
                      const float n2 = krv * rstd * kg2, pr = __shfl_xor(n2, 32);
                      const float r2 = (lane < 32) ? n2 * cs - pr * sn : n2 * cs + pr * sn;
                      kp[h * QKD + lane] = (bf16_t)f2bf(ka[h][0] * rstd * kg0); kp[h * QKD + 64 + lane] = (bf16_t)f2bf(ka[h][1] * rstd * kg1); kp[h * QKD + 128 + lane] = (bf16_t)f2bf(r2); }
                }
            }
            constexpr int NE = GH * GDV * GDK;
            for (int e = bid * 512 + tid; e < NE; e += G * 512) {
                const int hd = (e >> 15) * GDK + (e & 127);
                float s = 0.f;
                for (int c0 = 0; c0 < NCHUNK; c0 += 8) {
                    float uu[8], dd[8];
#pragma unroll
                    for (int i = 0; i < 8; ++i) { uu[i] = ST[(size_t)(c0 + i) * NE + e]; dd[i] = DEC[(size_t)(c0 + i) * (GH * GDK) + hd]; }
#pragma unroll
                    for (int i = 0; i < 8; ++i) { s = s * dd[i] + uu[i]; ST[(size_t)(c0 + i) * NE + e] = s; }
                }
            }
        }
        XSYNC();
        DBG_DUMP(3, (c < QW ? bf2f(Qb[(size_t)m * QW + c]) + bf2f(Kb[(size_t)m * QW + c]) : 0.f) + ST[(size_t)m * 8192 + c] + ST[(size_t)m * 8192 + 4096 + c]);
        {
            PHASE_BEGIN();
            for (int p = bid; p < 256; p += G) {
                const int h = p >> 5, s = p & 31;
                attn_unit(L, Qb, Kb, Vt, MIX, h, 63 - s);
                attn_unit(L, Qb, Kb, Vt, MIX, h, s);
            }
            const float* gnorm = a.in[12] + l * GDV;
            for (int u = bid; u < NCHUNK * GH; u += G) gla_out_unit(L, Z, ST, gnorm, MIX, u >> 2, u & 3);
        }
        XSYNC();
        DBG_DUMP(4, bf2f(MIX[(size_t)m * DM + c]));
        { PHASE_BEGIN();
        for (int m = gw; m < SEQ; m += NGW) {
            u32x4* p = (u32x4*)(MIX + (size_t)m * DM) + lane;
            u32x4 v0 = p[0], v1 = p[64]; float s = 0.f;
#pragma unroll
            for (int j = 0; j < 4; ++j) { const float a0 = bflo(v0[j]), a1 = bfhi(v0[j]), b0 = bflo(v1[j]), b1 = bfhi(v1[j]); s += a0 * a0 + a1 * a1 + b0 * b0 + b1 * b1; }
            const float rstd = rsqrtf(wave_sum(s) * (1.0f / 1024.0f) + EPS);
#pragma unroll
            for (int j = 0; j < 4; ++j) { v0[j] = pk2(bflo(v0[j]) * rstd, bfhi(v0[j]) * rstd); v1[j] = pk2(bflo(v1[j]) * rstd, bfhi(v1[j]) * rstd); }
            p[0] = v0; p[64] = v1;
        } }
        XSYNC();
        DBG_DUMP(5, bf2f(MIX[(size_t)m * DM + c]));
        {
            PHASE_BEGIN();
            pg8::Gemm g{MIX, Wout, SEQ, DM, DM, DM}; pg8::StaticOrder S; S.init(SEQ, DM, G, bid);
            pg8::EpiRes E{l == 0 ? xin : out, out, XB, ssq_x1};
            pg8::gemm_phase<pg8::EpiRes>(L, g, S, E);
        }
        XSYNC();
        DBG_DUMP(6, out[(size_t)m * DM + c] + bf2f(XB[(size_t)m * DM + c]));
        {
            PHASE_BEGIN();
            const float* cw = a.in[17] + (size_t)l * 3 * DFF2; const float* cb = a.in[18] + (size_t)l * DFF2;
            pg8::Gemm g{XB, Wup, SEQ, DFF2, DM, DM}; pg8::StaticOrder S; S.init(SEQ, DFF2, G, bid);
            pg8::EpiUpConv E{ACT, EDGE, ssq_x1, cw, cb, (LAS float*)(L + RING_BYTES)};
            pg8::gemm_phase<pg8::EpiUpConv>(L, g, S, E);
        }
        XSYNC();
        {
            PHASE_BEGIN();
            const float* cw = a.in[17] + (size_t)l * 3 * DFF2; const float* cb = a.in[18] + (size_t)l * DFF2;
            for (int idx = bid * 512 + tid; idx < 63 * DFF; idx += G * 512) {
                const int pm = 1 + idx / DFF, gcol = idx % DFF;
                float y0[2], y1[2];
#pragma unroll
                for (int q = 0; q < 2; ++q) { const int c = q * DFF + gcol;
                    const float um2 = EDGE[(size_t)((pm - 1) * 4 + 2) * DFF2 + c], um1 = EDGE[(size_t)((pm - 1) * 4 + 3) * DFF2 + c], u0 = EDGE[(size_t)(pm * 4 + 0) * DFF2 + c], u1 = EDGE[(size_t)(pm * 4 + 1) * DFF2 + c];
                    const float w0 = cw[c], w1 = cw[DFF2 + c], w2 = cw[2 * DFF2 + c], bb = cb[c];
                    y0[q] = bb + w0 * um2 + w1 * um1 + w2 * u0; y1[q] = bb + w0 * um1 + w1 * u0 + w2 * u1; }
                ACT[(size_t)(pm * 256) * DFF + gcol] = (bf16_t)f2bf(silu_f(y0[0]) * y0[1]);
                ACT[(size_t)(pm * 256 + 1) * DFF + gcol] = (bf16_t)f2bf(silu_f(y1[0]) * y1[1]);
            }
        }
        XSYNC();
        DBG_DUMP(8, bf2f(ACT[(size_t)m * DFF + c]) + bf2f(ACT[(size_t)m * DFF + 3000 + c]));
        {
            PHASE_BEGIN();
            pg8::Gemm g{ACT, Wdn, SEQ, DM, DFF, DFF}; pg8::StaticOrder S; S.init(SEQ, DM, G, bid);
            pg8::EpiRes E{out, out, XB, ssq_xn};
            pg8::gemm_phase<pg8::EpiRes>(L, g, S, E);
        }
        XSYNC();
        if (DBG_STOP == 9) return;
    }
}

extern "C" void kernel_launch(void* const* d_in, const int* in_sizes, int n_in, void* d_out, int out_size, void* d_ws, size_t ws_size, hipStream_t stream) {
    static int grid = 0;
    if (grid == 0) {
        if (n_in != 20 || out_size != SEQ * DM || ws_size < WS_END) { fprintf(stderr, "kernel_launch: unexpected shapes: n_in %d out %d ws %zu (need %zu)\n", n_in, out_size, ws_size, (size_t)WS_END); grid = -1; return; }
        int dev = 0, cus = 0, per_cu = 0;
        hipGetDevice(&dev); hipDeviceGetAttribute(&cus, hipDeviceAttributeMultiprocessorCount, dev);
        hipFuncSetAttribute((const void*)mk_fwd, hipFuncAttributeMaxDynamicSharedMemorySize, LDS_BYTES);
        hipOccupancyMaxActiveBlocksPerMultiprocessor(&per_cu, (const void*)mk_fwd, 512, LDS_BYTES);
        (void)hipGetLastError();
        if (per_cu < 1) per_cu = 1;
        grid = cus * 1;
    }
    if (grid < 0) return;
    hipMemsetAsync((char*)d_ws + WS_CTL, 0, CTL_BYTES, stream);
    Args a{};
    for (int i = 0; i < 20; ++i) a.in[i] = (const float*)d_in[i];
    a.out = (float*)d_out; a.ws = (unsigned char*)d_ws;
    for (int i = 0; i < 32; ++i) a.inv_freq[i] = (float)pow(10000.0, -(double)i / 32.0);
    void* args[] = {&a};
    hipError_t e = hipLaunchCooperativeKernel((const void*)mk_fwd, dim3(grid), dim3(512), args, LDS_BYTES, stream);
    if (e != hipSuccess) fprintf(stderr, "cooperative launch failed: %s (grid %d)\n", hipGetErrorString(e), grid);
}
```

```cpp
#include <hip/hip_runtime.h>
#include <hip/hip_cooperative_groups.h>
#include <cstdio>
#include <cstdint>
#include <cmath>
namespace cg = cooperative_groups;

#define LAS __attribute__((address_space(3)))
typedef unsigned short bf16_t;
typedef unsigned long long u64;
typedef short bf16x8 __attribute__((ext_vector_type(8)));
typedef short s16x4 __attribute__((ext_vector_type(4)));
typedef float f32x4 __attribute__((ext_vector_type(4)));
typedef float f32x16 __attribute__((ext_vector_type(16)));
typedef unsigned u32x4 __attribute__((ext_vector_type(4)));
typedef unsigned u32x2 __attribute__((ext_vector_type(2)));
typedef float f32x2_t __attribute__((ext_vector_type(2)));
typedef __bf16 bf16x2_t __attribute__((ext_vector_type(2)));

constexpr int SEQ = 16384, DM = 2048, NLAYER = 2;
constexpr int IN_DIM = 3920, IN_PAD = 4096;
constexpr int C_CQ = 0, C_CKV = 512, C_KR = 768, C_GQ = 832, C_GK = 1344, C_GV = 1856, C_GA = 2880, C_GG = 2896;
constexpr int QLORA = 512, KVLORA = 256, NH = 8, QKD = 192, NOPE = 128, VD = 128, QW = NH * QKD  , KVW = NH * 256  ;
constexpr int GH = 4, GDK = 128, GDV = 256, NCHUNK = SEQ / 64;
constexpr int DFF = 5632, DFF2 = 11264;
constexpr float EPS = 1e-6f;

constexpr size_t MiB = 1u << 20;
constexpr size_t WS_CTL = 0, CTL_BYTES = 2 * MiB;
constexpr size_t WS_BAR = 0;
constexpr size_t WS_SSQ = 65536;
constexpr size_t WS_WIN = 2 * MiB, WS_WUQ = 18 * MiB, WS_WUKV = WS_WUQ + 3 * MiB / 2, WS_WOUT = WS_WUKV + 1 * MiB, WS_WUP = WS_WOUT + 8 * MiB, WS_WDN = WS_WUP + 44 * MiB;
constexpr size_t WS_XB = 95 * MiB;
constexpr size_t WS_R = 159 * MiB;
constexpr size_t WS_Z = WS_R, WS_Q = WS_Z + 128 * MiB, WS_K = WS_Q + 48 * MiB, WS_VT = WS_K + 48 * MiB, WS_ST = WS_VT + 32 * MiB, WS_DEC = WS_ST + 128 * MiB, WS_MIX = WS_DEC + 1 * MiB;
constexpr size_t WS_ACT = WS_R, WS_EDGE = WS_ACT + 176 * MiB, WS_END = WS_MIX + 64 * MiB;
static_assert(WS_EDGE + 12 * MiB <= WS_END, "ws map");

#define GAS __attribute__((address_space(1)))
template <class T> __device__ __forceinline__ GAS T* G_(T* p) { return (GAS T*)p; }
#define LAUNDER_V(x) asm volatile("" : "+v"(x))
#define LAUNDER_S(x) asm volatile("" : "+s"(x))
__device__ __forceinline__ unsigned f2bf(float f) { unsigned u = __builtin_bit_cast(unsigned, f); return (u + 0x7fffu + ((u >> 16) & 1u)) >> 16; }
__device__ __forceinline__ unsigned pk2(float lo, float hi) { f32x2_t v = {lo, hi}; bf16x2_t b = __builtin_convertvector(v, bf16x2_t); return __builtin_bit_cast(unsigned, b); }
__device__ __forceinline__ float bf2f(unsigned b) { return __builtin_bit_cast(float, b << 16); }
__device__ __forceinline__ float bflo(unsigned w) { return __builtin_bit_cast(float, w << 16); }
__device__ __forceinline__ float bfhi(unsigned w) { return __builtin_bit_cast(float, w & 0xffff0000u); }
__device__ __forceinline__ float wave_sum(float v) {
#pragma unroll
    for (int o = 1; o < 64; o <<= 1) v += __shfl_xor(v, o);
    return v;
}
constexpr float SSQ_FX = 1048576.0f, SSQ_INV = 1.0f / 1048576.0f;
__device__ __forceinline__ void ssq_add(u64* p, float v) { __hip_atomic_fetch_add((GAS u64*)p, (u64)(v * SSQ_FX + 0.5f), __ATOMIC_RELAXED, __HIP_MEMORY_SCOPE_AGENT); }
__device__ __forceinline__ float ssq_get(const u64* p) { return (float)(*(GAS const u64*)p) * SSQ_INV; }
__device__ __forceinline__ float silu_f(float x) { return x * __builtin_amdgcn_rcpf(1.0f + __expf(-x)); }

namespace pg8 {
constexpr int BM = 256, BK = 64, HALF = 128, HTB = HALF * BK * 2, STAGE_BYTES = 8 * HTB, NXCD = 8, WGM = 8;
__host__ __device__ __forceinline__ int lds_byte(int r, int c) { const int st = (r >> 4) * 2 + (c >> 5), rr = r & 15, cc = c & 31, ob = rr * 64 + cc * 2; return st * 1024 + (ob ^ (((ob >> 9) & 1) << 5)); }
__host__ __device__ __forceinline__ void stage_rc(int b, int& R, int& C) { const int st = b / 1024, sb = b % 1024, swz = sb ^ (((sb >> 9) & 1) << 5); R = (st >> 1) * 16 + swz / 64; C = (st & 1) * 32 + (swz % 64) / 2; }
__host__ __device__ __forceinline__ int perm32(int rho) { const int n = rho >> 4, i = rho & 15; return 8 * (i >> 2) + 4 * n + (i & 3); }

struct Unit { int pm, pn; };
struct Gemm { const bf16_t* A; const bf16_t* Bt; int M, N, K, lda; };

struct StaticOrder {
    int nM, nN, nwg, G, c;
    __device__ void init(int M, int N, int G_, int c_) { nM = M / BM; nN = N / BM; nwg = nM * nN; G = G_; c = c_; }
    __device__ bool next(int i, Unit& u) const {
        const long L = (long)i * G + c; if (L >= nwg) return false;
        int wgid = (int)L; { const int q = nwg / NXCD, r = nwg % NXCD, xcd = wgid % NXCD, off = wgid / NXCD; wgid = (xcd < r ? xcd * (q + 1) : r * (q + 1) + (xcd - r) * q) + off; }
        const int nig = WGM * nN, gid = wgid / nig, fm = gid * WGM, gsz = (nM - fm) < WGM ? (nM - fm) : WGM;
        u.pm = fm + ((wgid % nig) % gsz); u.pn = (wgid % nig) / gsz; return true;
    }
};

struct EpiRowScale {
    static constexpr bool PERM = true;
    bf16_t* O; int ldc; const u64* ssq_in; float inv_dim; u64* ssq_a; int a_lo, a_hi; u64* ssq_b; int b_lo, b_hi;
    __device__ __forceinline__ void operator()(const f32x4 (&acc)[2][2][4][2], const Unit& u, int wr, int wc, int fr, int fq) const {
        const int row0 = u.pm * BM + wr * 64 + fr, col0 = u.pn * BM + wc * 32 + 8 * fq;
        u64* sacc = (u.pn >= a_lo && u.pn < a_hi) ? ssq_a : ((u.pn >= b_lo && u.pn < b_hi) ? ssq_b : nullptr);
#pragma unroll
        for (int ai = 0; ai < 2; ++ai)
#pragma unroll
            for (int m = 0; m < 4; ++m) {
                const int row = row0 + ai * HALF + m * 16;
                const float sc = ssq_in ? rsqrtf(ssq_get(ssq_in + row) * inv_dim + EPS) : 1.0f;
                float ss = 0.f;
#pragma unroll
                for (int bj = 0; bj < 2; ++bj) {
                    const f32x4 v0 = acc[ai][bj][m][0] * sc, v1 = acc[ai][bj][m][1] * sc;
                    ss += (v0[0] * v0[0] + v0[1] * v0[1]) + (v0[2] * v0[2] + v0[3] * v0[3]) + (v1[0] * v1[0] + v1[1] * v1[1]) + (v1[2] * v1[2] + v1[3] * v1[3]);
                    u32x4 w; w.x = pk2(v0[0], v0[1]); w.y = pk2(v0[2], v0[3]); w.z = pk2(v1[0], v1[1]); w.w = pk2(v1[2], v1[3]);
                    *(GAS u32x4*)(G_(O) + (size_t)row * ldc + col0 + bj * HALF) = w;
                }
                if (sacc) { ss += __shfl_xor(ss, 16); ss += __shfl_xor(ss, 32); if (fq == 0) ssq_add(sacc + row, ss); }
            }
    }
};
struct EpiUkv {
    static constexpr bool PERM = true;
    bf16_t* Kb; bf16_t* Vt; const u64* ssq_in; float inv_dim;
    __device__ __forceinline__ void operator()(const f32x4 (&acc)[2][2][4][2], const Unit& u, int wr, int wc, int fr, int fq) const {
        const int row0 = u.pm * BM + wr * 64 + fr, c0 = wc * 32 + 8 * fq;
#pragma unroll
        for (int ai = 0; ai < 2; ++ai)
#pragma unroll
            for (int m = 0; m < 4; ++m) {
                const int row = row0 + ai * HALF + m * 16;
                const int prow = (row & ~15) | (row & 3) | ((row & 4) << 1) | ((row & 8) >> 1);
                const float sc = rsqrtf(ssq_get(ssq_in + row) * inv_dim + EPS);
                { const f32x4 v0 = acc[ai][0][m][0] * sc, v1 = acc[ai][0][m][1] * sc;
                  u32x4 w; w.x = pk2(v0[0], v0[1]); w.y = pk2(v0[2], v0[3]); w.z = pk2(v1[0], v1[1]); w.w = pk2(v1[2], v1[3]);
                  *(GAS u32x4*)(G_(Kb) + (size_t)row * QW + u.pn * QKD + c0) = w; }
#pragma unroll
                for (int n = 0; n < 2; ++n)
#pragma unroll
                    for (int j = 0; j < 4; ++j) G_(Vt)[(size_t)(u.pn * VD + c0 + 4 * n + j) * SEQ + prow] = (bf16_t)f2bf(acc[ai][1][m][n][j] * sc);
            }
    }
};
struct EpiRes {
    static constexpr bool PERM = true;
    const float* base; float* out; bf16_t* xb; u64* ssq_out;
    __device__ __forceinline__ void operator()(const f32x4 (&acc)[2][2][4][2], const Unit& u, int wr, int wc, int fr, int fq) const {
        const int row0 = u.pm * BM + wr * 64 + fr, col0 = u.pn * BM + wc * 32 + 8 * fq;
#pragma unroll
        for (int ai = 0; ai < 2; ++ai)
#pragma unroll
            for (int m = 0; m < 4; ++m) {
                const int row = row0 + ai * HALF + m * 16; float ss = 0.f;
#pragma unroll
                for (int bj = 0; bj < 2; ++bj) {
                    const size_t off = (size_t)row * DM + col0 + bj * HALF;
                    const f32x4 v0 = acc[ai][bj][m][0] + *(GAS const f32x4*)(G_(base) + off), v1 = acc[ai][bj][m][1] + *(GAS const f32x4*)(G_(base) + off + 4);
                    ss += (v0[0] * v0[0] + v0[1] * v0[1]) + (v0[2] * v0[2] + v0[3] * v0[3]) + (v1[0] * v1[0] + v1[1] * v1[1]) + (v1[2] * v1[2] + v1[3] * v1[3]);
                    *(GAS f32x4*)(G_(out) + off) = v0; *(GAS f32x4*)(G_(out) + off + 4) = v1;
                    u32x4 w; w.x = pk2(v0[0], v0[1]); w.y = pk2(v0[2], v0[3]); w.z = pk2(v1[0], v1[1]); w.w = pk2(v1[2], v1[3]);
                    *(GAS u32x4*)(G_(xb) + off) = w;
                }
                ss += __shfl_xor(ss, 16); ss += __shfl_xor(ss, 32); if (fq == 0) ssq_add(ssq_out + row, ss);
            }
    }
};


#define DPP_SHR1(old, src) __builtin_bit_cast(float, __builtin_amdgcn_update_dpp(__builtin_bit_cast(int, (float)(old)), __builtin_bit_cast(int, (float)(src)), 0x111, 0xf, 0xf, false))
#define DPP_SHR2(old, src) __builtin_bit_cast(float, __builtin_amdgcn_update_dpp(__builtin_bit_cast(int, (float)(old)), __builtin_bit_cast(int, (float)(src)), 0x112, 0xf, 0xf, false))
#define DPP_ROR1(src) __builtin_bit_cast(float, __builtin_amdgcn_update_dpp(0, __builtin_bit_cast(int, (float)(src)), 0x121, 0xf, 0xf, false))
#define DPP_ROR2(src) __builtin_bit_cast(float, __builtin_amdgcn_update_dpp(0, __builtin_bit_cast(int, (float)(src)), 0x122, 0xf, 0xf, false))
struct EpiUpConv {
    static constexpr bool PERM = true;
    bf16_t* ACT; float* EDGE; const u64* ssq_in; const float* cw; const float* cb; LAS float* halo;
    __device__ __forceinline__ void operator()(f32x4 (&acc)[2][2][4][2], const Unit& u, int wr, int wc, int fr, int fq) const {
        const int row0 = u.pm * BM + wr * 64 + fr;
        const int g0 = u.pn * 128 + wc * 32 + 8 * fq;
#pragma unroll
        for (int ai = 0; ai < 2; ++ai)
#pragma unroll
            for (int m = 0; m < 4; ++m) {
                const float sc = rsqrtf(ssq_get(ssq_in + row0 + ai * HALF + m * 16) * (1.0f / DM) + EPS);
#pragma unroll
                for (int bj = 0; bj < 2; ++bj)
#pragma unroll
                    for (int n = 0; n < 2; ++n) acc[ai][bj][m][n] = acc[ai][bj][m][n] * sc;
            }
        if (fr >= 14) {
#pragma unroll
            for (int ai = 0; ai < 2; ++ai) { LAS float* hp = halo + ((((2 * ai + wr) * 4 + wc) * 2 + (fr - 14)) * 4 + fq) * 16;
#pragma unroll
                for (int bj = 0; bj < 2; ++bj)
#pragma unroll
                    for (int n = 0; n < 2; ++n) *(LAS f32x4*)(hp + bj * 8 + n * 4) = acc[ai][bj][3][n]; }
            if (wr == 1) { GAS float* ep = G_(EDGE) + (size_t)(u.pm * 4 + 2 + fr - 14) * DFF2 + g0;
#pragma unroll
                for (int bj = 0; bj < 2; ++bj)
#pragma unroll
                    for (int n = 0; n < 2; ++n) *(GAS f32x4*)(ep + bj * DFF + 4 * n) = acc[1][bj][3][n]; }
        }
        if (fr < 2 && wr == 0) { GAS float* ep = G_(EDGE) + (size_t)(u.pm * 4 + fr) * DFF2 + g0;
#pragma unroll
            for (int bj = 0; bj < 2; ++bj)
#pragma unroll
                for (int n = 0; n < 2; ++n) *(GAS f32x4*)(ep + bj * DFF + 4 * n) = acc[0][bj][0][n]; }
        asm volatile("s_waitcnt lgkmcnt(0)" ::: "memory"); __builtin_amdgcn_s_barrier(); asm volatile("" ::: "memory");
#pragma unroll
        for (int n = 0; n < 2; ++n) {
            const int gc = g0 + 4 * n;
            GAS const float* cwg = G_(cw); GAS const float* cbg = G_(cb);
            const f32x4 wg0 = *(GAS const f32x4*)(cwg + gc), wg1 = *(GAS const f32x4*)(cwg + DFF2 + gc), wg2 = *(GAS const f32x4*)(cwg + 2 * DFF2 + gc), bgv = *(GAS const f32x4*)(cbg + gc);
            const f32x4 wu0 = *(GAS const f32x4*)(cwg + DFF + gc), wu1 = *(GAS const f32x4*)(cwg + DFF2 + DFF + gc), wu2 = *(GAS const f32x4*)(cwg + 2 * DFF2 + DFF + gc), buv = *(GAS const f32x4*)(cbg + DFF + gc);
#pragma unroll
            for (int ai = 0; ai < 2; ++ai) {
                const int band = 2 * ai + wr;
                f32x4 pg = (f32x4){0.f, 0.f, 0.f, 0.f}, pu = pg;
                if (band > 0) { const LAS float* hp = halo + ((((band - 1) * 4 + wc) * 2 + (fr & 1)) * 4 + fq) * 16; pg = *(const LAS f32x4*)(hp + n * 4); pu = *(const LAS f32x4*)(hp + 8 + n * 4); }
#pragma unroll
                for (int m = 0; m < 4; ++m) {
                    const f32x4 cg = acc[ai][0][m][n], cu = acc[ai][1][m][n];
                    float av[4];
#pragma unroll
                    for (int j = 0; j < 4; ++j) {
                        const float g1 = DPP_SHR1(DPP_ROR1(pg[j]), cg[j]), g2 = DPP_SHR2(DPP_ROR2(pg[j]), cg[j]);
                        const float u1 = DPP_SHR1(DPP_ROR1(pu[j]), cu[j]), u2 = DPP_SHR2(DPP_ROR2(pu[j]), cu[j]);
                        const float yg = bgv[j] + wg0[j] * g2 + wg1[j] * g1 + wg2[j] * cg[j];
                        const float yu = buv[j] + wu0[j] * u2 + wu1[j] * u1 + wu2[j] * cu[j];
                        av[j] = silu_f(yg) * yu;
                    }
                    *(GAS u32x2*)(G_(ACT) + (size_t)(row0 + ai * HALF + m * 16) * DFF + gc) = (u32x2){pk2(av[0], av[1]), pk2(av[2], av[3])};
                    pg = cg; pu = cu;
                }
            }
        }
    }
};

template <class Epi>
__device__ __forceinline__ void gemm_phase(LAS unsigned char* lds, const Gemm g, const StaticOrder& S, const Epi& E) {
    int tid_ = threadIdx.x; LAUNDER_V(tid_);
    const int tid = tid_, wid = __builtin_amdgcn_readfirstlane(tid >> 6), lane = tid & 63, wr = wid >> 2, wc = wid & 3, fr = lane & 15, fq = lane >> 4;
    const int K = g.K, nt = K / BK;
    unsigned voffA[2], voffB[2];
#pragma unroll
    for (int i = 0; i < 2; ++i) { int R, C; stage_rc(tid * 16 + i * 8192, R, C); const int Rb = Epi::PERM ? ((R & ~31) + perm32(R & 31)) : R;
        voffA[i] = (unsigned)(R * g.lda + C) * 2u; voffB[i] = (unsigned)(Rb * K + C) * 2u; }
    const size_t kstep = (size_t)(BK * 2);
    const size_t hstepA = (size_t)HALF * g.lda * 2, hstepB = (size_t)HALF * K * 2;
    const size_t tstepA = 2 * hstepA, tstepB = 2 * hstepB;
    const unsigned ldsw = (unsigned)wid * 1024u;
    const int aoff = lds_byte(wr * 64 + fr, fq * 8), boff = lds_byte(wc * 32 + fr, fq * 8);
#define PG8_SA(b, h) (((b) * 2 + (h)) * HTB)
#define PG8_SB(b, h) ((4 + (b) * 2 + (h)) * HTB)
#define PG8_STAGE(bufoff, gbase, voff) do { _Pragma("unroll") for (int _i = 0; _i < 2; ++_i) \
        __builtin_amdgcn_global_load_lds((const unsigned*)((const char*)(gbase) + (voff)[_i]), (LAS unsigned*)(lds + (bufoff) + ldsw + _i * 8192), 16, 0, 0); } while (0)
#define PG8_LDA(dst, b, h) do { _Pragma("unroll") for (int m = 0; m < 4; ++m) _Pragma("unroll") for (int k = 0; k < 2; ++k) dst[m][k] = *(const LAS bf16x8*)(lds + PG8_SA(b, h) + aoff + m * 2048 + k * 1024); } while (0)
#define PG8_LDB(dst, b, h) do { _Pragma("unroll") for (int n = 0; n < 2; ++n) _Pragma("unroll") for (int k = 0; k < 2; ++k) dst[n][k] = *(const LAS bf16x8*)(lds + PG8_SB(b, h) + boff + n * 2048 + k * 1024); } while (0)
#define PG8_MMA(ai, bj, At, Bt) do { __builtin_amdgcn_s_setprio(1); _Pragma("unroll") for (int m = 0; m < 4; ++m) _Pragma("unroll") for (int n = 0; n < 2; ++n) _Pragma("unroll") for (int k = 0; k < 2; ++k) \
        acc[ai][bj][m][n] = __builtin_amdgcn_mfma_f32_16x16x32_bf16(Bt[n][k], At[m][k], acc[ai][bj][m][n], 0, 0, 0); __builtin_amdgcn_s_setprio(0); } while (0)
#define PG8_WAIT_V(n) asm volatile("s_waitcnt vmcnt(" #n ")" ::: "memory")
#define PG8_WAIT_L(n) asm volatile("s_waitcnt lgkmcnt(" #n ")" ::: "memory")
#define PG8_BAR __builtin_amdgcn_s_barrier()
#define PG8_SCHED __builtin_amdgcn_sched_barrier(0)
    Unit cur, nxt; int ui = 0;
    if (!S.next(0, cur)) return;
    f32x4 acc[2][2][4][2];
#pragma unroll
    for (int a = 0; a < 2; ++a)
#pragma unroll
        for (int b = 0; b < 2; ++b)
#pragma unroll
            for (int m = 0; m < 4; ++m)
#pragma unroll
                for (int n = 0; n < 2; ++n) acc[a][b][m][n] = (f32x4){0.f, 0.f, 0.f, 0.f};
    bf16x8 At[4][2], B0[2][2], B1[2][2];
    const char* cA = (const char*)g.A + (size_t)cur.pm * tstepA; const char* cB = (const char*)g.Bt + (size_t)cur.pn * tstepB;
    PG8_STAGE(PG8_SB(0, 0), cB, voffB); PG8_STAGE(PG8_SB(0, 1), cB + hstepB, voffB); PG8_STAGE(PG8_SA(0, 0), cA, voffA); PG8_STAGE(PG8_SA(0, 1), cA + hstepA, voffA);
    if (wr == 1) PG8_BAR;
    PG8_WAIT_V(2); PG8_BAR;
    PG8_STAGE(PG8_SB(1, 0), cB + kstep, voffB); PG8_STAGE(PG8_SA(1, 0), cA + kstep, voffA); PG8_STAGE(PG8_SB(1, 1), cB + hstepB + kstep, voffB);
    PG8_WAIT_V(6); PG8_BAR;
    for (;;) {
        const bool has_next = S.next(ui + 1, nxt);
        const char* nA = has_next ? (const char*)g.A + (size_t)nxt.pm * tstepA : cA; const char* nB = has_next ? (const char*)g.Bt + (size_t)nxt.pn * tstepB : cB;
        for (int t = 0; t < nt; t += 2) {
            const bool last = (t == nt - 2);
            const char* a1 = cA + (size_t)(t + 1) * kstep;
            const char* a2 = last ? nA : cA + (size_t)(t + 2) * kstep; const char* b2 = last ? nB : cB + (size_t)(t + 2) * kstep;
            const char* a3 = a2 + kstep; const char* b3 = b2 + kstep;
            PG8_LDB(B0, 0, 0); PG8_LDB(B1, 0, 1); PG8_SCHED; PG8_LDA(At, 0, 0); PG8_STAGE(PG8_SA(1, 1), a1 + hstepA, voffA);
            PG8_WAIT_V(8); PG8_WAIT_L(0); PG8_BAR; PG8_MMA(0, 0, At, B0); PG8_MMA(0, 1, At, B1); PG8_BAR; PG8_SCHED;
            PG8_LDA(At, 0, 1); PG8_STAGE(PG8_SB(0, 0), b2, voffB); PG8_STAGE(PG8_SB(0, 1), b2 + hstepB, voffB); PG8_STAGE(PG8_SA(0, 0), a2, voffA);
            PG8_WAIT_V(8); PG8_WAIT_L(0); PG8_BAR; PG8_MMA(1, 0, At, B0); PG8_MMA(1, 1, At, B1); PG8_BAR; PG8_SCHED;
            PG8_LDB(B0, 1, 0); PG8_LDB(B1, 1, 1); PG8_SCHED; PG8_LDA(At, 1, 0); PG8_STAGE(PG8_SA(0, 1), a2 + hstepA, voffA);
            PG8_WAIT_V(8); PG8_WAIT_L(0); PG8_BAR; PG8_MMA(0, 0, At, B0); PG8_MMA(0, 1, At, B1); PG8_BAR; PG8_SCHED;
            PG8_LDA(At, 1, 1); PG8_STAGE(PG8_SB(1, 0), b3, voffB); PG8_STAGE(PG8_SB(1, 1), b3 + hstepB, voffB); PG8_STAGE(PG8_SA(1, 0), a3, voffA);
            PG8_WAIT_V(8); PG8_WAIT_L(0); PG8_BAR; PG8_MMA(1, 0, At, B0); PG8_MMA(1, 1, At, B1); PG8_BAR; PG8_SCHED;
        }
        if (wr == 0) PG8_BAR;
        { int frE = fr, fqE = fq; LAUNDER_V(frE); LAUNDER_V(fqE); E(acc, cur, wr, wc, frE, fqE); }
        if (!has_next) break;
#pragma unroll
        for (int a = 0; a < 2; ++a)
#pragma unroll
            for (int b = 0; b < 2; ++b)
#pragma unroll
                for (int m = 0; m < 4; ++m)
#pragma unroll
                    for (int n = 0; n < 2; ++n) acc[a][b][m][n] = (f32x4){0.f, 0.f, 0.f, 0.f};
        cur = nxt; cA = nA; cB = nB; ++ui;
        if (wr == 1) PG8_BAR;
    }
    PG8_WAIT_V(0);
    PG8_BAR;
#undef PG8_SA
#undef PG8_SB
#undef PG8_STAGE
#undef PG8_LDA
#undef PG8_LDB
#undef PG8_MMA
#undef PG8_WAIT_V
#undef PG8_WAIT_L
#undef PG8_BAR
#undef PG8_SCHED
}
}

constexpr int RING_BYTES = 131072;
constexpr int LDS_BYTES = 147456;

struct Args { const float* in[20]; float* out; unsigned char* ws; float inv_freq[32]; };

#define DS_READ4(r0, r1, r2, r3, addr, o0, o1, o2, o3) asm volatile("ds_read_b128 %0, %4 offset:%5\n\tds_read_b128 %1, %4 offset:%6\n\tds_read_b128 %2, %4 offset:%7\n\tds_read_b128 %3, %4 offset:%8" \
    : "=&v"(r0), "=&v"(r1), "=&v"(r2), "=&v"(r3) : "v"(addr), "i"(o0), "i"(o1), "i"(o2), "i"(o3) : "memory")
#define LGKM_WAIT4(n, r0, r1, r2, r3) asm volatile("s_waitcnt lgkmcnt(" #n ")" : "+v"(r0), "+v"(r1), "+v"(r2), "+v"(r3) :: "memory")
#define MFMA32(a, b, c) __builtin_amdgcn_mfma_f32_32x32x16_bf16((a), (b), (c), 0, 0, 0)
__device__ __forceinline__ int crow(int r, int hi) { return (r & 3) + 8 * (r >> 2) + 4 * hi; }

__device__ __forceinline__ void wt_item(const float* __restrict__ W, int K, int N, const float* __restrict__ gain, int gainK, bf16_t* WT, LAS float* scr, int item, int nblk, int lane, bool remap_up = false) {
    const int kb = item / nblk, nb = item % nblk, k0 = 64 * kb, n0 = 32 * nb;
    const int ns0 = remap_up ? (((n0 & 255) < 128) ? 128 * (n0 >> 8) + (n0 & 255) : DFF + 128 * (n0 >> 8) + (n0 & 255) - 128) : n0;
    const int n = ns0 + (lane & 31);
#pragma unroll 8
    for (int i = 0; i < 32; ++i) { const int kk = 2 * i + (lane >> 5); float w = (n < N) ? G_(W)[(size_t)(k0 + kk) * N + n] : 0.f; if ((k0 + kk) < gainK) w *= G_(gain)[k0 + kk]; scr[kk * 33 + (lane & 31)] = w; }
    asm volatile("s_waitcnt lgkmcnt(0)" ::: "memory");
    const int c = lane & 7;
#pragma unroll
    for (int j = 0; j < 4; ++j) { const int nn = (lane >> 3) + 8 * j; const LAS float* s = scr + (8 * c) * 33 + nn;
        u32x4 o; o.x = pk2(s[0 * 33], s[1 * 33]); o.y = pk2(s[2 * 33], s[3 * 33]); o.z = pk2(s[4 * 33], s[5 * 33]); o.w = pk2(s[6 * 33], s[7 * 33]);
        *(GAS u32x4*)(G_(WT) + (size_t)(n0 + nn) * K + k0 + 8 * c) = o; }
    asm volatile("s_waitcnt lgkmcnt(0)" ::: "memory");
}

constexpr int AT_KSTR = 400, AT_VSTR = 144;
constexpr int AT_KB = 64 * AT_KSTR  , AT_VB = 128 * AT_VSTR  , AT_K0 = 0, AT_V0 = 2 * AT_KB, AT_WSF = AT_V0 + 2 * AT_VB;
static_assert(AT_WSF + 8 * 128 <= RING_BYTES, "attn lds");

__device__ __forceinline__ void attn_unit(LAS unsigned char* L, const bf16_t* Q_, const bf16_t* Kg_, const bf16_t* Vt_, bf16_t* mix_, int h, int qb) {
    GAS const bf16_t* Q = G_(Q_); GAS const bf16_t* Kg = G_(Kg_); GAS const bf16_t* Vt = G_(Vt_); GAS bf16_t* mix = G_(mix_);
    int tid_ = threadIdx.x; LAUNDER_V(tid_);
    const int tid = tid_, lane = tid & 63, w = __builtin_amdgcn_readfirstlane(tid >> 6), r32 = lane & 31, hh = lane >> 5;
    const int q0 = qb * 256;
    bf16x8 qf[12];
    { GAS const bf16_t* qrow = Q + (size_t)(q0 + 32 * w + r32) * QW + h * QKD + 8 * hh;
#pragma unroll
      for (int ks = 0; ks < 12; ++ks) qf[ks] = *(GAS const bf16x8*)(qrow + 16 * ks); }
    f32x16 o[4];
#pragma unroll
    for (int d = 0; d < 4; ++d)
#pragma unroll
        for (int i = 0; i < 16; ++i) o[d][i] = 0.f;
    float l_run = 0.f;
    const int NT = 4 * qb + 4, my_last = 4 * qb + (w >> 1);
    volatile LAS float* wsf = (volatile LAS float*)(L + AT_WSF) + w * 32;
    const unsigned lds_base = (unsigned)(uintptr_t)L;
    u32x4 kst[3], vst[2];
    int krow_[3], kcc_[3], vrow_[2], vcc_[2];
#pragma unroll
    for (int i = 0; i < 3; ++i) { const int id = tid + 512 * i; krow_[i] = id / 24; kcc_[i] = id % 24; }
#pragma unroll
    for (int i = 0; i < 2; ++i) { const int id = tid + 512 * i; vrow_[i] = id >> 3; vcc_[i] = id & 7; }
#define AT_GLOAD(t) do { const int kv0_ = (t) * 64; \
    _Pragma("unroll") for (int i = 0; i < 3; ++i) kst[i] = *(GAS const u32x4*)(Kg + (size_t)(kv0_ + krow_[i]) * QW + h * QKD + kcc_[i] * 8); \
    _Pragma("unroll") for (int i = 0; i < 2; ++i) vst[i] = *(GAS const u32x4*)(Vt + (size_t)(h * VD + vrow_[i]) * SEQ + kv0_ + vcc_[i] * 8); } while (0)
#define AT_SSTORE(buf) do { \
    _Pragma("unroll") for (int i = 0; i < 3; ++i) *(LAS u32x4*)(L + AT_K0 + (buf) * AT_KB + krow_[i] * AT_KSTR + kcc_[i] * 16) = kst[i]; \
    _Pragma("unroll") for (int i = 0; i < 2; ++i) *(LAS u32x4*)(L + AT_V0 + (buf) * AT_VB + vrow_[i] * AT_VSTR + vcc_[i] * 16) = vst[i]; } while (0)
    AT_GLOAD(0); AT_SSTORE(0); __syncthreads();
    for (int t = 0; t < NT; ++t) {
        const int buf = t & 1;
        if (t + 1 < NT) AT_GLOAD(t + 1);
        if (t <= my_last) {
            const unsigned kaddr = lds_base + AT_K0 + buf * AT_KB + r32 * AT_KSTR + hh * 16;
            const unsigned vaddr = lds_base + AT_V0 + buf * AT_VB + r32 * AT_VSTR + hh * 16;
            f32x16 p0, p1;
#pragma unroll
            for (int i = 0; i < 16; ++i) { p0[i] = 0.f; p1[i] = 0.f; }
            bf16x8 fa0, fa1, fa2, fa3, fb0, fb1, fb2, fb3;
#define QK_RD(s0, s1, s2, s3, g) DS_READ4(s0, s1, s2, s3, kaddr, (2 * (g)) * 32, (2 * (g)) * 32 + 32 * AT_KSTR, (2 * (g) + 1) * 32, (2 * (g) + 1) * 32 + 32 * AT_KSTR)
#define QK_MM(s0, s1, s2, s3, g) do { p0 = MFMA32(s0, qf[2 * (g)], p0); p1 = MFMA32(s1, qf[2 * (g)], p1); p0 = MFMA32(s2, qf[2 * (g) + 1], p0); p1 = MFMA32(s3, qf[2 * (g) + 1], p1); } while (0)
            QK_RD(fa0, fa1, fa2, fa3, 0);
            QK_RD(fb0, fb1, fb2, fb3, 1); LGKM_WAIT4(4, fa0, fa1, fa2, fa3); QK_MM(fa0, fa1, fa2, fa3, 0);
            QK_RD(fa0, fa1, fa2, fa3, 2); LGKM_WAIT4(4, fb0, fb1, fb2, fb3); QK_MM(fb0, fb1, fb2, fb3, 1);
            QK_RD(fb0, fb1, fb2, fb3, 3); LGKM_WAIT4(4, fa0, fa1, fa2, fa3); QK_MM(fa0, fa1, fa2, fa3, 2);
            QK_RD(fa0, fa1, fa2, fa3, 4); LGKM_WAIT4(4, fb0, fb1, fb2, fb3); QK_MM(fb0, fb1, fb2, fb3, 3);
            QK_RD(fb0, fb1, fb2, fb3, 5); LGKM_WAIT4(4, fa0, fa1, fa2, fa3); QK_MM(fa0, fa1, fa2, fa3, 4);
#define PV_RD(s0, s1, s2, s3, kb, ss) DS_READ4(s0, s1, s2, s3, vaddr, (kb) * 64 + (ss) * 32, 32 * AT_VSTR + (kb) * 64 + (ss) * 32, 64 * AT_VSTR + (kb) * 64 + (ss) * 32, 96 * AT_VSTR + (kb) * 64 + (ss) * 32)
            PV_RD(fa0, fa1, fa2, fa3, 0, 0); LGKM_WAIT4(4, fb0, fb1, fb2, fb3); QK_MM(fb0, fb1, fb2, fb3, 5);
            float ls = 0.f;
#pragma unroll
            for (int i = 0; i < 16; ++i) { p0[i] = __builtin_amdgcn_exp2f(fminf(p0[i], 100.f)); p1[i] = __builtin_amdgcn_exp2f(fminf(p1[i], 100.f)); ls += p0[i] + p1[i]; }
            l_run += ls;
#define PV_PK(P, ss) __builtin_bit_cast(bf16x8, (u32x4){pk2(P[8 * (ss) + 0], P[8 * (ss) + 1]), pk2(P[8 * (ss) + 2], P[8 * (ss) + 3]), pk2(P[8 * (ss) + 4], P[8 * (ss) + 5]), pk2(P[8 * (ss) + 6], P[8 * (ss) + 7])})
#define PV_MM(s0, s1, s2, s3, xs) do { o[0] = MFMA32(xs, s0, o[0]); o[1] = MFMA32(xs, s1, o[1]); o[2] = MFMA32(xs, s2, o[2]); o[3] = MFMA32(xs, s3, o[3]); } while (0)
            { const bf16x8 x00 = PV_PK(p0, 0), x01 = PV_PK(p0, 1), x10 = PV_PK(p1, 0), x11 = PV_PK(p1, 1);
              PV_RD(fb0, fb1, fb2, fb3, 0, 1); LGKM_WAIT4(4, fa0, fa1, fa2, fa3); PV_MM(fa0, fa1, fa2, fa3, x00);
              PV_RD(fa0, fa1, fa2, fa3, 1, 0); LGKM_WAIT4(4, fb0, fb1, fb2, fb3); PV_MM(fb0, fb1, fb2, fb3, x01);
              PV_RD(fb0, fb1, fb2, fb3, 1, 1); LGKM_WAIT4(4, fa0, fa1, fa2, fa3); PV_MM(fa0, fa1, fa2, fa3, x10);
              LGKM_WAIT4(0, fb0, fb1, fb2, fb3); PV_MM(fb0, fb1, fb2, fb3, x11); }
#undef QK_RD
#undef QK_MM
#undef PV_RD
#undef PV_PK
#undef PV_MM
        }
        if (t + 1 < NT) AT_SSTORE(buf ^ 1);
        __syncthreads();
    }
#undef AT_GLOAD
#undef AT_SSTORE
    const float lt = l_run + __shfl_xor(l_run, 32);
    wsf[r32] = 1.0f / lt;
    asm volatile("s_waitcnt lgkmcnt(0)" ::: "memory");
    GAS bf16_t* orow = mix + (size_t)(q0 + 32 * w) * DM + h * VD + r32;
#pragma unroll
    for (int i = 0; i < 16; ++i) { const int qr = crow(i, hh); const float a = wsf[qr];
#pragma unroll
        for (int d = 0; d < 4; ++d) orow[(size_t)qr * DM + 32 * d] = (bf16_t)f2bf(o[d][i] * a); }
    __syncthreads();
}

constexpr int GL_V = 0  , GL_KD = 32768  , GL_TOT = GL_KD + 18432  , GL_ZA = GL_TOT + 2048  ;
__device__ __forceinline__ void gla_chunk_unit(LAS unsigned char* L, const bf16_t* Z_, const float* wgate_, const float* bgate_, float* ST_, float* DEC_, int c, int h) {
    GAS const bf16_t* Z = G_(Z_); GAS const float* wgate = G_(wgate_); GAS const float* bgate = G_(bgate_); GAS float* ST = G_(ST_); GAS float* DEC = G_(DEC_);
    int tid_ = threadIdx.x; LAUNDER_V(tid_);
    const int tid = tid_, lane = tid & 63, w = __builtin_amdgcn_readfirstlane(tid >> 6), r32 = lane & 31, hh = lane >> 5;
    const size_t row0 = (size_t)c * 64;
#pragma unroll
    for (int i = 0; i < 4; ++i) { const int id = tid + 512 * i, r = id >> 5, cc = id & 31;
        *(LAS u32x4*)(L + GL_V + r * 512 + cc * 16) = *(GAS const u32x4*)(Z + (row0 + r) * IN_PAD + C_GV + h * GDV + cc * 8); }
#pragma unroll
    for (int i = 0; i < 2; ++i) { const int id = tid + 512 * i, r = id >> 4, cc = id & 15;
        ((LAS float*)(L + GL_ZA))[id] = bf2f(Z[(row0 + r) * IN_PAD + C_GA + cc]); }
    __syncthreads();
    const int tq = tid >> 7, col = tid & 127;
    float wg[16];
#pragma unroll
    for (int r = 0; r < 16; ++r) wg[r] = wgate[r * (GH * GDK) + h * GDK + col];
    const float bg = bgate[h * GDK + col];
    float pre[16]; float run = 0.f;
#pragma unroll
    for (int i = 0; i < 16; ++i) {
        const LAS float* za = (const LAS float*)(L + GL_ZA) + (16 * tq + i) * 16;
        float ga = bg;
#pragma unroll
        for (int r = 0; r < 16; ++r) ga += za[r] * wg[r];
        const float ls = fminf(ga, 0.f) - __logf(1.0f + __expf(-fabsf(ga)));
        run += ls * (1.0f / 16.0f); pre[i] = run;
    }
    ((LAS float*)(L + GL_TOT))[tq * 128 + col] = run;
    __syncthreads();
    float off = 0.f, bend = 0.f;
#pragma unroll
    for (int t = 0; t < 4; ++t) { const float v = ((LAS float*)(L + GL_TOT))[t * 128 + col]; bend += v; if (t < tq) off += v; }
    {
        unsigned pkv[8];
#pragma unroll
        for (int i = 0; i < 16; i += 2) {
            const float k0 = bf2f(Z[(row0 + 16 * tq + i) * IN_PAD + C_GK + h * GDK + col]), k1 = bf2f(Z[(row0 + 16 * tq + i + 1) * IN_PAD + C_GK + h * GDK + col]);
            pkv[i >> 1] = pk2(k0 * __expf(bend - off - pre[i]), k1 * __expf(bend - off - pre[i + 1]));
        }
        LAS u32x4* dst = (LAS u32x4*)(L + GL_KD + col * 144 + tq * 32);
        dst[0] = (u32x4){pkv[0], pkv[1], pkv[2], pkv[3]}; dst[1] = (u32x4){pkv[4], pkv[5], pkv[6], pkv[7]};
    }
    if (tq == 0) DEC[(size_t)(c * GH + h) * GDK + col] = __expf(bend);
    __syncthreads();
    f32x16 acc[4];
#pragma unroll
    for (int d = 0; d < 4; ++d)
#pragma unroll
        for (int i = 0; i < 16; ++i) acc[d][i] = 0.f;
#pragma unroll
    for (int ks = 0; ks < 4; ++ks) {
        bf16x8 a;
#pragma unroll
        for (int j = 0; j < 8; ++j) a[j] = (short)*(const LAS unsigned short*)(L + GL_V + (16 * ks + 8 * hh + j) * 512 + (32 * w + r32) * 2);
#pragma unroll
        for (int db = 0; db < 4; ++db) {
            const bf16x8 b = *(const LAS bf16x8*)(L + GL_KD + (32 * db + r32) * 144 + (16 * ks + 8 * hh) * 2);
            acc[db] = MFMA32(a, b, acc[db]);
        }
    }
    GAS float* stp = ST + ((size_t)(c * GH + h) * GDV + 32 * w) * GDK + r32;
#pragma unroll
    for (int db = 0; db < 4; ++db)
#pragma unroll
        for (int i = 0; i < 16; ++i) stp[(size_t)crow(i, hh) * GDK + 32 * db] = acc[db][i];
    __syncthreads();
}

constexpr int GO_STR = 260;
__device__ __forceinline__ void gla_out_unit(LAS unsigned char* L, const bf16_t* Z_, const float* ST_, const float* gnorm_, bf16_t* mix_, int c, int h) {
    GAS const bf16_t* Z = G_(Z_); GAS const float* ST = G_(ST_); GAS const float* gnorm = G_(gnorm_); GAS bf16_t* mix = G_(mix_);
    int tid_ = threadIdx.x; LAUNDER_V(tid_);
    const int tid = tid_, lane = tid & 63, w = __builtin_amdgcn_readfirstlane(tid >> 6), r32 = lane & 31, hh = lane >> 5;
    const size_t row0 = (size_t)c * 64;
    f32x16 acc[2];
#pragma unroll
    for (int d = 0; d < 2; ++d)
#pragma unroll
        for (int i = 0; i < 16; ++i) acc[d][i] = 0.f;
    GAS const float* sp = ST + ((size_t)(c * GH + h) * GDV + 32 * w + r32) * GDK + 8 * hh;
#pragma unroll
    for (int ks = 0; ks < 8; ++ks) {
        const f32x4 s0 = *(GAS const f32x4*)(sp + 16 * ks), s1 = *(GAS const f32x4*)(sp + 16 * ks + 4);
        u32x4 bw; bw.x = pk2(s0[0], s0[1]); bw.y = pk2(s0[2], s0[3]); bw.z = pk2(s1[0], s1[1]); bw.w = pk2(s1[2], s1[3]);
        const bf16x8 b = __builtin_bit_cast(bf16x8, bw);
#pragma unroll
        for (int tb = 0; tb < 2; ++tb) {
            const bf16x8 a = *(GAS const bf16x8*)(Z + (row0 + 32 * tb + r32) * IN_PAD + C_GQ + h * GDK + 16 * ks + 8 * hh);
            acc[tb] = MFMA32(a, b, acc[tb]);
        }
    }
    LAS float* of = (LAS float*)L;
#pragma unroll
    for (int tb = 0; tb < 2; ++tb)
#pragma unroll
        for (int i = 0; i < 16; ++i) of[(32 * tb + crow(i, hh)) * GO_STR + 32 * w + r32] = acc[tb][i] * 0.08838834764831845f;
    __syncthreads();
    const int tok = tid >> 3, part = tid & 7;
    float v[32]; float ss = 0.f;
#pragma unroll
    for (int i = 0; i < 32; ++i) { v[i] = of[tok * GO_STR + i * 8 + part]; ss += v[i] * v[i]; }
    ss += __shfl_xor(ss, 1); ss += __shfl_xor(ss, 2); ss += __shfl_xor(ss, 4);
    const float rstd = rsqrtf(ss * (1.0f / GDV) + EPS);
    GAS const bf16_t* zg = Z + (row0 + tok) * IN_PAD + C_GG + h * GDV;
    GAS bf16_t* op = mix + (row0 + tok) * DM + 1024 + h * GDV;
#pragma unroll
    for (int i = 0; i < 32; ++i) { const int dv = i * 8 + part; const float g = bf2f(zg[dv]); op[dv] = (bf16_t)f2bf(v[i] * rstd * gnorm[dv] * silu_f(g)); }
    __syncthreads();
}


#define XB_TMO      128
#define XB_XCNT(j)  (256  + 64 * (j))
#define XB_XSUB(j)  (1280 + 64 * (j))
#define XB_XGEN(j)  (2304 + 64 * (j))
#define XB_TOP      3328
#define XB_TOPGEN   3392
#define XCD_BAR_WORDS 3456
#define XB_SPIN_CAP (1u << 22)
__device__ __forceinline__ unsigned xb_ld(unsigned* p)              { return __hip_atomic_load(p, __ATOMIC_RELAXED, __HIP_MEMORY_SCOPE_AGENT); }
__device__ __forceinline__ unsigned xb_add(unsigned* p, unsigned v) { return __hip_atomic_fetch_add(p, v, __ATOMIC_RELAXED, __HIP_MEMORY_SCOPE_AGENT); }
__device__ __forceinline__ unsigned xb_xcc_id() { return (unsigned)__builtin_amdgcn_s_getreg((3 << 11) | 20) & 0xFu; }
#define XB_SPIN(cond, bar) do { unsigned _sp = 0; while (cond) { __builtin_amdgcn_s_sleep(1); \
    if ((++_sp & 255u) == 0u) { if (xb_ld(&(bar)[XB_TMO])) break; if (_sp > XB_SPIN_CAP) { atomicAdd(&(bar)[XB_TMO], 1u); break; } } } } while (0)
struct XcdBarrier { unsigned* bar; unsigned x; volatile LAS unsigned* st; };
__device__ __forceinline__ XcdBarrier xcd_barrier_post(unsigned* bar, volatile LAS unsigned* st) {
    XcdBarrier b; b.bar = bar; b.x = xb_xcc_id(); b.st = st;
    if (threadIdx.x == 0) (void)xb_add(&bar[XB_XCNT(b.x)], 1u);
    return b;
}
__device__ __forceinline__ void xcd_barrier_complete(unsigned* bar, unsigned x, unsigned& nloc, unsigned& nx) {
    const unsigned G = gridDim.x * gridDim.y * gridDim.z;
    unsigned sum, cnt, mine, sp = 0u;
    for (;;) {
        sum = 0u; cnt = 0u; mine = 0u;
#pragma unroll
        for (unsigned j = 0; j < 16; ++j) { const unsigned c = xb_ld(&bar[XB_XCNT(j)]); sum += c; cnt += (c > 0u) ? 1u : 0u; mine = (j == x) ? c : mine; }
        if (sum == G) break;
        __builtin_amdgcn_s_sleep(1);
        if ((++sp & 255u) == 0u) { if (xb_ld(&bar[XB_TMO])) break; if (sp > XB_SPIN_CAP) { atomicAdd(&bar[XB_TMO], 1u); break; } }
    }
    nloc = mine > 0u ? mine : 1u; nx = cnt > 0u ? cnt : 1u;
}
__device__ __forceinline__ void xcd_barrier(const XcdBarrier& b) {
    asm volatile("s_waitcnt vmcnt(0)" ::: "memory");
    __syncthreads();
    if (threadIdx.x == 0) {
        unsigned* bar = b.bar;
        __builtin_amdgcn_s_waitcnt(0);
        unsigned nloc = b.st[0], nx = b.st[1];
        if (nloc == 0u) { xcd_barrier_complete(bar, b.x, nloc, nx); b.st[0] = nloc; b.st[1] = nx; }
        const unsigned old = xb_add(&bar[XB_XSUB(b.x)], 1u);
        const unsigned gen = old / nloc;
        if (old + 1u == (gen + 1u) * nloc) {
            __builtin_amdgcn_fence(__ATOMIC_RELEASE, "agent");
            asm volatile("s_waitcnt vmcnt(0)" ::: "memory");
            const unsigned og = xb_add(&bar[XB_TOP], 1u);
            const unsigned tg = og / nx;
            if (og + 1u == (tg + 1u) * nx) xb_add(&bar[XB_TOPGEN], 1u);
            else XB_SPIN(xb_ld(&bar[XB_TOPGEN]) == tg, bar);
            __builtin_amdgcn_fence(__ATOMIC_ACQUIRE, "agent");
            xb_add(&bar[XB_XGEN(b.x)], 1u);
            asm volatile("s_waitcnt vmcnt(0)" ::: "memory");
        } else {
            XB_SPIN(xb_ld(&bar[XB_XGEN(b.x)]) == gen, bar);
            __builtin_amdgcn_fence(__ATOMIC_ACQUIRE, "agent");
            asm volatile("s_waitcnt vmcnt(0)" ::: "memory");
        }
    }
    __syncthreads();
}

__global__ void __launch_bounds__(512, 2) mk_fwd(Args a) {
    extern __shared__ __attribute__((aligned(16))) unsigned char lds[];
    cg::grid_group grid = cg::this_grid();
    LAS unsigned char* L = (LAS unsigned char*)lds;
    const int G = gridDim.x, bid = blockIdx.x, NGW = G * 8;
    volatile LAS unsigned* MISC = (volatile LAS unsigned*)(L + RING_BYTES + 8192);
    if (threadIdx.x < 4) MISC[threadIdx.x] = 0u;
    __syncthreads();
    (void)xcd_barrier_post((unsigned*)(a.ws + WS_BAR), MISC);
#define XSYNC() do { XcdBarrier xb_; xb_.bar = (unsigned*)(a.ws + WS_BAR); xb_.x = xb_xcc_id(); xb_.st = (volatile LAS unsigned*)(L + RING_BYTES + 8192); xcd_barrier(xb_); } while (0)
#define GRID_SYNC() do { asm volatile("s_waitcnt vmcnt(0) lgkmcnt(0)" ::: "memory"); __syncthreads(); grid.sync(); \
    __builtin_amdgcn_fence(__ATOMIC_ACQUIRE, "agent"); asm volatile("s_waitcnt vmcnt(0)" ::: "memory"); __syncthreads(); } while (0)
#ifndef DBG_STOP
#define DBG_STOP 0
#endif
#define DBG_DUMP(k, EXPR) do { if (DBG_STOP == (k)) { PHASE_BEGIN(); for (int m = gw; m < SEQ; m += NGW) for (int c = lane; c < DM; c += 64) out[(size_t)m * DM + c] = (EXPR); return; } } while (0)
#define PHASE_BEGIN() unsigned char* ws = a.ws; LAUNDER_S(ws); int tid_ = threadIdx.x; LAUNDER_V(tid_); const int tid = tid_, lane = tid & 63, wave = __builtin_amdgcn_readfirstlane(tid >> 6), gw = bid * 8 + wave; \
    u64* ssq = (u64*)(ws + WS_SSQ); (void)lane; (void)gw; (void)ssq; \
    u64* ssq_x = ssq + (size_t)l * SEQ; u64* ssq_xn = ssq + (size_t)(l + 1) * SEQ; u64* ssq_cq = ssq + (size_t)(3 + l) * SEQ; u64* ssq_ckv = ssq + (size_t)(5 + l) * SEQ; u64* ssq_x1 = ssq + (size_t)(7 + l) * SEQ; \
    (void)ssq_x; (void)ssq_xn; (void)ssq_cq; (void)ssq_ckv; (void)ssq_x1; \
    bf16_t* Win = (bf16_t*)(ws + WS_WIN); bf16_t* Wuq = (bf16_t*)(ws + WS_WUQ); bf16_t* Wukv = (bf16_t*)(ws + WS_WUKV); \
    bf16_t* Wout = (bf16_t*)(ws + WS_WOUT); bf16_t* Wup = (bf16_t*)(ws + WS_WUP); bf16_t* Wdn = (bf16_t*)(ws + WS_WDN); \
    bf16_t* XB = (bf16_t*)(ws + WS_XB); bf16_t* Z = (bf16_t*)(ws + WS_Z); bf16_t* Qb = (bf16_t*)(ws + WS_Q); bf16_t* Kb = (bf16_t*)(ws + WS_K); bf16_t* Vt = (bf16_t*)(ws + WS_VT); \
    float* ST = (float*)(ws + WS_ST); float* DEC = (float*)(ws + WS_DEC); bf16_t* MIX = (bf16_t*)(ws + WS_MIX); \
    bf16_t* ACT = (bf16_t*)(ws + WS_ACT); float* EDGE = (float*)(ws + WS_EDGE); \
    const float* xin = a.in[0]; float* out = a.out; \
    (void)Win; (void)Wuq; (void)Wukv; (void)Wout; (void)Wup; (void)Wdn; (void)XB; (void)Z; (void)Qb; (void)Kb; (void)Vt; (void)ST; (void)DEC; (void)MIX; (void)EDGE; (void)ACT; (void)xin; (void)out;

    for (int l = 0; l < NLAYER; ++l) {
        {
            PHASE_BEGIN();
            LAS float* scr = (LAS float*)(L + wave * 16384);
            const float* w_in = a.in[3] + (size_t)l * DM * IN_DIM; const float* w_uq = a.in[5] + (size_t)l * QLORA * QW; const float* w_ukv = a.in[7] + (size_t)l * KVLORA * KVW;
            const float* w_out = a.in[14] + (size_t)l * DM * DM; const float* w_up = a.in[16] + (size_t)l * DM * DFF2; const float* w_dn = a.in[19] + (size_t)l * DFF * DM;
            const float* g_attn = a.in[2] + l * DM; const float* g_cq = a.in[4] + l * QLORA; const float* g_ckv = a.in[6] + l * KVLORA; const float* g_mla = a.in[13] + l * 1024; const float* g_ffn = a.in[15] + l * DM;
            constexpr int I_IN = (DM / 64) * (IN_PAD / 32), I_UQ = (QLORA / 64) * (QW / 32), I_UKV = (KVLORA / 64) * (KVW / 32), I_OUT = (DM / 64) * (DM / 32), I_UP = (DM / 64) * (DFF2 / 32), I_DN = (DFF / 64) * (DM / 32);
            constexpr int NITEMS = I_IN + I_UQ + I_UKV + I_OUT + I_UP + I_DN;
            for (int it = gw; it < NITEMS; it += NGW) {
                int r = it;
                if (r < I_IN) { wt_item(w_in, DM, IN_DIM, g_attn, DM, Win, scr, r, IN_PAD / 32, lane); continue; } r -= I_IN;
                if (r < I_UQ) { wt_item(w_uq, QLORA, QW, g_cq, QLORA, Wuq, scr, r, QW / 32, lane); continue; } r -= I_UQ;
                if (r < I_UKV) { wt_item(w_ukv, KVLORA, KVW, g_ckv, KVLORA, Wukv, scr, r, KVW / 32, lane); continue; } r -= I_UKV;
                if (r < I_OUT) { wt_item(w_out, DM, DM, g_mla, 1024, Wout, scr, r, DM / 32, lane); continue; } r -= I_OUT;
                if (r < I_UP) { wt_item(w_up, DM, DFF2, g_ffn, DM, Wup, scr, r, DFF2 / 32, lane, true); continue; } r -= I_UP;
                wt_item(w_dn, DFF, DM, g_ffn, 0, Wdn, scr, r, DM / 32, lane);
            }
            if (l == 0) {
                for (int m = gw; m < SEQ; m += NGW) {
                    GAS const f32x4* xr = (GAS const f32x4*)(G_(xin) + (size_t)m * DM) + lane; float s = 0.f;
                    GAS u32x2* o8 = (GAS u32x2*)(G_(XB) + (size_t)m * DM) + lane;
#pragma unroll
                    for (int j = 0; j < 8; ++j) { const f32x4 v = xr[64 * j]; s += (v[0] * v[0] + v[1] * v[1]) + (v[2] * v[2] + v[3] * v[3]); o8[64 * j] = (u32x2){pk2(v[0], v[1]), pk2(v[2], v[3])}; }
                    s = wave_sum(s); if (lane == 0) G_(ssq_x)[m] = (u64)(s * SSQ_FX + 0.5f);
                }
            }
        }
        if (l == 0) GRID_SYNC(); else XSYNC();
        {
            PHASE_BEGIN();
            pg8::Gemm g{XB, Win, SEQ, IN_PAD, DM, DM}; pg8::StaticOrder S; S.init(SEQ, IN_PAD, G, bid);
            pg8::EpiRowScale E{Z, IN_PAD, ssq_x, 1.0f / DM, ssq_cq, 0, 2, ssq_ckv, 2, 3};
            pg8::gemm_phase<pg8::EpiRowScale>(L, g, S, E);
        }
        XSYNC();
        DBG_DUMP(1, bf2f(Z[(size_t)m * IN_PAD + c]) + bf2f(Z[(size_t)m * IN_PAD + 2048 + c]));
        {
            PHASE_BEGIN();
            { pg8::Gemm g{Z + C_CQ, Wuq, SEQ, QW, QLORA, IN_PAD}; pg8::StaticOrder S; S.init(SEQ, QW, G, bid);
              pg8::EpiRowScale E{Qb, QW, ssq_cq, 1.0f / QLORA, nullptr, 0, 0, nullptr, 0, 0};
              pg8::gemm_phase<pg8::EpiRowScale>(L, g, S, E); }
            { pg8::Gemm g{Z + C_CKV, Wukv, SEQ, KVW, KVLORA, IN_PAD}; pg8::StaticOrder S; S.init(SEQ, KVW, G, bid);
              pg8::EpiUkv E{Kb, Vt, ssq_ckv, 1.0f / KVLORA};
              pg8::gemm_phase<pg8::EpiUkv>(L, g, S, E); }
            const float* wgate = a.in[10] + (size_t)l * 16 * (GH * GDK); const float* bgate = a.in[11] + (size_t)l * (GH * GDK);
            for (int u = bid; u < NCHUNK * GH; u += G) gla_chunk_unit(L, Z, wgate, bgate, ST, DEC, u >> 2, u & 3);
        }
        XSYNC();
        DBG_DUMP(2, (c < QW ? bf2f(Qb[(size_t)m * QW + c]) + bf2f(Kb[(size_t)m * QW + c]) : bf2f(Vt[(size_t)(c - QW) * SEQ + m])) + ST[(size_t)m * 8192 + c] + ST[(size_t)m * 8192 + 4096 + c]);
        {
            PHASE_BEGIN();
            const int* pos = (const int*)a.in[1];
            const float* qn = a.in[8] + l * QKD; const float* kn = a.in[9] + l * QKD;
            const float qscale = 0.07216878364870322f * 1.4426950408889634f;
            for (int m = gw; m < SEQ; m += NGW) {
                const int i = lane & 31;
                const float ang = (float)G_(pos)[m] * a.inv_freq[i];
                double rev = (double)ang * 0.15915494309189535; rev -= __builtin_rint(rev);
                const float sn = __builtin_amdgcn_sinf((float)rev), cs = __builtin_amdgcn_cosf((float)rev);
                const float krv = bf2f(G_(Z)[(size_t)m * IN_PAD + C_KR + lane]);
                GAS bf16_t* qp = G_(Qb) + (size_t)m * QW; GAS bf16_t* kp = G_(Kb) + (size_t)m * QW;
                float qa[NH][3], ka[NH][2], qs[NH], ks[NH];
#pragma unroll
                for (int h = 0; h < NH; ++h) { qa[h][0] = bf2f(qp[h * QKD + lane]); qa[h][1] = bf2f(qp[h * QKD + 64 + lane]); qa[h][2] = bf2f(qp[h * QKD + 128 + lane]);
                                               ka[h][0] = bf2f(kp[h * QKD + lane]); ka[h][1] = bf2f(kp[h * QKD + 64 + lane]); }
#pragma unroll
                for (int h = 0; h < NH; ++h) { qs[h] = qa[h][0] * qa[h][0] + qa[h][1] * qa[h][1] + qa[h][2] * qa[h][2]; ks[h] = ka[h][0] * ka[h][0] + ka[h][1] * ka[h][1] + krv * krv; }
#pragma unroll
                for (int o = 1; o < 64; o <<= 1)
#pragma unroll
                    for (int h = 0; h < NH; ++h) { qs[h] += __shfl_xor(qs[h], o); ks[h] += __shfl_xor(ks[h], o); }
                const float qg0 = G_(qn)[lane], qg1 = G_(qn)[64 + lane], qg2 = G_(qn)[128 + lane], kg0 = G_(kn)[lane], kg1 = G_(kn)[64 + lane], kg2 = G_(kn)[128 + lane];
#pragma unroll
                for (int h = 0; h < NH; ++h) {
                    { const float rstd = rsqrtf(qs[h] * (1.0f / QKD) + EPS);
                      const float n2 = qa[h][2] * rstd * qg2, pr = __shfl_xor(n2, 32);
                      const float r2 = (lane < 32) ? n2 * cs - pr * sn : n2 * cs + pr * sn;
                      qp[h * QKD + lane] = (bf16_t)f2bf(qa[h][0] * rstd * qg0 * qscale); qp[h * QKD + 64 + lane] = (bf16_t)f2bf(qa[h][1] * rstd * qg1 * qscale); qp[h * QKD + 128 + lane] = (bf16_t)f2bf(r2 * qscale); }
                    { const float rstd = rsqrtf(ks[h] * (1.0f / QKD) + EPS);
                      const float n2 = krv * rstd * kg2, pr = __shfl_xor(n2, 32);
                      const float r2 = (lane < 32) ? n2 * cs - pr * sn : n2 * cs + pr * sn;
                      kp[h * QKD + lane] = (bf16_t)f2bf(ka[h][0] * rstd * kg0); kp[h * QKD + 64 + lane] = (bf16_t)f2bf(ka[h][1] * rstd * kg1); kp[h * QKD + 128 + lane] = (bf16_t)f2bf(r2); }
                }
            }
            constexpr int NE = GH * GDV * GDK;
            for (int e = bid * 512 + tid; e < NE; e += G * 512) {
                const int hd = (e >> 15) * GDK + (e & 127);
                float s = 0.f;
                for (int c0 = 0; c0 < NCHUNK; c0 += 8) {
                    float uu[8], dd[8];
#pragma unroll
                    for (int i = 0; i < 8; ++i) { uu[i] = G_(ST)[(size_t)(c0 + i) * NE + e]; dd[i] = G_(DEC)[(size_t)(c0 + i) * (GH * GDK) + hd]; }
#pragma unroll
                    for (int i = 0; i < 8; ++i) { s = s * dd[i] + uu[i]; G_(ST)[(size_t)(c0 + i) * NE + e] = s; }
                }
            }
        }
        XSYNC();
        DBG_DUMP(3, (c < QW ? bf2f(Qb[(size_t)m * QW + c]) + bf2f(Kb[(size_t)m * QW + c]) : 0.f) + ST[(size_t)m * 8192 + c] + ST[(size_t)m * 8192 + 4096 + c]);
        {
            PHASE_BEGIN();
            for (int p = bid; p < 256; p += G) {
                const int h = p & 7, s = p >> 3;
                attn_unit(L, Qb, Kb, Vt, MIX, h, 63 - s);
                attn_unit(L, Qb, Kb, Vt, MIX, h, s);
            }
            const float* gnorm = a.in[12] + l * GDV;
            for (int u = bid; u < NCHUNK * GH; u += G) gla_out_unit(L, Z, ST, gnorm, MIX, u >> 2, u & 3);
        }
        XSYNC();
        DBG_DUMP(4, bf2f(MIX[(size_t)m * DM + c]));
        { PHASE_BEGIN();
        for (int m = gw; m < SEQ; m += NGW) {
            GAS u32x4* p = (GAS u32x4*)(G_(MIX) + (size_t)m * DM) + lane;
            u32x4 v0 = p[0], v1 = p[64]; float s = 0.f;
#pragma unroll
            for (int j = 0; j < 4; ++j) { const float a0 = bflo(v0[j]), a1 = bfhi(v0[j]), b0 = bflo(v1[j]), b1 = bfhi(v1[j]); s += a0 * a0 + a1 * a1 + b0 * b0 + b1 * b1; }
            const float rstd = rsqrtf(wave_sum(s) * (1.0f / 1024.0f) + EPS);
#pragma unroll
            for (int j = 0; j < 4; ++j) { v0[j] = pk2(bflo(v0[j]) * rstd, bfhi(v0[j]) * rstd); v1[j] = pk2(bflo(v1[j]) * rstd, bfhi(v1[j]) * rstd); }
            p[0] = v0; p[64] = v1;
        } }
        XSYNC();
        DBG_DUMP(5, bf2f(MIX[(size_t)m * DM + c]));
        {
            PHASE_BEGIN();
            pg8::Gemm g{MIX, Wout, SEQ, DM, DM, DM}; pg8::StaticOrder S; S.init(SEQ, DM, G, bid);
            pg8::EpiRes E{l == 0 ? xin : out, out, XB, ssq_x1};
            pg8::gemm_phase<pg8::EpiRes>(L, g, S, E);
        }
        XSYNC();
        DBG_DUMP(6, out[(size_t)m * DM + c] + bf2f(XB[(size_t)m * DM + c]));
        {
            PHASE_BEGIN();
            const float* cw = a.in[17] + (size_t)l * 3 * DFF2; const float* cb = a.in[18] + (size_t)l * DFF2;
            pg8::Gemm g{XB, Wup, SEQ, DFF2, DM, DM}; pg8::StaticOrder S; S.init(SEQ, DFF2, G, bid);
            pg8::EpiUpConv E{ACT, EDGE, ssq_x1, cw, cb, (LAS float*)(L + RING_BYTES)};
            pg8::gemm_phase<pg8::EpiUpConv>(L, g, S, E);
        }
        XSYNC();
        {
            PHASE_BEGIN();
            const float* cw = a.in[17] + (size_t)l * 3 * DFF2; const float* cb = a.in[18] + (size_t)l * DFF2;
            for (int idx = bid * 512 + tid; idx < 63 * DFF; idx += G * 512) {
                const int pm = 1 + idx / DFF, gcol = idx % DFF;
                float y0[2], y1[2];
#pragma unroll
                for (int q = 0; q < 2; ++q) { const int c = q * DFF + gcol;
                    const float um2 = G_(EDGE)[(size_t)((pm - 1) * 4 + 2) * DFF2 + c], um1 = G_(EDGE)[(size_t)((pm - 1) * 4 + 3) * DFF2 + c], u0 = G_(EDGE)[(size_t)(pm * 4 + 0) * DFF2 + c], u1 = G_(EDGE)[(size_t)(pm * 4 + 1) * DFF2 + c];
                    const float w0 = G_(cw)[c], w1 = G_(cw)[DFF2 + c], w2 = G_(cw)[2 * DFF2 + c], bb = G_(cb)[c];
                    y0[q] = bb + w0 * um2 + w1 * um1 + w2 * u0; y1[q] = bb + w0 * um1 + w1 * u0 + w2 * u1; }
                G_(ACT)[(size_t)(pm * 256) * DFF + gcol] = (bf16_t)f2bf(silu_f(y0[0]) * y0[1]);
                G_(ACT)[(size_t)(pm * 256 + 1) * DFF + gcol] = (bf16_t)f2bf(silu_f(y1[0]) * y1[1]);
            }
        }
        XSYNC();
        DBG_DUMP(8, bf2f(ACT[(size_t)m * DFF + c]) + bf2f(ACT[(size_t)m * DFF + 3000 + c]));
        {
            PHASE_BEGIN();
            pg8::Gemm g{ACT, Wdn, SEQ, DM, DFF, DFF}; pg8::StaticOrder S; S.init(SEQ, DM, G, bid);
            pg8::EpiRes E{out, out, XB, ssq_xn};
            pg8::gemm_phase<pg8::EpiRes>(L, g, S, E);
        }
        XSYNC();
        if (DBG_STOP == 9) return;
    }
}

extern "C" void kernel_launch(void* const* d_in, const int* in_sizes, int n_in, void* d_out, int out_size, void* d_ws, size_t ws_size, hipStream_t stream) {
    static int grid = 0;
    if (grid == 0) {
        if (n_in != 20 || out_size != SEQ * DM || ws_size < WS_END) { fprintf(stderr, "kernel_launch: unexpected shapes: n_in %d out %d ws %zu (need %zu)\n", n_in, out_size, ws_size, (size_t)WS_END); grid = -1; return; }
        int dev = 0, cus = 0, per_cu = 0;
        hipGetDevice(&dev); hipDeviceGetAttribute(&cus, hipDeviceAttributeMultiprocessorCount, dev);
        hipFuncSetAttribute((const void*)mk_fwd, hipFuncAttributeMaxDynamicSharedMemorySize, LDS_BYTES);
        hipOccupancyMaxActiveBlocksPerMultiprocessor(&per_cu, (const void*)mk_fwd, 512, LDS_BYTES);
        (void)hipGetLastError();
        if (per_cu < 1) per_cu = 1;
        grid = cus * 1;
    }
    if (grid < 0) return;
    hipMemsetAsync((char*)d_ws + WS_CTL, 0, CTL_BYTES, stream);
    Args a{};
    for (int i = 0; i < 20; ++i) a.in[i] = (const float*)d_in[i];
    a.out = (float*)d_out; a.ws = (unsigned char*)d_ws;
    for (int i = 0; i < 32; ++i) a.inv_freq[i] = (float)pow(10000.0, -(double)i / 32.0);
    void* args[] = {&a};
    hipError_t e = hipLaunchCooperativeKernel((const void*)mk_fwd, dim3(grid), dim3(512), args, LDS_BYTES, stream);
    if (e != hipSuccess) fprintf(stderr, "cooperative launch failed: %s (grid %d)\n", hipGetErrorString(e), grid);
}
```

```cpp
#include <hip/hip_runtime.h>
#include <hip/hip_cooperative_groups.h>
#include <cstdio>
#include <cstdint>
#include <cmath>
namespace cg = cooperative_groups;

#define LAS __attribute__((address_space(3)))
typedef unsigned short bf16_t;
typedef unsigned long long u64;
typedef short bf16x8 __attribute__((ext_vector_type(8)));
typedef short s16x4 __attribute__((ext_vector_type(4)));
typedef float f32x4 __attribute__((ext_vector_type(4)));
typedef float f32x16 __attribute__((ext_vector_type(16)));
typedef unsigned u32x4 __attribute__((ext_vector_type(4)));
typedef unsigned u32x2 __attribute__((ext_vector_type(2)));
typedef float f32x2_t __attribute__((ext_vector_type(2)));
typedef __bf16 bf16x2_t __attribute__((ext_vector_type(2)));

constexpr int SEQ = 16384, DM = 2048, NLAYER = 2;
constexpr int IN_DIM = 3920, IN_PAD = 4096;
constexpr int C_CQ = 0, C_CKV = 512, C_KR = 768, C_GQ = 832, C_GK = 1344, C_GV = 1856, C_GA = 2880, C_GG = 2896;
constexpr int QLORA = 512, KVLORA = 256, NH = 8, QKD = 192, NOPE = 128, VD = 128, QW = NH * QKD  , KVW = NH * 256  ;
constexpr int GH = 4, GDK = 128, GDV = 256, NCHUNK = SEQ / 64;
constexpr int DFF = 5632, DFF2 = 11264;
constexpr float EPS = 1e-6f;

constexpr size_t MiB = 1u << 20;
constexpr size_t WS_CTL = 0, CTL_BYTES = 2 * MiB;
constexpr size_t WS_BAR = 0;
constexpr size_t WS_SSQ = 65536;
constexpr size_t WS_WIN = 2 * MiB, WS_WUQ = 18 * MiB, WS_WUKV = WS_WUQ + 3 * MiB / 2, WS_WOUT = WS_WUKV + 1 * MiB, WS_WUP = WS_WOUT + 8 * MiB, WS_WDN = WS_WUP + 44 * MiB;
constexpr size_t WS_XB = 95 * MiB;
constexpr size_t WS_R = 159 * MiB;
constexpr size_t WS_Z = WS_R, WS_Q = WS_Z + 128 * MiB, WS_K = WS_Q + 48 * MiB, WS_VT = WS_K + 48 * MiB, WS_ST = WS_VT + 32 * MiB, WS_DEC = WS_ST + 128 * MiB, WS_MIX = WS_DEC + 1 * MiB;
constexpr size_t WS_ACT = WS_R, WS_EDGE = WS_ACT + 176 * MiB, WS_END = WS_MIX + 64 * MiB;
static_assert(WS_EDGE + 12 * MiB <= WS_END, "ws map");

#define GAS __attribute__((address_space(1)))
template <class T> __device__ __forceinline__ GAS T* G_(T* p) { return (GAS T*)p; }
#define LAUNDER_V(x) asm volatile("" : "+v"(x))
#define LAUNDER_S(x) asm volatile("" : "+s"(x))
__device__ __forceinline__ unsigned f2bf(float f) { unsigned u = __builtin_bit_cast(unsigned, f); return (u + 0x7fffu + ((u >> 16) & 1u)) >> 16; }
__device__ __forceinline__ unsigned pk2(float lo, float hi) { f32x2_t v = {lo, hi}; bf16x2_t b = __builtin_convertvector(v, bf16x2_t); return __builtin_bit_cast(unsigned, b); }
__device__ __forceinline__ float bf2f(unsigned b) { return __builtin_bit_cast(float, b << 16); }
__device__ __forceinline__ float bflo(unsigned w) { return __builtin_bit_cast(float, w << 16); }
__device__ __forceinline__ float bfhi(unsigned w) { return __builtin_bit_cast(float, w & 0xffff0000u); }
__device__ __forceinline__ float wave_sum(float v) {
#pragma unroll
    for (int o = 1; o < 64; o <<= 1) v += __shfl_xor(v, o);
    return v;
}
constexpr float SSQ_FX = 1048576.0f, SSQ_INV = 1.0f / 1048576.0f;
__device__ __forceinline__ void ssq_add(u64* p, float v) { __hip_atomic_fetch_add((GAS u64*)p, (u64)(v * SSQ_FX + 0.5f), __ATOMIC_RELAXED, __HIP_MEMORY_SCOPE_AGENT); }
__device__ __forceinline__ float ssq_get(const u64* p) { return (float)(*(GAS const u64*)p) * SSQ_INV; }
__device__ __forceinline__ float silu_f(float x) { return x * __builtin_amdgcn_rcpf(1.0f + __expf(-x)); }

namespace pg8 {
constexpr int BM = 256, BK = 64, HALF = 128, HTB = HALF * BK * 2, STAGE_BYTES = 8 * HTB, NXCD = 8, WGM = 8;
__host__ __device__ __forceinline__ int lds_byte(int r, int c) { const int st = (r >> 4) * 2 + (c >> 5), rr = r & 15, cc = c & 31, ob = rr * 64 + cc * 2; return st * 1024 + (ob ^ (((ob >> 9) & 1) << 5)); }
__host__ __device__ __forceinline__ void stage_rc(int b, int& R, int& C) { const int st = b / 1024, sb = b % 1024, swz = sb ^ (((sb >> 9) & 1) << 5); R = (st >> 1) * 16 + swz / 64; C = (st & 1) * 32 + (swz % 64) / 2; }
__host__ __device__ __forceinline__ int perm32(int rho) { const int n = rho >> 4, i = rho & 15; return 8 * (i >> 2) + 4 * n + (i & 3); }

struct Unit { int pm, pn; };
struct Gemm { const bf16_t* A; const bf16_t* Bt; int M, N, K, lda; };

struct StaticOrder {
    int nM, nN, nwg, G, c;
    __device__ void init(int M, int N, int G_, int c_) { nM = M / BM; nN = N / BM; nwg = nM * nN; G = G_; c = c_; }
    __device__ bool next(int i, Unit& u) const {
        const long L = (long)i * G + c; if (L >= nwg) return false;
        int wgid = (int)L; { const int q = nwg / NXCD, r = nwg % NXCD, xcd = wgid % NXCD, off = wgid / NXCD; wgid = (xcd < r ? xcd * (q + 1) : r * (q + 1) + (xcd - r) * q) + off; }
        const int nig = WGM * nN, gid = wgid / nig, fm = gid * WGM, gsz = (nM - fm) < WGM ? (nM - fm) : WGM;
        u.pm = fm + ((wgid % nig) % gsz); u.pn = (wgid % nig) / gsz; return true;
    }
};

struct EpiRowScale {
    static constexpr bool PERM = true;
    bf16_t* O; int ldc; const u64* ssq_in; float inv_dim; u64* ssq_a; int a_lo, a_hi; u64* ssq_b; int b_lo, b_hi;
    __device__ __forceinline__ void operator()(const f32x4 (&acc)[2][2][4][2], const Unit& u, int wr, int wc, int fr, int fq) const {
        const int row0 = u.pm * BM + wr * 64 + fr, col0 = u.pn * BM + wc * 32 + 8 * fq;
        u64* sacc = (u.pn >= a_lo && u.pn < a_hi) ? ssq_a : ((u.pn >= b_lo && u.pn < b_hi) ? ssq_b : nullptr);
#pragma unroll
        for (int ai = 0; ai < 2; ++ai)
#pragma unroll
            for (int m = 0; m < 4; ++m) {
                const int row = row0 + ai * HALF + m * 16;
                const float sc = ssq_in ? rsqrtf(ssq_get(ssq_in + row) * inv_dim + EPS) : 1.0f;
                float ss = 0.f;
#pragma unroll
                for (int bj = 0; bj < 2; ++bj) {
                    const f32x4 v0 = acc[ai][bj][m][0] * sc, v1 = acc[ai][bj][m][1] * sc;
                    ss += (v0[0] * v0[0] + v0[1] * v0[1]) + (v0[2] * v0[2] + v0[3] * v0[3]) + (v1[0] * v1[0] + v1[1] * v1[1]) + (v1[2] * v1[2] + v1[3] * v1[3]);
                    u32x4 w; w.x = pk2(v0[0], v0[1]); w.y = pk2(v0[2], v0[3]); w.z = pk2(v1[0], v1[1]); w.w = pk2(v1[2], v1[3]);
                    *(GAS u32x4*)(G_(O) + (size_t)row * ldc + col0 + bj * HALF) = w;
                }
                if (sacc) { ss += __shfl_xor(ss, 16); ss += __shfl_xor(ss, 32); if (fq == 0) ssq_add(sacc + row, ss); }
            }
    }
};
struct EpiUkv {
    static constexpr bool PERM = true;
    bf16_t* Kb; bf16_t* Vt; const u64* ssq_in; float inv_dim;
    __device__ __forceinline__ void operator()(const f32x4 (&acc)[2][2][4][2], const Unit& u, int wr, int wc, int fr, int fq) const {
        const int row0 = u.pm * BM + wr * 64 + fr, c0 = wc * 32 + 8 * fq;
#pragma unroll
        for (int ai = 0; ai < 2; ++ai)
#pragma unroll
            for (int m = 0; m < 4; ++m) {
                const int row = row0 + ai * HALF + m * 16;
                const int prow = (row & ~15) | (row & 3) | ((row & 4) << 1) | ((row & 8) >> 1);
                const float sc = rsqrtf(ssq_get(ssq_in + row) * inv_dim + EPS);
                { const f32x4 v0 = acc[ai][0][m][0] * sc, v1 = acc[ai][0][m][1] * sc;
                  u32x4 w; w.x = pk2(v0[0], v0[1]); w.y = pk2(v0[2], v0[3]); w.z = pk2(v1[0], v1[1]); w.w = pk2(v1[2], v1[3]);
                  *(GAS u32x4*)(G_(Kb) + (size_t)row * QW + u.pn * QKD + c0) = w; }
#pragma unroll
                for (int n = 0; n < 2; ++n)
#pragma unroll
                    for (int j = 0; j < 4; ++j) G_(Vt)[(size_t)(u.pn * VD + c0 + 4 * n + j) * SEQ + prow] = (bf16_t)f2bf(acc[ai][1][m][n][j] * sc);
            }
    }
};
struct EpiRes {
    static constexpr bool PERM = true;
    const float* base; float* out; bf16_t* xb; u64* ssq_out;
    __device__ __forceinline__ void operator()(const f32x4 (&acc)[2][2][4][2], const Unit& u, int wr, int wc, int fr, int fq) const {
        const int row0 = u.pm * BM + wr * 64 + fr, col0 = u.pn * BM + wc * 32 + 8 * fq;
#pragma unroll
        for (int ai = 0; ai < 2; ++ai)
#pragma unroll
            for (int m = 0; m < 4; ++m) {
                const int row = row0 + ai * HALF + m * 16; float ss = 0.f;
#pragma unroll
                for (int bj = 0; bj < 2; ++bj) {
                    const size_t off = (size_t)row * DM + col0 + bj * HALF;
                    const f32x4 v0 = acc[ai][bj][m][0] + *(GAS const f32x4*)(G_(base) + off), v1 = acc[ai][bj][m][1] + *(GAS const f32x4*)(G_(base) + off + 4);
                    ss += (v0[0] * v0[0] + v0[1] * v0[1]) + (v0[2] * v0[2] + v0[3] * v0[3]) + (v1[0] * v1[0] + v1[1] * v1[1]) + (v1[2] * v1[2] + v1[3] * v1[3]);
                    *(GAS f32x4*)(G_(out) + off) = v0; *(GAS f32x4*)(G_(out) + off + 4) = v1;
                    u32x4 w; w.x = pk2(v0[0], v0[1]); w.y = pk2(v0[2], v0[3]); w.z = pk2(v1[0], v1[1]); w.w = pk2(v1[2], v1[3]);
                    *(GAS u32x4*)(G_(xb) + off) = w;
                }
                ss += __shfl_xor(ss, 16); ss += __shfl_xor(ss, 32); if (fq == 0) ssq_add(ssq_out + row, ss);
            }
    }
};


#define DPP_SHR1(old, src) __builtin_bit_cast(float, __builtin_amdgcn_update_dpp(__builtin_bit_cast(int, (float)(old)), __builtin_bit_cast(int, (float)(src)), 0x111, 0xf, 0xf, false))
#define DPP_SHR2(old, src) __builtin_bit_cast(float, __builtin_amdgcn_update_dpp(__builtin_bit_cast(int, (float)(old)), __builtin_bit_cast(int, (float)(src)), 0x112, 0xf, 0xf, false))
#define DPP_ROR1(src) __builtin_bit_cast(float, __builtin_amdgcn_update_dpp(0, __builtin_bit_cast(int, (float)(src)), 0x121, 0xf, 0xf, false))
#define DPP_ROR2(src) __builtin_bit_cast(float, __builtin_amdgcn_update_dpp(0, __builtin_bit_cast(int, (float)(src)), 0x122, 0xf, 0xf, false))
struct EpiUpConv {
    static constexpr bool PERM = true;
    bf16_t* ACT; float* EDGE; const u64* ssq_in; const float* cw; const float* cb; LAS float* halo;
    __device__ __forceinline__ void operator()(f32x4 (&acc)[2][2][4][2], const Unit& u, int wr, int wc, int fr, int fq) const {
        const int row0 = u.pm * BM + wr * 64 + fr;
        const int g0 = u.pn * 128 + wc * 32 + 8 * fq;
#pragma unroll
        for (int ai = 0; ai < 2; ++ai)
#pragma unroll
            for (int m = 0; m < 4; ++m) {
                const float sc = rsqrtf(ssq_get(ssq_in + row0 + ai * HALF + m * 16) * (1.0f / DM) + EPS);
#pragma unroll
                for (int bj = 0; bj < 2; ++bj)
#pragma unroll
                    for (int n = 0; n < 2; ++n) acc[ai][bj][m][n] = acc[ai][bj][m][n] * sc;
            }
        if (fr >= 14) {
#pragma unroll
            for (int ai = 0; ai < 2; ++ai) { LAS float* hp = halo + ((((2 * ai + wr) * 4 + wc) * 2 + (fr - 14)) * 4 + fq) * 16;
#pragma unroll
                for (int bj = 0; bj < 2; ++bj)
#pragma unroll
                    for (int n = 0; n < 2; ++n) *(LAS f32x4*)(hp + bj * 8 + n * 4) = acc[ai][bj][3][n]; }
            if (wr == 1) { GAS float* ep = G_(EDGE) + (size_t)(u.pm * 4 + 2 + fr - 14) * DFF2 + g0;
#pragma unroll
                for (int bj = 0; bj < 2; ++bj)
#pragma unroll
                    for (int n = 0; n < 2; ++n) *(GAS f32x4*)(ep + bj * DFF + 4 * n) = acc[1][bj][3][n]; }
        }
        if (fr < 2 && wr == 0) { GAS float* ep = G_(EDGE) + (size_t)(u.pm * 4 + fr) * DFF2 + g0;
#pragma unroll
            for (int bj = 0; bj < 2; ++bj)
#pragma unroll
                for (int n = 0; n < 2; ++n) *(GAS f32x4*)(ep + bj * DFF + 4 * n) = acc[0][bj][0][n]; }
        asm volatile("s_waitcnt lgkmcnt(0)" ::: "memory"); __builtin_amdgcn_s_barrier(); asm volatile("" ::: "memory");
#pragma unroll
        for (int n = 0; n < 2; ++n) {
            const int gc = g0 + 4 * n;
            GAS const float* cwg = G_(cw); GAS const float* cbg = G_(cb);
            const f32x4 wg0 = *(GAS const f32x4*)(cwg + gc), wg1 = *(GAS const f32x4*)(cwg + DFF2 + gc), wg2 = *(GAS const f32x4*)(cwg + 2 * DFF2 + gc), bgv = *(GAS const f32x4*)(cbg + gc);
            const f32x4 wu0 = *(GAS const f32x4*)(cwg + DFF + gc), wu1 = *(GAS const f32x4*)(cwg + DFF2 + DFF + gc), wu2 = *(GAS const f32x4*)(cwg + 2 * DFF2 + DFF + gc), buv = *(GAS const f32x4*)(cbg + DFF + gc);
#pragma unroll
            for (int ai = 0; ai < 2; ++ai) {
                const int band = 2 * ai + wr;
                f32x4 pg = (f32x4){0.f, 0.f, 0.f, 0.f}, pu = pg;
                if (band > 0) { const LAS float* hp = halo + ((((band - 1) * 4 + wc) * 2 + (fr & 1)) * 4 + fq) * 16; pg = *(const LAS f32x4*)(hp + n * 4); pu = *(const LAS f32x4*)(hp + 8 + n * 4); }
#pragma unroll
                for (int m = 0; m < 4; ++m) {
                    const f32x4 cg = acc[ai][0][m][n], cu = acc[ai][1][m][n];
                    float av[4];
#pragma unroll
                    for (int j = 0; j < 4; ++j) {
                        const float g1 = DPP_SHR1(DPP_ROR1(pg[j]), cg[j]), g2 = DPP_SHR2(DPP_ROR2(pg[j]), cg[j]);
                        const float u1 = DPP_SHR1(DPP_ROR1(pu[j]), cu[j]), u2 = DPP_SHR2(DPP_ROR2(pu[j]), cu[j]);
                        const float yg = bgv[j] + wg0[j] * g2 + wg1[j] * g1 + wg2[j] * cg[j];
                        const float yu = buv[j] + wu0[j] * u2 + wu1[j] * u1 + wu2[j] * cu[j];
                        av[j] = silu_f(yg) * yu;
                    }
                    *(GAS u32x2*)(G_(ACT) + (size_t)(row0 + ai * HALF + m * 16) * DFF + gc) = (u32x2){pk2(av[0], av[1]), pk2(av[2], av[3])};
                    pg = cg; pu = cu;
                }
            }
        }
    }
};

template <class Epi>
__device__ __forceinline__ void gemm_phase(LAS unsigned char* lds, const Gemm g, const StaticOrder& S, const Epi& E) {
    int tid_ = threadIdx.x; LAUNDER_V(tid_);
    const int tid = tid_, wid = __builtin_amdgcn_readfirstlane(tid >> 6), lane = tid & 63, wr = wid >> 2, wc = wid & 3, fr = lane & 15, fq = lane >> 4;
    const int K = g.K, nt = K / BK;
    unsigned voffA[2], voffB[2];
#pragma unroll
    for (int i = 0; i < 2; ++i) { int R, C; stage_rc(tid * 16 + i * 8192, R, C); const int Rb = Epi::PERM ? ((R & ~31) + perm32(R & 31)) : R;
        voffA[i] = (unsigned)(R * g.lda + C) * 2u; voffB[i] = (unsigned)(Rb * K + C) * 2u; }
    const size_t kstep = (size_t)(BK * 2);
    const size_t hstepA = (size_t)HALF * g.lda * 2, hstepB = (size_t)HALF * K * 2;
    const size_t tstepA = 2 * hstepA, tstepB = 2 * hstepB;
    const unsigned ldsw = (unsigned)wid * 1024u;
    const int aoff = lds_byte(wr * 64 + fr, fq * 8), boff = lds_byte(wc * 32 + fr, fq * 8);
#define PG8_SA(b, h) (((b) * 2 + (h)) * HTB)
#define PG8_SB(b, h) ((4 + (b) * 2 + (h)) * HTB)
#define PG8_STAGE(bufoff, gbase, voff) do { _Pragma("unroll") for (int _i = 0; _i < 2; ++_i) \
        __builtin_amdgcn_global_load_lds((const unsigned*)((const char*)(gbase) + (voff)[_i]), (LAS unsigned*)(lds + (bufoff) + ldsw + _i * 8192), 16, 0, 0); } while (0)
#define PG8_LDA(dst, b, h) do { _Pragma("unroll") for (int m = 0; m < 4; ++m) _Pragma("unroll") for (int k = 0; k < 2; ++k) dst[m][k] = *(const LAS bf16x8*)(lds + PG8_SA(b, h) + aoff + m * 2048 + k * 1024); } while (0)
#define PG8_LDB(dst, b, h) do { _Pragma("unroll") for (int n = 0; n < 2; ++n) _Pragma("unroll") for (int k = 0; k < 2; ++k) dst[n][k] = *(const LAS bf16x8*)(lds + PG8_SB(b, h) + boff + n * 2048 + k * 1024); } while (0)
#define PG8_MMA(ai, bj, At, Bt) do { __builtin_amdgcn_s_setprio(1); _Pragma("unroll") for (int m = 0; m < 4; ++m) _Pragma("unroll") for (int n = 0; n < 2; ++n) _Pragma("unroll") for (int k = 0; k < 2; ++k) \
        acc[ai][bj][m][n] = __builtin_amdgcn_mfma_f32_16x16x32_bf16(Bt[n][k], At[m][k], acc[ai][bj][m][n], 0, 0, 0); __builtin_amdgcn_s_setprio(0); } while (0)
#define PG8_WAIT_V(n) asm volatile("s_waitcnt vmcnt(" #n ")" ::: "memory")
#define PG8_WAIT_L(n) asm volatile("s_waitcnt lgkmcnt(" #n ")" ::: "memory")
#define PG8_BAR __builtin_amdgcn_s_barrier()
#define PG8_SCHED __builtin_amdgcn_sched_barrier(0)
    Unit cur, nxt; int ui = 0;
    if (!S.next(0, cur)) return;
    f32x4 acc[2][2][4][2];
#pragma unroll
    for (int a = 0; a < 2; ++a)
#pragma unroll
        for (int b = 0; b < 2; ++b)
#pragma unroll
            for (int m = 0; m < 4; ++m)
#pragma unroll
                for (int n = 0; n < 2; ++n) acc[a][b][m][n] = (f32x4){0.f, 0.f, 0.f, 0.f};
    bf16x8 At[4][2], B0[2][2], B1[2][2];
    const char* cA = (const char*)g.A + (size_t)cur.pm * tstepA; const char* cB = (const char*)g.Bt + (size_t)cur.pn * tstepB;
    PG8_STAGE(PG8_SB(0, 0), cB, voffB); PG8_STAGE(PG8_SB(0, 1), cB + hstepB, voffB); PG8_STAGE(PG8_SA(0, 0), cA, voffA); PG8_STAGE(PG8_SA(0, 1), cA + hstepA, voffA);
    if (wr == 1) PG8_BAR;
    PG8_WAIT_V(2); PG8_BAR;
    PG8_STAGE(PG8_SB(1, 0), cB + kstep, voffB); PG8_STAGE(PG8_SA(1, 0), cA + kstep, voffA); PG8_STAGE(PG8_SB(1, 1), cB + hstepB + kstep, voffB);
    PG8_WAIT_V(6); PG8_BAR;
    for (;;) {
        const bool has_next = S.next(ui + 1, nxt);
        const char* nA = has_next ? (const char*)g.A + (size_t)nxt.pm * tstepA : cA; const char* nB = has_next ? (const char*)g.Bt + (size_t)nxt.pn * tstepB : cB;
        for (int t = 0; t < nt; t += 2) {
            const bool last = (t == nt - 2);
            const char* a1 = cA + (size_t)(t + 1) * kstep;
            const char* a2 = last ? nA : cA + (size_t)(t + 2) * kstep; const char* b2 = last ? nB : cB + (size_t)(t + 2) * kstep;
            const char* a3 = a2 + kstep; const char* b3 = b2 + kstep;
            PG8_LDB(B0, 0, 0); PG8_LDB(B1, 0, 1); PG8_SCHED; PG8_LDA(At, 0, 0); PG8_STAGE(PG8_SA(1, 1), a1 + hstepA, voffA);
            PG8_WAIT_V(8); PG8_WAIT_L(0); PG8_BAR; PG8_MMA(0, 0, At, B0); PG8_MMA(0, 1, At, B1); PG8_BAR; PG8_SCHED;
            PG8_LDA(At, 0, 1); PG8_STAGE(PG8_SB(0, 0), b2, voffB); PG8_STAGE(PG8_SB(0, 1), b2 + hstepB, voffB); PG8_STAGE(PG8_SA(0, 0), a2, voffA);
            PG8_WAIT_V(8); PG8_WAIT_L(0); PG8_BAR; PG8_MMA(1, 0, At, B0); PG8_MMA(1, 1, At, B1); PG8_BAR; PG8_SCHED;
            PG8_LDB(B0, 1, 0); PG8_LDB(B1, 1, 1); PG8_SCHED; PG8_LDA(At, 1, 0); PG8_STAGE(PG8_SA(0, 1), a2 + hstepA, voffA);
            PG8_WAIT_V(8); PG8_WAIT_L(0); PG8_BAR; PG8_MMA(0, 0, At, B0); PG8_MMA(0, 1, At, B1); PG8_BAR; PG8_SCHED;
            PG8_LDA(At, 1, 1); PG8_STAGE(PG8_SB(1, 0), b3, voffB); PG8_STAGE(PG8_SB(1, 1), b3 + hstepB, voffB); PG8_STAGE(PG8_SA(1, 0), a3, voffA);
            PG8_WAIT_V(8); PG8_WAIT_L(0); PG8_BAR; PG8_MMA(1, 0, At, B0); PG8_MMA(1, 1, At, B1); PG8_BAR; PG8_SCHED;
        }
        if (wr == 0) PG8_BAR;
        { int frE = fr, fqE = fq; LAUNDER_V(frE); LAUNDER_V(fqE); E(acc, cur, wr, wc, frE, fqE); }
        if (!has_next) break;
#pragma unroll
        for (int a = 0; a < 2; ++a)
#pragma unroll
            for (int b = 0; b < 2; ++b)
#pragma unroll
                for (int m = 0; m < 4; ++m)
#pragma unroll
                    for (int n = 0; n < 2; ++n) acc[a][b][m][n] = (f32x4){0.f, 0.f, 0.f, 0.f};
        cur = nxt; cA = nA; cB = nB; ++ui;
        if (wr == 1) PG8_BAR;
    }
    PG8_WAIT_V(0);
    PG8_BAR;
#undef PG8_SA
#undef PG8_SB
#undef PG8_STAGE
#undef PG8_LDA
#undef PG8_LDB
#undef PG8_MMA
#undef PG8_WAIT_V
#undef PG8_WAIT_L
#undef PG8_BAR
#undef PG8_SCHED
}
}

constexpr int RING_BYTES = 131072;
constexpr int LDS_BYTES = 147456;

struct Args { const float* in[20]; float* out; unsigned char* ws; float inv_freq[32]; };
typedef const __attribute__((address_space(4))) Args* KAP_T;

#define DS_READ4(r0, r1, r2, r3, addr, o0, o1, o2, o3) asm volatile("ds_read_b128 %0, %4 offset:%5\n\tds_read_b128 %1, %4 offset:%6\n\tds_read_b128 %2, %4 offset:%7\n\tds_read_b128 %3, %4 offset:%8" \
    : "=&v"(r0), "=&v"(r1), "=&v"(r2), "=&v"(r3) : "v"(addr), "i"(o0), "i"(o1), "i"(o2), "i"(o3) : "memory")
#define LGKM_WAIT4(n, r0, r1, r2, r3) asm volatile("s_waitcnt lgkmcnt(" #n ")" : "+v"(r0), "+v"(r1), "+v"(r2), "+v"(r3) :: "memory")
#define MFMA32(a, b, c) __builtin_amdgcn_mfma_f32_32x32x16_bf16((a), (b), (c), 0, 0, 0)
__device__ __forceinline__ int crow(int r, int hi) { return (r & 3) + 8 * (r >> 2) + 4 * hi; }

__device__ __forceinline__ void wt_item(const float* __restrict__ W, int K, int N, const float* __restrict__ gain, int gainK, bf16_t* WT, LAS float* scr, int item, int nblk, int lane, bool remap_up = false) {
    const int kb = item / nblk, nb = item % nblk, k0 = 64 * kb, n0 = 32 * nb;
    const int ns0 = remap_up ? (((n0 & 255) < 128) ? 128 * (n0 >> 8) + (n0 & 255) : DFF + 128 * (n0 >> 8) + (n0 & 255) - 128) : n0;
    const int n = ns0 + (lane & 31);
    float wv[32];
#pragma unroll
    for (int i = 0; i < 32; ++i) { const int kk = 2 * i + (lane >> 5); wv[i] = (n < N) ? G_(W)[(size_t)(k0 + kk) * N + n] : 0.f; }
#pragma unroll
    for (int i = 0; i < 32; ++i) { const int kk = 2 * i + (lane >> 5); scr[kk * 33 + (lane & 31)] = wv[i]; }
    asm volatile("s_waitcnt lgkmcnt(0)" ::: "memory");
    const int c = lane & 7;
    f32x4 g0 = (f32x4){1.f, 1.f, 1.f, 1.f}, g1 = g0;
    if (k0 < gainK) { g0 = *(GAS const f32x4*)(G_(gain) + k0 + 8 * c); g1 = *(GAS const f32x4*)(G_(gain) + k0 + 8 * c + 4); }
#pragma unroll
    for (int j = 0; j < 4; ++j) { const int nn = (lane >> 3) + 8 * j; const LAS float* s = scr + (8 * c) * 33 + nn;
        u32x4 o; o.x = pk2(s[0 * 33] * g0[0], s[1 * 33] * g0[1]); o.y = pk2(s[2 * 33] * g0[2], s[3 * 33] * g0[3]); o.z = pk2(s[4 * 33] * g1[0], s[5 * 33] * g1[1]); o.w = pk2(s[6 * 33] * g1[2], s[7 * 33] * g1[3]);
        *(GAS u32x4*)(G_(WT) + (size_t)(n0 + nn) * K + k0 + 8 * c) = o; }
    asm volatile("s_waitcnt lgkmcnt(0)" ::: "memory");
}

constexpr int AT_KSTR = 400, AT_VSTR = 144;
constexpr int AT_KB = 64 * AT_KSTR  , AT_VB = 128 * AT_VSTR  , AT_K0 = 0, AT_V0 = 2 * AT_KB, AT_WSF = AT_V0 + 2 * AT_VB;
static_assert(AT_WSF + 8 * 128 <= RING_BYTES, "attn lds");

__device__ __forceinline__ void attn_unit(LAS unsigned char* L, const bf16_t* Q_, const bf16_t* Kg_, const bf16_t* Vt_, bf16_t* mix_, int h, int qb) {
    GAS const bf16_t* Q = G_(Q_); GAS const bf16_t* Kg = G_(Kg_); GAS const bf16_t* Vt = G_(Vt_); GAS bf16_t* mix = G_(mix_);
    int tid_ = threadIdx.x; LAUNDER_V(tid_);
    const int tid = tid_, lane = tid & 63, w = __builtin_amdgcn_readfirstlane(tid >> 6), r32 = lane & 31, hh = lane >> 5;
    const int q0 = qb * 256;
    bf16x8 qf[12];
    { GAS const bf16_t* qrow = Q + (size_t)(q0 + 32 * w + r32) * QW + h * QKD + 8 * hh;
#pragma unroll
      for (int ks = 0; ks < 12; ++ks) qf[ks] = *(GAS const bf16x8*)(qrow + 16 * ks); }
    f32x16 o[4];
#pragma unroll
    for (int d = 0; d < 4; ++d)
#pragma unroll
        for (int i = 0; i < 16; ++i) o[d][i] = 0.f;
    float l_run = 0.f;
    const int NT = 4 * qb + 4, my_last = 4 * qb + (w >> 1);
    volatile LAS float* wsf = (volatile LAS float*)(L + AT_WSF) + w * 32;
    const unsigned lds_base = (unsigned)(uintptr_t)L;
    u32x4 kst[3], vst[2];
#define AT_GLOAD(t) do { const int kv0_ = (t) * 64; int x_ = tid; LAUNDER_V(x_); \
    _Pragma("unroll") for (int i = 0; i < 3; ++i) { const int id_ = x_ + 512 * i, r_ = id_ / 24, c_ = id_ - 24 * r_; kst[i] = *(GAS const u32x4*)(Kg + (size_t)(kv0_ + r_) * QW + h * QKD + c_ * 8); } \
    _Pragma("unroll") for (int i = 0; i < 2; ++i) { const int id_ = x_ + 512 * i; vst[i] = *(GAS const u32x4*)(Vt + (size_t)(h * VD + (id_ >> 3)) * SEQ + kv0_ + (id_ & 7) * 8); } } while (0)
#define AT_SSTORE(buf) do { int x_ = tid; LAUNDER_V(x_); \
    _Pragma("unroll") for (int i = 0; i < 3; ++i) { const int id_ = x_ + 512 * i, r_ = id_ / 24, c_ = id_ - 24 * r_; *(LAS u32x4*)(L + AT_K0 + (buf) * AT_KB + r_ * AT_KSTR + c_ * 16) = kst[i]; } \
    _Pragma("unroll") for (int i = 0; i < 2; ++i) { const int id_ = x_ + 512 * i; *(LAS u32x4*)(L + AT_V0 + (buf) * AT_VB + (id_ >> 3) * AT_VSTR + (id_ & 7) * 16) = vst[i]; } } while (0)
    AT_GLOAD(0); AT_SSTORE(0); __syncthreads();
    for (int t = 0; t < NT; ++t) {
        const int buf = t & 1;
        if (t + 1 < NT) AT_GLOAD(t + 1);
        if (t <= my_last) {
            const unsigned kaddr = lds_base + AT_K0 + buf * AT_KB + r32 * AT_KSTR + hh * 16;
            const unsigned vaddr = lds_base + AT_V0 + buf * AT_VB + r32 * AT_VSTR + hh * 16;
            f32x16 p0, p1;
#pragma unroll
            for (int i = 0; i < 16; ++i) { p0[i] = 0.f; p1[i] = 0.f; }
            bf16x8 fa0, fa1, fa2, fa3, fb0, fb1, fb2, fb3;
#define QK_RD(s0, s1, s2, s3, kb, g) DS_READ4(s0, s1, s2, s3, kaddr, (kb) * 32 * AT_KSTR + (4 * (g)) * 32, (kb) * 32 * AT_KSTR + (4 * (g) + 1) * 32, (kb) * 32 * AT_KSTR + (4 * (g) + 2) * 32, (kb) * 32 * AT_KSTR + (4 * (g) + 3) * 32)
#define QK_MM(s0, s1, s2, s3, P, g) do { P = MFMA32(s0, qf[4 * (g)], P); P = MFMA32(s1, qf[4 * (g) + 1], P); P = MFMA32(s2, qf[4 * (g) + 2], P); P = MFMA32(s3, qf[4 * (g) + 3], P); } while (0)
#define PV_RD(s0, s1, s2, s3, kb, ss) DS_READ4(s0, s1, s2, s3, vaddr, (kb) * 64 + (ss) * 32, 32 * AT_VSTR + (kb) * 64 + (ss) * 32, 64 * AT_VSTR + (kb) * 64 + (ss) * 32, 96 * AT_VSTR + (kb) * 64 + (ss) * 32)
#define PV_PK(P, ss) __builtin_bit_cast(bf16x8, (u32x4){pk2(P[8 * (ss) + 0], P[8 * (ss) + 1]), pk2(P[8 * (ss) + 2], P[8 * (ss) + 3]), pk2(P[8 * (ss) + 4], P[8 * (ss) + 5]), pk2(P[8 * (ss) + 6], P[8 * (ss) + 7])})
#define PV_MM(s0, s1, s2, s3, xs) do { o[0] = MFMA32(xs, s0, o[0]); o[1] = MFMA32(xs, s1, o[1]); o[2] = MFMA32(xs, s2, o[2]); o[3] = MFMA32(xs, s3, o[3]); } while (0)
            QK_RD(fa0, fa1, fa2, fa3, 0, 0);
            QK_RD(fb0, fb1, fb2, fb3, 0, 1); LGKM_WAIT4(4, fa0, fa1, fa2, fa3); QK_MM(fa0, fa1, fa2, fa3, p0, 0);
            QK_RD(fa0, fa1, fa2, fa3, 0, 2); LGKM_WAIT4(4, fb0, fb1, fb2, fb3); QK_MM(fb0, fb1, fb2, fb3, p0, 1);
            QK_RD(fb0, fb1, fb2, fb3, 1, 0); LGKM_WAIT4(4, fa0, fa1, fa2, fa3); QK_MM(fa0, fa1, fa2, fa3, p0, 2);
            float ls0 = 0.f, ls1 = 0.f;
#pragma unroll
            for (int i = 0; i < 16; ++i) { p0[i] = __builtin_amdgcn_exp2f(fminf(p0[i], 100.f)); ls0 += p0[i]; }
            QK_RD(fa0, fa1, fa2, fa3, 1, 1); LGKM_WAIT4(4, fb0, fb1, fb2, fb3); QK_MM(fb0, fb1, fb2, fb3, p1, 0);
            QK_RD(fb0, fb1, fb2, fb3, 1, 2); LGKM_WAIT4(4, fa0, fa1, fa2, fa3); QK_MM(fa0, fa1, fa2, fa3, p1, 1);
            PV_RD(fa0, fa1, fa2, fa3, 0, 0); LGKM_WAIT4(4, fb0, fb1, fb2, fb3); QK_MM(fb0, fb1, fb2, fb3, p1, 2);
            { const bf16x8 x00 = PV_PK(p0, 0), x01 = PV_PK(p0, 1);
#pragma unroll
              for (int i = 0; i < 16; ++i) { p1[i] = __builtin_amdgcn_exp2f(fminf(p1[i], 100.f)); ls1 += p1[i]; }
              PV_RD(fb0, fb1, fb2, fb3, 0, 1); LGKM_WAIT4(4, fa0, fa1, fa2, fa3); PV_MM(fa0, fa1, fa2, fa3, x00);
              PV_RD(fa0, fa1, fa2, fa3, 1, 0); LGKM_WAIT4(4, fb0, fb1, fb2, fb3); PV_MM(fb0, fb1, fb2, fb3, x01);
              const bf16x8 x10 = PV_PK(p1, 0), x11 = PV_PK(p1, 1);
              PV_RD(fb0, fb1, fb2, fb3, 1, 1); LGKM_WAIT4(4, fa0, fa1, fa2, fa3); PV_MM(fa0, fa1, fa2, fa3, x10);
              LGKM_WAIT4(0, fb0, fb1, fb2, fb3); PV_MM(fb0, fb1, fb2, fb3, x11); }
            l_run += ls0 + ls1;
#undef QK_RD
#undef QK_MM
#undef PV_RD
#undef PV_PK
#undef PV_MM
        }
        if (t + 1 < NT) AT_SSTORE(buf ^ 1);
        __syncthreads();
    }
#undef AT_GLOAD
#undef AT_SSTORE
    const float lt = l_run + __shfl_xor(l_run, 32);
    wsf[r32] = 1.0f / lt;
    asm volatile("s_waitcnt lgkmcnt(0)" ::: "memory");
    GAS bf16_t* orow = mix + (size_t)(q0 + 32 * w) * DM + h * VD + r32;
#pragma unroll
    for (int i = 0; i < 16; ++i) { const int qr = crow(i, hh); const float a = wsf[qr];
#pragma unroll
        for (int d = 0; d < 4; ++d) orow[(size_t)qr * DM + 32 * d] = (bf16_t)f2bf(o[d][i] * a); }
    __syncthreads();
}

constexpr int GL_V = 0  , GL_KD = 32768  , GL_TOT = GL_KD + 18432  , GL_ZA = GL_TOT + 2048  ;
__device__ __forceinline__ void gla_chunk_unit(LAS unsigned char* L, const bf16_t* Z_, const float* wgate_, const float* bgate_, float* ST_, float* DEC_, int c, int h) {
    GAS const bf16_t* Z = G_(Z_); GAS const float* wgate = G_(wgate_); GAS const float* bgate = G_(bgate_); GAS float* ST = G_(ST_); GAS float* DEC = G_(DEC_);
    int tid_ = threadIdx.x; LAUNDER_V(tid_);
    const int tid = tid_, lane = tid & 63, w = __builtin_amdgcn_readfirstlane(tid >> 6), r32 = lane & 31, hh = lane >> 5;
    const size_t row0 = (size_t)c * 64;
#pragma unroll
    for (int i = 0; i < 4; ++i) { const int id = tid + 512 * i, r = id >> 5, cc = id & 31;
        *(LAS u32x4*)(L + GL_V + r * 512 + cc * 16) = *(GAS const u32x4*)(Z + (row0 + r) * IN_PAD + C_GV + h * GDV + cc * 8); }
#pragma unroll
    for (int i = 0; i < 2; ++i) { const int id = tid + 512 * i, r = id >> 4, cc = id & 15;
        ((LAS float*)(L + GL_ZA))[id] = bf2f(Z[(row0 + r) * IN_PAD + C_GA + cc]); }
    __syncthreads();
    const int tq = tid >> 7, col = tid & 127;
    float wg[16];
#pragma unroll
    for (int r = 0; r < 16; ++r) wg[r] = wgate[r * (GH * GDK) + h * GDK + col];
    const float bg = bgate[h * GDK + col];
    float pre[16]; float run = 0.f;
#pragma unroll
    for (int i = 0; i < 16; ++i) {
        const LAS float* za = (const LAS float*)(L + GL_ZA) + (16 * tq + i) * 16;
        float ga = bg;
#pragma unroll
        for (int r = 0; r < 16; ++r) ga += za[r] * wg[r];
        const float ls = fminf(ga, 0.f) - __logf(1.0f + __expf(-fabsf(ga)));
        run += ls * (1.0f / 16.0f); pre[i] = run;
    }
    ((LAS float*)(L + GL_TOT))[tq * 128 + col] = run;
    __syncthreads();
    float off = 0.f, bend = 0.f;
#pragma unroll
    for (int t = 0; t < 4; ++t) { const float v = ((LAS float*)(L + GL_TOT))[t * 128 + col]; bend += v; if (t < tq) off += v; }
    {
        unsigned pkv[8];
#pragma unroll
        for (int i = 0; i < 16; i += 2) {
            const float k0 = bf2f(Z[(row0 + 16 * tq + i) * IN_PAD + C_GK + h * GDK + col]), k1 = bf2f(Z[(row0 + 16 * tq + i + 1) * IN_PAD + C_GK + h * GDK + col]);
            pkv[i >> 1] = pk2(k0 * __expf(bend - off - pre[i]), k1 * __expf(bend - off - pre[i + 1]));
        }
        LAS u32x4* dst = (LAS u32x4*)(L + GL_KD + col * 144 + tq * 32);
        dst[0] = (u32x4){pkv[0], pkv[1], pkv[2], pkv[3]}; dst[1] = (u32x4){pkv[4], pkv[5], pkv[6], pkv[7]};
    }
    if (tq == 0) DEC[(size_t)(c * GH + h) * GDK + col] = __expf(bend);
    __syncthreads();
    f32x16 acc[4];
#pragma unroll
    for (int d = 0; d < 4; ++d)
#pragma unroll
        for (int i = 0; i < 16; ++i) acc[d][i] = 0.f;
#pragma unroll
    for (int ks = 0; ks < 4; ++ks) {
        bf16x8 a;
#pragma unroll
        for (int j = 0; j < 8; ++j) a[j] = (short)*(const LAS unsigned short*)(L + GL_V + (16 * ks + 8 * hh + j) * 512 + (32 * w + r32) * 2);
#pragma unroll
        for (int db = 0; db < 4; ++db) {
            const bf16x8 b = *(const LAS bf16x8*)(L + GL_KD + (32 * db + r32) * 144 + (16 * ks + 8 * hh) * 2);
            acc[db] = MFMA32(a, b, acc[db]);
        }
    }
    GAS float* stp = ST + ((size_t)(c * GH + h) * GDV + 32 * w) * GDK + r32;
#pragma unroll
    for (int db = 0; db < 4; ++db)
#pragma unroll
        for (int i = 0; i < 16; ++i) stp[(size_t)crow(i, hh) * GDK + 32 * db] = acc[db][i];
    __syncthreads();
}

constexpr int GO_STR = 260;
__device__ __forceinline__ void gla_out_unit(LAS unsigned char* L, const bf16_t* Z_, const float* ST_, const float* gnorm_, bf16_t* mix_, int c, int h) {
    GAS const bf16_t* Z = G_(Z_); GAS const float* ST = G_(ST_); GAS const float* gnorm = G_(gnorm_); GAS bf16_t* mix = G_(mix_);
    int tid_ = threadIdx.x; LAUNDER_V(tid_);
    const int tid = tid_, lane = tid & 63, w = __builtin_amdgcn_readfirstlane(tid >> 6), r32 = lane & 31, hh = lane >> 5;
    const size_t row0 = (size_t)c * 64;
    f32x16 acc[2];
#pragma unroll
    for (int d = 0; d < 2; ++d)
#pragma unroll
        for (int i = 0; i < 16; ++i) acc[d][i] = 0.f;
    GAS const float* sp = ST + ((size_t)(c * GH + h) * GDV + 32 * w + r32) * GDK + 8 * hh;
#pragma unroll
    for (int ks = 0; ks < 8; ++ks) {
        const f32x4 s0 = *(GAS const f32x4*)(sp + 16 * ks), s1 = *(GAS const f32x4*)(sp + 16 * ks + 4);
        u32x4 bw; bw.x = pk2(s0[0], s0[1]); bw.y = pk2(s0[2], s0[3]); bw.z = pk2(s1[0], s1[1]); bw.w = pk2(s1[2], s1[3]);
        const bf16x8 b = __builtin_bit_cast(bf16x8, bw);
#pragma unroll
        for (int tb = 0; tb < 2; ++tb) {
            const bf16x8 a = *(GAS const bf16x8*)(Z + (row0 + 32 * tb + r32) * IN_PAD + C_GQ + h * GDK + 16 * ks + 8 * hh);
            acc[tb] = MFMA32(a, b, acc[tb]);
        }
    }
    LAS float* of = (LAS float*)L;
#pragma unroll
    for (int tb = 0; tb < 2; ++tb)
#pragma unroll
        for (int i = 0; i < 16; ++i) of[(32 * tb + crow(i, hh)) * GO_STR + 32 * w + r32] = acc[tb][i] * 0.08838834764831845f;
    __syncthreads();
    const int tok = tid >> 3, part = tid & 7;
    float v[32]; float ss = 0.f;
#pragma unroll
    for (int i = 0; i < 32; ++i) { v[i] = of[tok * GO_STR + i * 8 + part]; ss += v[i] * v[i]; }
    ss += __shfl_xor(ss, 1); ss += __shfl_xor(ss, 2); ss += __shfl_xor(ss, 4);
    const float rstd = rsqrtf(ss * (1.0f / GDV) + EPS);
    GAS const bf16_t* zg = Z + (row0 + tok) * IN_PAD + C_GG + h * GDV;
    GAS bf16_t* op = mix + (row0 + tok) * DM + 1024 + h * GDV;
#pragma unroll
    for (int i = 0; i < 32; ++i) { const int dv = i * 8 + part; const float g = bf2f(zg[dv]); op[dv] = (bf16_t)f2bf(v[i] * rstd * gnorm[dv] * silu_f(g)); }
    __syncthreads();
}


#define XB_TMO      128
#define XB_XCNT(j)  (256  + 64 * (j))
#define XB_XSUB(j)  (1280 + 64 * (j))
#define XB_XGEN(j)  (2304 + 64 * (j))
#define XB_TOP      3328
#define XB_TOPGEN   3392
#define XCD_BAR_WORDS 3456
#define XB_SPIN_CAP (1u << 22)
__device__ __forceinline__ unsigned xb_ld(unsigned* p)              { return __hip_atomic_load(p, __ATOMIC_RELAXED, __HIP_MEMORY_SCOPE_AGENT); }
__device__ __forceinline__ unsigned xb_add(unsigned* p, unsigned v) { return __hip_atomic_fetch_add(p, v, __ATOMIC_RELAXED, __HIP_MEMORY_SCOPE_AGENT); }
__device__ __forceinline__ unsigned xb_xcc_id() { return (unsigned)__builtin_amdgcn_s_getreg((3 << 11) | 20) & 0xFu; }
#define XB_SPIN(cond, bar) do { unsigned _sp = 0; while (cond) { __builtin_amdgcn_s_sleep(1); \
    if ((++_sp & 255u) == 0u) { if (xb_ld(&(bar)[XB_TMO])) break; if (_sp > XB_SPIN_CAP) { atomicAdd(&(bar)[XB_TMO], 1u); break; } } } } while (0)
struct XcdBarrier { unsigned* bar; unsigned x; volatile LAS unsigned* st; };
__device__ __forceinline__ XcdBarrier xcd_barrier_post(unsigned* bar, volatile LAS unsigned* st) {
    XcdBarrier b; b.bar = bar; b.x = xb_xcc_id(); b.st = st;
    if (threadIdx.x == 0) (void)xb_add(&bar[XB_XCNT(b.x)], 1u);
    return b;
}
__device__ __forceinline__ void xcd_barrier_complete(unsigned* bar, unsigned x, unsigned& nloc, unsigned& nx) {
    const unsigned G = gridDim.x * gridDim.y * gridDim.z;
    unsigned sum, cnt, mine, sp = 0u;
    for (;;) {
        sum = 0u; cnt = 0u; mine = 0u;
#pragma unroll
        for (unsigned j = 0; j < 16; ++j) { const unsigned c = xb_ld(&bar[XB_XCNT(j)]); sum += c; cnt += (c > 0u) ? 1u : 0u; mine = (j == x) ? c : mine; }
        if (sum == G) break;
        __builtin_amdgcn_s_sleep(1);
        if ((++sp & 255u) == 0u) { if (xb_ld(&bar[XB_TMO])) break; if (sp > XB_SPIN_CAP) { atomicAdd(&bar[XB_TMO], 1u); break; } }
    }
    nloc = mine > 0u ? mine : 1u; nx = cnt > 0u ? cnt : 1u;
}
__device__ __forceinline__ void xcd_barrier(const XcdBarrier& b) {
    asm volatile("s_waitcnt vmcnt(0)" ::: "memory");
    __syncthreads();
    if (threadIdx.x == 0) {
        unsigned* bar = b.bar;
        __builtin_amdgcn_s_waitcnt(0);
        unsigned nloc = b.st[0], nx = b.st[1];
        if (nloc == 0u) { xcd_barrier_complete(bar, b.x, nloc, nx); b.st[0] = nloc; b.st[1] = nx; }
        const unsigned old = xb_add(&bar[XB_XSUB(b.x)], 1u);
        const unsigned gen = old / nloc;
        if (old + 1u == (gen + 1u) * nloc) {
            __builtin_amdgcn_fence(__ATOMIC_RELEASE, "agent");
            asm volatile("s_waitcnt vmcnt(0)" ::: "memory");
            const unsigned og = xb_add(&bar[XB_TOP], 1u);
            const unsigned tg = og / nx;
            if (og + 1u == (tg + 1u) * nx) xb_add(&bar[XB_TOPGEN], 1u);
            else XB_SPIN(xb_ld(&bar[XB_TOPGEN]) == tg, bar);
            __builtin_amdgcn_fence(__ATOMIC_ACQUIRE, "agent");
            xb_add(&bar[XB_XGEN(b.x)], 1u);
            asm volatile("s_waitcnt vmcnt(0)" ::: "memory");
        } else {
            XB_SPIN(xb_ld(&bar[XB_XGEN(b.x)]) == gen, bar);
            __builtin_amdgcn_fence(__ATOMIC_ACQUIRE, "agent");
            asm volatile("s_waitcnt vmcnt(0)" ::: "memory");
        }
    }
    __syncthreads();
}

__global__ void __launch_bounds__(512, 2) mk_fwd(Args a) {
    extern __shared__ __attribute__((aligned(16))) unsigned char lds[];
    cg::grid_group grid = cg::this_grid();
    LAS unsigned char* L = (LAS unsigned char*)lds;
    const int G = gridDim.x, bid = blockIdx.x, NGW = G * 8;
    volatile LAS unsigned* MISC = (volatile LAS unsigned*)(L + RING_BYTES + 8192);
    if (threadIdx.x < 4) MISC[threadIdx.x] = 0u;
    __syncthreads();
    { KAP_T kap0 = (KAP_T)__builtin_amdgcn_kernarg_segment_ptr(); (void)xcd_barrier_post((unsigned*)(kap0->ws + WS_BAR), MISC); }
#define XSYNC() do { KAP_T kap_ = (KAP_T)__builtin_amdgcn_kernarg_segment_ptr(); LAUNDER_S(kap_); XcdBarrier xb_; xb_.bar = (unsigned*)(kap_->ws + WS_BAR); xb_.x = xb_xcc_id(); xb_.st = (volatile LAS unsigned*)(L + RING_BYTES + 8192); xcd_barrier(xb_); } while (0)
#define GRID_SYNC() do { asm volatile("s_waitcnt vmcnt(0) lgkmcnt(0)" ::: "memory"); __syncthreads(); grid.sync(); \
    __builtin_amdgcn_fence(__ATOMIC_ACQUIRE, "agent"); asm volatile("s_waitcnt vmcnt(0)" ::: "memory"); __syncthreads(); } while (0)
#ifndef DBG_STOP
#define DBG_STOP 0
#endif
#define DBG_DUMP(k, EXPR) do { if (DBG_STOP == (k)) { PHASE_BEGIN(); for (int m = gw; m < SEQ; m += NGW) for (int c = lane; c < DM; c += 64) out[(size_t)m * DM + c] = (EXPR); return; } } while (0)
#define PHASE_BEGIN() KAP_T kap = (KAP_T)__builtin_amdgcn_kernarg_segment_ptr(); LAUNDER_S(kap); unsigned char* ws = kap->ws; LAUNDER_S(ws); int tid_ = threadIdx.x; LAUNDER_V(tid_); const int tid = tid_, lane = tid & 63, wave = __builtin_amdgcn_readfirstlane(tid >> 6), gw = bid * 8 + wave; \
    u64* ssq = (u64*)(ws + WS_SSQ); (void)lane; (void)gw; (void)ssq; \
    u64* ssq_x = ssq + (size_t)l * SEQ; u64* ssq_xn = ssq + (size_t)(l + 1) * SEQ; u64* ssq_cq = ssq + (size_t)(3 + l) * SEQ; u64* ssq_ckv = ssq + (size_t)(5 + l) * SEQ; u64* ssq_x1 = ssq + (size_t)(7 + l) * SEQ; \
    (void)ssq_x; (void)ssq_xn; (void)ssq_cq; (void)ssq_ckv; (void)ssq_x1; \
    bf16_t* Win = (bf16_t*)(ws + WS_WIN); bf16_t* Wuq = (bf16_t*)(ws + WS_WUQ); bf16_t* Wukv = (bf16_t*)(ws + WS_WUKV); \
    bf16_t* Wout = (bf16_t*)(ws + WS_WOUT); bf16_t* Wup = (bf16_t*)(ws + WS_WUP); bf16_t* Wdn = (bf16_t*)(ws + WS_WDN); \
    bf16_t* XB = (bf16_t*)(ws + WS_XB); bf16_t* Z = (bf16_t*)(ws + WS_Z); bf16_t* Qb = (bf16_t*)(ws + WS_Q); bf16_t* Kb = (bf16_t*)(ws + WS_K); bf16_t* Vt = (bf16_t*)(ws + WS_VT); \
    float* ST = (float*)(ws + WS_ST); float* DEC = (float*)(ws + WS_DEC); bf16_t* MIX = (bf16_t*)(ws + WS_MIX); \
    bf16_t* ACT = (bf16_t*)(ws + WS_ACT); float* EDGE = (float*)(ws + WS_EDGE); \
    const float* xin = kap->in[0]; float* out = kap->out; \
    (void)Win; (void)Wuq; (void)Wukv; (void)Wout; (void)Wup; (void)Wdn; (void)XB; (void)Z; (void)Qb; (void)Kb; (void)Vt; (void)ST; (void)DEC; (void)MIX; (void)EDGE; (void)ACT; (void)xin; (void)out;

    for (int l = 0; l < NLAYER; ++l) {
        {
            PHASE_BEGIN();
            LAS float* scr = (LAS float*)(L + wave * 16384);
            const float* w_in = kap->in[3] + (size_t)l * DM * IN_DIM; const float* w_uq = kap->in[5] + (size_t)l * QLORA * QW; const float* w_ukv = kap->in[7] + (size_t)l * KVLORA * KVW;
            const float* w_out = kap->in[14] + (size_t)l * DM * DM; const float* w_up = kap->in[16] + (size_t)l * DM * DFF2; const float* w_dn = kap->in[19] + (size_t)l * DFF * DM;
            const float* g_attn = kap->in[2] + l * DM; const float* g_cq = kap->in[4] + l * QLORA; const float* g_ckv = kap->in[6] + l * KVLORA; const float* g_mla = kap->in[13] + l * 1024; const float* g_ffn = kap->in[15] + l * DM;
            constexpr int I_IN = (DM / 64) * (IN_PAD / 32), I_UQ = (QLORA / 64) * (QW / 32), I_UKV = (KVLORA / 64) * (KVW / 32), I_OUT = (DM / 64) * (DM / 32), I_UP = (DM / 64) * (DFF2 / 32), I_DN = (DFF / 64) * (DM / 32);
            constexpr int NITEMS = I_IN + I_UQ + I_UKV + I_OUT + I_UP + I_DN;
            for (int it = gw; it < NITEMS; it += NGW) {
                int r = it;
                if (r < I_IN) { wt_item(w_in, DM, IN_DIM, g_attn, DM, Win, scr, r, IN_PAD / 32, lane); continue; } r -= I_IN;
                if (r < I_UQ) { wt_item(w_uq, QLORA, QW, g_cq, QLORA, Wuq, scr, r, QW / 32, lane); continue; } r -= I_UQ;
                if (r < I_UKV) { wt_item(w_ukv, KVLORA, KVW, g_ckv, KVLORA, Wukv, scr, r, KVW / 32, lane); continue; } r -= I_UKV;
                if (r < I_OUT) { wt_item(w_out, DM, DM, g_mla, 1024, Wout, scr, r, DM / 32, lane); continue; } r -= I_OUT;
                if (r < I_UP) { wt_item(w_up, DM, DFF2, g_ffn, DM, Wup, scr, r, DFF2 / 32, lane, true); continue; } r -= I_UP;
                wt_item(w_dn, DFF, DM, g_ffn, 0, Wdn, scr, r, DM / 32, lane);
            }
            if (l == 0) {
                for (int m = gw; m < SEQ; m += NGW) {
                    GAS const f32x4* xr = (GAS const f32x4*)(G_(xin) + (size_t)m * DM) + lane; float s = 0.f;
                    GAS u32x2* o8 = (GAS u32x2*)(G_(XB) + (size_t)m * DM) + lane;
#pragma unroll
                    for (int j = 0; j < 8; ++j) { const f32x4 v = xr[64 * j]; s += (v[0] * v[0] + v[1] * v[1]) + (v[2] * v[2] + v[3] * v[3]); o8[64 * j] = (u32x2){pk2(v[0], v[1]), pk2(v[2], v[3])}; }
                    s = wave_sum(s); if (lane == 0) G_(ssq_x)[m] = (u64)(s * SSQ_FX + 0.5f);
                }
            }
        }
        if (l == 0) GRID_SYNC(); else XSYNC();
        {
            PHASE_BEGIN();
            pg8::Gemm g{XB, Win, SEQ, IN_PAD, DM, DM}; pg8::StaticOrder S; S.init(SEQ, IN_PAD, G, bid);
            pg8::EpiRowScale E{Z, IN_PAD, ssq_x, 1.0f / DM, ssq_cq, 0, 2, ssq_ckv, 2, 3};
            pg8::gemm_phase<pg8::EpiRowScale>(L, g, S, E);
        }
        XSYNC();
        DBG_DUMP(1, bf2f(Z[(size_t)m * IN_PAD + c]) + bf2f(Z[(size_t)m * IN_PAD + 2048 + c]));
        {
            PHASE_BEGIN();
            { pg8::Gemm g{Z + C_CQ, Wuq, SEQ, QW, QLORA, IN_PAD}; pg8::StaticOrder S; S.init(SEQ, QW, G, bid);
              pg8::EpiRowScale E{Qb, QW, ssq_cq, 1.0f / QLORA, nullptr, 0, 0, nullptr, 0, 0};
              pg8::gemm_phase<pg8::EpiRowScale>(L, g, S, E); }
            { pg8::Gemm g{Z + C_CKV, Wukv, SEQ, KVW, KVLORA, IN_PAD}; pg8::StaticOrder S; S.init(SEQ, KVW, G, bid);
              pg8::EpiUkv E{Kb, Vt, ssq_ckv, 1.0f / KVLORA};
              pg8::gemm_phase<pg8::EpiUkv>(L, g, S, E); }
            const float* wgate = kap->in[10] + (size_t)l * 16 * (GH * GDK); const float* bgate = kap->in[11] + (size_t)l * (GH * GDK);
            for (int u = bid; u < NCHUNK * GH; u += G) gla_chunk_unit(L, Z, wgate, bgate, ST, DEC, u >> 2, u & 3);
        }
        XSYNC();
        DBG_DUMP(2, (c < QW ? bf2f(Qb[(size_t)m * QW + c]) + bf2f(Kb[(size_t)m * QW + c]) : bf2f(Vt[(size_t)(c - QW) * SEQ + m])) + ST[(size_t)m * 8192 + c] + ST[(size_t)m * 8192 + 4096 + c]);
        {
            PHASE_BEGIN();
            const int* pos = (const int*)kap->in[1];
            const float* qn = kap->in[8] + l * QKD; const float* kn = kap->in[9] + l * QKD;
            const float qscale = 0.07216878364870322f * 1.4426950408889634f;
            for (int m = gw; m < SEQ; m += NGW) {
                const int i = lane & 31;
                const float ang = (float)G_(pos)[m] * kap->inv_freq[i];
                double rev = (double)ang * 0.15915494309189535; rev -= __builtin_rint(rev);
                const float sn = __builtin_amdgcn_sinf((float)rev), cs = __builtin_amdgcn_cosf((float)rev);
                const float krv = bf2f(G_(Z)[(size_t)m * IN_PAD + C_KR + lane]);
                GAS bf16_t* qp = G_(Qb) + (size_t)m * QW; GAS bf16_t* kp = G_(Kb) + (size_t)m * QW;
                float qa[NH][3], ka[NH][2], qs[NH], ks[NH];
#pragma unroll
                for (int h = 0; h < NH; ++h) { qa[h][0] = bf2f(qp[h * QKD + lane]); qa[h][1] = bf2f(qp[h * QKD + 64 + lane]); qa[h][2] = bf2f(qp[h * QKD + 128 + lane]);
                                               ka[h][0] = bf2f(kp[h * QKD + lane]); ka[h][1] = bf2f(kp[h * QKD + 64 + lane]); }
#pragma unroll
                for (int h = 0; h < NH; ++h) { qs[h] = qa[h][0] * qa[h][0] + qa[h][1] * qa[h][1] + qa[h][2] * qa[h][2]; ks[h] = ka[h][0] * ka[h][0] + ka[h][1] * ka[h][1] + krv * krv; }
#pragma unroll
                for (int o = 1; o < 64; o <<= 1)
#pragma unroll
                    for (int h = 0; h < NH; ++h) { qs[h] += __shfl_xor(qs[h], o); ks[h] += __shfl_xor(ks[h], o); }
                const float qg0 = G_(qn)[lane], qg1 = G_(qn)[64 + lane], qg2 = G_(qn)[128 + lane], kg0 = G_(kn)[lane], kg1 = G_(kn)[64 + lane], kg2 = G_(kn)[128 + lane];
#pragma unroll
                for (int h = 0; h < NH; ++h) {
                    { const float rstd = rsqrtf(qs[h] * (1.0f / QKD) + EPS);
                      const float n2 = qa[h][2] * rstd * qg2, pr = __shfl_xor(n2, 32);
                      const float r2 = (lane < 32) ? n2 * cs - pr * sn : n2 * cs + pr * sn;
                      qp[h * QKD + lane] = (bf16_t)f2bf(qa[h][0] * rstd * qg0 * qscale); qp[h * QKD + 64 + lane] = (bf16_t)f2bf(qa[h][1] * rstd * qg1 * qscale); qp[h * QKD + 128 + lane] = (bf16_t)f2bf(r2 * qscale); }
                    { const float rstd = rsqrtf(ks[h] * (1.0f / QKD) + EPS);
                      const float n2 = krv * rstd * kg2, pr = __shfl_xor(n2, 32);
                      const float r2 = (lane < 32) ? n2 * cs - pr * sn : n2 * cs + pr * sn;
                      kp[h * QKD + lane] = (bf16_t)f2bf(ka[h][0] * rstd * kg0); kp[h * QKD + 64 + lane] = (bf16_t)f2bf(ka[h][1] * rstd * kg1); kp[h * QKD + 128 + lane] = (bf16_t)f2bf(r2); }
                }
            }
            constexpr int NE = GH * GDV * GDK;
            for (int e = bid * 512 + tid; e < NE; e += G * 512) {
                const int hd = (e >> 15) * GDK + (e & 127);
                float s = 0.f;
                for (int c0 = 0; c0 < NCHUNK; c0 += 8) {
                    float uu[8], dd[8];
#pragma unroll
                    for (int i = 0; i < 8; ++i) { uu[i] = G_(ST)[(size_t)(c0 + i) * NE + e]; dd[i] = G_(DEC)[(size_t)(c0 + i) * (GH * GDK) + hd]; }
#pragma unroll
                    for (int i = 0; i < 8; ++i) { s = s * dd[i] + uu[i]; G_(ST)[(size_t)(c0 + i) * NE + e] = s; }
                }
            }
        }
        XSYNC();
        DBG_DUMP(3, (c < QW ? bf2f(Qb[(size_t)m * QW + c]) + bf2f(Kb[(size_t)m * QW + c]) : 0.f) + ST[(size_t)m * 8192 + c] + ST[(size_t)m * 8192 + 4096 + c]);
        {
            PHASE_BEGIN();
            for (int p = bid; p < 256; p += G) {
                const int h = p & 7, s = p >> 3;
                attn_unit(L, Qb, Kb, Vt, MIX, h, 63 - s);
                attn_unit(L, Qb, Kb, Vt, MIX, h, s);
            }
            const float* gnorm = kap->in[12] + l * GDV;
            for (int u = bid; u < NCHUNK * GH; u += G) gla_out_unit(L, Z, ST, gnorm, MIX, u >> 2, u & 3);
        }
        XSYNC();
        DBG_DUMP(4, bf2f(MIX[(size_t)m * DM + c]));
        { PHASE_BEGIN();
        for (int m = gw; m < SEQ; m += NGW) {
            GAS u32x4* p = (GAS u32x4*)(G_(MIX) + (size_t)m * DM) + lane;
            u32x4 v0 = p[0], v1 = p[64]; float s = 0.f;
#pragma unroll
            for (int j = 0; j < 4; ++j) { const float a0 = bflo(v0[j]), a1 = bfhi(v0[j]), b0 = bflo(v1[j]), b1 = bfhi(v1[j]); s += a0 * a0 + a1 * a1 + b0 * b0 + b1 * b1; }
            const float rstd = rsqrtf(wave_sum(s) * (1.0f / 1024.0f) + EPS);
#pragma unroll
            for (int j = 0; j < 4; ++j) { v0[j] = pk2(bflo(v0[j]) * rstd, bfhi(v0[j]) * rstd); v1[j] = pk2(bflo(v1[j]) * rstd, bfhi(v1[j]) * rstd); }
            p[0] = v0; p[64] = v1;
        } }
        XSYNC();
        DBG_DUMP(5, bf2f(MIX[(size_t)m * DM + c]));
        {
            PHASE_BEGIN();
            pg8::Gemm g{MIX, Wout, SEQ, DM, DM, DM}; pg8::StaticOrder S; S.init(SEQ, DM, G, bid);
            pg8::EpiRes E{l == 0 ? xin : out, out, XB, ssq_x1};
            pg8::gemm_phase<pg8::EpiRes>(L, g, S, E);
        }
        XSYNC();
        DBG_DUMP(6, out[(size_t)m * DM + c] + bf2f(XB[(size_t)m * DM + c]));
        {
            PHASE_BEGIN();
            const float* cw = kap->in[17] + (size_t)l * 3 * DFF2; const float* cb = kap->in[18] + (size_t)l * DFF2;
            pg8::Gemm g{XB, Wup, SEQ, DFF2, DM, DM}; pg8::StaticOrder S; S.init(SEQ, DFF2, G, bid);
            pg8::EpiUpConv E{ACT, EDGE, ssq_x1, cw, cb, (LAS float*)(L + RING_BYTES)};
            pg8::gemm_phase<pg8::EpiUpConv>(L, g, S, E);
        }
        XSYNC();
        {
            PHASE_BEGIN();
            const float* cw = kap->in[17] + (size_t)l * 3 * DFF2; const float* cb = kap->in[18] + (size_t)l * DFF2;
            for (int idx = bid * 512 + tid; idx < 63 * DFF; idx += G * 512) {
                const int pm = 1 + idx / DFF, gcol = idx % DFF;
                float y0[2], y1[2];
#pragma unroll
                for (int q = 0; q < 2; ++q) { const int c = q * DFF + gcol;
                    const float um2 = G_(EDGE)[(size_t)((pm - 1) * 4 + 2) * DFF2 + c], um1 = G_(EDGE)[(size_t)((pm - 1) * 4 + 3) * DFF2 + c], u0 = G_(EDGE)[(size_t)(pm * 4 + 0) * DFF2 + c], u1 = G_(EDGE)[(size_t)(pm * 4 + 1) * DFF2 + c];
                    const float w0 = G_(cw)[c], w1 = G_(cw)[DFF2 + c], w2 = G_(cw)[2 * DFF2 + c], bb = G_(cb)[c];
                    y0[q] = bb + w0 * um2 + w1 * um1 + w2 * u0; y1[q] = bb + w0 * um1 + w1 * u0 + w2 * u1; }
                G_(ACT)[(size_t)(pm * 256) * DFF + gcol] = (bf16_t)f2bf(silu_f(y0[0]) * y0[1]);
                G_(ACT)[(size_t)(pm * 256 + 1) * DFF + gcol] = (bf16_t)f2bf(silu_f(y1[0]) * y1[1]);
            }
        }
        XSYNC();
        DBG_DUMP(8, bf2f(ACT[(size_t)m * DFF + c]) + bf2f(ACT[(size_t)m * DFF + 3000 + c]));
        {
            PHASE_BEGIN();
            pg8::Gemm g{ACT, Wdn, SEQ, DM, DFF, DFF}; pg8::StaticOrder S; S.init(SEQ, DM, G, bid);
            pg8::EpiRes E{out, out, XB, ssq_xn};
            pg8::gemm_phase<pg8::EpiRes>(L, g, S, E);
        }
        XSYNC();
        if (DBG_STOP == 9) return;
    }
}

extern "C" void kernel_launch(void* const* d_in, const int* in_sizes, int n_in, void* d_out, int out_size, void* d_ws, size_t ws_size, hipStream_t stream) {
    static int grid = 0;
    if (grid == 0) {
        if (n_in != 20 || out_size != SEQ * DM || ws_size < WS_END) { fprintf(stderr, "kernel_launch: unexpected shapes: n_in %d out %d ws %zu (need %zu)\n", n_in, out_size, ws_size, (size_t)WS_END); grid = -1; return; }
        int dev = 0, cus = 0, per_cu = 0;
        hipGetDevice(&dev); hipDeviceGetAttribute(&cus, hipDeviceAttributeMultiprocessorCount, dev);
        hipFuncSetAttribute((const void*)mk_fwd, hipFuncAttributeMaxDynamicSharedMemorySize, LDS_BYTES);
        hipOccupancyMaxActiveBlocksPerMultiprocessor(&per_cu, (const void*)mk_fwd, 512, LDS_BYTES);
        (void)hipGetLastError();
        if (per_cu < 1) per_cu = 1;
        grid = cus * 1;
    }
    if (grid < 0) return;
    hipMemsetAsync((char*)d_ws + WS_CTL, 0, CTL_BYTES, stream);
    Args a{};
    for (int i = 0; i < 20; ++i) a.in[i] = (const float*)d_in[i];
    a.out = (float*)d_out; a.ws = (unsigned char*)d_ws;
    for (int i = 0; i < 32; ++i) a.inv_freq[i] = (float)pow(10000.0, -(double)i / 32.0);
    void* args[] = {&a};
    hipError_t e = hipLaunchCooperativeKernel((const void*)mk_fwd, dim3(grid), dim3(512), args, LDS_BYTES, stream);
    if (e != hipSuccess) fprintf(stderr, "cooperative launch failed: %s (grid %d)\n", hipGetErrorString(e), grid);
}
```

```cpp
#include <hip/hip_runtime.h>
#include <hip/hip_cooperative_groups.h>
#include <cstdio>
#include <cstdint>
#include <cmath>
namespace cg = cooperative_groups;

#define LAS __attribute__((address_space(3)))
typedef unsigned short bf16_t;
typedef unsigned long long u64;
typedef short bf16x8 __attribute__((ext_vector_type(8)));
typedef short s16x4 __attribute__((ext_vector_type(4)));
typedef float f32x4 __attribute__((ext_vector_type(4)));
typedef float f32x16 __attribute__((ext_vector_type(16)));
typedef unsigned u32x4 __attribute__((ext_vector_type(4)));
typedef unsigned u32x2 __attribute__((ext_vector_type(2)));
typedef float f32x2_t __attribute__((ext_vector_type(2)));
typedef __bf16 bf16x2_t __attribute__((ext_vector_type(2)));

constexpr int SEQ = 16384, DM = 2048, NLAYER = 2;
constexpr int IN_DIM = 3920, IN_PAD = 4096;
constexpr int C_CQ = 0, C_CKV = 512, C_KR = 768, C_GQ = 832, C_GK = 1344, C_GV = 1856, C_GA = 2880, C_GG = 2896;
constexpr int QLORA = 512, KVLORA = 256, NH = 8, QKD = 192, NOPE = 128, VD = 128, QW = NH * QKD  , KVW = NH * 256  ;
constexpr int GH = 4, GDK = 128, GDV = 256, NCHUNK = SEQ / 64;
constexpr int DFF = 5632, DFF2 = 11264;
constexpr float EPS = 1e-6f;

constexpr size_t MiB = 1u << 20;
constexpr size_t WS_CTL = 0, CTL_BYTES = 2 * MiB;
constexpr size_t WS_BAR = 0;
constexpr size_t WS_SSQ = 65536;
constexpr size_t WS_WIN = 2 * MiB, WS_WUQ = 18 * MiB, WS_WUKV = WS_WUQ + 3 * MiB / 2, WS_WOUT = WS_WUKV + 1 * MiB, WS_WUP = WS_WOUT + 8 * MiB, WS_WDN = WS_WUP + 44 * MiB;
constexpr size_t WS_XB = 95 * MiB;
constexpr size_t WS_R = 159 * MiB;
constexpr size_t WS_Z = WS_R, WS_Q = WS_Z + 128 * MiB, WS_K = WS_Q + 48 * MiB, WS_VT = WS_K + 48 * MiB, WS_ST = WS_VT + 32 * MiB, WS_DEC = WS_ST + 128 * MiB, WS_MIX = WS_DEC + 1 * MiB;
constexpr size_t WS_ACT = WS_R, WS_EDGE = WS_ACT + 176 * MiB, WS_END = WS_MIX + 64 * MiB;
static_assert(WS_EDGE + 12 * MiB <= WS_END, "ws map");

#define GAS __attribute__((address_space(1)))
template <class T> __device__ __forceinline__ GAS T* G_(T* p) { return (GAS T*)p; }
#define LAUNDER_V(x) asm volatile("" : "+v"(x))
#define LAUNDER_S(x) asm volatile("" : "+s"(x))
__device__ __forceinline__ unsigned f2bf(float f) { unsigned u = __builtin_bit_cast(unsigned, f); return (u + 0x7fffu + ((u >> 16) & 1u)) >> 16; }
__device__ __forceinline__ unsigned pk2(float lo, float hi) { f32x2_t v = {lo, hi}; bf16x2_t b = __builtin_convertvector(v, bf16x2_t); return __builtin_bit_cast(unsigned, b); }
__device__ __forceinline__ float bf2f(unsigned b) { return __builtin_bit_cast(float, b << 16); }
__device__ __forceinline__ float bflo(unsigned w) { return __builtin_bit_cast(float, w << 16); }
__device__ __forceinline__ float bfhi(unsigned w) { return __builtin_bit_cast(float, w & 0xffff0000u); }
__device__ __forceinline__ float wave_sum(float v) {
#pragma unroll
    for (int o = 1; o < 64; o <<= 1) v += __shfl_xor(v, o);
    return v;
}
constexpr float SSQ_FX = 1048576.0f, SSQ_INV = 1.0f / 1048576.0f;
__device__ __forceinline__ void ssq_add(u64* p, float v) { __hip_atomic_fetch_add((GAS u64*)p, (u64)(v * SSQ_FX + 0.5f), __ATOMIC_RELAXED, __HIP_MEMORY_SCOPE_AGENT); }
__device__ __forceinline__ float ssq_get(const u64* p) { return (float)(*(GAS const u64*)p) * SSQ_INV; }
__device__ __forceinline__ float silu_f(float x) { return x * __builtin_amdgcn_rcpf(1.0f + __expf(-x)); }

namespace pg8 {
constexpr int BM = 256, BK = 64, HALF = 128, HTB = HALF * BK * 2, STAGE_BYTES = 8 * HTB, NXCD = 8, WGM = 8;
__host__ __device__ __forceinline__ int lds_byte(int r, int c) { const int st = (r >> 4) * 2 + (c >> 5), rr = r & 15, cc = c & 31, ob = rr * 64 + cc * 2; return st * 1024 + (ob ^ (((ob >> 9) & 1) << 5)); }
__host__ __device__ __forceinline__ void stage_rc(int b, int& R, int& C) { const int st = b / 1024, sb = b % 1024, swz = sb ^ (((sb >> 9) & 1) << 5); R = (st >> 1) * 16 + swz / 64; C = (st & 1) * 32 + (swz % 64) / 2; }
__host__ __device__ __forceinline__ int perm32(int rho) { const int n = rho >> 4, i = rho & 15; return 8 * (i >> 2) + 4 * n + (i & 3); }

struct Unit { int pm, pn; };
struct Gemm { const bf16_t* A; const bf16_t* Bt; int M, N, K, lda; };

struct StaticOrder {
    int nM, nN, nwg, G, c;
    __device__ void init(int M, int N, int G_, int c_) { nM = M / BM; nN = N / BM; nwg = nM * nN; G = G_; c = c_; }
    __device__ bool next(int i, Unit& u) const {
        const long L = (long)i * G + c; if (L >= nwg) return false;
        int wgid = (int)L; { const int q = nwg / NXCD, r = nwg % NXCD, xcd = wgid % NXCD, off = wgid / NXCD; wgid = (xcd < r ? xcd * (q + 1) : r * (q + 1) + (xcd - r) * q) + off; }
        const int nig = WGM * nN, gid = wgid / nig, fm = gid * WGM, gsz = (nM - fm) < WGM ? (nM - fm) : WGM;
        u.pm = fm + ((wgid % nig) % gsz); u.pn = (wgid % nig) / gsz; return true;
    }
};

struct EpiRowScale {
    static constexpr bool PERM = true;
    bf16_t* O; int ldc; const u64* ssq_in; float inv_dim; u64* ssq_a; int a_lo, a_hi; u64* ssq_b; int b_lo, b_hi;
    __device__ __forceinline__ void operator()(const f32x4 (&acc)[2][2][4][2], const Unit& u, int wr, int wc, int fr, int fq) const {
        const int row0 = u.pm * BM + wr * 64 + fr, col0 = u.pn * BM + wc * 32 + 8 * fq;
        u64* sacc = (u.pn >= a_lo && u.pn < a_hi) ? ssq_a : ((u.pn >= b_lo && u.pn < b_hi) ? ssq_b : nullptr);
#pragma unroll
        for (int ai = 0; ai < 2; ++ai)
#pragma unroll
            for (int m = 0; m < 4; ++m) {
                const int row = row0 + ai * HALF + m * 16;
                const float sc = ssq_in ? rsqrtf(ssq_get(ssq_in + row) * inv_dim + EPS) : 1.0f;
                float ss = 0.f;
#pragma unroll
                for (int bj = 0; bj < 2; ++bj) {
                    const f32x4 v0 = acc[ai][bj][m][0] * sc, v1 = acc[ai][bj][m][1] * sc;
                    ss += (v0[0] * v0[0] + v0[1] * v0[1]) + (v0[2] * v0[2] + v0[3] * v0[3]) + (v1[0] * v1[0] + v1[1] * v1[1]) + (v1[2] * v1[2] + v1[3] * v1[3]);
                    u32x4 w; w.x = pk2(v0[0], v0[1]); w.y = pk2(v0[2], v0[3]); w.z = pk2(v1[0], v1[1]); w.w = pk2(v1[2], v1[3]);
                    *(GAS u32x4*)(G_(O) + (size_t)row * ldc + col0 + bj * HALF) = w;
                }
                if (sacc) { ss += __shfl_xor(ss, 16); ss += __shfl_xor(ss, 32); if (fq == 0) ssq_add(sacc + row, ss); }
            }
    }
};
struct EpiUkv {
    static constexpr bool PERM = true;
    bf16_t* Kb; bf16_t* Vt; const u64* ssq_in; float inv_dim;
    __device__ __forceinline__ void operator()(const f32x4 (&acc)[2][2][4][2], const Unit& u, int wr, int wc, int fr, int fq) const {
        const int row0 = u.pm * BM + wr * 64 + fr, c0 = wc * 32 + 8 * fq;
#pragma unroll
        for (int ai = 0; ai < 2; ++ai)
#pragma unroll
            for (int m = 0; m < 4; ++m) {
                const int row = row0 + ai * HALF + m * 16;
                const int prow = (row & ~15) | (row & 3) | ((row & 4) << 1) | ((row & 8) >> 1);
                const float sc = rsqrtf(ssq_get(ssq_in + row) * inv_dim + EPS);
                { const f32x4 v0 = acc[ai][0][m][0] * sc, v1 = acc[ai][0][m][1] * sc;
                  u32x4 w; w.x = pk2(v0[0], v0[1]); w.y = pk2(v0[2], v0[3]); w.z = pk2(v1[0], v1[1]); w.w = pk2(v1[2], v1[3]);
                  *(GAS u32x4*)(G_(Kb) + (size_t)row * QW + u.pn * QKD + c0) = w; }
#pragma unroll
                for (int n = 0; n < 2; ++n)
#pragma unroll
                    for (int j = 0; j < 4; ++j) G_(Vt)[(size_t)(u.pn * VD + c0 + 4 * n + j) * SEQ + prow] = (bf16_t)f2bf(acc[ai][1][m][n][j] * sc);
            }
    }
};
struct EpiRes {
    static constexpr bool PERM = true;
    const float* base; float* out; bf16_t* xb; u64* ssq_out;
    __device__ __forceinline__ void operator()(const f32x4 (&acc)[2][2][4][2], const Unit& u, int wr, int wc, int fr, int fq) const {
        const int row0 = u.pm * BM + wr * 64 + fr, col0 = u.pn * BM + wc * 32 + 8 * fq;
#pragma unroll
        for (int ai = 0; ai < 2; ++ai)
#pragma unroll
            for (int m = 0; m < 4; ++m) {
                const int row = row0 + ai * HALF + m * 16; float ss = 0.f;
#pragma unroll
                for (int bj = 0; bj < 2; ++bj) {
                    const size_t off = (size_t)row * DM + col0 + bj * HALF;
                    const f32x4 v0 = acc[ai][bj][m][0] + *(GAS const f32x4*)(G_(base) + off), v1 = acc[ai][bj][m][1] + *(GAS const f32x4*)(G_(base) + off + 4);
                    ss += (v0[0] * v0[0] + v0[1] * v0[1]) + (v0[2] * v0[2] + v0[3] * v0[3]) + (v1[0] * v1[0] + v1[1] * v1[1]) + (v1[2] * v1[2] + v1[3] * v1[3]);
                    *(GAS f32x4*)(G_(out) + off) = v0; *(GAS f32x4*)(G_(out) + off + 4) = v1;
                    u32x4 w; w.x = pk2(v0[0], v0[1]); w.y = pk2(v0[2], v0[3]); w.z = pk2(v1[0], v1[1]); w.w = pk2(v1[2], v1[3]);
                    *(GAS u32x4*)(G_(xb) + off) = w;
                }
                ss += __shfl_xor(ss, 16); ss += __shfl_xor(ss, 32); if (fq == 0) ssq_add(ssq_out + row, ss);
            }
    }
};


#define DPP_SHR1(old, src) __builtin_bit_cast(float, __builtin_amdgcn_update_dpp(__builtin_bit_cast(int, (float)(old)), __builtin_bit_cast(int, (float)(src)), 0x111, 0xf, 0xf, false))
#define DPP_SHR2(old, src) __builtin_bit_cast(float, __builtin_amdgcn_update_dpp(__builtin_bit_cast(int, (float)(old)), __builtin_bit_cast(int, (float)(src)), 0x112, 0xf, 0xf, false))
#define DPP_ROR1(src) __builtin_bit_cast(float, __builtin_amdgcn_update_dpp(0, __builtin_bit_cast(int, (float)(src)), 0x121, 0xf, 0xf, false))
#define DPP_ROR2(src) __builtin_bit_cast(float, __builtin_amdgcn_update_dpp(0, __builtin_bit_cast(int, (float)(src)), 0x122, 0xf, 0xf, false))
struct EpiUpConv {
    static constexpr bool PERM = true;
    bf16_t* ACT; float* EDGE; const u64* ssq_in; const float* cw; const float* cb; LAS float* halo;
    __device__ __forceinline__ void operator()(f32x4 (&acc)[2][2][4][2], const Unit& u, int wr, int wc, int fr, int fq) const {
        const int row0 = u.pm * BM + wr * 64 + fr;
        const int g0 = u.pn * 128 + wc * 32 + 8 * fq;
#pragma unroll
        for (int ai = 0; ai < 2; ++ai)
#pragma unroll
            for (int m = 0; m < 4; ++m) {
                const float sc = rsqrtf(ssq_get(ssq_in + row0 + ai * HALF + m * 16) * (1.0f / DM) + EPS);
#pragma unroll
                for (int bj = 0; bj < 2; ++bj)
#pragma unroll
                    for (int n = 0; n < 2; ++n) acc[ai][bj][m][n] = acc[ai][bj][m][n] * sc;
            }
        if (fr >= 14) {
#pragma unroll
            for (int ai = 0; ai < 2; ++ai) { LAS float* hp = halo + ((((2 * ai + wr) * 4 + wc) * 2 + (fr - 14)) * 4 + fq) * 16;
#pragma unroll
                for (int bj = 0; bj < 2; ++bj)
#pragma unroll
                    for (int n = 0; n < 2; ++n) *(LAS f32x4*)(hp + bj * 8 + n * 4) = acc[ai][bj][3][n]; }
            if (wr == 1) { GAS float* ep = G_(EDGE) + (size_t)(u.pm * 4 + 2 + fr - 14) * DFF2 + g0;
#pragma unroll
                for (int bj = 0; bj < 2; ++bj)
#pragma unroll
                    for (int n = 0; n < 2; ++n) *(GAS f32x4*)(ep + bj * DFF + 4 * n) = acc[1][bj][3][n]; }
        }
        if (fr < 2 && wr == 0) { GAS float* ep = G_(EDGE) + (size_t)(u.pm * 4 + fr) * DFF2 + g0;
#pragma unroll
            for (int bj = 0; bj < 2; ++bj)
#pragma unroll
                for (int n = 0; n < 2; ++n) *(GAS f32x4*)(ep + bj * DFF + 4 * n) = acc[0][bj][0][n]; }
        asm volatile("s_waitcnt lgkmcnt(0)" ::: "memory"); __builtin_amdgcn_s_barrier(); asm volatile("" ::: "memory");
#pragma unroll
        for (int n = 0; n < 2; ++n) {
            const int gc = g0 + 4 * n;
            GAS const float* cwg = G_(cw); GAS const float* cbg = G_(cb);
            const f32x4 wg0 = *(GAS const f32x4*)(cwg + gc), wg1 = *(GAS const f32x4*)(cwg + DFF2 + gc), wg2 = *(GAS const f32x4*)(cwg + 2 * DFF2 + gc), bgv = *(GAS const f32x4*)(cbg + gc);
            const f32x4 wu0 = *(GAS const f32x4*)(cwg + DFF + gc), wu1 = *(GAS const f32x4*)(cwg + DFF2 + DFF + gc), wu2 = *(GAS const f32x4*)(cwg + 2 * DFF2 + DFF + gc), buv = *(GAS const f32x4*)(cbg + DFF + gc);
#pragma unroll
            for (int ai = 0; ai < 2; ++ai) {
                const int band = 2 * ai + wr;
                f32x4 pg = (f32x4){0.f, 0.f, 0.f, 0.f}, pu = pg;
                if (band > 0) { const LAS float* hp = halo + ((((band - 1) * 4 + wc) * 2 + (fr & 1)) * 4 + fq) * 16; pg = *(const LAS f32x4*)(hp + n * 4); pu = *(const LAS f32x4*)(hp + 8 + n * 4); }
#pragma unroll
                for (int m = 0; m < 4; ++m) {
                    const f32x4 cg = acc[ai][0][m][n], cu = acc[ai][1][m][n];
                    float av[4];
#pragma unroll
                    for (int j = 0; j < 4; ++j) {
                        const float g1 = DPP_SHR1(DPP_ROR1(pg[j]), cg[j]), g2 = DPP_SHR2(DPP_ROR2(pg[j]), cg[j]);
                        const float u1 = DPP_SHR1(DPP_ROR1(pu[j]), cu[j]), u2 = DPP_SHR2(DPP_ROR2(pu[j]), cu[j]);
                        const float yg = bgv[j] + wg0[j] * g2 + wg1[j] * g1 + wg2[j] * cg[j];
                        const float yu = buv[j] + wu0[j] * u2 + wu1[j] * u1 + wu2[j] * cu[j];
                        av[j] = silu_f(yg) * yu;
                    }
                    *(GAS u32x2*)(G_(ACT) + (size_t)(row0 + ai * HALF + m * 16) * DFF + gc) = (u32x2){pk2(av[0], av[1]), pk2(av[2], av[3])};
                    pg = cg; pu = cu;
                }
            }
        }
    }
};

template <class Epi>
__device__ __forceinline__ void gemm_phase(LAS unsigned char* lds, const Gemm g, const StaticOrder& S, const Epi& E) {
    int tid_ = threadIdx.x; LAUNDER_V(tid_);
    const int tid = tid_, wid = __builtin_amdgcn_readfirstlane(tid >> 6), lane = tid & 63, wr = wid >> 2, wc = wid & 3, fr = lane & 15, fq = lane >> 4;
    const int K = g.K, nt = K / BK;
    unsigned voffA[2], voffB[2];
#pragma unroll
    for (int i = 0; i < 2; ++i) { int R, C; stage_rc(tid * 16 + i * 8192, R, C); const int Rb = Epi::PERM ? ((R & ~31) + perm32(R & 31)) : R;
        voffA[i] = (unsigned)(R * g.lda + C) * 2u; voffB[i] = (unsigned)(Rb * K + C) * 2u; }
    const size_t kstep = (size_t)(BK * 2);
    const size_t hstepA = (size_t)HALF * g.lda * 2, hstepB = (size_t)HALF * K * 2;
    const size_t tstepA = 2 * hstepA, tstepB = 2 * hstepB;
    const unsigned ldsw = (unsigned)wid * 1024u;
    const int aoff = lds_byte(wr * 64 + fr, fq * 8), boff = lds_byte(wc * 32 + fr, fq * 8);
#define PG8_SA(b, h) (((b) * 2 + (h)) * HTB)
#define PG8_SB(b, h) ((4 + (b) * 2 + (h)) * HTB)
#define PG8_STAGE(bufoff, gbase, voff) do { _Pragma("unroll") for (int _i = 0; _i < 2; ++_i) \
        __builtin_amdgcn_global_load_lds((const unsigned*)((const char*)(gbase) + (voff)[_i]), (LAS unsigned*)(lds + (bufoff) + ldsw + _i * 8192), 16, 0, 0); } while (0)
#define PG8_LDA(dst, b, h) do { _Pragma("unroll") for (int m = 0; m < 4; ++m) _Pragma("unroll") for (int k = 0; k < 2; ++k) dst[m][k] = *(const LAS bf16x8*)(lds + PG8_SA(b, h) + aoff + m * 2048 + k * 1024); } while (0)
#define PG8_LDB(dst, b, h) do { _Pragma("unroll") for (int n = 0; n < 2; ++n) _Pragma("unroll") for (int k = 0; k < 2; ++k) dst[n][k] = *(const LAS bf16x8*)(lds + PG8_SB(b, h) + boff + n * 2048 + k * 1024); } while (0)
#define PG8_MMA(ai, bj, At, Bt) do { __builtin_amdgcn_s_setprio(1); _Pragma("unroll") for (int m = 0; m < 4; ++m) _Pragma("unroll") for (int n = 0; n < 2; ++n) _Pragma("unroll") for (int k = 0; k < 2; ++k) \
        acc[ai][bj][m][n] = __builtin_amdgcn_mfma_f32_16x16x32_bf16(Bt[n][k], At[m][k], acc[ai][bj][m][n], 0, 0, 0); __builtin_amdgcn_s_setprio(0); } while (0)
#define PG8_WAIT_V(n) asm volatile("s_waitcnt vmcnt(" #n ")" ::: "memory")
#define PG8_WAIT_L(n) asm volatile("s_waitcnt lgkmcnt(" #n ")" ::: "memory")
#define PG8_BAR __builtin_amdgcn_s_barrier()
#define PG8_SCHED __builtin_amdgcn_sched_barrier(0)
    Unit cur, nxt; int ui = 0;
    if (!S.next(0, cur)) return;
    f32x4 acc[2][2][4][2];
#pragma unroll
    for (int a = 0; a < 2; ++a)
#pragma unroll
        for (int b = 0; b < 2; ++b)
#pragma unroll
            for (int m = 0; m < 4; ++m)
#pragma unroll
                for (int n = 0; n < 2; ++n) acc[a][b][m][n] = (f32x4){0.f, 0.f, 0.f, 0.f};
    bf16x8 At[4][2], B0[2][2], B1[2][2];
    const char* cA = (const char*)g.A + (size_t)cur.pm * tstepA; const char* cB = (const char*)g.Bt + (size_t)cur.pn * tstepB;
    PG8_STAGE(PG8_SB(0, 0), cB, voffB); PG8_STAGE(PG8_SB(0, 1), cB + hstepB, voffB); PG8_STAGE(PG8_SA(0, 0), cA, voffA); PG8_STAGE(PG8_SA(0, 1), cA + hstepA, voffA);
    if (wr == 1) PG8_BAR;
    PG8_WAIT_V(2); PG8_BAR;
    PG8_STAGE(PG8_SB(1, 0), cB + kstep, voffB); PG8_STAGE(PG8_SA(1, 0), cA + kstep, voffA); PG8_STAGE(PG8_SB(1, 1), cB + hstepB + kstep, voffB);
    PG8_WAIT_V(6); PG8_BAR;
    for (;;) {
        const bool has_next = S.next(ui + 1, nxt);
        const char* nA = has_next ? (const char*)g.A + (size_t)nxt.pm * tstepA : cA; const char* nB = has_next ? (const char*)g.Bt + (size_t)nxt.pn * tstepB : cB;
        for (int t = 0; t < nt; t += 2) {
            const bool last = (t == nt - 2);
            const char* a1 = cA + (size_t)(t + 1) * kstep;
            const char* a2 = last ? nA : cA + (size_t)(t + 2) * kstep; const char* b2 = last ? nB : cB + (size_t)(t + 2) * kstep;
            const char* a3 = a2 + kstep; const char* b3 = b2 + kstep;
            PG8_LDB(B0, 0, 0); PG8_LDB(B1, 0, 1); PG8_SCHED; PG8_LDA(At, 0, 0); PG8_STAGE(PG8_SA(1, 1), a1 + hstepA, voffA);
            PG8_WAIT_V(8); PG8_WAIT_L(0); PG8_BAR; PG8_MMA(0, 0, At, B0); PG8_MMA(0, 1, At, B1); PG8_BAR; PG8_SCHED;
            PG8_LDA(At, 0, 1); PG8_STAGE(PG8_SB(0, 0), b2, voffB); PG8_STAGE(PG8_SB(0, 1), b2 + hstepB, voffB); PG8_STAGE(PG8_SA(0, 0), a2, voffA);
            PG8_WAIT_V(8); PG8_WAIT_L(0); PG8_BAR; PG8_MMA(1, 0, At, B0); PG8_MMA(1, 1, At, B1); PG8_BAR; PG8_SCHED;
            PG8_LDB(B0, 1, 0); PG8_LDB(B1, 1, 1); PG8_SCHED; PG8_LDA(At, 1, 0); PG8_STAGE(PG8_SA(0, 1), a2 + hstepA, voffA);
            PG8_WAIT_V(8); PG8_WAIT_L(0); PG8_BAR; PG8_MMA(0, 0, At, B0); PG8_MMA(0, 1, At, B1); PG8_BAR; PG8_SCHED;
            PG8_LDA(At, 1, 1); PG8_STAGE(PG8_SB(1, 0), b3, voffB); PG8_STAGE(PG8_SB(1, 1), b3 + hstepB, voffB); PG8_STAGE(PG8_SA(1, 0), a3, voffA);
            PG8_WAIT_V(8); PG8_WAIT_L(0); PG8_BAR; PG8_MMA(1, 0, At, B0); PG8_MMA(1, 1, At, B1); PG8_BAR; PG8_SCHED;
        }
        if (wr == 0) PG8_BAR;
        { int frE = fr, fqE = fq; LAUNDER_V(frE); LAUNDER_V(fqE); E(acc, cur, wr, wc, frE, fqE); }
        if (!has_next) break;
#pragma unroll
        for (int a = 0; a < 2; ++a)
#pragma unroll
            for (int b = 0; b < 2; ++b)
#pragma unroll
                for (int m = 0; m < 4; ++m)
#pragma unroll
                    for (int n = 0; n < 2; ++n) acc[a][b][m][n] = (f32x4){0.f, 0.f, 0.f, 0.f};
        cur = nxt; cA = nA; cB = nB; ++ui;
        if (wr == 1) PG8_BAR;
    }
    PG8_WAIT_V(0);
    PG8_BAR;
#undef PG8_SA
#undef PG8_SB
#undef PG8_STAGE
#undef PG8_LDA
#undef PG8_LDB
#undef PG8_MMA
#undef PG8_WAIT_V
#undef PG8_WAIT_L
#undef PG8_BAR
#undef PG8_SCHED
}
}

constexpr int RING_BYTES = 131072;
constexpr int LDS_BYTES = 147456;

struct Args { const float* in[20]; float* out; unsigned char* ws; float inv_freq[32]; };
typedef const __attribute__((address_space(4))) Args* KAP_T;

#define DS_READ4(r0, r1, r2, r3, addr, o0, o1, o2, o3) asm volatile("ds_read_b128 %0, %4 offset:%5\n\tds_read_b128 %1, %4 offset:%6\n\tds_read_b128 %2, %4 offset:%7\n\tds_read_b128 %3, %4 offset:%8" \
    : "=&v"(r0), "=&v"(r1), "=&v"(r2), "=&v"(r3) : "v"(addr), "i"(o0), "i"(o1), "i"(o2), "i"(o3) : "memory")
#define LGKM_WAIT4(n, r0, r1, r2, r3) asm volatile("s_waitcnt lgkmcnt(" #n ")" : "+v"(r0), "+v"(r1), "+v"(r2), "+v"(r3) :: "memory")
#define MFMA32(a, b, c) __builtin_amdgcn_mfma_f32_32x32x16_bf16((a), (b), (c), 0, 0, 0)
__device__ __forceinline__ int crow(int r, int hi) { return (r & 3) + 8 * (r >> 2) + 4 * hi; }

__device__ __forceinline__ void wt_item(const float* __restrict__ W, int K, int N, const float* __restrict__ gain, int gainK, bf16_t* WT, LAS float* scr, int item, int nblk, int lane, bool remap_up = false) {
    const int kb = item / nblk, nb = item % nblk, k0 = 64 * kb, n0 = 32 * nb;
    const int ns0 = remap_up ? (((n0 & 255) < 128) ? 128 * (n0 >> 8) + (n0 & 255) : DFF + 128 * (n0 >> 8) + (n0 & 255) - 128) : n0;
    const int n = ns0 + (lane & 31);
    float wv[32];
#pragma unroll
    for (int i = 0; i < 32; ++i) { const int kk = 2 * i + (lane >> 5); wv[i] = (n < N) ? G_(W)[(size_t)(k0 + kk) * N + n] : 0.f; }
#pragma unroll
    for (int i = 0; i < 32; ++i) { const int kk = 2 * i + (lane >> 5); scr[kk * 33 + (lane & 31)] = wv[i]; }
    asm volatile("s_waitcnt lgkmcnt(0)" ::: "memory");
    const int c = lane & 7;
    f32x4 g0 = (f32x4){1.f, 1.f, 1.f, 1.f}, g1 = g0;
    if (k0 < gainK) { g0 = *(GAS const f32x4*)(G_(gain) + k0 + 8 * c); g1 = *(GAS const f32x4*)(G_(gain) + k0 + 8 * c + 4); }
#pragma unroll
    for (int j = 0; j < 4; ++j) { const int nn = (lane >> 3) + 8 * j; const LAS float* s = scr + (8 * c) * 33 + nn;
        u32x4 o; o.x = pk2(s[0 * 33] * g0[0], s[1 * 33] * g0[1]); o.y = pk2(s[2 * 33] * g0[2], s[3 * 33] * g0[3]); o.z = pk2(s[4 * 33] * g1[0], s[5 * 33] * g1[1]); o.w = pk2(s[6 * 33] * g1[2], s[7 * 33] * g1[3]);
        *(GAS u32x4*)(G_(WT) + (size_t)(n0 + nn) * K + k0 + 8 * c) = o; }
    asm volatile("s_waitcnt lgkmcnt(0)" ::: "memory");
}

constexpr int AT_KSTR = 400, AT_VSTR = 144;
constexpr int AT_KB = 64 * AT_KSTR  , AT_VB = 128 * AT_VSTR  , AT_K0 = 0, AT_V0 = 2 * AT_KB, AT_WSF = AT_V0 + 2 * AT_VB;
static_assert(AT_WSF + 8 * 128 <= RING_BYTES, "attn lds");

__device__ __forceinline__ void attn_unit(LAS unsigned char* L, const bf16_t* Q_, const bf16_t* Kg_, const bf16_t* Vt_, bf16_t* mix_, int h, int qb) {
    GAS const bf16_t* Q = G_(Q_); GAS const bf16_t* Kg = G_(Kg_); GAS const bf16_t* Vt = G_(Vt_); GAS bf16_t* mix = G_(mix_);
    int tid_ = threadIdx.x; LAUNDER_V(tid_);
    const int tid = tid_, lane = tid & 63, w = __builtin_amdgcn_readfirstlane(tid >> 6), r32 = lane & 31, hh = lane >> 5;
    const int q0 = qb * 256;
    bf16x8 qf[12];
    { GAS const bf16_t* qrow = Q + (size_t)(q0 + 32 * w + r32) * QW + h * QKD + 8 * hh;
#pragma unroll
      for (int ks = 0; ks < 12; ++ks) qf[ks] = *(GAS const bf16x8*)(qrow + 16 * ks); }
    f32x16 o[4];
#pragma unroll
    for (int d = 0; d < 4; ++d)
#pragma unroll
        for (int i = 0; i < 16; ++i) o[d][i] = 0.f;
    float l_run = 0.f;
    const int NT = 4 * qb + 4, my_last = 4 * qb + (w >> 1);
    volatile LAS float* wsf = (volatile LAS float*)(L + AT_WSF) + w * 32;
    const unsigned lds_base = (unsigned)(uintptr_t)L;
    u32x4 kst[3], vst[2];
#define AT_GLOAD(t) do { const int kv0_ = (t) * 64; int x_ = tid; LAUNDER_V(x_); \
    _Pragma("unroll") for (int i = 0; i < 3; ++i) { const int id_ = x_ + 512 * i, r_ = id_ / 24, c_ = id_ - 24 * r_; kst[i] = *(GAS const u32x4*)(Kg + (size_t)(kv0_ + r_) * QW + h * QKD + c_ * 8); } \
    _Pragma("unroll") for (int i = 0; i < 2; ++i) { const int id_ = x_ + 512 * i; vst[i] = *(GAS const u32x4*)(Vt + (size_t)(h * VD + (id_ >> 3)) * SEQ + kv0_ + (id_ & 7) * 8); } } while (0)
#define AT_SSTORE(buf) do { int x_ = tid; LAUNDER_V(x_); \
    _Pragma("unroll") for (int i = 0; i < 3; ++i) { const int id_ = x_ + 512 * i, r_ = id_ / 24, c_ = id_ - 24 * r_; *(LAS u32x4*)(L + AT_K0 + (buf) * AT_KB + r_ * AT_KSTR + c_ * 16) = kst[i]; } \
    _Pragma("unroll") for (int i = 0; i < 2; ++i) { const int id_ = x_ + 512 * i; *(LAS u32x4*)(L + AT_V0 + (buf) * AT_VB + (id_ >> 3) * AT_VSTR + (id_ & 7) * 16) = vst[i]; } } while (0)
    AT_GLOAD(0); AT_SSTORE(0); __syncthreads();
    for (int t = 0; t < NT; ++t) {
        const int buf = t & 1;
        if (t + 1 < NT) AT_GLOAD(t + 1);
        if (t <= my_last) {
            const unsigned kaddr = lds_base + AT_K0 + buf * AT_KB + r32 * AT_KSTR + hh * 16;
            const unsigned vaddr = lds_base + AT_V0 + buf * AT_VB + r32 * AT_VSTR + hh * 16;
            f32x16 p0, p1;
#pragma unroll
            for (int i = 0; i < 16; ++i) { p0[i] = 0.f; p1[i] = 0.f; }
            bf16x8 fa0, fa1, fa2, fa3, fb0, fb1, fb2, fb3;
#define QK_RD(s0, s1, s2, s3, kb, g) DS_READ4(s0, s1, s2, s3, kaddr, (kb) * 32 * AT_KSTR + (4 * (g)) * 32, (kb) * 32 * AT_KSTR + (4 * (g) + 1) * 32, (kb) * 32 * AT_KSTR + (4 * (g) + 2) * 32, (kb) * 32 * AT_KSTR + (4 * (g) + 3) * 32)
#define QK_MM(s0, s1, s2, s3, P, g) do { P = MFMA32(s0, qf[4 * (g)], P); P = MFMA32(s1, qf[4 * (g) + 1], P); P = MFMA32(s2, qf[4 * (g) + 2], P); P = MFMA32(s3, qf[4 * (g) + 3], P); } while (0)
#define PV_RD(s0, s1, s2, s3, kb, ss) DS_READ4(s0, s1, s2, s3, vaddr, (kb) * 64 + (ss) * 32, 32 * AT_VSTR + (kb) * 64 + (ss) * 32, 64 * AT_VSTR + (kb) * 64 + (ss) * 32, 96 * AT_VSTR + (kb) * 64 + (ss) * 32)
#define PV_PK(P, ss) __builtin_bit_cast(bf16x8, (u32x4){pk2(P[8 * (ss) + 0], P[8 * (ss) + 1]), pk2(P[8 * (ss) + 2], P[8 * (ss) + 3]), pk2(P[8 * (ss) + 4], P[8 * (ss) + 5]), pk2(P[8 * (ss) + 6], P[8 * (ss) + 7])})
#define PV_MM(s0, s1, s2, s3, xs) do { o[0] = MFMA32(xs, s0, o[0]); o[1] = MFMA32(xs, s1, o[1]); o[2] = MFMA32(xs, s2, o[2]); o[3] = MFMA32(xs, s3, o[3]); } while (0)
            QK_RD(fa0, fa1, fa2, fa3, 0, 0);
            QK_RD(fb0, fb1, fb2, fb3, 0, 1); LGKM_WAIT4(4, fa0, fa1, fa2, fa3); QK_MM(fa0, fa1, fa2, fa3, p0, 0);
            QK_RD(fa0, fa1, fa2, fa3, 0, 2); LGKM_WAIT4(4, fb0, fb1, fb2, fb3); QK_MM(fb0, fb1, fb2, fb3, p0, 1);
            QK_RD(fb0, fb1, fb2, fb3, 1, 0); LGKM_WAIT4(4, fa0, fa1, fa2, fa3); QK_MM(fa0, fa1, fa2, fa3, p0, 2);
            float ls0 = 0.f, ls1 = 0.f;
#pragma unroll
            for (int i = 0; i < 16; ++i) { p0[i] = __builtin_amdgcn_exp2f(fminf(p0[i], 100.f)); ls0 += p0[i]; }
            QK_RD(fa0, fa1, fa2, fa3, 1, 1); LGKM_WAIT4(4, fb0, fb1, fb2, fb3); QK_MM(fb0, fb1, fb2, fb3, p1, 0);
            QK_RD(fb0, fb1, fb2, fb3, 1, 2); LGKM_WAIT4(4, fa0, fa1, fa2, fa3); QK_MM(fa0, fa1, fa2, fa3, p1, 1);
            PV_RD(fa0, fa1, fa2, fa3, 0, 0); LGKM_WAIT4(4, fb0, fb1, fb2, fb3); QK_MM(fb0, fb1, fb2, fb3, p1, 2);
            { const bf16x8 x00 = PV_PK(p0, 0), x01 = PV_PK(p0, 1);
#pragma unroll
              for (int i = 0; i < 16; ++i) { p1[i] = __builtin_amdgcn_exp2f(fminf(p1[i], 100.f)); ls1 += p1[i]; }
              PV_RD(fb0, fb1, fb2, fb3, 0, 1); LGKM_WAIT4(4, fa0, fa1, fa2, fa3); PV_MM(fa0, fa1, fa2, fa3, x00);
              PV_RD(fa0, fa1, fa2, fa3, 1, 0); LGKM_WAIT4(4, fb0, fb1, fb2, fb3); PV_MM(fb0, fb1, fb2, fb3, x01);
              const bf16x8 x10 = PV_PK(p1, 0), x11 = PV_PK(p1, 1);
              PV_RD(fb0, fb1, fb2, fb3, 1, 1); LGKM_WAIT4(4, fa0, fa1, fa2, fa3); PV_MM(fa0, fa1, fa2, fa3, x10);
              LGKM_WAIT4(0, fb0, fb1, fb2, fb3); PV_MM(fb0, fb1, fb2, fb3, x11); }
            l_run += ls0 + ls1;
#undef QK_RD
#undef QK_MM
#undef PV_RD
#undef PV_PK
#undef PV_MM
        }
        if (t + 1 < NT) AT_SSTORE(buf ^ 1);
        __syncthreads();
    }
#undef AT_GLOAD
#undef AT_SSTORE
    const float lt = l_run + __shfl_xor(l_run, 32);
    wsf[r32] = 1.0f / lt;
    asm volatile("s_waitcnt lgkmcnt(0)" ::: "memory");
    GAS bf16_t* orow = mix + (size_t)(q0 + 32 * w) * DM + h * VD + r32;
#pragma unroll
    for (int i = 0; i < 16; ++i) { const int qr = crow(i, hh); const float a = wsf[qr];
#pragma unroll
        for (int d = 0; d < 4; ++d) orow[(size_t)qr * DM + 32 * d] = (bf16_t)f2bf(o[d][i] * a); }
    __syncthreads();
}

constexpr int GL_V = 0  , GL_KD = 32768  , GL_TOT = GL_KD + 18432  , GL_ZA = GL_TOT + 2048  ;
__device__ __forceinline__ void gla_chunk_unit(LAS unsigned char* L, const bf16_t* Z_, const float* wgate_, const float* bgate_, bf16_t* ST_, float* DEC_, int c, int h) {
    GAS const bf16_t* Z = G_(Z_); GAS const float* wgate = G_(wgate_); GAS const float* bgate = G_(bgate_); GAS bf16_t* ST = G_(ST_); GAS float* DEC = G_(DEC_);
    int tid_ = threadIdx.x; LAUNDER_V(tid_);
    const int tid = tid_, lane = tid & 63, w = __builtin_amdgcn_readfirstlane(tid >> 6), r32 = lane & 31, hh = lane >> 5;
    const size_t row0 = (size_t)c * 64;
#pragma unroll
    for (int i = 0; i < 4; ++i) { const int id = tid + 512 * i, r = id >> 5, cc = id & 31;
        *(LAS u32x4*)(L + GL_V + r * 512 + cc * 16) = *(GAS const u32x4*)(Z + (row0 + r) * IN_PAD + C_GV + h * GDV + cc * 8); }
#pragma unroll
    for (int i = 0; i < 2; ++i) { const int id = tid + 512 * i, r = id >> 4, cc = id & 15;
        ((LAS float*)(L + GL_ZA))[id] = bf2f(Z[(row0 + r) * IN_PAD + C_GA + cc]); }
    __syncthreads();
    const int tq = tid >> 7, col = tid & 127;
    float wg[16];
#pragma unroll
    for (int r = 0; r < 16; ++r) wg[r] = wgate[r * (GH * GDK) + h * GDK + col];
    const float bg = bgate[h * GDK + col];
    float pre[16]; float run = 0.f;
#pragma unroll
    for (int i = 0; i < 16; ++i) {
        const LAS float* za = (const LAS float*)(L + GL_ZA) + (16 * tq + i) * 16;
        float ga = bg;
#pragma unroll
        for (int r = 0; r < 16; ++r) ga += za[r] * wg[r];
        const float ls = fminf(ga, 0.f) - __logf(1.0f + __expf(-fabsf(ga)));
        run += ls * (1.0f / 16.0f); pre[i] = run;
    }
    ((LAS float*)(L + GL_TOT))[tq * 128 + col] = run;
    __syncthreads();
    float off = 0.f, bend = 0.f;
#pragma unroll
    for (int t = 0; t < 4; ++t) { const float v = ((LAS float*)(L + GL_TOT))[t * 128 + col]; bend += v; if (t < tq) off += v; }
    {
        unsigned pkv[8];
#pragma unroll
        for (int i = 0; i < 16; i += 2) {
            const float k0 = bf2f(Z[(row0 + 16 * tq + i) * IN_PAD + C_GK + h * GDK + col]), k1 = bf2f(Z[(row0 + 16 * tq + i + 1) * IN_PAD + C_GK + h * GDK + col]);
            pkv[i >> 1] = pk2(k0 * __expf(bend - off - pre[i]), k1 * __expf(bend - off - pre[i + 1]));
        }
        LAS u32x4* dst = (LAS u32x4*)(L + GL_KD + col * 144 + tq * 32);
        dst[0] = (u32x4){pkv[0], pkv[1], pkv[2], pkv[3]}; dst[1] = (u32x4){pkv[4], pkv[5], pkv[6], pkv[7]};
    }
    if (tq == 0) DEC[(size_t)(c * GH + h) * GDK + col] = __expf(bend);
    __syncthreads();
    f32x16 acc[4];
#pragma unroll
    for (int d = 0; d < 4; ++d)
#pragma unroll
        for (int i = 0; i < 16; ++i) acc[d][i] = 0.f;
#pragma unroll
    for (int ks = 0; ks < 4; ++ks) {
        bf16x8 a;
#pragma unroll
        for (int j = 0; j < 8; ++j) a[j] = (short)*(const LAS unsigned short*)(L + GL_V + (16 * ks + 8 * hh + j) * 512 + (32 * w + r32) * 2);
#pragma unroll
        for (int db = 0; db < 4; ++db) {
            const bf16x8 b = *(const LAS bf16x8*)(L + GL_KD + (32 * db + r32) * 144 + (16 * ks + 8 * hh) * 2);
            acc[db] = MFMA32(a, b, acc[db]);
        }
    }
    GAS bf16_t* stp = ST + ((size_t)(c * GH + h) * GDV + 32 * w) * GDK + r32;
#pragma unroll
    for (int db = 0; db < 4; ++db)
#pragma unroll
        for (int i = 0; i < 16; ++i) stp[(size_t)crow(i, hh) * GDK + 32 * db] = (bf16_t)f2bf(acc[db][i]);
    __syncthreads();
}

constexpr int GO_STR = 260;
__device__ __forceinline__ void gla_out_unit(LAS unsigned char* L, const bf16_t* Z_, const bf16_t* ST_, const float* gnorm_, bf16_t* mix_, int c, int h) {
    GAS const bf16_t* Z = G_(Z_); GAS const bf16_t* ST = G_(ST_); GAS const float* gnorm = G_(gnorm_); GAS bf16_t* mix = G_(mix_);
    int tid_ = threadIdx.x; LAUNDER_V(tid_);
    const int tid = tid_, lane = tid & 63, w = __builtin_amdgcn_readfirstlane(tid >> 6), r32 = lane & 31, hh = lane >> 5;
    const size_t row0 = (size_t)c * 64;
    f32x16 acc[2];
#pragma unroll
    for (int d = 0; d < 2; ++d)
#pragma unroll
        for (int i = 0; i < 16; ++i) acc[d][i] = 0.f;
    GAS const bf16_t* sp = ST + ((size_t)(c * GH + h) * GDV + 32 * w + r32) * GDK + 8 * hh;
#pragma unroll
    for (int ks = 0; ks < 8; ++ks) {
        const bf16x8 b = *(GAS const bf16x8*)(sp + 16 * ks);
#pragma unroll
        for (int tb = 0; tb < 2; ++tb) {
            const bf16x8 a = *(GAS const bf16x8*)(Z + (row0 + 32 * tb + r32) * IN_PAD + C_GQ + h * GDK + 16 * ks + 8 * hh);
            acc[tb] = MFMA32(a, b, acc[tb]);
        }
    }
    LAS float* of = (LAS float*)L;
#pragma unroll
    for (int tb = 0; tb < 2; ++tb)
#pragma unroll
        for (int i = 0; i < 16; ++i) of[(32 * tb + crow(i, hh)) * GO_STR + 32 * w + r32] = acc[tb][i] * 0.08838834764831845f;
    __syncthreads();
    const int tok = tid >> 3, part = tid & 7;
    float v[32]; float ss = 0.f;
#pragma unroll
    for (int i = 0; i < 32; ++i) { v[i] = of[tok * GO_STR + i * 8 + part]; ss += v[i] * v[i]; }
    ss += __shfl_xor(ss, 1); ss += __shfl_xor(ss, 2); ss += __shfl_xor(ss, 4);
    const float rstd = rsqrtf(ss * (1.0f / GDV) + EPS);
    GAS const bf16_t* zg = Z + (row0 + tok) * IN_PAD + C_GG + h * GDV;
    GAS bf16_t* op = mix + (row0 + tok) * DM + 1024 + h * GDV;
#pragma unroll
    for (int i = 0; i < 32; ++i) { const int dv = i * 8 + part; const float g = bf2f(zg[dv]); op[dv] = (bf16_t)f2bf(v[i] * rstd * gnorm[dv] * silu_f(g)); }
    __syncthreads();
}


#define XB_TMO      128
#define XB_XCNT(j)  (256  + 64 * (j))
#define XB_XSUB(j)  (1280 + 64 * (j))
#define XB_XGEN(j)  (2304 + 64 * (j))
#define XB_TOP      3328
#define XB_TOPGEN   3392
#define XCD_BAR_WORDS 3456
#define XB_SPIN_CAP (1u << 22)
__device__ __forceinline__ unsigned xb_ld(unsigned* p)              { return __hip_atomic_load(p, __ATOMIC_RELAXED, __HIP_MEMORY_SCOPE_AGENT); }
__device__ __forceinline__ unsigned xb_add(unsigned* p, unsigned v) { return __hip_atomic_fetch_add(p, v, __ATOMIC_RELAXED, __HIP_MEMORY_SCOPE_AGENT); }
__device__ __forceinline__ unsigned xb_xcc_id() { return (unsigned)__builtin_amdgcn_s_getreg((3 << 11) | 20) & 0xFu; }
#define XB_SPIN(cond, bar) do { unsigned _sp = 0; while (cond) { __builtin_amdgcn_s_sleep(1); \
    if ((++_sp & 255u) == 0u) { if (xb_ld(&(bar)[XB_TMO])) break; if (_sp > XB_SPIN_CAP) { atomicAdd(&(bar)[XB_TMO], 1u); break; } } } } while (0)
struct XcdBarrier { unsigned* bar; unsigned x; volatile LAS unsigned* st; };
__device__ __forceinline__ XcdBarrier xcd_barrier_post(unsigned* bar, volatile LAS unsigned* st) {
    XcdBarrier b; b.bar = bar; b.x = xb_xcc_id(); b.st = st;
    if (threadIdx.x == 0) (void)xb_add(&bar[XB_XCNT(b.x)], 1u);
    return b;
}
__device__ __forceinline__ void xcd_barrier_complete(unsigned* bar, unsigned x, unsigned& nloc, unsigned& nx) {
    const unsigned G = gridDim.x * gridDim.y * gridDim.z;
    unsigned sum, cnt, mine, sp = 0u;
    for (;;) {
        sum = 0u; cnt = 0u; mine = 0u;
#pragma unroll
        for (unsigned j = 0; j < 16; ++j) { const unsigned c = xb_ld(&bar[XB_XCNT(j)]); sum += c; cnt += (c > 0u) ? 1u : 0u; mine = (j == x) ? c : mine; }
        if (sum == G) break;
        __builtin_amdgcn_s_sleep(1);
        if ((++sp & 255u) == 0u) { if (xb_ld(&bar[XB_TMO])) break; if (sp > XB_SPIN_CAP) { atomicAdd(&bar[XB_TMO], 1u); break; } }
    }
    nloc = mine > 0u ? mine : 1u; nx = cnt > 0u ? cnt : 1u;
}
__device__ __forceinline__ void xcd_barrier(const XcdBarrier& b) {
    asm volatile("s_waitcnt vmcnt(0)" ::: "memory");
    __syncthreads();
    if (threadIdx.x == 0) {
        unsigned* bar = b.bar;
        __builtin_amdgcn_s_waitcnt(0);
        unsigned nloc = b.st[0], nx = b.st[1];
        if (nloc == 0u) { xcd_barrier_complete(bar, b.x, nloc, nx); b.st[0] = nloc; b.st[1] = nx; }
        const unsigned old = xb_add(&bar[XB_XSUB(b.x)], 1u);
        const unsigned gen = old / nloc;
        if (old + 1u == (gen + 1u) * nloc) {
            __builtin_amdgcn_fence(__ATOMIC_RELEASE, "agent");
            asm volatile("s_waitcnt vmcnt(0)" ::: "memory");
            const unsigned og = xb_add(&bar[XB_TOP], 1u);
            const unsigned tg = og / nx;
            if (og + 1u == (tg + 1u) * nx) xb_add(&bar[XB_TOPGEN], 1u);
            else XB_SPIN(xb_ld(&bar[XB_TOPGEN]) == tg, bar);
            __builtin_amdgcn_fence(__ATOMIC_ACQUIRE, "agent");
            xb_add(&bar[XB_XGEN(b.x)], 1u);
            asm volatile("s_waitcnt vmcnt(0)" ::: "memory");
        } else {
            XB_SPIN(xb_ld(&bar[XB_XGEN(b.x)]) == gen, bar);
            __builtin_amdgcn_fence(__ATOMIC_ACQUIRE, "agent");
            asm volatile("s_waitcnt vmcnt(0)" ::: "memory");
        }
    }
    __syncthreads();
}

__global__ void __launch_bounds__(512, 2) mk_fwd(Args a) {
    extern __shared__ __attribute__((aligned(16))) unsigned char lds[];
    cg::grid_group grid = cg::this_grid();
    LAS unsigned char* L = (LAS unsigned char*)lds;
    const int G = gridDim.x, bid = blockIdx.x, NGW = G * 8;
    volatile LAS unsigned* MISC = (volatile LAS unsigned*)(L + RING_BYTES + 8192);
    if (threadIdx.x < 4) MISC[threadIdx.x] = 0u;
    __syncthreads();
    { KAP_T kap0 = (KAP_T)__builtin_amdgcn_kernarg_segment_ptr(); (void)xcd_barrier_post((unsigned*)(kap0->ws + WS_BAR), MISC); }
#define XSYNC() do { KAP_T kap_ = (KAP_T)__builtin_amdgcn_kernarg_segment_ptr(); LAUNDER_S(kap_); XcdBarrier xb_; xb_.bar = (unsigned*)(kap_->ws + WS_BAR); xb_.x = xb_xcc_id(); xb_.st = (volatile LAS unsigned*)(L + RING_BYTES + 8192); xcd_barrier(xb_); } while (0)
#define GRID_SYNC() do { asm volatile("s_waitcnt vmcnt(0) lgkmcnt(0)" ::: "memory"); __syncthreads(); grid.sync(); \
    __builtin_amdgcn_fence(__ATOMIC_ACQUIRE, "agent"); asm volatile("s_waitcnt vmcnt(0)" ::: "memory"); __syncthreads(); } while (0)
#ifndef DBG_STOP
#define DBG_STOP 0
#endif
#define DBG_DUMP(k, EXPR) do { if (DBG_STOP == (k)) { PHASE_BEGIN(); for (int m = gw; m < SEQ; m += NGW) for (int c = lane; c < DM; c += 64) out[(size_t)m * DM + c] = (EXPR); return; } } while (0)
#define PHASE_BEGIN() KAP_T kap = (KAP_T)__builtin_amdgcn_kernarg_segment_ptr(); LAUNDER_S(kap); unsigned char* ws = kap->ws; LAUNDER_S(ws); int tid_ = threadIdx.x; LAUNDER_V(tid_); const int tid = tid_, lane = tid & 63, wave = __builtin_amdgcn_readfirstlane(tid >> 6), gw = bid * 8 + wave; \
    u64* ssq = (u64*)(ws + WS_SSQ); (void)lane; (void)gw; (void)ssq; \
    u64* ssq_x = ssq + (size_t)l * SEQ; u64* ssq_xn = ssq + (size_t)(l + 1) * SEQ; u64* ssq_cq = ssq + (size_t)(3 + l) * SEQ; u64* ssq_ckv = ssq + (size_t)(5 + l) * SEQ; u64* ssq_x1 = ssq + (size_t)(7 + l) * SEQ; \
    (void)ssq_x; (void)ssq_xn; (void)ssq_cq; (void)ssq_ckv; (void)ssq_x1; \
    bf16_t* Win = (bf16_t*)(ws + WS_WIN); bf16_t* Wuq = (bf16_t*)(ws + WS_WUQ); bf16_t* Wukv = (bf16_t*)(ws + WS_WUKV); \
    bf16_t* Wout = (bf16_t*)(ws + WS_WOUT); bf16_t* Wup = (bf16_t*)(ws + WS_WUP); bf16_t* Wdn = (bf16_t*)(ws + WS_WDN); \
    bf16_t* XB = (bf16_t*)(ws + WS_XB); bf16_t* Z = (bf16_t*)(ws + WS_Z); bf16_t* Qb = (bf16_t*)(ws + WS_Q); bf16_t* Kb = (bf16_t*)(ws + WS_K); bf16_t* Vt = (bf16_t*)(ws + WS_VT); \
    bf16_t* ST = (bf16_t*)(ws + WS_ST); float* DEC = (float*)(ws + WS_DEC); bf16_t* MIX = (bf16_t*)(ws + WS_MIX); \
    bf16_t* ACT = (bf16_t*)(ws + WS_ACT); float* EDGE = (float*)(ws + WS_EDGE); \
    const float* xin = kap->in[0]; float* out = kap->out; \
    (void)Win; (void)Wuq; (void)Wukv; (void)Wout; (void)Wup; (void)Wdn; (void)XB; (void)Z; (void)Qb; (void)Kb; (void)Vt; (void)ST; (void)DEC; (void)MIX; (void)EDGE; (void)ACT; (void)xin; (void)out;

    for (int l = 0; l < NLAYER; ++l) {
        {
            PHASE_BEGIN();
            LAS float* scr = (LAS float*)(L + wave * 16384);
            const float* w_in = kap->in[3] + (size_t)l * DM * IN_DIM; const float* w_uq = kap->in[5] + (size_t)l * QLORA * QW; const float* w_ukv = kap->in[7] + (size_t)l * KVLORA * KVW;
            const float* w_out = kap->in[14] + (size_t)l * DM * DM; const float* w_up = kap->in[16] + (size_t)l * DM * DFF2; const float* w_dn = kap->in[19] + (size_t)l * DFF * DM;
            const float* g_attn = kap->in[2] + l * DM; const float* g_cq = kap->in[4] + l * QLORA; const float* g_ckv = kap->in[6] + l * KVLORA; const float* g_mla = kap->in[13] + l * 1024; const float* g_ffn = kap->in[15] + l * DM;
            constexpr int I_IN = (DM / 64) * (IN_PAD / 32), I_UQ = (QLORA / 64) * (QW / 32), I_UKV = (KVLORA / 64) * (KVW / 32), I_OUT = (DM / 64) * (DM / 32), I_UP = (DM / 64) * (DFF2 / 32), I_DN = (DFF / 64) * (DM / 32);
            constexpr int NITEMS = I_IN + I_UQ + I_UKV + I_OUT + I_UP + I_DN;
            for (int it = gw; it < NITEMS; it += NGW) {
                int r = it;
                if (r < I_IN) { wt_item(w_in, DM, IN_DIM, g_attn, DM, Win, scr, r, IN_PAD / 32, lane); continue; } r -= I_IN;
                if (r < I_UQ) { wt_item(w_uq, QLORA, QW, g_cq, QLORA, Wuq, scr, r, QW / 32, lane); continue; } r -= I_UQ;
                if (r < I_UKV) { wt_item(w_ukv, KVLORA, KVW, g_ckv, KVLORA, Wukv, scr, r, KVW / 32, lane); continue; } r -= I_UKV;
                if (r < I_OUT) { wt_item(w_out, DM, DM, g_mla, 1024, Wout, scr, r, DM / 32, lane); continue; } r -= I_OUT;
                if (r < I_UP) { wt_item(w_up, DM, DFF2, g_ffn, DM, Wup, scr, r, DFF2 / 32, lane, true); continue; } r -= I_UP;
                wt_item(w_dn, DFF, DM, g_ffn, 0, Wdn, scr, r, DM / 32, lane);
            }
            if (l == 0) {
                for (int m = gw; m < SEQ; m += NGW) {
                    GAS const f32x4* xr = (GAS const f32x4*)(G_(xin) + (size_t)m * DM) + lane; float s = 0.f;
                    GAS u32x2* o8 = (GAS u32x2*)(G_(XB) + (size_t)m * DM) + lane;
#pragma unroll
                    for (int j = 0; j < 8; ++j) { const f32x4 v = xr[64 * j]; s += (v[0] * v[0] + v[1] * v[1]) + (v[2] * v[2] + v[3] * v[3]); o8[64 * j] = (u32x2){pk2(v[0], v[1]), pk2(v[2], v[3])}; }
                    s = wave_sum(s); if (lane == 0) G_(ssq_x)[m] = (u64)(s * SSQ_FX + 0.5f);
                }
            }
        }
        if (l == 0) GRID_SYNC(); else XSYNC();
        {
            PHASE_BEGIN();
            pg8::Gemm g{XB, Win, SEQ, IN_PAD, DM, DM}; pg8::StaticOrder S; S.init(SEQ, IN_PAD, G, bid);
            pg8::EpiRowScale E{Z, IN_PAD, ssq_x, 1.0f / DM, ssq_cq, 0, 2, ssq_ckv, 2, 3};
            pg8::gemm_phase<pg8::EpiRowScale>(L, g, S, E);
        }
        XSYNC();
        DBG_DUMP(1, bf2f(Z[(size_t)m * IN_PAD + c]) + bf2f(Z[(size_t)m * IN_PAD + 2048 + c]));
        {
            PHASE_BEGIN();
            { pg8::Gemm g{Z + C_CQ, Wuq, SEQ, QW, QLORA, IN_PAD}; pg8::StaticOrder S; S.init(SEQ, QW, G, bid);
              pg8::EpiRowScale E{Qb, QW, ssq_cq, 1.0f / QLORA, nullptr, 0, 0, nullptr, 0, 0};
              pg8::gemm_phase<pg8::EpiRowScale>(L, g, S, E); }
            { pg8::Gemm g{Z + C_CKV, Wukv, SEQ, KVW, KVLORA, IN_PAD}; pg8::StaticOrder S; S.init(SEQ, KVW, G, bid);
              pg8::EpiUkv E{Kb, Vt, ssq_ckv, 1.0f / KVLORA};
              pg8::gemm_phase<pg8::EpiUkv>(L, g, S, E); }
            const float* wgate = kap->in[10] + (size_t)l * 16 * (GH * GDK); const float* bgate = kap->in[11] + (size_t)l * (GH * GDK);
            for (int u = bid; u < NCHUNK * GH; u += G) gla_chunk_unit(L, Z, wgate, bgate, ST, DEC, u >> 2, u & 3);
        }
        XSYNC();
        DBG_DUMP(2, (c < QW ? bf2f(Qb[(size_t)m * QW + c]) + bf2f(Kb[(size_t)m * QW + c]) : bf2f(Vt[(size_t)(c - QW) * SEQ + m])) + bf2f(ST[(size_t)m * 8192 + c]) + bf2f(ST[(size_t)m * 8192 + 4096 + c]));
        {
            PHASE_BEGIN();
            const int* pos = (const int*)kap->in[1];
            const float* qn = kap->in[8] + l * QKD; const float* kn = kap->in[9] + l * QKD;
            const float qscale = 0.07216878364870322f * 1.4426950408889634f;
            for (int m = gw; m < SEQ; m += NGW) {
                const int i = lane & 31;
                const float ang = (float)G_(pos)[m] * kap->inv_freq[i];
                double rev = (double)ang * 0.15915494309189535; rev -= __builtin_rint(rev);
                const float sn = __builtin_amdgcn_sinf((float)rev), cs = __builtin_amdgcn_cosf((float)rev);
                const float krv = bf2f(G_(Z)[(size_t)m * IN_PAD + C_KR + lane]);
                GAS bf16_t* qp = G_(Qb) + (size_t)m * QW; GAS bf16_t* kp = G_(Kb) + (size_t)m * QW;
                float qa[NH][3], ka[NH][2], qs[NH], ks[NH];
#pragma unroll
                for (int h = 0; h < NH; ++h) { qa[h][0] = bf2f(qp[h * QKD + lane]); qa[h][1] = bf2f(qp[h * QKD + 64 + lane]); qa[h][2] = bf2f(qp[h * QKD + 128 + lane]);
                                               ka[h][0] = bf2f(kp[h * QKD + lane]); ka[h][1] = bf2f(kp[h * QKD + 64 + lane]); }
#pragma unroll
                for (int h = 0; h < NH; ++h) { qs[h] = qa[h][0] * qa[h][0] + qa[h][1] * qa[h][1] + qa[h][2] * qa[h][2]; ks[h] = ka[h][0] * ka[h][0] + ka[h][1] * ka[h][1] + krv * krv; }
#pragma unroll
                for (int o = 1; o < 64; o <<= 1)
#pragma unroll
                    for (int h = 0; h < NH; ++h) { qs[h] += __shfl_xor(qs[h], o); ks[h] += __shfl_xor(ks[h], o); }
                const float qg0 = G_(qn)[lane], qg1 = G_(qn)[64 + lane], qg2 = G_(qn)[128 + lane], kg0 = G_(kn)[lane], kg1 = G_(kn)[64 + lane], kg2 = G_(kn)[128 + lane];
#pragma unroll
                for (int h = 0; h < NH; ++h) {
                    { const float rstd = rsqrtf(qs[h] * (1.0f / QKD) + EPS);
                      const float n2 = qa[h][2] * rstd * qg2, pr = __shfl_xor(n2, 32);
                      const float r2 = (lane < 32) ? n2 * cs - pr * sn : n2 * cs + pr * sn;
                      qp[h * QKD + lane] = (bf16_t)f2bf(qa[h][0] * rstd * qg0 * qscale); qp[h * QKD + 64 + lane] = (bf16_t)f2bf(qa[h][1] * rstd * qg1 * qscale); qp[h * QKD + 128 + lane] = (bf16_t)f2bf(r2 * qscale); }
                    { const float rstd = rsqrtf(ks[h] * (1.0f / QKD) + EPS);
                      const float n2 = krv * rstd * kg2, pr = __shfl_xor(n2, 32);
                      const float r2 = (lane < 32) ? n2 * cs - pr * sn : n2 * cs + pr * sn;
                      kp[h * QKD + lane] = (bf16_t)f2bf(ka[h][0] * rstd * kg0); kp[h * QKD + 64 + lane] = (bf16_t)f2bf(ka[h][1] * rstd * kg1); kp[h * QKD + 128 + lane] = (bf16_t)f2bf(r2); }
                }
            }
            constexpr int NE = GH * GDV * GDK;
            for (int e = bid * 512 + tid; e < NE; e += G * 512) {
                const int hd = (e >> 15) * GDK + (e & 127);
                float s = 0.f;
                for (int c0 = 0; c0 < NCHUNK; c0 += 8) {
                    float uu[8], dd[8];
#pragma unroll
                    for (int i = 0; i < 8; ++i) { uu[i] = bf2f(G_(ST)[(size_t)(c0 + i) * NE + e]); dd[i] = G_(DEC)[(size_t)(c0 + i) * (GH * GDK) + hd]; }
#pragma unroll
                    for (int i = 0; i < 8; ++i) { s = s * dd[i] + uu[i]; G_(ST)[(size_t)(c0 + i) * NE + e] = (bf16_t)f2bf(s); }
                }
            }
        }
        XSYNC();
        DBG_DUMP(3, (c < QW ? bf2f(Qb[(size_t)m * QW + c]) + bf2f(Kb[(size_t)m * QW + c]) : 0.f) + bf2f(ST[(size_t)m * 8192 + c]) + bf2f(ST[(size_t)m * 8192 + 4096 + c]));
        {
            PHASE_BEGIN();
            for (int p = bid; p < 256; p += G) {
                const int h = p & 7, s = p >> 3;
                attn_unit(L, Qb, Kb, Vt, MIX, h, 63 - s);
                attn_unit(L, Qb, Kb, Vt, MIX, h, s);
            }
            const float* gnorm = kap->in[12] + l * GDV;
            for (int u = bid; u < NCHUNK * GH; u += G) gla_out_unit(L, Z, ST, gnorm, MIX, u >> 2, u & 3);
        }
        XSYNC();
        DBG_DUMP(4, bf2f(MIX[(size_t)m * DM + c]));
        { PHASE_BEGIN();
        for (int m = gw; m < SEQ; m += NGW) {
            GAS u32x4* p = (GAS u32x4*)(G_(MIX) + (size_t)m * DM) + lane;
            u32x4 v0 = p[0], v1 = p[64]; float s = 0.f;
#pragma unroll
            for (int j = 0; j < 4; ++j) { const float a0 = bflo(v0[j]), a1 = bfhi(v0[j]), b0 = bflo(v1[j]), b1 = bfhi(v1[j]); s += a0 * a0 + a1 * a1 + b0 * b0 + b1 * b1; }
            const float rstd = rsqrtf(wave_sum(s) * (1.0f / 1024.0f) + EPS);
#pragma unroll
            for (int j = 0; j < 4; ++j) { v0[j] = pk2(bflo(v0[j]) * rstd, bfhi(v0[j]) * rstd); v1[j] = pk2(bflo(v1[j]) * rstd, bfhi(v1[j]) * rstd); }
            p[0] = v0; p[64] = v1;
        } }
        XSYNC();
        DBG_DUMP(5, bf2f(MIX[(size_t)m * DM + c]));
        {
            PHASE_BEGIN();
            pg8::Gemm g{MIX, Wout, SEQ, DM, DM, DM}; pg8::StaticOrder S; S.init(SEQ, DM, G, bid);
            pg8::EpiRes E{l == 0 ? xin : out, out, XB, ssq_x1};
            pg8::gemm_phase<pg8::EpiRes>(L, g, S, E);
        }
        XSYNC();
        DBG_DUMP(6, out[(size_t)m * DM + c] + bf2f(XB[(size_t)m * DM + c]));
        {
            PHASE_BEGIN();
            const float* cw = kap->in[17] + (size_t)l * 3 * DFF2; const float* cb = kap->in[18] + (size_t)l * DFF2;
            pg8::Gemm g{XB, Wup, SEQ, DFF2, DM, DM}; pg8::StaticOrder S; S.init(SEQ, DFF2, G, bid);
            pg8::EpiUpConv E{ACT, EDGE, ssq_x1, cw, cb, (LAS float*)(L + RING_BYTES)};
            pg8::gemm_phase<pg8::EpiUpConv>(L, g, S, E);
        }
        XSYNC();
        {
            PHASE_BEGIN();
            const float* cw = kap->in[17] + (size_t)l * 3 * DFF2; const float* cb = kap->in[18] + (size_t)l * DFF2;
            for (int idx = bid * 512 + tid; idx < 63 * DFF; idx += G * 512) {
                const int pm = 1 + idx / DFF, gcol = idx % DFF;
                float y0[2], y1[2];
#pragma unroll
                for (int q = 0; q < 2; ++q) { const int c = q * DFF + gcol;
                    const float um2 = G_(EDGE)[(size_t)((pm - 1) * 4 + 2) * DFF2 + c], um1 = G_(EDGE)[(size_t)((pm - 1) * 4 + 3) * DFF2 + c], u0 = G_(EDGE)[(size_t)(pm * 4 + 0) * DFF2 + c], u1 = G_(EDGE)[(size_t)(pm * 4 + 1) * DFF2 + c];
                    const float w0 = G_(cw)[c], w1 = G_(cw)[DFF2 + c], w2 = G_(cw)[2 * DFF2 + c], bb = G_(cb)[c];
                    y0[q] = bb + w0 * um2 + w1 * um1 + w2 * u0; y1[q] = bb + w0 * um1 + w1 * u0 + w2 * u1; }
                G_(ACT)[(size_t)(pm * 256) * DFF + gcol] = (bf16_t)f2bf(silu_f(y0[0]) * y0[1]);
                G_(ACT)[(size_t)(pm * 256 + 1) * DFF + gcol] = (bf16_t)f2bf(silu_f(y1[0]) * y1[1]);
            }
        }
        XSYNC();
        DBG_DUMP(8, bf2f(ACT[(size_t)m * DFF + c]) + bf2f(ACT[(size_t)m * DFF + 3000 + c]));
        {
            PHASE_BEGIN();
            pg8::Gemm g{ACT, Wdn, SEQ, DM, DFF, DFF}; pg8::StaticOrder S; S.init(SEQ, DM, G, bid);
            pg8::EpiRes E{out, out, XB, ssq_xn};
            pg8::gemm_phase<pg8::EpiRes>(L, g, S, E);
        }
        XSYNC();
        if (DBG_STOP == 9) return;
    }
}

extern "C" void kernel_launch(void* const* d_in, const int* in_sizes, int n_in, void* d_out, int out_size, void* d_ws, size_t ws_size, hipStream_t stream) {
    static int grid = 0;
    if (grid == 0) {
        if (n_in != 20 || out_size != SEQ * DM || ws_size < WS_END) { fprintf(stderr, "kernel_launch: unexpected shapes: n_in %d out %d ws %zu (need %zu)\n", n_in, out_size, ws_size, (size_t)WS_END); grid = -1; return; }
        int dev = 0, cus = 0, per_cu = 0;
        hipGetDevice(&dev); hipDeviceGetAttribute(&cus, hipDeviceAttributeMultiprocessorCount, dev);
        hipFuncSetAttribute((const void*)mk_fwd, hipFuncAttributeMaxDynamicSharedMemorySize, LDS_BYTES);
        hipOccupancyMaxActiveBlocksPerMultiprocessor(&per_cu, (const void*)mk_fwd, 512, LDS_BYTES);
        (void)hipGetLastError();
        if (per_cu < 1) per_cu = 1;
        grid = cus * 1;
    }
    if (grid < 0) return;
    hipMemsetAsync((char*)d_ws + WS_CTL, 0, CTL_BYTES, stream);
    Args a{};
    for (int i = 0; i < 20; ++i) a.in[i] = (const float*)d_in[i];
    a.out = (float*)d_out; a.ws = (unsigned char*)d_ws;
    for (int i = 0; i < 32; ++i) a.inv_freq[i] = (float)pow(10000.0, -(double)i / 32.0);
    void* args[] = {&a};
    hipError_t e = hipLaunchCooperativeKernel((const void*)mk_fwd, dim3(grid), dim3(512), args, LDS_BYTES, stream);
    if (e != hipSuccess) fprintf(stderr, "cooperative launch failed: %s (grid %d)\n", hipGetErrorString(e), grid);
}
```

```cpp
#include <hip/hip_runtime.h>
#include <hip/hip_cooperative_groups.h>
#include <cstdio>
#include <cstdint>
#include <cmath>
namespace cg = cooperative_groups;

#define LAS __attribute__((address_space(3)))
typedef unsigned short bf16_t;
typedef unsigned long long u64;
typedef short bf16x8 __attribute__((ext_vector_type(8)));
typedef short s16x4 __attribute__((ext_vector_type(4)));
typedef float f32x4 __attribute__((ext_vector_type(4)));
typedef float f32x16 __attribute__((ext_vector_type(16)));
typedef unsigned u32x4 __attribute__((ext_vector_type(4)));
typedef unsigned u32x2 __attribute__((ext_vector_type(2)));
typedef float f32x2_t __attribute__((ext_vector_type(2)));
typedef __bf16 bf16x2_t __attribute__((ext_vector_type(2)));

constexpr int SEQ = 16384, DM = 2048, NLAYER = 2;
constexpr int IN_DIM = 3920, IN_PAD = 4096;
constexpr int C_CQ = 0, C_CKV = 512, C_KR = 768, C_GQ = 832, C_GK = 1344, C_GV = 1856, C_GA = 2880, C_GG = 2896;
constexpr int QLORA = 512, KVLORA = 256, NH = 8, QKD = 192, NOPE = 128, VD = 128, QW = NH * QKD  , KVW = NH * 256  ;
constexpr int GH = 4, GDK = 128, GDV = 256, NCHUNK = SEQ / 64;
constexpr int DFF = 5632, DFF2 = 11264;
constexpr float EPS = 1e-6f;

constexpr size_t MiB = 1u << 20;
constexpr size_t WS_CTL = 0, CTL_BYTES = 2 * MiB;
constexpr size_t WS_BAR = 0;
constexpr size_t WS_SSQ = 65536;
constexpr size_t WS_WIN = 2 * MiB, WS_WUQ = 18 * MiB, WS_WUKV = WS_WUQ + 3 * MiB / 2, WS_WOUT = WS_WUKV + 1 * MiB, WS_WUP = WS_WOUT + 8 * MiB, WS_WDN = WS_WUP + 44 * MiB;
constexpr size_t WS_XB = 95 * MiB;
constexpr size_t WS_R = 159 * MiB;
constexpr size_t WS_Z = WS_R, WS_Q = WS_Z + 128 * MiB, WS_K = WS_Q + 48 * MiB, WS_VT = WS_K + 48 * MiB, WS_ST = WS_VT + 32 * MiB, WS_DEC = WS_ST + 128 * MiB, WS_MIX = WS_DEC + 1 * MiB;
constexpr size_t WS_ACT = WS_R, WS_EDGE = WS_ACT + 176 * MiB, WS_END = WS_MIX + 64 * MiB;
static_assert(WS_EDGE + 12 * MiB <= WS_END, "ws map");

#define GAS __attribute__((address_space(1)))
template <class T> __device__ __forceinline__ GAS T* G_(T* p) { return (GAS T*)p; }
#define LAUNDER_V(x) asm volatile("" : "+v"(x))
#define LAUNDER_S(x) asm volatile("" : "+s"(x))
__device__ __forceinline__ unsigned f2bf(float f) { unsigned u = __builtin_bit_cast(unsigned, f); return (u + 0x7fffu + ((u >> 16) & 1u)) >> 16; }
__device__ __forceinline__ unsigned pk2(float lo, float hi) { f32x2_t v = {lo, hi}; bf16x2_t b = __builtin_convertvector(v, bf16x2_t); return __builtin_bit_cast(unsigned, b); }
__device__ __forceinline__ float bf2f(unsigned b) { return __builtin_bit_cast(float, b << 16); }
__device__ __forceinline__ float bflo(unsigned w) { return __builtin_bit_cast(float, w << 16); }
__device__ __forceinline__ float bfhi(unsigned w) { return __builtin_bit_cast(float, w & 0xffff0000u); }
__device__ __forceinline__ float wave_sum(float v) {
#pragma unroll
    for (int o = 1; o < 64; o <<= 1) v += __shfl_xor(v, o);
    return v;
}
constexpr float SSQ_FX = 1048576.0f, SSQ_INV = 1.0f / 1048576.0f;
__device__ __forceinline__ void ssq_add(u64* p, float v) { __hip_atomic_fetch_add((GAS u64*)p, (u64)(v * SSQ_FX + 0.5f), __ATOMIC_RELAXED, __HIP_MEMORY_SCOPE_AGENT); }
__device__ __forceinline__ float ssq_get(const u64* p) { return (float)(*(GAS const u64*)p) * SSQ_INV; }
__device__ __forceinline__ float silu_f(float x) { return x * __builtin_amdgcn_rcpf(1.0f + __expf(-x)); }

namespace pg8 {
constexpr int BM = 256, BK = 64, HALF = 128, HTB = HALF * BK * 2, STAGE_BYTES = 8 * HTB, NXCD = 8, WGM = 8;
__host__ __device__ __forceinline__ int lds_byte(int r, int c) { const int st = (r >> 4) * 2 + (c >> 5), rr = r & 15, cc = c & 31, ob = rr * 64 + cc * 2; return st * 1024 + (ob ^ (((ob >> 9) & 1) << 5)); }
__host__ __device__ __forceinline__ void stage_rc(int b, int& R, int& C) { const int st = b / 1024, sb = b % 1024, swz = sb ^ (((sb >> 9) & 1) << 5); R = (st >> 1) * 16 + swz / 64; C = (st & 1) * 32 + (swz % 64) / 2; }
__host__ __device__ __forceinline__ int perm32(int rho) { const int n = rho >> 4, i = rho & 15; return 8 * (i >> 2) + 4 * n + (i & 3); }

struct Unit { int pm, pn; };
struct Gemm { const bf16_t* A; const bf16_t* Bt; int M, N, K, lda; const u64* mid_ssq; float mid_inv; };

struct StaticOrder {
    int nM, nN, nwg, G, c;
    __device__ void init(int M, int N, int G_, int c_) { nM = M / BM; nN = N / BM; nwg = nM * nN; G = G_; c = c_; }
    __device__ bool next(int i, Unit& u) const {
        const long L = (long)i * G + c; if (L >= nwg) return false;
        int wgid = (int)L; { const int q = nwg / NXCD, r = nwg % NXCD, xcd = wgid % NXCD, off = wgid / NXCD; wgid = (xcd < r ? xcd * (q + 1) : r * (q + 1) + (xcd - r) * q) + off; }
        const int nig = WGM * nN, gid = wgid / nig, fm = gid * WGM, gsz = (nM - fm) < WGM ? (nM - fm) : WGM;
        u.pm = fm + ((wgid % nig) % gsz); u.pn = (wgid % nig) / gsz; return true;
    }
};

struct EpiRowScale {
    static constexpr bool PERM = true;
    bf16_t* O; int ldc; const u64* ssq_in; float inv_dim; u64* ssq_a; int a_lo, a_hi; u64* ssq_b; int b_lo, b_hi;
    __device__ __forceinline__ void operator()(const f32x4 (&acc)[2][2][4][2], const Unit& u, int wr, int wc, int fr, int fq) const {
        const int row0 = u.pm * BM + wr * 64 + fr, col0 = u.pn * BM + wc * 32 + 8 * fq;
        u64* sacc = (u.pn >= a_lo && u.pn < a_hi) ? ssq_a : ((u.pn >= b_lo && u.pn < b_hi) ? ssq_b : nullptr);
#pragma unroll
        for (int ai = 0; ai < 2; ++ai)
#pragma unroll
            for (int m = 0; m < 4; ++m) {
                const int row = row0 + ai * HALF + m * 16;
                const float sc = ssq_in ? rsqrtf(ssq_get(ssq_in + row) * inv_dim + EPS) : 1.0f;
                float ss = 0.f;
#pragma unroll
                for (int bj = 0; bj < 2; ++bj) {
                    const f32x4 v0 = acc[ai][bj][m][0] * sc, v1 = acc[ai][bj][m][1] * sc;
                    ss += (v0[0] * v0[0] + v0[1] * v0[1]) + (v0[2] * v0[2] + v0[3] * v0[3]) + (v1[0] * v1[0] + v1[1] * v1[1]) + (v1[2] * v1[2] + v1[3] * v1[3]);
                    u32x4 w; w.x = pk2(v0[0], v0[1]); w.y = pk2(v0[2], v0[3]); w.z = pk2(v1[0], v1[1]); w.w = pk2(v1[2], v1[3]);
                    *(GAS u32x4*)(G_(O) + (size_t)row * ldc + col0 + bj * HALF) = w;
                }
                if (sacc) { ss += __shfl_xor(ss, 16); ss += __shfl_xor(ss, 32); if (fq == 0) ssq_add(sacc + row, ss); }
            }
    }
};
struct EpiUkv {
    static constexpr bool PERM = true;
    bf16_t* Kb; bf16_t* Vt; const u64* ssq_in; float inv_dim;
    __device__ __forceinline__ void operator()(const f32x4 (&acc)[2][2][4][2], const Unit& u, int wr, int wc, int fr, int fq) const {
        const int row0 = u.pm * BM + wr * 64 + fr, c0 = wc * 32 + 8 * fq;
#pragma unroll
        for (int ai = 0; ai < 2; ++ai)
#pragma unroll
            for (int m = 0; m < 4; ++m) {
                const int row = row0 + ai * HALF + m * 16;
                const int prow = (row & ~15) | (row & 3) | ((row & 4) << 1) | ((row & 8) >> 1);
                const float sc = rsqrtf(ssq_get(ssq_in + row) * inv_dim + EPS);
                { const f32x4 v0 = acc[ai][0][m][0] * sc, v1 = acc[ai][0][m][1] * sc;
                  u32x4 w; w.x = pk2(v0[0], v0[1]); w.y = pk2(v0[2], v0[3]); w.z = pk2(v1[0], v1[1]); w.w = pk2(v1[2], v1[3]);
                  *(GAS u32x4*)(G_(Kb) + (size_t)row * QW + u.pn * QKD + c0) = w; }
#pragma unroll
                for (int n = 0; n < 2; ++n)
#pragma unroll
                    for (int j = 0; j < 4; ++j) G_(Vt)[(size_t)(u.pn * VD + c0 + 4 * n + j) * SEQ + prow] = (bf16_t)f2bf(acc[ai][1][m][n][j] * sc);
            }
    }
};
struct EpiRes {
    static constexpr bool PERM = true;
    const float* base; float* out; bf16_t* xb; u64* ssq_out;
    __device__ __forceinline__ void operator()(const f32x4 (&acc)[2][2][4][2], const Unit& u, int wr, int wc, int fr, int fq) const {
        const int row0 = u.pm * BM + wr * 64 + fr, col0 = u.pn * BM + wc * 32 + 8 * fq;
#pragma unroll
        for (int ai = 0; ai < 2; ++ai)
#pragma unroll
            for (int m = 0; m < 4; ++m) {
                const int row = row0 + ai * HALF + m * 16; float ss = 0.f;
#pragma unroll
                for (int bj = 0; bj < 2; ++bj) {
                    const size_t off = (size_t)row * DM + col0 + bj * HALF;
                    const f32x4 v0 = acc[ai][bj][m][0] + *(GAS const f32x4*)(G_(base) + off), v1 = acc[ai][bj][m][1] + *(GAS const f32x4*)(G_(base) + off + 4);
                    ss += (v0[0] * v0[0] + v0[1] * v0[1]) + (v0[2] * v0[2] + v0[3] * v0[3]) + (v1[0] * v1[0] + v1[1] * v1[1]) + (v1[2] * v1[2] + v1[3] * v1[3]);
                    *(GAS f32x4*)(G_(out) + off) = v0; *(GAS f32x4*)(G_(out) + off + 4) = v1;
                    u32x4 w; w.x = pk2(v0[0], v0[1]); w.y = pk2(v0[2], v0[3]); w.z = pk2(v1[0], v1[1]); w.w = pk2(v1[2], v1[3]);
                    *(GAS u32x4*)(G_(xb) + off) = w;
                }
                ss += __shfl_xor(ss, 16); ss += __shfl_xor(ss, 32); if (fq == 0) ssq_add(ssq_out + row, ss);
            }
    }
};


#define DPP_SHR1(old, src) __builtin_bit_cast(float, __builtin_amdgcn_update_dpp(__builtin_bit_cast(int, (float)(old)), __builtin_bit_cast(int, (float)(src)), 0x111, 0xf, 0xf, false))
#define DPP_SHR2(old, src) __builtin_bit_cast(float, __builtin_amdgcn_update_dpp(__builtin_bit_cast(int, (float)(old)), __builtin_bit_cast(int, (float)(src)), 0x112, 0xf, 0xf, false))
#define DPP_ROR1(src) __builtin_bit_cast(float, __builtin_amdgcn_update_dpp(0, __builtin_bit_cast(int, (float)(src)), 0x121, 0xf, 0xf, false))
#define DPP_ROR2(src) __builtin_bit_cast(float, __builtin_amdgcn_update_dpp(0, __builtin_bit_cast(int, (float)(src)), 0x122, 0xf, 0xf, false))
struct EpiUpConv {
    static constexpr bool PERM = true;
    bf16_t* ACT; float* EDGE; const u64* ssq_in; const float* cw; const float* cb; LAS float* halo;
    __device__ __forceinline__ void operator()(f32x4 (&acc)[2][2][4][2], const Unit& u, int wr, int wc, int fr, int fq) const {
        const int row0 = u.pm * BM + wr * 64 + fr;
        const int g0 = u.pn * 128 + wc * 32 + 8 * fq;
#pragma unroll
        for (int ai = 0; ai < 2; ++ai)
#pragma unroll
            for (int m = 0; m < 4; ++m) {
                const float sc = rsqrtf(ssq_get(ssq_in + row0 + ai * HALF + m * 16) * (1.0f / DM) + EPS);
#pragma unroll
                for (int bj = 0; bj < 2; ++bj)
#pragma unroll
                    for (int n = 0; n < 2; ++n) acc[ai][bj][m][n] = acc[ai][bj][m][n] * sc;
            }
        if (fr >= 14) {
#pragma unroll
            for (int ai = 0; ai < 2; ++ai) { LAS float* hp = halo + ((((2 * ai + wr) * 4 + wc) * 2 + (fr - 14)) * 4 + fq) * 16;
#pragma unroll
                for (int bj = 0; bj < 2; ++bj)
#pragma unroll
                    for (int n = 0; n < 2; ++n) *(LAS f32x4*)(hp + bj * 8 + n * 4) = acc[ai][bj][3][n]; }
            if (wr == 1) { GAS float* ep = G_(EDGE) + (size_t)(u.pm * 4 + 2 + fr - 14) * DFF2 + g0;
#pragma unroll
                for (int bj = 0; bj < 2; ++bj)
#pragma unroll
                    for (int n = 0; n < 2; ++n) *(GAS f32x4*)(ep + bj * DFF + 4 * n) = acc[1][bj][3][n]; }
        }
        if (fr < 2 && wr == 0) { GAS float* ep = G_(EDGE) + (size_t)(u.pm * 4 + fr) * DFF2 + g0;
#pragma unroll
            for (int bj = 0; bj < 2; ++bj)
#pragma unroll
                for (int n = 0; n < 2; ++n) *(GAS f32x4*)(ep + bj * DFF + 4 * n) = acc[0][bj][0][n]; }
        asm volatile("s_waitcnt lgkmcnt(0)" ::: "memory"); __builtin_amdgcn_s_barrier(); asm volatile("" ::: "memory");
#pragma unroll
        for (int n = 0; n < 2; ++n) {
            const int gc = g0 + 4 * n;
            GAS const float* cwg = G_(cw); GAS const float* cbg = G_(cb);
            const f32x4 wg0 = *(GAS const f32x4*)(cwg + gc), wg1 = *(GAS const f32x4*)(cwg + DFF2 + gc), wg2 = *(GAS const f32x4*)(cwg + 2 * DFF2 + gc), bgv = *(GAS const f32x4*)(cbg + gc);
            const f32x4 wu0 = *(GAS const f32x4*)(cwg + DFF + gc), wu1 = *(GAS const f32x4*)(cwg + DFF2 + DFF + gc), wu2 = *(GAS const f32x4*)(cwg + 2 * DFF2 + DFF + gc), buv = *(GAS const f32x4*)(cbg + DFF + gc);
#pragma unroll
            for (int ai = 0; ai < 2; ++ai) {
                const int band = 2 * ai + wr;
                f32x4 pg = (f32x4){0.f, 0.f, 0.f, 0.f}, pu = pg;
                if (band > 0) { const LAS float* hp = halo + ((((band - 1) * 4 + wc) * 2 + (fr & 1)) * 4 + fq) * 16; pg = *(const LAS f32x4*)(hp + n * 4); pu = *(const LAS f32x4*)(hp + 8 + n * 4); }
#pragma unroll
                for (int m = 0; m < 4; ++m) {
                    const f32x4 cg = acc[ai][0][m][n], cu = acc[ai][1][m][n];
                    float av[4];
#pragma unroll
                    for (int j = 0; j < 4; ++j) {
                        const float g1 = DPP_SHR1(DPP_ROR1(pg[j]), cg[j]), g2 = DPP_SHR2(DPP_ROR2(pg[j]), cg[j]);
                        const float u1 = DPP_SHR1(DPP_ROR1(pu[j]), cu[j]), u2 = DPP_SHR2(DPP_ROR2(pu[j]), cu[j]);
                        const float yg = bgv[j] + wg0[j] * g2 + wg1[j] * g1 + wg2[j] * cg[j];
                        const float yu = buv[j] + wu0[j] * u2 + wu1[j] * u1 + wu2[j] * cu[j];
                        av[j] = silu_f(yg) * yu;
                    }
                    *(GAS u32x2*)(G_(ACT) + (size_t)(row0 + ai * HALF + m * 16) * DFF + gc) = (u32x2){pk2(av[0], av[1]), pk2(av[2], av[3])};
                    pg = cg; pu = cu;
                }
            }
        }
    }
};

template <class Epi, bool MIDSCALE = false>
__device__ __forceinline__ void gemm_phase(LAS unsigned char* lds, const Gemm g, const StaticOrder& S, const Epi& E) {
    int tid_ = threadIdx.x; LAUNDER_V(tid_);
    const int tid = tid_, wid = __builtin_amdgcn_readfirstlane(tid >> 6), lane = tid & 63, wr = wid >> 2, wc = wid & 3, fr = lane & 15, fq = lane >> 4;
    const int K = g.K, nt = K / BK;
    unsigned voffA[2], voffB[2];
#pragma unroll
    for (int i = 0; i < 2; ++i) { int R, C; stage_rc(tid * 16 + i * 8192, R, C); const int Rb = Epi::PERM ? ((R & ~31) + perm32(R & 31)) : R;
        voffA[i] = (unsigned)(R * g.lda + C) * 2u; voffB[i] = (unsigned)(Rb * K + C) * 2u; }
    const size_t kstep = (size_t)(BK * 2);
    const size_t hstepA = (size_t)HALF * g.lda * 2, hstepB = (size_t)HALF * K * 2;
    const size_t tstepA = 2 * hstepA, tstepB = 2 * hstepB;
    const unsigned ldsw = (unsigned)wid * 1024u;
    const int aoff = lds_byte(wr * 64 + fr, fq * 8), boff = lds_byte(wc * 32 + fr, fq * 8);
#define PG8_SA(b, h) (((b) * 2 + (h)) * HTB)
#define PG8_SB(b, h) ((4 + (b) * 2 + (h)) * HTB)
#define PG8_STAGE(bufoff, gbase, voff) do { _Pragma("unroll") for (int _i = 0; _i < 2; ++_i) \
        __builtin_amdgcn_global_load_lds((const unsigned*)((const char*)(gbase) + (voff)[_i]), (LAS unsigned*)(lds + (bufoff) + ldsw + _i * 8192), 16, 0, 0); } while (0)
#define PG8_LDA(dst, b, h) do { _Pragma("unroll") for (int m = 0; m < 4; ++m) _Pragma("unroll") for (int k = 0; k < 2; ++k) dst[m][k] = *(const LAS bf16x8*)(lds + PG8_SA(b, h) + aoff + m * 2048 + k * 1024); } while (0)
#define PG8_LDB(dst, b, h) do { _Pragma("unroll") for (int n = 0; n < 2; ++n) _Pragma("unroll") for (int k = 0; k < 2; ++k) dst[n][k] = *(const LAS bf16x8*)(lds + PG8_SB(b, h) + boff + n * 2048 + k * 1024); } while (0)
#define PG8_MMA(ai, bj, At, Bt) do { __builtin_amdgcn_s_setprio(1); _Pragma("unroll") for (int m = 0; m < 4; ++m) _Pragma("unroll") for (int n = 0; n < 2; ++n) _Pragma("unroll") for (int k = 0; k < 2; ++k) \
        acc[ai][bj][m][n] = __builtin_amdgcn_mfma_f32_16x16x32_bf16(Bt[n][k], At[m][k], acc[ai][bj][m][n], 0, 0, 0); __builtin_amdgcn_s_setprio(0); } while (0)
#define PG8_WAIT_V(n) asm volatile("s_waitcnt vmcnt(" #n ")" ::: "memory")
#define PG8_WAIT_L(n) asm volatile("s_waitcnt lgkmcnt(" #n ")" ::: "memory")
#define PG8_BAR __builtin_amdgcn_s_barrier()
#define PG8_SCHED __builtin_amdgcn_sched_barrier(0)
    Unit cur, nxt; int ui = 0;
    if (!S.next(0, cur)) return;
    f32x4 acc[2][2][4][2];
#pragma unroll
    for (int a = 0; a < 2; ++a)
#pragma unroll
        for (int b = 0; b < 2; ++b)
#pragma unroll
            for (int m = 0; m < 4; ++m)
#pragma unroll
                for (int n = 0; n < 2; ++n) acc[a][b][m][n] = (f32x4){0.f, 0.f, 0.f, 0.f};
    bf16x8 At[4][2], B0[2][2], B1[2][2];
    const char* cA = (const char*)g.A + (size_t)cur.pm * tstepA; const char* cB = (const char*)g.Bt + (size_t)cur.pn * tstepB;
    PG8_STAGE(PG8_SB(0, 0), cB, voffB); PG8_STAGE(PG8_SB(0, 1), cB + hstepB, voffB); PG8_STAGE(PG8_SA(0, 0), cA, voffA); PG8_STAGE(PG8_SA(0, 1), cA + hstepA, voffA);
    if (wr == 1) PG8_BAR;
    PG8_WAIT_V(2); PG8_BAR;
    PG8_STAGE(PG8_SB(1, 0), cB + kstep, voffB); PG8_STAGE(PG8_SA(1, 0), cA + kstep, voffA); PG8_STAGE(PG8_SB(1, 1), cB + hstepB + kstep, voffB);
    PG8_WAIT_V(6); PG8_BAR;
    for (;;) {
        const bool has_next = S.next(ui + 1, nxt);
        const char* nA = has_next ? (const char*)g.A + (size_t)nxt.pm * tstepA : cA; const char* nB = has_next ? (const char*)g.Bt + (size_t)nxt.pn * tstepB : cB;
        for (int t = 0; t < nt; t += 2) {
            const bool last = (t == nt - 2);
            const char* a1 = cA + (size_t)(t + 1) * kstep;
            const char* a2 = last ? nA : cA + (size_t)(t + 2) * kstep; const char* b2 = last ? nB : cB + (size_t)(t + 2) * kstep;
            const char* a3 = a2 + kstep; const char* b3 = b2 + kstep;
            if constexpr (MIDSCALE) { if (t == nt / 2) {
#pragma unroll
                for (int ai = 0; ai < 2; ++ai)
#pragma unroll
                    for (int m = 0; m < 4; ++m) { const float sc = rsqrtf(ssq_get(g.mid_ssq + cur.pm * BM + ai * HALF + wr * 64 + m * 16 + fr) * g.mid_inv + EPS);
#pragma unroll
                        for (int bj = 0; bj < 2; ++bj)
#pragma unroll
                            for (int n = 0; n < 2; ++n) acc[ai][bj][m][n] = acc[ai][bj][m][n] * sc; } } }
            PG8_LDB(B0, 0, 0); PG8_LDB(B1, 0, 1); PG8_SCHED; PG8_LDA(At, 0, 0); PG8_STAGE(PG8_SA(1, 1), a1 + hstepA, voffA);
            PG8_WAIT_V(8); PG8_WAIT_L(0); PG8_BAR; PG8_MMA(0, 0, At, B0); PG8_MMA(0, 1, At, B1); PG8_BAR; PG8_SCHED;
            PG8_LDA(At, 0, 1); PG8_STAGE(PG8_SB(0, 0), b2, voffB); PG8_STAGE(PG8_SB(0, 1), b2 + hstepB, voffB); PG8_STAGE(PG8_SA(0, 0), a2, voffA);
            PG8_WAIT_V(8); PG8_WAIT_L(0); PG8_BAR; PG8_MMA(1, 0, At, B0); PG8_MMA(1, 1, At, B1); PG8_BAR; PG8_SCHED;
            PG8_LDB(B0, 1, 0); PG8_LDB(B1, 1, 1); PG8_SCHED; PG8_LDA(At, 1, 0); PG8_STAGE(PG8_SA(0, 1), a2 + hstepA, voffA);
            PG8_WAIT_V(8); PG8_WAIT_L(0); PG8_BAR; PG8_MMA(0, 0, At, B0); PG8_MMA(0, 1, At, B1); PG8_BAR; PG8_SCHED;
            PG8_LDA(At, 1, 1); PG8_STAGE(PG8_SB(1, 0), b3, voffB); PG8_STAGE(PG8_SB(1, 1), b3 + hstepB, voffB); PG8_STAGE(PG8_SA(1, 0), a3, voffA);
            PG8_WAIT_V(8); PG8_WAIT_L(0); PG8_BAR; PG8_MMA(1, 0, At, B0); PG8_MMA(1, 1, At, B1); PG8_BAR; PG8_SCHED;
        }
        if (wr == 0) PG8_BAR;
        { int frE = fr, fqE = fq; LAUNDER_V(frE); LAUNDER_V(fqE); E(acc, cur, wr, wc, frE, fqE); }
        if (!has_next) break;
#pragma unroll
        for (int a = 0; a < 2; ++a)
#pragma unroll
            for (int b = 0; b < 2; ++b)
#pragma unroll
                for (int m = 0; m < 4; ++m)
#pragma unroll
                    for (int n = 0; n < 2; ++n) acc[a][b][m][n] = (f32x4){0.f, 0.f, 0.f, 0.f};
        cur = nxt; cA = nA; cB = nB; ++ui;
        if (wr == 1) PG8_BAR;
    }
    PG8_WAIT_V(0);
    PG8_BAR;
#undef PG8_SA
#undef PG8_SB
#undef PG8_STAGE
#undef PG8_LDA
#undef PG8_LDB
#undef PG8_MMA
#undef PG8_WAIT_V
#undef PG8_WAIT_L
#undef PG8_BAR
#undef PG8_SCHED
}
}

constexpr int RING_BYTES = 131072;
constexpr int LDS_BYTES = 147456;

struct Args { const float* in[20]; float* out; unsigned char* ws; float inv_freq[32]; };
typedef const __attribute__((address_space(4))) Args* KAP_T;

#define DS_READ4(r0, r1, r2, r3, addr, o0, o1, o2, o3) asm volatile("ds_read_b128 %0, %4 offset:%5\n\tds_read_b128 %1, %4 offset:%6\n\tds_read_b128 %2, %4 offset:%7\n\tds_read_b128 %3, %4 offset:%8" \
    : "=&v"(r0), "=&v"(r1), "=&v"(r2), "=&v"(r3) : "v"(addr), "i"(o0), "i"(o1), "i"(o2), "i"(o3) : "memory")
#define LGKM_WAIT4(n, r0, r1, r2, r3) asm volatile("s_waitcnt lgkmcnt(" #n ")" : "+v"(r0), "+v"(r1), "+v"(r2), "+v"(r3) :: "memory")
#define MFMA32(a, b, c) __builtin_amdgcn_mfma_f32_32x32x16_bf16((a), (b), (c), 0, 0, 0)
__device__ __forceinline__ int crow(int r, int hi) { return (r & 3) + 8 * (r >> 2) + 4 * hi; }

__device__ __forceinline__ void wt_item(const float* __restrict__ W, int K, int N, const float* __restrict__ gain, int gainK, bf16_t* WT, LAS float* scr, int item, int nblk, int lane, bool remap_up = false) {
    const int kb = item / nblk, nb = item % nblk, k0 = 64 * kb, n0 = 32 * nb;
    const int ns0 = remap_up ? (((n0 & 255) < 128) ? 128 * (n0 >> 8) + (n0 & 255) : DFF + 128 * (n0 >> 8) + (n0 & 255) - 128) : n0;
    const int n = ns0 + (lane & 31);
    float wv[32];
#pragma unroll
    for (int i = 0; i < 32; ++i) { const int kk = 2 * i + (lane >> 5); wv[i] = (n < N) ? G_(W)[(size_t)(k0 + kk) * N + n] : 0.f; }
#pragma unroll
    for (int i = 0; i < 32; ++i) { const int kk = 2 * i + (lane >> 5); scr[kk * 33 + (lane & 31)] = wv[i]; }
    asm volatile("s_waitcnt lgkmcnt(0)" ::: "memory");
    const int c = lane & 7;
    f32x4 g0 = (f32x4){1.f, 1.f, 1.f, 1.f}, g1 = g0;
    if (k0 < gainK) { g0 = *(GAS const f32x4*)(G_(gain) + k0 + 8 * c); g1 = *(GAS const f32x4*)(G_(gain) + k0 + 8 * c + 4); }
#pragma unroll
    for (int j = 0; j < 4; ++j) { const int nn = (lane >> 3) + 8 * j; const LAS float* s = scr + (8 * c) * 33 + nn;
        u32x4 o; o.x = pk2(s[0 * 33] * g0[0], s[1 * 33] * g0[1]); o.y = pk2(s[2 * 33] * g0[2], s[3 * 33] * g0[3]); o.z = pk2(s[4 * 33] * g1[0], s[5 * 33] * g1[1]); o.w = pk2(s[6 * 33] * g1[2], s[7 * 33] * g1[3]);
        *(GAS u32x4*)(G_(WT) + (size_t)(n0 + nn) * K + k0 + 8 * c) = o; }
    asm volatile("s_waitcnt lgkmcnt(0)" ::: "memory");
}

constexpr int AT_KSTR = 400, AT_VSTR = 144;
constexpr int AT_KB = 64 * AT_KSTR  , AT_VB = 128 * AT_VSTR  , AT_K0 = 0, AT_V0 = 2 * AT_KB, AT_WSF = AT_V0 + 2 * AT_VB;
static_assert(AT_WSF + 8 * 128 <= RING_BYTES, "attn lds");

__device__ __forceinline__ void attn_unit(LAS unsigned char* L, const bf16_t* Q_, const bf16_t* Kg_, const bf16_t* Vt_, bf16_t* mix_, u64* ssq_a, int h, int qb) {
    GAS const bf16_t* Q = G_(Q_); GAS const bf16_t* Kg = G_(Kg_); GAS const bf16_t* Vt = G_(Vt_); GAS bf16_t* mix = G_(mix_);
    int tid_ = threadIdx.x; LAUNDER_V(tid_);
    const int tid = tid_, lane = tid & 63, w = __builtin_amdgcn_readfirstlane(tid >> 6), r32 = lane & 31, hh = lane >> 5;
    const int q0 = qb * 256;
    bf16x8 qf[12];
    { GAS const bf16_t* qrow = Q + (size_t)(q0 + 32 * w + r32) * QW + h * QKD + 8 * hh;
#pragma unroll
      for (int ks = 0; ks < 12; ++ks) qf[ks] = *(GAS const bf16x8*)(qrow + 16 * ks); }
    f32x16 o[4];
#pragma unroll
    for (int d = 0; d < 4; ++d)
#pragma unroll
        for (int i = 0; i < 16; ++i) o[d][i] = 0.f;
    float l_run = 0.f;
    const int NT = 4 * qb + 4, my_last = 4 * qb + (w >> 1);
    volatile LAS float* wsf = (volatile LAS float*)(L + AT_WSF) + w * 32;
    const unsigned lds_base = (unsigned)(uintptr_t)L;
    u32x4 kst[3], vst[2];
#define AT_GLOAD(t) do { const int kv0_ = (t) * 64; int x_ = tid; LAUNDER_V(x_); \
    _Pragma("unroll") for (int i = 0; i < 3; ++i) { const int id_ = x_ + 512 * i, r_ = id_ / 24, c_ = id_ - 24 * r_; kst[i] = *(GAS const u32x4*)(Kg + (size_t)(kv0_ + r_) * QW + h * QKD + c_ * 8); } \
    _Pragma("unroll") for (int i = 0; i < 2; ++i) { const int id_ = x_ + 512 * i; vst[i] = *(GAS const u32x4*)(Vt + (size_t)(h * VD + (id_ >> 3)) * SEQ + kv0_ + (id_ & 7) * 8); } } while (0)
#define AT_SSTORE(buf) do { int x_ = tid; LAUNDER_V(x_); \
    _Pragma("unroll") for (int i = 0; i < 3; ++i) { const int id_ = x_ + 512 * i, r_ = id_ / 24, c_ = id_ - 24 * r_; *(LAS u32x4*)(L + AT_K0 + (buf) * AT_KB + r_ * AT_KSTR + c_ * 16) = kst[i]; } \
    _Pragma("unroll") for (int i = 0; i < 2; ++i) { const int id_ = x_ + 512 * i; *(LAS u32x4*)(L + AT_V0 + (buf) * AT_VB + (id_ >> 3) * AT_VSTR + (id_ & 7) * 16) = vst[i]; } } while (0)
    AT_GLOAD(0); AT_SSTORE(0); __syncthreads();
    for (int t = 0; t < NT; ++t) {
        const int buf = t & 1;
        if (t + 1 < NT) AT_GLOAD(t + 1);
        if (t <= my_last) {
            const unsigned kaddr = lds_base + AT_K0 + buf * AT_KB + r32 * AT_KSTR + hh * 16;
            const unsigned vaddr = lds_base + AT_V0 + buf * AT_VB + r32 * AT_VSTR + hh * 16;
            f32x16 p0, p1;
#pragma unroll
            for (int i = 0; i < 16; ++i) { p0[i] = 0.f; p1[i] = 0.f; }
            bf16x8 fa0, fa1, fa2, fa3, fb0, fb1, fb2, fb3;
#define QK_RD(s0, s1, s2, s3, kb, g) DS_READ4(s0, s1, s2, s3, kaddr, (kb) * 32 * AT_KSTR + (4 * (g)) * 32, (kb) * 32 * AT_KSTR + (4 * (g) + 1) * 32, (kb) * 32 * AT_KSTR + (4 * (g) + 2) * 32, (kb) * 32 * AT_KSTR + (4 * (g) + 3) * 32)
#define QK_MM(s0, s1, s2, s3, P, g) do { P = MFMA32(s0, qf[4 * (g)], P); P = MFMA32(s1, qf[4 * (g) + 1], P); P = MFMA32(s2, qf[4 * (g) + 2], P); P = MFMA32(s3, qf[4 * (g) + 3], P); } while (0)
#define PV_RD(s0, s1, s2, s3, kb, ss) DS_READ4(s0, s1, s2, s3, vaddr, (kb) * 64 + (ss) * 32, 32 * AT_VSTR + (kb) * 64 + (ss) * 32, 64 * AT_VSTR + (kb) * 64 + (ss) * 32, 96 * AT_VSTR + (kb) * 64 + (ss) * 32)
#define PV_PK(P, ss) __builtin_bit_cast(bf16x8, (u32x4){pk2(P[8 * (ss) + 0], P[8 * (ss) + 1]), pk2(P[8 * (ss) + 2], P[8 * (ss) + 3]), pk2(P[8 * (ss) + 4], P[8 * (ss) + 5]), pk2(P[8 * (ss) + 6], P[8 * (ss) + 7])})
#define PV_MM(s0, s1, s2, s3, xs) do { o[0] = MFMA32(xs, s0, o[0]); o[1] = MFMA32(xs, s1, o[1]); o[2] = MFMA32(xs, s2, o[2]); o[3] = MFMA32(xs, s3, o[3]); } while (0)
            QK_RD(fa0, fa1, fa2, fa3, 0, 0);
            QK_RD(fb0, fb1, fb2, fb3, 0, 1); LGKM_WAIT4(4, fa0, fa1, fa2, fa3); QK_MM(fa0, fa1, fa2, fa3, p0, 0);
            QK_RD(fa0, fa1, fa2, fa3, 0, 2); LGKM_WAIT4(4, fb0, fb1, fb2, fb3); QK_MM(fb0, fb1, fb2, fb3, p0, 1);
            QK_RD(fb0, fb1, fb2, fb3, 1, 0); LGKM_WAIT4(4, fa0, fa1, fa2, fa3); QK_MM(fa0, fa1, fa2, fa3, p0, 2);
            float ls0 = 0.f, ls1 = 0.f;
#pragma unroll
            for (int i = 0; i < 16; ++i) { p0[i] = __builtin_amdgcn_exp2f(fminf(p0[i], 100.f)); ls0 += p0[i]; }
            QK_RD(fa0, fa1, fa2, fa3, 1, 1); LGKM_WAIT4(4, fb0, fb1, fb2, fb3); QK_MM(fb0, fb1, fb2, fb3, p1, 0);
            QK_RD(fb0, fb1, fb2, fb3, 1, 2); LGKM_WAIT4(4, fa0, fa1, fa2, fa3); QK_MM(fa0, fa1, fa2, fa3, p1, 1);
            PV_RD(fa0, fa1, fa2, fa3, 0, 0); LGKM_WAIT4(4, fb0, fb1, fb2, fb3); QK_MM(fb0, fb1, fb2, fb3, p1, 2);
            { const bf16x8 x00 = PV_PK(p0, 0), x01 = PV_PK(p0, 1);
#pragma unroll
              for (int i = 0; i < 16; ++i) { p1[i] = __builtin_amdgcn_exp2f(fminf(p1[i], 100.f)); ls1 += p1[i]; }
              PV_RD(fb0, fb1, fb2, fb3, 0, 1); LGKM_WAIT4(4, fa0, fa1, fa2, fa3); PV_MM(fa0, fa1, fa2, fa3, x00);
              PV_RD(fa0, fa1, fa2, fa3, 1, 0); LGKM_WAIT4(4, fb0, fb1, fb2, fb3); PV_MM(fb0, fb1, fb2, fb3, x01);
              const bf16x8 x10 = PV_PK(p1, 0), x11 = PV_PK(p1, 1);
              PV_RD(fb0, fb1, fb2, fb3, 1, 1); LGKM_WAIT4(4, fa0, fa1, fa2, fa3); PV_MM(fa0, fa1, fa2, fa3, x10);
              LGKM_WAIT4(0, fb0, fb1, fb2, fb3); PV_MM(fb0, fb1, fb2, fb3, x11); }
            l_run += ls0 + ls1;
#undef QK_RD
#undef QK_MM
#undef PV_RD
#undef PV_PK
#undef PV_MM
        }
        if (t + 1 < NT) AT_SSTORE(buf ^ 1);
        __syncthreads();
    }
#undef AT_GLOAD
#undef AT_SSTORE
    const float lt = l_run + __shfl_xor(l_run, 32);
    wsf[r32] = 1.0f / lt;
    asm volatile("s_waitcnt lgkmcnt(0)" ::: "memory");
    GAS bf16_t* orow = mix + (size_t)(q0 + 32 * w) * DM + h * VD + r32;
#pragma unroll
    for (int i = 0; i < 16; ++i) { const int qr = crow(i, hh); const float a = wsf[qr]; float ss = 0.f;
#pragma unroll
        for (int d = 0; d < 4; ++d) { const float v = o[d][i] * a; ss += v * v; orow[(size_t)qr * DM + 32 * d] = (bf16_t)f2bf(v); }
        ss += __shfl_xor(ss, 1); ss += __shfl_xor(ss, 2); ss += __shfl_xor(ss, 4); ss += __shfl_xor(ss, 8); ss += __shfl_xor(ss, 16);
        if (r32 == 0) ssq_add(ssq_a + q0 + 32 * w + qr, ss); }
    __syncthreads();
}

constexpr int GL_V = 0  , GL_KD = 32768  , GL_TOT = GL_KD + 18432  , GL_ZA = GL_TOT + 2048  ;
__device__ __forceinline__ void gla_chunk_unit(LAS unsigned char* L, const bf16_t* Z_, const float* wgate_, const float* bgate_, bf16_t* ST_, float* DEC_, int c, int h) {
    GAS const bf16_t* Z = G_(Z_); GAS const float* wgate = G_(wgate_); GAS const float* bgate = G_(bgate_); GAS bf16_t* ST = G_(ST_); GAS float* DEC = G_(DEC_);
    int tid_ = threadIdx.x; LAUNDER_V(tid_);
    const int tid = tid_, lane = tid & 63, w = __builtin_amdgcn_readfirstlane(tid >> 6), r32 = lane & 31, hh = lane >> 5;
    const size_t row0 = (size_t)c * 64;
#pragma unroll
    for (int i = 0; i < 4; ++i) { const int id = tid + 512 * i, r = id >> 5, cc = id & 31;
        *(LAS u32x4*)(L + GL_V + r * 512 + cc * 16) = *(GAS const u32x4*)(Z + (row0 + r) * IN_PAD + C_GV + h * GDV + cc * 8); }
#pragma unroll
    for (int i = 0; i < 2; ++i) { const int id = tid + 512 * i, r = id >> 4, cc = id & 15;
        ((LAS float*)(L + GL_ZA))[id] = bf2f(Z[(row0 + r) * IN_PAD + C_GA + cc]); }
    __syncthreads();
    const int tq = tid >> 7, col = tid & 127;
    float wg[16];
#pragma unroll
    for (int r = 0; r < 16; ++r) wg[r] = wgate[r * (GH * GDK) + h * GDK + col];
    const float bg = bgate[h * GDK + col];
    float pre[16]; float run = 0.f;
#pragma unroll
    for (int i = 0; i < 16; ++i) {
        const LAS float* za = (const LAS float*)(L + GL_ZA) + (16 * tq + i) * 16;
        float ga = bg;
#pragma unroll
        for (int r = 0; r < 16; ++r) ga += za[r] * wg[r];
        const float ls = fminf(ga, 0.f) - __logf(1.0f + __expf(-fabsf(ga)));
        run += ls * (1.0f / 16.0f); pre[i] = run;
    }
    ((LAS float*)(L + GL_TOT))[tq * 128 + col] = run;
    __syncthreads();
    float off = 0.f, bend = 0.f;
#pragma unroll
    for (int t = 0; t < 4; ++t) { const float v = ((LAS float*)(L + GL_TOT))[t * 128 + col]; bend += v; if (t < tq) off += v; }
    {
        unsigned pkv[8];
#pragma unroll
        for (int i = 0; i < 16; i += 2) {
            const float k0 = bf2f(Z[(row0 + 16 * tq + i) * IN_PAD + C_GK + h * GDK + col]), k1 = bf2f(Z[(row0 + 16 * tq + i + 1) * IN_PAD + C_GK + h * GDK + col]);
            pkv[i >> 1] = pk2(k0 * __expf(bend - off - pre[i]), k1 * __expf(bend - off - pre[i + 1]));
        }
        LAS u32x4* dst = (LAS u32x4*)(L + GL_KD + col * 144 + tq * 32);
        dst[0] = (u32x4){pkv[0], pkv[1], pkv[2], pkv[3]}; dst[1] = (u32x4){pkv[4], pkv[5], pkv[6], pkv[7]};
    }
    if (tq == 0) DEC[(size_t)(c * GH + h) * GDK + col] = __expf(bend);
    __syncthreads();
    f32x16 acc[4];
#pragma unroll
    for (int d = 0; d < 4; ++d)
#pragma unroll
        for (int i = 0; i < 16; ++i) acc[d][i] = 0.f;
#pragma unroll
    for (int ks = 0; ks < 4; ++ks) {
        bf16x8 a;
#pragma unroll
        for (int j = 0; j < 8; ++j) a[j] = (short)*(const LAS unsigned short*)(L + GL_V + (16 * ks + 8 * hh + j) * 512 + (32 * w + r32) * 2);
#pragma unroll
        for (int db = 0; db < 4; ++db) {
            const bf16x8 b = *(const LAS bf16x8*)(L + GL_KD + (32 * db + r32) * 144 + (16 * ks + 8 * hh) * 2);
            acc[db] = MFMA32(a, b, acc[db]);
        }
    }
    GAS bf16_t* stp = ST + ((size_t)(c * GH + h) * GDV + 32 * w) * GDK + r32;
#pragma unroll
    for (int db = 0; db < 4; ++db)
#pragma unroll
        for (int i = 0; i < 16; ++i) stp[(size_t)crow(i, hh) * GDK + 32 * db] = (bf16_t)f2bf(acc[db][i]);
    __syncthreads();
}

constexpr int GO_STR = 260;
__device__ __forceinline__ void gla_out_unit(LAS unsigned char* L, const bf16_t* Z_, const bf16_t* ST_, const float* gnorm_, bf16_t* mix_, int c, int h) {
    GAS const bf16_t* Z = G_(Z_); GAS const bf16_t* ST = G_(ST_); GAS const float* gnorm = G_(gnorm_); GAS bf16_t* mix = G_(mix_);
    int tid_ = threadIdx.x; LAUNDER_V(tid_);
    const int tid = tid_, lane = tid & 63, w = __builtin_amdgcn_readfirstlane(tid >> 6), r32 = lane & 31, hh = lane >> 5;
    const size_t row0 = (size_t)c * 64;
    f32x16 acc[2];
#pragma unroll
    for (int d = 0; d < 2; ++d)
#pragma unroll
        for (int i = 0; i < 16; ++i) acc[d][i] = 0.f;
    GAS const bf16_t* sp = ST + ((size_t)(c * GH + h) * GDV + 32 * w + r32) * GDK + 8 * hh;
#pragma unroll
    for (int ks = 0; ks < 8; ++ks) {
        const bf16x8 b = *(GAS const bf16x8*)(sp + 16 * ks);
#pragma unroll
        for (int tb = 0; tb < 2; ++tb) {
            const bf16x8 a = *(GAS const bf16x8*)(Z + (row0 + 32 * tb + r32) * IN_PAD + C_GQ + h * GDK + 16 * ks + 8 * hh);
            acc[tb] = MFMA32(a, b, acc[tb]);
        }
    }
    LAS float* of = (LAS float*)L;
#pragma unroll
    for (int tb = 0; tb < 2; ++tb)
#pragma unroll
        for (int i = 0; i < 16; ++i) of[(32 * tb + crow(i, hh)) * GO_STR + 32 * w + r32] = acc[tb][i] * 0.08838834764831845f;
    __syncthreads();
    const int tok = tid >> 3, part = tid & 7;
    float v[32]; float ss = 0.f;
#pragma unroll
    for (int i = 0; i < 32; ++i) { v[i] = of[tok * GO_STR + i * 8 + part]; ss += v[i] * v[i]; }
    ss += __shfl_xor(ss, 1); ss += __shfl_xor(ss, 2); ss += __shfl_xor(ss, 4);
    const float rstd = rsqrtf(ss * (1.0f / GDV) + EPS);
    GAS const bf16_t* zg = Z + (row0 + tok) * IN_PAD + C_GG + h * GDV;
    GAS bf16_t* op = mix + (row0 + tok) * DM + 1024 + h * GDV;
#pragma unroll
    for (int i = 0; i < 32; ++i) { const int dv = i * 8 + part; const float g = bf2f(zg[dv]); op[dv] = (bf16_t)f2bf(v[i] * rstd * gnorm[dv] * silu_f(g)); }
    __syncthreads();
}


#define XB_TMO      128
#define XB_XCNT(j)  (256  + 64 * (j))
#define XB_XSUB(j)  (1280 + 64 * (j))
#define XB_XGEN(j)  (2304 + 64 * (j))
#define XB_TOP      3328
#define XB_TOPGEN   3392
#define XCD_BAR_WORDS 3456
#define XB_SPIN_CAP (1u << 22)
__device__ __forceinline__ unsigned xb_ld(unsigned* p)              { return __hip_atomic_load(p, __ATOMIC_RELAXED, __HIP_MEMORY_SCOPE_AGENT); }
__device__ __forceinline__ unsigned xb_add(unsigned* p, unsigned v) { return __hip_atomic_fetch_add(p, v, __ATOMIC_RELAXED, __HIP_MEMORY_SCOPE_AGENT); }
__device__ __forceinline__ unsigned xb_xcc_id() { return (unsigned)__builtin_amdgcn_s_getreg((3 << 11) | 20) & 0xFu; }
#define XB_SPIN(cond, bar) do { unsigned _sp = 0; while (cond) { __builtin_amdgcn_s_sleep(1); \
    if ((++_sp & 255u) == 0u) { if (xb_ld(&(bar)[XB_TMO])) break; if (_sp > XB_SPIN_CAP) { atomicAdd(&(bar)[XB_TMO], 1u); break; } } } } while (0)
struct XcdBarrier { unsigned* bar; unsigned x; volatile LAS unsigned* st; };
__device__ __forceinline__ XcdBarrier xcd_barrier_post(unsigned* bar, volatile LAS unsigned* st) {
    XcdBarrier b; b.bar = bar; b.x = xb_xcc_id(); b.st = st;
    if (threadIdx.x == 0) (void)xb_add(&bar[XB_XCNT(b.x)], 1u);
    return b;
}
__device__ __forceinline__ void xcd_barrier_complete(unsigned* bar, unsigned x, unsigned& nloc, unsigned& nx) {
    const unsigned G = gridDim.x * gridDim.y * gridDim.z;
    unsigned sum, cnt, mine, sp = 0u;
    for (;;) {
        sum = 0u; cnt = 0u; mine = 0u;
#pragma unroll
        for (unsigned j = 0; j < 16; ++j) { const unsigned c = xb_ld(&bar[XB_XCNT(j)]); sum += c; cnt += (c > 0u) ? 1u : 0u; mine = (j == x) ? c : mine; }
        if (sum == G) break;
        __builtin_amdgcn_s_sleep(1);
        if ((++sp & 255u) == 0u) { if (xb_ld(&bar[XB_TMO])) break; if (sp > XB_SPIN_CAP) { atomicAdd(&bar[XB_TMO], 1u); break; } }
    }
    nloc = mine > 0u ? mine : 1u; nx = cnt > 0u ? cnt : 1u;
}
__device__ __forceinline__ void xcd_barrier(const XcdBarrier& b) {
    asm volatile("s_waitcnt vmcnt(0)" ::: "memory");
    __syncthreads();
    if (threadIdx.x == 0) {
        unsigned* bar = b.bar;
        __builtin_amdgcn_s_waitcnt(0);
        unsigned nloc = b.st[0], nx = b.st[1];
        if (nloc == 0u) { xcd_barrier_complete(bar, b.x, nloc, nx); b.st[0] = nloc; b.st[1] = nx; }
        const unsigned old = xb_add(&bar[XB_XSUB(b.x)], 1u);
        const unsigned gen = old / nloc;
        if (old + 1u == (gen + 1u) * nloc) {
            __builtin_amdgcn_fence(__ATOMIC_RELEASE, "agent");
            asm volatile("s_waitcnt vmcnt(0)" ::: "memory");
            const unsigned og = xb_add(&bar[XB_TOP], 1u);
            const unsigned tg = og / nx;
            if (og + 1u == (tg + 1u) * nx) xb_add(&bar[XB_TOPGEN], 1u);
            else XB_SPIN(xb_ld(&bar[XB_TOPGEN]) == tg, bar);
            __builtin_amdgcn_fence(__ATOMIC_ACQUIRE, "agent");
            xb_add(&bar[XB_XGEN(b.x)], 1u);
            asm volatile("s_waitcnt vmcnt(0)" ::: "memory");
        } else {
            XB_SPIN(xb_ld(&bar[XB_XGEN(b.x)]) == gen, bar);
            __builtin_amdgcn_fence(__ATOMIC_ACQUIRE, "agent");
            asm volatile("s_waitcnt vmcnt(0)" ::: "memory");
        }
    }
    __syncthreads();
}

__global__ void __launch_bounds__(512, 2) mk_fwd(Args a) {
    extern __shared__ __attribute__((aligned(16))) unsigned char lds[];
    cg::grid_group grid = cg::this_grid();
    LAS unsigned char* L = (LAS unsigned char*)lds;
    const int G = gridDim.x, bid = blockIdx.x, NGW = G * 8;
    volatile LAS unsigned* MISC = (volatile LAS unsigned*)(L + RING_BYTES + 8192);
    if (threadIdx.x < 4) MISC[threadIdx.x] = 0u;
    __syncthreads();
    { KAP_T kap0 = (KAP_T)__builtin_amdgcn_kernarg_segment_ptr(); (void)xcd_barrier_post((unsigned*)(kap0->ws + WS_BAR), MISC); }
#define XSYNC() do { KAP_T kap_ = (KAP_T)__builtin_amdgcn_kernarg_segment_ptr(); LAUNDER_S(kap_); XcdBarrier xb_; xb_.bar = (unsigned*)(kap_->ws + WS_BAR); xb_.x = xb_xcc_id(); xb_.st = (volatile LAS unsigned*)(L + RING_BYTES + 8192); xcd_barrier(xb_); } while (0)
#define GRID_SYNC() do { asm volatile("s_waitcnt vmcnt(0) lgkmcnt(0)" ::: "memory"); __syncthreads(); grid.sync(); \
    __builtin_amdgcn_fence(__ATOMIC_ACQUIRE, "agent"); asm volatile("s_waitcnt vmcnt(0)" ::: "memory"); __syncthreads(); } while (0)
#ifndef DBG_STOP
#define DBG_STOP 0
#endif
#define DBG_DUMP(k, EXPR) do { if (DBG_STOP == (k)) { PHASE_BEGIN(); for (int m = gw; m < SEQ; m += NGW) for (int c = lane; c < DM; c += 64) out[(size_t)m * DM + c] = (EXPR); return; } } while (0)
#define PHASE_BEGIN() KAP_T kap = (KAP_T)__builtin_amdgcn_kernarg_segment_ptr(); LAUNDER_S(kap); unsigned char* ws = kap->ws; LAUNDER_S(ws); int tid_ = threadIdx.x; LAUNDER_V(tid_); const int tid = tid_, lane = tid & 63, wave = __builtin_amdgcn_readfirstlane(tid >> 6), gw = bid * 8 + wave; \
    u64* ssq = (u64*)(ws + WS_SSQ); (void)lane; (void)gw; (void)ssq; \
    u64* ssq_x = ssq + (size_t)l * SEQ; u64* ssq_xn = ssq + (size_t)(l + 1) * SEQ; u64* ssq_cq = ssq + (size_t)(3 + l) * SEQ; u64* ssq_ckv = ssq + (size_t)(5 + l) * SEQ; u64* ssq_x1 = ssq + (size_t)(7 + l) * SEQ; u64* ssq_a = ssq + (size_t)(9 + l) * SEQ; (void)ssq_a; \
    (void)ssq_x; (void)ssq_xn; (void)ssq_cq; (void)ssq_ckv; (void)ssq_x1; \
    bf16_t* Win = (bf16_t*)(ws + WS_WIN); bf16_t* Wuq = (bf16_t*)(ws + WS_WUQ); bf16_t* Wukv = (bf16_t*)(ws + WS_WUKV); \
    bf16_t* Wout = (bf16_t*)(ws + WS_WOUT); bf16_t* Wup = (bf16_t*)(ws + WS_WUP); bf16_t* Wdn = (bf16_t*)(ws + WS_WDN); \
    bf16_t* XB = (bf16_t*)(ws + WS_XB); bf16_t* Z = (bf16_t*)(ws + WS_Z); bf16_t* Qb = (bf16_t*)(ws + WS_Q); bf16_t* Kb = (bf16_t*)(ws + WS_K); bf16_t* Vt = (bf16_t*)(ws + WS_VT); \
    bf16_t* ST = (bf16_t*)(ws + WS_ST); float* DEC = (float*)(ws + WS_DEC); bf16_t* MIX = (bf16_t*)(ws + WS_MIX); \
    bf16_t* ACT = (bf16_t*)(ws + WS_ACT); float* EDGE = (float*)(ws + WS_EDGE); \
    const float* xin = kap->in[0]; float* out = kap->out; \
    (void)Win; (void)Wuq; (void)Wukv; (void)Wout; (void)Wup; (void)Wdn; (void)XB; (void)Z; (void)Qb; (void)Kb; (void)Vt; (void)ST; (void)DEC; (void)MIX; (void)EDGE; (void)ACT; (void)xin; (void)out;

    for (int l = 0; l < NLAYER; ++l) {
        {
            PHASE_BEGIN();
            LAS float* scr = (LAS float*)(L + wave * 16384);
            const float* w_in = kap->in[3] + (size_t)l * DM * IN_DIM; const float* w_uq = kap->in[5] + (size_t)l * QLORA * QW; const float* w_ukv = kap->in[7] + (size_t)l * KVLORA * KVW;
            const float* w_out = kap->in[14] + (size_t)l * DM * DM; const float* w_up = kap->in[16] + (size_t)l * DM * DFF2; const float* w_dn = kap->in[19] + (size_t)l * DFF * DM;
            const float* g_attn = kap->in[2] + l * DM; const float* g_cq = kap->in[4] + l * QLORA; const float* g_ckv = kap->in[6] + l * KVLORA; const float* g_mla = kap->in[13] + l * 1024; const float* g_ffn = kap->in[15] + l * DM;
            constexpr int I_IN = (DM / 64) * (IN_PAD / 32), I_UQ = (QLORA / 64) * (QW / 32), I_UKV = (KVLORA / 64) * (KVW / 32), I_OUT = (DM / 64) * (DM / 32), I_UP = (DM / 64) * (DFF2 / 32), I_DN = (DFF / 64) * (DM / 32);
            constexpr int NITEMS = I_IN + I_UQ + I_UKV + I_OUT + I_UP + I_DN;
            for (int it = gw; it < NITEMS; it += NGW) {
                int r = it;
                if (r < I_IN) { wt_item(w_in, DM, IN_DIM, g_attn, DM, Win, scr, r, IN_PAD / 32, lane); continue; } r -= I_IN;
                if (r < I_UQ) { wt_item(w_uq, QLORA, QW, g_cq, QLORA, Wuq, scr, r, QW / 32, lane); continue; } r -= I_UQ;
                if (r < I_UKV) { wt_item(w_ukv, KVLORA, KVW, g_ckv, KVLORA, Wukv, scr, r, KVW / 32, lane); continue; } r -= I_UKV;
                if (r < I_OUT) { wt_item(w_out, DM, DM, g_mla, 1024, Wout, scr, r, DM / 32, lane); continue; } r -= I_OUT;
                if (r < I_UP) { wt_item(w_up, DM, DFF2, g_ffn, DM, Wup, scr, r, DFF2 / 32, lane, true); continue; } r -= I_UP;
                wt_item(w_dn, DFF, DM, g_ffn, 0, Wdn, scr, r, DM / 32, lane);
            }
            if (l == 0) {
                for (int m = gw; m < SEQ; m += NGW) {
                    GAS const f32x4* xr = (GAS const f32x4*)(G_(xin) + (size_t)m * DM) + lane; float s = 0.f;
                    GAS u32x2* o8 = (GAS u32x2*)(G_(XB) + (size_t)m * DM) + lane;
#pragma unroll
                    for (int j = 0; j < 8; ++j) { const f32x4 v = xr[64 * j]; s += (v[0] * v[0] + v[1] * v[1]) + (v[2] * v[2] + v[3] * v[3]); o8[64 * j] = (u32x2){pk2(v[0], v[1]), pk2(v[2], v[3])}; }
                    s = wave_sum(s); if (lane == 0) G_(ssq_x)[m] = (u64)(s * SSQ_FX + 0.5f);
                }
            }
        }
        if (l == 0) GRID_SYNC(); else XSYNC();
        {
            PHASE_BEGIN();
            pg8::Gemm g{XB, Win, SEQ, IN_PAD, DM, DM, nullptr, 0.f}; pg8::StaticOrder S; S.init(SEQ, IN_PAD, G, bid);
            pg8::EpiRowScale E{Z, IN_PAD, ssq_x, 1.0f / DM, ssq_cq, 0, 2, ssq_ckv, 2, 3};
            pg8::gemm_phase<pg8::EpiRowScale>(L, g, S, E);
        }
        XSYNC();
        DBG_DUMP(1, bf2f(Z[(size_t)m * IN_PAD + c]) + bf2f(Z[(size_t)m * IN_PAD + 2048 + c]));
        {
            PHASE_BEGIN();
            { pg8::Gemm g{Z + C_CQ, Wuq, SEQ, QW, QLORA, IN_PAD, nullptr, 0.f}; pg8::StaticOrder S; S.init(SEQ, QW, G, bid);
              pg8::EpiRowScale E{Qb, QW, ssq_cq, 1.0f / QLORA, nullptr, 0, 0, nullptr, 0, 0};
              pg8::gemm_phase<pg8::EpiRowScale>(L, g, S, E); }
            { pg8::Gemm g{Z + C_CKV, Wukv, SEQ, KVW, KVLORA, IN_PAD, nullptr, 0.f}; pg8::StaticOrder S; S.init(SEQ, KVW, G, bid);
              pg8::EpiUkv E{Kb, Vt, ssq_ckv, 1.0f / KVLORA};
              pg8::gemm_phase<pg8::EpiUkv>(L, g, S, E); }
            const float* wgate = kap->in[10] + (size_t)l * 16 * (GH * GDK); const float* bgate = kap->in[11] + (size_t)l * (GH * GDK);
            for (int u = bid; u < NCHUNK * GH; u += G) gla_chunk_unit(L, Z, wgate, bgate, ST, DEC, u >> 2, u & 3);
        }
        XSYNC();
        DBG_DUMP(2, (c < QW ? bf2f(Qb[(size_t)m * QW + c]) + bf2f(Kb[(size_t)m * QW + c]) : bf2f(Vt[(size_t)(c - QW) * SEQ + m])) + bf2f(ST[(size_t)m * 8192 + c]) + bf2f(ST[(size_t)m * 8192 + 4096 + c]));
        {
            PHASE_BEGIN();
            const int* pos = (const int*)kap->in[1];
            const float* qn = kap->in[8] + l * QKD; const float* kn = kap->in[9] + l * QKD;
            const float qscale = 0.07216878364870322f * 1.4426950408889634f;
            for (int m = gw; m < SEQ; m += NGW) {
                const int i = lane & 31;
                const float ang = (float)G_(pos)[m] * kap->inv_freq[i];
                double rev = (double)ang * 0.15915494309189535; rev -= __builtin_rint(rev);
                const float sn = __builtin_amdgcn_sinf((float)rev), cs = __builtin_amdgcn_cosf((float)rev);
                const float krv = bf2f(G_(Z)[(size_t)m * IN_PAD + C_KR + lane]);
                GAS bf16_t* qp = G_(Qb) + (size_t)m * QW; GAS bf16_t* kp = G_(Kb) + (size_t)m * QW;
                float qa[NH][3], ka[NH][2], qs[NH], ks[NH];
#pragma unroll
                for (int h = 0; h < NH; ++h) { qa[h][0] = bf2f(qp[h * QKD + lane]); qa[h][1] = bf2f(qp[h * QKD + 64 + lane]); qa[h][2] = bf2f(qp[h * QKD + 128 + lane]);
                                               ka[h][0] = bf2f(kp[h * QKD + lane]); ka[h][1] = bf2f(kp[h * QKD + 64 + lane]); }
#pragma unroll
                for (int h = 0; h < NH; ++h) { qs[h] = qa[h][0] * qa[h][0] + qa[h][1] * qa[h][1] + qa[h][2] * qa[h][2]; ks[h] = ka[h][0] * ka[h][0] + ka[h][1] * ka[h][1] + krv * krv; }
#pragma unroll
                for (int o = 1; o < 64; o <<= 1)
#pragma unroll
                    for (int h = 0; h < NH; ++h) { qs[h] += __shfl_xor(qs[h], o); ks[h] += __shfl_xor(ks[h], o); }
                const float qg0 = G_(qn)[lane], qg1 = G_(qn)[64 + lane], qg2 = G_(qn)[128 + lane], kg0 = G_(kn)[lane], kg1 = G_(kn)[64 + lane], kg2 = G_(kn)[128 + lane];
#pragma unroll
                for (int h = 0; h < NH; ++h) {
                    { const float rstd = rsqrtf(qs[h] * (1.0f / QKD) + EPS);
                      const float n2 = qa[h][2] * rstd * qg2, pr = __shfl_xor(n2, 32);
                      const float r2 = (lane < 32) ? n2 * cs - pr * sn : n2 * cs + pr * sn;
                      qp[h * QKD + lane] = (bf16_t)f2bf(qa[h][0] * rstd * qg0 * qscale); qp[h * QKD + 64 + lane] = (bf16_t)f2bf(qa[h][1] * rstd * qg1 * qscale); qp[h * QKD + 128 + lane] = (bf16_t)f2bf(r2 * qscale); }
                    { const float rstd = rsqrtf(ks[h] * (1.0f / QKD) + EPS);
                      const float n2 = krv * rstd * kg2, pr = __shfl_xor(n2, 32);
                      const float r2 = (lane < 32) ? n2 * cs - pr * sn : n2 * cs + pr * sn;
                      kp[h * QKD + lane] = (bf16_t)f2bf(ka[h][0] * rstd * kg0); kp[h * QKD + 64 + lane] = (bf16_t)f2bf(ka[h][1] * rstd * kg1); kp[h * QKD + 128 + lane] = (bf16_t)f2bf(r2); }
                }
            }
            constexpr int NE = GH * GDV * GDK;
            for (int e = bid * 512 + tid; e < NE; e += G * 512) {
                const int hd = (e >> 15) * GDK + (e & 127);
                float s = 0.f;
                for (int c0 = 0; c0 < NCHUNK; c0 += 8) {
                    float uu[8], dd[8];
#pragma unroll
                    for (int i = 0; i < 8; ++i) { uu[i] = bf2f(G_(ST)[(size_t)(c0 + i) * NE + e]); dd[i] = G_(DEC)[(size_t)(c0 + i) * (GH * GDK) + hd]; }
#pragma unroll
                    for (int i = 0; i < 8; ++i) { s = s * dd[i] + uu[i]; G_(ST)[(size_t)(c0 + i) * NE + e] = (bf16_t)f2bf(s); }
                }
            }
        }
        XSYNC();
        DBG_DUMP(3, (c < QW ? bf2f(Qb[(size_t)m * QW + c]) + bf2f(Kb[(size_t)m * QW + c]) : 0.f) + bf2f(ST[(size_t)m * 8192 + c]) + bf2f(ST[(size_t)m * 8192 + 4096 + c]));
        {
            PHASE_BEGIN();
            for (int p = bid; p < 256; p += G) {
                const int h = p & 7, s = p >> 3;
                attn_unit(L, Qb, Kb, Vt, MIX, ssq_a, h, 63 - s);
                attn_unit(L, Qb, Kb, Vt, MIX, ssq_a, h, s);
            }
            const float* gnorm = kap->in[12] + l * GDV;
            for (int u = bid; u < NCHUNK * GH; u += G) gla_out_unit(L, Z, ST, gnorm, MIX, u >> 2, u & 3);
        }
        XSYNC();
        DBG_DUMP(4, bf2f(MIX[(size_t)m * DM + c]));
        DBG_DUMP(5, bf2f(MIX[(size_t)m * DM + c]));
        {
            PHASE_BEGIN();
            pg8::Gemm g{MIX, Wout, SEQ, DM, DM, DM, ssq_a, 1.0f / 1024.0f}; pg8::StaticOrder S; S.init(SEQ, DM, G, bid);
            pg8::EpiRes E{l == 0 ? xin : out, out, XB, ssq_x1};
            pg8::gemm_phase<pg8::EpiRes, true>(L, g, S, E);
        }
        XSYNC();
        DBG_DUMP(6, out[(size_t)m * DM + c] + bf2f(XB[(size_t)m * DM + c]));
        {
            PHASE_BEGIN();
            const float* cw = kap->in[17] + (size_t)l * 3 * DFF2; const float* cb = kap->in[18] + (size_t)l * DFF2;
            pg8::Gemm g{XB, Wup, SEQ, DFF2, DM, DM, nullptr, 0.f}; pg8::StaticOrder S; S.init(SEQ, DFF2, G, bid);
            pg8::EpiUpConv E{ACT, EDGE, ssq_x1, cw, cb, (LAS float*)(L + RING_BYTES)};
            pg8::gemm_phase<pg8::EpiUpConv>(L, g, S, E);
        }
        XSYNC();
        {
            PHASE_BEGIN();
            const float* cw = kap->in[17] + (size_t)l * 3 * DFF2; const float* cb = kap->in[18] + (size_t)l * DFF2;
            for (int idx = bid * 512 + tid; idx < 63 * DFF; idx += G * 512) {
                const int pm = 1 + idx / DFF, gcol = idx % DFF;
                float y0[2], y1[2];
#pragma unroll
                for (int q = 0; q < 2; ++q) { const int c = q * DFF + gcol;
                    const float um2 = G_(EDGE)[(size_t)((pm - 1) * 4 + 2) * DFF2 + c], um1 = G_(EDGE)[(size_t)((pm - 1) * 4 + 3) * DFF2 + c], u0 = G_(EDGE)[(size_t)(pm * 4 + 0) * DFF2 + c], u1 = G_(EDGE)[(size_t)(pm * 4 + 1) * DFF2 + c];
                    const float w0 = G_(cw)[c], w1 = G_(cw)[DFF2 + c], w2 = G_(cw)[2 * DFF2 + c], bb = G_(cb)[c];
                    y0[q] = bb + w0 * um2 + w1 * um1 + w2 * u0; y1[q] = bb + w0 * um1 + w1 * u0 + w2 * u1; }
                G_(ACT)[(size_t)(pm * 256) * DFF + gcol] = (bf16_t)f2bf(silu_f(y0[0]) * y0[1]);
                G_(ACT)[(size_t)(pm * 256 + 1) * DFF + gcol] = (bf16_t)f2bf(silu_f(y1[0]) * y1[1]);
            }
        }
        XSYNC();
        DBG_DUMP(8, bf2f(ACT[(size_t)m * DFF + c]) + bf2f(ACT[(size_t)m * DFF + 3000 + c]));
        {
            PHASE_BEGIN();
            pg8::Gemm g{ACT, Wdn, SEQ, DM, DFF, DFF, nullptr, 0.f}; pg8::StaticOrder S; S.init(SEQ, DM, G, bid);
            pg8::EpiRes E{out, out, XB, ssq_xn};
            pg8::gemm_phase<pg8::EpiRes>(L, g, S, E);
        }
        XSYNC();
        if (DBG_STOP == 9) return;
    }
}

extern "C" void kernel_launch(void* const* d_in, const int* in_sizes, int n_in, void* d_out, int out_size, void* d_ws, size_t ws_size, hipStream_t stream) {
    static int grid = 0;
    if (grid == 0) {
        if (n_in != 20 || out_size != SEQ * DM || ws_size < WS_END) { fprintf(stderr, "kernel_launch: unexpected shapes: n_in %d out %d ws %zu (need %zu)\n", n_in, out_size, ws_size, (size_t)WS_END); grid = -1; return; }
        int dev = 0, cus = 0, per_cu = 0;
        hipGetDevice(&dev); hipDeviceGetAttribute(&cus, hipDeviceAttributeMultiprocessorCount, dev);
        hipFuncSetAttribute((const void*)mk_fwd, hipFuncAttributeMaxDynamicSharedMemorySize, LDS_BYTES);
        hipOccupancyMaxActiveBlocksPerMultiprocessor(&per_cu, (const void*)mk_fwd, 512, LDS_BYTES);
        (void)hipGetLastError();
        if (per_cu < 1) per_cu = 1;
        grid = cus * 1;
    }
    if (grid < 0) return;
    hipMemsetAsync((char*)d_ws + WS_CTL, 0, CTL_BYTES, stream);
    Args a{};
    for (int i = 0; i < 20; ++i) a.in[i] = (const float*)d_in[i];
    a.out = (float*)d_out; a.ws = (unsigned char*)d_ws;
    for (int i = 0; i < 32; ++i) a.inv_freq[i] = (float)pow(10000.0, -(double)i / 32.0);
    void* args[] = {&a};
    hipError_t e = hipLaunchCooperativeKernel((const void*)mk_fwd, dim3(grid), dim3(512), args, LDS_BYTES, stream);
    if (e != hipSuccess) fprintf(stderr, "cooperative launch failed: %s (grid %d)\n", hipGetErrorString(e), grid);
}
```

```cpp
#include <hip/hip_runtime.h>
#include <hip/hip_cooperative_groups.h>
#include <cstdio>
#include <cstdint>
#include <cmath>
namespace cg = cooperative_groups;

#define LAS __attribute__((address_space(3)))
typedef unsigned short bf16_t;
typedef unsigned long long u64;
typedef short bf16x8 __attribute__((ext_vector_type(8)));
typedef short s16x4 __attribute__((ext_vector_type(4)));
typedef float f32x4 __attribute__((ext_vector_type(4)));
typedef float f32x16 __attribute__((ext_vector_type(16)));
typedef unsigned u32x4 __attribute__((ext_vector_type(4)));
typedef unsigned u32x2 __attribute__((ext_vector_type(2)));
typedef float f32x2_t __attribute__((ext_vector_type(2)));
typedef __bf16 bf16x2_t __attribute__((ext_vector_type(2)));

constexpr int SEQ = 16384, DM = 2048, NLAYER = 2;
constexpr int IN_DIM = 3920, IN_PAD = 4096;
constexpr int C_CQ = 0, C_CKV = 512, C_KR = 768, C_GQ = 832, C_GK = 1344, C_GV = 1856, C_GA = 2880, C_GG = 2896;
constexpr int QLORA = 512, KVLORA = 256, NH = 8, QKD = 192, NOPE = 128, VD = 128, QW = NH * QKD  , KVW = NH * 256  ;
constexpr int GH = 4, GDK = 128, GDV = 256, NCHUNK = SEQ / 64;
constexpr int DFF = 5632, DFF2 = 11264;
constexpr float EPS = 1e-6f;

constexpr size_t MiB = 1u << 20;
constexpr size_t WS_CTL = 0, CTL_BYTES = 2 * MiB;
constexpr size_t WS_BAR = 0;
constexpr size_t WS_SSQ = 65536;
constexpr size_t WS_WIN = 2 * MiB, WS_WUQ = 18 * MiB, WS_WUKV = WS_WUQ + 3 * MiB / 2, WS_WOUT = WS_WUKV + 1 * MiB, WS_WUP = WS_WOUT + 8 * MiB, WS_WDN = WS_WUP + 44 * MiB;
constexpr size_t WS_XB = 95 * MiB;
constexpr size_t WS_R = 159 * MiB;
constexpr size_t WS_Z = WS_R, WS_Q = WS_Z + 128 * MiB, WS_K = WS_Q + 48 * MiB, WS_VT = WS_K + 48 * MiB, WS_ST = WS_VT + 32 * MiB, WS_DEC = WS_ST + 128 * MiB, WS_MIX = WS_DEC + 1 * MiB;
constexpr size_t WS_ACT = WS_R, WS_EDGE = WS_ACT + 176 * MiB, WS_END = WS_MIX + 64 * MiB;
static_assert(WS_EDGE + 12 * MiB <= WS_END, "ws map");

#define GAS __attribute__((address_space(1)))
template <class T> __device__ __forceinline__ GAS T* G_(T* p) { return (GAS T*)p; }
#define LAUNDER_V(x) asm volatile("" : "+v"(x))
#define LAUNDER_S(x) asm volatile("" : "+s"(x))
__device__ __forceinline__ unsigned f2bf(float f) { unsigned u = __builtin_bit_cast(unsigned, f); return (u + 0x7fffu + ((u >> 16) & 1u)) >> 16; }
__device__ __forceinline__ unsigned pk2(float lo, float hi) { f32x2_t v = {lo, hi}; bf16x2_t b = __builtin_convertvector(v, bf16x2_t); return __builtin_bit_cast(unsigned, b); }
__device__ __forceinline__ float bf2f(unsigned b) { return __builtin_bit_cast(float, b << 16); }
__device__ __forceinline__ float bflo(unsigned w) { return __builtin_bit_cast(float, w << 16); }
__device__ __forceinline__ float bfhi(unsigned w) { return __builtin_bit_cast(float, w & 0xffff0000u); }
__device__ __forceinline__ float wave_sum(float v) {
#pragma unroll
    for (int o = 1; o < 64; o <<= 1) v += __shfl_xor(v, o);
    return v;
}
constexpr float SSQ_FX = 1048576.0f, SSQ_INV = 1.0f / 1048576.0f;
__device__ __forceinline__ void ssq_add(u64* p, float v) { __hip_atomic_fetch_add((GAS u64*)p, (u64)(v * SSQ_FX + 0.5f), __ATOMIC_RELAXED, __HIP_MEMORY_SCOPE_AGENT); }
__device__ __forceinline__ float ssq_get(const u64* p) { return (float)(*(GAS const u64*)p) * SSQ_INV; }
__device__ __forceinline__ float silu_f(float x) { return x * __builtin_amdgcn_rcpf(1.0f + __expf(-x)); }

namespace pg8 {
constexpr int BM = 256, BK = 64, HALF = 128, HTB = HALF * BK * 2, STAGE_BYTES = 8 * HTB, NXCD = 8, WGM = 8;
__host__ __device__ __forceinline__ int lds_byte(int r, int c) { const int st = (r >> 4) * 2 + (c >> 5), rr = r & 15, cc = c & 31, ob = rr * 64 + cc * 2; return st * 1024 + (ob ^ (((ob >> 9) & 1) << 5)); }
__host__ __device__ __forceinline__ void stage_rc(int b, int& R, int& C) { const int st = b / 1024, sb = b % 1024, swz = sb ^ (((sb >> 9) & 1) << 5); R = (st >> 1) * 16 + swz / 64; C = (st & 1) * 32 + (swz % 64) / 2; }
__host__ __device__ __forceinline__ int perm32(int rho) { const int n = rho >> 4, i = rho & 15; return 8 * (i >> 2) + 4 * n + (i & 3); }

struct Unit { int pm, pn; };
struct Gemm { const bf16_t* A; const bf16_t* Bt; int M, N, K, lda; const u64* mid_ssq; float mid_inv; };

struct StaticOrder {
    int nM, nN, nwg, G, c;
    __device__ void init(int M, int N, int G_, int c_) { nM = M / BM; nN = N / BM; nwg = nM * nN; G = G_; c = c_; }
    __device__ bool next(int i, Unit& u) const {
        const long L = (long)i * G + c; if (L >= nwg) return false;
        int wgid = (int)L; { const int q = nwg / NXCD, r = nwg % NXCD, xcd = wgid % NXCD, off = wgid / NXCD; wgid = (xcd < r ? xcd * (q + 1) : r * (q + 1) + (xcd - r) * q) + off; }
        const int nig = WGM * nN, gid = wgid / nig, fm = gid * WGM, gsz = (nM - fm) < WGM ? (nM - fm) : WGM;
        u.pm = fm + ((wgid % nig) % gsz); u.pn = (wgid % nig) / gsz; return true;
    }
};

struct EpiRowScale {
    static constexpr bool PERM = true;
    bf16_t* O; int ldc; const u64* ssq_in; float inv_dim; u64* ssq_a; int a_lo, a_hi; u64* ssq_b; int b_lo, b_hi;
    __device__ __forceinline__ void operator()(const f32x4 (&acc)[2][2][4][2], const Unit& u, int wr, int wc, int fr, int fq) const {
        const int row0 = u.pm * BM + wr * 64 + fr, col0 = u.pn * BM + wc * 32 + 8 * fq;
        u64* sacc = (u.pn >= a_lo && u.pn < a_hi) ? ssq_a : ((u.pn >= b_lo && u.pn < b_hi) ? ssq_b : nullptr);
#pragma unroll
        for (int ai = 0; ai < 2; ++ai)
#pragma unroll
            for (int m = 0; m < 4; ++m) {
                const int row = row0 + ai * HALF + m * 16;
                const float sc = ssq_in ? rsqrtf(ssq_get(ssq_in + row) * inv_dim + EPS) : 1.0f;
                float ss = 0.f;
#pragma unroll
                for (int bj = 0; bj < 2; ++bj) {
                    const f32x4 v0 = acc[ai][bj][m][0] * sc, v1 = acc[ai][bj][m][1] * sc;
                    ss += (v0[0] * v0[0] + v0[1] * v0[1]) + (v0[2] * v0[2] + v0[3] * v0[3]) + (v1[0] * v1[0] + v1[1] * v1[1]) + (v1[2] * v1[2] + v1[3] * v1[3]);
                    u32x4 w; w.x = pk2(v0[0], v0[1]); w.y = pk2(v0[2], v0[3]); w.z = pk2(v1[0], v1[1]); w.w = pk2(v1[2], v1[3]);
                    *(GAS u32x4*)(G_(O) + (size_t)row * ldc + col0 + bj * HALF) = w;
                }
                if (sacc) { ss += __shfl_xor(ss, 16); ss += __shfl_xor(ss, 32); if (fq == 0) ssq_add(sacc + row, ss); }
            }
    }
};
struct EpiUkv {
    static constexpr bool PERM = true;
    bf16_t* Kb; bf16_t* Vt; const u64* ssq_in; float inv_dim;
    __device__ __forceinline__ void operator()(const f32x4 (&acc)[2][2][4][2], const Unit& u, int wr, int wc, int fr, int fq) const {
        const int row0 = u.pm * BM + wr * 64 + fr, c0 = wc * 32 + 8 * fq;
#pragma unroll
        for (int ai = 0; ai < 2; ++ai)
#pragma unroll
            for (int m = 0; m < 4; ++m) {
                const int row = row0 + ai * HALF + m * 16;
                const int prow = (row & ~15) | (row & 3) | ((row & 4) << 1) | ((row & 8) >> 1);
                const float sc = rsqrtf(ssq_get(ssq_in + row) * inv_dim + EPS);
                { const f32x4 v0 = acc[ai][0][m][0] * sc, v1 = acc[ai][0][m][1] * sc;
                  u32x4 w; w.x = pk2(v0[0], v0[1]); w.y = pk2(v0[2], v0[3]); w.z = pk2(v1[0], v1[1]); w.w = pk2(v1[2], v1[3]);
                  *(GAS u32x4*)(G_(Kb) + (size_t)row * QW + u.pn * QKD + c0) = w; }
#pragma unroll
                for (int n = 0; n < 2; ++n)
#pragma unroll
                    for (int j = 0; j < 4; ++j) G_(Vt)[(size_t)(u.pn * VD + c0 + 4 * n + j) * SEQ + prow] = (bf16_t)f2bf(acc[ai][1][m][n][j] * sc);
            }
    }
};
struct EpiRes {
    static constexpr bool PERM = true;
    const float* base; float* out; bf16_t* xb; u64* ssq_out;
    __device__ __forceinline__ void operator()(const f32x4 (&acc)[2][2][4][2], const Unit& u, int wr, int wc, int fr, int fq) const {
        const int row0 = u.pm * BM + wr * 64 + fr, col0 = u.pn * BM + wc * 32 + 8 * fq;
#pragma unroll
        for (int ai = 0; ai < 2; ++ai)
#pragma unroll
            for (int m = 0; m < 4; ++m) {
                const int row = row0 + ai * HALF + m * 16; float ss = 0.f;
#pragma unroll
                for (int bj = 0; bj < 2; ++bj) {
                    const size_t off = (size_t)row * DM + col0 + bj * HALF;
                    const f32x4 v0 = acc[ai][bj][m][0] + *(GAS const f32x4*)(G_(base) + off), v1 = acc[ai][bj][m][1] + *(GAS const f32x4*)(G_(base) + off + 4);
                    ss += (v0[0] * v0[0] + v0[1] * v0[1]) + (v0[2] * v0[2] + v0[3] * v0[3]) + (v1[0] * v1[0] + v1[1] * v1[1]) + (v1[2] * v1[2] + v1[3] * v1[3]);
                    *(GAS f32x4*)(G_(out) + off) = v0; *(GAS f32x4*)(G_(out) + off + 4) = v1;
                    u32x4 w; w.x = pk2(v0[0], v0[1]); w.y = pk2(v0[2], v0[3]); w.z = pk2(v1[0], v1[1]); w.w = pk2(v1[2], v1[3]);
                    *(GAS u32x4*)(G_(xb) + off) = w;
                }
                ss += __shfl_xor(ss, 16); ss += __shfl_xor(ss, 32); if (fq == 0) ssq_add(ssq_out + row, ss);
            }
    }
};


#define DPP_SHR1(old, src) __builtin_bit_cast(float, __builtin_amdgcn_update_dpp(__builtin_bit_cast(int, (float)(old)), __builtin_bit_cast(int, (float)(src)), 0x111, 0xf, 0xf, false))
#define DPP_SHR2(old, src) __builtin_bit_cast(float, __builtin_amdgcn_update_dpp(__builtin_bit_cast(int, (float)(old)), __builtin_bit_cast(int, (float)(src)), 0x112, 0xf, 0xf, false))
#define DPP_ROR1(src) __builtin_bit_cast(float, __builtin_amdgcn_update_dpp(0, __builtin_bit_cast(int, (float)(src)), 0x121, 0xf, 0xf, false))
#define DPP_ROR2(src) __builtin_bit_cast(float, __builtin_amdgcn_update_dpp(0, __builtin_bit_cast(int, (float)(src)), 0x122, 0xf, 0xf, false))
struct EpiUpConv {
    static constexpr bool PERM = true;
    bf16_t* ACT; float* EDGE; const u64* ssq_in; const float* cw; const float* cb; LAS float* halo;
    __device__ __forceinline__ void operator()(f32x4 (&acc)[2][2][4][2], const Unit& u, int wr, int wc, int fr, int fq) const {
        const int row0 = u.pm * BM + wr * 64 + fr;
        const int g0 = u.pn * 128 + wc * 32 + 8 * fq;
#pragma unroll
        for (int ai = 0; ai < 2; ++ai)
#pragma unroll
            for (int m = 0; m < 4; ++m) {
                const float sc = rsqrtf(ssq_get(ssq_in + row0 + ai * HALF + m * 16) * (1.0f / DM) + EPS);
#pragma unroll
                for (int bj = 0; bj < 2; ++bj)
#pragma unroll
                    for (int n = 0; n < 2; ++n) acc[ai][bj][m][n] = acc[ai][bj][m][n] * sc;
            }
        if (fr >= 14) {
#pragma unroll
            for (int ai = 0; ai < 2; ++ai) { LAS float* hp = halo + ((((2 * ai + wr) * 4 + wc) * 2 + (fr - 14)) * 4 + fq) * 16;
#pragma unroll
                for (int bj = 0; bj < 2; ++bj)
#pragma unroll
                    for (int n = 0; n < 2; ++n) *(LAS f32x4*)(hp + bj * 8 + n * 4) = acc[ai][bj][3][n]; }
            if (wr == 1) { GAS float* ep = G_(EDGE) + (size_t)(u.pm * 4 + 2 + fr - 14) * DFF2 + g0;
#pragma unroll
                for (int bj = 0; bj < 2; ++bj)
#pragma unroll
                    for (int n = 0; n < 2; ++n) *(GAS f32x4*)(ep + bj * DFF + 4 * n) = acc[1][bj][3][n]; }
        }
        if (fr < 2 && wr == 0) { GAS float* ep = G_(EDGE) + (size_t)(u.pm * 4 + fr) * DFF2 + g0;
#pragma unroll
            for (int bj = 0; bj < 2; ++bj)
#pragma unroll
                for (int n = 0; n < 2; ++n) *(GAS f32x4*)(ep + bj * DFF + 4 * n) = acc[0][bj][0][n]; }
        asm volatile("s_waitcnt lgkmcnt(0)" ::: "memory"); __builtin_amdgcn_s_barrier(); asm volatile("" ::: "memory");
#pragma unroll
        for (int n = 0; n < 2; ++n) {
            const int gc = g0 + 4 * n;
            GAS const float* cwg = G_(cw); GAS const float* cbg = G_(cb);
            const f32x4 wg0 = *(GAS const f32x4*)(cwg + gc), wg1 = *(GAS const f32x4*)(cwg + DFF2 + gc), wg2 = *(GAS const f32x4*)(cwg + 2 * DFF2 + gc), bgv = *(GAS const f32x4*)(cbg + gc);
            const f32x4 wu0 = *(GAS const f32x4*)(cwg + DFF + gc), wu1 = *(GAS const f32x4*)(cwg + DFF2 + DFF + gc), wu2 = *(GAS const f32x4*)(cwg + 2 * DFF2 + DFF + gc), buv = *(GAS const f32x4*)(cbg + DFF + gc);
#pragma unroll
            for (int ai = 0; ai < 2; ++ai) {
                const int band = 2 * ai + wr;
                f32x4 pg = (f32x4){0.f, 0.f, 0.f, 0.f}, pu = pg;
                if (band > 0) { const LAS float* hp = halo + ((((band - 1) * 4 + wc) * 2 + (fr & 1)) * 4 + fq) * 16; pg = *(const LAS f32x4*)(hp + n * 4); pu = *(const LAS f32x4*)(hp + 8 + n * 4); }
#pragma unroll
                for (int m = 0; m < 4; ++m) {
                    const f32x4 cg = acc[ai][0][m][n], cu = acc[ai][1][m][n];
                    float av[4];
#pragma unroll
                    for (int j = 0; j < 4; ++j) {
                        const float g1 = DPP_SHR1(DPP_ROR1(pg[j]), cg[j]), g2 = DPP_SHR2(DPP_ROR2(pg[j]), cg[j]);
                        const float u1 = DPP_SHR1(DPP_ROR1(pu[j]), cu[j]), u2 = DPP_SHR2(DPP_ROR2(pu[j]), cu[j]);
                        const float yg = bgv[j] + wg0[j] * g2 + wg1[j] * g1 + wg2[j] * cg[j];
                        const float yu = buv[j] + wu0[j] * u2 + wu1[j] * u1 + wu2[j] * cu[j];
                        av[j] = silu_f(yg) * yu;
                    }
                    *(GAS u32x2*)(G_(ACT) + (size_t)(row0 + ai * HALF + m * 16) * DFF + gc) = (u32x2){pk2(av[0], av[1]), pk2(av[2], av[3])};
                    pg = cg; pu = cu;
                }
            }
        }
    }
};

template <class Epi, bool MIDSCALE = false>
__device__ __forceinline__ void gemm_phase(LAS unsigned char* lds, const Gemm g, const StaticOrder& S, const Epi& E) {
    int tid_ = threadIdx.x; LAUNDER_V(tid_);
    const int tid = tid_, wid = __builtin_amdgcn_readfirstlane(tid >> 6), lane = tid & 63, wr = wid >> 2, wc = wid & 3, fr = lane & 15, fq = lane >> 4;
    const int K = g.K, nt = K / BK;
    unsigned voffA[2], voffB[2];
#pragma unroll
    for (int i = 0; i < 2; ++i) { int R, C; stage_rc(tid * 16 + i * 8192, R, C); const int Rb = Epi::PERM ? ((R & ~31) + perm32(R & 31)) : R;
        voffA[i] = (unsigned)(R * g.lda + C) * 2u; voffB[i] = (unsigned)(Rb * K + C) * 2u; }
    const size_t kstep = (size_t)(BK * 2);
    const size_t hstepA = (size_t)HALF * g.lda * 2, hstepB = (size_t)HALF * K * 2;
    const size_t tstepA = 2 * hstepA, tstepB = 2 * hstepB;
    const unsigned ldsw = (unsigned)wid * 1024u;
    const int aoff = lds_byte(wr * 64 + fr, fq * 8), boff = lds_byte(wc * 32 + fr, fq * 8);
#define PG8_SA(b, h) (((b) * 2 + (h)) * HTB)
#define PG8_SB(b, h) ((4 + (b) * 2 + (h)) * HTB)
#define PG8_STAGE(bufoff, gbase, voff) do { _Pragma("unroll") for (int _i = 0; _i < 2; ++_i) \
        __builtin_amdgcn_global_load_lds((const unsigned*)((const char*)(gbase) + (voff)[_i]), (LAS unsigned*)(lds + (bufoff) + ldsw + _i * 8192), 16, 0, 0); } while (0)
#define PG8_LDA(dst, b, h) do { _Pragma("unroll") for (int m = 0; m < 4; ++m) _Pragma("unroll") for (int k = 0; k < 2; ++k) dst[m][k] = *(const LAS bf16x8*)(lds + PG8_SA(b, h) + aoff + m * 2048 + k * 1024); } while (0)
#define PG8_LDB(dst, b, h) do { _Pragma("unroll") for (int n = 0; n < 2; ++n) _Pragma("unroll") for (int k = 0; k < 2; ++k) dst[n][k] = *(const LAS bf16x8*)(lds + PG8_SB(b, h) + boff + n * 2048 + k * 1024); } while (0)
#define PG8_MMA(ai, bj, At, Bt) do { __builtin_amdgcn_s_setprio(1); _Pragma("unroll") for (int m = 0; m < 4; ++m) _Pragma("unroll") for (int n = 0; n < 2; ++n) _Pragma("unroll") for (int k = 0; k < 2; ++k) \
        acc[ai][bj][m][n] = __builtin_amdgcn_mfma_f32_16x16x32_bf16(Bt[n][k], At[m][k], acc[ai][bj][m][n], 0, 0, 0); __builtin_amdgcn_s_setprio(0); } while (0)
#define PG8_WAIT_V(n) asm volatile("s_waitcnt vmcnt(" #n ")" ::: "memory")
#define PG8_WAIT_L(n) asm volatile("s_waitcnt lgkmcnt(" #n ")" ::: "memory")
#define PG8_BAR __builtin_amdgcn_s_barrier()
#define PG8_SCHED __builtin_amdgcn_sched_barrier(0)
    Unit cur, nxt; int ui = 0;
    if (!S.next(0, cur)) return;
    f32x4 acc[2][2][4][2];
#pragma unroll
    for (int a = 0; a < 2; ++a)
#pragma unroll
        for (int b = 0; b < 2; ++b)
#pragma unroll
            for (int m = 0; m < 4; ++m)
#pragma unroll
                for (int n = 0; n < 2; ++n) acc[a][b][m][n] = (f32x4){0.f, 0.f, 0.f, 0.f};
    bf16x8 At[4][2], B0[2][2], B1[2][2];
    const char* cA = (const char*)g.A + (size_t)cur.pm * tstepA; const char* cB = (const char*)g.Bt + (size_t)cur.pn * tstepB;
    PG8_STAGE(PG8_SB(0, 0), cB, voffB); PG8_STAGE(PG8_SB(0, 1), cB + hstepB, voffB); PG8_STAGE(PG8_SA(0, 0), cA, voffA); PG8_STAGE(PG8_SA(0, 1), cA + hstepA, voffA);
    if (wr == 1) PG8_BAR;
    PG8_WAIT_V(2); PG8_BAR;
    PG8_STAGE(PG8_SB(1, 0), cB + kstep, voffB); PG8_STAGE(PG8_SA(1, 0), cA + kstep, voffA); PG8_STAGE(PG8_SB(1, 1), cB + hstepB + kstep, voffB);
    PG8_WAIT_V(6); PG8_BAR;
    for (;;) {
        const bool has_next = S.next(ui + 1, nxt);
        const char* nA = has_next ? (const char*)g.A + (size_t)nxt.pm * tstepA : cA; const char* nB = has_next ? (const char*)g.Bt + (size_t)nxt.pn * tstepB : cB;
        for (int t = 0; t < nt; t += 2) {
            const bool last = (t == nt - 2);
            const char* a1 = cA + (size_t)(t + 1) * kstep;
            const char* a2 = last ? nA : cA + (size_t)(t + 2) * kstep; const char* b2 = last ? nB : cB + (size_t)(t + 2) * kstep;
            const char* a3 = a2 + kstep; const char* b3 = b2 + kstep;
            if constexpr (MIDSCALE) { if (t == nt / 2) {
#pragma unroll
                for (int ai = 0; ai < 2; ++ai)
#pragma unroll
                    for (int m = 0; m < 4; ++m) { const float sc = rsqrtf(ssq_get(g.mid_ssq + cur.pm * BM + ai * HALF + wr * 64 + m * 16 + fr) * g.mid_inv + EPS);
#pragma unroll
                        for (int bj = 0; bj < 2; ++bj)
#pragma unroll
                            for (int n = 0; n < 2; ++n) acc[ai][bj][m][n] = acc[ai][bj][m][n] * sc; } } }
            PG8_LDB(B0, 0, 0); PG8_LDB(B1, 0, 1); PG8_SCHED; PG8_LDA(At, 0, 0); PG8_STAGE(PG8_SA(1, 1), a1 + hstepA, voffA);
            PG8_WAIT_V(8); PG8_WAIT_L(0); PG8_BAR; PG8_MMA(0, 0, At, B0); PG8_MMA(0, 1, At, B1); PG8_BAR; PG8_SCHED;
            PG8_LDA(At, 0, 1); PG8_STAGE(PG8_SB(0, 0), b2, voffB); PG8_STAGE(PG8_SB(0, 1), b2 + hstepB, voffB); PG8_STAGE(PG8_SA(0, 0), a2, voffA);
            PG8_WAIT_V(8); PG8_WAIT_L(0); PG8_BAR; PG8_MMA(1, 0, At, B0); PG8_MMA(1, 1, At, B1); PG8_BAR; PG8_SCHED;
            PG8_LDB(B0, 1, 0); PG8_LDB(B1, 1, 1); PG8_SCHED; PG8_LDA(At, 1, 0); PG8_STAGE(PG8_SA(0, 1), a2 + hstepA, voffA);
            PG8_WAIT_V(8); PG8_WAIT_L(0); PG8_BAR; PG8_MMA(0, 0, At, B0); PG8_MMA(0, 1, At, B1); PG8_BAR; PG8_SCHED;
            PG8_LDA(At, 1, 1); PG8_STAGE(PG8_SB(1, 0), b3, voffB); PG8_STAGE(PG8_SB(1, 1), b3 + hstepB, voffB); PG8_STAGE(PG8_SA(1, 0), a3, voffA);
            PG8_WAIT_V(8); PG8_WAIT_L(0); PG8_BAR; PG8_MMA(1, 0, At, B0); PG8_MMA(1, 1, At, B1); PG8_BAR; PG8_SCHED;
        }
        if (wr == 0) PG8_BAR;
        { int frE = fr, fqE = fq; LAUNDER_V(frE); LAUNDER_V(fqE); E(acc, cur, wr, wc, frE, fqE); }
        if (!has_next) break;
#pragma unroll
        for (int a = 0; a < 2; ++a)
#pragma unroll
            for (int b = 0; b < 2; ++b)
#pragma unroll
                for (int m = 0; m < 4; ++m)
#pragma unroll
                    for (int n = 0; n < 2; ++n) acc[a][b][m][n] = (f32x4){0.f, 0.f, 0.f, 0.f};
        cur = nxt; cA = nA; cB = nB; ++ui;
        if (wr == 1) PG8_BAR;
    }
    PG8_WAIT_V(0);
    PG8_BAR;
#undef PG8_SA
#undef PG8_SB
#undef PG8_STAGE
#undef PG8_LDA
#undef PG8_LDB
#undef PG8_MMA
#undef PG8_WAIT_V
#undef PG8_WAIT_L
#undef PG8_BAR
#undef PG8_SCHED
}
}

constexpr int RING_BYTES = 131072;
constexpr int LDS_BYTES = 147456;

struct Args { const float* in[20]; float* out; unsigned char* ws; float inv_freq[32]; };
typedef const __attribute__((address_space(4))) Args* KAP_T;

#define DS_READ4(r0, r1, r2, r3, addr, o0, o1, o2, o3) asm volatile("ds_read_b128 %0, %4 offset:%5\n\tds_read_b128 %1, %4 offset:%6\n\tds_read_b128 %2, %4 offset:%7\n\tds_read_b128 %3, %4 offset:%8" \
    : "=&v"(r0), "=&v"(r1), "=&v"(r2), "=&v"(r3) : "v"(addr), "i"(o0), "i"(o1), "i"(o2), "i"(o3) : "memory")
#define LGKM_WAIT4(n, r0, r1, r2, r3) asm volatile("s_waitcnt lgkmcnt(" #n ")" : "+v"(r0), "+v"(r1), "+v"(r2), "+v"(r3) :: "memory")
#define MFMA32(a, b, c) __builtin_amdgcn_mfma_f32_32x32x16_bf16((a), (b), (c), 0, 0, 0)
__device__ __forceinline__ int crow(int r, int hi) { return (r & 3) + 8 * (r >> 2) + 4 * hi; }

__device__ __forceinline__ void wt_item(const float* __restrict__ W, int K, int N, const float* __restrict__ gain, int gainK, bf16_t* WT, LAS float* scr, int item, int nblk, int lane, bool remap_up = false) {
    const int kb = item / nblk, nb = item % nblk, k0 = 64 * kb, n0 = 32 * nb;
    const int ns0 = remap_up ? (((n0 & 255) < 128) ? 128 * (n0 >> 8) + (n0 & 255) : DFF + 128 * (n0 >> 8) + (n0 & 255) - 128) : n0;
    const int n = ns0 + (lane & 31);
    float wv[32];
#pragma unroll
    for (int i = 0; i < 32; ++i) { const int kk = 2 * i + (lane >> 5); wv[i] = (n < N) ? G_(W)[(size_t)(k0 + kk) * N + n] : 0.f; }
#pragma unroll
    for (int i = 0; i < 32; ++i) { const int kk = 2 * i + (lane >> 5); scr[kk * 33 + (lane & 31)] = wv[i]; }
    asm volatile("s_waitcnt lgkmcnt(0)" ::: "memory");
    const int c = lane & 7;
    f32x4 g0 = (f32x4){1.f, 1.f, 1.f, 1.f}, g1 = g0;
    if (k0 < gainK) { g0 = *(GAS const f32x4*)(G_(gain) + k0 + 8 * c); g1 = *(GAS const f32x4*)(G_(gain) + k0 + 8 * c + 4); }
#pragma unroll
    for (int j = 0; j < 4; ++j) { const int nn = (lane >> 3) + 8 * j; const LAS float* s = scr + (8 * c) * 33 + nn;
        u32x4 o; o.x = pk2(s[0 * 33] * g0[0], s[1 * 33] * g0[1]); o.y = pk2(s[2 * 33] * g0[2], s[3 * 33] * g0[3]); o.z = pk2(s[4 * 33] * g1[0], s[5 * 33] * g1[1]); o.w = pk2(s[6 * 33] * g1[2], s[7 * 33] * g1[3]);
        *(GAS u32x4*)(G_(WT) + (size_t)(n0 + nn) * K + k0 + 8 * c) = o; }
    asm volatile("s_waitcnt lgkmcnt(0)" ::: "memory");
}

constexpr int AT_KSTR = 400, AT_VSTR = 144;
constexpr int AT_KB = 64 * AT_KSTR  , AT_VB = 128 * AT_VSTR  , AT_K0 = 0, AT_V0 = 2 * AT_KB, AT_WSF = AT_V0 + 2 * AT_VB;
static_assert(AT_WSF + 8 * 128 <= RING_BYTES, "attn lds");

__device__ __forceinline__ void attn_unit(LAS unsigned char* L, const bf16_t* Q_, const bf16_t* Kg_, const bf16_t* Vt_, bf16_t* mix_, u64* ssq_a, int h, int qb) {
    GAS const bf16_t* Q = G_(Q_); GAS const bf16_t* Kg = G_(Kg_); GAS const bf16_t* Vt = G_(Vt_); GAS bf16_t* mix = G_(mix_);
    int tid_ = threadIdx.x; LAUNDER_V(tid_);
    const int tid = tid_, lane = tid & 63, w = __builtin_amdgcn_readfirstlane(tid >> 6), r32 = lane & 31, hh = lane >> 5;
    const int q0 = qb * 256;
    bf16x8 qf[12];
    { GAS const bf16_t* qrow = Q + (size_t)(q0 + 32 * w + r32) * QW + h * QKD + 8 * hh;
#pragma unroll
      for (int ks = 0; ks < 12; ++ks) qf[ks] = *(GAS const bf16x8*)(qrow + 16 * ks); }
    f32x16 o[4];
#pragma unroll
    for (int d = 0; d < 4; ++d)
#pragma unroll
        for (int i = 0; i < 16; ++i) o[d][i] = 0.f;
    float l_run = 0.f;
    const int NT = 4 * qb + 4, my_last = 4 * qb + (w >> 1);
    volatile LAS float* wsf = (volatile LAS float*)(L + AT_WSF) + w * 32;
    const unsigned lds_base = (unsigned)(uintptr_t)L;
    u32x4 kst[3], vst[2];
#define AT_GLOAD(t) do { const int kv0_ = (t) * 64; int x_ = tid; LAUNDER_V(x_); \
    _Pragma("unroll") for (int i = 0; i < 3; ++i) { const int id_ = x_ + 512 * i, r_ = id_ / 24, c_ = id_ - 24 * r_; kst[i] = *(GAS const u32x4*)(Kg + (size_t)(kv0_ + r_) * QW + h * QKD + c_ * 8); } \
    _Pragma("unroll") for (int i = 0; i < 2; ++i) { const int id_ = x_ + 512 * i; vst[i] = *(GAS const u32x4*)(Vt + (size_t)(h * VD + (id_ >> 3)) * SEQ + kv0_ + (id_ & 7) * 8); } } while (0)
#define AT_SSTORE(buf) do { int x_ = tid; LAUNDER_V(x_); \
    _Pragma("unroll") for (int i = 0; i < 3; ++i) { const int id_ = x_ + 512 * i, r_ = id_ / 24, c_ = id_ - 24 * r_; *(LAS u32x4*)(L + AT_K0 + (buf) * AT_KB + r_ * AT_KSTR + c_ * 16) = kst[i]; } \
    _Pragma("unroll") for (int i = 0; i < 2; ++i) { const int id_ = x_ + 512 * i; *(LAS u32x4*)(L + AT_V0 + (buf) * AT_VB + (id_ >> 3) * AT_VSTR + (id_ & 7) * 16) = vst[i]; } } while (0)
    AT_GLOAD(0); AT_SSTORE(0); AT_GLOAD(1); __syncthreads();
    for (int t = 0; t < NT; ++t) {
        const int buf = t & 1;
        if (t + 1 < NT) AT_SSTORE(buf ^ 1);
        if (t + 2 < NT) AT_GLOAD(t + 2);
        if (t <= my_last) {
            const unsigned kaddr = lds_base + AT_K0 + buf * AT_KB + r32 * AT_KSTR + hh * 16;
            const unsigned vaddr = lds_base + AT_V0 + buf * AT_VB + r32 * AT_VSTR + hh * 16;
            f32x16 p0, p1;
#pragma unroll
            for (int i = 0; i < 16; ++i) { p0[i] = 0.f; p1[i] = 0.f; }
            bf16x8 fa0, fa1, fa2, fa3, fb0, fb1, fb2, fb3;
#define QK_RD(s0, s1, s2, s3, kb, g) DS_READ4(s0, s1, s2, s3, kaddr, (kb) * 32 * AT_KSTR + (4 * (g)) * 32, (kb) * 32 * AT_KSTR + (4 * (g) + 1) * 32, (kb) * 32 * AT_KSTR + (4 * (g) + 2) * 32, (kb) * 32 * AT_KSTR + (4 * (g) + 3) * 32)
#define QK_MM(s0, s1, s2, s3, P, g) do { P = MFMA32(s0, qf[4 * (g)], P); P = MFMA32(s1, qf[4 * (g) + 1], P); P = MFMA32(s2, qf[4 * (g) + 2], P); P = MFMA32(s3, qf[4 * (g) + 3], P); } while (0)
#define PV_RD(s0, s1, s2, s3, kb, ss) DS_READ4(s0, s1, s2, s3, vaddr, (kb) * 64 + (ss) * 32, 32 * AT_VSTR + (kb) * 64 + (ss) * 32, 64 * AT_VSTR + (kb) * 64 + (ss) * 32, 96 * AT_VSTR + (kb) * 64 + (ss) * 32)
#define PV_PK(P, ss) __builtin_bit_cast(bf16x8, (u32x4){pk2(P[8 * (ss) + 0], P[8 * (ss) + 1]), pk2(P[8 * (ss) + 2], P[8 * (ss) + 3]), pk2(P[8 * (ss) + 4], P[8 * (ss) + 5]), pk2(P[8 * (ss) + 6], P[8 * (ss) + 7])})
#define PV_MM(s0, s1, s2, s3, xs) do { o[0] = MFMA32(xs, s0, o[0]); o[1] = MFMA32(xs, s1, o[1]); o[2] = MFMA32(xs, s2, o[2]); o[3] = MFMA32(xs, s3, o[3]); } while (0)
            QK_RD(fa0, fa1, fa2, fa3, 0, 0);
            QK_RD(fb0, fb1, fb2, fb3, 0, 1); LGKM_WAIT4(4, fa0, fa1, fa2, fa3); QK_MM(fa0, fa1, fa2, fa3, p0, 0);
            QK_RD(fa0, fa1, fa2, fa3, 0, 2); LGKM_WAIT4(4, fb0, fb1, fb2, fb3); QK_MM(fb0, fb1, fb2, fb3, p0, 1);
            QK_RD(fb0, fb1, fb2, fb3, 1, 0); LGKM_WAIT4(4, fa0, fa1, fa2, fa3); QK_MM(fa0, fa1, fa2, fa3, p0, 2);
            float ls0 = 0.f, ls1 = 0.f;
#pragma unroll
            for (int i = 0; i < 16; ++i) { p0[i] = __builtin_amdgcn_exp2f(__builtin_amdgcn_fmed3f(p0[i], -1000.f, 100.f)); ls0 += p0[i]; }
            QK_RD(fa0, fa1, fa2, fa3, 1, 1); LGKM_WAIT4(4, fb0, fb1, fb2, fb3); QK_MM(fb0, fb1, fb2, fb3, p1, 0);
            QK_RD(fb0, fb1, fb2, fb3, 1, 2); LGKM_WAIT4(4, fa0, fa1, fa2, fa3); QK_MM(fa0, fa1, fa2, fa3, p1, 1);
            PV_RD(fa0, fa1, fa2, fa3, 0, 0); LGKM_WAIT4(4, fb0, fb1, fb2, fb3); QK_MM(fb0, fb1, fb2, fb3, p1, 2);
            { const bf16x8 x00 = PV_PK(p0, 0), x01 = PV_PK(p0, 1);
#pragma unroll
              for (int i = 0; i < 16; ++i) { p1[i] = __builtin_amdgcn_exp2f(__builtin_amdgcn_fmed3f(p1[i], -1000.f, 100.f)); ls1 += p1[i]; }
              PV_RD(fb0, fb1, fb2, fb3, 0, 1); LGKM_WAIT4(4, fa0, fa1, fa2, fa3); PV_MM(fa0, fa1, fa2, fa3, x00);
              PV_RD(fa0, fa1, fa2, fa3, 1, 0); LGKM_WAIT4(4, fb0, fb1, fb2, fb3); PV_MM(fb0, fb1, fb2, fb3, x01);
              const bf16x8 x10 = PV_PK(p1, 0), x11 = PV_PK(p1, 1);
              PV_RD(fb0, fb1, fb2, fb3, 1, 1); LGKM_WAIT4(4, fa0, fa1, fa2, fa3); PV_MM(fa0, fa1, fa2, fa3, x10);
              LGKM_WAIT4(0, fb0, fb1, fb2, fb3); PV_MM(fb0, fb1, fb2, fb3, x11); }
            l_run += ls0 + ls1;
#undef QK_RD
#undef QK_MM
#undef PV_RD
#undef PV_PK
#undef PV_MM
        }
        asm volatile("s_waitcnt lgkmcnt(0)" ::: "memory"); __builtin_amdgcn_s_barrier(); asm volatile("" ::: "memory");
    }
#undef AT_GLOAD
#undef AT_SSTORE
    const float lt = l_run + __shfl_xor(l_run, 32);
    wsf[r32] = 1.0f / lt;
    asm volatile("s_waitcnt lgkmcnt(0)" ::: "memory");
    GAS bf16_t* orow = mix + (size_t)(q0 + 32 * w) * DM + h * VD + r32;
#pragma unroll
    for (int i = 0; i < 16; ++i) { const int qr = crow(i, hh); const float a = wsf[qr]; float ss = 0.f;
#pragma unroll
        for (int d = 0; d < 4; ++d) { const float v = o[d][i] * a; ss += v * v; orow[(size_t)qr * DM + 32 * d] = (bf16_t)f2bf(v); }
        ss += __shfl_xor(ss, 1); ss += __shfl_xor(ss, 2); ss += __shfl_xor(ss, 4); ss += __shfl_xor(ss, 8); ss += __shfl_xor(ss, 16);
        if (r32 == 0) ssq_add(ssq_a + q0 + 32 * w + qr, ss); }
    __syncthreads();
}

constexpr int GL_V = 0  , GL_KD = 32768  , GL_TOT = GL_KD + 18432  , GL_ZA = GL_TOT + 2048  ;
__device__ __forceinline__ void gla_chunk_unit(LAS unsigned char* L, const bf16_t* Z_, const float* wgate_, const float* bgate_, bf16_t* ST_, float* DEC_, int c, int h) {
    GAS const bf16_t* Z = G_(Z_); GAS const float* wgate = G_(wgate_); GAS const float* bgate = G_(bgate_); GAS bf16_t* ST = G_(ST_); GAS float* DEC = G_(DEC_);
    int tid_ = threadIdx.x; LAUNDER_V(tid_);
    const int tid = tid_, lane = tid & 63, w = __builtin_amdgcn_readfirstlane(tid >> 6), r32 = lane & 31, hh = lane >> 5;
    const size_t row0 = (size_t)c * 64;
#pragma unroll
    for (int i = 0; i < 4; ++i) { const int id = tid + 512 * i, r = id >> 5, cc = id & 31;
        *(LAS u32x4*)(L + GL_V + r * 512 + cc * 16) = *(GAS const u32x4*)(Z + (row0 + r) * IN_PAD + C_GV + h * GDV + cc * 8); }
#pragma unroll
    for (int i = 0; i < 2; ++i) { const int id = tid + 512 * i, r = id >> 4, cc = id & 15;
        ((LAS float*)(L + GL_ZA))[id] = bf2f(Z[(row0 + r) * IN_PAD + C_GA + cc]); }
    __syncthreads();
    const int tq = tid >> 7, col = tid & 127;
    float wg[16];
#pragma unroll
    for (int r = 0; r < 16; ++r) wg[r] = wgate[r * (GH * GDK) + h * GDK + col];
    const float bg = bgate[h * GDK + col];
    float pre[16]; float run = 0.f;
#pragma unroll
    for (int i = 0; i < 16; ++i) {
        const LAS float* za = (const LAS float*)(L + GL_ZA) + (16 * tq + i) * 16;
        float ga = bg;
#pragma unroll
        for (int r = 0; r < 16; ++r) ga += za[r] * wg[r];
        const float ls = fminf(ga, 0.f) - __logf(1.0f + __expf(-fabsf(ga)));
        run += ls * (1.0f / 16.0f); pre[i] = run;
    }
    ((LAS float*)(L + GL_TOT))[tq * 128 + col] = run;
    __syncthreads();
    float off = 0.f, bend = 0.f;
#pragma unroll
    for (int t = 0; t < 4; ++t) { const float v = ((LAS float*)(L + GL_TOT))[t * 128 + col]; bend += v; if (t < tq) off += v; }
    {
        unsigned pkv[8];
#pragma unroll
        for (int i = 0; i < 16; i += 2) {
            const float k0 = bf2f(Z[(row0 + 16 * tq + i) * IN_PAD + C_GK + h * GDK + col]), k1 = bf2f(Z[(row0 + 16 * tq + i + 1) * IN_PAD + C_GK + h * GDK + col]);
            pkv[i >> 1] = pk2(k0 * __expf(bend - off - pre[i]), k1 * __expf(bend - off - pre[i + 1]));
        }
        LAS u32x4* dst = (LAS u32x4*)(L + GL_KD + col * 144 + tq * 32);
        dst[0] = (u32x4){pkv[0], pkv[1], pkv[2], pkv[3]}; dst[1] = (u32x4){pkv[4], pkv[5], pkv[6], pkv[7]};
    }
    if (tq == 0) DEC[(size_t)(c * GH + h) * GDK + col] = __expf(bend);
    __syncthreads();
    f32x16 acc[4];
#pragma unroll
    for (int d = 0; d < 4; ++d)
#pragma unroll
        for (int i = 0; i < 16; ++i) acc[d][i] = 0.f;
#pragma unroll
    for (int ks = 0; ks < 4; ++ks) {
        bf16x8 a;
#pragma unroll
        for (int j = 0; j < 8; ++j) a[j] = (short)*(const LAS unsigned short*)(L + GL_V + (16 * ks + 8 * hh + j) * 512 + (32 * w + r32) * 2);
#pragma unroll
        for (int db = 0; db < 4; ++db) {
            const bf16x8 b = *(const LAS bf16x8*)(L + GL_KD + (32 * db + r32) * 144 + (16 * ks + 8 * hh) * 2);
            acc[db] = MFMA32(a, b, acc[db]);
        }
    }
    GAS bf16_t* stp = ST + ((size_t)(c * GH + h) * GDV + 32 * w) * GDK + r32;
#pragma unroll
    for (int db = 0; db < 4; ++db)
#pragma unroll
        for (int i = 0; i < 16; ++i) stp[(size_t)crow(i, hh) * GDK + 32 * db] = (bf16_t)f2bf(acc[db][i]);
    __syncthreads();
}

constexpr int GO_STR = 260;
__device__ __forceinline__ void gla_out_unit(LAS unsigned char* L, const bf16_t* Z_, const bf16_t* ST_, const float* gnorm_, bf16_t* mix_, int c, int h) {
    GAS const bf16_t* Z = G_(Z_); GAS const bf16_t* ST = G_(ST_); GAS const float* gnorm = G_(gnorm_); GAS bf16_t* mix = G_(mix_);
    int tid_ = threadIdx.x; LAUNDER_V(tid_);
    const int tid = tid_, lane = tid & 63, w = __builtin_amdgcn_readfirstlane(tid >> 6), r32 = lane & 31, hh = lane >> 5;
    const size_t row0 = (size_t)c * 64;
    f32x16 acc[2];
#pragma unroll
    for (int d = 0; d < 2; ++d)
#pragma unroll
        for (int i = 0; i < 16; ++i) acc[d][i] = 0.f;
    GAS const bf16_t* sp = ST + ((size_t)(c * GH + h) * GDV + 32 * w + r32) * GDK + 8 * hh;
#pragma unroll
    for (int ks = 0; ks < 8; ++ks) {
        const bf16x8 b = *(GAS const bf16x8*)(sp + 16 * ks);
#pragma unroll
        for (int tb = 0; tb < 2; ++tb) {
            const bf16x8 a = *(GAS const bf16x8*)(Z + (row0 + 32 * tb + r32) * IN_PAD + C_GQ + h * GDK + 16 * ks + 8 * hh);
            acc[tb] = MFMA32(a, b, acc[tb]);
        }
    }
    LAS float* of = (LAS float*)L;
#pragma unroll
    for (int tb = 0; tb < 2; ++tb)
#pragma unroll
        for (int i = 0; i < 16; ++i) of[(32 * tb + crow(i, hh)) * GO_STR + 32 * w + r32] = acc[tb][i] * 0.08838834764831845f;
    __syncthreads();
    const int tok = tid >> 3, part = tid & 7;
    float v[32]; float ss = 0.f;
#pragma unroll
    for (int i = 0; i < 32; ++i) { v[i] = of[tok * GO_STR + i * 8 + part]; ss += v[i] * v[i]; }
    ss += __shfl_xor(ss, 1); ss += __shfl_xor(ss, 2); ss += __shfl_xor(ss, 4);
    const float rstd = rsqrtf(ss * (1.0f / GDV) + EPS);
    GAS const bf16_t* zg = Z + (row0 + tok) * IN_PAD + C_GG + h * GDV;
    GAS bf16_t* op = mix + (row0 + tok) * DM + 1024 + h * GDV;
#pragma unroll
    for (int i = 0; i < 32; ++i) { const int dv = i * 8 + part; const float g = bf2f(zg[dv]); op[dv] = (bf16_t)f2bf(v[i] * rstd * gnorm[dv] * silu_f(g)); }
    __syncthreads();
}


#define XB_TMO      128
#define XB_XCNT(j)  (256  + 64 * (j))
#define XB_XSUB(j)  (1280 + 64 * (j))
#define XB_XGEN(j)  (2304 + 64 * (j))
#define XB_TOP      3328
#define XB_TOPGEN   3392
#define XCD_BAR_WORDS 3456
#define XB_SPIN_CAP (1u << 22)
__device__ __forceinline__ unsigned xb_ld(unsigned* p)              { return __hip_atomic_load(p, __ATOMIC_RELAXED, __HIP_MEMORY_SCOPE_AGENT); }
__device__ __forceinline__ unsigned xb_add(unsigned* p, unsigned v) { return __hip_atomic_fetch_add(p, v, __ATOMIC_RELAXED, __HIP_MEMORY_SCOPE_AGENT); }
__device__ __forceinline__ unsigned xb_xcc_id() { return (unsigned)__builtin_amdgcn_s_getreg((3 << 11) | 20) & 0xFu; }
#define XB_SPIN(cond, bar) do { unsigned _sp = 0; while (cond) { __builtin_amdgcn_s_sleep(1); \
    if ((++_sp & 255u) == 0u) { if (xb_ld(&(bar)[XB_TMO])) break; if (_sp > XB_SPIN_CAP) { atomicAdd(&(bar)[XB_TMO], 1u); break; } } } } while (0)
struct XcdBarrier { unsigned* bar; unsigned x; volatile LAS unsigned* st; };
__device__ __forceinline__ XcdBarrier xcd_barrier_post(unsigned* bar, volatile LAS unsigned* st) {
    XcdBarrier b; b.bar = bar; b.x = xb_xcc_id(); b.st = st;
    if (threadIdx.x == 0) (void)xb_add(&bar[XB_XCNT(b.x)], 1u);
    return b;
}
__device__ __forceinline__ void xcd_barrier_complete(unsigned* bar, unsigned x, unsigned& nloc, unsigned& nx) {
    const unsigned G = gridDim.x * gridDim.y * gridDim.z;
    unsigned sum, cnt, mine, sp = 0u;
    for (;;) {
        sum = 0u; cnt = 0u; mine = 0u;
#pragma unroll
        for (unsigned j = 0; j < 16; ++j) { const unsigned c = xb_ld(&bar[XB_XCNT(j)]); sum += c; cnt += (c > 0u) ? 1u : 0u; mine = (j == x) ? c : mine; }
        if (sum == G) break;
        __builtin_amdgcn_s_sleep(1);
        if ((++sp & 255u) == 0u) { if (xb_ld(&bar[XB_TMO])) break; if (sp > XB_SPIN_CAP) { atomicAdd(&bar[XB_TMO], 1u); break; } }
    }
    nloc = mine > 0u ? mine : 1u; nx = cnt > 0u ? cnt : 1u;
}
__device__ __forceinline__ void xcd_barrier(const XcdBarrier& b) {
    asm volatile("s_waitcnt vmcnt(0)" ::: "memory");
    __syncthreads();
    if (threadIdx.x == 0) {
        unsigned* bar = b.bar;
        __builtin_amdgcn_s_waitcnt(0);
        unsigned nloc = b.st[0], nx = b.st[1];
        if (nloc == 0u) { xcd_barrier_complete(bar, b.x, nloc, nx); b.st[0] = nloc; b.st[1] = nx; }
        const unsigned old = xb_add(&bar[XB_XSUB(b.x)], 1u);
        const unsigned gen = old / nloc;
        if (old + 1u == (gen + 1u) * nloc) {
            __builtin_amdgcn_fence(__ATOMIC_RELEASE, "agent");
            asm volatile("s_waitcnt vmcnt(0)" ::: "memory");
            const unsigned og = xb_add(&bar[XB_TOP], 1u);
            const unsigned tg = og / nx;
            if (og + 1u == (tg + 1u) * nx) xb_add(&bar[XB_TOPGEN], 1u);
            else XB_SPIN(xb_ld(&bar[XB_TOPGEN]) == tg, bar);
            __builtin_amdgcn_fence(__ATOMIC_ACQUIRE, "agent");
            xb_add(&bar[XB_XGEN(b.x)], 1u);
            asm volatile("s_waitcnt vmcnt(0)" ::: "memory");
        } else {
            XB_SPIN(xb_ld(&bar[XB_XGEN(b.x)]) == gen, bar);
            __builtin_amdgcn_fence(__ATOMIC_ACQUIRE, "agent");
            asm volatile("s_waitcnt vmcnt(0)" ::: "memory");
        }
    }
    __syncthreads();
}

__global__ void __launch_bounds__(512, 2) mk_fwd(Args a) {
    extern __shared__ __attribute__((aligned(16))) unsigned char lds[];
    cg::grid_group grid = cg::this_grid();
    LAS unsigned char* L = (LAS unsigned char*)lds;
    const int G = gridDim.x, bid = blockIdx.x, NGW = G * 8;
    volatile LAS unsigned* MISC = (volatile LAS unsigned*)(L + RING_BYTES + 8192);
    if (threadIdx.x < 4) MISC[threadIdx.x] = 0u;
    __syncthreads();
    { KAP_T kap0 = (KAP_T)__builtin_amdgcn_kernarg_segment_ptr(); (void)xcd_barrier_post((unsigned*)(kap0->ws + WS_BAR), MISC); }
#define XSYNC() do { KAP_T kap_ = (KAP_T)__builtin_amdgcn_kernarg_segment_ptr(); LAUNDER_S(kap_); XcdBarrier xb_; xb_.bar = (unsigned*)(kap_->ws + WS_BAR); xb_.x = xb_xcc_id(); xb_.st = (volatile LAS unsigned*)(L + RING_BYTES + 8192); xcd_barrier(xb_); } while (0)
#define GRID_SYNC() do { asm volatile("s_waitcnt vmcnt(0) lgkmcnt(0)" ::: "memory"); __syncthreads(); grid.sync(); \
    __builtin_amdgcn_fence(__ATOMIC_ACQUIRE, "agent"); asm volatile("s_waitcnt vmcnt(0)" ::: "memory"); __syncthreads(); } while (0)
#ifndef DBG_STOP
#define DBG_STOP 0
#endif
#define DBG_DUMP(k, EXPR) do { if (DBG_STOP == (k)) { PHASE_BEGIN(); for (int m = gw; m < SEQ; m += NGW) for (int c = lane; c < DM; c += 64) out[(size_t)m * DM + c] = (EXPR); return; } } while (0)
#define PHASE_BEGIN() KAP_T kap = (KAP_T)__builtin_amdgcn_kernarg_segment_ptr(); LAUNDER_S(kap); unsigned char* ws = kap->ws; LAUNDER_S(ws); int tid_ = threadIdx.x; LAUNDER_V(tid_); const int tid = tid_, lane = tid & 63, wave = __builtin_amdgcn_readfirstlane(tid >> 6), gw = bid * 8 + wave; \
    u64* ssq = (u64*)(ws + WS_SSQ); (void)lane; (void)gw; (void)ssq; \
    u64* ssq_x = ssq + (size_t)l * SEQ; u64* ssq_xn = ssq + (size_t)(l + 1) * SEQ; u64* ssq_cq = ssq + (size_t)(3 + l) * SEQ; u64* ssq_ckv = ssq + (size_t)(5 + l) * SEQ; u64* ssq_x1 = ssq + (size_t)(7 + l) * SEQ; u64* ssq_a = ssq + (size_t)(9 + l) * SEQ; (void)ssq_a; \
    (void)ssq_x; (void)ssq_xn; (void)ssq_cq; (void)ssq_ckv; (void)ssq_x1; \
    bf16_t* Win = (bf16_t*)(ws + WS_WIN); bf16_t* Wuq = (bf16_t*)(ws + WS_WUQ); bf16_t* Wukv = (bf16_t*)(ws + WS_WUKV); \
    bf16_t* Wout = (bf16_t*)(ws + WS_WOUT); bf16_t* Wup = (bf16_t*)(ws + WS_WUP); bf16_t* Wdn = (bf16_t*)(ws + WS_WDN); \
    bf16_t* XB = (bf16_t*)(ws + WS_XB); bf16_t* Z = (bf16_t*)(ws + WS_Z); bf16_t* Qb = (bf16_t*)(ws + WS_Q); bf16_t* Kb = (bf16_t*)(ws + WS_K); bf16_t* Vt = (bf16_t*)(ws + WS_VT); \
    bf16_t* ST = (bf16_t*)(ws + WS_ST); float* DEC = (float*)(ws + WS_DEC); bf16_t* MIX = (bf16_t*)(ws + WS_MIX); \
    bf16_t* ACT = (bf16_t*)(ws + WS_ACT); float* EDGE = (float*)(ws + WS_EDGE); \
    const float* xin = kap->in[0]; float* out = kap->out; \
    (void)Win; (void)Wuq; (void)Wukv; (void)Wout; (void)Wup; (void)Wdn; (void)XB; (void)Z; (void)Qb; (void)Kb; (void)Vt; (void)ST; (void)DEC; (void)MIX; (void)EDGE; (void)ACT; (void)xin; (void)out;

    for (int l = 0; l < NLAYER; ++l) {
        {
            PHASE_BEGIN();
            LAS float* scr = (LAS float*)(L + wave * 16384);
            const float* w_in = kap->in[3] + (size_t)l * DM * IN_DIM; const float* w_uq = kap->in[5] + (size_t)l * QLORA * QW; const float* w_ukv = kap->in[7] + (size_t)l * KVLORA * KVW;
            const float* w_out = kap->in[14] + (size_t)l * DM * DM; const float* w_up = kap->in[16] + (size_t)l * DM * DFF2; const float* w_dn = kap->in[19] + (size_t)l * DFF * DM;
            const float* g_attn = kap->in[2] + l * DM; const float* g_cq = kap->in[4] + l * QLORA; const float* g_ckv = kap->in[6] + l * KVLORA; const float* g_mla = kap->in[13] + l * 1024; const float* g_ffn = kap->in[15] + l * DM;
            constexpr int I_IN = (DM / 64) * (IN_PAD / 32), I_UQ = (QLORA / 64) * (QW / 32), I_UKV = (KVLORA / 64) * (KVW / 32), I_OUT = (DM / 64) * (DM / 32), I_UP = (DM / 64) * (DFF2 / 32), I_DN = (DFF / 64) * (DM / 32);
            constexpr int NITEMS = I_IN + I_UQ + I_UKV + I_OUT + I_UP + I_DN;
            for (int it = gw; it < NITEMS; it += NGW) {
                int r = it;
                if (r < I_IN) { wt_item(w_in, DM, IN_DIM, g_attn, DM, Win, scr, r, IN_PAD / 32, lane); continue; } r -= I_IN;
                if (r < I_UQ) { wt_item(w_uq, QLORA, QW, g_cq, QLORA, Wuq, scr, r, QW / 32, lane); continue; } r -= I_UQ;
                if (r < I_UKV) { wt_item(w_ukv, KVLORA, KVW, g_ckv, KVLORA, Wukv, scr, r, KVW / 32, lane); continue; } r -= I_UKV;
                if (r < I_OUT) { wt_item(w_out, DM, DM, g_mla, 1024, Wout, scr, r, DM / 32, lane); continue; } r -= I_OUT;
                if (r < I_UP) { wt_item(w_up, DM, DFF2, g_ffn, DM, Wup, scr, r, DFF2 / 32, lane, true); continue; } r -= I_UP;
                wt_item(w_dn, DFF, DM, g_ffn, 0, Wdn, scr, r, DM / 32, lane);
            }
            if (l == 0) {
                for (int m = gw; m < SEQ; m += NGW) {
                    GAS const f32x4* xr = (GAS const f32x4*)(G_(xin) + (size_t)m * DM) + lane; float s = 0.f;
                    GAS u32x2* o8 = (GAS u32x2*)(G_(XB) + (size_t)m * DM) + lane;
#pragma unroll
                    for (int j = 0; j < 8; ++j) { const f32x4 v = xr[64 * j]; s += (v[0] * v[0] + v[1] * v[1]) + (v[2] * v[2] + v[3] * v[3]); o8[64 * j] = (u32x2){pk2(v[0], v[1]), pk2(v[2], v[3])}; }
                    s = wave_sum(s); if (lane == 0) G_(ssq_x)[m] = (u64)(s * SSQ_FX + 0.5f);
                }
            }
        }
        if (l == 0) GRID_SYNC(); else XSYNC();
        {
            PHASE_BEGIN();
            pg8::Gemm g{XB, Win, SEQ, IN_PAD, DM, DM, nullptr, 0.f}; pg8::StaticOrder S; S.init(SEQ, IN_PAD, G, bid);
            pg8::EpiRowScale E{Z, IN_PAD, ssq_x, 1.0f / DM, ssq_cq, 0, 2, ssq_ckv, 2, 3};
            pg8::gemm_phase<pg8::EpiRowScale>(L, g, S, E);
        }
        XSYNC();
        DBG_DUMP(1, bf2f(Z[(size_t)m * IN_PAD + c]) + bf2f(Z[(size_t)m * IN_PAD + 2048 + c]));
        {
            PHASE_BEGIN();
            { pg8::Gemm g{Z + C_CQ, Wuq, SEQ, QW, QLORA, IN_PAD, nullptr, 0.f}; pg8::StaticOrder S; S.init(SEQ, QW, G, bid);
              pg8::EpiRowScale E{Qb, QW, ssq_cq, 1.0f / QLORA, nullptr, 0, 0, nullptr, 0, 0};
              pg8::gemm_phase<pg8::EpiRowScale>(L, g, S, E); }
            { pg8::Gemm g{Z + C_CKV, Wukv, SEQ, KVW, KVLORA, IN_PAD, nullptr, 0.f}; pg8::StaticOrder S; S.init(SEQ, KVW, G, bid);
              pg8::EpiUkv E{Kb, Vt, ssq_ckv, 1.0f / KVLORA};
              pg8::gemm_phase<pg8::EpiUkv>(L, g, S, E); }
            const float* wgate = kap->in[10] + (size_t)l * 16 * (GH * GDK); const float* bgate = kap->in[11] + (size_t)l * (GH * GDK);
            for (int u = bid; u < NCHUNK * GH; u += G) gla_chunk_unit(L, Z, wgate, bgate, ST, DEC, u >> 2, u & 3);
        }
        XSYNC();
        DBG_DUMP(2, (c < QW ? bf2f(Qb[(size_t)m * QW + c]) + bf2f(Kb[(size_t)m * QW + c]) : bf2f(Vt[(size_t)(c - QW) * SEQ + m])) + bf2f(ST[(size_t)m * 8192 + c]) + bf2f(ST[(size_t)m * 8192 + 4096 + c]));
        {
            PHASE_BEGIN();
            const int* pos = (const int*)kap->in[1];
            const float* qn = kap->in[8] + l * QKD; const float* kn = kap->in[9] + l * QKD;
            const float qscale = 0.07216878364870322f * 1.4426950408889634f;
            for (int m = gw; m < SEQ; m += NGW) {
                const int i = lane & 31;
                const float ang = (float)G_(pos)[m] * kap->inv_freq[i];
                double rev = (double)ang * 0.15915494309189535; rev -= __builtin_rint(rev);
                const float sn = __builtin_amdgcn_sinf((float)rev), cs = __builtin_amdgcn_cosf((float)rev);
                const float krv = bf2f(G_(Z)[(size_t)m * IN_PAD + C_KR + lane]);
                GAS bf16_t* qp = G_(Qb) + (size_t)m * QW; GAS bf16_t* kp = G_(Kb) + (size_t)m * QW;
                float qa[NH][3], ka[NH][2], qs[NH], ks[NH];
#pragma unroll
                for (int h = 0; h < NH; ++h) { qa[h][0] = bf2f(qp[h * QKD + lane]); qa[h][1] = bf2f(qp[h * QKD + 64 + lane]); qa[h][2] = bf2f(qp[h * QKD + 128 + lane]);
                                               ka[h][0] = bf2f(kp[h * QKD + lane]); ka[h][1] = bf2f(kp[h * QKD + 64 + lane]); }
#pragma unroll
                for (int h = 0; h < NH; ++h) { qs[h] = qa[h][0] * qa[h][0] + qa[h][1] * qa[h][1] + qa[h][2] * qa[h][2]; ks[h] = ka[h][0] * ka[h][0] + ka[h][1] * ka[h][1] + krv * krv; }
#pragma unroll
                for (int o = 1; o < 64; o <<= 1)
#pragma unroll
                    for (int h = 0; h < NH; ++h) { qs[h] += __shfl_xor(qs[h], o); ks[h] += __shfl_xor(ks[h], o); }
                const float qg0 = G_(qn)[lane], qg1 = G_(qn)[64 + lane], qg2 = G_(qn)[128 + lane], kg0 = G_(kn)[lane], kg1 = G_(kn)[64 + lane], kg2 = G_(kn)[128 + lane];
#pragma unroll
                for (int h = 0; h < NH; ++h) {
                    { const float rstd = rsqrtf(qs[h] * (1.0f / QKD) + EPS);
                      const float n2 = qa[h][2] * rstd * qg2, pr = __shfl_xor(n2, 32);
                      const float r2 = (lane < 32) ? n2 * cs - pr * sn : n2 * cs + pr * sn;
                      qp[h * QKD + lane] = (bf16_t)f2bf(qa[h][0] * rstd * qg0 * qscale); qp[h * QKD + 64 + lane] = (bf16_t)f2bf(qa[h][1] * rstd * qg1 * qscale); qp[h * QKD + 128 + lane] = (bf16_t)f2bf(r2 * qscale); }
                    { const float rstd = rsqrtf(ks[h] * (1.0f / QKD) + EPS);
                      const float n2 = krv * rstd * kg2, pr = __shfl_xor(n2, 32);
                      const float r2 = (lane < 32) ? n2 * cs - pr * sn : n2 * cs + pr * sn;
                      kp[h * QKD + lane] = (bf16_t)f2bf(ka[h][0] * rstd * kg0); kp[h * QKD + 64 + lane] = (bf16_t)f2bf(ka[h][1] * rstd * kg1); kp[h * QKD + 128 + lane] = (bf16_t)f2bf(r2); }
                }
            }
            constexpr int NE = GH * GDV * GDK;
            for (int e = bid * 512 + tid; e < NE; e += G * 512) {
                const int hd = (e >> 15) * GDK + (e & 127);
                float s = 0.f;
                for (int c0 = 0; c0 < NCHUNK; c0 += 8) {
                    float uu[8], dd[8];
#pragma unroll
                    for (int i = 0; i < 8; ++i) { uu[i] = bf2f(G_(ST)[(size_t)(c0 + i) * NE + e]); dd[i] = G_(DEC)[(size_t)(c0 + i) * (GH * GDK) + hd]; }
#pragma unroll
                    for (int i = 0; i < 8; ++i) { s = s * dd[i] + uu[i]; G_(ST)[(size_t)(c0 + i) * NE + e] = (bf16_t)f2bf(s); }
                }
            }
        }
        XSYNC();
        DBG_DUMP(3, (c < QW ? bf2f(Qb[(size_t)m * QW + c]) + bf2f(Kb[(size_t)m * QW + c]) : 0.f) + bf2f(ST[(size_t)m * 8192 + c]) + bf2f(ST[(size_t)m * 8192 + 4096 + c]));
        {
            PHASE_BEGIN();
            for (int p = bid; p < 256; p += G) {
                const int h = p & 7, s = p >> 3;
                attn_unit(L, Qb, Kb, Vt, MIX, ssq_a, h, 63 - s);
                attn_unit(L, Qb, Kb, Vt, MIX, ssq_a, h, s);
            }
            const float* gnorm = kap->in[12] + l * GDV;
            for (int u = bid; u < NCHUNK * GH; u += G) gla_out_unit(L, Z, ST, gnorm, MIX, u >> 2, u & 3);
        }
        XSYNC();
        DBG_DUMP(4, bf2f(MIX[(size_t)m * DM + c]));
        DBG_DUMP(5, bf2f(MIX[(size_t)m * DM + c]));
        {
            PHASE_BEGIN();
            pg8::Gemm g{MIX, Wout, SEQ, DM, DM, DM, ssq_a, 1.0f / 1024.0f}; pg8::StaticOrder S; S.init(SEQ, DM, G, bid);
            pg8::EpiRes E{l == 0 ? xin : out, out, XB, ssq_x1};
            pg8::gemm_phase<pg8::EpiRes, true>(L, g, S, E);
        }
        XSYNC();
        DBG_DUMP(6, out[(size_t)m * DM + c] + bf2f(XB[(size_t)m * DM + c]));
        {
            PHASE_BEGIN();
            const float* cw = kap->in[17] + (size_t)l * 3 * DFF2; const float* cb = kap->in[18] + (size_t)l * DFF2;
            pg8::Gemm g{XB, Wup, SEQ, DFF2, DM, DM, nullptr, 0.f}; pg8::StaticOrder S; S.init(SEQ, DFF2, G, bid);
            pg8::EpiUpConv E{ACT, EDGE, ssq_x1, cw, cb, (LAS float*)(L + RING_BYTES)};
            pg8::gemm_phase<pg8::EpiUpConv>(L, g, S, E);
        }
        XSYNC();
        {
            PHASE_BEGIN();
            const float* cw = kap->in[17] + (size_t)l * 3 * DFF2; const float* cb = kap->in[18] + (size_t)l * DFF2;
            for (int idx = bid * 512 + tid; idx < 63 * DFF; idx += G * 512) {
                const int pm = 1 + idx / DFF, gcol = idx % DFF;
                float y0[2], y1[2];
#pragma unroll
                for (int q = 0; q < 2; ++q) { const int c = q * DFF + gcol;
                    const float um2 = G_(EDGE)[(size_t)((pm - 1) * 4 + 2) * DFF2 + c], um1 = G_(EDGE)[(size_t)((pm - 1) * 4 + 3) * DFF2 + c], u0 = G_(EDGE)[(size_t)(pm * 4 + 0) * DFF2 + c], u1 = G_(EDGE)[(size_t)(pm * 4 + 1) * DFF2 + c];
                    const float w0 = G_(cw)[c], w1 = G_(cw)[DFF2 + c], w2 = G_(cw)[2 * DFF2 + c], bb = G_(cb)[c];
                    y0[q] = bb + w0 * um2 + w1 * um1 + w2 * u0; y1[q] = bb + w0 * um1 + w1 * u0 + w2 * u1; }
                G_(ACT)[(size_t)(pm * 256) * DFF + gcol] = (bf16_t)f2bf(silu_f(y0[0]) * y0[1]);
                G_(ACT)[(size_t)(pm * 256 + 1) * DFF + gcol] = (bf16_t)f2bf(silu_f(y1[0]) * y1[1]);
            }
        }
        XSYNC();
        DBG_DUMP(8, bf2f(ACT[(size_t)m * DFF + c]) + bf2f(ACT[(size_t)m * DFF + 3000 + c]));
        {
            PHASE_BEGIN();
            pg8::Gemm g{ACT, Wdn, SEQ, DM, DFF, DFF, nullptr, 0.f}; pg8::StaticOrder S; S.init(SEQ, DM, G, bid);
            pg8::EpiRes E{out, out, XB, ssq_xn};
            pg8::gemm_phase<pg8::EpiRes>(L, g, S, E);
        }
        XSYNC();
        if (DBG_STOP == 9) return;
    }
}

extern "C" void kernel_launch(void* const* d_in, const int* in_sizes, int n_in, void* d_out, int out_size, void* d_ws, size_t ws_size, hipStream_t stream) {
    static int grid = 0;
    if (grid == 0) {
        if (n_in != 20 || out_size != SEQ * DM || ws_size < WS_END) { fprintf(stderr, "kernel_launch: unexpected shapes: n_in %d out %d ws %zu (need %zu)\n", n_in, out_size, ws_size, (size_t)WS_END); grid = -1; return; }
        int dev = 0, cus = 0, per_cu = 0;
        hipGetDevice(&dev); hipDeviceGetAttribute(&cus, hipDeviceAttributeMultiprocessorCount, dev);
        hipFuncSetAttribute((const void*)mk_fwd, hipFuncAttributeMaxDynamicSharedMemorySize, LDS_BYTES);
        hipOccupancyMaxActiveBlocksPerMultiprocessor(&per_cu, (const void*)mk_fwd, 512, LDS_BYTES);
        (void)hipGetLastError();
        if (per_cu < 1) per_cu = 1;
        grid = cus * 1;
    }
    if (grid < 0) return;
    hipMemsetAsync((char*)d_ws + WS_CTL, 0, CTL_BYTES, stream);
    Args a{};
    for (int i = 0; i < 20; ++i) a.in[i] = (const float*)d_in[i];
    a.out = (float*)d_out; a.ws = (unsigned char*)d_ws;
    for (int i = 0; i < 32; ++i) a.inv_freq[i] = (float)pow(10000.0, -(double)i / 32.0);
    void* args[] = {&a};
    hipError_t e = hipLaunchCooperativeKernel((const void*)mk_fwd, dim3(grid), dim3(512), args, LDS_BYTES, stream);
    if (e != hipSuccess) fprintf(stderr, "cooperative launch failed: %s (grid %d)\n", hipGetErrorString(e), grid);
}
```

```cpp
#include <hip/hip_runtime.h>
#include <hip/hip_cooperative_groups.h>
#include <cstdio>
#include <cstdint>
#include <cmath>
namespace cg = cooperative_groups;

#define LAS __attribute__((address_space(3)))
typedef unsigned short bf16_t;
typedef unsigned long long u64;
typedef short bf16x8 __attribute__((ext_vector_type(8)));
typedef short s16x4 __attribute__((ext_vector_type(4)));
typedef float f32x4 __attribute__((ext_vector_type(4)));
typedef float f32x16 __attribute__((ext_vector_type(16)));
typedef unsigned u32x4 __attribute__((ext_vector_type(4)));
typedef unsigned u32x2 __attribute__((ext_vector_type(2)));
typedef float f32x2_t __attribute__((ext_vector_type(2)));
typedef __bf16 bf16x2_t __attribute__((ext_vector_type(2)));

constexpr int SEQ = 16384, DM = 2048, NLAYER = 2;
constexpr int IN_DIM = 3920, IN_PAD = 4096;
constexpr int C_CQ = 0, C_CKV = 512, C_KR = 768, C_GQ = 832, C_GK = 1344, C_GV = 1856, C_GA = 2880, C_GG = 2896;
constexpr int QLORA = 512, KVLORA = 256, NH = 8, QKD = 192, NOPE = 128, VD = 128, QW = NH * QKD  , KVW = NH * 256  ;
constexpr int GH = 4, GDK = 128, GDV = 256, NCHUNK = SEQ / 64;
constexpr int DFF = 5632, DFF2 = 11264;
constexpr float EPS = 1e-6f;

constexpr size_t MiB = 1u << 20;
constexpr size_t WS_CTL = 0, CTL_BYTES = 2 * MiB;
constexpr size_t WS_BAR = 0;
constexpr size_t WS_SSQ = 65536;
constexpr size_t WS_WIN = 2 * MiB, WS_WUQ = 18 * MiB, WS_WUKV = WS_WUQ + 3 * MiB / 2, WS_WOUT = WS_WUKV + 1 * MiB, WS_WUP = WS_WOUT + 8 * MiB, WS_WDN = WS_WUP + 44 * MiB;
constexpr size_t WS_XB = 95 * MiB;
constexpr size_t WS_R = 159 * MiB;
constexpr size_t WS_Z = WS_R, WS_Q = WS_Z + 128 * MiB, WS_K = WS_Q + 48 * MiB, WS_VT = WS_K + 48 * MiB, WS_ST = WS_VT + 32 * MiB, WS_DEC = WS_ST + 128 * MiB, WS_MIX = WS_DEC + 1 * MiB;
constexpr size_t WS_ACT = WS_R, WS_EDGE = WS_ACT + 176 * MiB, WS_END = WS_MIX + 64 * MiB;
static_assert(WS_EDGE + 12 * MiB <= WS_END, "ws map");

#define GAS __attribute__((address_space(1)))
template <class T> __device__ __forceinline__ GAS T* G_(T* p) { return (GAS T*)p; }
#define LAUNDER_V(x) asm volatile("" : "+v"(x))
#define LAUNDER_S(x) asm volatile("" : "+s"(x))
__device__ __forceinline__ unsigned f2bf(float f) { unsigned u = __builtin_bit_cast(unsigned, f); return (u + 0x7fffu + ((u >> 16) & 1u)) >> 16; }
__device__ __forceinline__ unsigned pk2(float lo, float hi) { f32x2_t v = {lo, hi}; bf16x2_t b = __builtin_convertvector(v, bf16x2_t); return __builtin_bit_cast(unsigned, b); }
__device__ __forceinline__ float bf2f(unsigned b) { return __builtin_bit_cast(float, b << 16); }
__device__ __forceinline__ float bflo(unsigned w) { return __builtin_bit_cast(float, w << 16); }
__device__ __forceinline__ float bfhi(unsigned w) { return __builtin_bit_cast(float, w & 0xffff0000u); }
__device__ __forceinline__ float wave_sum(float v) {
#pragma unroll
    for (int o = 1; o < 64; o <<= 1) v += __shfl_xor(v, o);
    return v;
}
constexpr float SSQ_FX = 1048576.0f, SSQ_INV = 1.0f / 1048576.0f;
__device__ __forceinline__ void ssq_add(u64* p, float v) { __hip_atomic_fetch_add((GAS u64*)p, (u64)(v * SSQ_FX + 0.5f), __ATOMIC_RELAXED, __HIP_MEMORY_SCOPE_AGENT); }
__device__ __forceinline__ float ssq_get(const u64* p) { return (float)(*(GAS const u64*)p) * SSQ_INV; }
__device__ __forceinline__ float silu_f(float x) { return x * __builtin_amdgcn_rcpf(1.0f + __expf(-x)); }

namespace pg8 {
constexpr int BM = 256, BK = 64, HALF = 128, HTB = HALF * BK * 2, STAGE_BYTES = 8 * HTB, NXCD = 8, WGM = 8;
__host__ __device__ __forceinline__ int lds_byte(int r, int c) { const int st = (r >> 4) * 2 + (c >> 5), rr = r & 15, cc = c & 31, ob = rr * 64 + cc * 2; return st * 1024 + (ob ^ (((ob >> 9) & 1) << 5)); }
__host__ __device__ __forceinline__ void stage_rc(int b, int& R, int& C) { const int st = b / 1024, sb = b % 1024, swz = sb ^ (((sb >> 9) & 1) << 5); R = (st >> 1) * 16 + swz / 64; C = (st & 1) * 32 + (swz % 64) / 2; }
__host__ __device__ __forceinline__ int perm32(int rho) { const int n = rho >> 4, i = rho & 15; return 8 * (i >> 2) + 4 * n + (i & 3); }

struct Unit { int pm, pn; };
struct Gemm { const bf16_t* A; const bf16_t* Bt; int M, N, K, lda; const u64* mid_ssq; float mid_inv; };

struct StaticOrder {
    int nM, nN, nwg, G, c;
    __device__ void init(int M, int N, int G_, int c_) { nM = M / BM; nN = N / BM; nwg = nM * nN; G = G_; c = c_; }
    __device__ bool next(int i, Unit& u) const {
        const long L = (long)i * G + c; if (L >= nwg) return false;
        int wgid = (int)L; { const int q = nwg / NXCD, r = nwg % NXCD, xcd = wgid % NXCD, off = wgid / NXCD; wgid = (xcd < r ? xcd * (q + 1) : r * (q + 1) + (xcd - r) * q) + off; }
        const int nig = WGM * nN, gid = wgid / nig, fm = gid * WGM, gsz = (nM - fm) < WGM ? (nM - fm) : WGM;
        u.pm = fm + ((wgid % nig) % gsz); u.pn = (wgid % nig) / gsz; return true;
    }
};

struct EpiRowScale {
    static constexpr bool PERM = true;
    bf16_t* O; int ldc; const u64* ssq_in; float inv_dim; u64* ssq_a; int a_lo, a_hi; u64* ssq_b; int b_lo, b_hi;
    __device__ __forceinline__ void operator()(const f32x4 (&acc)[2][2][4][2], const Unit& u, int wr, int wc, int fr, int fq) const {
        const int row0 = u.pm * BM + wr * 64 + fr, col0 = u.pn * BM + wc * 32 + 8 * fq;
        u64* sacc = (u.pn >= a_lo && u.pn < a_hi) ? ssq_a : ((u.pn >= b_lo && u.pn < b_hi) ? ssq_b : nullptr);
#pragma unroll
        for (int ai = 0; ai < 2; ++ai)
#pragma unroll
            for (int m = 0; m < 4; ++m) {
                const int row = row0 + ai * HALF + m * 16;
                const float sc = ssq_in ? rsqrtf(ssq_get(ssq_in + row) * inv_dim + EPS) : 1.0f;
                float ss = 0.f;
#pragma unroll
                for (int bj = 0; bj < 2; ++bj) {
                    const f32x4 v0 = acc[ai][bj][m][0] * sc, v1 = acc[ai][bj][m][1] * sc;
                    ss += (v0[0] * v0[0] + v0[1] * v0[1]) + (v0[2] * v0[2] + v0[3] * v0[3]) + (v1[0] * v1[0] + v1[1] * v1[1]) + (v1[2] * v1[2] + v1[3] * v1[3]);
                    u32x4 w; w.x = pk2(v0[0], v0[1]); w.y = pk2(v0[2], v0[3]); w.z = pk2(v1[0], v1[1]); w.w = pk2(v1[2], v1[3]);
                    *(GAS u32x4*)(G_(O) + (size_t)row * ldc + col0 + bj * HALF) = w;
                }
                if (sacc) { ss += __shfl_xor(ss, 16); ss += __shfl_xor(ss, 32); if (fq == 0) ssq_add(sacc + row, ss); }
            }
    }
};
struct EpiUkv {
    static constexpr bool PERM = true;
    bf16_t* Kb; bf16_t* Vt; const u64* ssq_in; float inv_dim;
    __device__ __forceinline__ void operator()(const f32x4 (&acc)[2][2][4][2], const Unit& u, int wr, int wc, int fr, int fq) const {
        const int row0 = u.pm * BM + wr * 64 + fr, c0 = wc * 32 + 8 * fq;
#pragma unroll
        for (int ai = 0; ai < 2; ++ai)
#pragma unroll
            for (int m = 0; m < 4; ++m) {
                const int row = row0 + ai * HALF + m * 16;
                const int prow = (row & ~15) | (row & 3) | ((row & 4) << 1) | ((row & 8) >> 1);
                const float sc = rsqrtf(ssq_get(ssq_in + row) * inv_dim + EPS);
                { const f32x4 v0 = acc[ai][0][m][0] * sc, v1 = acc[ai][0][m][1] * sc;
                  u32x4 w; w.x = pk2(v0[0], v0[1]); w.y = pk2(v0[2], v0[3]); w.z = pk2(v1[0], v1[1]); w.w = pk2(v1[2], v1[3]);
                  *(GAS u32x4*)(G_(Kb) + (size_t)row * QW + u.pn * QKD + c0) = w; }
#pragma unroll
                for (int n = 0; n < 2; ++n)
#pragma unroll
                    for (int j = 0; j < 4; ++j) G_(Vt)[(size_t)(u.pn * VD + c0 + 4 * n + j) * SEQ + prow] = (bf16_t)f2bf(acc[ai][1][m][n][j] * sc);
            }
    }
};
struct EpiRes {
    static constexpr bool PERM = true;
    const float* base; float* out; bf16_t* xb; u64* ssq_out;
    __device__ __forceinline__ void operator()(const f32x4 (&acc)[2][2][4][2], const Unit& u, int wr, int wc, int fr, int fq) const {
        const int row0 = u.pm * BM + wr * 64 + fr, col0 = u.pn * BM + wc * 32 + 8 * fq;
#pragma unroll
        for (int ai = 0; ai < 2; ++ai)
#pragma unroll
            for (int m = 0; m < 4; ++m) {
                const int row = row0 + ai * HALF + m * 16; float ss = 0.f;
#pragma unroll
                for (int bj = 0; bj < 2; ++bj) {
                    const size_t off = (size_t)row * DM + col0 + bj * HALF;
                    const f32x4 v0 = acc[ai][bj][m][0] + *(GAS const f32x4*)(G_(base) + off), v1 = acc[ai][bj][m][1] + *(GAS const f32x4*)(G_(base) + off + 4);
                    ss += (v0[0] * v0[0] + v0[1] * v0[1]) + (v0[2] * v0[2] + v0[3] * v0[3]) + (v1[0] * v1[0] + v1[1] * v1[1]) + (v1[2] * v1[2] + v1[3] * v1[3]);
                    *(GAS f32x4*)(G_(out) + off) = v0; *(GAS f32x4*)(G_(out) + off + 4) = v1;
                    u32x4 w; w.x = pk2(v0[0], v0[1]); w.y = pk2(v0[2], v0[3]); w.z = pk2(v1[0], v1[1]); w.w = pk2(v1[2], v1[3]);
                    *(GAS u32x4*)(G_(xb) + off) = w;
                }
                ss += __shfl_xor(ss, 16); ss += __shfl_xor(ss, 32); if (fq == 0) ssq_add(ssq_out + row, ss);
            }
    }
};


#define DPP_SHR1(old, src) __builtin_bit_cast(float, __builtin_amdgcn_update_dpp(__builtin_bit_cast(int, (float)(old)), __builtin_bit_cast(int, (float)(src)), 0x111, 0xf, 0xf, false))
#define DPP_SHR2(old, src) __builtin_bit_cast(float, __builtin_amdgcn_update_dpp(__builtin_bit_cast(int, (float)(old)), __builtin_bit_cast(int, (float)(src)), 0x112, 0xf, 0xf, false))
#define DPP_ROR1(src) __builtin_bit_cast(float, __builtin_amdgcn_update_dpp(0, __builtin_bit_cast(int, (float)(src)), 0x121, 0xf, 0xf, false))
#define DPP_ROR2(src) __builtin_bit_cast(float, __builtin_amdgcn_update_dpp(0, __builtin_bit_cast(int, (float)(src)), 0x122, 0xf, 0xf, false))
struct EpiUpConv {
    static constexpr bool PERM = true;
    bf16_t* ACT; float* EDGE; const u64* ssq_in; const float* cw; const float* cb; LAS float* halo;
    __device__ __forceinline__ void operator()(f32x4 (&acc)[2][2][4][2], const Unit& u, int wr, int wc, int fr, int fq) const {
        const int row0 = u.pm * BM + wr * 64 + fr;
        const int g0 = u.pn * 128 + wc * 32 + 8 * fq;
#pragma unroll
        for (int ai = 0; ai < 2; ++ai)
#pragma unroll
            for (int m = 0; m < 4; ++m) {
                const float sc = rsqrtf(ssq_get(ssq_in + row0 + ai * HALF + m * 16) * (1.0f / DM) + EPS);
#pragma unroll
                for (int bj = 0; bj < 2; ++bj)
#pragma unroll
                    for (int n = 0; n < 2; ++n) acc[ai][bj][m][n] = acc[ai][bj][m][n] * sc;
            }
        if (fr >= 14) {
#pragma unroll
            for (int ai = 0; ai < 2; ++ai) { LAS float* hp = halo + ((((2 * ai + wr) * 4 + wc) * 2 + (fr - 14)) * 4 + fq) * 16;
#pragma unroll
                for (int bj = 0; bj < 2; ++bj)
#pragma unroll
                    for (int n = 0; n < 2; ++n) *(LAS f32x4*)(hp + bj * 8 + n * 4) = acc[ai][bj][3][n]; }
            if (wr == 1) { GAS float* ep = G_(EDGE) + (size_t)(u.pm * 4 + 2 + fr - 14) * DFF2 + g0;
#pragma unroll
                for (int bj = 0; bj < 2; ++bj)
#pragma unroll
                    for (int n = 0; n < 2; ++n) *(GAS f32x4*)(ep + bj * DFF + 4 * n) = acc[1][bj][3][n]; }
        }
        if (fr < 2 && wr == 0) { GAS float* ep = G_(EDGE) + (size_t)(u.pm * 4 + fr) * DFF2 + g0;
#pragma unroll
            for (int bj = 0; bj < 2; ++bj)
#pragma unroll
                for (int n = 0; n < 2; ++n) *(GAS f32x4*)(ep + bj * DFF + 4 * n) = acc[0][bj][0][n]; }
        asm volatile("s_waitcnt lgkmcnt(0)" ::: "memory"); __builtin_amdgcn_s_barrier(); asm volatile("" ::: "memory");
#pragma unroll
        for (int n = 0; n < 2; ++n) {
            const int gc = g0 + 4 * n;
            GAS const float* cwg = G_(cw); GAS const float* cbg = G_(cb);
            const f32x4 wg0 = *(GAS const f32x4*)(cwg + gc), wg1 = *(GAS const f32x4*)(cwg + DFF2 + gc), wg2 = *(GAS const f32x4*)(cwg + 2 * DFF2 + gc), bgv = *(GAS const f32x4*)(cbg + gc);
            const f32x4 wu0 = *(GAS const f32x4*)(cwg + DFF + gc), wu1 = *(GAS const f32x4*)(cwg + DFF2 + DFF + gc), wu2 = *(GAS const f32x4*)(cwg + 2 * DFF2 + DFF + gc), buv = *(GAS const f32x4*)(cbg + DFF + gc);
#pragma unroll
            for (int ai = 0; ai < 2; ++ai) {
                const int band = 2 * ai + wr;
                f32x4 pg = (f32x4){0.f, 0.f, 0.f, 0.f}, pu = pg;
                if (band > 0) { const LAS float* hp = halo + ((((band - 1) * 4 + wc) * 2 + (fr & 1)) * 4 + fq) * 16; pg = *(const LAS f32x4*)(hp + n * 4); pu = *(const LAS f32x4*)(hp + 8 + n * 4); }
#pragma unroll
                for (int m = 0; m < 4; ++m) {
                    const f32x4 cg = acc[ai][0][m][n], cu = acc[ai][1][m][n];
                    float av[4];
#pragma unroll
                    for (int j = 0; j < 4; ++j) {
                        const float g1 = DPP_SHR1(DPP_ROR1(pg[j]), cg[j]), g2 = DPP_SHR2(DPP_ROR2(pg[j]), cg[j]);
                        const float u1 = DPP_SHR1(DPP_ROR1(pu[j]), cu[j]), u2 = DPP_SHR2(DPP_ROR2(pu[j]), cu[j]);
                        const float yg = bgv[j] + wg0[j] * g2 + wg1[j] * g1 + wg2[j] * cg[j];
                        const float yu = buv[j] + wu0[j] * u2 + wu1[j] * u1 + wu2[j] * cu[j];
                        av[j] = silu_f(yg) * yu;
                    }
                    *(GAS u32x2*)(G_(ACT) + (size_t)(row0 + ai * HALF + m * 16) * DFF + gc) = (u32x2){pk2(av[0], av[1]), pk2(av[2], av[3])};
                    pg = cg; pu = cu;
                }
            }
        }
    }
};

template <class Epi, bool MIDSCALE = false>
__device__ __forceinline__ void gemm_phase(LAS unsigned char* lds, const Gemm g, const StaticOrder& S, const Epi& E) {
    int tid_ = threadIdx.x; LAUNDER_V(tid_);
    const int tid = tid_, wid = __builtin_amdgcn_readfirstlane(tid >> 6), lane = tid & 63, wr = wid >> 2, wc = wid & 3, fr = lane & 15, fq = lane >> 4;
    const int K = g.K, nt = K / BK;
    unsigned voffA[2], voffB[2];
#pragma unroll
    for (int i = 0; i < 2; ++i) { int R, C; stage_rc(tid * 16 + i * 8192, R, C); const int Rb = Epi::PERM ? ((R & ~31) + perm32(R & 31)) : R;
        voffA[i] = (unsigned)(R * g.lda + C) * 2u; voffB[i] = (unsigned)(Rb * K + C) * 2u; }
    const size_t kstep = (size_t)(BK * 2);
    const size_t hstepA = (size_t)HALF * g.lda * 2, hstepB = (size_t)HALF * K * 2;
    const size_t tstepA = 2 * hstepA, tstepB = 2 * hstepB;
    const unsigned ldsw = (unsigned)wid * 1024u;
    const int aoff = lds_byte(wr * 64 + fr, fq * 8), boff = lds_byte(wc * 32 + fr, fq * 8);
#define PG8_SA(b, h) (((b) * 2 + (h)) * HTB)
#define PG8_SB(b, h) ((4 + (b) * 2 + (h)) * HTB)
#define PG8_STAGE(bufoff, gbase, voff) do { _Pragma("unroll") for (int _i = 0; _i < 2; ++_i) \
        __builtin_amdgcn_global_load_lds((const unsigned*)((const char*)(gbase) + (voff)[_i]), (LAS unsigned*)(lds + (bufoff) + ldsw + _i * 8192), 16, 0, 0); } while (0)
#define PG8_LDA(dst, b, h) do { _Pragma("unroll") for (int m = 0; m < 4; ++m) _Pragma("unroll") for (int k = 0; k < 2; ++k) dst[m][k] = *(const LAS bf16x8*)(lds + PG8_SA(b, h) + aoff + m * 2048 + k * 1024); } while (0)
#define PG8_LDB(dst, b, h) do { _Pragma("unroll") for (int n = 0; n < 2; ++n) _Pragma("unroll") for (int k = 0; k < 2; ++k) dst[n][k] = *(const LAS bf16x8*)(lds + PG8_SB(b, h) + boff + n * 2048 + k * 1024); } while (0)
#define PG8_MMA(ai, bj, At, Bt) do { __builtin_amdgcn_s_setprio(1); _Pragma("unroll") for (int m = 0; m < 4; ++m) _Pragma("unroll") for (int n = 0; n < 2; ++n) _Pragma("unroll") for (int k = 0; k < 2; ++k) \
        acc[ai][bj][m][n] = __builtin_amdgcn_mfma_f32_16x16x32_bf16(Bt[n][k], At[m][k], acc[ai][bj][m][n], 0, 0, 0); __builtin_amdgcn_s_setprio(0); } while (0)
#define PG8_WAIT_V(n) asm volatile("s_waitcnt vmcnt(" #n ")" ::: "memory")
#define PG8_WAIT_L(n) asm volatile("s_waitcnt lgkmcnt(" #n ")" ::: "memory")
#define PG8_BAR __builtin_amdgcn_s_barrier()
#define PG8_SCHED __builtin_amdgcn_sched_barrier(0)
    Unit cur, nxt; int ui = 0;
    if (!S.next(0, cur)) return;
    f32x4 acc[2][2][4][2];
#pragma unroll
    for (int a = 0; a < 2; ++a)
#pragma unroll
        for (int b = 0; b < 2; ++b)
#pragma unroll
            for (int m = 0; m < 4; ++m)
#pragma unroll
                for (int n = 0; n < 2; ++n) acc[a][b][m][n] = (f32x4){0.f, 0.f, 0.f, 0.f};
    bf16x8 At[4][2], B0[2][2], B1[2][2];
    const char* cA = (const char*)g.A + (size_t)cur.pm * tstepA; const char* cB = (const char*)g.Bt + (size_t)cur.pn * tstepB;
    PG8_STAGE(PG8_SB(0, 0), cB, voffB); PG8_STAGE(PG8_SB(0, 1), cB + hstepB, voffB); PG8_STAGE(PG8_SA(0, 0), cA, voffA); PG8_STAGE(PG8_SA(0, 1), cA + hstepA, voffA);
    if (wr == 1) PG8_BAR;
    PG8_WAIT_V(2); PG8_BAR;
    PG8_STAGE(PG8_SB(1, 0), cB + kstep, voffB); PG8_STAGE(PG8_SA(1, 0), cA + kstep, voffA); PG8_STAGE(PG8_SB(1, 1), cB + hstepB + kstep, voffB);
    PG8_WAIT_V(6); PG8_BAR;
    for (;;) {
        const bool has_next = S.next(ui + 1, nxt);
        const char* nA = has_next ? (const char*)g.A + (size_t)nxt.pm * tstepA : cA; const char* nB = has_next ? (const char*)g.Bt + (size_t)nxt.pn * tstepB : cB;
        for (int t = 0; t < nt; t += 2) {
            const bool last = (t == nt - 2);
            const char* a1 = cA + (size_t)(t + 1) * kstep;
            const char* a2 = last ? nA : cA + (size_t)(t + 2) * kstep; const char* b2 = last ? nB : cB + (size_t)(t + 2) * kstep;
            const char* a3 = a2 + kstep; const char* b3 = b2 + kstep;
            if constexpr (MIDSCALE) { if (t == nt / 2) {
#pragma unroll
                for (int ai = 0; ai < 2; ++ai)
#pragma unroll
                    for (int m = 0; m < 4; ++m) { const float sc = rsqrtf(ssq_get(g.mid_ssq + cur.pm * BM + ai * HALF + wr * 64 + m * 16 + fr) * g.mid_inv + EPS);
#pragma unroll
                        for (int bj = 0; bj < 2; ++bj)
#pragma unroll
                            for (int n = 0; n < 2; ++n) acc[ai][bj][m][n] = acc[ai][bj][m][n] * sc; } } }
            PG8_LDB(B0, 0, 0); PG8_LDB(B1, 0, 1); PG8_SCHED; PG8_LDA(At, 0, 0); PG8_STAGE(PG8_SA(1, 1), a1 + hstepA, voffA);
            PG8_WAIT_V(8); PG8_WAIT_L(0); PG8_BAR; PG8_MMA(0, 0, At, B0); PG8_MMA(0, 1, At, B1); PG8_BAR; PG8_SCHED;
            PG8_LDA(At, 0, 1); PG8_STAGE(PG8_SB(0, 0), b2, voffB); PG8_STAGE(PG8_SB(0, 1), b2 + hstepB, voffB); PG8_STAGE(PG8_SA(0, 0), a2, voffA);
            PG8_WAIT_V(8); PG8_WAIT_L(0); PG8_BAR; PG8_MMA(1, 0, At, B0); PG8_MMA(1, 1, At, B1); PG8_BAR; PG8_SCHED;
            PG8_LDB(B0, 1, 0); PG8_LDB(B1, 1, 1); PG8_SCHED; PG8_LDA(At, 1, 0); PG8_STAGE(PG8_SA(0, 1), a2 + hstepA, voffA);
            PG8_WAIT_V(8); PG8_WAIT_L(0); PG8_BAR; PG8_MMA(0, 0, At, B0); PG8_MMA(0, 1, At, B1); PG8_BAR; PG8_SCHED;
            PG8_LDA(At, 1, 1); PG8_STAGE(PG8_SB(1, 0), b3, voffB); PG8_STAGE(PG8_SB(1, 1), b3 + hstepB, voffB); PG8_STAGE(PG8_SA(1, 0), a3, voffA);
            PG8_WAIT_V(8); PG8_WAIT_L(0); PG8_BAR; PG8_MMA(1, 0, At, B0); PG8_MMA(1, 1, At, B1); PG8_BAR; PG8_SCHED;
        }
        if (wr == 0) PG8_BAR;
        { int frE = fr, fqE = fq; LAUNDER_V(frE); LAUNDER_V(fqE); E(acc, cur, wr, wc, frE, fqE); }
        if (!has_next) break;
#pragma unroll
        for (int a = 0; a < 2; ++a)
#pragma unroll
            for (int b = 0; b < 2; ++b)
#pragma unroll
                for (int m = 0; m < 4; ++m)
#pragma unroll
                    for (int n = 0; n < 2; ++n) acc[a][b][m][n] = (f32x4){0.f, 0.f, 0.f, 0.f};
        cur = nxt; cA = nA; cB = nB; ++ui;
        if (wr == 1) PG8_BAR;
    }
    PG8_WAIT_V(0);
    PG8_BAR;
#undef PG8_SA
#undef PG8_SB
#undef PG8_STAGE
#undef PG8_LDA
#undef PG8_LDB
#undef PG8_MMA
#undef PG8_WAIT_V
#undef PG8_WAIT_L
#undef PG8_BAR
#undef PG8_SCHED
}
}

constexpr int RING_BYTES = 131072;
constexpr int LDS_BYTES = 147456;

struct Args { const float* in[20]; float* out; unsigned char* ws; float inv_freq[32]; };
typedef const __attribute__((address_space(4))) Args* KAP_T;

#define DS_READ4(r0, r1, r2, r3, addr, o0, o1, o2, o3) asm volatile("ds_read_b128 %0, %4 offset:%5\n\tds_read_b128 %1, %4 offset:%6\n\tds_read_b128 %2, %4 offset:%7\n\tds_read_b128 %3, %4 offset:%8" \
    : "=&v"(r0), "=&v"(r1), "=&v"(r2), "=&v"(r3) : "v"(addr), "i"(o0), "i"(o1), "i"(o2), "i"(o3) : "memory")
#define LGKM_WAIT4(n, r0, r1, r2, r3) asm volatile("s_waitcnt lgkmcnt(" #n ")" : "+v"(r0), "+v"(r1), "+v"(r2), "+v"(r3) :: "memory")
#define MFMA32(a, b, c) __builtin_amdgcn_mfma_f32_32x32x16_bf16((a), (b), (c), 0, 0, 0)
__device__ __forceinline__ int crow(int r, int hi) { return (r & 3) + 8 * (r >> 2) + 4 * hi; }

__device__ __forceinline__ void wt_item(const float* __restrict__ W, int K, int N, const float* __restrict__ gain, int gainK, bf16_t* WT, LAS float* scr, int item, int nblk, int lane, bool remap_up = false) {
    const int kb = item / nblk, nb = item % nblk, k0 = 64 * kb, n0 = 32 * nb;
    const int ns0 = remap_up ? (((n0 & 255) < 128) ? 128 * (n0 >> 8) + (n0 & 255) : DFF + 128 * (n0 >> 8) + (n0 & 255) - 128) : n0;
    const int n = ns0 + (lane & 31);
    float wv[32];
#pragma unroll
    for (int i = 0; i < 32; ++i) { const int kk = 2 * i + (lane >> 5); wv[i] = (n < N) ? G_(W)[(size_t)(k0 + kk) * N + n] : 0.f; }
#pragma unroll
    for (int i = 0; i < 32; ++i) { const int kk = 2 * i + (lane >> 5); scr[kk * 33 + (lane & 31)] = wv[i]; }
    asm volatile("s_waitcnt lgkmcnt(0)" ::: "memory");
    const int c = lane & 7;
    f32x4 g0 = (f32x4){1.f, 1.f, 1.f, 1.f}, g1 = g0;
    if (k0 < gainK) { g0 = *(GAS const f32x4*)(G_(gain) + k0 + 8 * c); g1 = *(GAS const f32x4*)(G_(gain) + k0 + 8 * c + 4); }
#pragma unroll
    for (int j = 0; j < 4; ++j) { const int nn = (lane >> 3) + 8 * j; const LAS float* s = scr + (8 * c) * 33 + nn;
        u32x4 o; o.x = pk2(s[0 * 33] * g0[0], s[1 * 33] * g0[1]); o.y = pk2(s[2 * 33] * g0[2], s[3 * 33] * g0[3]); o.z = pk2(s[4 * 33] * g1[0], s[5 * 33] * g1[1]); o.w = pk2(s[6 * 33] * g1[2], s[7 * 33] * g1[3]);
        *(GAS u32x4*)(G_(WT) + (size_t)(n0 + nn) * K + k0 + 8 * c) = o; }
    asm volatile("s_waitcnt lgkmcnt(0)" ::: "memory");
}

constexpr int AT_KSTR = 400, AT_VSTR = 144;
constexpr int AT_KB = 64 * AT_KSTR  , AT_VB = 128 * AT_VSTR  , AT_K0 = 0, AT_V0 = 2 * AT_KB, AT_WSF = AT_V0 + 2 * AT_VB;
static_assert(AT_WSF + 8 * 128 <= RING_BYTES, "attn lds");

__device__ __forceinline__ void attn_unit(LAS unsigned char* L, const bf16_t* Q_, const bf16_t* Kg_, const bf16_t* Vt_, bf16_t* mix_, u64* ssq_a, int h, int qb) {
    GAS const bf16_t* Q = G_(Q_); GAS const bf16_t* Kg = G_(Kg_); GAS const bf16_t* Vt = G_(Vt_); GAS bf16_t* mix = G_(mix_);
    int tid_ = threadIdx.x; LAUNDER_V(tid_);
    const int tid = tid_, lane = tid & 63, w = __builtin_amdgcn_readfirstlane(tid >> 6), r32 = lane & 31, hh = lane >> 5;
    const int q0 = qb * 256;
    bf16x8 qf[12];
    { GAS const bf16_t* qrow = Q + (size_t)(q0 + 32 * w + r32) * QW + h * QKD + 8 * hh;
#pragma unroll
      for (int ks = 0; ks < 12; ++ks) qf[ks] = *(GAS const bf16x8*)(qrow + 16 * ks); }
    f32x16 o[4];
#pragma unroll
    for (int d = 0; d < 4; ++d)
#pragma unroll
        for (int i = 0; i < 16; ++i) o[d][i] = 0.f;
    float l_run = 0.f;
    const int NT = 4 * qb + 4, my_last = 4 * qb + (w >> 1);
    volatile LAS float* wsf = (volatile LAS float*)(L + AT_WSF) + w * 32;
    const unsigned lds_base = (unsigned)(uintptr_t)L;
    u32x4 kst[3], vst[2];
#define AT_GLOAD(t) do { const int kv0_ = (t) * 64; int x_ = tid; LAUNDER_V(x_); \
    _Pragma("unroll") for (int i = 0; i < 3; ++i) { const int id_ = x_ + 512 * i, r_ = id_ / 24, c_ = id_ - 24 * r_; kst[i] = *(GAS const u32x4*)(Kg + (size_t)(kv0_ + r_) * QW + h * QKD + c_ * 8); } \
    _Pragma("unroll") for (int i = 0; i < 2; ++i) { const int id_ = x_ + 512 * i; vst[i] = *(GAS const u32x4*)(Vt + (size_t)(h * VD + (id_ >> 3)) * SEQ + kv0_ + (id_ & 7) * 8); } } while (0)
#define AT_SSTORE(buf) do { int x_ = tid; LAUNDER_V(x_); \
    _Pragma("unroll") for (int i = 0; i < 3; ++i) { const int id_ = x_ + 512 * i, r_ = id_ / 24, c_ = id_ - 24 * r_; *(LAS u32x4*)(L + AT_K0 + (buf) * AT_KB + r_ * AT_KSTR + c_ * 16) = kst[i]; } \
    _Pragma("unroll") for (int i = 0; i < 2; ++i) { const int id_ = x_ + 512 * i; *(LAS u32x4*)(L + AT_V0 + (buf) * AT_VB + (id_ >> 3) * AT_VSTR + (id_ & 7) * 16) = vst[i]; } } while (0)
    AT_GLOAD(0); AT_SSTORE(0); AT_GLOAD(1); __syncthreads();
    for (int t = 0; t < NT; ++t) {
        const int buf = t & 1;
        if (t + 1 < NT) AT_SSTORE(buf ^ 1);
        if (t + 2 < NT) AT_GLOAD(t + 2);
        if (t <= my_last) {
            const unsigned kaddr = lds_base + AT_K0 + buf * AT_KB + r32 * AT_KSTR + hh * 16;
            const unsigned vaddr = lds_base + AT_V0 + buf * AT_VB + r32 * AT_VSTR + hh * 16;
            f32x16 p0, p1;
#pragma unroll
            for (int i = 0; i < 16; ++i) { p0[i] = 0.f; p1[i] = 0.f; }
            bf16x8 fa0, fa1, fa2, fa3, fb0, fb1, fb2, fb3;
#define QK_RD(s0, s1, s2, s3, kb, g) DS_READ4(s0, s1, s2, s3, kaddr, (kb) * 32 * AT_KSTR + (4 * (g)) * 32, (kb) * 32 * AT_KSTR + (4 * (g) + 1) * 32, (kb) * 32 * AT_KSTR + (4 * (g) + 2) * 32, (kb) * 32 * AT_KSTR + (4 * (g) + 3) * 32)
#define QK_MM(s0, s1, s2, s3, P, g) do { P = MFMA32(s0, qf[4 * (g)], P); P = MFMA32(s1, qf[4 * (g) + 1], P); P = MFMA32(s2, qf[4 * (g) + 2], P); P = MFMA32(s3, qf[4 * (g) + 3], P); } while (0)
#define PV_RD(s0, s1, s2, s3, kb, ss) DS_READ4(s0, s1, s2, s3, vaddr, (kb) * 64 + (ss) * 32, 32 * AT_VSTR + (kb) * 64 + (ss) * 32, 64 * AT_VSTR + (kb) * 64 + (ss) * 32, 96 * AT_VSTR + (kb) * 64 + (ss) * 32)
#define PV_PK(P, ss) __builtin_bit_cast(bf16x8, (u32x4){pk2(P[8 * (ss) + 0], P[8 * (ss) + 1]), pk2(P[8 * (ss) + 2], P[8 * (ss) + 3]), pk2(P[8 * (ss) + 4], P[8 * (ss) + 5]), pk2(P[8 * (ss) + 6], P[8 * (ss) + 7])})
#define PV_MM(s0, s1, s2, s3, xs) do { o[0] = MFMA32(xs, s0, o[0]); o[1] = MFMA32(xs, s1, o[1]); o[2] = MFMA32(xs, s2, o[2]); o[3] = MFMA32(xs, s3, o[3]); } while (0)
            QK_RD(fa0, fa1, fa2, fa3, 0, 0);
            QK_RD(fb0, fb1, fb2, fb3, 0, 1); LGKM_WAIT4(4, fa0, fa1, fa2, fa3); QK_MM(fa0, fa1, fa2, fa3, p0, 0);
            QK_RD(fa0, fa1, fa2, fa3, 0, 2); LGKM_WAIT4(4, fb0, fb1, fb2, fb3); QK_MM(fb0, fb1, fb2, fb3, p0, 1);
            QK_RD(fb0, fb1, fb2, fb3, 1, 0); LGKM_WAIT4(4, fa0, fa1, fa2, fa3); QK_MM(fa0, fa1, fa2, fa3, p0, 2);
            float ls0 = 0.f, ls1 = 0.f;
#pragma unroll
            for (int i = 0; i < 16; ++i) { p0[i] = __builtin_amdgcn_exp2f(__builtin_amdgcn_fmed3f(p0[i], -1000.f, 100.f)); ls0 += p0[i]; }
            QK_RD(fa0, fa1, fa2, fa3, 1, 1); LGKM_WAIT4(4, fb0, fb1, fb2, fb3); QK_MM(fb0, fb1, fb2, fb3, p1, 0);
            QK_RD(fb0, fb1, fb2, fb3, 1, 2); LGKM_WAIT4(4, fa0, fa1, fa2, fa3); QK_MM(fa0, fa1, fa2, fa3, p1, 1);
            PV_RD(fa0, fa1, fa2, fa3, 0, 0); LGKM_WAIT4(4, fb0, fb1, fb2, fb3); QK_MM(fb0, fb1, fb2, fb3, p1, 2);
            { const bf16x8 x00 = PV_PK(p0, 0), x01 = PV_PK(p0, 1);
#pragma unroll
              for (int i = 0; i < 16; ++i) { p1[i] = __builtin_amdgcn_exp2f(__builtin_amdgcn_fmed3f(p1[i], -1000.f, 100.f)); ls1 += p1[i]; }
              PV_RD(fb0, fb1, fb2, fb3, 0, 1); LGKM_WAIT4(4, fa0, fa1, fa2, fa3); PV_MM(fa0, fa1, fa2, fa3, x00);
              PV_RD(fa0, fa1, fa2, fa3, 1, 0); LGKM_WAIT4(4, fb0, fb1, fb2, fb3); PV_MM(fb0, fb1, fb2, fb3, x01);
              const bf16x8 x10 = PV_PK(p1, 0), x11 = PV_PK(p1, 1);
              PV_RD(fb0, fb1, fb2, fb3, 1, 1); LGKM_WAIT4(4, fa0, fa1, fa2, fa3); PV_MM(fa0, fa1, fa2, fa3, x10);
              LGKM_WAIT4(0, fb0, fb1, fb2, fb3); PV_MM(fb0, fb1, fb2, fb3, x11); }
            l_run += ls0 + ls1;
#undef QK_RD
#undef QK_MM
#undef PV_RD
#undef PV_PK
#undef PV_MM
        }
        asm volatile("s_waitcnt lgkmcnt(0)" ::: "memory"); __builtin_amdgcn_s_barrier(); asm volatile("" ::: "memory");
    }
#undef AT_GLOAD
#undef AT_SSTORE
    const float lt = l_run + __shfl_xor(l_run, 32);
    wsf[r32] = 1.0f / lt;
    asm volatile("s_waitcnt lgkmcnt(0)" ::: "memory");
    GAS bf16_t* orow = mix + (size_t)(q0 + 32 * w) * DM + h * VD + r32;
#pragma unroll
    for (int i = 0; i < 16; ++i) { const int qr = crow(i, hh); const float a = wsf[qr]; float ss = 0.f;
#pragma unroll
        for (int d = 0; d < 4; ++d) { const float v = o[d][i] * a; ss += v * v; orow[(size_t)qr * DM + 32 * d] = (bf16_t)f2bf(v); }
        ss += __shfl_xor(ss, 1); ss += __shfl_xor(ss, 2); ss += __shfl_xor(ss, 4); ss += __shfl_xor(ss, 8); ss += __shfl_xor(ss, 16);
        if (r32 == 0) ssq_add(ssq_a + q0 + 32 * w + qr, ss); }
    __syncthreads();
}

constexpr int GL_V = 0  , GL_KD = 32768  , GL_TOT = GL_KD + 18432  , GL_ZA = GL_TOT + 2048  ;
__device__ __forceinline__ void gla_chunk_unit(LAS unsigned char* L, const bf16_t* Z_, const float* wgate_, const float* bgate_, bf16_t* ST_, float* DEC_, int c, int h) {
    GAS const bf16_t* Z = G_(Z_); GAS const float* wgate = G_(wgate_); GAS const float* bgate = G_(bgate_); GAS bf16_t* ST = G_(ST_); GAS float* DEC = G_(DEC_);
    int tid_ = threadIdx.x; LAUNDER_V(tid_);
    const int tid = tid_, lane = tid & 63, w = __builtin_amdgcn_readfirstlane(tid >> 6), r32 = lane & 31, hh = lane >> 5;
    const size_t row0 = (size_t)c * 64;
#pragma unroll
    for (int i = 0; i < 4; ++i) { const int id = tid + 512 * i, r = id >> 5, cc = id & 31;
        *(LAS u32x4*)(L + GL_V + r * 512 + cc * 16) = *(GAS const u32x4*)(Z + (row0 + r) * IN_PAD + C_GV + h * GDV + cc * 8); }
#pragma unroll
    for (int i = 0; i < 2; ++i) { const int id = tid + 512 * i, r = id >> 4, cc = id & 15;
        ((LAS float*)(L + GL_ZA))[id] = bf2f(Z[(row0 + r) * IN_PAD + C_GA + cc]); }
    __syncthreads();
    const int tq = tid >> 7, col = tid & 127;
    float wg[16];
#pragma unroll
    for (int r = 0; r < 16; ++r) wg[r] = wgate[r * (GH * GDK) + h * GDK + col];
    const float bg = bgate[h * GDK + col];
    float pre[16]; float run = 0.f;
#pragma unroll
    for (int i = 0; i < 16; ++i) {
        const LAS float* za = (const LAS float*)(L + GL_ZA) + (16 * tq + i) * 16;
        float ga = bg;
#pragma unroll
        for (int r = 0; r < 16; ++r) ga += za[r] * wg[r];
        const float ls = fminf(ga, 0.f) - __logf(1.0f + __expf(-fabsf(ga)));
        run += ls * (1.0f / 16.0f); pre[i] = run;
    }
    ((LAS float*)(L + GL_TOT))[tq * 128 + col] = run;
    __syncthreads();
    float off = 0.f, bend = 0.f;
#pragma unroll
    for (int t = 0; t < 4; ++t) { const float v = ((LAS float*)(L + GL_TOT))[t * 128 + col]; bend += v; if (t < tq) off += v; }
    {
        unsigned pkv[8];
#pragma unroll
        for (int i = 0; i < 16; i += 2) {
            const float k0 = bf2f(Z[(row0 + 16 * tq + i) * IN_PAD + C_GK + h * GDK + col]), k1 = bf2f(Z[(row0 + 16 * tq + i + 1) * IN_PAD + C_GK + h * GDK + col]);
            pkv[i >> 1] = pk2(k0 * __expf(bend - off - pre[i]), k1 * __expf(bend - off - pre[i + 1]));
        }
        LAS u32x4* dst = (LAS u32x4*)(L + GL_KD + col * 144 + tq * 32);
        dst[0] = (u32x4){pkv[0], pkv[1], pkv[2], pkv[3]}; dst[1] = (u32x4){pkv[4], pkv[5], pkv[6], pkv[7]};
    }
    if (tq == 0) DEC[(size_t)(c * GH + h) * GDK + col] = __expf(bend);
    __syncthreads();
    f32x16 acc[4];
#pragma unroll
    for (int d = 0; d < 4; ++d)
#pragma unroll
        for (int i = 0; i < 16; ++i) acc[d][i] = 0.f;
#pragma unroll
    for (int ks = 0; ks < 4; ++ks) {
        bf16x8 a;
#pragma unroll
        for (int j = 0; j < 8; ++j) a[j] = (short)*(const LAS unsigned short*)(L + GL_V + (16 * ks + 8 * hh + j) * 512 + (32 * w + r32) * 2);
#pragma unroll
        for (int db = 0; db < 4; ++db) {
            const bf16x8 b = *(const LAS bf16x8*)(L + GL_KD + (32 * db + r32) * 144 + (16 * ks + 8 * hh) * 2);
            acc[db] = MFMA32(a, b, acc[db]);
        }
    }
    GAS bf16_t* stp = ST + ((size_t)(c * GH + h) * GDV + 32 * w) * GDK + r32;
#pragma unroll
    for (int db = 0; db < 4; ++db)
#pragma unroll
        for (int i = 0; i < 16; ++i) stp[(size_t)crow(i, hh) * GDK + 32 * db] = (bf16_t)f2bf(acc[db][i]);
    __syncthreads();
}

constexpr int GO_STR = 260;
__device__ __forceinline__ void gla_out_unit(LAS unsigned char* L, const bf16_t* Z_, const bf16_t* ST_, const float* gnorm_, bf16_t* mix_, int c, int h) {
    GAS const bf16_t* Z = G_(Z_); GAS const bf16_t* ST = G_(ST_); GAS const float* gnorm = G_(gnorm_); GAS bf16_t* mix = G_(mix_);
    int tid_ = threadIdx.x; LAUNDER_V(tid_);
    const int tid = tid_, lane = tid & 63, w = __builtin_amdgcn_readfirstlane(tid >> 6), r32 = lane & 31, hh = lane >> 5;
    const size_t row0 = (size_t)c * 64;
    f32x16 acc[2];
#pragma unroll
    for (int d = 0; d < 2; ++d)
#pragma unroll
        for (int i = 0; i < 16; ++i) acc[d][i] = 0.f;
    GAS const bf16_t* sp = ST + ((size_t)(c * GH + h) * GDV + 32 * w + r32) * GDK + 8 * hh;
#pragma unroll
    for (int ks = 0; ks < 8; ++ks) {
        const bf16x8 b = *(GAS const bf16x8*)(sp + 16 * ks);
#pragma unroll
        for (int tb = 0; tb < 2; ++tb) {
            const bf16x8 a = *(GAS const bf16x8*)(Z + (row0 + 32 * tb + r32) * IN_PAD + C_GQ + h * GDK + 16 * ks + 8 * hh);
            acc[tb] = MFMA32(a, b, acc[tb]);
        }
    }
    LAS float* of = (LAS float*)L;
#pragma unroll
    for (int tb = 0; tb < 2; ++tb)
#pragma unroll
        for (int i = 0; i < 16; ++i) of[(32 * tb + crow(i, hh)) * GO_STR + 32 * w + r32] = acc[tb][i] * 0.08838834764831845f;
    __syncthreads();
    const int tok = tid >> 3, part = tid & 7;
    f32x4 v[4][2]; float ss = 0.f;
#pragma unroll
    for (int j = 0; j < 4; ++j)
#pragma unroll
        for (int q = 0; q < 2; ++q) { v[j][q] = *(const LAS f32x4*)(of + tok * GO_STR + part * 8 + 64 * j + 4 * q); ss += (v[j][q][0] * v[j][q][0] + v[j][q][1] * v[j][q][1]) + (v[j][q][2] * v[j][q][2] + v[j][q][3] * v[j][q][3]); }
    ss += __shfl_xor(ss, 1); ss += __shfl_xor(ss, 2); ss += __shfl_xor(ss, 4);
    const float rstd = rsqrtf(ss * (1.0f / GDV) + EPS);
    GAS const bf16_t* zg = Z + (row0 + tok) * IN_PAD + C_GG + h * GDV + part * 8;
    GAS bf16_t* op = mix + (row0 + tok) * DM + 1024 + h * GDV + part * 8;
#pragma unroll
    for (int j = 0; j < 4; ++j) {
        const u32x4 gw_ = *(GAS const u32x4*)(zg + 64 * j);
        const f32x4 n0 = *(GAS const f32x4*)(gnorm + part * 8 + 64 * j), n1 = *(GAS const f32x4*)(gnorm + part * 8 + 64 * j + 4);
        u32x4 ow;
        ow.x = pk2(v[j][0][0] * rstd * n0[0] * silu_f(bflo(gw_.x)), v[j][0][1] * rstd * n0[1] * silu_f(bfhi(gw_.x)));
        ow.y = pk2(v[j][0][2] * rstd * n0[2] * silu_f(bflo(gw_.y)), v[j][0][3] * rstd * n0[3] * silu_f(bfhi(gw_.y)));
        ow.z = pk2(v[j][1][0] * rstd * n1[0] * silu_f(bflo(gw_.z)), v[j][1][1] * rstd * n1[1] * silu_f(bfhi(gw_.z)));
        ow.w = pk2(v[j][1][2] * rstd * n1[2] * silu_f(bflo(gw_.w)), v[j][1][3] * rstd * n1[3] * silu_f(bfhi(gw_.w)));
        *(GAS u32x4*)(op + 64 * j) = ow;
    }
    __syncthreads();
}


#define XB_TMO      128
#define XB_XCNT(j)  (256  + 64 * (j))
#define XB_XSUB(j)  (1280 + 64 * (j))
#define XB_XGEN(j)  (2304 + 64 * (j))
#define XB_TOP      3328
#define XB_TOPGEN   3392
#define XCD_BAR_WORDS 3456
#define XB_SPIN_CAP (1u << 22)
__device__ __forceinline__ unsigned xb_ld(unsigned* p)              { return __hip_atomic_load(p, __ATOMIC_RELAXED, __HIP_MEMORY_SCOPE_AGENT); }
__device__ __forceinline__ unsigned xb_add(unsigned* p, unsigned v) { return __hip_atomic_fetch_add(p, v, __ATOMIC_RELAXED, __HIP_MEMORY_SCOPE_AGENT); }
__device__ __forceinline__ unsigned xb_xcc_id() { return (unsigned)__builtin_amdgcn_s_getreg((3 << 11) | 20) & 0xFu; }
#define XB_SPIN(cond, bar) do { unsigned _sp = 0; while (cond) { __builtin_amdgcn_s_sleep(1); \
    if ((++_sp & 255u) == 0u) { if (xb_ld(&(bar)[XB_TMO])) break; if (_sp > XB_SPIN_CAP) { atomicAdd(&(bar)[XB_TMO], 1u); break; } } } } while (0)
struct XcdBarrier { unsigned* bar; unsigned x; volatile LAS unsigned* st; };
__device__ __forceinline__ XcdBarrier xcd_barrier_post(unsigned* bar, volatile LAS unsigned* st) {
    XcdBarrier b; b.bar = bar; b.x = xb_xcc_id(); b.st = st;
    if (threadIdx.x == 0) (void)xb_add(&bar[XB_XCNT(b.x)], 1u);
    return b;
}
__device__ __forceinline__ void xcd_barrier_complete(unsigned* bar, unsigned x, unsigned& nloc, unsigned& nx) {
    const unsigned G = gridDim.x * gridDim.y * gridDim.z;
    unsigned sum, cnt, mine, sp = 0u;
    for (;;) {
        sum = 0u; cnt = 0u; mine = 0u;
#pragma unroll
        for (unsigned j = 0; j < 16; ++j) { const unsigned c = xb_ld(&bar[XB_XCNT(j)]); sum += c; cnt += (c > 0u) ? 1u : 0u; mine = (j == x) ? c : mine; }
        if (sum == G) break;
        __builtin_amdgcn_s_sleep(1);
        if ((++sp & 255u) == 0u) { if (xb_ld(&bar[XB_TMO])) break; if (sp > XB_SPIN_CAP) { atomicAdd(&bar[XB_TMO], 1u); break; } }
    }
    nloc = mine > 0u ? mine : 1u; nx = cnt > 0u ? cnt : 1u;
}
__device__ __forceinline__ void xcd_barrier(const XcdBarrier& b) {
    asm volatile("s_waitcnt vmcnt(0)" ::: "memory");
    __syncthreads();
    if (threadIdx.x == 0) {
        unsigned* bar = b.bar;
        __builtin_amdgcn_s_waitcnt(0);
        unsigned nloc = b.st[0], nx = b.st[1];
        if (nloc == 0u) { xcd_barrier_complete(bar, b.x, nloc, nx); b.st[0] = nloc; b.st[1] = nx; }
        const unsigned old = xb_add(&bar[XB_XSUB(b.x)], 1u);
        const unsigned gen = old / nloc;
        if (old + 1u == (gen + 1u) * nloc) {
            __builtin_amdgcn_fence(__ATOMIC_RELEASE, "agent");
            asm volatile("s_waitcnt vmcnt(0)" ::: "memory");
            const unsigned og = xb_add(&bar[XB_TOP], 1u);
            const unsigned tg = og / nx;
            if (og + 1u == (tg + 1u) * nx) xb_add(&bar[XB_TOPGEN], 1u);
            else XB_SPIN(xb_ld(&bar[XB_TOPGEN]) == tg, bar);
            __builtin_amdgcn_fence(__ATOMIC_ACQUIRE, "agent");
            xb_add(&bar[XB_XGEN(b.x)], 1u);
            asm volatile("s_waitcnt vmcnt(0)" ::: "memory");
        } else {
            XB_SPIN(xb_ld(&bar[XB_XGEN(b.x)]) == gen, bar);
            __builtin_amdgcn_fence(__ATOMIC_ACQUIRE, "agent");
            asm volatile("s_waitcnt vmcnt(0)" ::: "memory");
        }
    }
    __syncthreads();
}

__global__ void __launch_bounds__(512, 2) mk_fwd(Args a) {
    extern __shared__ __attribute__((aligned(16))) unsigned char lds[];
    cg::grid_group grid = cg::this_grid();
    LAS unsigned char* L = (LAS unsigned char*)lds;
    const int G = gridDim.x, bid = blockIdx.x, NGW = G * 8;
    volatile LAS unsigned* MISC = (volatile LAS unsigned*)(L + RING_BYTES + 8192);
    if (threadIdx.x < 4) MISC[threadIdx.x] = 0u;
    __syncthreads();
    { KAP_T kap0 = (KAP_T)__builtin_amdgcn_kernarg_segment_ptr(); (void)xcd_barrier_post((unsigned*)(kap0->ws + WS_BAR), MISC); }
#define XSYNC() do { KAP_T kap_ = (KAP_T)__builtin_amdgcn_kernarg_segment_ptr(); LAUNDER_S(kap_); XcdBarrier xb_; xb_.bar = (unsigned*)(kap_->ws + WS_BAR); xb_.x = xb_xcc_id(); xb_.st = (volatile LAS unsigned*)(L + RING_BYTES + 8192); xcd_barrier(xb_); } while (0)
#define GRID_SYNC() do { asm volatile("s_waitcnt vmcnt(0) lgkmcnt(0)" ::: "memory"); __syncthreads(); grid.sync(); \
    __builtin_amdgcn_fence(__ATOMIC_ACQUIRE, "agent"); asm volatile("s_waitcnt vmcnt(0)" ::: "memory"); __syncthreads(); } while (0)
#ifndef DBG_STOP
#define DBG_STOP 0
#endif
#define DBG_DUMP(k, EXPR) do { if (DBG_STOP == (k)) { PHASE_BEGIN(); for (int m = gw; m < SEQ; m += NGW) for (int c = lane; c < DM; c += 64) out[(size_t)m * DM + c] = (EXPR); return; } } while (0)
#define PHASE_BEGIN() KAP_T kap = (KAP_T)__builtin_amdgcn_kernarg_segment_ptr(); LAUNDER_S(kap); unsigned char* ws = kap->ws; LAUNDER_S(ws); int tid_ = threadIdx.x; LAUNDER_V(tid_); const int tid = tid_, lane = tid & 63, wave = __builtin_amdgcn_readfirstlane(tid >> 6), gw = bid * 8 + wave; \
    u64* ssq = (u64*)(ws + WS_SSQ); (void)lane; (void)gw; (void)ssq; \
    u64* ssq_x = ssq + (size_t)l * SEQ; u64* ssq_xn = ssq + (size_t)(l + 1) * SEQ; u64* ssq_cq = ssq + (size_t)(3 + l) * SEQ; u64* ssq_ckv = ssq + (size_t)(5 + l) * SEQ; u64* ssq_x1 = ssq + (size_t)(7 + l) * SEQ; u64* ssq_a = ssq + (size_t)(9 + l) * SEQ; (void)ssq_a; \
    (void)ssq_x; (void)ssq_xn; (void)ssq_cq; (void)ssq_ckv; (void)ssq_x1; \
    bf16_t* Win = (bf16_t*)(ws + WS_WIN); bf16_t* Wuq = (bf16_t*)(ws + WS_WUQ); bf16_t* Wukv = (bf16_t*)(ws + WS_WUKV); \
    bf16_t* Wout = (bf16_t*)(ws + WS_WOUT); bf16_t* Wup = (bf16_t*)(ws + WS_WUP); bf16_t* Wdn = (bf16_t*)(ws + WS_WDN); \
    bf16_t* XB = (bf16_t*)(ws + WS_XB); bf16_t* Z = (bf16_t*)(ws + WS_Z); bf16_t* Qb = (bf16_t*)(ws + WS_Q); bf16_t* Kb = (bf16_t*)(ws + WS_K); bf16_t* Vt = (bf16_t*)(ws + WS_VT); \
    bf16_t* ST = (bf16_t*)(ws + WS_ST); float* DEC = (float*)(ws + WS_DEC); bf16_t* MIX = (bf16_t*)(ws + WS_MIX); \
    bf16_t* ACT = (bf16_t*)(ws + WS_ACT); float* EDGE = (float*)(ws + WS_EDGE); \
    const float* xin = kap->in[0]; float* out = kap->out; \
    (void)Win; (void)Wuq; (void)Wukv; (void)Wout; (void)Wup; (void)Wdn; (void)XB; (void)Z; (void)Qb; (void)Kb; (void)Vt; (void)ST; (void)DEC; (void)MIX; (void)EDGE; (void)ACT; (void)xin; (void)out;

    for (int l = 0; l < NLAYER; ++l) {
        {
            PHASE_BEGIN();
            LAS float* scr = (LAS float*)(L + wave * 16384);
            const float* w_in = kap->in[3] + (size_t)l * DM * IN_DIM; const float* w_uq = kap->in[5] + (size_t)l * QLORA * QW; const float* w_ukv = kap->in[7] + (size_t)l * KVLORA * KVW;
            const float* w_out = kap->in[14] + (size_t)l * DM * DM; const float* w_up = kap->in[16] + (size_t)l * DM * DFF2; const float* w_dn = kap->in[19] + (size_t)l * DFF * DM;
            const float* g_attn = kap->in[2] + l * DM; const float* g_cq = kap->in[4] + l * QLORA; const float* g_ckv = kap->in[6] + l * KVLORA; const float* g_mla = kap->in[13] + l * 1024; const float* g_ffn = kap->in[15] + l * DM;
            constexpr int I_IN = (DM / 64) * (IN_PAD / 32), I_UQ = (QLORA / 64) * (QW / 32), I_UKV = (KVLORA / 64) * (KVW / 32), I_OUT = (DM / 64) * (DM / 32), I_UP = (DM / 64) * (DFF2 / 32), I_DN = (DFF / 64) * (DM / 32);
            constexpr int NITEMS = I_IN + I_UQ + I_UKV + I_OUT + I_UP + I_DN;
            for (int it = gw; it < NITEMS; it += NGW) {
                int r = it;
                if (r < I_IN) { wt_item(w_in, DM, IN_DIM, g_attn, DM, Win, scr, r, IN_PAD / 32, lane); continue; } r -= I_IN;
                if (r < I_UQ) { wt_item(w_uq, QLORA, QW, g_cq, QLORA, Wuq, scr, r, QW / 32, lane); continue; } r -= I_UQ;
                if (r < I_UKV) { wt_item(w_ukv, KVLORA, KVW, g_ckv, KVLORA, Wukv, scr, r, KVW / 32, lane); continue; } r -= I_UKV;
                if (r < I_OUT) { wt_item(w_out, DM, DM, g_mla, 1024, Wout, scr, r, DM / 32, lane); continue; } r -= I_OUT;
                if (r < I_UP) { wt_item(w_up, DM, DFF2, g_ffn, DM, Wup, scr, r, DFF2 / 32, lane, true); continue; } r -= I_UP;
                wt_item(w_dn, DFF, DM, g_ffn, 0, Wdn, scr, r, DM / 32, lane);
            }
            if (l == 0) {
                for (int m = gw; m < SEQ; m += NGW) {
                    GAS const f32x4* xr = (GAS const f32x4*)(G_(xin) + (size_t)m * DM) + lane; float s = 0.f;
                    GAS u32x2* o8 = (GAS u32x2*)(G_(XB) + (size_t)m * DM) + lane;
#pragma unroll
                    for (int j = 0; j < 8; ++j) { const f32x4 v = xr[64 * j]; s += (v[0] * v[0] + v[1] * v[1]) + (v[2] * v[2] + v[3] * v[3]); o8[64 * j] = (u32x2){pk2(v[0], v[1]), pk2(v[2], v[3])}; }
                    s = wave_sum(s); if (lane == 0) G_(ssq_x)[m] = (u64)(s * SSQ_FX + 0.5f);
                }
            }
        }
        XSYNC();
        {
            PHASE_BEGIN();
            pg8::Gemm g{XB, Win, SEQ, IN_PAD, DM, DM, nullptr, 0.f}; pg8::StaticOrder S; S.init(SEQ, IN_PAD, G, bid);
            pg8::EpiRowScale E{Z, IN_PAD, ssq_x, 1.0f / DM, ssq_cq, 0, 2, ssq_ckv, 2, 3};
            pg8::gemm_phase<pg8::EpiRowScale>(L, g, S, E);
        }
        XSYNC();
        DBG_DUMP(1, bf2f(Z[(size_t)m * IN_PAD + c]) + bf2f(Z[(size_t)m * IN_PAD + 2048 + c]));
        {
            PHASE_BEGIN();
            { pg8::Gemm g{Z + C_CQ, Wuq, SEQ, QW, QLORA, IN_PAD, nullptr, 0.f}; pg8::StaticOrder S; S.init(SEQ, QW, G, bid);
              pg8::EpiRowScale E{Qb, QW, ssq_cq, 1.0f / QLORA, nullptr, 0, 0, nullptr, 0, 0};
              pg8::gemm_phase<pg8::EpiRowScale>(L, g, S, E); }
            { pg8::Gemm g{Z + C_CKV, Wukv, SEQ, KVW, KVLORA, IN_PAD, nullptr, 0.f}; pg8::StaticOrder S; S.init(SEQ, KVW, G, bid);
              pg8::EpiUkv E{Kb, Vt, ssq_ckv, 1.0f / KVLORA};
              pg8::gemm_phase<pg8::EpiUkv>(L, g, S, E); }
            const float* wgate = kap->in[10] + (size_t)l * 16 * (GH * GDK); const float* bgate = kap->in[11] + (size_t)l * (GH * GDK);
            for (int u = bid; u < NCHUNK * GH; u += G) gla_chunk_unit(L, Z, wgate, bgate, ST, DEC, u >> 2, u & 3);
        }
        if (l == 0) GRID_SYNC(); else XSYNC();
        DBG_DUMP(2, (c < QW ? bf2f(Qb[(size_t)m * QW + c]) + bf2f(Kb[(size_t)m * QW + c]) : bf2f(Vt[(size_t)(c - QW) * SEQ + m])) + bf2f(ST[(size_t)m * 8192 + c]) + bf2f(ST[(size_t)m * 8192 + 4096 + c]));
        {
            PHASE_BEGIN();
            const int* pos = (const int*)kap->in[1];
            const float* qn = kap->in[8] + l * QKD; const float* kn = kap->in[9] + l * QKD;
            const float qscale = 0.07216878364870322f * 1.4426950408889634f;
            for (int m = gw; m < SEQ; m += NGW) {
                const int i = lane & 31;
                const float ang = (float)G_(pos)[m] * kap->inv_freq[i];
                double rev = (double)ang * 0.15915494309189535; rev -= __builtin_rint(rev);
                const float sn = __builtin_amdgcn_sinf((float)rev), cs = __builtin_amdgcn_cosf((float)rev);
                const float krv = bf2f(G_(Z)[(size_t)m * IN_PAD + C_KR + lane]);
                GAS bf16_t* qp = G_(Qb) + (size_t)m * QW; GAS bf16_t* kp = G_(Kb) + (size_t)m * QW;
                float qa[NH][3], ka[NH][2], qs[NH], ks[NH];
#pragma unroll
                for (int h = 0; h < NH; ++h) { qa[h][0] = bf2f(qp[h * QKD + lane]); qa[h][1] = bf2f(qp[h * QKD + 64 + lane]); qa[h][2] = bf2f(qp[h * QKD + 128 + lane]);
                                               ka[h][0] = bf2f(kp[h * QKD + lane]); ka[h][1] = bf2f(kp[h * QKD + 64 + lane]); }
#pragma unroll
                for (int h = 0; h < NH; ++h) { qs[h] = qa[h][0] * qa[h][0] + qa[h][1] * qa[h][1] + qa[h][2] * qa[h][2]; ks[h] = ka[h][0] * ka[h][0] + ka[h][1] * ka[h][1] + krv * krv; }
#pragma unroll
                for (int o = 1; o < 64; o <<= 1)
#pragma unroll
                    for (int h = 0; h < NH; ++h) { qs[h] += __shfl_xor(qs[h], o); ks[h] += __shfl_xor(ks[h], o); }
                const float qg0 = G_(qn)[lane], qg1 = G_(qn)[64 + lane], qg2 = G_(qn)[128 + lane], kg0 = G_(kn)[lane], kg1 = G_(kn)[64 + lane], kg2 = G_(kn)[128 + lane];
#pragma unroll
                for (int h = 0; h < NH; ++h) {
                    { const float rstd = rsqrtf(qs[h] * (1.0f / QKD) + EPS);
                      const float n2 = qa[h][2] * rstd * qg2, pr = __shfl_xor(n2, 32);
                      const float r2 = (lane < 32) ? n2 * cs - pr * sn : n2 * cs + pr * sn;
                      qp[h * QKD + lane] = (bf16_t)f2bf(qa[h][0] * rstd * qg0 * qscale); qp[h * QKD + 64 + lane] = (bf16_t)f2bf(qa[h][1] * rstd * qg1 * qscale); qp[h * QKD + 128 + lane] = (bf16_t)f2bf(r2 * qscale); }
                    { const float rstd = rsqrtf(ks[h] * (1.0f / QKD) + EPS);
                      const float n2 = krv * rstd * kg2, pr = __shfl_xor(n2, 32);
                      const float r2 = (lane < 32) ? n2 * cs - pr * sn : n2 * cs + pr * sn;
                      kp[h * QKD + lane] = (bf16_t)f2bf(ka[h][0] * rstd * kg0); kp[h * QKD + 64 + lane] = (bf16_t)f2bf(ka[h][1] * rstd * kg1); kp[h * QKD + 128 + lane] = (bf16_t)f2bf(r2); }
                }
            }
            constexpr int NE = GH * GDV * GDK;
            for (int e = bid * 512 + tid; e < NE; e += G * 512) {
                const int hd = (e >> 15) * GDK + (e & 127);
                float s = 0.f;
                for (int c0 = 0; c0 < NCHUNK; c0 += 8) {
                    float uu[8], dd[8];
#pragma unroll
                    for (int i = 0; i < 8; ++i) { uu[i] = bf2f(G_(ST)[(size_t)(c0 + i) * NE + e]); dd[i] = G_(DEC)[(size_t)(c0 + i) * (GH * GDK) + hd]; }
#pragma unroll
                    for (int i = 0; i < 8; ++i) { s = s * dd[i] + uu[i]; G_(ST)[(size_t)(c0 + i) * NE + e] = (bf16_t)f2bf(s); }
                }
            }
        }
        XSYNC();
        DBG_DUMP(3, (c < QW ? bf2f(Qb[(size_t)m * QW + c]) + bf2f(Kb[(size_t)m * QW + c]) : 0.f) + bf2f(ST[(size_t)m * 8192 + c]) + bf2f(ST[(size_t)m * 8192 + 4096 + c]));
        {
            PHASE_BEGIN();
            for (int p = bid; p < 256; p += G) {
                const int h = p & 7, s = p >> 3;
                attn_unit(L, Qb, Kb, Vt, MIX, ssq_a, h, 63 - s);
                attn_unit(L, Qb, Kb, Vt, MIX, ssq_a, h, s);
            }
            const float* gnorm = kap->in[12] + l * GDV;
            for (int u = bid; u < NCHUNK * GH; u += G) gla_out_unit(L, Z, ST, gnorm, MIX, u >> 2, u & 3);
        }
        XSYNC();
        DBG_DUMP(4, bf2f(MIX[(size_t)m * DM + c]));
        DBG_DUMP(5, bf2f(MIX[(size_t)m * DM + c]));
        {
            PHASE_BEGIN();
            pg8::Gemm g{MIX, Wout, SEQ, DM, DM, DM, ssq_a, 1.0f / 1024.0f}; pg8::StaticOrder S; S.init(SEQ, DM, G, bid);
            pg8::EpiRes E{l == 0 ? xin : out, out, XB, ssq_x1};
            pg8::gemm_phase<pg8::EpiRes, true>(L, g, S, E);
        }
        XSYNC();
        DBG_DUMP(6, out[(size_t)m * DM + c] + bf2f(XB[(size_t)m * DM + c]));
        {
            PHASE_BEGIN();
            const float* cw = kap->in[17] + (size_t)l * 3 * DFF2; const float* cb = kap->in[18] + (size_t)l * DFF2;
            pg8::Gemm g{XB, Wup, SEQ, DFF2, DM, DM, nullptr, 0.f}; pg8::StaticOrder S; S.init(SEQ, DFF2, G, bid);
            pg8::EpiUpConv E{ACT, EDGE, ssq_x1, cw, cb, (LAS float*)(L + RING_BYTES)};
            pg8::gemm_phase<pg8::EpiUpConv>(L, g, S, E);
        }
        XSYNC();
        {
            PHASE_BEGIN();
            const float* cw = kap->in[17] + (size_t)l * 3 * DFF2; const float* cb = kap->in[18] + (size_t)l * DFF2;
            for (int idx = bid * 512 + tid; idx < 63 * DFF; idx += G * 512) {
                const int pm = 1 + idx / DFF, gcol = idx % DFF;
                float y0[2], y1[2];
#pragma unroll
                for (int q = 0; q < 2; ++q) { const int c = q * DFF + gcol;
                    const float um2 = G_(EDGE)[(size_t)((pm - 1) * 4 + 2) * DFF2 + c], um1 = G_(EDGE)[(size_t)((pm - 1) * 4 + 3) * DFF2 + c], u0 = G_(EDGE)[(size_t)(pm * 4 + 0) * DFF2 + c], u1 = G_(EDGE)[(size_t)(pm * 4 + 1) * DFF2 + c];
                    const float w0 = G_(cw)[c], w1 = G_(cw)[DFF2 + c], w2 = G_(cw)[2 * DFF2 + c], bb = G_(cb)[c];
                    y0[q] = bb + w0 * um2 + w1 * um1 + w2 * u0; y1[q] = bb + w0 * um1 + w1 * u0 + w2 * u1; }
                G_(ACT)[(size_t)(pm * 256) * DFF + gcol] = (bf16_t)f2bf(silu_f(y0[0]) * y0[1]);
                G_(ACT)[(size_t)(pm * 256 + 1) * DFF + gcol] = (bf16_t)f2bf(silu_f(y1[0]) * y1[1]);
            }
        }
        XSYNC();
        DBG_DUMP(8, bf2f(ACT[(size_t)m * DFF + c]) + bf2f(ACT[(size_t)m * DFF + 3000 + c]));
        {
            PHASE_BEGIN();
            pg8::Gemm g{ACT, Wdn, SEQ, DM, DFF, DFF, nullptr, 0.f}; pg8::StaticOrder S; S.init(SEQ, DM, G, bid);
            pg8::EpiRes E{out, out, XB, ssq_xn};
            pg8::gemm_phase<pg8::EpiRes>(L, g, S, E);
        }
        XSYNC();
        if (DBG_STOP == 9) return;
    }
}

extern "C" void kernel_launch(void* const* d_in, const int* in_sizes, int n_in, void* d_out, int out_size, void* d_ws, size_t ws_size, hipStream_t stream) {
    static int grid = 0;
    if (grid == 0) {
        if (n_in != 20 || out_size != SEQ * DM || ws_size < WS_END) { fprintf(stderr, "kernel_launch: unexpected shapes: n_in %d out %d ws %zu (need %zu)\n", n_in, out_size, ws_size, (size_t)WS_END); grid = -1; return; }
        int dev = 0, cus = 0, per_cu = 0;
        hipGetDevice(&dev); hipDeviceGetAttribute(&cus, hipDeviceAttributeMultiprocessorCount, dev);
        hipFuncSetAttribute((const void*)mk_fwd, hipFuncAttributeMaxDynamicSharedMemorySize, LDS_BYTES);
        hipOccupancyMaxActiveBlocksPerMultiprocessor(&per_cu, (const void*)mk_fwd, 512, LDS_BYTES);
        (void)hipGetLastError();
        if (per_cu < 1) per_cu = 1;
        grid = cus * 1;
    }
    if (grid < 0) return;
    hipMemsetAsync((char*)d_ws + WS_CTL, 0, CTL_BYTES, stream);
    Args a{};
    for (int i = 0; i < 20; ++i) a.in[i] = (const float*)d_in[i];
    a.out = (float*)d_out; a.ws = (unsigned char*)d_ws;
    for (int i = 0; i < 32; ++i) a.inv_freq[i] = (float)pow(10000.0, -(double)i / 32.0);
    void* args[] = {&a};
    hipError_t e = hipLaunchCooperativeKernel((const void*)mk_fwd, dim3(grid), dim3(512), args, LDS_BYTES, stream);
    if (e != hipSuccess) fprintf(stderr, "cooperative launch failed: %s (grid %d)\n", hipGetErrorString(e), grid);
}
```

```cpp
#include <hip/hip_runtime.h>
#include <hip/hip_cooperative_groups.h>
#include <cstdio>
#include <cstdint>
#include <cmath>
namespace cg = cooperative_groups;

#define LAS __attribute__((address_space(3)))
typedef unsigned short bf16_t;
typedef unsigned long long u64;
typedef short bf16x8 __attribute__((ext_vector_type(8)));
typedef short s16x4 __attribute__((ext_vector_type(4)));
typedef float f32x4 __attribute__((ext_vector_type(4)));
typedef float f32x16 __attribute__((ext_vector_type(16)));
typedef unsigned u32x4 __attribute__((ext_vector_type(4)));
typedef unsigned u32x2 __attribute__((ext_vector_type(2)));
typedef float f32x2_t __attribute__((ext_vector_type(2)));
typedef __bf16 bf16x2_t __attribute__((ext_vector_type(2)));

constexpr int SEQ = 16384, DM = 2048, NLAYER = 2;
constexpr int IN_DIM = 3920, IN_PAD = 4096;
constexpr int C_CQ = 0, C_CKV = 512, C_KR = 768, C_GQ = 832, C_GK = 1344, C_GV = 1856, C_GA = 2880, C_GG = 2896;
constexpr int QLORA = 512, KVLORA = 256, NH = 8, QKD = 192, NOPE = 128, VD = 128, QW = NH * QKD  , KVW = NH * 256  ;
constexpr int GH = 4, GDK = 128, GDV = 256, NCHUNK = SEQ / 64;
constexpr int DFF = 5632, DFF2 = 11264;
constexpr float EPS = 1e-6f;

constexpr size_t MiB = 1u << 20;
constexpr size_t WS_CTL = 0, CTL_BYTES = 2 * MiB;
constexpr size_t WS_BAR = 0;
constexpr size_t WS_SSQ = 65536;
constexpr size_t WS_WIN = 2 * MiB, WS_WUQ = 18 * MiB, WS_WUKV = WS_WUQ + 3 * MiB / 2, WS_WOUT = WS_WUKV + 1 * MiB, WS_WUP = WS_WOUT + 8 * MiB, WS_WDN = WS_WUP + 44 * MiB;
constexpr size_t WS_XB = 95 * MiB;
constexpr size_t WS_R = 159 * MiB;
constexpr size_t WS_Z = WS_R, WS_Q = WS_Z + 128 * MiB, WS_K = WS_Q + 48 * MiB, WS_VT = WS_K + 48 * MiB, WS_ST = WS_VT + 32 * MiB, WS_DEC = WS_ST + 128 * MiB, WS_MIX = WS_DEC + 1 * MiB;
constexpr size_t WS_ACT = WS_R, WS_EDGE = WS_ACT + 176 * MiB, WS_END = WS_MIX + 64 * MiB;
static_assert(WS_EDGE + 12 * MiB <= WS_END, "ws map");

#define GAS __attribute__((address_space(1)))
template <class T> __device__ __forceinline__ GAS T* G_(T* p) { return (GAS T*)p; }
__device__ __forceinline__ int lane_id_() { unsigned z = 0u; asm volatile("" : "+v"(z)); return (int)__builtin_amdgcn_mbcnt_hi(~0u, __builtin_amdgcn_mbcnt_lo(~0u, z)); }
#define LAUNDER_V(x) asm volatile("" : "+v"(x))
#define LAUNDER_S(x) asm volatile("" : "+s"(x))
__device__ __forceinline__ unsigned f2bf(float f) { unsigned u = __builtin_bit_cast(unsigned, f); return (u + 0x7fffu + ((u >> 16) & 1u)) >> 16; }
__device__ __forceinline__ unsigned pk2(float lo, float hi) { f32x2_t v = {lo, hi}; bf16x2_t b = __builtin_convertvector(v, bf16x2_t); return __builtin_bit_cast(unsigned, b); }
__device__ __forceinline__ float bf2f(unsigned b) { return __builtin_bit_cast(float, b << 16); }
__device__ __forceinline__ float bflo(unsigned w) { return __builtin_bit_cast(float, w << 16); }
__device__ __forceinline__ float bfhi(unsigned w) { return __builtin_bit_cast(float, w & 0xffff0000u); }
__device__ __forceinline__ float wave_sum(float v) {
#pragma unroll
    for (int o = 1; o < 64; o <<= 1) v += __shfl_xor(v, o);
    return v;
}
constexpr float SSQ_FX = 1048576.0f, SSQ_INV = 1.0f / 1048576.0f;
__device__ __forceinline__ void ssq_add(u64* p, float v) { __hip_atomic_fetch_add((GAS u64*)p, (u64)(v * SSQ_FX + 0.5f), __ATOMIC_RELAXED, __HIP_MEMORY_SCOPE_AGENT); }
__device__ __forceinline__ float ssq_get(const u64* p) { return (float)(*(GAS const u64*)p) * SSQ_INV; }
__device__ __forceinline__ float silu_f(float x) { return x * __builtin_amdgcn_rcpf(1.0f + __expf(-x)); }

namespace pg8 {
constexpr int BM = 256, BK = 64, HALF = 128, HTB = HALF * BK * 2, STAGE_BYTES = 8 * HTB, NXCD = 8, WGM = 8;
__host__ __device__ __forceinline__ int lds_byte(int r, int c) { const int st = (r >> 4) * 2 + (c >> 5), rr = r & 15, cc = c & 31, ob = rr * 64 + cc * 2; return st * 1024 + (ob ^ (((ob >> 9) & 1) << 5)); }
__host__ __device__ __forceinline__ void stage_rc(int b, int& R, int& C) { const int st = b / 1024, sb = b % 1024, swz = sb ^ (((sb >> 9) & 1) << 5); R = (st >> 1) * 16 + swz / 64; C = (st & 1) * 32 + (swz % 64) / 2; }
__host__ __device__ __forceinline__ int perm32(int rho) { const int n = rho >> 4, i = rho & 15; return 8 * (i >> 2) + 4 * n + (i & 3); }

struct Unit { int pm, pn; };
struct Gemm { const bf16_t* A; const bf16_t* Bt; int M, N, K, lda; const u64* mid_ssq; float mid_inv; };

struct StaticOrder {
    int nM, nN, nwg, G, c;
    __device__ void init(int M, int N, int G_, int c_) { nM = M / BM; nN = N / BM; nwg = nM * nN; G = G_; c = c_; }
    __device__ bool next(int i, Unit& u) const {
        const long L = (long)i * G + c; if (L >= nwg) return false;
        int wgid = (int)L; { const int q = nwg / NXCD, r = nwg % NXCD, xcd = wgid % NXCD, off = wgid / NXCD; wgid = (xcd < r ? xcd * (q + 1) : r * (q + 1) + (xcd - r) * q) + off; }
        const int nig = WGM * nN, gid = wgid / nig, fm = gid * WGM, gsz = (nM - fm) < WGM ? (nM - fm) : WGM;
        u.pm = fm + ((wgid % nig) % gsz); u.pn = (wgid % nig) / gsz; return true;
    }
};

struct EpiRowScale {
    static constexpr bool PERM = true;
    bf16_t* O; int ldc; const u64* ssq_in; float inv_dim; u64* ssq_a; int a_lo, a_hi; u64* ssq_b; int b_lo, b_hi;
    __device__ __forceinline__ void operator()(const f32x4 (&acc)[2][2][4][2], const Unit& u, int wr, int wc, int fr, int fq) const {
        const int row0 = u.pm * BM + wr * 64 + fr, col0 = u.pn * BM + wc * 32 + 8 * fq;
        u64* sacc = (u.pn >= a_lo && u.pn < a_hi) ? ssq_a : ((u.pn >= b_lo && u.pn < b_hi) ? ssq_b : nullptr);
#pragma unroll
        for (int ai = 0; ai < 2; ++ai)
#pragma unroll
            for (int m = 0; m < 4; ++m) {
                const int row = row0 + ai * HALF + m * 16;
                const float sc = ssq_in ? rsqrtf(ssq_get(ssq_in + row) * inv_dim + EPS) : 1.0f;
                float ss = 0.f;
#pragma unroll
                for (int bj = 0; bj < 2; ++bj) {
                    const f32x4 v0 = acc[ai][bj][m][0] * sc, v1 = acc[ai][bj][m][1] * sc;
                    ss += (v0[0] * v0[0] + v0[1] * v0[1]) + (v0[2] * v0[2] + v0[3] * v0[3]) + (v1[0] * v1[0] + v1[1] * v1[1]) + (v1[2] * v1[2] + v1[3] * v1[3]);
                    u32x4 w; w.x = pk2(v0[0], v0[1]); w.y = pk2(v0[2], v0[3]); w.z = pk2(v1[0], v1[1]); w.w = pk2(v1[2], v1[3]);
                    *(GAS u32x4*)(G_(O) + (size_t)row * ldc + col0 + bj * HALF) = w;
                }
                if (sacc) { ss += __shfl_xor(ss, 16); ss += __shfl_xor(ss, 32); if (fq == 0) ssq_add(sacc + row, ss); }
            }
    }
};
struct EpiUkv {
    static constexpr bool PERM = true;
    bf16_t* Kb; bf16_t* Vt; const u64* ssq_in; float inv_dim;
    __device__ __forceinline__ void operator()(const f32x4 (&acc)[2][2][4][2], const Unit& u, int wr, int wc, int fr, int fq) const {
        const int row0 = u.pm * BM + wr * 64 + fr, c0 = wc * 32 + 8 * fq;
#pragma unroll
        for (int ai = 0; ai < 2; ++ai)
#pragma unroll
            for (int m = 0; m < 4; ++m) {
                const int row = row0 + ai * HALF + m * 16;
                const int prow = (row & ~15) | (row & 3) | ((row & 4) << 1) | ((row & 8) >> 1);
                const float sc = rsqrtf(ssq_get(ssq_in + row) * inv_dim + EPS);
                { const f32x4 v0 = acc[ai][0][m][0] * sc, v1 = acc[ai][0][m][1] * sc;
                  u32x4 w; w.x = pk2(v0[0], v0[1]); w.y = pk2(v0[2], v0[3]); w.z = pk2(v1[0], v1[1]); w.w = pk2(v1[2], v1[3]);
                  *(GAS u32x4*)(G_(Kb) + (size_t)row * QW + u.pn * QKD + c0) = w; }
#pragma unroll
                for (int n = 0; n < 2; ++n)
#pragma unroll
                    for (int j = 0; j < 4; ++j) G_(Vt)[(size_t)(u.pn * VD + c0 + 4 * n + j) * SEQ + prow] = (bf16_t)f2bf(acc[ai][1][m][n][j] * sc);
            }
    }
};
struct EpiRes {
    static constexpr bool PERM = true;
    const float* base; float* out; bf16_t* xb; u64* ssq_out;
    __device__ __forceinline__ void operator()(const f32x4 (&acc)[2][2][4][2], const Unit& u, int wr, int wc, int fr, int fq) const {
        const int row0 = u.pm * BM + wr * 64 + fr, col0 = u.pn * BM + wc * 32 + 8 * fq;
#pragma unroll
        for (int ai = 0; ai < 2; ++ai)
#pragma unroll
            for (int m = 0; m < 4; ++m) {
                const int row = row0 + ai * HALF + m * 16; float ss = 0.f;
#pragma unroll
                for (int bj = 0; bj < 2; ++bj) {
                    const size_t off = (size_t)row * DM + col0 + bj * HALF;
                    const f32x4 v0 = acc[ai][bj][m][0] + *(GAS const f32x4*)(G_(base) + off), v1 = acc[ai][bj][m][1] + *(GAS const f32x4*)(G_(base) + off + 4);
                    ss += (v0[0] * v0[0] + v0[1] * v0[1]) + (v0[2] * v0[2] + v0[3] * v0[3]) + (v1[0] * v1[0] + v1[1] * v1[1]) + (v1[2] * v1[2] + v1[3] * v1[3]);
                    *(GAS f32x4*)(G_(out) + off) = v0; *(GAS f32x4*)(G_(out) + off + 4) = v1;
                    u32x4 w; w.x = pk2(v0[0], v0[1]); w.y = pk2(v0[2], v0[3]); w.z = pk2(v1[0], v1[1]); w.w = pk2(v1[2], v1[3]);
                    *(GAS u32x4*)(G_(xb) + off) = w;
                }
                ss += __shfl_xor(ss, 16); ss += __shfl_xor(ss, 32); if (fq == 0) ssq_add(ssq_out + row, ss);
            }
    }
};


#define DPP_SHR1(old, src) __builtin_bit_cast(float, __builtin_amdgcn_update_dpp(__builtin_bit_cast(int, (float)(old)), __builtin_bit_cast(int, (float)(src)), 0x111, 0xf, 0xf, false))
#define DPP_SHR2(old, src) __builtin_bit_cast(float, __builtin_amdgcn_update_dpp(__builtin_bit_cast(int, (float)(old)), __builtin_bit_cast(int, (float)(src)), 0x112, 0xf, 0xf, false))
#define DPP_ROR1(src) __builtin_bit_cast(float, __builtin_amdgcn_update_dpp(0, __builtin_bit_cast(int, (float)(src)), 0x121, 0xf, 0xf, false))
#define DPP_ROR2(src) __builtin_bit_cast(float, __builtin_amdgcn_update_dpp(0, __builtin_bit_cast(int, (float)(src)), 0x122, 0xf, 0xf, false))
struct EpiUpConv {
    static constexpr bool PERM = true;
    bf16_t* ACT; float* EDGE; const u64* ssq_in; const float* cw; const float* cb; LAS float* halo;
    __device__ __forceinline__ void operator()(f32x4 (&acc)[2][2][4][2], const Unit& u, int wr, int wc, int fr, int fq) const {
        const int row0 = u.pm * BM + wr * 64 + fr;
        const int g0 = u.pn * 128 + wc * 32 + 8 * fq;
#pragma unroll
        for (int ai = 0; ai < 2; ++ai)
#pragma unroll
            for (int m = 0; m < 4; ++m) {
                const float sc = rsqrtf(ssq_get(ssq_in + row0 + ai * HALF + m * 16) * (1.0f / DM) + EPS);
#pragma unroll
                for (int bj = 0; bj < 2; ++bj)
#pragma unroll
                    for (int n = 0; n < 2; ++n) acc[ai][bj][m][n] = acc[ai][bj][m][n] * sc;
            }
        if (fr >= 14) {
#pragma unroll
            for (int ai = 0; ai < 2; ++ai) { LAS float* hp = halo + ((((2 * ai + wr) * 4 + wc) * 2 + (fr - 14)) * 4 + fq) * 16;
#pragma unroll
                for (int bj = 0; bj < 2; ++bj)
#pragma unroll
                    for (int n = 0; n < 2; ++n) *(LAS f32x4*)(hp + bj * 8 + n * 4) = acc[ai][bj][3][n]; }
            if (wr == 1) { GAS float* ep = G_(EDGE) + (size_t)(u.pm * 4 + 2 + fr - 14) * DFF2 + g0;
#pragma unroll
                for (int bj = 0; bj < 2; ++bj)
#pragma unroll
                    for (int n = 0; n < 2; ++n) *(GAS f32x4*)(ep + bj * DFF + 4 * n) = acc[1][bj][3][n]; }
        }
        if (fr < 2 && wr == 0) { GAS float* ep = G_(EDGE) + (size_t)(u.pm * 4 + fr) * DFF2 + g0;
#pragma unroll
            for (int bj = 0; bj < 2; ++bj)
#pragma unroll
                for (int n = 0; n < 2; ++n) *(GAS f32x4*)(ep + bj * DFF + 4 * n) = acc[0][bj][0][n]; }
        asm volatile("s_waitcnt lgkmcnt(0)" ::: "memory"); __builtin_amdgcn_s_barrier(); asm volatile("" ::: "memory");
#pragma unroll
        for (int n = 0; n < 2; ++n) {
            const int gc = g0 + 4 * n;
            GAS const float* cwg = G_(cw); GAS const float* cbg = G_(cb);
            const f32x4 wg0 = *(GAS const f32x4*)(cwg + gc), wg1 = *(GAS const f32x4*)(cwg + DFF2 + gc), wg2 = *(GAS const f32x4*)(cwg + 2 * DFF2 + gc), bgv = *(GAS const f32x4*)(cbg + gc);
            const f32x4 wu0 = *(GAS const f32x4*)(cwg + DFF + gc), wu1 = *(GAS const f32x4*)(cwg + DFF2 + DFF + gc), wu2 = *(GAS const f32x4*)(cwg + 2 * DFF2 + DFF + gc), buv = *(GAS const f32x4*)(cbg + DFF + gc);
#pragma unroll
            for (int ai = 0; ai < 2; ++ai) {
                const int band = 2 * ai + wr;
                f32x4 pg = (f32x4){0.f, 0.f, 0.f, 0.f}, pu = pg;
                if (band > 0) { const LAS float* hp = halo + ((((band - 1) * 4 + wc) * 2 + (fr & 1)) * 4 + fq) * 16; pg = *(const LAS f32x4*)(hp + n * 4); pu = *(const LAS f32x4*)(hp + 8 + n * 4); }
#pragma unroll
                for (int m = 0; m < 4; ++m) {
                    const f32x4 cg = acc[ai][0][m][n], cu = acc[ai][1][m][n];
                    float av[4];
#pragma unroll
                    for (int j = 0; j < 4; ++j) {
                        const float g1 = DPP_SHR1(DPP_ROR1(pg[j]), cg[j]), g2 = DPP_SHR2(DPP_ROR2(pg[j]), cg[j]);
                        const float u1 = DPP_SHR1(DPP_ROR1(pu[j]), cu[j]), u2 = DPP_SHR2(DPP_ROR2(pu[j]), cu[j]);
                        const float yg = bgv[j] + wg0[j] * g2 + wg1[j] * g1 + wg2[j] * cg[j];
                        const float yu = buv[j] + wu0[j] * u2 + wu1[j] * u1 + wu2[j] * cu[j];
                        av[j] = silu_f(yg) * yu;
                    }
                    *(GAS u32x2*)(G_(ACT) + (size_t)(row0 + ai * HALF + m * 16) * DFF + gc) = (u32x2){pk2(av[0], av[1]), pk2(av[2], av[3])};
                    pg = cg; pu = cu;
                }
            }
        }
    }
};

template <class Epi, bool MIDSCALE = false>
__device__ __forceinline__ void gemm_phase(LAS unsigned char* lds, const Gemm g, const StaticOrder& S, const Epi& E, int wv) {
    int tid_ = wv * 64 + lane_id_(); LAUNDER_V(tid_);
    const int tid = tid_, wid = __builtin_amdgcn_readfirstlane(tid >> 6), lane = tid & 63, wr = wid >> 2, wc = wid & 3, fr = lane & 15, fq = lane >> 4;
    const int K = g.K, nt = K / BK;
    unsigned voffA[2], voffB[2];
#pragma unroll
    for (int i = 0; i < 2; ++i) { int R, C; stage_rc(tid * 16 + i * 8192, R, C); const int Rb = Epi::PERM ? ((R & ~31) + perm32(R & 31)) : R;
        voffA[i] = (unsigned)(R * g.lda + C) * 2u; voffB[i] = (unsigned)(Rb * K + C) * 2u; }
    const size_t kstep = (size_t)(BK * 2);
    const size_t hstepA = (size_t)HALF * g.lda * 2, hstepB = (size_t)HALF * K * 2;
    const size_t tstepA = 2 * hstepA, tstepB = 2 * hstepB;
    const unsigned ldsw = (unsigned)wid * 1024u;
    const int aoff = lds_byte(wr * 64 + fr, fq * 8), boff = lds_byte(wc * 32 + fr, fq * 8);
#define PG8_SA(b, h) (((b) * 2 + (h)) * HTB)
#define PG8_SB(b, h) ((4 + (b) * 2 + (h)) * HTB)
#define PG8_STAGE(bufoff, gbase, voff) do { _Pragma("unroll") for (int _i = 0; _i < 2; ++_i) \
        __builtin_amdgcn_global_load_lds((const unsigned*)((const char*)(gbase) + (voff)[_i]), (LAS unsigned*)(lds + (bufoff) + ldsw + _i * 8192), 16, 0, 0); } while (0)
#define PG8_LDA(dst, b, h) do { _Pragma("unroll") for (int m = 0; m < 4; ++m) _Pragma("unroll") for (int k = 0; k < 2; ++k) dst[m][k] = *(const LAS bf16x8*)(lds + PG8_SA(b, h) + aoff + m * 2048 + k * 1024); } while (0)
#define PG8_LDB(dst, b, h) do { _Pragma("unroll") for (int n = 0; n < 2; ++n) _Pragma("unroll") for (int k = 0; k < 2; ++k) dst[n][k] = *(const LAS bf16x8*)(lds + PG8_SB(b, h) + boff + n * 2048 + k * 1024); } while (0)
#define PG8_MMA(ai, bj, At, Bt) do { __builtin_amdgcn_s_setprio(1); _Pragma("unroll") for (int m = 0; m < 4; ++m) _Pragma("unroll") for (int n = 0; n < 2; ++n) _Pragma("unroll") for (int k = 0; k < 2; ++k) \
        acc[ai][bj][m][n] = __builtin_amdgcn_mfma_f32_16x16x32_bf16(Bt[n][k], At[m][k], acc[ai][bj][m][n], 0, 0, 0); __builtin_amdgcn_s_setprio(0); } while (0)
#define PG8_WAIT_V(n) asm volatile("s_waitcnt vmcnt(" #n ")" ::: "memory")
#define PG8_WAIT_L(n) asm volatile("s_waitcnt lgkmcnt(" #n ")" ::: "memory")
#define PG8_BAR __builtin_amdgcn_s_barrier()
#define PG8_SCHED __builtin_amdgcn_sched_barrier(0)
    Unit cur, nxt; int ui = 0;
    if (!S.next(0, cur)) return;
    f32x4 acc[2][2][4][2];
#pragma unroll
    for (int a = 0; a < 2; ++a)
#pragma unroll
        for (int b = 0; b < 2; ++b)
#pragma unroll
            for (int m = 0; m < 4; ++m)
#pragma unroll
                for (int n = 0; n < 2; ++n) acc[a][b][m][n] = (f32x4){0.f, 0.f, 0.f, 0.f};
    bf16x8 At[4][2], B0[2][2], B1[2][2];
    const char* cA = (const char*)g.A + (size_t)cur.pm * tstepA; const char* cB = (const char*)g.Bt + (size_t)cur.pn * tstepB;
    PG8_STAGE(PG8_SB(0, 0), cB, voffB); PG8_STAGE(PG8_SB(0, 1), cB + hstepB, voffB); PG8_STAGE(PG8_SA(0, 0), cA, voffA); PG8_STAGE(PG8_SA(0, 1), cA + hstepA, voffA);
    if (wr == 1) PG8_BAR;
    PG8_WAIT_V(2); PG8_BAR;
    PG8_STAGE(PG8_SB(1, 0), cB + kstep, voffB); PG8_STAGE(PG8_SA(1, 0), cA + kstep, voffA); PG8_STAGE(PG8_SB(1, 1), cB + hstepB + kstep, voffB);
    PG8_WAIT_V(6); PG8_BAR;
    for (;;) {
        const bool has_next = S.next(ui + 1, nxt);
        const char* nA = has_next ? (const char*)g.A + (size_t)nxt.pm * tstepA : cA; const char* nB = has_next ? (const char*)g.Bt + (size_t)nxt.pn * tstepB : cB;
        for (int t = 0; t < nt; t += 2) {
            const bool last = (t == nt - 2);
            const char* a1 = cA + (size_t)(t + 1) * kstep;
            const char* a2 = last ? nA : cA + (size_t)(t + 2) * kstep; const char* b2 = last ? nB : cB + (size_t)(t + 2) * kstep;
            const char* a3 = a2 + kstep; const char* b3 = b2 + kstep;
            if constexpr (MIDSCALE) { if (t == nt / 2) {
#pragma unroll
                for (int ai = 0; ai < 2; ++ai)
#pragma unroll
                    for (int m = 0; m < 4; ++m) { const float sc = rsqrtf(ssq_get(g.mid_ssq + cur.pm * BM + ai * HALF + wr * 64 + m * 16 + fr) * g.mid_inv + EPS);
#pragma unroll
                        for (int bj = 0; bj < 2; ++bj)
#pragma unroll
                            for (int n = 0; n < 2; ++n) acc[ai][bj][m][n] = acc[ai][bj][m][n] * sc; } } }
            PG8_LDB(B0, 0, 0); PG8_LDB(B1, 0, 1); PG8_SCHED; PG8_LDA(At, 0, 0); PG8_STAGE(PG8_SA(1, 1), a1 + hstepA, voffA);
            PG8_WAIT_V(8); PG8_WAIT_L(0); PG8_BAR; PG8_MMA(0, 0, At, B0); PG8_MMA(0, 1, At, B1); PG8_BAR; PG8_SCHED;
            PG8_LDA(At, 0, 1); PG8_STAGE(PG8_SB(0, 0), b2, voffB); PG8_STAGE(PG8_SB(0, 1), b2 + hstepB, voffB); PG8_STAGE(PG8_SA(0, 0), a2, voffA);
            PG8_WAIT_V(8); PG8_WAIT_L(0); PG8_BAR; PG8_MMA(1, 0, At, B0); PG8_MMA(1, 1, At, B1); PG8_BAR; PG8_SCHED;
            PG8_LDB(B0, 1, 0); PG8_LDB(B1, 1, 1); PG8_SCHED; PG8_LDA(At, 1, 0); PG8_STAGE(PG8_SA(0, 1), a2 + hstepA, voffA);
            PG8_WAIT_V(8); PG8_WAIT_L(0); PG8_BAR; PG8_MMA(0, 0, At, B0); PG8_MMA(0, 1, At, B1); PG8_BAR; PG8_SCHED;
            PG8_LDA(At, 1, 1); PG8_STAGE(PG8_SB(1, 0), b3, voffB); PG8_STAGE(PG8_SB(1, 1), b3 + hstepB, voffB); PG8_STAGE(PG8_SA(1, 0), a3, voffA);
            PG8_WAIT_V(8); PG8_WAIT_L(0); PG8_BAR; PG8_MMA(1, 0, At, B0); PG8_MMA(1, 1, At, B1); PG8_BAR; PG8_SCHED;
        }
        if (wr == 0) PG8_BAR;
        { int frE = fr, fqE = fq; LAUNDER_V(frE); LAUNDER_V(fqE); E(acc, cur, wr, wc, frE, fqE); }
        if (!has_next) break;
#pragma unroll
        for (int a = 0; a < 2; ++a)
#pragma unroll
            for (int b = 0; b < 2; ++b)
#pragma unroll
                for (int m = 0; m < 4; ++m)
#pragma unroll
                    for (int n = 0; n < 2; ++n) acc[a][b][m][n] = (f32x4){0.f, 0.f, 0.f, 0.f};
        cur = nxt; cA = nA; cB = nB; ++ui;
        if (wr == 1) PG8_BAR;
    }
    PG8_WAIT_V(0);
    PG8_BAR;
#undef PG8_SA
#undef PG8_SB
#undef PG8_STAGE
#undef PG8_LDA
#undef PG8_LDB
#undef PG8_MMA
#undef PG8_WAIT_V
#undef PG8_WAIT_L
#undef PG8_BAR
#undef PG8_SCHED
}
}

constexpr int RING_BYTES = 131072;
constexpr int LDS_BYTES = 147456;

struct Args { const float* in[20]; float* out; unsigned char* ws; float inv_freq[32]; };
typedef const __attribute__((address_space(4))) Args* KAP_T;

#define DS_READ4(r0, r1, r2, r3, addr, o0, o1, o2, o3) asm volatile("ds_read_b128 %0, %4 offset:%5\n\tds_read_b128 %1, %4 offset:%6\n\tds_read_b128 %2, %4 offset:%7\n\tds_read_b128 %3, %4 offset:%8" \
    : "=&v"(r0), "=&v"(r1), "=&v"(r2), "=&v"(r3) : "v"(addr), "i"(o0), "i"(o1), "i"(o2), "i"(o3) : "memory")
#define LGKM_WAIT4(n, r0, r1, r2, r3) asm volatile("s_waitcnt lgkmcnt(" #n ")" : "+v"(r0), "+v"(r1), "+v"(r2), "+v"(r3) :: "memory")
#define MFMA32(a, b, c) __builtin_amdgcn_mfma_f32_32x32x16_bf16((a), (b), (c), 0, 0, 0)
__device__ __forceinline__ int crow(int r, int hi) { return (r & 3) + 8 * (r >> 2) + 4 * hi; }

__device__ __forceinline__ void wt_item(const float* __restrict__ W, int K, int N, const float* __restrict__ gain, int gainK, bf16_t* WT, LAS float* scr, int item, int nblk, int lane, bool remap_up = false) {
    const int kb = item / nblk, nb = item % nblk, k0 = 64 * kb, n0 = 32 * nb;
    const int ns0 = remap_up ? (((n0 & 255) < 128) ? 128 * (n0 >> 8) + (n0 & 255) : DFF + 128 * (n0 >> 8) + (n0 & 255) - 128) : n0;
    const int n = ns0 + (lane & 31);
    float wv[32];
#pragma unroll
    for (int i = 0; i < 32; ++i) { const int kk = 2 * i + (lane >> 5); wv[i] = (n < N) ? G_(W)[(size_t)(k0 + kk) * N + n] : 0.f; }
#pragma unroll
    for (int i = 0; i < 32; ++i) { const int kk = 2 * i + (lane >> 5); scr[kk * 33 + (lane & 31)] = wv[i]; }
    asm volatile("s_waitcnt lgkmcnt(0)" ::: "memory");
    const int c = lane & 7;
    f32x4 g0 = (f32x4){1.f, 1.f, 1.f, 1.f}, g1 = g0;
    if (k0 < gainK) { g0 = *(GAS const f32x4*)(G_(gain) + k0 + 8 * c); g1 = *(GAS const f32x4*)(G_(gain) + k0 + 8 * c + 4); }
#pragma unroll
    for (int j = 0; j < 4; ++j) { const int nn = (lane >> 3) + 8 * j; const LAS float* s = scr + (8 * c) * 33 + nn;
        u32x4 o; o.x = pk2(s[0 * 33] * g0[0], s[1 * 33] * g0[1]); o.y = pk2(s[2 * 33] * g0[2], s[3 * 33] * g0[3]); o.z = pk2(s[4 * 33] * g1[0], s[5 * 33] * g1[1]); o.w = pk2(s[6 * 33] * g1[2], s[7 * 33] * g1[3]);
        *(GAS u32x4*)(G_(WT) + (size_t)(n0 + nn) * K + k0 + 8 * c) = o; }
    asm volatile("s_waitcnt lgkmcnt(0)" ::: "memory");
}

constexpr int AT_KB = 3 * 8192, AT_VB = 16384, AT_NBUF = 3, AT_BUF = AT_KB + AT_VB  , AT_WSF = AT_NBUF * AT_BUF;
static_assert(AT_WSF + 8 * 128 <= RING_BYTES, "attn lds");
#define DS_READ4X(r0, r1, r2, r3, a0, a1, a2, a3, o0, o1, o2, o3) asm volatile("ds_read_b128 %0, %4 offset:%8\n\tds_read_b128 %1, %5 offset:%9\n\tds_read_b128 %2, %6 offset:%10\n\tds_read_b128 %3, %7 offset:%11" \
    : "=&v"(r0), "=&v"(r1), "=&v"(r2), "=&v"(r3) : "v"(a0), "v"(a1), "v"(a2), "v"(a3), "i"(o0), "i"(o1), "i"(o2), "i"(o3) : "memory")

__device__ __forceinline__ void attn_unit(LAS unsigned char* L, const bf16_t* Q_, const bf16_t* Kg_, const bf16_t* Vt_, bf16_t* mix_, u64* ssq_a, int h, int qb, int wv) {
    GAS const bf16_t* Q = G_(Q_); GAS const bf16_t* Kg = G_(Kg_); GAS const bf16_t* Vt = G_(Vt_); GAS bf16_t* mix = G_(mix_);
    int tid_ = wv * 64 + lane_id_(); LAUNDER_V(tid_);
    const int tid = tid_, lane = tid & 63, w = __builtin_amdgcn_readfirstlane(tid >> 6), r32 = lane & 31, hh = lane >> 5;
    const int q0 = qb * 256;
    bf16x8 qf[12];
    { GAS const bf16_t* qrow = Q + (size_t)(q0 + 32 * w + r32) * QW + h * QKD + 8 * hh;
#pragma unroll
      for (int ks = 0; ks < 12; ++ks) qf[ks] = *(GAS const bf16x8*)(qrow + 16 * ks); }
    f32x16 o[4];
#pragma unroll
    for (int d = 0; d < 4; ++d)
#pragma unroll
        for (int i = 0; i < 16; ++i) o[d][i] = 0.f;
    float l_run = 0.f;
    const int NT = 4 * qb + 4, my_last = 4 * qb + (w >> 1);
    volatile LAS float* wsf = (volatile LAS float*)(L + AT_WSF) + w * 32;
    const unsigned lds_base = (unsigned)(uintptr_t)L;
    unsigned foff[4];
#pragma unroll
    for (int j = 0; j < 4; ++j) foff[j] = lds_base + (unsigned)((r32 >> 1) * 256 + ((((r32 & 1) * 8) + 2 * j + hh) ^ ((r32 >> 1) & 7)) * 16);
    const int du = 4 * w + (lane >> 4), dsl = lane & 15, drb = dsl >> 3, dc = (dsl & 7) ^ (du & 7);
    GAS const bf16_t* ksrc = Kg + (size_t)(2 * du + drb) * QW + h * QKD + dc * 8;
    GAS const bf16_t* vsrc = Vt + (size_t)(h * VD + 2 * du + drb) * SEQ + dc * 8;
#define AT_DMA(t, bi) do { const int kv0_ = (t) * 64; \
    _Pragma("unroll") for (int i = 0; i < 3; ++i) __builtin_amdgcn_global_load_lds((const unsigned*)(ksrc + (size_t)kv0_ * QW + i * 64), (LAS unsigned*)(L + (bi) * AT_BUF + (8 * i + w) * 1024), 16, 0, 0); \
    _Pragma("unroll") for (int i = 0; i < 2; ++i) __builtin_amdgcn_global_load_lds((const unsigned*)(vsrc + (size_t)i * 64 * SEQ + kv0_), (LAS unsigned*)(L + (bi) * AT_BUF + AT_KB + (8 * i + w) * 1024), 16, 0, 0); } while (0)
    AT_DMA(0, 0); AT_DMA(1, 1);
    asm volatile("s_waitcnt vmcnt(5)" ::: "memory"); __builtin_amdgcn_s_barrier(); asm volatile("" ::: "memory");
    int bcur = 0, bnx2 = 2;
    for (int t = 0; t < NT; ++t) {
        if (t + 2 < NT) AT_DMA(t + 2, bnx2);
        if (t <= my_last) {
            const unsigned ka0 = foff[0] + bcur * AT_BUF, ka1 = foff[1] + bcur * AT_BUF, ka2 = foff[2] + bcur * AT_BUF, ka3 = foff[3] + bcur * AT_BUF;
            f32x16 p0, p1;
#pragma unroll
            for (int i = 0; i < 16; ++i) { p0[i] = 0.f; p1[i] = 0.f; }
            bf16x8 fa0, fa1, fa2, fa3, fb0, fb1, fb2, fb3, fc0, fc1, fc2, fc3;
#define QK_RD(s0, s1, s2, s3, kb, g) DS_READ4X(s0, s1, s2, s3, ka0, ka1, ka2, ka3, (g) * 8192 + (kb) * 4096, (g) * 8192 + (kb) * 4096, (g) * 8192 + (kb) * 4096, (g) * 8192 + (kb) * 4096)
#define QK_MM(s0, s1, s2, s3, P, g) do { P = MFMA32(s0, qf[4 * (g)], P); P = MFMA32(s1, qf[4 * (g) + 1], P); P = MFMA32(s2, qf[4 * (g) + 2], P); P = MFMA32(s3, qf[4 * (g) + 3], P); } while (0)
#define PV_RD(s0, s1, s2, s3, va) DS_READ4(s0, s1, s2, s3, va, AT_KB, AT_KB + 4096, AT_KB + 8192, AT_KB + 12288)
#define PV_PK(P, ss) __builtin_bit_cast(bf16x8, (u32x4){pk2(P[8 * (ss) + 0], P[8 * (ss) + 1]), pk2(P[8 * (ss) + 2], P[8 * (ss) + 3]), pk2(P[8 * (ss) + 4], P[8 * (ss) + 5]), pk2(P[8 * (ss) + 6], P[8 * (ss) + 7])})
#define PV_MM(s0, s1, s2, s3, xs) do { o[0] = MFMA32(xs, s0, o[0]); o[1] = MFMA32(xs, s1, o[1]); o[2] = MFMA32(xs, s2, o[2]); o[3] = MFMA32(xs, s3, o[3]); } while (0)
            QK_RD(fa0, fa1, fa2, fa3, 0, 0);
            QK_RD(fb0, fb1, fb2, fb3, 0, 1);
            QK_RD(fc0, fc1, fc2, fc3, 0, 2); LGKM_WAIT4(8, fa0, fa1, fa2, fa3); QK_MM(fa0, fa1, fa2, fa3, p0, 0);
            QK_RD(fa0, fa1, fa2, fa3, 1, 0); LGKM_WAIT4(8, fb0, fb1, fb2, fb3); QK_MM(fb0, fb1, fb2, fb3, p0, 1);
            QK_RD(fb0, fb1, fb2, fb3, 1, 1); LGKM_WAIT4(8, fc0, fc1, fc2, fc3); QK_MM(fc0, fc1, fc2, fc3, p0, 2);
            float ls0 = 0.f, ls1 = 0.f;
#pragma unroll
            for (int i = 0; i < 16; ++i) { p0[i] = __builtin_amdgcn_exp2f(__builtin_amdgcn_fmed3f(p0[i], -1000.f, 100.f)); ls0 += p0[i]; }
            QK_RD(fc0, fc1, fc2, fc3, 1, 2); LGKM_WAIT4(8, fa0, fa1, fa2, fa3); QK_MM(fa0, fa1, fa2, fa3, p1, 0);
            PV_RD(fa0, fa1, fa2, fa3, ka0);  LGKM_WAIT4(8, fb0, fb1, fb2, fb3); QK_MM(fb0, fb1, fb2, fb3, p1, 1);
            PV_RD(fb0, fb1, fb2, fb3, ka1);  LGKM_WAIT4(8, fc0, fc1, fc2, fc3); QK_MM(fc0, fc1, fc2, fc3, p1, 2);
            { const bf16x8 x00 = PV_PK(p0, 0), x01 = PV_PK(p0, 1);
#pragma unroll
              for (int i = 0; i < 16; ++i) { p1[i] = __builtin_amdgcn_exp2f(__builtin_amdgcn_fmed3f(p1[i], -1000.f, 100.f)); ls1 += p1[i]; }
              PV_RD(fc0, fc1, fc2, fc3, ka2); LGKM_WAIT4(8, fa0, fa1, fa2, fa3); PV_MM(fa0, fa1, fa2, fa3, x00);
              PV_RD(fa0, fa1, fa2, fa3, ka3); LGKM_WAIT4(8, fb0, fb1, fb2, fb3); PV_MM(fb0, fb1, fb2, fb3, x01);
              const bf16x8 x10 = PV_PK(p1, 0), x11 = PV_PK(p1, 1);
              LGKM_WAIT4(4, fc0, fc1, fc2, fc3); PV_MM(fc0, fc1, fc2, fc3, x10);
              LGKM_WAIT4(0, fa0, fa1, fa2, fa3); PV_MM(fa0, fa1, fa2, fa3, x11); }
            l_run += ls0 + ls1;
#undef QK_RD
#undef QK_MM
#undef PV_RD
#undef PV_PK
#undef PV_MM
        }
        if (t + 2 < NT) asm volatile("s_waitcnt vmcnt(5) lgkmcnt(0)" ::: "memory"); else asm volatile("s_waitcnt vmcnt(0) lgkmcnt(0)" ::: "memory");
        __builtin_amdgcn_s_barrier(); asm volatile("" ::: "memory");
        bcur = (bcur == 2) ? 0 : bcur + 1; bnx2 = (bnx2 == 2) ? 0 : bnx2 + 1;
    }
#undef AT_DMA
    const float lt = l_run + __shfl_xor(l_run, 32);
    wsf[r32] = 1.0f / lt;
    asm volatile("s_waitcnt lgkmcnt(0)" ::: "memory");
    GAS bf16_t* orow = mix + (size_t)(q0 + 32 * w) * DM + h * VD + r32;
#pragma unroll
    for (int i = 0; i < 16; ++i) { const int qr = crow(i, hh); const float a = wsf[qr]; float ss = 0.f;
#pragma unroll
        for (int d = 0; d < 4; ++d) { const float v = o[d][i] * a; ss += v * v; orow[(size_t)qr * DM + 32 * d] = (bf16_t)f2bf(v); }
        ss += __shfl_xor(ss, 1); ss += __shfl_xor(ss, 2); ss += __shfl_xor(ss, 4); ss += __shfl_xor(ss, 8); ss += __shfl_xor(ss, 16);
        if (r32 == 0) ssq_add(ssq_a + q0 + 32 * w + qr, ss); }
    __syncthreads();
}

constexpr int GL_V = 0  , GL_KD = 32768  , GL_TOT = GL_KD + 18432  , GL_ZA = GL_TOT + 2048  ;
__device__ __forceinline__ void gla_chunk_unit(LAS unsigned char* L, const bf16_t* Z_, const float* wgate_, const float* bgate_, bf16_t* ST_, float* DEC_, int c, int h, int wv) {
    GAS const bf16_t* Z = G_(Z_); GAS const float* wgate = G_(wgate_); GAS const float* bgate = G_(bgate_); GAS bf16_t* ST = G_(ST_); GAS float* DEC = G_(DEC_);
    int tid_ = wv * 64 + lane_id_(); LAUNDER_V(tid_);
    const int tid = tid_, lane = tid & 63, w = __builtin_amdgcn_readfirstlane(tid >> 6), r32 = lane & 31, hh = lane >> 5;
    const size_t row0 = (size_t)c * 64;
#pragma unroll
    for (int i = 0; i < 4; ++i) { const int id = tid + 512 * i, r = id >> 5, cc = id & 31;
        *(LAS u32x4*)(L + GL_V + r * 512 + cc * 16) = *(GAS const u32x4*)(Z + (row0 + r) * IN_PAD + C_GV + h * GDV + cc * 8); }
#pragma unroll
    for (int i = 0; i < 2; ++i) { const int id = tid + 512 * i, r = id >> 4, cc = id & 15;
        ((LAS float*)(L + GL_ZA))[id] = bf2f(Z[(row0 + r) * IN_PAD + C_GA + cc]); }
    __syncthreads();
    const int tq = tid >> 7, col = tid & 127;
    float wg[16];
#pragma unroll
    for (int r = 0; r < 16; ++r) wg[r] = wgate[r * (GH * GDK) + h * GDK + col];
    const float bg = bgate[h * GDK + col];
    float pre[16]; float run = 0.f;
#pragma unroll
    for (int i = 0; i < 16; ++i) {
        const LAS float* za = (const LAS float*)(L + GL_ZA) + (16 * tq + i) * 16;
        float ga = bg;
#pragma unroll
        for (int r = 0; r < 16; ++r) ga += za[r] * wg[r];
        const float ls = fminf(ga, 0.f) - __logf(1.0f + __expf(-fabsf(ga)));
        run += ls * (1.0f / 16.0f); pre[i] = run;
    }
    ((LAS float*)(L + GL_TOT))[tq * 128 + col] = run;
    __syncthreads();
    float off = 0.f, bend = 0.f;
#pragma unroll
    for (int t = 0; t < 4; ++t) { const float v = ((LAS float*)(L + GL_TOT))[t * 128 + col]; bend += v; if (t < tq) off += v; }
    {
        unsigned pkv[8];
#pragma unroll
        for (int i = 0; i < 16; i += 2) {
            const float k0 = bf2f(Z[(row0 + 16 * tq + i) * IN_PAD + C_GK + h * GDK + col]), k1 = bf2f(Z[(row0 + 16 * tq + i + 1) * IN_PAD + C_GK + h * GDK + col]);
            pkv[i >> 1] = pk2(k0 * __expf(bend - off - pre[i]), k1 * __expf(bend - off - pre[i + 1]));
        }
        LAS u32x4* dst = (LAS u32x4*)(L + GL_KD + col * 144 + tq * 32);
        dst[0] = (u32x4){pkv[0], pkv[1], pkv[2], pkv[3]}; dst[1] = (u32x4){pkv[4], pkv[5], pkv[6], pkv[7]};
    }
    if (tq == 0) DEC[(size_t)(c * GH + h) * GDK + col] = __expf(bend);
    __syncthreads();
    f32x16 acc[4];
#pragma unroll
    for (int d = 0; d < 4; ++d)
#pragma unroll
        for (int i = 0; i < 16; ++i) acc[d][i] = 0.f;
#pragma unroll
    for (int ks = 0; ks < 4; ++ks) {
        bf16x8 a;
#pragma unroll
        for (int j = 0; j < 8; ++j) a[j] = (short)*(const LAS unsigned short*)(L + GL_V + (16 * ks + 8 * hh + j) * 512 + (32 * w + r32) * 2);
#pragma unroll
        for (int db = 0; db < 4; ++db) {
            const bf16x8 b = *(const LAS bf16x8*)(L + GL_KD + (32 * db + r32) * 144 + (16 * ks + 8 * hh) * 2);
            acc[db] = MFMA32(a, b, acc[db]);
        }
    }
    GAS bf16_t* stp = ST + ((size_t)(c * GH + h) * GDV + 32 * w) * GDK + r32;
#pragma unroll
    for (int db = 0; db < 4; ++db)
#pragma unroll
        for (int i = 0; i < 16; ++i) stp[(size_t)crow(i, hh) * GDK + 32 * db] = (bf16_t)f2bf(acc[db][i]);
    __syncthreads();
}

constexpr int GO_STR = 260;
__device__ __forceinline__ void gla_out_unit(LAS unsigned char* L, const bf16_t* Z_, const bf16_t* ST_, const float* gnorm_, bf16_t* mix_, int c, int h, int wv) {
    GAS const bf16_t* Z = G_(Z_); GAS const bf16_t* ST = G_(ST_); GAS const float* gnorm = G_(gnorm_); GAS bf16_t* mix = G_(mix_);
    int tid_ = wv * 64 + lane_id_(); LAUNDER_V(tid_);
    const int tid = tid_, lane = tid & 63, w = __builtin_amdgcn_readfirstlane(tid >> 6), r32 = lane & 31, hh = lane >> 5;
    const size_t row0 = (size_t)c * 64;
    f32x16 acc[2];
#pragma unroll
    for (int d = 0; d < 2; ++d)
#pragma unroll
        for (int i = 0; i < 16; ++i) acc[d][i] = 0.f;
    GAS const bf16_t* sp = ST + ((size_t)(c * GH + h) * GDV + 32 * w + r32) * GDK + 8 * hh;
#pragma unroll
    for (int ks = 0; ks < 8; ++ks) {
        const bf16x8 b = *(GAS const bf16x8*)(sp + 16 * ks);
#pragma unroll
        for (int tb = 0; tb < 2; ++tb) {
            const bf16x8 a = *(GAS const bf16x8*)(Z + (row0 + 32 * tb + r32) * IN_PAD + C_GQ + h * GDK + 16 * ks + 8 * hh);
            acc[tb] = MFMA32(a, b, acc[tb]);
        }
    }
    LAS float* of = (LAS float*)L;
#pragma unroll
    for (int tb = 0; tb < 2; ++tb)
#pragma unroll
        for (int i = 0; i < 16; ++i) of[(32 * tb + crow(i, hh)) * GO_STR + 32 * w + r32] = acc[tb][i] * 0.08838834764831845f;
    __syncthreads();
    const int tok = tid >> 3, part = tid & 7;
    f32x4 v[4][2]; float ss = 0.f;
#pragma unroll
    for (int j = 0; j < 4; ++j)
#pragma unroll
        for (int q = 0; q < 2; ++q) { v[j][q] = *(const LAS f32x4*)(of + tok * GO_STR + part * 8 + 64 * j + 4 * q); ss += (v[j][q][0] * v[j][q][0] + v[j][q][1] * v[j][q][1]) + (v[j][q][2] * v[j][q][2] + v[j][q][3] * v[j][q][3]); }
    ss += __shfl_xor(ss, 1); ss += __shfl_xor(ss, 2); ss += __shfl_xor(ss, 4);
    const float rstd = rsqrtf(ss * (1.0f / GDV) + EPS);
    GAS const bf16_t* zg = Z + (row0 + tok) * IN_PAD + C_GG + h * GDV + part * 8;
    GAS bf16_t* op = mix + (row0 + tok) * DM + 1024 + h * GDV + part * 8;
#pragma unroll
    for (int j = 0; j < 4; ++j) {
        const u32x4 gw_ = *(GAS const u32x4*)(zg + 64 * j);
        const f32x4 n0 = *(GAS const f32x4*)(gnorm + part * 8 + 64 * j), n1 = *(GAS const f32x4*)(gnorm + part * 8 + 64 * j + 4);
        u32x4 ow;
        ow.x = pk2(v[j][0][0] * rstd * n0[0] * silu_f(bflo(gw_.x)), v[j][0][1] * rstd * n0[1] * silu_f(bfhi(gw_.x)));
        ow.y = pk2(v[j][0][2] * rstd * n0[2] * silu_f(bflo(gw_.y)), v[j][0][3] * rstd * n0[3] * silu_f(bfhi(gw_.y)));
        ow.z = pk2(v[j][1][0] * rstd * n1[0] * silu_f(bflo(gw_.z)), v[j][1][1] * rstd * n1[1] * silu_f(bfhi(gw_.z)));
        ow.w = pk2(v[j][1][2] * rstd * n1[2] * silu_f(bflo(gw_.w)), v[j][1][3] * rstd * n1[3] * silu_f(bfhi(gw_.w)));
        *(GAS u32x4*)(op + 64 * j) = ow;
    }
    __syncthreads();
}


#define XB_TMO      128
#define XB_XCNT(j)  (256  + 64 * (j))
#define XB_XSUB(j)  (1280 + 64 * (j))
#define XB_XGEN(j)  (2304 + 64 * (j))
#define XB_TOP      3328
#define XB_TOPGEN   3392
#define XCD_BAR_WORDS 3456
#define XB_SPIN_CAP (1u << 22)
__device__ __forceinline__ unsigned xb_ld(unsigned* p)              { return __hip_atomic_load(p, __ATOMIC_RELAXED, __HIP_MEMORY_SCOPE_AGENT); }
__device__ __forceinline__ unsigned xb_add(unsigned* p, unsigned v) { return __hip_atomic_fetch_add(p, v, __ATOMIC_RELAXED, __HIP_MEMORY_SCOPE_AGENT); }
__device__ __forceinline__ unsigned xb_xcc_id() { return (unsigned)__builtin_amdgcn_s_getreg((3 << 11) | 20) & 0xFu; }
#define XB_SPIN(cond, bar) do { unsigned _sp = 0; while (cond) { __builtin_amdgcn_s_sleep(1); \
    if ((++_sp & 255u) == 0u) { if (xb_ld(&(bar)[XB_TMO])) break; if (_sp > XB_SPIN_CAP) { atomicAdd(&(bar)[XB_TMO], 1u); break; } } } } while (0)
struct XcdBarrier { unsigned* bar; unsigned x; volatile LAS unsigned* st; };
__device__ __forceinline__ XcdBarrier xcd_barrier_post(unsigned* bar, volatile LAS unsigned* st, bool t0) {
    XcdBarrier b; b.bar = bar; b.x = xb_xcc_id(); b.st = st;
    if (t0) (void)xb_add(&bar[XB_XCNT(b.x)], 1u);
    return b;
}
__device__ __forceinline__ void xcd_barrier_complete(unsigned* bar, unsigned x, unsigned& nloc, unsigned& nx) {
    const unsigned G = gridDim.x * gridDim.y * gridDim.z;
    unsigned sum, cnt, mine, sp = 0u;
    for (;;) {
        sum = 0u; cnt = 0u; mine = 0u;
#pragma unroll
        for (unsigned j = 0; j < 16; ++j) { const unsigned c = xb_ld(&bar[XB_XCNT(j)]); sum += c; cnt += (c > 0u) ? 1u : 0u; mine = (j == x) ? c : mine; }
        if (sum == G) break;
        __builtin_amdgcn_s_sleep(1);
        if ((++sp & 255u) == 0u) { if (xb_ld(&bar[XB_TMO])) break; if (sp > XB_SPIN_CAP) { atomicAdd(&bar[XB_TMO], 1u); break; } }
    }
    nloc = mine > 0u ? mine : 1u; nx = cnt > 0u ? cnt : 1u;
}
__device__ __forceinline__ void xcd_barrier(const XcdBarrier& b, bool t0) {
    asm volatile("s_waitcnt vmcnt(0)" ::: "memory");
    __syncthreads();
    if (t0) {
        unsigned* bar = b.bar;
        __builtin_amdgcn_s_waitcnt(0);
        unsigned nloc = b.st[0], nx = b.st[1];
        if (nloc == 0u) { xcd_barrier_complete(bar, b.x, nloc, nx); b.st[0] = nloc; b.st[1] = nx; }
        const unsigned old = xb_add(&bar[XB_XSUB(b.x)], 1u);
        const unsigned gen = old / nloc;
        if (old + 1u == (gen + 1u) * nloc) {
            __builtin_amdgcn_fence(__ATOMIC_RELEASE, "agent");
            asm volatile("s_waitcnt vmcnt(0)" ::: "memory");
            const unsigned og = xb_add(&bar[XB_TOP], 1u);
            const unsigned tg = og / nx;
            if (og + 1u == (tg + 1u) * nx) xb_add(&bar[XB_TOPGEN], 1u);
            else XB_SPIN(xb_ld(&bar[XB_TOPGEN]) == tg, bar);
            __builtin_amdgcn_fence(__ATOMIC_ACQUIRE, "agent");
            xb_add(&bar[XB_XGEN(b.x)], 1u);
            asm volatile("s_waitcnt vmcnt(0)" ::: "memory");
        } else {
            XB_SPIN(xb_ld(&bar[XB_XGEN(b.x)]) == gen, bar);
            __builtin_amdgcn_fence(__ATOMIC_ACQUIRE, "agent");
            asm volatile("s_waitcnt vmcnt(0)" ::: "memory");
        }
    }
    __syncthreads();
}

__global__ void __launch_bounds__(512, 2) mk_fwd(Args a) {
    extern __shared__ __attribute__((aligned(16))) unsigned char lds[];
    cg::grid_group grid = cg::this_grid();
    LAS unsigned char* L = (LAS unsigned char*)lds;
    const int G = gridDim.x, bid = blockIdx.x, NGW = G * 8;
    volatile LAS unsigned* MISC = (volatile LAS unsigned*)(L + RING_BYTES + 8192);
    const int wave_s = __builtin_amdgcn_readfirstlane(threadIdx.x >> 6);
    if (wave_s == 0 && lane_id_() < 4) MISC[lane_id_()] = 0u;
    __syncthreads();
    { KAP_T kap0 = (KAP_T)__builtin_amdgcn_kernarg_segment_ptr(); (void)xcd_barrier_post((unsigned*)(kap0->ws + WS_BAR), MISC, wave_s == 0 && lane_id_() == 0); }
#define XSYNC() do { KAP_T kap_ = (KAP_T)__builtin_amdgcn_kernarg_segment_ptr(); LAUNDER_S(kap_); XcdBarrier xb_; xb_.bar = (unsigned*)(kap_->ws + WS_BAR); xb_.x = xb_xcc_id(); xb_.st = (volatile LAS unsigned*)(L + RING_BYTES + 8192); xcd_barrier(xb_, wave_s == 0 && lane_id_() == 0); } while (0)
#define GRID_SYNC() do { asm volatile("s_waitcnt vmcnt(0) lgkmcnt(0)" ::: "memory"); __syncthreads(); grid.sync(); \
    __builtin_amdgcn_fence(__ATOMIC_ACQUIRE, "agent"); asm volatile("s_waitcnt vmcnt(0)" ::: "memory"); __syncthreads(); } while (0)
#ifndef DBG_STOP
#define DBG_STOP 0
#endif
#define DBG_DUMP(k, EXPR) do { if (DBG_STOP == (k)) { PHASE_BEGIN(); for (int m = gw; m < SEQ; m += NGW) for (int c = lane; c < DM; c += 64) out[(size_t)m * DM + c] = (EXPR); return; } } while (0)
#define PHASE_BEGIN() KAP_T kap = (KAP_T)__builtin_amdgcn_kernarg_segment_ptr(); LAUNDER_S(kap); unsigned char* ws = kap->ws; LAUNDER_S(ws); int tid_ = wave_s * 64 + lane_id_(); LAUNDER_V(tid_); const int tid = tid_, lane = tid & 63, wave = __builtin_amdgcn_readfirstlane(tid >> 6), gw = bid * 8 + wave; \
    u64* ssq = (u64*)(ws + WS_SSQ); (void)lane; (void)gw; (void)ssq; \
    u64* ssq_x = ssq + (size_t)l * SEQ; u64* ssq_xn = ssq + (size_t)(l + 1) * SEQ; u64* ssq_cq = ssq + (size_t)(3 + l) * SEQ; u64* ssq_ckv = ssq + (size_t)(5 + l) * SEQ; u64* ssq_x1 = ssq + (size_t)(7 + l) * SEQ; u64* ssq_a = ssq + (size_t)(9 + l) * SEQ; (void)ssq_a; \
    (void)ssq_x; (void)ssq_xn; (void)ssq_cq; (void)ssq_ckv; (void)ssq_x1; \
    bf16_t* Win = (bf16_t*)(ws + WS_WIN); bf16_t* Wuq = (bf16_t*)(ws + WS_WUQ); bf16_t* Wukv = (bf16_t*)(ws + WS_WUKV); \
    bf16_t* Wout = (bf16_t*)(ws + WS_WOUT); bf16_t* Wup = (bf16_t*)(ws + WS_WUP); bf16_t* Wdn = (bf16_t*)(ws + WS_WDN); \
    bf16_t* XB = (bf16_t*)(ws + WS_XB); bf16_t* Z = (bf16_t*)(ws + WS_Z); bf16_t* Qb = (bf16_t*)(ws + WS_Q); bf16_t* Kb = (bf16_t*)(ws + WS_K); bf16_t* Vt = (bf16_t*)(ws + WS_VT); \
    bf16_t* ST = (bf16_t*)(ws + WS_ST); float* DEC = (float*)(ws + WS_DEC); bf16_t* MIX = (bf16_t*)(ws + WS_MIX); \
    bf16_t* ACT = (bf16_t*)(ws + WS_ACT); float* EDGE = (float*)(ws + WS_EDGE); \
    const float* xin = kap->in[0]; float* out = kap->out; \
    (void)Win; (void)Wuq; (void)Wukv; (void)Wout; (void)Wup; (void)Wdn; (void)XB; (void)Z; (void)Qb; (void)Kb; (void)Vt; (void)ST; (void)DEC; (void)MIX; (void)EDGE; (void)ACT; (void)xin; (void)out;

    for (int l = 0; l < NLAYER; ++l) {
        {
            PHASE_BEGIN();
            LAS float* scr = (LAS float*)(L + wave * 16384);
            const float* w_in = kap->in[3] + (size_t)l * DM * IN_DIM; const float* w_uq = kap->in[5] + (size_t)l * QLORA * QW; const float* w_ukv = kap->in[7] + (size_t)l * KVLORA * KVW;
            const float* w_out = kap->in[14] + (size_t)l * DM * DM; const float* w_up = kap->in[16] + (size_t)l * DM * DFF2; const float* w_dn = kap->in[19] + (size_t)l * DFF * DM;
            const float* g_attn = kap->in[2] + l * DM; const float* g_cq = kap->in[4] + l * QLORA; const float* g_ckv = kap->in[6] + l * KVLORA; const float* g_mla = kap->in[13] + l * 1024; const float* g_ffn = kap->in[15] + l * DM;
            constexpr int I_IN = (DM / 64) * (IN_PAD / 32), I_UQ = (QLORA / 64) * (QW / 32), I_UKV = (KVLORA / 64) * (KVW / 32), I_OUT = (DM / 64) * (DM / 32), I_UP = (DM / 64) * (DFF2 / 32), I_DN = (DFF / 64) * (DM / 32);
            constexpr int NITEMS = I_IN + I_UQ + I_UKV + I_OUT + I_UP + I_DN;
            for (int it = gw; it < NITEMS; it += NGW) {
                int r = it;
                if (r < I_IN) { wt_item(w_in, DM, IN_DIM, g_attn, DM, Win, scr, r, IN_PAD / 32, lane); continue; } r -= I_IN;
                if (r < I_UQ) { wt_item(w_uq, QLORA, QW, g_cq, QLORA, Wuq, scr, r, QW / 32, lane); continue; } r -= I_UQ;
                if (r < I_UKV) { wt_item(w_ukv, KVLORA, KVW, g_ckv, KVLORA, Wukv, scr, r, KVW / 32, lane); continue; } r -= I_UKV;
                if (r < I_OUT) { wt_item(w_out, DM, DM, g_mla, 1024, Wout, scr, r, DM / 32, lane); continue; } r -= I_OUT;
                if (r < I_UP) { wt_item(w_up, DM, DFF2, g_ffn, DM, Wup, scr, r, DFF2 / 32, lane, true); continue; } r -= I_UP;
                wt_item(w_dn, DFF, DM, g_ffn, 0, Wdn, scr, r, DM / 32, lane);
            }
            if (l == 0) {
                for (int m = gw; m < SEQ; m += NGW) {
                    GAS const f32x4* xr = (GAS const f32x4*)(G_(xin) + (size_t)m * DM) + lane; float s = 0.f;
                    GAS u32x2* o8 = (GAS u32x2*)(G_(XB) + (size_t)m * DM) + lane;
#pragma unroll
                    for (int j = 0; j < 8; ++j) { const f32x4 v = xr[64 * j]; s += (v[0] * v[0] + v[1] * v[1]) + (v[2] * v[2] + v[3] * v[3]); o8[64 * j] = (u32x2){pk2(v[0], v[1]), pk2(v[2], v[3])}; }
                    s = wave_sum(s); if (lane == 0) G_(ssq_x)[m] = (u64)(s * SSQ_FX + 0.5f);
                }
            }
        }
        if (l == 0) GRID_SYNC(); else XSYNC();
        {
            PHASE_BEGIN();
            pg8::Gemm g{XB, Win, SEQ, IN_PAD, DM, DM, nullptr, 0.f}; pg8::StaticOrder S; S.init(SEQ, IN_PAD, G, bid);
            pg8::EpiRowScale E{Z, IN_PAD, ssq_x, 1.0f / DM, ssq_cq, 0, 2, ssq_ckv, 2, 3};
            pg8::gemm_phase<pg8::EpiRowScale>(L, g, S, E, wave_s);
        }
        XSYNC();
        DBG_DUMP(1, bf2f(Z[(size_t)m * IN_PAD + c]) + bf2f(Z[(size_t)m * IN_PAD + 2048 + c]));
        {
            PHASE_BEGIN();
            { pg8::Gemm g{Z + C_CQ, Wuq, SEQ, QW, QLORA, IN_PAD, nullptr, 0.f}; pg8::StaticOrder S; S.init(SEQ, QW, G, bid);
              pg8::EpiRowScale E{Qb, QW, ssq_cq, 1.0f / QLORA, nullptr, 0, 0, nullptr, 0, 0};
              pg8::gemm_phase<pg8::EpiRowScale>(L, g, S, E, wave_s); }
            { pg8::Gemm g{Z + C_CKV, Wukv, SEQ, KVW, KVLORA, IN_PAD, nullptr, 0.f}; pg8::StaticOrder S; S.init(SEQ, KVW, G, bid);
              pg8::EpiUkv E{Kb, Vt, ssq_ckv, 1.0f / KVLORA};
              pg8::gemm_phase<pg8::EpiUkv>(L, g, S, E, wave_s); }
            const float* wgate = kap->in[10] + (size_t)l * 16 * (GH * GDK); const float* bgate = kap->in[11] + (size_t)l * (GH * GDK);
            for (int u = bid; u < NCHUNK * GH; u += G) gla_chunk_unit(L, Z, wgate, bgate, ST, DEC, u >> 2, u & 3, wave_s);
        }
        XSYNC();
        DBG_DUMP(2, (c < QW ? bf2f(Qb[(size_t)m * QW + c]) + bf2f(Kb[(size_t)m * QW + c]) : bf2f(Vt[(size_t)(c - QW) * SEQ + m])) + bf2f(ST[(size_t)m * 8192 + c]) + bf2f(ST[(size_t)m * 8192 + 4096 + c]));
        {
            PHASE_BEGIN();
            const int* pos = (const int*)kap->in[1];
            const float* qn = kap->in[8] + l * QKD; const float* kn = kap->in[9] + l * QKD;
            const float qscale = 0.07216878364870322f * 1.4426950408889634f;
            for (int m = gw; m < SEQ; m += NGW) {
                const int i = lane & 31;
                const float ang = (float)G_(pos)[m] * kap->inv_freq[i];
                double rev = (double)ang * 0.15915494309189535; rev -= __builtin_rint(rev);
                const float sn = __builtin_amdgcn_sinf((float)rev), cs = __builtin_amdgcn_cosf((float)rev);
                const float krv = bf2f(G_(Z)[(size_t)m * IN_PAD + C_KR + lane]);
                GAS bf16_t* qp = G_(Qb) + (size_t)m * QW; GAS bf16_t* kp = G_(Kb) + (size_t)m * QW;
                float qa[NH][3], ka[NH][2], qs[NH], ks[NH];
#pragma unroll
                for (int h = 0; h < NH; ++h) { qa[h][0] = bf2f(qp[h * QKD + lane]); qa[h][1] = bf2f(qp[h * QKD + 64 + lane]); qa[h][2] = bf2f(qp[h * QKD + 128 + lane]);
                                               ka[h][0] = bf2f(kp[h * QKD + lane]); ka[h][1] = bf2f(kp[h * QKD + 64 + lane]); }
#pragma unroll
                for (int h = 0; h < NH; ++h) { qs[h] = qa[h][0] * qa[h][0] + qa[h][1] * qa[h][1] + qa[h][2] * qa[h][2]; ks[h] = ka[h][0] * ka[h][0] + ka[h][1] * ka[h][1] + krv * krv; }
#pragma unroll
                for (int o = 1; o < 64; o <<= 1)
#pragma unroll
                    for (int h = 0; h < NH; ++h) { qs[h] += __shfl_xor(qs[h], o); ks[h] += __shfl_xor(ks[h], o); }
                const float qg0 = G_(qn)[lane], qg1 = G_(qn)[64 + lane], qg2 = G_(qn)[128 + lane], kg0 = G_(kn)[lane], kg1 = G_(kn)[64 + lane], kg2 = G_(kn)[128 + lane];
#pragma unroll
                for (int h = 0; h < NH; ++h) {
                    { const float rstd = rsqrtf(qs[h] * (1.0f / QKD) + EPS);
                      const float n2 = qa[h][2] * rstd * qg2, pr = __shfl_xor(n2, 32);
                      const float r2 = (lane < 32) ? n2 * cs - pr * sn : n2 * cs + pr * sn;
                      qp[h * QKD + lane] = (bf16_t)f2bf(qa[h][0] * rstd * qg0 * qscale); qp[h * QKD + 64 + lane] = (bf16_t)f2bf(qa[h][1] * rstd * qg1 * qscale); qp[h * QKD + 128 + lane] = (bf16_t)f2bf(r2 * qscale); }
                    { const float rstd = rsqrtf(ks[h] * (1.0f / QKD) + EPS);
                      const float n2 = krv * rstd * kg2, pr = __shfl_xor(n2, 32);
                      const float r2 = (lane < 32) ? n2 * cs - pr * sn : n2 * cs + pr * sn;
                      kp[h * QKD + lane] = (bf16_t)f2bf(ka[h][0] * rstd * kg0); kp[h * QKD + 64 + lane] = (bf16_t)f2bf(ka[h][1] * rstd * kg1); kp[h * QKD + 128 + lane] = (bf16_t)f2bf(r2); }
                }
            }
            constexpr int NE = GH * GDV * GDK;
            for (int e = bid * 512 + tid; e < NE; e += G * 512) {
                const int hd = (e >> 15) * GDK + (e & 127);
                float s = 0.f;
                for (int c0 = 0; c0 < NCHUNK; c0 += 8) {
                    float uu[8], dd[8];
#pragma unroll
                    for (int i = 0; i < 8; ++i) { uu[i] = bf2f(G_(ST)[(size_t)(c0 + i) * NE + e]); dd[i] = G_(DEC)[(size_t)(c0 + i) * (GH * GDK) + hd]; }
#pragma unroll
                    for (int i = 0; i < 8; ++i) { s = s * dd[i] + uu[i]; G_(ST)[(size_t)(c0 + i) * NE + e] = (bf16_t)f2bf(s); }
                }
            }
        }
        XSYNC();
        DBG_DUMP(3, (c < QW ? bf2f(Qb[(size_t)m * QW + c]) + bf2f(Kb[(size_t)m * QW + c]) : 0.f) + bf2f(ST[(size_t)m * 8192 + c]) + bf2f(ST[(size_t)m * 8192 + 4096 + c]));
        {
            PHASE_BEGIN();
            for (int p = bid; p < 256; p += G) {
                const int h = p & 7, s = p >> 3;
                attn_unit(L, Qb, Kb, Vt, MIX, ssq_a, h, 63 - s, wave_s);
                attn_unit(L, Qb, Kb, Vt, MIX, ssq_a, h, s, wave_s);
            }
            const float* gnorm = kap->in[12] + l * GDV;
            for (int u = bid; u < NCHUNK * GH; u += G) gla_out_unit(L, Z, ST, gnorm, MIX, u >> 2, u & 3, wave_s);
        }
        XSYNC();
        DBG_DUMP(4, bf2f(MIX[(size_t)m * DM + c]));
        DBG_DUMP(5, bf2f(MIX[(size_t)m * DM + c]));
        {
            PHASE_BEGIN();
            pg8::Gemm g{MIX, Wout, SEQ, DM, DM, DM, ssq_a, 1.0f / 1024.0f}; pg8::StaticOrder S; S.init(SEQ, DM, G, bid);
            pg8::EpiRes E{l == 0 ? xin : out, out, XB, ssq_x1};
            pg8::gemm_phase<pg8::EpiRes, true>(L, g, S, E, wave_s);
        }
        XSYNC();
        DBG_DUMP(6, out[(size_t)m * DM + c] + bf2f(XB[(size_t)m * DM + c]));
        {
            PHASE_BEGIN();
            const float* cw = kap->in[17] + (size_t)l * 3 * DFF2; const float* cb = kap->in[18] + (size_t)l * DFF2;
            pg8::Gemm g{XB, Wup, SEQ, DFF2, DM, DM, nullptr, 0.f}; pg8::StaticOrder S; S.init(SEQ, DFF2, G, bid);
            pg8::EpiUpConv E{ACT, EDGE, ssq_x1, cw, cb, (LAS float*)(L + RING_BYTES)};
            pg8::gemm_phase<pg8::EpiUpConv>(L, g, S, E, wave_s);
        }
        XSYNC();
        {
            PHASE_BEGIN();
            const float* cw = kap->in[17] + (size_t)l * 3 * DFF2; const float* cb = kap->in[18] + (size_t)l * DFF2;
            for (int idx = bid * 512 + tid; idx < 63 * DFF; idx += G * 512) {
                const int pm = 1 + idx / DFF, gcol = idx % DFF;
                float y0[2], y1[2];
#pragma unroll
                for (int q = 0; q < 2; ++q) { const int c = q * DFF + gcol;
                    const float um2 = G_(EDGE)[(size_t)((pm - 1) * 4 + 2) * DFF2 + c], um1 = G_(EDGE)[(size_t)((pm - 1) * 4 + 3) * DFF2 + c], u0 = G_(EDGE)[(size_t)(pm * 4 + 0) * DFF2 + c], u1 = G_(EDGE)[(size_t)(pm * 4 + 1) * DFF2 + c];
                    const float w0 = G_(cw)[c], w1 = G_(cw)[DFF2 + c], w2 = G_(cw)[2 * DFF2 + c], bb = G_(cb)[c];
                    y0[q] = bb + w0 * um2 + w1 * um1 + w2 * u0; y1[q] = bb + w0 * um1 + w1 * u0 + w2 * u1; }
                G_(ACT)[(size_t)(pm * 256) * DFF + gcol] = (bf16_t)f2bf(silu_f(y0[0]) * y0[1]);
                G_(ACT)[(size_t)(pm * 256 + 1) * DFF + gcol] = (bf16_t)f2bf(silu_f(y1[0]) * y1[1]);
            }
        }
        XSYNC();
        DBG_DUMP(8, bf2f(ACT[(size_t)m * DFF + c]) + bf2f(ACT[(size_t)m * DFF + 3000 + c]));
        {
            PHASE_BEGIN();
            pg8::Gemm g{ACT, Wdn, SEQ, DM, DFF, DFF, nullptr, 0.f}; pg8::StaticOrder S; S.init(SEQ, DM, G, bid);
            pg8::EpiRes E{out, out, XB, ssq_xn};
            pg8::gemm_phase<pg8::EpiRes>(L, g, S, E, wave_s);
        }
        XSYNC();
        if (DBG_STOP == 9) return;
    }
}

extern "C" void kernel_launch(void* const* d_in, const int* in_sizes, int n_in, void* d_out, int out_size, void* d_ws, size_t ws_size, hipStream_t stream) {
    static int grid = 0;
    if (grid == 0) {
        if (n_in != 20 || out_size != SEQ * DM || ws_size < WS_END) { fprintf(stderr, "kernel_launch: unexpected shapes: n_in %d out %d ws %zu (need %zu)\n", n_in, out_size, ws_size, (size_t)WS_END); grid = -1; return; }
        int dev = 0, cus = 0, per_cu = 0;
        hipGetDevice(&dev); hipDeviceGetAttribute(&cus, hipDeviceAttributeMultiprocessorCount, dev);
        hipFuncSetAttribute((const void*)mk_fwd, hipFuncAttributeMaxDynamicSharedMemorySize, LDS_BYTES);
        hipOccupancyMaxActiveBlocksPerMultiprocessor(&per_cu, (const void*)mk_fwd, 512, LDS_BYTES);
        (void)hipGetLastError();
        if (per_cu < 1) per_cu = 1;
        grid = cus * 1;
    }
    if (grid < 0) return;
    hipMemsetAsync((char*)d_ws + WS_CTL, 0, CTL_BYTES, stream);
    Args a{};
    for (int i = 0; i < 20; ++i) a.in[i] = (const float*)d_in[i];
    a.out = (float*)d_out; a.ws = (unsigned char*)d_ws;
    for (int i = 0; i < 32; ++i) a.inv_freq[i] = (float)pow(10000.0, -(double)i / 32.0);
    void* args[] = {&a};
    hipError_t e = hipLaunchCooperativeKernel((const void*)mk_fwd, dim3(grid), dim3(512), args, LDS_BYTES, stream);
    if (e != hipSuccess) fprintf(stderr, "cooperative launch failed: %s (grid %d)\n", hipGetErrorString(e), grid);
}
```

```cpp
#include <hip/hip_runtime.h>
#include <hip/hip_cooperative_groups.h>
#include <cstdio>
#include <cstdint>
#include <cmath>
namespace cg = cooperative_groups;

#define LAS __attribute__((address_space(3)))
typedef unsigned short bf16_t;
typedef unsigned long long u64;
typedef short bf16x8 __attribute__((ext_vector_type(8)));
typedef short s16x4 __attribute__((ext_vector_type(4)));
typedef float f32x4 __attribute__((ext_vector_type(4)));
typedef float f32x16 __attribute__((ext_vector_type(16)));
typedef unsigned u32x4 __attribute__((ext_vector_type(4)));
typedef unsigned u32x2 __attribute__((ext_vector_type(2)));
typedef float f32x2_t __attribute__((ext_vector_type(2)));
typedef __bf16 bf16x2_t __attribute__((ext_vector_type(2)));

constexpr int SEQ = 16384, DM = 2048, NLAYER = 2;
constexpr int IN_DIM = 3920, IN_PAD = 4096;
constexpr int C_CQ = 0, C_CKV = 512, C_KR = 768, C_GQ = 832, C_GK = 1344, C_GV = 1856, C_GA = 2880, C_GG = 2896;
constexpr int QLORA = 512, KVLORA = 256, NH = 8, QKD = 192, NOPE = 128, VD = 128, QW = NH * QKD  , KVW = NH * 256  ;
constexpr int GH = 4, GDK = 128, GDV = 256, NCHUNK = SEQ / 64;
constexpr int DFF = 5632, DFF2 = 11264;
constexpr float EPS = 1e-6f;

constexpr size_t MiB = 1u << 20;
constexpr size_t WS_CTL = 0, CTL_BYTES = 2 * MiB;
constexpr size_t WS_BAR = 0;
constexpr size_t WS_SSQ = 65536;
constexpr size_t WS_WIN = 2 * MiB, WS_WUQ = 18 * MiB, WS_WUKV = WS_WUQ + 3 * MiB / 2, WS_WOUT = WS_WUKV + 1 * MiB, WS_WUP = WS_WOUT + 8 * MiB, WS_WDN = WS_WUP + 44 * MiB;
constexpr size_t WS_XB = 95 * MiB;
constexpr size_t WS_R = 159 * MiB;
constexpr size_t WS_Z = WS_R, WS_Q = WS_Z + 128 * MiB, WS_K = WS_Q + 48 * MiB, WS_VT = WS_K + 48 * MiB, WS_ST = WS_VT + 32 * MiB, WS_DEC = WS_ST + 128 * MiB, WS_MIX = WS_DEC + 1 * MiB;
constexpr size_t WS_ACT = WS_R, WS_EDGE = WS_ACT + 176 * MiB, WS_END = WS_MIX + 64 * MiB;
static_assert(WS_EDGE + 12 * MiB <= WS_END, "ws map");

#define GAS __attribute__((address_space(1)))
template <class T> __device__ __forceinline__ GAS T* G_(T* p) { return (GAS T*)p; }
__device__ __forceinline__ int lane_id_() { unsigned z = 0u; asm volatile("" : "+v"(z)); return (int)__builtin_amdgcn_mbcnt_hi(~0u, __builtin_amdgcn_mbcnt_lo(~0u, z)); }
#define LAUNDER_V(x) asm volatile("" : "+v"(x))
#define LAUNDER_S(x) asm volatile("" : "+s"(x))
__device__ __forceinline__ unsigned f2bf(float f) { unsigned u = __builtin_bit_cast(unsigned, f); return (u + 0x7fffu + ((u >> 16) & 1u)) >> 16; }
__device__ __forceinline__ unsigned pk2(float lo, float hi) { f32x2_t v = {lo, hi}; bf16x2_t b = __builtin_convertvector(v, bf16x2_t); return __builtin_bit_cast(unsigned, b); }
__device__ __forceinline__ float bf2f(unsigned b) { return __builtin_bit_cast(float, b << 16); }
__device__ __forceinline__ float bflo(unsigned w) { return __builtin_bit_cast(float, w << 16); }
__device__ __forceinline__ float bfhi(unsigned w) { return __builtin_bit_cast(float, w & 0xffff0000u); }
__device__ __forceinline__ float wave_sum(float v) {
#pragma unroll
    for (int o = 1; o < 64; o <<= 1) v += __shfl_xor(v, o);
    return v;
}
constexpr float SSQ_FX = 1048576.0f, SSQ_INV = 1.0f / 1048576.0f;
__device__ __forceinline__ void ssq_add(u64* p, float v) { __hip_atomic_fetch_add((GAS u64*)p, (u64)(v * SSQ_FX + 0.5f), __ATOMIC_RELAXED, __HIP_MEMORY_SCOPE_AGENT); }
__device__ __forceinline__ float ssq_get(const u64* p) { return (float)(*(GAS const u64*)p) * SSQ_INV; }
__device__ __forceinline__ float silu_f(float x) { return x * __builtin_amdgcn_rcpf(1.0f + __expf(-x)); }

namespace pg8 {
constexpr int BM = 256, BK = 64, HALF = 128, HTB = HALF * BK * 2, STAGE_BYTES = 8 * HTB, NXCD = 8, WGM = 8;
__host__ __device__ __forceinline__ int lds_byte(int r, int c) { const int st = (r >> 4) * 2 + (c >> 5), rr = r & 15, cc = c & 31, ob = rr * 64 + cc * 2; return st * 1024 + (ob ^ (((ob >> 9) & 1) << 5)); }
__host__ __device__ __forceinline__ void stage_rc(int b, int& R, int& C) { const int st = b / 1024, sb = b % 1024, swz = sb ^ (((sb >> 9) & 1) << 5); R = (st >> 1) * 16 + swz / 64; C = (st & 1) * 32 + (swz % 64) / 2; }
__host__ __device__ __forceinline__ int perm32(int rho) { const int n = rho >> 4, i = rho & 15; return 8 * (i >> 2) + 4 * n + (i & 3); }

struct Unit { int pm, pn; };
struct Gemm { const bf16_t* A; const bf16_t* Bt; int M, N, K, lda; const u64* mid_ssq; float mid_inv; };

struct StaticOrder {
    int nM, nN, nwg, G, c;
    __device__ void init(int M, int N, int G_, int c_) { nM = M / BM; nN = N / BM; nwg = nM * nN; G = G_; c = c_; }
    __device__ bool next(int i, Unit& u) const {
        const long L = (long)i * G + c; if (L >= nwg) return false;
        int wgid = (int)L; { const int q = nwg / NXCD, r = nwg % NXCD, xcd = wgid % NXCD, off = wgid / NXCD; wgid = (xcd < r ? xcd * (q + 1) : r * (q + 1) + (xcd - r) * q) + off; }
        const int nig = WGM * nN, gid = wgid / nig, fm = gid * WGM, gsz = (nM - fm) < WGM ? (nM - fm) : WGM;
        u.pm = fm + ((wgid % nig) % gsz); u.pn = (wgid % nig) / gsz; return true;
    }
};

struct EpiRowScale {
    static constexpr bool PERM = true;
    bf16_t* O; int ldc; const u64* ssq_in; float inv_dim; u64* ssq_a; int a_lo, a_hi; u64* ssq_b; int b_lo, b_hi;
    __device__ __forceinline__ void operator()(const f32x4 (&acc)[2][2][4][2], const Unit& u, int wr, int wc, int fr, int fq) const {
        const int row0 = u.pm * BM + wr * 64 + fr, col0 = u.pn * BM + wc * 32 + 8 * fq;
        u64* sacc = (u.pn >= a_lo && u.pn < a_hi) ? ssq_a : ((u.pn >= b_lo && u.pn < b_hi) ? ssq_b : nullptr);
        float scv[2][4];
#pragma unroll
        for (int ai = 0; ai < 2; ++ai)
#pragma unroll
            for (int m = 0; m < 4; ++m) scv[ai][m] = ssq_in ? ssq_get(ssq_in + row0 + ai * HALF + m * 16) : 0.f;
        asm volatile("" ::: "memory");
#pragma unroll
        for (int ai = 0; ai < 2; ++ai)
#pragma unroll
            for (int m = 0; m < 4; ++m) {
                const int row = row0 + ai * HALF + m * 16;
                const float sc = ssq_in ? rsqrtf(scv[ai][m] * inv_dim + EPS) : 1.0f;
                float ss = 0.f;
#pragma unroll
                for (int bj = 0; bj < 2; ++bj) {
                    const f32x4 v0 = acc[ai][bj][m][0] * sc, v1 = acc[ai][bj][m][1] * sc;
                    ss += (v0[0] * v0[0] + v0[1] * v0[1]) + (v0[2] * v0[2] + v0[3] * v0[3]) + (v1[0] * v1[0] + v1[1] * v1[1]) + (v1[2] * v1[2] + v1[3] * v1[3]);
                    u32x4 w; w.x = pk2(v0[0], v0[1]); w.y = pk2(v0[2], v0[3]); w.z = pk2(v1[0], v1[1]); w.w = pk2(v1[2], v1[3]);
                    *(GAS u32x4*)(G_(O) + (size_t)row * ldc + col0 + bj * HALF) = w;
                }
                if (sacc) { ss += __shfl_xor(ss, 16); ss += __shfl_xor(ss, 32); if (fq == 0) ssq_add(sacc + row, ss); }
            }
    }
};
struct EpiUkv {
    static constexpr bool PERM = true;
    bf16_t* Kb; bf16_t* Vt; const u64* ssq_in; float inv_dim;
    __device__ __forceinline__ void operator()(const f32x4 (&acc)[2][2][4][2], const Unit& u, int wr, int wc, int fr, int fq) const {
        const int row0 = u.pm * BM + wr * 64 + fr, c0 = wc * 32 + 8 * fq;
        float scv[2][4];
#pragma unroll
        for (int ai = 0; ai < 2; ++ai)
#pragma unroll
            for (int m = 0; m < 4; ++m) scv[ai][m] = ssq_get(ssq_in + row0 + ai * HALF + m * 16);
        asm volatile("" ::: "memory");
#pragma unroll
        for (int ai = 0; ai < 2; ++ai)
#pragma unroll
            for (int m = 0; m < 4; ++m) {
                const int row = row0 + ai * HALF + m * 16;
                const int prow = (row & ~15) | (row & 3) | ((row & 4) << 1) | ((row & 8) >> 1);
                const float sc = rsqrtf(scv[ai][m] * inv_dim + EPS);
                { const f32x4 v0 = acc[ai][0][m][0] * sc, v1 = acc[ai][0][m][1] * sc;
                  u32x4 w; w.x = pk2(v0[0], v0[1]); w.y = pk2(v0[2], v0[3]); w.z = pk2(v1[0], v1[1]); w.w = pk2(v1[2], v1[3]);
                  *(GAS u32x4*)(G_(Kb) + (size_t)row * QW + u.pn * QKD + c0) = w; }
#pragma unroll
                for (int n = 0; n < 2; ++n)
#pragma unroll
                    for (int j = 0; j < 4; ++j) G_(Vt)[(size_t)(u.pn * VD + c0 + 4 * n + j) * SEQ + prow] = (bf16_t)f2bf(acc[ai][1][m][n][j] * sc);
            }
    }
};
struct EpiRes {
    static constexpr bool PERM = true;
    const float* base; float* out; bf16_t* xb; u64* ssq_out;
    __device__ __forceinline__ void operator()(const f32x4 (&acc)[2][2][4][2], const Unit& u, int wr, int wc, int fr, int fq) const {
        const int row0 = u.pm * BM + wr * 64 + fr, col0 = u.pn * BM + wc * 32 + 8 * fq;
#pragma unroll
        for (int ai = 0; ai < 2; ++ai) {
            f32x4 bv[4][2][2];
#pragma unroll
            for (int m = 0; m < 4; ++m)
#pragma unroll
                for (int bj = 0; bj < 2; ++bj) { const size_t off = (size_t)(row0 + ai * HALF + m * 16) * DM + col0 + bj * HALF;
                    bv[m][bj][0] = *(GAS const f32x4*)(G_(base) + off); bv[m][bj][1] = *(GAS const f32x4*)(G_(base) + off + 4); }
            asm volatile("" ::: "memory");
#pragma unroll
            for (int m = 0; m < 4; ++m) {
                const int row = row0 + ai * HALF + m * 16; float ss = 0.f;
#pragma unroll
                for (int bj = 0; bj < 2; ++bj) {
                    const size_t off = (size_t)row * DM + col0 + bj * HALF;
                    const f32x4 v0 = acc[ai][bj][m][0] + bv[m][bj][0], v1 = acc[ai][bj][m][1] + bv[m][bj][1];
                    ss += (v0[0] * v0[0] + v0[1] * v0[1]) + (v0[2] * v0[2] + v0[3] * v0[3]) + (v1[0] * v1[0] + v1[1] * v1[1]) + (v1[2] * v1[2] + v1[3] * v1[3]);
                    *(GAS f32x4*)(G_(out) + off) = v0; *(GAS f32x4*)(G_(out) + off + 4) = v1;
                    u32x4 w; w.x = pk2(v0[0], v0[1]); w.y = pk2(v0[2], v0[3]); w.z = pk2(v1[0], v1[1]); w.w = pk2(v1[2], v1[3]);
                    *(GAS u32x4*)(G_(xb) + off) = w;
                }
                ss += __shfl_xor(ss, 16); ss += __shfl_xor(ss, 32); if (fq == 0) ssq_add(ssq_out + row, ss);
            }
        }
    }
};


#define DPP_SHR1(old, src) __builtin_bit_cast(float, __builtin_amdgcn_update_dpp(__builtin_bit_cast(int, (float)(old)), __builtin_bit_cast(int, (float)(src)), 0x111, 0xf, 0xf, false))
#define DPP_SHR2(old, src) __builtin_bit_cast(float, __builtin_amdgcn_update_dpp(__builtin_bit_cast(int, (float)(old)), __builtin_bit_cast(int, (float)(src)), 0x112, 0xf, 0xf, false))
#define DPP_ROR1(src) __builtin_bit_cast(float, __builtin_amdgcn_update_dpp(0, __builtin_bit_cast(int, (float)(src)), 0x121, 0xf, 0xf, false))
#define DPP_ROR2(src) __builtin_bit_cast(float, __builtin_amdgcn_update_dpp(0, __builtin_bit_cast(int, (float)(src)), 0x122, 0xf, 0xf, false))
struct EpiUpConv {
    static constexpr bool PERM = true;
    bf16_t* ACT; float* EDGE; const u64* ssq_in; const float* cw; const float* cb; LAS float* halo;
    __device__ __forceinline__ void operator()(f32x4 (&acc)[2][2][4][2], const Unit& u, int wr, int wc, int fr, int fq) const {
        const int row0 = u.pm * BM + wr * 64 + fr;
        const int g0 = u.pn * 128 + wc * 32 + 8 * fq;
#pragma unroll
        for (int ai = 0; ai < 2; ++ai)
#pragma unroll
            for (int m = 0; m < 4; ++m) {
                const float sc = rsqrtf(ssq_get(ssq_in + row0 + ai * HALF + m * 16) * (1.0f / DM) + EPS);
#pragma unroll
                for (int bj = 0; bj < 2; ++bj)
#pragma unroll
                    for (int n = 0; n < 2; ++n) acc[ai][bj][m][n] = acc[ai][bj][m][n] * sc;
            }
        if (fr >= 14) {
#pragma unroll
            for (int ai = 0; ai < 2; ++ai) { LAS float* hp = halo + ((((2 * ai + wr) * 4 + wc) * 2 + (fr - 14)) * 4 + fq) * 16;
#pragma unroll
                for (int bj = 0; bj < 2; ++bj)
#pragma unroll
                    for (int n = 0; n < 2; ++n) *(LAS f32x4*)(hp + bj * 8 + n * 4) = acc[ai][bj][3][n]; }
            if (wr == 1) { GAS float* ep = G_(EDGE) + (size_t)(u.pm * 4 + 2 + fr - 14) * DFF2 + g0;
#pragma unroll
                for (int bj = 0; bj < 2; ++bj)
#pragma unroll
                    for (int n = 0; n < 2; ++n) *(GAS f32x4*)(ep + bj * DFF + 4 * n) = acc[1][bj][3][n]; }
        }
        if (fr < 2 && wr == 0) { GAS float* ep = G_(EDGE) + (size_t)(u.pm * 4 + fr) * DFF2 + g0;
#pragma unroll
            for (int bj = 0; bj < 2; ++bj)
#pragma unroll
                for (int n = 0; n < 2; ++n) *(GAS f32x4*)(ep + bj * DFF + 4 * n) = acc[0][bj][0][n]; }
        asm volatile("s_waitcnt lgkmcnt(0)" ::: "memory"); __builtin_amdgcn_s_barrier(); asm volatile("" ::: "memory");
#pragma unroll
        for (int n = 0; n < 2; ++n) {
            const int gc = g0 + 4 * n;
            GAS const float* cwg = G_(cw); GAS const float* cbg = G_(cb);
            const f32x4 wg0 = *(GAS const f32x4*)(cwg + gc), wg1 = *(GAS const f32x4*)(cwg + DFF2 + gc), wg2 = *(GAS const f32x4*)(cwg + 2 * DFF2 + gc), bgv = *(GAS const f32x4*)(cbg + gc);
            const f32x4 wu0 = *(GAS const f32x4*)(cwg + DFF + gc), wu1 = *(GAS const f32x4*)(cwg + DFF2 + DFF + gc), wu2 = *(GAS const f32x4*)(cwg + 2 * DFF2 + DFF + gc), buv = *(GAS const f32x4*)(cbg + DFF + gc);
#pragma unroll
            for (int ai = 0; ai < 2; ++ai) {
                const int band = 2 * ai + wr;
                f32x4 pg = (f32x4){0.f, 0.f, 0.f, 0.f}, pu = pg;
                if (band > 0) { const LAS float* hp = halo + ((((band - 1) * 4 + wc) * 2 + (fr & 1)) * 4 + fq) * 16; pg = *(const LAS f32x4*)(hp + n * 4); pu = *(const LAS f32x4*)(hp + 8 + n * 4); }
#pragma unroll
                for (int m = 0; m < 4; ++m) {
                    const f32x4 cg = acc[ai][0][m][n], cu = acc[ai][1][m][n];
                    float av[4];
#pragma unroll
                    for (int j = 0; j < 4; ++j) {
                        const float g1 = DPP_SHR1(DPP_ROR1(pg[j]), cg[j]), g2 = DPP_SHR2(DPP_ROR2(pg[j]), cg[j]);
                        const float u1 = DPP_SHR1(DPP_ROR1(pu[j]), cu[j]), u2 = DPP_SHR2(DPP_ROR2(pu[j]), cu[j]);
                        const float yg = bgv[j] + wg0[j] * g2 + wg1[j] * g1 + wg2[j] * cg[j];
                        const float yu = buv[j] + wu0[j] * u2 + wu1[j] * u1 + wu2[j] * cu[j];
                        av[j] = silu_f(yg) * yu;
                    }
                    *(GAS u32x2*)(G_(ACT) + (size_t)(row0 + ai * HALF + m * 16) * DFF + gc) = (u32x2){pk2(av[0], av[1]), pk2(av[2], av[3])};
                    pg = cg; pu = cu;
                }
            }
        }
    }
};

template <class Epi, bool MIDSCALE = false>
__device__ __forceinline__ void gemm_phase(LAS unsigned char* lds, const Gemm g, const StaticOrder& S, const Epi& E, int wv) {
    int tid_ = wv * 64 + lane_id_(); LAUNDER_V(tid_);
    const int tid = tid_, wid = __builtin_amdgcn_readfirstlane(tid >> 6), lane = tid & 63, wr = wid >> 2, wc = wid & 3, fr = lane & 15, fq = lane >> 4;
    const int K = g.K, nt = K / BK;
    unsigned voffA[2], voffB[2];
#pragma unroll
    for (int i = 0; i < 2; ++i) { int R, C; stage_rc(tid * 16 + i * 8192, R, C); const int Rb = Epi::PERM ? ((R & ~31) + perm32(R & 31)) : R;
        voffA[i] = (unsigned)(R * g.lda + C) * 2u; voffB[i] = (unsigned)(Rb * K + C) * 2u; }
    const size_t kstep = (size_t)(BK * 2);
    const size_t hstepA = (size_t)HALF * g.lda * 2, hstepB = (size_t)HALF * K * 2;
    const size_t tstepA = 2 * hstepA, tstepB = 2 * hstepB;
    const unsigned ldsw = (unsigned)wid * 1024u;
    const int aoff = lds_byte(wr * 64 + fr, fq * 8), boff = lds_byte(wc * 32 + fr, fq * 8);
#define PG8_SA(b, h) (((b) * 2 + (h)) * HTB)
#define PG8_SB(b, h) ((4 + (b) * 2 + (h)) * HTB)
#define PG8_STAGE(bufoff, gbase, voff) do { _Pragma("unroll") for (int _i = 0; _i < 2; ++_i) \
        __builtin_amdgcn_global_load_lds((const unsigned*)((const char*)(gbase) + (voff)[_i]), (LAS unsigned*)(lds + (bufoff) + ldsw + _i * 8192), 16, 0, 0); } while (0)
#define PG8_LDA(dst, b, h) do { _Pragma("unroll") for (int m = 0; m < 4; ++m) _Pragma("unroll") for (int k = 0; k < 2; ++k) dst[m][k] = *(const LAS bf16x8*)(lds + PG8_SA(b, h) + aoff + m * 2048 + k * 1024); } while (0)
#define PG8_LDB(dst, b, h) do { _Pragma("unroll") for (int n = 0; n < 2; ++n) _Pragma("unroll") for (int k = 0; k < 2; ++k) dst[n][k] = *(const LAS bf16x8*)(lds + PG8_SB(b, h) + boff + n * 2048 + k * 1024); } while (0)
#define PG8_MMA(ai, bj, At, Bt) do { __builtin_amdgcn_s_setprio(1); _Pragma("unroll") for (int m = 0; m < 4; ++m) _Pragma("unroll") for (int n = 0; n < 2; ++n) _Pragma("unroll") for (int k = 0; k < 2; ++k) \
        acc[ai][bj][m][n] = __builtin_amdgcn_mfma_f32_16x16x32_bf16(Bt[n][k], At[m][k], acc[ai][bj][m][n], 0, 0, 0); __builtin_amdgcn_s_setprio(0); } while (0)
#define PG8_WAIT_V(n) asm volatile("s_waitcnt vmcnt(" #n ")" ::: "memory")
#define PG8_WAIT_L(n) asm volatile("s_waitcnt lgkmcnt(" #n ")" ::: "memory")
#define PG8_BAR __builtin_amdgcn_s_barrier()
#define PG8_SCHED __builtin_amdgcn_sched_barrier(0)
    Unit cur, nxt; int ui = 0;
    if (!S.next(0, cur)) return;
    f32x4 acc[2][2][4][2];
#pragma unroll
    for (int a = 0; a < 2; ++a)
#pragma unroll
        for (int b = 0; b < 2; ++b)
#pragma unroll
            for (int m = 0; m < 4; ++m)
#pragma unroll
                for (int n = 0; n < 2; ++n) acc[a][b][m][n] = (f32x4){0.f, 0.f, 0.f, 0.f};
    bf16x8 At[4][2], B0[2][2], B1[2][2];
    const char* cA = (const char*)g.A + (size_t)cur.pm * tstepA; const char* cB = (const char*)g.Bt + (size_t)cur.pn * tstepB;
    PG8_STAGE(PG8_SB(0, 0), cB, voffB); PG8_STAGE(PG8_SB(0, 1), cB + hstepB, voffB); PG8_STAGE(PG8_SA(0, 0), cA, voffA); PG8_STAGE(PG8_SA(0, 1), cA + hstepA, voffA);
    if (wr == 1) PG8_BAR;
    PG8_WAIT_V(2); PG8_BAR;
    PG8_STAGE(PG8_SB(1, 0), cB + kstep, voffB); PG8_STAGE(PG8_SA(1, 0), cA + kstep, voffA); PG8_STAGE(PG8_SB(1, 1), cB + hstepB + kstep, voffB);
    PG8_WAIT_V(6); PG8_BAR;
    for (;;) {
        const bool has_next = S.next(ui + 1, nxt);
        const char* nA = has_next ? (const char*)g.A + (size_t)nxt.pm * tstepA : cA; const char* nB = has_next ? (const char*)g.Bt + (size_t)nxt.pn * tstepB : cB;
        for (int t = 0; t < nt; t += 2) {
            const bool last = (t == nt - 2);
            const char* a1 = cA + (size_t)(t + 1) * kstep;
            const char* a2 = last ? nA : cA + (size_t)(t + 2) * kstep; const char* b2 = last ? nB : cB + (size_t)(t + 2) * kstep;
            const char* a3 = a2 + kstep; const char* b3 = b2 + kstep;
            if constexpr (MIDSCALE) { if (t == nt / 2) {
#pragma unroll
                for (int ai = 0; ai < 2; ++ai)
#pragma unroll
                    for (int m = 0; m < 4; ++m) { const float sc = rsqrtf(ssq_get(g.mid_ssq + cur.pm * BM + ai * HALF + wr * 64 + m * 16 + fr) * g.mid_inv + EPS);
#pragma unroll
                        for (int bj = 0; bj < 2; ++bj)
#pragma unroll
                            for (int n = 0; n < 2; ++n) acc[ai][bj][m][n] = acc[ai][bj][m][n] * sc; } } }
            PG8_LDB(B0, 0, 0); PG8_LDB(B1, 0, 1); PG8_SCHED; PG8_LDA(At, 0, 0); PG8_STAGE(PG8_SA(1, 1), a1 + hstepA, voffA);
            PG8_WAIT_V(8); PG8_WAIT_L(0); PG8_BAR; PG8_MMA(0, 0, At, B0); PG8_MMA(0, 1, At, B1); PG8_BAR; PG8_SCHED;
            PG8_LDA(At, 0, 1); PG8_STAGE(PG8_SB(0, 0), b2, voffB); PG8_STAGE(PG8_SB(0, 1), b2 + hstepB, voffB); PG8_STAGE(PG8_SA(0, 0), a2, voffA);
            PG8_WAIT_V(8); PG8_WAIT_L(0); PG8_BAR; PG8_MMA(1, 0, At, B0); PG8_MMA(1, 1, At, B1); PG8_BAR; PG8_SCHED;
            PG8_LDB(B0, 1, 0); PG8_LDB(B1, 1, 1); PG8_SCHED; PG8_LDA(At, 1, 0); PG8_STAGE(PG8_SA(0, 1), a2 + hstepA, voffA);
            PG8_WAIT_V(8); PG8_WAIT_L(0); PG8_BAR; PG8_MMA(0, 0, At, B0); PG8_MMA(0, 1, At, B1); PG8_BAR; PG8_SCHED;
            PG8_LDA(At, 1, 1); PG8_STAGE(PG8_SB(1, 0), b3, voffB); PG8_STAGE(PG8_SB(1, 1), b3 + hstepB, voffB); PG8_STAGE(PG8_SA(1, 0), a3, voffA);
            PG8_WAIT_V(8); PG8_WAIT_L(0); PG8_BAR; PG8_MMA(1, 0, At, B0); PG8_MMA(1, 1, At, B1); PG8_BAR; PG8_SCHED;
        }
        if (wr == 0) PG8_BAR;
        { int frE = fr, fqE = fq; LAUNDER_V(frE); LAUNDER_V(fqE); E(acc, cur, wr, wc, frE, fqE); }
        if (!has_next) break;
#pragma unroll
        for (int a = 0; a < 2; ++a)
#pragma unroll
            for (int b = 0; b < 2; ++b)
#pragma unroll
                for (int m = 0; m < 4; ++m)
#pragma unroll
                    for (int n = 0; n < 2; ++n) acc[a][b][m][n] = (f32x4){0.f, 0.f, 0.f, 0.f};
        cur = nxt; cA = nA; cB = nB; ++ui;
        if (wr == 1) PG8_BAR;
    }
    PG8_WAIT_V(0);
    PG8_BAR;
#undef PG8_SA
#undef PG8_SB
#undef PG8_STAGE
#undef PG8_LDA
#undef PG8_LDB
#undef PG8_MMA
#undef PG8_WAIT_V
#undef PG8_WAIT_L
#undef PG8_BAR
#undef PG8_SCHED
}
}

constexpr int RING_BYTES = 131072;
constexpr int LDS_BYTES = 147456;

struct Args { const float* in[20]; float* out; unsigned char* ws; float inv_freq[32]; };
typedef const __attribute__((address_space(4))) Args* KAP_T;

#define DS_READ4(r0, r1, r2, r3, addr, o0, o1, o2, o3) asm volatile("ds_read_b128 %0, %4 offset:%5\n\tds_read_b128 %1, %4 offset:%6\n\tds_read_b128 %2, %4 offset:%7\n\tds_read_b128 %3, %4 offset:%8" \
    : "=&v"(r0), "=&v"(r1), "=&v"(r2), "=&v"(r3) : "v"(addr), "i"(o0), "i"(o1), "i"(o2), "i"(o3) : "memory")
#define LGKM_WAIT4(n, r0, r1, r2, r3) asm volatile("s_waitcnt lgkmcnt(" #n ")" : "+v"(r0), "+v"(r1), "+v"(r2), "+v"(r3) :: "memory")
#define MFMA32(a, b, c) __builtin_amdgcn_mfma_f32_32x32x16_bf16((a), (b), (c), 0, 0, 0)
__device__ __forceinline__ int crow(int r, int hi) { return (r & 3) + 8 * (r >> 2) + 4 * hi; }

__device__ __forceinline__ void wt_item(const float* __restrict__ W, int K, int N, const float* __restrict__ gain, int gainK, bf16_t* WT, LAS float* scr, int item, int nblk, int lane, bool remap_up = false) {
    const int kb = item / nblk, nb = item % nblk, k0 = 64 * kb, n0 = 32 * nb;
    const int ns0 = remap_up ? (((n0 & 255) < 128) ? 128 * (n0 >> 8) + (n0 & 255) : DFF + 128 * (n0 >> 8) + (n0 & 255) - 128) : n0;
    const int n = ns0 + (lane & 31);
    float wv[32];
#pragma unroll
    for (int i = 0; i < 32; ++i) { const int kk = 2 * i + (lane >> 5); wv[i] = (n < N) ? G_(W)[(size_t)(k0 + kk) * N + n] : 0.f; }
#pragma unroll
    for (int i = 0; i < 32; ++i) { const int kk = 2 * i + (lane >> 5); scr[kk * 33 + (lane & 31)] = wv[i]; }
    asm volatile("s_waitcnt lgkmcnt(0)" ::: "memory");
    const int c = lane & 7;
    f32x4 g0 = (f32x4){1.f, 1.f, 1.f, 1.f}, g1 = g0;
    if (k0 < gainK) { g0 = *(GAS const f32x4*)(G_(gain) + k0 + 8 * c); g1 = *(GAS const f32x4*)(G_(gain) + k0 + 8 * c + 4); }
#pragma unroll
    for (int j = 0; j < 4; ++j) { const int nn = (lane >> 3) + 8 * j; const LAS float* s = scr + (8 * c) * 33 + nn;
        u32x4 o; o.x = pk2(s[0 * 33] * g0[0], s[1 * 33] * g0[1]); o.y = pk2(s[2 * 33] * g0[2], s[3 * 33] * g0[3]); o.z = pk2(s[4 * 33] * g1[0], s[5 * 33] * g1[1]); o.w = pk2(s[6 * 33] * g1[2], s[7 * 33] * g1[3]);
        *(GAS u32x4*)(G_(WT) + (size_t)(n0 + nn) * K + k0 + 8 * c) = o; }
    asm volatile("s_waitcnt lgkmcnt(0)" ::: "memory");
}

constexpr int AT_KB = 3 * 8192, AT_VB = 16384, AT_NBUF = 3, AT_BUF = AT_KB + AT_VB  , AT_WSF = AT_NBUF * AT_BUF;
static_assert(AT_WSF + 8 * 128 <= RING_BYTES, "attn lds");
#define DS_READ4X(r0, r1, r2, r3, a0, a1, a2, a3, o0, o1, o2, o3) asm volatile("ds_read_b128 %0, %4 offset:%8\n\tds_read_b128 %1, %5 offset:%9\n\tds_read_b128 %2, %6 offset:%10\n\tds_read_b128 %3, %7 offset:%11" \
    : "=&v"(r0), "=&v"(r1), "=&v"(r2), "=&v"(r3) : "v"(a0), "v"(a1), "v"(a2), "v"(a3), "i"(o0), "i"(o1), "i"(o2), "i"(o3) : "memory")

__device__ __forceinline__ void attn_unit(LAS unsigned char* L, const bf16_t* Q_, const bf16_t* Kg_, const bf16_t* Vt_, bf16_t* mix_, u64* ssq_a, int h, int qb, int wv) {
    GAS const bf16_t* Q = G_(Q_); GAS const bf16_t* Kg = G_(Kg_); GAS const bf16_t* Vt = G_(Vt_); GAS bf16_t* mix = G_(mix_);
    int tid_ = wv * 64 + lane_id_(); LAUNDER_V(tid_);
    const int tid = tid_, lane = tid & 63, w = __builtin_amdgcn_readfirstlane(tid >> 6), r32 = lane & 31, hh = lane >> 5;
    const int q0 = qb * 256;
    bf16x8 qf[12];
    { GAS const bf16_t* qrow = Q + (size_t)(q0 + 32 * w + r32) * QW + h * QKD + 8 * hh;
#pragma unroll
      for (int ks = 0; ks < 12; ++ks) qf[ks] = *(GAS const bf16x8*)(qrow + 16 * ks); }
    f32x16 o[4];
#pragma unroll
    for (int d = 0; d < 4; ++d)
#pragma unroll
        for (int i = 0; i < 16; ++i) o[d][i] = 0.f;
    float l_run = 0.f;
    const int NT = 4 * qb + 4, my_last = 4 * qb + (w >> 1);
    volatile LAS float* wsf = (volatile LAS float*)(L + AT_WSF) + w * 32;
    const unsigned lds_base = (unsigned)(uintptr_t)L;
#define AT_FOFF(j, lz, bo) (lds_base + (bo) + (unsigned)((((lz) & 31) >> 1) * 256 + ((((((lz) & 31) & 1) * 8) + 2 * (j) + ((lz) >> 5)) ^ ((((lz) & 31) >> 1) & 7)) * 16))
    const int du = 4 * w + (lane >> 4), dsl = lane & 15, drb = dsl >> 3, dc = (dsl & 7) ^ (du & 7);
    GAS const bf16_t* ksrc = Kg + (size_t)(2 * du + drb) * QW + h * QKD + dc * 8;
    GAS const bf16_t* vsrc = Vt + (size_t)(h * VD + 2 * du + drb) * SEQ + dc * 8;
#define AT_DMA(t, bi) do { const int kv0_ = (t) * 64; \
    _Pragma("unroll") for (int i = 0; i < 3; ++i) __builtin_amdgcn_global_load_lds((const unsigned*)(ksrc + (size_t)kv0_ * QW + i * 64), (LAS unsigned*)(L + (bi) * AT_BUF + (8 * i + w) * 1024), 16, 0, 0); \
    _Pragma("unroll") for (int i = 0; i < 2; ++i) __builtin_amdgcn_global_load_lds((const unsigned*)(vsrc + (size_t)i * 64 * SEQ + kv0_), (LAS unsigned*)(L + (bi) * AT_BUF + AT_KB + (8 * i + w) * 1024), 16, 0, 0); } while (0)
    AT_DMA(0, 0); AT_DMA(1, 1);
    asm volatile("s_waitcnt vmcnt(5)" ::: "memory"); __builtin_amdgcn_s_barrier(); asm volatile("" ::: "memory");
    int bcur = 0, bnx2 = 2;
    for (int t = 0; t < NT; ++t) {
        if (t + 2 < NT) AT_DMA(t + 2, bnx2);
        if (t <= my_last) {
            int lz_ = lane; LAUNDER_V(lz_); const unsigned bo_ = (unsigned)bcur * AT_BUF;
            const unsigned ka0 = AT_FOFF(0, lz_, bo_), ka1 = AT_FOFF(1, lz_, bo_), ka2 = AT_FOFF(2, lz_, bo_), ka3 = AT_FOFF(3, lz_, bo_);
            f32x16 p0, p1;
#pragma unroll
            for (int i = 0; i < 16; ++i) { p0[i] = 0.f; p1[i] = 0.f; }
            bf16x8 fa0, fa1, fa2, fa3, fb0, fb1, fb2, fb3, fc0, fc1, fc2, fc3;
#define QK_RD(s0, s1, s2, s3, kb, g) DS_READ4X(s0, s1, s2, s3, ka0, ka1, ka2, ka3, (g) * 8192 + (kb) * 4096, (g) * 8192 + (kb) * 4096, (g) * 8192 + (kb) * 4096, (g) * 8192 + (kb) * 4096)
#define QK_MM(s0, s1, s2, s3, P, g) do { P = MFMA32(s0, qf[4 * (g)], P); P = MFMA32(s1, qf[4 * (g) + 1], P); P = MFMA32(s2, qf[4 * (g) + 2], P); P = MFMA32(s3, qf[4 * (g) + 3], P); } while (0)
#define PV_RD(s0, s1, s2, s3, va) DS_READ4(s0, s1, s2, s3, va, AT_KB, AT_KB + 4096, AT_KB + 8192, AT_KB + 12288)
#define PV_PK(P, ss) __builtin_bit_cast(bf16x8, (u32x4){pk2(P[8 * (ss) + 0], P[8 * (ss) + 1]), pk2(P[8 * (ss) + 2], P[8 * (ss) + 3]), pk2(P[8 * (ss) + 4], P[8 * (ss) + 5]), pk2(P[8 * (ss) + 6], P[8 * (ss) + 7])})
#define PV_MM(s0, s1, s2, s3, xs) do { o[0] = MFMA32(xs, s0, o[0]); o[1] = MFMA32(xs, s1, o[1]); o[2] = MFMA32(xs, s2, o[2]); o[3] = MFMA32(xs, s3, o[3]); } while (0)
            QK_RD(fa0, fa1, fa2, fa3, 0, 0);
            QK_RD(fb0, fb1, fb2, fb3, 0, 1);
            QK_RD(fc0, fc1, fc2, fc3, 0, 2); LGKM_WAIT4(8, fa0, fa1, fa2, fa3); QK_MM(fa0, fa1, fa2, fa3, p0, 0);
            QK_RD(fa0, fa1, fa2, fa3, 1, 0); LGKM_WAIT4(8, fb0, fb1, fb2, fb3); QK_MM(fb0, fb1, fb2, fb3, p0, 1);
            QK_RD(fb0, fb1, fb2, fb3, 1, 1); LGKM_WAIT4(8, fc0, fc1, fc2, fc3); QK_MM(fc0, fc1, fc2, fc3, p0, 2);
            float ls0 = 0.f, ls1 = 0.f;
#pragma unroll
            for (int i = 0; i < 16; ++i) { p0[i] = __builtin_amdgcn_exp2f(__builtin_amdgcn_fmed3f(p0[i], -1000.f, 100.f)); ls0 += p0[i]; }
            QK_RD(fc0, fc1, fc2, fc3, 1, 2); LGKM_WAIT4(8, fa0, fa1, fa2, fa3); QK_MM(fa0, fa1, fa2, fa3, p1, 0);
            PV_RD(fa0, fa1, fa2, fa3, ka0);  LGKM_WAIT4(8, fb0, fb1, fb2, fb3); QK_MM(fb0, fb1, fb2, fb3, p1, 1);
            PV_RD(fb0, fb1, fb2, fb3, ka1);  LGKM_WAIT4(8, fc0, fc1, fc2, fc3); QK_MM(fc0, fc1, fc2, fc3, p1, 2);
            { const bf16x8 x00 = PV_PK(p0, 0), x01 = PV_PK(p0, 1);
#pragma unroll
              for (int i = 0; i < 16; ++i) { p1[i] = __builtin_amdgcn_exp2f(__builtin_amdgcn_fmed3f(p1[i], -1000.f, 100.f)); ls1 += p1[i]; }
              PV_RD(fc0, fc1, fc2, fc3, ka2); LGKM_WAIT4(8, fa0, fa1, fa2, fa3); PV_MM(fa0, fa1, fa2, fa3, x00);
              PV_RD(fa0, fa1, fa2, fa3, ka3); LGKM_WAIT4(8, fb0, fb1, fb2, fb3); PV_MM(fb0, fb1, fb2, fb3, x01);
              const bf16x8 x10 = PV_PK(p1, 0), x11 = PV_PK(p1, 1);
              LGKM_WAIT4(4, fc0, fc1, fc2, fc3); PV_MM(fc0, fc1, fc2, fc3, x10);
              LGKM_WAIT4(0, fa0, fa1, fa2, fa3); PV_MM(fa0, fa1, fa2, fa3, x11); }
            l_run += ls0 + ls1;
#undef QK_RD
#undef QK_MM
#undef PV_RD
#undef PV_PK
#undef PV_MM
        }
        if (t + 2 < NT) asm volatile("s_waitcnt vmcnt(5) lgkmcnt(0)" ::: "memory"); else asm volatile("s_waitcnt vmcnt(0) lgkmcnt(0)" ::: "memory");
        __builtin_amdgcn_s_barrier(); asm volatile("" ::: "memory");
        bcur = (bcur == 2) ? 0 : bcur + 1; bnx2 = (bnx2 == 2) ? 0 : bnx2 + 1;
    }
#undef AT_DMA
#undef AT_FOFF
    const float lt = l_run + __shfl_xor(l_run, 32);
    wsf[r32] = 1.0f / lt;
    asm volatile("s_waitcnt lgkmcnt(0)" ::: "memory");
    GAS bf16_t* orow = mix + (size_t)(q0 + 32 * w) * DM + h * VD + r32;
#pragma unroll
    for (int i = 0; i < 16; ++i) { const int qr = crow(i, hh); const float a = wsf[qr]; float ss = 0.f;
#pragma unroll
        for (int d = 0; d < 4; ++d) { const float v = o[d][i] * a; ss += v * v; orow[(size_t)qr * DM + 32 * d] = (bf16_t)f2bf(v); }
        ss += __shfl_xor(ss, 1); ss += __shfl_xor(ss, 2); ss += __shfl_xor(ss, 4); ss += __shfl_xor(ss, 8); ss += __shfl_xor(ss, 16);
        if (r32 == 0) ssq_add(ssq_a + q0 + 32 * w + qr, ss); }
    __syncthreads();
}

constexpr int GL_V = 0  , GL_KD = 32768  , GL_TOT = GL_KD + 18432  , GL_ZA = GL_TOT + 2048  ;
__device__ __forceinline__ void gla_chunk_unit(LAS unsigned char* L, const bf16_t* Z_, const float* wgate_, const float* bgate_, bf16_t* ST_, float* DEC_, int c, int h, int wv) {
    GAS const bf16_t* Z = G_(Z_); GAS const float* wgate = G_(wgate_); GAS const float* bgate = G_(bgate_); GAS bf16_t* ST = G_(ST_); GAS float* DEC = G_(DEC_);
    int tid_ = wv * 64 + lane_id_(); LAUNDER_V(tid_);
    const int tid = tid_, lane = tid & 63, w = __builtin_amdgcn_readfirstlane(tid >> 6), r32 = lane & 31, hh = lane >> 5;
    const size_t row0 = (size_t)c * 64;
#pragma unroll
    for (int i = 0; i < 4; ++i) { const int id = tid + 512 * i, r = id >> 5, cc = id & 31;
        *(LAS u32x4*)(L + GL_V + r * 512 + cc * 16) = *(GAS const u32x4*)(Z + (row0 + r) * IN_PAD + C_GV + h * GDV + cc * 8); }
#pragma unroll
    for (int i = 0; i < 2; ++i) { const int id = tid + 512 * i, r = id >> 4, cc = id & 15;
        ((LAS float*)(L + GL_ZA))[id] = bf2f(Z[(row0 + r) * IN_PAD + C_GA + cc]); }
    __syncthreads();
    const int tq = tid >> 7, col = tid & 127;
    float wg[16];
#pragma unroll
    for (int r = 0; r < 16; ++r) wg[r] = wgate[r * (GH * GDK) + h * GDK + col];
    const float bg = bgate[h * GDK + col];
    float pre[16]; float run = 0.f;
#pragma unroll
    for (int i = 0; i < 16; ++i) {
        const LAS float* za = (const LAS float*)(L + GL_ZA) + (16 * tq + i) * 16;
        float ga = bg;
#pragma unroll
        for (int r = 0; r < 16; ++r) ga += za[r] * wg[r];
        const float ls = fminf(ga, 0.f) - __logf(1.0f + __expf(-fabsf(ga)));
        run += ls * (1.0f / 16.0f); pre[i] = run;
    }
    ((LAS float*)(L + GL_TOT))[tq * 128 + col] = run;
    __syncthreads();
    float off = 0.f, bend = 0.f;
#pragma unroll
    for (int t = 0; t < 4; ++t) { const float v = ((LAS float*)(L + GL_TOT))[t * 128 + col]; bend += v; if (t < tq) off += v; }
    {
        unsigned pkv[8];
#pragma unroll
        for (int i = 0; i < 16; i += 2) {
            const float k0 = bf2f(Z[(row0 + 16 * tq + i) * IN_PAD + C_GK + h * GDK + col]), k1 = bf2f(Z[(row0 + 16 * tq + i + 1) * IN_PAD + C_GK + h * GDK + col]);
            pkv[i >> 1] = pk2(k0 * __expf(bend - off - pre[i]), k1 * __expf(bend - off - pre[i + 1]));
        }
        LAS u32x4* dst = (LAS u32x4*)(L + GL_KD + col * 144 + tq * 32);
        dst[0] = (u32x4){pkv[0], pkv[1], pkv[2], pkv[3]}; dst[1] = (u32x4){pkv[4], pkv[5], pkv[6], pkv[7]};
    }
    if (tq == 0) DEC[(size_t)(c * GH + h) * GDK + col] = __expf(bend);
    __syncthreads();
    f32x16 acc[4];
#pragma unroll
    for (int d = 0; d < 4; ++d)
#pragma unroll
        for (int i = 0; i < 16; ++i) acc[d][i] = 0.f;
#pragma unroll
    for (int ks = 0; ks < 4; ++ks) {
        bf16x8 a;
#pragma unroll
        for (int j = 0; j < 8; ++j) a[j] = (short)*(const LAS unsigned short*)(L + GL_V + (16 * ks + 8 * hh + j) * 512 + (32 * w + r32) * 2);
#pragma unroll
        for (int db = 0; db < 4; ++db) {
            const bf16x8 b = *(const LAS bf16x8*)(L + GL_KD + (32 * db + r32) * 144 + (16 * ks + 8 * hh) * 2);
            acc[db] = MFMA32(a, b, acc[db]);
        }
    }
    GAS bf16_t* stp = ST + ((size_t)(c * GH + h) * GDV + 32 * w) * GDK + r32;
#pragma unroll
    for (int db = 0; db < 4; ++db)
#pragma unroll
        for (int i = 0; i < 16; ++i) stp[(size_t)crow(i, hh) * GDK + 32 * db] = (bf16_t)f2bf(acc[db][i]);
    __syncthreads();
}

constexpr int GO_STR = 260;
__device__ __forceinline__ void gla_out_unit(LAS unsigned char* L, const bf16_t* Z_, const bf16_t* ST_, const float* gnorm_, bf16_t* mix_, int c, int h, int wv) {
    GAS const bf16_t* Z = G_(Z_); GAS const bf16_t* ST = G_(ST_); GAS const float* gnorm = G_(gnorm_); GAS bf16_t* mix = G_(mix_);
    int tid_ = wv * 64 + lane_id_(); LAUNDER_V(tid_);
    const int tid = tid_, lane = tid & 63, w = __builtin_amdgcn_readfirstlane(tid >> 6), r32 = lane & 31, hh = lane >> 5;
    const size_t row0 = (size_t)c * 64;
    f32x16 acc[2];
#pragma unroll
    for (int d = 0; d < 2; ++d)
#pragma unroll
        for (int i = 0; i < 16; ++i) acc[d][i] = 0.f;
    GAS const bf16_t* sp = ST + ((size_t)(c * GH + h) * GDV + 32 * w + r32) * GDK + 8 * hh;
#pragma unroll
    for (int ks = 0; ks < 8; ++ks) {
        const bf16x8 b = *(GAS const bf16x8*)(sp + 16 * ks);
#pragma unroll
        for (int tb = 0; tb < 2; ++tb) {
            const bf16x8 a = *(GAS const bf16x8*)(Z + (row0 + 32 * tb + r32) * IN_PAD + C_GQ + h * GDK + 16 * ks + 8 * hh);
            acc[tb] = MFMA32(a, b, acc[tb]);
        }
    }
    LAS float* of = (LAS float*)L;
#pragma unroll
    for (int tb = 0; tb < 2; ++tb)
#pragma unroll
        for (int i = 0; i < 16; ++i) of[(32 * tb + crow(i, hh)) * GO_STR + 32 * w + r32] = acc[tb][i] * 0.08838834764831845f;
    __syncthreads();
    const int tok = tid >> 3, part = tid & 7;
    f32x4 v[4][2]; float ss = 0.f;
#pragma unroll
    for (int j = 0; j < 4; ++j)
#pragma unroll
        for (int q = 0; q < 2; ++q) { v[j][q] = *(const LAS f32x4*)(of + tok * GO_STR + part * 8 + 64 * j + 4 * q); ss += (v[j][q][0] * v[j][q][0] + v[j][q][1] * v[j][q][1]) + (v[j][q][2] * v[j][q][2] + v[j][q][3] * v[j][q][3]); }
    ss += __shfl_xor(ss, 1); ss += __shfl_xor(ss, 2); ss += __shfl_xor(ss, 4);
    const float rstd = rsqrtf(ss * (1.0f / GDV) + EPS);
    GAS const bf16_t* zg = Z + (row0 + tok) * IN_PAD + C_GG + h * GDV + part * 8;
    GAS bf16_t* op = mix + (row0 + tok) * DM + 1024 + h * GDV + part * 8;
#pragma unroll
    for (int j = 0; j < 4; ++j) {
        const u32x4 gw_ = *(GAS const u32x4*)(zg + 64 * j);
        const f32x4 n0 = *(GAS const f32x4*)(gnorm + part * 8 + 64 * j), n1 = *(GAS const f32x4*)(gnorm + part * 8 + 64 * j + 4);
        u32x4 ow;
        ow.x = pk2(v[j][0][0] * rstd * n0[0] * silu_f(bflo(gw_.x)), v[j][0][1] * rstd * n0[1] * silu_f(bfhi(gw_.x)));
        ow.y = pk2(v[j][0][2] * rstd * n0[2] * silu_f(bflo(gw_.y)), v[j][0][3] * rstd * n0[3] * silu_f(bfhi(gw_.y)));
        ow.z = pk2(v[j][1][0] * rstd * n1[0] * silu_f(bflo(gw_.z)), v[j][1][1] * rstd * n1[1] * silu_f(bfhi(gw_.z)));
        ow.w = pk2(v[j][1][2] * rstd * n1[2] * silu_f(bflo(gw_.w)), v[j][1][3] * rstd * n1[3] * silu_f(bfhi(gw_.w)));
        *(GAS u32x4*)(op + 64 * j) = ow;
    }
    __syncthreads();
}


#define XB_TMO      128
#define XB_XCNT(j)  (256  + 64 * (j))
#define XB_XSUB(j)  (1280 + 64 * (j))
#define XB_XGEN(j)  (2304 + 64 * (j))
#define XB_TOP      3328
#define XB_TOPGEN   3392
#define XCD_BAR_WORDS 3456
#define XB_SPIN_CAP (1u << 22)
__device__ __forceinline__ unsigned xb_ld(unsigned* p)              { return __hip_atomic_load(p, __ATOMIC_RELAXED, __HIP_MEMORY_SCOPE_AGENT); }
__device__ __forceinline__ unsigned xb_add(unsigned* p, unsigned v) { return __hip_atomic_fetch_add(p, v, __ATOMIC_RELAXED, __HIP_MEMORY_SCOPE_AGENT); }
__device__ __forceinline__ unsigned xb_xcc_id() { return (unsigned)__builtin_amdgcn_s_getreg((3 << 11) | 20) & 0xFu; }
#define XB_SPIN(cond, bar) do { unsigned _sp = 0; while (cond) { __builtin_amdgcn_s_sleep(1); \
    if ((++_sp & 255u) == 0u) { if (xb_ld(&(bar)[XB_TMO])) break; if (_sp > XB_SPIN_CAP) { atomicAdd(&(bar)[XB_TMO], 1u); break; } } } } while (0)
struct XcdBarrier { unsigned* bar; unsigned x; volatile LAS unsigned* st; };
__device__ __forceinline__ XcdBarrier xcd_barrier_post(unsigned* bar, volatile LAS unsigned* st, bool t0) {
    XcdBarrier b; b.bar = bar; b.x = xb_xcc_id(); b.st = st;
    if (t0) (void)xb_add(&bar[XB_XCNT(b.x)], 1u);
    return b;
}
__device__ __forceinline__ void xcd_barrier_complete(unsigned* bar, unsigned x, unsigned& nloc, unsigned& nx) {
    const unsigned G = gridDim.x * gridDim.y * gridDim.z;
    unsigned sum, cnt, mine, sp = 0u;
    for (;;) {
        sum = 0u; cnt = 0u; mine = 0u;
#pragma unroll
        for (unsigned j = 0; j < 16; ++j) { const unsigned c = xb_ld(&bar[XB_XCNT(j)]); sum += c; cnt += (c > 0u) ? 1u : 0u; mine = (j == x) ? c : mine; }
        if (sum == G) break;
        __builtin_amdgcn_s_sleep(1);
        if ((++sp & 255u) == 0u) { if (xb_ld(&bar[XB_TMO])) break; if (sp > XB_SPIN_CAP) { atomicAdd(&bar[XB_TMO], 1u); break; } }
    }
    nloc = mine > 0u ? mine : 1u; nx = cnt > 0u ? cnt : 1u;
}
__device__ __forceinline__ void xcd_barrier(const XcdBarrier& b, bool t0) {
    asm volatile("s_waitcnt vmcnt(0)" ::: "memory");
    __syncthreads();
    if (t0) {
        unsigned* bar = b.bar;
        __builtin_amdgcn_s_waitcnt(0);
        unsigned nloc = b.st[0], nx = b.st[1];
        if (nloc == 0u) { xcd_barrier_complete(bar, b.x, nloc, nx); b.st[0] = nloc; b.st[1] = nx; }
        const unsigned old = xb_add(&bar[XB_XSUB(b.x)], 1u);
        const unsigned gen = old / nloc;
        if (old + 1u == (gen + 1u) * nloc) {
            __builtin_amdgcn_fence(__ATOMIC_RELEASE, "agent");
            asm volatile("s_waitcnt vmcnt(0)" ::: "memory");
            const unsigned og = xb_add(&bar[XB_TOP], 1u);
            const unsigned tg = og / nx;
            if (og + 1u == (tg + 1u) * nx) xb_add(&bar[XB_TOPGEN], 1u);
            else XB_SPIN(xb_ld(&bar[XB_TOPGEN]) == tg, bar);
            __builtin_amdgcn_fence(__ATOMIC_ACQUIRE, "agent");
            xb_add(&bar[XB_XGEN(b.x)], 1u);
            asm volatile("s_waitcnt vmcnt(0)" ::: "memory");
        } else {
            XB_SPIN(xb_ld(&bar[XB_XGEN(b.x)]) == gen, bar);
            __builtin_amdgcn_fence(__ATOMIC_ACQUIRE, "agent");
            asm volatile("s_waitcnt vmcnt(0)" ::: "memory");
        }
    }
    __syncthreads();
}

__global__ void __launch_bounds__(512, 2) mk_fwd(Args a) {
    extern __shared__ __attribute__((aligned(16))) unsigned char lds[];
    cg::grid_group grid = cg::this_grid();
    LAS unsigned char* L = (LAS unsigned char*)lds;
    const int G = gridDim.x, bid = blockIdx.x, NGW = G * 8;
    volatile LAS unsigned* MISC = (volatile LAS unsigned*)(L + RING_BYTES + 8192);
    const int wave_s = __builtin_amdgcn_readfirstlane(threadIdx.x >> 6);
    if (wave_s == 0 && lane_id_() < 4) MISC[lane_id_()] = 0u;
    __syncthreads();
    { KAP_T kap0 = (KAP_T)__builtin_amdgcn_kernarg_segment_ptr(); (void)xcd_barrier_post((unsigned*)(kap0->ws + WS_BAR), MISC, wave_s == 0 && lane_id_() == 0); }
#define XSYNC() do { KAP_T kap_ = (KAP_T)__builtin_amdgcn_kernarg_segment_ptr(); LAUNDER_S(kap_); XcdBarrier xb_; xb_.bar = (unsigned*)(kap_->ws + WS_BAR); xb_.x = xb_xcc_id(); xb_.st = (volatile LAS unsigned*)(L + RING_BYTES + 8192); xcd_barrier(xb_, wave_s == 0 && lane_id_() == 0); } while (0)
#define GRID_SYNC() do { asm volatile("s_waitcnt vmcnt(0) lgkmcnt(0)" ::: "memory"); __syncthreads(); grid.sync(); \
    __builtin_amdgcn_fence(__ATOMIC_ACQUIRE, "agent"); asm volatile("s_waitcnt vmcnt(0)" ::: "memory"); __syncthreads(); } while (0)
#ifndef DBG_STOP
#define DBG_STOP 0
#endif
#define DBG_DUMP(k, EXPR) do { if (DBG_STOP == (k)) { PHASE_BEGIN(); for (int m = gw; m < SEQ; m += NGW) for (int c = lane; c < DM; c += 64) out[(size_t)m * DM + c] = (EXPR); return; } } while (0)
#define PHASE_BEGIN() KAP_T kap = (KAP_T)__builtin_amdgcn_kernarg_segment_ptr(); LAUNDER_S(kap); unsigned char* ws = kap->ws; LAUNDER_S(ws); int tid_ = wave_s * 64 + lane_id_(); LAUNDER_V(tid_); const int tid = tid_, lane = tid & 63, wave = __builtin_amdgcn_readfirstlane(tid >> 6), gw = bid * 8 + wave; \
    u64* ssq = (u64*)(ws + WS_SSQ); (void)lane; (void)gw; (void)ssq; \
    u64* ssq_x = ssq + (size_t)l * SEQ; u64* ssq_xn = ssq + (size_t)(l + 1) * SEQ; u64* ssq_cq = ssq + (size_t)(3 + l) * SEQ; u64* ssq_ckv = ssq + (size_t)(5 + l) * SEQ; u64* ssq_x1 = ssq + (size_t)(7 + l) * SEQ; u64* ssq_a = ssq + (size_t)(9 + l) * SEQ; (void)ssq_a; \
    (void)ssq_x; (void)ssq_xn; (void)ssq_cq; (void)ssq_ckv; (void)ssq_x1; \
    bf16_t* Win = (bf16_t*)(ws + WS_WIN); bf16_t* Wuq = (bf16_t*)(ws + WS_WUQ); bf16_t* Wukv = (bf16_t*)(ws + WS_WUKV); \
    bf16_t* Wout = (bf16_t*)(ws + WS_WOUT); bf16_t* Wup = (bf16_t*)(ws + WS_WUP); bf16_t* Wdn = (bf16_t*)(ws + WS_WDN); \
    bf16_t* XB = (bf16_t*)(ws + WS_XB); bf16_t* Z = (bf16_t*)(ws + WS_Z); bf16_t* Qb = (bf16_t*)(ws + WS_Q); bf16_t* Kb = (bf16_t*)(ws + WS_K); bf16_t* Vt = (bf16_t*)(ws + WS_VT); \
    bf16_t* ST = (bf16_t*)(ws + WS_ST); float* DEC = (float*)(ws + WS_DEC); bf16_t* MIX = (bf16_t*)(ws + WS_MIX); \
    bf16_t* ACT = (bf16_t*)(ws + WS_ACT); float* EDGE = (float*)(ws + WS_EDGE); \
    const float* xin = kap->in[0]; float* out = kap->out; \
    (void)Win; (void)Wuq; (void)Wukv; (void)Wout; (void)Wup; (void)Wdn; (void)XB; (void)Z; (void)Qb; (void)Kb; (void)Vt; (void)ST; (void)DEC; (void)MIX; (void)EDGE; (void)ACT; (void)xin; (void)out;

    for (int l = 0; l < NLAYER; ++l) {
        {
            PHASE_BEGIN();
            LAS float* scr = (LAS float*)(L + wave * 16384);
            const float* w_in = kap->in[3] + (size_t)l * DM * IN_DIM; const float* w_uq = kap->in[5] + (size_t)l * QLORA * QW; const float* w_ukv = kap->in[7] + (size_t)l * KVLORA * KVW;
            const float* w_out = kap->in[14] + (size_t)l * DM * DM; const float* w_up = kap->in[16] + (size_t)l * DM * DFF2; const float* w_dn = kap->in[19] + (size_t)l * DFF * DM;
            const float* g_attn = kap->in[2] + l * DM; const float* g_cq = kap->in[4] + l * QLORA; const float* g_ckv = kap->in[6] + l * KVLORA; const float* g_mla = kap->in[13] + l * 1024; const float* g_ffn = kap->in[15] + l * DM;
            constexpr int I_IN = (DM / 64) * (IN_PAD / 32), I_UQ = (QLORA / 64) * (QW / 32), I_UKV = (KVLORA / 64) * (KVW / 32), I_OUT = (DM / 64) * (DM / 32), I_UP = (DM / 64) * (DFF2 / 32), I_DN = (DFF / 64) * (DM / 32);
            constexpr int NITEMS = I_IN + I_UQ + I_UKV + I_OUT + I_UP + I_DN;
            for (int it = gw; it < NITEMS; it += NGW) {
                int r = it;
                if (r < I_IN) { wt_item(w_in, DM, IN_DIM, g_attn, DM, Win, scr, r, IN_PAD / 32, lane); continue; } r -= I_IN;
                if (r < I_UQ) { wt_item(w_uq, QLORA, QW, g_cq, QLORA, Wuq, scr, r, QW / 32, lane); continue; } r -= I_UQ;
                if (r < I_UKV) { wt_item(w_ukv, KVLORA, KVW, g_ckv, KVLORA, Wukv, scr, r, KVW / 32, lane); continue; } r -= I_UKV;
                if (r < I_OUT) { wt_item(w_out, DM, DM, g_mla, 1024, Wout, scr, r, DM / 32, lane); continue; } r -= I_OUT;
                if (r < I_UP) { wt_item(w_up, DM, DFF2, g_ffn, DM, Wup, scr, r, DFF2 / 32, lane, true); continue; } r -= I_UP;
                wt_item(w_dn, DFF, DM, g_ffn, 0, Wdn, scr, r, DM / 32, lane);
            }
            if (l == 0) {
                for (int m = gw; m < SEQ; m += NGW) {
                    GAS const f32x4* xr = (GAS const f32x4*)(G_(xin) + (size_t)m * DM) + lane; float s = 0.f;
                    GAS u32x2* o8 = (GAS u32x2*)(G_(XB) + (size_t)m * DM) + lane;
#pragma unroll
                    for (int j = 0; j < 8; ++j) { const f32x4 v = xr[64 * j]; s += (v[0] * v[0] + v[1] * v[1]) + (v[2] * v[2] + v[3] * v[3]); o8[64 * j] = (u32x2){pk2(v[0], v[1]), pk2(v[2], v[3])}; }
                    s = wave_sum(s); if (lane == 0) G_(ssq_x)[m] = (u64)(s * SSQ_FX + 0.5f);
                }
            }
        }
        if (l == 0) GRID_SYNC(); else XSYNC();
        {
            PHASE_BEGIN();
            pg8::Gemm g{XB, Win, SEQ, IN_PAD, DM, DM, nullptr, 0.f}; pg8::StaticOrder S; S.init(SEQ, IN_PAD, G, bid);
            pg8::EpiRowScale E{Z, IN_PAD, ssq_x, 1.0f / DM, ssq_cq, 0, 2, ssq_ckv, 2, 3};
            pg8::gemm_phase<pg8::EpiRowScale>(L, g, S, E, wave_s);
        }
        XSYNC();
        DBG_DUMP(1, bf2f(Z[(size_t)m * IN_PAD + c]) + bf2f(Z[(size_t)m * IN_PAD + 2048 + c]));
        {
            PHASE_BEGIN();
            { pg8::Gemm g{Z + C_CQ, Wuq, SEQ, QW, QLORA, IN_PAD, nullptr, 0.f}; pg8::StaticOrder S; S.init(SEQ, QW, G, bid);
              pg8::EpiRowScale E{Qb, QW, ssq_cq, 1.0f / QLORA, nullptr, 0, 0, nullptr, 0, 0};
              pg8::gemm_phase<pg8::EpiRowScale>(L, g, S, E, wave_s); }
            { pg8::Gemm g{Z + C_CKV, Wukv, SEQ, KVW, KVLORA, IN_PAD, nullptr, 0.f}; pg8::StaticOrder S; S.init(SEQ, KVW, G, bid);
              pg8::EpiUkv E{Kb, Vt, ssq_ckv, 1.0f / KVLORA};
              pg8::gemm_phase<pg8::EpiUkv>(L, g, S, E, wave_s); }
            const float* wgate = kap->in[10] + (size_t)l * 16 * (GH * GDK); const float* bgate = kap->in[11] + (size_t)l * (GH * GDK);
            for (int u = bid; u < NCHUNK * GH; u += G) gla_chunk_unit(L, Z, wgate, bgate, ST, DEC, u >> 2, u & 3, wave_s);
        }
        XSYNC();
        DBG_DUMP(2, (c < QW ? bf2f(Qb[(size_t)m * QW + c]) + bf2f(Kb[(size_t)m * QW + c]) : bf2f(Vt[(size_t)(c - QW) * SEQ + m])) + bf2f(ST[(size_t)m * 8192 + c]) + bf2f(ST[(size_t)m * 8192 + 4096 + c]));
        {
            PHASE_BEGIN();
            const int* pos = (const int*)kap->in[1];
            const float* qn = kap->in[8] + l * QKD; const float* kn = kap->in[9] + l * QKD;
            const float qscale = 0.07216878364870322f * 1.4426950408889634f;
            for (int m = gw; m < SEQ; m += NGW) {
                const int i = lane & 31;
                const float ang = (float)G_(pos)[m] * kap->inv_freq[i];
                double rev = (double)ang * 0.15915494309189535; rev -= __builtin_rint(rev);
                const float sn = __builtin_amdgcn_sinf((float)rev), cs = __builtin_amdgcn_cosf((float)rev);
                const float krv = bf2f(G_(Z)[(size_t)m * IN_PAD + C_KR + lane]);
                GAS bf16_t* qp = G_(Qb) + (size_t)m * QW; GAS bf16_t* kp = G_(Kb) + (size_t)m * QW;
                float qa[NH][3], ka[NH][2], qs[NH], ks[NH];
#pragma unroll
                for (int h = 0; h < NH; ++h) { qa[h][0] = bf2f(qp[h * QKD + lane]); qa[h][1] = bf2f(qp[h * QKD + 64 + lane]); qa[h][2] = bf2f(qp[h * QKD + 128 + lane]);
                                               ka[h][0] = bf2f(kp[h * QKD + lane]); ka[h][1] = bf2f(kp[h * QKD + 64 + lane]); }
#pragma unroll
                for (int h = 0; h < NH; ++h) { qs[h] = qa[h][0] * qa[h][0] + qa[h][1] * qa[h][1] + qa[h][2] * qa[h][2]; ks[h] = ka[h][0] * ka[h][0] + ka[h][1] * ka[h][1] + krv * krv; }
#pragma unroll
                for (int o = 1; o < 64; o <<= 1)
#pragma unroll
                    for (int h = 0; h < NH; ++h) { qs[h] += __shfl_xor(qs[h], o); ks[h] += __shfl_xor(ks[h], o); }
                const float qg0 = G_(qn)[lane], qg1 = G_(qn)[64 + lane], qg2 = G_(qn)[128 + lane], kg0 = G_(kn)[lane], kg1 = G_(kn)[64 + lane], kg2 = G_(kn)[128 + lane];
#pragma unroll
                for (int h = 0; h < NH; ++h) {
                    { const float rstd = rsqrtf(qs[h] * (1.0f / QKD) + EPS);
                      const float n2 = qa[h][2] * rstd * qg2, pr = __shfl_xor(n2, 32);
                      const float r2 = (lane < 32) ? n2 * cs - pr * sn : n2 * cs + pr * sn;
                      qp[h * QKD + lane] = (bf16_t)f2bf(qa[h][0] * rstd * qg0 * qscale); qp[h * QKD + 64 + lane] = (bf16_t)f2bf(qa[h][1] * rstd * qg1 * qscale); qp[h * QKD + 128 + lane] = (bf16_t)f2bf(r2 * qscale); }
                    { const float rstd = rsqrtf(ks[h] * (1.0f / QKD) + EPS);
                      const float n2 = krv * rstd * kg2, pr = __shfl_xor(n2, 32);
                      const float r2 = (lane < 32) ? n2 * cs - pr * sn : n2 * cs + pr * sn;
                      kp[h * QKD + lane] = (bf16_t)f2bf(ka[h][0] * rstd * kg0); kp[h * QKD + 64 + lane] = (bf16_t)f2bf(ka[h][1] * rstd * kg1); kp[h * QKD + 128 + lane] = (bf16_t)f2bf(r2); }
                }
            }
            constexpr int NE = GH * GDV * GDK;
            for (int e = bid * 512 + tid; e < NE; e += G * 512) {
                const int hd = (e >> 15) * GDK + (e & 127);
                float s = 0.f;
                for (int c0 = 0; c0 < NCHUNK; c0 += 8) {
                    float uu[8], dd[8];
#pragma unroll
                    for (int i = 0; i < 8; ++i) { uu[i] = bf2f(G_(ST)[(size_t)(c0 + i) * NE + e]); dd[i] = G_(DEC)[(size_t)(c0 + i) * (GH * GDK) + hd]; }
#pragma unroll
                    for (int i = 0; i < 8; ++i) { s = s * dd[i] + uu[i]; G_(ST)[(size_t)(c0 + i) * NE + e] = (bf16_t)f2bf(s); }
                }
            }
        }
        XSYNC();
        DBG_DUMP(3, (c < QW ? bf2f(Qb[(size_t)m * QW + c]) + bf2f(Kb[(size_t)m * QW + c]) : 0.f) + bf2f(ST[(size_t)m * 8192 + c]) + bf2f(ST[(size_t)m * 8192 + 4096 + c]));
        {
            PHASE_BEGIN();
            for (int p = bid; p < 256; p += G) {
                const int h = p & 7, s = p >> 3;
                attn_unit(L, Qb, Kb, Vt, MIX, ssq_a, h, 63 - s, wave_s);
                attn_unit(L, Qb, Kb, Vt, MIX, ssq_a, h, s, wave_s);
            }
            const float* gnorm = kap->in[12] + l * GDV;
            for (int u = bid; u < NCHUNK * GH; u += G) gla_out_unit(L, Z, ST, gnorm, MIX, u >> 2, u & 3, wave_s);
        }
        XSYNC();
        DBG_DUMP(4, bf2f(MIX[(size_t)m * DM + c]));
        DBG_DUMP(5, bf2f(MIX[(size_t)m * DM + c]));
        {
            PHASE_BEGIN();
            pg8::Gemm g{MIX, Wout, SEQ, DM, DM, DM, ssq_a, 1.0f / 1024.0f}; pg8::StaticOrder S; S.init(SEQ, DM, G, bid);
            pg8::EpiRes E{l == 0 ? xin : out, out, XB, ssq_x1};
            pg8::gemm_phase<pg8::EpiRes, true>(L, g, S, E, wave_s);
        }
        XSYNC();
        DBG_DUMP(6, out[(size_t)m * DM + c] + bf2f(XB[(size_t)m * DM + c]));
        {
            PHASE_BEGIN();
            const float* cw = kap->in[17] + (size_t)l * 3 * DFF2; const float* cb = kap->in[18] + (size_t)l * DFF2;
            pg8::Gemm g{XB, Wup, SEQ, DFF2, DM, DM, nullptr, 0.f}; pg8::StaticOrder S; S.init(SEQ, DFF2, G, bid);
            pg8::EpiUpConv E{ACT, EDGE, ssq_x1, cw, cb, (LAS float*)(L + RING_BYTES)};
            pg8::gemm_phase<pg8::EpiUpConv>(L, g, S, E, wave_s);
        }
        XSYNC();
        {
            PHASE_BEGIN();
            const float* cw = kap->in[17] + (size_t)l * 3 * DFF2; const float* cb = kap->in[18] + (size_t)l * DFF2;
            for (int idx = bid * 512 + tid; idx < 63 * DFF; idx += G * 512) {
                const int pm = 1 + idx / DFF, gcol = idx % DFF;
                float y0[2], y1[2];
#pragma unroll
                for (int q = 0; q < 2; ++q) { const int c = q * DFF + gcol;
                    const float um2 = G_(EDGE)[(size_t)((pm - 1) * 4 + 2) * DFF2 + c], um1 = G_(EDGE)[(size_t)((pm - 1) * 4 + 3) * DFF2 + c], u0 = G_(EDGE)[(size_t)(pm * 4 + 0) * DFF2 + c], u1 = G_(EDGE)[(size_t)(pm * 4 + 1) * DFF2 + c];
                    const float w0 = G_(cw)[c], w1 = G_(cw)[DFF2 + c], w2 = G_(cw)[2 * DFF2 + c], bb = G_(cb)[c];
                    y0[q] = bb + w0 * um2 + w1 * um1 + w2 * u0; y1[q] = bb + w0 * um1 + w1 * u0 + w2 * u1; }
                G_(ACT)[(size_t)(pm * 256) * DFF + gcol] = (bf16_t)f2bf(silu_f(y0[0]) * y0[1]);
                G_(ACT)[(size_t)(pm * 256 + 1) * DFF + gcol] = (bf16_t)f2bf(silu_f(y1[0]) * y1[1]);
            }
        }
        XSYNC();
        DBG_DUMP(8, bf2f(ACT[(size_t)m * DFF + c]) + bf2f(ACT[(size_t)m * DFF + 3000 + c]));
        {
            PHASE_BEGIN();
            pg8::Gemm g{ACT, Wdn, SEQ, DM, DFF, DFF, nullptr, 0.f}; pg8::StaticOrder S; S.init(SEQ, DM, G, bid);
            pg8::EpiRes E{out, out, XB, ssq_xn};
            pg8::gemm_phase<pg8::EpiRes>(L, g, S, E, wave_s);
        }
        XSYNC();
        if (DBG_STOP == 9) return;
    }
}

extern "C" void kernel_launch(void* const* d_in, const int* in_sizes, int n_in, void* d_out, int out_size, void* d_ws, size_t ws_size, hipStream_t stream) {
    static int grid = 0;
    if (grid == 0) {
        if (n_in != 20 || out_size != SEQ * DM || ws_size < WS_END) { fprintf(stderr, "kernel_launch: unexpected shapes: n_in %d out %d ws %zu (need %zu)\n", n_in, out_size, ws_size, (size_t)WS_END); grid = -1; return; }
        int dev = 0, cus = 0, per_cu = 0;
        hipGetDevice(&dev); hipDeviceGetAttribute(&cus, hipDeviceAttributeMultiprocessorCount, dev);
        hipFuncSetAttribute((const void*)mk_fwd, hipFuncAttributeMaxDynamicSharedMemorySize, LDS_BYTES);
        hipOccupancyMaxActiveBlocksPerMultiprocessor(&per_cu, (const void*)mk_fwd, 512, LDS_BYTES);
        (void)hipGetLastError();
        if (per_cu < 1) per_cu = 1;
        grid = cus * 1;
    }
    if (grid < 0) return;
    hipMemsetAsync((char*)d_ws + WS_CTL, 0, CTL_BYTES, stream);
    Args a{};
    for (int i = 0; i < 20; ++i) a.in[i] = (const float*)d_in[i];
    a.out = (float*)d_out; a.ws = (unsigned char*)d_ws;
    for (int i = 0; i < 32; ++i) a.inv_freq[i] = (float)pow(10000.0, -(double)i / 32.0);
    void* args[] = {&a};
    hipError_t e = hipLaunchCooperativeKernel((const void*)mk_fwd, dim3(grid), dim3(512), args, LDS_BYTES, stream);
    if (e != hipSuccess) fprintf(stderr, "cooperative launch failed: %s (grid %d)\n", hipGetErrorString(e), grid);
}
```

```cpp
#include <hip/hip_runtime.h>
#include <hip/hip_cooperative_groups.h>
#include <cstdio>
#include <cstdint>
#include <cmath>
namespace cg = cooperative_groups;

#define LAS __attribute__((address_space(3)))
typedef unsigned short bf16_t;
typedef unsigned long long u64;
typedef short bf16x8 __attribute__((ext_vector_type(8)));
typedef short s16x4 __attribute__((ext_vector_type(4)));
typedef float f32x4 __attribute__((ext_vector_type(4)));
typedef float f32x16 __attribute__((ext_vector_type(16)));
typedef unsigned u32x4 __attribute__((ext_vector_type(4)));
typedef unsigned u32x2 __attribute__((ext_vector_type(2)));
typedef float f32x2_t __attribute__((ext_vector_type(2)));
typedef __bf16 bf16x2_t __attribute__((ext_vector_type(2)));

constexpr int SEQ = 16384, DM = 2048, NLAYER = 2;
constexpr int IN_DIM = 3920, IN_PAD = 4096;
constexpr int C_CQ = 0, C_CKV = 512, C_KR = 768, C_GQ = 832, C_GK = 1344, C_GV = 1856, C_GA = 2880, C_GG = 2896;
constexpr int QLORA = 512, KVLORA = 256, NH = 8, QKD = 192, NOPE = 128, VD = 128, QW = NH * QKD  , KVW = NH * 256  ;
constexpr int GH = 4, GDK = 128, GDV = 256, NCHUNK = SEQ / 64;
constexpr int DFF = 5632, DFF2 = 11264;
constexpr float EPS = 1e-6f;

constexpr size_t MiB = 1u << 20;
constexpr size_t WS_CTL = 0, CTL_BYTES = 2 * MiB;
constexpr size_t WS_BAR = 0;
constexpr size_t WS_SSQ = 65536;
constexpr size_t WS_WIN = 2 * MiB, WS_WUQ = 18 * MiB, WS_WUKV = WS_WUQ + 3 * MiB / 2, WS_WOUT = WS_WUKV + 1 * MiB, WS_WUP = WS_WOUT + 8 * MiB, WS_WDN = WS_WUP + 44 * MiB;
constexpr size_t WS_XB = 95 * MiB;
constexpr size_t WS_R = 159 * MiB;
constexpr size_t WS_Z = WS_R, WS_Q = WS_Z + 128 * MiB, WS_K = WS_Q + 48 * MiB, WS_VT = WS_K + 48 * MiB, WS_ST = WS_VT + 32 * MiB, WS_DEC = WS_ST + 128 * MiB, WS_MIX = WS_DEC + 1 * MiB;
constexpr size_t WS_ACT = WS_R, WS_EDGE = WS_ACT + 176 * MiB, WS_END = WS_MIX + 64 * MiB;
static_assert(WS_EDGE + 12 * MiB <= WS_END, "ws map");

#define GAS __attribute__((address_space(1)))
template <class T> __device__ __forceinline__ GAS T* G_(T* p) { return (GAS T*)p; }
__device__ __forceinline__ int lane_id_() { unsigned z = 0u; asm volatile("" : "+v"(z)); return (int)__builtin_amdgcn_mbcnt_hi(~0u, __builtin_amdgcn_mbcnt_lo(~0u, z)); }
#define LAUNDER_V(x) asm volatile("" : "+v"(x))
#define LAUNDER_S(x) asm volatile("" : "+s"(x))
__device__ __forceinline__ unsigned f2bf(float f) { unsigned u = __builtin_bit_cast(unsigned, f); return (u + 0x7fffu + ((u >> 16) & 1u)) >> 16; }
__device__ __forceinline__ unsigned pk2(float lo, float hi) { f32x2_t v = {lo, hi}; bf16x2_t b = __builtin_convertvector(v, bf16x2_t); return __builtin_bit_cast(unsigned, b); }
__device__ __forceinline__ float bf2f(unsigned b) { return __builtin_bit_cast(float, b << 16); }
__device__ __forceinline__ float bflo(unsigned w) { return __builtin_bit_cast(float, w << 16); }
__device__ __forceinline__ float bfhi(unsigned w) { return __builtin_bit_cast(float, w & 0xffff0000u); }
__device__ __forceinline__ float wave_sum(float v) {
#pragma unroll
    for (int o = 1; o < 64; o <<= 1) v += __shfl_xor(v, o);
    return v;
}
constexpr float SSQ_FX = 1048576.0f, SSQ_INV = 1.0f / 1048576.0f;
__device__ __forceinline__ void ssq_add(u64* p, float v) { __hip_atomic_fetch_add((GAS u64*)p, (u64)(v * SSQ_FX + 0.5f), __ATOMIC_RELAXED, __HIP_MEMORY_SCOPE_AGENT); }
__device__ __forceinline__ float ssq_get(const u64* p) { return (float)(*(GAS const u64*)p) * SSQ_INV; }
__device__ __forceinline__ float silu_f(float x) { return x * __builtin_amdgcn_rcpf(1.0f + __expf(-x)); }

namespace pg8 {
constexpr int BM = 256, BK = 64, HALF = 128, HTB = HALF * BK * 2, STAGE_BYTES = 8 * HTB, NXCD = 8, WGM = 8;
__host__ __device__ __forceinline__ int lds_byte(int r, int c) { const int st = (r >> 4) * 2 + (c >> 5), rr = r & 15, cc = c & 31, ob = rr * 64 + cc * 2; return st * 1024 + (ob ^ (((ob >> 9) & 1) << 5)); }
__host__ __device__ __forceinline__ void stage_rc(int b, int& R, int& C) { const int st = b / 1024, sb = b % 1024, swz = sb ^ (((sb >> 9) & 1) << 5); R = (st >> 1) * 16 + swz / 64; C = (st & 1) * 32 + (swz % 64) / 2; }
__host__ __device__ __forceinline__ int perm32(int rho) { const int n = rho >> 4, i = rho & 15; return 8 * (i >> 2) + 4 * n + (i & 3); }

struct Unit { int pm, pn; };
struct Gemm { const bf16_t* A; const bf16_t* Bt; int M, N, K, lda; const u64* mid_ssq; float mid_inv; };

struct StaticOrder {
    int nM, nN, nwg, G, c;
    __device__ void init(int M, int N, int G_, int c_) { nM = M / BM; nN = N / BM; nwg = nM * nN; G = G_; c = c_; }
    __device__ bool next(int i, Unit& u) const {
        const long L = (long)i * G + c; if (L >= nwg) return false;
        int wgid = (int)L; { const int q = nwg / NXCD, r = nwg % NXCD, xcd = wgid % NXCD, off = wgid / NXCD; wgid = (xcd < r ? xcd * (q + 1) : r * (q + 1) + (xcd - r) * q) + off; }
        const int nig = WGM * nN, gid = wgid / nig, fm = gid * WGM, gsz = (nM - fm) < WGM ? (nM - fm) : WGM;
        u.pm = fm + ((wgid % nig) % gsz); u.pn = (wgid % nig) / gsz; return true;
    }
};

struct EpiRowScale {
    static constexpr bool PERM = true;
    bf16_t* O; int ldc; const u64* ssq_in; float inv_dim; u64* ssq_a; int a_lo, a_hi; u64* ssq_b; int b_lo, b_hi;
    __device__ __forceinline__ void operator()(const f32x4 (&acc)[2][2][4][2], const Unit& u, int wr, int wc, int fr, int fq) const {
        const int row0 = u.pm * BM + wr * 64 + fr, col0 = u.pn * BM + wc * 32 + 8 * fq;
        u64* sacc = (u.pn >= a_lo && u.pn < a_hi) ? ssq_a : ((u.pn >= b_lo && u.pn < b_hi) ? ssq_b : nullptr);
        float scv[2][4];
#pragma unroll
        for (int ai = 0; ai < 2; ++ai)
#pragma unroll
            for (int m = 0; m < 4; ++m) scv[ai][m] = ssq_in ? ssq_get(ssq_in + row0 + ai * HALF + m * 16) : 0.f;
        asm volatile("" ::: "memory");
#pragma unroll
        for (int ai = 0; ai < 2; ++ai)
#pragma unroll
            for (int m = 0; m < 4; ++m) {
                const int row = row0 + ai * HALF + m * 16;
                const float sc = ssq_in ? rsqrtf(scv[ai][m] * inv_dim + EPS) : 1.0f;
                float ss = 0.f;
#pragma unroll
                for (int bj = 0; bj < 2; ++bj) {
                    const f32x4 v0 = acc[ai][bj][m][0] * sc, v1 = acc[ai][bj][m][1] * sc;
                    ss += (v0[0] * v0[0] + v0[1] * v0[1]) + (v0[2] * v0[2] + v0[3] * v0[3]) + (v1[0] * v1[0] + v1[1] * v1[1]) + (v1[2] * v1[2] + v1[3] * v1[3]);
                    u32x4 w; w.x = pk2(v0[0], v0[1]); w.y = pk2(v0[2], v0[3]); w.z = pk2(v1[0], v1[1]); w.w = pk2(v1[2], v1[3]);
                    *(GAS u32x4*)(G_(O) + (size_t)row * ldc + col0 + bj * HALF) = w;
                }
                if (sacc) { ss += __shfl_xor(ss, 16); ss += __shfl_xor(ss, 32); if (fq == 0) ssq_add(sacc + row, ss); }
            }
    }
};
struct EpiUkv {
    static constexpr bool PERM = true;
    bf16_t* Kb; bf16_t* Vt; const u64* ssq_in; float inv_dim;
    __device__ __forceinline__ void operator()(const f32x4 (&acc)[2][2][4][2], const Unit& u, int wr, int wc, int fr, int fq) const {
        const int row0 = u.pm * BM + wr * 64 + fr, c0 = wc * 32 + 8 * fq;
        float scv[2][4];
#pragma unroll
        for (int ai = 0; ai < 2; ++ai)
#pragma unroll
            for (int m = 0; m < 4; ++m) scv[ai][m] = ssq_get(ssq_in + row0 + ai * HALF + m * 16);
        asm volatile("" ::: "memory");
#pragma unroll
        for (int ai = 0; ai < 2; ++ai)
#pragma unroll
            for (int m = 0; m < 4; ++m) {
                const int row = row0 + ai * HALF + m * 16;
                const int prow = (row & ~15) | (row & 3) | ((row & 4) << 1) | ((row & 8) >> 1);
                const float sc = rsqrtf(scv[ai][m] * inv_dim + EPS);
                { const f32x4 v0 = acc[ai][0][m][0] * sc, v1 = acc[ai][0][m][1] * sc;
                  u32x4 w; w.x = pk2(v0[0], v0[1]); w.y = pk2(v0[2], v0[3]); w.z = pk2(v1[0], v1[1]); w.w = pk2(v1[2], v1[3]);
                  *(GAS u32x4*)(G_(Kb) + (size_t)row * QW + u.pn * QKD + c0) = w; }
#pragma unroll
                for (int n = 0; n < 2; ++n)
#pragma unroll
                    for (int j = 0; j < 4; ++j) G_(Vt)[(size_t)(u.pn * VD + c0 + 4 * n + j) * SEQ + prow] = (bf16_t)f2bf(acc[ai][1][m][n][j] * sc);
            }
    }
};
struct EpiRes {
    static constexpr bool PERM = true;
    const float* base; float* out; bf16_t* xb; u64* ssq_out;
    __device__ __forceinline__ void operator()(const f32x4 (&acc)[2][2][4][2], const Unit& u, int wr, int wc, int fr, int fq) const {
        const int row0 = u.pm * BM + wr * 64 + fr, col0 = u.pn * BM + wc * 32 + 8 * fq;
#pragma unroll
        for (int ai = 0; ai < 2; ++ai) {
            f32x4 bv[4][2][2];
#pragma unroll
            for (int m = 0; m < 4; ++m)
#pragma unroll
                for (int bj = 0; bj < 2; ++bj) { const size_t off = (size_t)(row0 + ai * HALF + m * 16) * DM + col0 + bj * HALF;
                    bv[m][bj][0] = *(GAS const f32x4*)(G_(base) + off); bv[m][bj][1] = *(GAS const f32x4*)(G_(base) + off + 4); }
            asm volatile("" ::: "memory");
#pragma unroll
            for (int m = 0; m < 4; ++m) {
                const int row = row0 + ai * HALF + m * 16; float ss = 0.f;
#pragma unroll
                for (int bj = 0; bj < 2; ++bj) {
                    const size_t off = (size_t)row * DM + col0 + bj * HALF;
                    const f32x4 v0 = acc[ai][bj][m][0] + bv[m][bj][0], v1 = acc[ai][bj][m][1] + bv[m][bj][1];
                    ss += (v0[0] * v0[0] + v0[1] * v0[1]) + (v0[2] * v0[2] + v0[3] * v0[3]) + (v1[0] * v1[0] + v1[1] * v1[1]) + (v1[2] * v1[2] + v1[3] * v1[3]);
                    *(GAS f32x4*)(G_(out) + off) = v0; *(GAS f32x4*)(G_(out) + off + 4) = v1;
                    u32x4 w; w.x = pk2(v0[0], v0[1]); w.y = pk2(v0[2], v0[3]); w.z = pk2(v1[0], v1[1]); w.w = pk2(v1[2], v1[3]);
                    *(GAS u32x4*)(G_(xb) + off) = w;
                }
                ss += __shfl_xor(ss, 16); ss += __shfl_xor(ss, 32); if (fq == 0) ssq_add(ssq_out + row, ss);
            }
        }
    }
};


#define DPP_SHR1(old, src) __builtin_bit_cast(float, __builtin_amdgcn_update_dpp(__builtin_bit_cast(int, (float)(old)), __builtin_bit_cast(int, (float)(src)), 0x111, 0xf, 0xf, false))
#define DPP_SHR2(old, src) __builtin_bit_cast(float, __builtin_amdgcn_update_dpp(__builtin_bit_cast(int, (float)(old)), __builtin_bit_cast(int, (float)(src)), 0x112, 0xf, 0xf, false))
#define DPP_ROR1(src) __builtin_bit_cast(float, __builtin_amdgcn_update_dpp(0, __builtin_bit_cast(int, (float)(src)), 0x121, 0xf, 0xf, false))
#define DPP_ROR2(src) __builtin_bit_cast(float, __builtin_amdgcn_update_dpp(0, __builtin_bit_cast(int, (float)(src)), 0x122, 0xf, 0xf, false))
struct EpiUpConv {
    static constexpr bool PERM = true;
    bf16_t* ACT; float* EDGE; const u64* ssq_in; const float* cw; const float* cb; LAS float* halo;
    __device__ __forceinline__ void operator()(f32x4 (&acc)[2][2][4][2], const Unit& u, int wr, int wc, int fr, int fq) const {
        const int row0 = u.pm * BM + wr * 64 + fr;
        const int g0 = u.pn * 128 + wc * 32 + 8 * fq;
#pragma unroll
        for (int ai = 0; ai < 2; ++ai)
#pragma unroll
            for (int m = 0; m < 4; ++m) {
                const float sc = rsqrtf(ssq_get(ssq_in + row0 + ai * HALF + m * 16) * (1.0f / DM) + EPS);
#pragma unroll
                for (int bj = 0; bj < 2; ++bj)
#pragma unroll
                    for (int n = 0; n < 2; ++n) acc[ai][bj][m][n] = acc[ai][bj][m][n] * sc;
            }
        if (fr >= 14) {
#pragma unroll
            for (int ai = 0; ai < 2; ++ai) { LAS float* hp = halo + ((((2 * ai + wr) * 4 + wc) * 2 + (fr - 14)) * 4 + fq) * 16;
#pragma unroll
                for (int bj = 0; bj < 2; ++bj)
#pragma unroll
                    for (int n = 0; n < 2; ++n) *(LAS f32x4*)(hp + bj * 8 + n * 4) = acc[ai][bj][3][n]; }
            if (wr == 1) { GAS float* ep = G_(EDGE) + (size_t)(u.pm * 4 + 2 + fr - 14) * DFF2 + g0;
#pragma unroll
                for (int bj = 0; bj < 2; ++bj)
#pragma unroll
                    for (int n = 0; n < 2; ++n) *(GAS f32x4*)(ep + bj * DFF + 4 * n) = acc[1][bj][3][n]; }
        }
        if (fr < 2 && wr == 0) { GAS float* ep = G_(EDGE) + (size_t)(u.pm * 4 + fr) * DFF2 + g0;
#pragma unroll
            for (int bj = 0; bj < 2; ++bj)
#pragma unroll
                for (int n = 0; n < 2; ++n) *(GAS f32x4*)(ep + bj * DFF + 4 * n) = acc[0][bj][0][n]; }
        asm volatile("s_waitcnt lgkmcnt(0)" ::: "memory"); __builtin_amdgcn_s_barrier(); asm volatile("" ::: "memory");
#pragma unroll
        for (int n = 0; n < 2; ++n) {
            const int gc = g0 + 4 * n;
            GAS const float* cwg = G_(cw); GAS const float* cbg = G_(cb);
            const f32x4 wg0 = *(GAS const f32x4*)(cwg + gc), wg1 = *(GAS const f32x4*)(cwg + DFF2 + gc), wg2 = *(GAS const f32x4*)(cwg + 2 * DFF2 + gc), bgv = *(GAS const f32x4*)(cbg + gc);
            const f32x4 wu0 = *(GAS const f32x4*)(cwg + DFF + gc), wu1 = *(GAS const f32x4*)(cwg + DFF2 + DFF + gc), wu2 = *(GAS const f32x4*)(cwg + 2 * DFF2 + DFF + gc), buv = *(GAS const f32x4*)(cbg + DFF + gc);
#pragma unroll
            for (int ai = 0; ai < 2; ++ai) {
                const int band = 2 * ai + wr;
                f32x4 pg = (f32x4){0.f, 0.f, 0.f, 0.f}, pu = pg;
                if (band > 0) { const LAS float* hp = halo + ((((band - 1) * 4 + wc) * 2 + (fr & 1)) * 4 + fq) * 16; pg = *(const LAS f32x4*)(hp + n * 4); pu = *(const LAS f32x4*)(hp + 8 + n * 4); }
#pragma unroll
                for (int m = 0; m < 4; ++m) {
                    const f32x4 cg = acc[ai][0][m][n], cu = acc[ai][1][m][n];
                    float av[4];
#pragma unroll
                    for (int j = 0; j < 4; ++j) {
                        const float g1 = DPP_SHR1(DPP_ROR1(pg[j]), cg[j]), g2 = DPP_SHR2(DPP_ROR2(pg[j]), cg[j]);
                        const float u1 = DPP_SHR1(DPP_ROR1(pu[j]), cu[j]), u2 = DPP_SHR2(DPP_ROR2(pu[j]), cu[j]);
                        const float yg = bgv[j] + wg0[j] * g2 + wg1[j] * g1 + wg2[j] * cg[j];
                        const float yu = buv[j] + wu0[j] * u2 + wu1[j] * u1 + wu2[j] * cu[j];
                        av[j] = silu_f(yg) * yu;
                    }
                    *(GAS u32x2*)(G_(ACT) + (size_t)(row0 + ai * HALF + m * 16) * DFF + gc) = (u32x2){pk2(av[0], av[1]), pk2(av[2], av[3])};
                    pg = cg; pu = cu;
                }
            }
        }
    }
};

template <class Epi, bool MIDSCALE = false>
__device__ __forceinline__ void gemm_phase(LAS unsigned char* lds, const Gemm g, const StaticOrder& S, const Epi& E, int wv) {
    int tid_ = wv * 64 + lane_id_(); LAUNDER_V(tid_);
    const int tid = tid_, wid = __builtin_amdgcn_readfirstlane(tid >> 6), lane = tid & 63, wr = wid >> 2, wc = wid & 3, fr = lane & 15, fq = lane >> 4;
    const int K = g.K, nt = K / BK;
    unsigned voffA[2], voffB[2];
#pragma unroll
    for (int i = 0; i < 2; ++i) { int R, C; stage_rc(tid * 16 + i * 8192, R, C); const int Rb = Epi::PERM ? ((R & ~31) + perm32(R & 31)) : R;
        voffA[i] = (unsigned)(R * g.lda + C) * 2u; voffB[i] = (unsigned)(Rb * K + C) * 2u; }
    const size_t kstep = (size_t)(BK * 2);
    const size_t hstepA = (size_t)HALF * g.lda * 2, hstepB = (size_t)HALF * K * 2;
    const size_t tstepA = 2 * hstepA, tstepB = 2 * hstepB;
    const unsigned ldsw = (unsigned)wid * 1024u;
    const int aoff = lds_byte(wr * 64 + fr, fq * 8), boff = lds_byte(wc * 32 + fr, fq * 8);
#define PG8_SA(b, h) (((b) * 2 + (h)) * HTB)
#define PG8_SB(b, h) ((4 + (b) * 2 + (h)) * HTB)
#define PG8_STAGE(bufoff, gbase, voff) do { _Pragma("unroll") for (int _i = 0; _i < 2; ++_i) \
        __builtin_amdgcn_global_load_lds((const unsigned*)((const char*)(gbase) + (voff)[_i]), (LAS unsigned*)(lds + (bufoff) + ldsw + _i * 8192), 16, 0, 0); } while (0)
#define PG8_LDA(dst, b, h) do { _Pragma("unroll") for (int m = 0; m < 4; ++m) _Pragma("unroll") for (int k = 0; k < 2; ++k) dst[m][k] = *(const LAS bf16x8*)(lds + PG8_SA(b, h) + aoff + m * 2048 + k * 1024); } while (0)
#define PG8_LDB(dst, b, h) do { _Pragma("unroll") for (int n = 0; n < 2; ++n) _Pragma("unroll") for (int k = 0; k < 2; ++k) dst[n][k] = *(const LAS bf16x8*)(lds + PG8_SB(b, h) + boff + n * 2048 + k * 1024); } while (0)
#define PG8_MMA(ai, bj, At, Bt) do { __builtin_amdgcn_s_setprio(1); _Pragma("unroll") for (int m = 0; m < 4; ++m) _Pragma("unroll") for (int n = 0; n < 2; ++n) _Pragma("unroll") for (int k = 0; k < 2; ++k) \
        acc[ai][bj][m][n] = __builtin_amdgcn_mfma_f32_16x16x32_bf16(Bt[n][k], At[m][k], acc[ai][bj][m][n], 0, 0, 0); __builtin_amdgcn_s_setprio(0); } while (0)
#define PG8_WAIT_V(n) asm volatile("s_waitcnt vmcnt(" #n ")" ::: "memory")
#define PG8_WAIT_L(n) asm volatile("s_waitcnt lgkmcnt(" #n ")" ::: "memory")
#define PG8_BAR __builtin_amdgcn_s_barrier()
#define PG8_SCHED __builtin_amdgcn_sched_barrier(0)
    Unit cur, nxt; int ui = 0;
    if (!S.next(0, cur)) return;
    f32x4 acc[2][2][4][2];
#pragma unroll
    for (int a = 0; a < 2; ++a)
#pragma unroll
        for (int b = 0; b < 2; ++b)
#pragma unroll
            for (int m = 0; m < 4; ++m)
#pragma unroll
                for (int n = 0; n < 2; ++n) acc[a][b][m][n] = (f32x4){0.f, 0.f, 0.f, 0.f};
    bf16x8 At[4][2], B0[2][2], B1[2][2];
    const char* cA = (const char*)g.A + (size_t)cur.pm * tstepA; const char* cB = (const char*)g.Bt + (size_t)cur.pn * tstepB;
    PG8_STAGE(PG8_SB(0, 0), cB, voffB); PG8_STAGE(PG8_SB(0, 1), cB + hstepB, voffB); PG8_STAGE(PG8_SA(0, 0), cA, voffA); PG8_STAGE(PG8_SA(0, 1), cA + hstepA, voffA);
    if (wr == 1) PG8_BAR;
    PG8_WAIT_V(2); PG8_BAR;
    PG8_STAGE(PG8_SB(1, 0), cB + kstep, voffB); PG8_STAGE(PG8_SA(1, 0), cA + kstep, voffA); PG8_STAGE(PG8_SB(1, 1), cB + hstepB + kstep, voffB);
    PG8_WAIT_V(6); PG8_BAR;
    for (;;) {
        const bool has_next = S.next(ui + 1, nxt);
        const char* nA = has_next ? (const char*)g.A + (size_t)nxt.pm * tstepA : cA; const char* nB = has_next ? (const char*)g.Bt + (size_t)nxt.pn * tstepB : cB;
        for (int t = 0; t < nt; t += 2) {
            const bool last = (t == nt - 2);
            const char* a1 = cA + (size_t)(t + 1) * kstep;
            const char* a2 = last ? nA : cA + (size_t)(t + 2) * kstep; const char* b2 = last ? nB : cB + (size_t)(t + 2) * kstep;
            const char* a3 = a2 + kstep; const char* b3 = b2 + kstep;
            if constexpr (MIDSCALE) { if (t == nt / 2) {
#pragma unroll
                for (int ai = 0; ai < 2; ++ai)
#pragma unroll
                    for (int m = 0; m < 4; ++m) { const float sc = rsqrtf(ssq_get(g.mid_ssq + cur.pm * BM + ai * HALF + wr * 64 + m * 16 + fr) * g.mid_inv + EPS);
#pragma unroll
                        for (int bj = 0; bj < 2; ++bj)
#pragma unroll
                            for (int n = 0; n < 2; ++n) acc[ai][bj][m][n] = acc[ai][bj][m][n] * sc; } } }
            PG8_LDB(B0, 0, 0); PG8_LDB(B1, 0, 1); PG8_SCHED; PG8_LDA(At, 0, 0); PG8_STAGE(PG8_SA(1, 1), a1 + hstepA, voffA);
            PG8_WAIT_V(8); PG8_WAIT_L(0); PG8_BAR; PG8_MMA(0, 0, At, B0); PG8_MMA(0, 1, At, B1); PG8_BAR; PG8_SCHED;
            PG8_LDA(At, 0, 1); PG8_STAGE(PG8_SB(0, 0), b2, voffB); PG8_STAGE(PG8_SB(0, 1), b2 + hstepB, voffB); PG8_STAGE(PG8_SA(0, 0), a2, voffA);
            PG8_WAIT_V(8); PG8_WAIT_L(0); PG8_BAR; PG8_MMA(1, 0, At, B0); PG8_MMA(1, 1, At, B1); PG8_BAR; PG8_SCHED;
            PG8_LDB(B0, 1, 0); PG8_LDB(B1, 1, 1); PG8_SCHED; PG8_LDA(At, 1, 0); PG8_STAGE(PG8_SA(0, 1), a2 + hstepA, voffA);
            PG8_WAIT_V(8); PG8_WAIT_L(0); PG8_BAR; PG8_MMA(0, 0, At, B0); PG8_MMA(0, 1, At, B1); PG8_BAR; PG8_SCHED;
            PG8_LDA(At, 1, 1); PG8_STAGE(PG8_SB(1, 0), b3, voffB); PG8_STAGE(PG8_SB(1, 1), b3 + hstepB, voffB); PG8_STAGE(PG8_SA(1, 0), a3, voffA);
            PG8_WAIT_V(8); PG8_WAIT_L(0); PG8_BAR; PG8_MMA(1, 0, At, B0); PG8_MMA(1, 1, At, B1); PG8_BAR; PG8_SCHED;
        }
        if (wr == 0) PG8_BAR;
        { int frE = fr, fqE = fq; LAUNDER_V(frE); LAUNDER_V(fqE); E(acc, cur, wr, wc, frE, fqE); }
        if (!has_next) break;
#pragma unroll
        for (int a = 0; a < 2; ++a)
#pragma unroll
            for (int b = 0; b < 2; ++b)
#pragma unroll
                for (int m = 0; m < 4; ++m)
#pragma unroll
                    for (int n = 0; n < 2; ++n) acc[a][b][m][n] = (f32x4){0.f, 0.f, 0.f, 0.f};
        cur = nxt; cA = nA; cB = nB; ++ui;
        if (wr == 1) PG8_BAR;
    }
    PG8_WAIT_V(0);
    PG8_BAR;
#undef PG8_SA
#undef PG8_SB
#undef PG8_STAGE
#undef PG8_LDA
#undef PG8_LDB
#undef PG8_MMA
#undef PG8_WAIT_V
#undef PG8_WAIT_L
#undef PG8_BAR
#undef PG8_SCHED
}
}

constexpr int RING_BYTES = 131072;
constexpr int LDS_BYTES = 147456;

struct Args { const float* in[20]; float* out; unsigned char* ws; float inv_freq[32]; };
typedef const __attribute__((address_space(4))) Args* KAP_T;

#define DS_READ4(r0, r1, r2, r3, addr, o0, o1, o2, o3) asm volatile("ds_read_b128 %0, %4 offset:%5\n\tds_read_b128 %1, %4 offset:%6\n\tds_read_b128 %2, %4 offset:%7\n\tds_read_b128 %3, %4 offset:%8" \
    : "=&v"(r0), "=&v"(r1), "=&v"(r2), "=&v"(r3) : "v"(addr), "i"(o0), "i"(o1), "i"(o2), "i"(o3) : "memory")
#define LGKM_WAIT4(n, r0, r1, r2, r3) asm volatile("s_waitcnt lgkmcnt(" #n ")" : "+v"(r0), "+v"(r1), "+v"(r2), "+v"(r3) :: "memory")
#define MFMA32(a, b, c) __builtin_amdgcn_mfma_f32_32x32x16_bf16((a), (b), (c), 0, 0, 0)
__device__ __forceinline__ int crow(int r, int hi) { return (r & 3) + 8 * (r >> 2) + 4 * hi; }

__device__ __forceinline__ void wt_item(const float* __restrict__ W, int K, int N, const float* __restrict__ gain, int gainK, bf16_t* WT, LAS float* scr, int item, int nblk, int lane, bool remap_up = false) {
    const int kb = item / nblk, nb = item % nblk, k0 = 64 * kb, n0 = 32 * nb;
    const int ns0 = remap_up ? (((n0 & 255) < 128) ? 128 * (n0 >> 8) + (n0 & 255) : DFF + 128 * (n0 >> 8) + (n0 & 255) - 128) : n0;
    const int n = ns0 + (lane & 31);
    float wv[32];
#pragma unroll
    for (int i = 0; i < 32; ++i) { const int kk = 2 * i + (lane >> 5); wv[i] = (n < N) ? G_(W)[(size_t)(k0 + kk) * N + n] : 0.f; }
#pragma unroll
    for (int i = 0; i < 32; ++i) { const int kk = 2 * i + (lane >> 5); scr[kk * 33 + (lane & 31)] = wv[i]; }
    asm volatile("s_waitcnt lgkmcnt(0)" ::: "memory");
    const int c = lane & 7;
    f32x4 g0 = (f32x4){1.f, 1.f, 1.f, 1.f}, g1 = g0;
    if (k0 < gainK) { g0 = *(GAS const f32x4*)(G_(gain) + k0 + 8 * c); g1 = *(GAS const f32x4*)(G_(gain) + k0 + 8 * c + 4); }
#pragma unroll
    for (int j = 0; j < 4; ++j) { const int nn = (lane >> 3) + 8 * j; const LAS float* s = scr + (8 * c) * 33 + nn;
        u32x4 o; o.x = pk2(s[0 * 33] * g0[0], s[1 * 33] * g0[1]); o.y = pk2(s[2 * 33] * g0[2], s[3 * 33] * g0[3]); o.z = pk2(s[4 * 33] * g1[0], s[5 * 33] * g1[1]); o.w = pk2(s[6 * 33] * g1[2], s[7 * 33] * g1[3]);
        *(GAS u32x4*)(G_(WT) + (size_t)(n0 + nn) * K + k0 + 8 * c) = o; }
    asm volatile("s_waitcnt lgkmcnt(0)" ::: "memory");
}

constexpr int AT_KB = 3 * 8192, AT_VB = 16384, AT_NBUF = 3, AT_BUF = AT_KB + AT_VB  , AT_WSF = AT_NBUF * AT_BUF;
static_assert(AT_WSF + 8 * 128 <= RING_BYTES, "attn lds");
#define DS_READ4X(r0, r1, r2, r3, a0, a1, a2, a3, o0, o1, o2, o3) asm volatile("ds_read_b128 %0, %4 offset:%8\n\tds_read_b128 %1, %5 offset:%9\n\tds_read_b128 %2, %6 offset:%10\n\tds_read_b128 %3, %7 offset:%11" \
    : "=&v"(r0), "=&v"(r1), "=&v"(r2), "=&v"(r3) : "v"(a0), "v"(a1), "v"(a2), "v"(a3), "i"(o0), "i"(o1), "i"(o2), "i"(o3) : "memory")

__device__ __forceinline__ void attn_unit(LAS unsigned char* L, const bf16_t* Q_, const bf16_t* Kg_, const bf16_t* Vt_, bf16_t* mix_, u64* ssq_a, int h, int qb, int wv, const int* pos_, const float* qn_, KAP_T kap) {
    GAS const bf16_t* Q = G_(Q_); GAS const bf16_t* Kg = G_(Kg_); GAS const bf16_t* Vt = G_(Vt_); GAS bf16_t* mix = G_(mix_);
    int tid_ = wv * 64 + lane_id_(); LAUNDER_V(tid_);
    const int tid = tid_, lane = tid & 63, w = __builtin_amdgcn_readfirstlane(tid >> 6), r32 = lane & 31, hh = lane >> 5;
    const int q0 = qb * 256;
    bf16x8 qf[12];
    {
        const int qrow_i = q0 + 32 * w + r32;
        GAS const bf16_t* qrow = Q + (size_t)qrow_i * QW + h * QKD + 8 * hh;
        u32x4 raw[12];
#pragma unroll
        for (int ks = 0; ks < 12; ++ks) raw[ks] = *(GAS const u32x4*)(qrow + 16 * ks);
        const float posf = (float)G_(pos_)[qrow_i];
        float ss = 0.f;
#pragma unroll
        for (int ks = 0; ks < 12; ++ks)
#pragma unroll
            for (int jj = 0; jj < 4; ++jj) { const float lo = bflo(raw[ks][jj]), hi = bfhi(raw[ks][jj]); ss += lo * lo + hi * hi; }
        ss += __shfl_xor(ss, 32);
        const float rs = rsqrtf(ss * (1.0f / QKD) + EPS) * (0.07216878364870322f * 1.4426950408889634f);
        GAS const float* qn = G_(qn_) + 8 * hh;
#pragma unroll
        for (int ks = 0; ks < 8; ++ks) { const f32x4 g0 = *(GAS const f32x4*)(qn + 16 * ks), g1 = *(GAS const f32x4*)(qn + 16 * ks + 4);
            u32x4 o_; o_.x = pk2(bflo(raw[ks].x) * rs * g0[0], bfhi(raw[ks].x) * rs * g0[1]); o_.y = pk2(bflo(raw[ks].y) * rs * g0[2], bfhi(raw[ks].y) * rs * g0[3]);
            o_.z = pk2(bflo(raw[ks].z) * rs * g1[0], bfhi(raw[ks].z) * rs * g1[1]); o_.w = pk2(bflo(raw[ks].w) * rs * g1[2], bfhi(raw[ks].w) * rs * g1[3]);
            qf[ks] = __builtin_bit_cast(bf16x8, o_); }
#pragma unroll
        for (int a = 0; a < 2; ++a) {
            const f32x4 ga0 = *(GAS const f32x4*)(qn + 16 * (8 + a)), ga1 = *(GAS const f32x4*)(qn + 16 * (8 + a) + 4), gb0 = *(GAS const f32x4*)(qn + 16 * (10 + a)), gb1 = *(GAS const f32x4*)(qn + 16 * (10 + a) + 4);
            float x1[8], x2[8], y1[8], y2[8];
#pragma unroll
            for (int jj = 0; jj < 4; ++jj) { x1[2 * jj] = bflo(raw[8 + a][jj]); x1[2 * jj + 1] = bfhi(raw[8 + a][jj]); x2[2 * jj] = bflo(raw[10 + a][jj]); x2[2 * jj + 1] = bfhi(raw[10 + a][jj]); }
#pragma unroll
            for (int j = 0; j < 8; ++j) {
                const float ang = posf * kap->inv_freq[16 * a + 8 * hh + j];
                double rev = (double)ang * 0.15915494309189535; rev -= __builtin_rint(rev);
                const float sn = __builtin_amdgcn_sinf((float)rev), cs = __builtin_amdgcn_cosf((float)rev);
                const float n1 = x1[j] * rs * (j < 4 ? ga0[j & 3] : ga1[j & 3]), n2 = x2[j] * rs * (j < 4 ? gb0[j & 3] : gb1[j & 3]);
                y1[j] = n1 * cs - n2 * sn; y2[j] = n2 * cs + n1 * sn;
            }
            qf[8 + a] = __builtin_bit_cast(bf16x8, (u32x4){pk2(y1[0], y1[1]), pk2(y1[2], y1[3]), pk2(y1[4], y1[5]), pk2(y1[6], y1[7])});
            qf[10 + a] = __builtin_bit_cast(bf16x8, (u32x4){pk2(y2[0], y2[1]), pk2(y2[2], y2[3]), pk2(y2[4], y2[5]), pk2(y2[6], y2[7])});
        }
    }
    f32x16 o[4];
#pragma unroll
    for (int d = 0; d < 4; ++d)
#pragma unroll
        for (int i = 0; i < 16; ++i) o[d][i] = 0.f;
    float l_run = 0.f;
    const int NT = 4 * qb + 4, my_last = 4 * qb + (w >> 1);
    volatile LAS float* wsf = (volatile LAS float*)(L + AT_WSF) + w * 32;
    const unsigned lds_base = (unsigned)(uintptr_t)L;
#define AT_FOFF(j, lz, bo) (lds_base + (bo) + (unsigned)((((lz) & 31) >> 1) * 256 + ((((((lz) & 31) & 1) * 8) + 2 * (j) + ((lz) >> 5)) ^ ((((lz) & 31) >> 1) & 7)) * 16))
    const int du = 4 * w + (lane >> 4), dsl = lane & 15, drb = dsl >> 3, dc = (dsl & 7) ^ (du & 7);
    GAS const bf16_t* ksrc = Kg + (size_t)(2 * du + drb) * QW + h * QKD + dc * 8;
    GAS const bf16_t* vsrc = Vt + (size_t)(h * VD + 2 * du + drb) * SEQ + dc * 8;
#define AT_DMA(t, bi) do { const int kv0_ = (t) * 64; \
    _Pragma("unroll") for (int i = 0; i < 3; ++i) __builtin_amdgcn_global_load_lds((const unsigned*)(ksrc + (size_t)kv0_ * QW + i * 64), (LAS unsigned*)(L + (bi) * AT_BUF + (8 * i + w) * 1024), 16, 0, 0); \
    _Pragma("unroll") for (int i = 0; i < 2; ++i) __builtin_amdgcn_global_load_lds((const unsigned*)(vsrc + (size_t)i * 64 * SEQ + kv0_), (LAS unsigned*)(L + (bi) * AT_BUF + AT_KB + (8 * i + w) * 1024), 16, 0, 0); } while (0)
    AT_DMA(0, 0); AT_DMA(1, 1);
    asm volatile("s_waitcnt vmcnt(5)" ::: "memory"); __builtin_amdgcn_s_barrier(); asm volatile("" ::: "memory");
    int bcur = 0, bnx2 = 2;
    for (int t = 0; t < NT; ++t) {
        if (t + 2 < NT) AT_DMA(t + 2, bnx2);
        if (t <= my_last) {
            int lz_ = lane; LAUNDER_V(lz_); const unsigned bo_ = (unsigned)bcur * AT_BUF;
            const unsigned ka0 = AT_FOFF(0, lz_, bo_), ka1 = AT_FOFF(1, lz_, bo_), ka2 = AT_FOFF(2, lz_, bo_), ka3 = AT_FOFF(3, lz_, bo_);
            f32x16 p0, p1;
#pragma unroll
            for (int i = 0; i < 16; ++i) { p0[i] = 0.f; p1[i] = 0.f; }
            bf16x8 fa0, fa1, fa2, fa3, fb0, fb1, fb2, fb3, fc0, fc1, fc2, fc3;
#define QK_RD(s0, s1, s2, s3, kb, g) DS_READ4X(s0, s1, s2, s3, ka0, ka1, ka2, ka3, (g) * 8192 + (kb) * 4096, (g) * 8192 + (kb) * 4096, (g) * 8192 + (kb) * 4096, (g) * 8192 + (kb) * 4096)
#define QK_MM(s0, s1, s2, s3, P, g) do { P = MFMA32(s0, qf[4 * (g)], P); P = MFMA32(s1, qf[4 * (g) + 1], P); P = MFMA32(s2, qf[4 * (g) + 2], P); P = MFMA32(s3, qf[4 * (g) + 3], P); } while (0)
#define PV_RD(s0, s1, s2, s3, va) DS_READ4(s0, s1, s2, s3, va, AT_KB, AT_KB + 4096, AT_KB + 8192, AT_KB + 12288)
#define PV_PK(P, ss) __builtin_bit_cast(bf16x8, (u32x4){pk2(P[8 * (ss) + 0], P[8 * (ss) + 1]), pk2(P[8 * (ss) + 2], P[8 * (ss) + 3]), pk2(P[8 * (ss) + 4], P[8 * (ss) + 5]), pk2(P[8 * (ss) + 6], P[8 * (ss) + 7])})
#define PV_MM(s0, s1, s2, s3, xs) do { o[0] = MFMA32(xs, s0, o[0]); o[1] = MFMA32(xs, s1, o[1]); o[2] = MFMA32(xs, s2, o[2]); o[3] = MFMA32(xs, s3, o[3]); } while (0)
            QK_RD(fa0, fa1, fa2, fa3, 0, 0);
            QK_RD(fb0, fb1, fb2, fb3, 0, 1);
            QK_RD(fc0, fc1, fc2, fc3, 0, 2); LGKM_WAIT4(8, fa0, fa1, fa2, fa3); QK_MM(fa0, fa1, fa2, fa3, p0, 0);
            QK_RD(fa0, fa1, fa2, fa3, 1, 0); LGKM_WAIT4(8, fb0, fb1, fb2, fb3); QK_MM(fb0, fb1, fb2, fb3, p0, 1);
            QK_RD(fb0, fb1, fb2, fb3, 1, 1); LGKM_WAIT4(8, fc0, fc1, fc2, fc3); QK_MM(fc0, fc1, fc2, fc3, p0, 2);
            float ls0 = 0.f, ls1 = 0.f;
#pragma unroll
            for (int i = 0; i < 16; ++i) { p0[i] = __builtin_amdgcn_exp2f(__builtin_amdgcn_fmed3f(p0[i], -1000.f, 100.f)); ls0 += p0[i]; }
            QK_RD(fc0, fc1, fc2, fc3, 1, 2); LGKM_WAIT4(8, fa0, fa1, fa2, fa3); QK_MM(fa0, fa1, fa2, fa3, p1, 0);
            PV_RD(fa0, fa1, fa2, fa3, ka0);  LGKM_WAIT4(8, fb0, fb1, fb2, fb3); QK_MM(fb0, fb1, fb2, fb3, p1, 1);
            PV_RD(fb0, fb1, fb2, fb3, ka1);  LGKM_WAIT4(8, fc0, fc1, fc2, fc3); QK_MM(fc0, fc1, fc2, fc3, p1, 2);
            { const bf16x8 x00 = PV_PK(p0, 0), x01 = PV_PK(p0, 1);
#pragma unroll
              for (int i = 0; i < 16; ++i) { p1[i] = __builtin_amdgcn_exp2f(__builtin_amdgcn_fmed3f(p1[i], -1000.f, 100.f)); ls1 += p1[i]; }
              PV_RD(fc0, fc1, fc2, fc3, ka2); LGKM_WAIT4(8, fa0, fa1, fa2, fa3); PV_MM(fa0, fa1, fa2, fa3, x00);
              PV_RD(fa0, fa1, fa2, fa3, ka3); LGKM_WAIT4(8, fb0, fb1, fb2, fb3); PV_MM(fb0, fb1, fb2, fb3, x01);
              const bf16x8 x10 = PV_PK(p1, 0), x11 = PV_PK(p1, 1);
              LGKM_WAIT4(4, fc0, fc1, fc2, fc3); PV_MM(fc0, fc1, fc2, fc3, x10);
              LGKM_WAIT4(0, fa0, fa1, fa2, fa3); PV_MM(fa0, fa1, fa2, fa3, x11); }
            l_run += ls0 + ls1;
#undef QK_RD
#undef QK_MM
#undef PV_RD
#undef PV_PK
#undef PV_MM
        }
        if (t + 2 < NT) asm volatile("s_waitcnt vmcnt(5) lgkmcnt(0)" ::: "memory"); else asm volatile("s_waitcnt vmcnt(0) lgkmcnt(0)" ::: "memory");
        __builtin_amdgcn_s_barrier(); asm volatile("" ::: "memory");
        bcur = (bcur == 2) ? 0 : bcur + 1; bnx2 = (bnx2 == 2) ? 0 : bnx2 + 1;
    }
#undef AT_DMA
#undef AT_FOFF
    const float lt = l_run + __shfl_xor(l_run, 32);
    wsf[r32] = 1.0f / lt;
    asm volatile("s_waitcnt lgkmcnt(0)" ::: "memory");
    GAS bf16_t* orow = mix + (size_t)(q0 + 32 * w) * DM + h * VD + r32;
#pragma unroll
    for (int i = 0; i < 16; ++i) { const int qr = crow(i, hh); const float a = wsf[qr]; float ss = 0.f;
#pragma unroll
        for (int d = 0; d < 4; ++d) { const float v = o[d][i] * a; ss += v * v; orow[(size_t)qr * DM + 32 * d] = (bf16_t)f2bf(v); }
        ss += __shfl_xor(ss, 1); ss += __shfl_xor(ss, 2); ss += __shfl_xor(ss, 4); ss += __shfl_xor(ss, 8); ss += __shfl_xor(ss, 16);
        if (r32 == 0) ssq_add(ssq_a + q0 + 32 * w + qr, ss); }
    __syncthreads();
}

constexpr int GL_V = 0  , GL_KD = 32768  , GL_TOT = GL_KD + 18432  , GL_ZA = GL_TOT + 2048  ;
__device__ __forceinline__ void gla_chunk_unit(LAS unsigned char* L, const bf16_t* Z_, const float* wgate_, const float* bgate_, bf16_t* ST_, float* DEC_, int c, int h, int wv) {
    GAS const bf16_t* Z = G_(Z_); GAS const float* wgate = G_(wgate_); GAS const float* bgate = G_(bgate_); GAS bf16_t* ST = G_(ST_); GAS float* DEC = G_(DEC_);
    int tid_ = wv * 64 + lane_id_(); LAUNDER_V(tid_);
    const int tid = tid_, lane = tid & 63, w = __builtin_amdgcn_readfirstlane(tid >> 6), r32 = lane & 31, hh = lane >> 5;
    const size_t row0 = (size_t)c * 64;
#pragma unroll
    for (int i = 0; i < 4; ++i) { const int id = tid + 512 * i, r = id >> 5, cc = id & 31;
        *(LAS u32x4*)(L + GL_V + r * 512 + cc * 16) = *(GAS const u32x4*)(Z + (row0 + r) * IN_PAD + C_GV + h * GDV + cc * 8); }
#pragma unroll
    for (int i = 0; i < 2; ++i) { const int id = tid + 512 * i, r = id >> 4, cc = id & 15;
        ((LAS float*)(L + GL_ZA))[id] = bf2f(Z[(row0 + r) * IN_PAD + C_GA + cc]); }
    __syncthreads();
    const int tq = tid >> 7, col = tid & 127;
    float wg[16];
#pragma unroll
    for (int r = 0; r < 16; ++r) wg[r] = wgate[r * (GH * GDK) + h * GDK + col];
    const float bg = bgate[h * GDK + col];
    float pre[16]; float run = 0.f;
#pragma unroll
    for (int i = 0; i < 16; ++i) {
        const LAS float* za = (const LAS float*)(L + GL_ZA) + (16 * tq + i) * 16;
        float ga = bg;
#pragma unroll
        for (int r = 0; r < 16; ++r) ga += za[r] * wg[r];
        const float ls = fminf(ga, 0.f) - __logf(1.0f + __expf(-fabsf(ga)));
        run += ls * (1.0f / 16.0f); pre[i] = run;
    }
    ((LAS float*)(L + GL_TOT))[tq * 128 + col] = run;
    __syncthreads();
    float off = 0.f, bend = 0.f;
#pragma unroll
    for (int t = 0; t < 4; ++t) { const float v = ((LAS float*)(L + GL_TOT))[t * 128 + col]; bend += v; if (t < tq) off += v; }
    {
        unsigned pkv[8];
#pragma unroll
        for (int i = 0; i < 16; i += 2) {
            const float k0 = bf2f(Z[(row0 + 16 * tq + i) * IN_PAD + C_GK + h * GDK + col]), k1 = bf2f(Z[(row0 + 16 * tq + i + 1) * IN_PAD + C_GK + h * GDK + col]);
            pkv[i >> 1] = pk2(k0 * __expf(bend - off - pre[i]), k1 * __expf(bend - off - pre[i + 1]));
        }
        LAS u32x4* dst = (LAS u32x4*)(L + GL_KD + col * 144 + tq * 32);
        dst[0] = (u32x4){pkv[0], pkv[1], pkv[2], pkv[3]}; dst[1] = (u32x4){pkv[4], pkv[5], pkv[6], pkv[7]};
    }
    if (tq == 0) DEC[(size_t)(c * GH + h) * GDK + col] = __expf(bend);
    __syncthreads();
    f32x16 acc[4];
#pragma unroll
    for (int d = 0; d < 4; ++d)
#pragma unroll
        for (int i = 0; i < 16; ++i) acc[d][i] = 0.f;
#pragma unroll
    for (int ks = 0; ks < 4; ++ks) {
        bf16x8 a;
#pragma unroll
        for (int j = 0; j < 8; ++j) a[j] = (short)*(const LAS unsigned short*)(L + GL_V + (16 * ks + 8 * hh + j) * 512 + (32 * w + r32) * 2);
#pragma unroll
        for (int db = 0; db < 4; ++db) {
            const bf16x8 b = *(const LAS bf16x8*)(L + GL_KD + (32 * db + r32) * 144 + (16 * ks + 8 * hh) * 2);
            acc[db] = MFMA32(a, b, acc[db]);
        }
    }
    GAS bf16_t* stp = ST + ((size_t)(c * GH + h) * GDV + 32 * w) * GDK + r32;
#pragma unroll
    for (int db = 0; db < 4; ++db)
#pragma unroll
        for (int i = 0; i < 16; ++i) stp[(size_t)crow(i, hh) * GDK + 32 * db] = (bf16_t)f2bf(acc[db][i]);
    __syncthreads();
}

constexpr int GO_STR = 260;
__device__ __forceinline__ void gla_out_unit(LAS unsigned char* L, const bf16_t* Z_, const bf16_t* ST_, const float* gnorm_, bf16_t* mix_, int c, int h, int wv) {
    GAS const bf16_t* Z = G_(Z_); GAS const bf16_t* ST = G_(ST_); GAS const float* gnorm = G_(gnorm_); GAS bf16_t* mix = G_(mix_);
    int tid_ = wv * 64 + lane_id_(); LAUNDER_V(tid_);
    const int tid = tid_, lane = tid & 63, w = __builtin_amdgcn_readfirstlane(tid >> 6), r32 = lane & 31, hh = lane >> 5;
    const size_t row0 = (size_t)c * 64;
    f32x16 acc[2];
#pragma unroll
    for (int d = 0; d < 2; ++d)
#pragma unroll
        for (int i = 0; i < 16; ++i) acc[d][i] = 0.f;
    GAS const bf16_t* sp = ST + ((size_t)(c * GH + h) * GDV + 32 * w + r32) * GDK + 8 * hh;
#pragma unroll
    for (int ks = 0; ks < 8; ++ks) {
        const bf16x8 b = *(GAS const bf16x8*)(sp + 16 * ks);
#pragma unroll
        for (int tb = 0; tb < 2; ++tb) {
            const bf16x8 a = *(GAS const bf16x8*)(Z + (row0 + 32 * tb + r32) * IN_PAD + C_GQ + h * GDK + 16 * ks + 8 * hh);
            acc[tb] = MFMA32(a, b, acc[tb]);
        }
    }
    LAS float* of = (LAS float*)L;
#pragma unroll
    for (int tb = 0; tb < 2; ++tb)
#pragma unroll
        for (int i = 0; i < 16; ++i) of[(32 * tb + crow(i, hh)) * GO_STR + 32 * w + r32] = acc[tb][i] * 0.08838834764831845f;
    __syncthreads();
    const int tok = tid >> 3, part = tid & 7;
    f32x4 v[4][2]; float ss = 0.f;
#pragma unroll
    for (int j = 0; j < 4; ++j)
#pragma unroll
        for (int q = 0; q < 2; ++q) { v[j][q] = *(const LAS f32x4*)(of + tok * GO_STR + part * 8 + 64 * j + 4 * q); ss += (v[j][q][0] * v[j][q][0] + v[j][q][1] * v[j][q][1]) + (v[j][q][2] * v[j][q][2] + v[j][q][3] * v[j][q][3]); }
    ss += __shfl_xor(ss, 1); ss += __shfl_xor(ss, 2); ss += __shfl_xor(ss, 4);
    const float rstd = rsqrtf(ss * (1.0f / GDV) + EPS);
    GAS const bf16_t* zg = Z + (row0 + tok) * IN_PAD + C_GG + h * GDV + part * 8;
    GAS bf16_t* op = mix + (row0 + tok) * DM + 1024 + h * GDV + part * 8;
#pragma unroll
    for (int j = 0; j < 4; ++j) {
        const u32x4 gw_ = *(GAS const u32x4*)(zg + 64 * j);
        const f32x4 n0 = *(GAS const f32x4*)(gnorm + part * 8 + 64 * j), n1 = *(GAS const f32x4*)(gnorm + part * 8 + 64 * j + 4);
        u32x4 ow;
        ow.x = pk2(v[j][0][0] * rstd * n0[0] * silu_f(bflo(gw_.x)), v[j][0][1] * rstd * n0[1] * silu_f(bfhi(gw_.x)));
        ow.y = pk2(v[j][0][2] * rstd * n0[2] * silu_f(bflo(gw_.y)), v[j][0][3] * rstd * n0[3] * silu_f(bfhi(gw_.y)));
        ow.z = pk2(v[j][1][0] * rstd * n1[0] * silu_f(bflo(gw_.z)), v[j][1][1] * rstd * n1[1] * silu_f(bfhi(gw_.z)));
        ow.w = pk2(v[j][1][2] * rstd * n1[2] * silu_f(bflo(gw_.w)), v[j][1][3] * rstd * n1[3] * silu_f(bfhi(gw_.w)));
        *(GAS u32x4*)(op + 64 * j) = ow;
    }
    __syncthreads();
}


#define XB_TMO      128
#define XB_XCNT(j)  (256  + 64 * (j))
#define XB_XSUB(j)  (1280 + 64 * (j))
#define XB_XGEN(j)  (2304 + 64 * (j))
#define XB_TOP      3328
#define XB_TOPGEN   3392
#define XCD_BAR_WORDS 3456
#define XB_SPIN_CAP (1u << 22)
__device__ __forceinline__ unsigned xb_ld(unsigned* p)              { return __hip_atomic_load(p, __ATOMIC_RELAXED, __HIP_MEMORY_SCOPE_AGENT); }
__device__ __forceinline__ unsigned xb_add(unsigned* p, unsigned v) { return __hip_atomic_fetch_add(p, v, __ATOMIC_RELAXED, __HIP_MEMORY_SCOPE_AGENT); }
__device__ __forceinline__ unsigned xb_xcc_id() { return (unsigned)__builtin_amdgcn_s_getreg((3 << 11) | 20) & 0xFu; }
#define XB_SPIN(cond, bar) do { unsigned _sp = 0; while (cond) { __builtin_amdgcn_s_sleep(1); \
    if ((++_sp & 255u) == 0u) { if (xb_ld(&(bar)[XB_TMO])) break; if (_sp > XB_SPIN_CAP) { atomicAdd(&(bar)[XB_TMO], 1u); break; } } } } while (0)
struct XcdBarrier { unsigned* bar; unsigned x; volatile LAS unsigned* st; };
__device__ __forceinline__ XcdBarrier xcd_barrier_post(unsigned* bar, volatile LAS unsigned* st, bool t0) {
    XcdBarrier b; b.bar = bar; b.x = xb_xcc_id(); b.st = st;
    if (t0) (void)xb_add(&bar[XB_XCNT(b.x)], 1u);
    return b;
}
__device__ __forceinline__ void xcd_barrier_complete(unsigned* bar, unsigned x, unsigned& nloc, unsigned& nx) {
    const unsigned G = gridDim.x * gridDim.y * gridDim.z;
    unsigned sum, cnt, mine, sp = 0u;
    for (;;) {
        sum = 0u; cnt = 0u; mine = 0u;
#pragma unroll
        for (unsigned j = 0; j < 16; ++j) { const unsigned c = xb_ld(&bar[XB_XCNT(j)]); sum += c; cnt += (c > 0u) ? 1u : 0u; mine = (j == x) ? c : mine; }
        if (sum == G) break;
        __builtin_amdgcn_s_sleep(1);
        if ((++sp & 255u) == 0u) { if (xb_ld(&bar[XB_TMO])) break; if (sp > XB_SPIN_CAP) { atomicAdd(&bar[XB_TMO], 1u); break; } }
    }
    nloc = mine > 0u ? mine : 1u; nx = cnt > 0u ? cnt : 1u;
}
__device__ __forceinline__ void xcd_barrier(const XcdBarrier& b, bool t0) {
    asm volatile("s_waitcnt vmcnt(0)" ::: "memory");
    __syncthreads();
    if (t0) {
        unsigned* bar = b.bar;
        __builtin_amdgcn_s_waitcnt(0);
        unsigned nloc = b.st[0], nx = b.st[1];
        if (nloc == 0u) { xcd_barrier_complete(bar, b.x, nloc, nx); b.st[0] = nloc; b.st[1] = nx; }
        const unsigned old = xb_add(&bar[XB_XSUB(b.x)], 1u);
        const unsigned gen = old / nloc;
        if (old + 1u == (gen + 1u) * nloc) {
            __builtin_amdgcn_fence(__ATOMIC_RELEASE, "agent");
            asm volatile("s_waitcnt vmcnt(0)" ::: "memory");
            const unsigned og = xb_add(&bar[XB_TOP], 1u);
            const unsigned tg = og / nx;
            if (og + 1u == (tg + 1u) * nx) xb_add(&bar[XB_TOPGEN], 1u);
            else XB_SPIN(xb_ld(&bar[XB_TOPGEN]) == tg, bar);
            __builtin_amdgcn_fence(__ATOMIC_ACQUIRE, "agent");
            xb_add(&bar[XB_XGEN(b.x)], 1u);
            asm volatile("s_waitcnt vmcnt(0)" ::: "memory");
        } else {
            XB_SPIN(xb_ld(&bar[XB_XGEN(b.x)]) == gen, bar);
            __builtin_amdgcn_fence(__ATOMIC_ACQUIRE, "agent");
            asm volatile("s_waitcnt vmcnt(0)" ::: "memory");
        }
    }
    __syncthreads();
}

__global__ void __launch_bounds__(512, 2) mk_fwd(Args a) {
    extern __shared__ __attribute__((aligned(16))) unsigned char lds[];
    cg::grid_group grid = cg::this_grid();
    LAS unsigned char* L = (LAS unsigned char*)lds;
    const int G = gridDim.x, bid = blockIdx.x, NGW = G * 8;
    volatile LAS unsigned* MISC = (volatile LAS unsigned*)(L + RING_BYTES + 8192);
    const int wave_s = __builtin_amdgcn_readfirstlane(threadIdx.x >> 6);
    if (wave_s == 0 && lane_id_() < 4) MISC[lane_id_()] = 0u;
    __syncthreads();
    { KAP_T kap0 = (KAP_T)__builtin_amdgcn_kernarg_segment_ptr(); (void)xcd_barrier_post((unsigned*)(kap0->ws + WS_BAR), MISC, wave_s == 0 && lane_id_() == 0); }
#define XSYNC() do { KAP_T kap_ = (KAP_T)__builtin_amdgcn_kernarg_segment_ptr(); LAUNDER_S(kap_); XcdBarrier xb_; xb_.bar = (unsigned*)(kap_->ws + WS_BAR); xb_.x = xb_xcc_id(); xb_.st = (volatile LAS unsigned*)(L + RING_BYTES + 8192); xcd_barrier(xb_, wave_s == 0 && lane_id_() == 0); } while (0)
#define GRID_SYNC() do { asm volatile("s_waitcnt vmcnt(0) lgkmcnt(0)" ::: "memory"); __syncthreads(); grid.sync(); \
    __builtin_amdgcn_fence(__ATOMIC_ACQUIRE, "agent"); asm volatile("s_waitcnt vmcnt(0)" ::: "memory"); __syncthreads(); } while (0)
#ifndef DBG_STOP
#define DBG_STOP 0
#endif
#define DBG_DUMP(k, EXPR) do { if (DBG_STOP == (k)) { PHASE_BEGIN(); for (int m = gw; m < SEQ; m += NGW) for (int c = lane; c < DM; c += 64) out[(size_t)m * DM + c] = (EXPR); return; } } while (0)
#define PHASE_BEGIN() KAP_T kap = (KAP_T)__builtin_amdgcn_kernarg_segment_ptr(); LAUNDER_S(kap); unsigned char* ws = kap->ws; LAUNDER_S(ws); int tid_ = wave_s * 64 + lane_id_(); LAUNDER_V(tid_); const int tid = tid_, lane = tid & 63, wave = __builtin_amdgcn_readfirstlane(tid >> 6), gw = bid * 8 + wave; \
    u64* ssq = (u64*)(ws + WS_SSQ); (void)lane; (void)gw; (void)ssq; \
    u64* ssq_x = ssq + (size_t)l * SEQ; u64* ssq_xn = ssq + (size_t)(l + 1) * SEQ; u64* ssq_cq = ssq + (size_t)(3 + l) * SEQ; u64* ssq_ckv = ssq + (size_t)(5 + l) * SEQ; u64* ssq_x1 = ssq + (size_t)(7 + l) * SEQ; u64* ssq_a = ssq + (size_t)(9 + l) * SEQ; (void)ssq_a; \
    (void)ssq_x; (void)ssq_xn; (void)ssq_cq; (void)ssq_ckv; (void)ssq_x1; \
    bf16_t* Win = (bf16_t*)(ws + WS_WIN); bf16_t* Wuq = (bf16_t*)(ws + WS_WUQ); bf16_t* Wukv = (bf16_t*)(ws + WS_WUKV); \
    bf16_t* Wout = (bf16_t*)(ws + WS_WOUT); bf16_t* Wup = (bf16_t*)(ws + WS_WUP); bf16_t* Wdn = (bf16_t*)(ws + WS_WDN); \
    bf16_t* XB = (bf16_t*)(ws + WS_XB); bf16_t* Z = (bf16_t*)(ws + WS_Z); bf16_t* Qb = (bf16_t*)(ws + WS_Q); bf16_t* Kb = (bf16_t*)(ws + WS_K); bf16_t* Vt = (bf16_t*)(ws + WS_VT); \
    bf16_t* ST = (bf16_t*)(ws + WS_ST); float* DEC = (float*)(ws + WS_DEC); bf16_t* MIX = (bf16_t*)(ws + WS_MIX); \
    bf16_t* ACT = (bf16_t*)(ws + WS_ACT); float* EDGE = (float*)(ws + WS_EDGE); \
    const float* xin = kap->in[0]; float* out = kap->out; \
    (void)Win; (void)Wuq; (void)Wukv; (void)Wout; (void)Wup; (void)Wdn; (void)XB; (void)Z; (void)Qb; (void)Kb; (void)Vt; (void)ST; (void)DEC; (void)MIX; (void)EDGE; (void)ACT; (void)xin; (void)out;

    for (int l = 0; l < NLAYER; ++l) {
        {
            PHASE_BEGIN();
            LAS float* scr = (LAS float*)(L + wave * 16384);
            const float* w_in = kap->in[3] + (size_t)l * DM * IN_DIM; const float* w_uq = kap->in[5] + (size_t)l * QLORA * QW; const float* w_ukv = kap->in[7] + (size_t)l * KVLORA * KVW;
            const float* w_out = kap->in[14] + (size_t)l * DM * DM; const float* w_up = kap->in[16] + (size_t)l * DM * DFF2; const float* w_dn = kap->in[19] + (size_t)l * DFF * DM;
            const float* g_attn = kap->in[2] + l * DM; const float* g_cq = kap->in[4] + l * QLORA; const float* g_ckv = kap->in[6] + l * KVLORA; const float* g_mla = kap->in[13] + l * 1024; const float* g_ffn = kap->in[15] + l * DM;
            constexpr int I_IN = (DM / 64) * (IN_PAD / 32), I_UQ = (QLORA / 64) * (QW / 32), I_UKV = (KVLORA / 64) * (KVW / 32), I_OUT = (DM / 64) * (DM / 32), I_UP = (DM / 64) * (DFF2 / 32), I_DN = (DFF / 64) * (DM / 32);
            constexpr int NITEMS = I_IN + I_UQ + I_UKV + I_OUT + I_UP + I_DN;
            for (int it = gw; it < NITEMS; it += NGW) {
                int r = it;
                if (r < I_IN) { wt_item(w_in, DM, IN_DIM, g_attn, DM, Win, scr, r, IN_PAD / 32, lane); continue; } r -= I_IN;
                if (r < I_UQ) { wt_item(w_uq, QLORA, QW, g_cq, QLORA, Wuq, scr, r, QW / 32, lane); continue; } r -= I_UQ;
                if (r < I_UKV) { wt_item(w_ukv, KVLORA, KVW, g_ckv, KVLORA, Wukv, scr, r, KVW / 32, lane); continue; } r -= I_UKV;
                if (r < I_OUT) { wt_item(w_out, DM, DM, g_mla, 1024, Wout, scr, r, DM / 32, lane); continue; } r -= I_OUT;
                if (r < I_UP) { wt_item(w_up, DM, DFF2, g_ffn, DM, Wup, scr, r, DFF2 / 32, lane, true); continue; } r -= I_UP;
                wt_item(w_dn, DFF, DM, g_ffn, 0, Wdn, scr, r, DM / 32, lane);
            }
            if (l == 0) {
                for (int m = gw; m < SEQ; m += NGW) {
                    GAS const f32x4* xr = (GAS const f32x4*)(G_(xin) + (size_t)m * DM) + lane; float s = 0.f;
                    GAS u32x2* o8 = (GAS u32x2*)(G_(XB) + (size_t)m * DM) + lane;
#pragma unroll
                    for (int j = 0; j < 8; ++j) { const f32x4 v = xr[64 * j]; s += (v[0] * v[0] + v[1] * v[1]) + (v[2] * v[2] + v[3] * v[3]); o8[64 * j] = (u32x2){pk2(v[0], v[1]), pk2(v[2], v[3])}; }
                    s = wave_sum(s); if (lane == 0) G_(ssq_x)[m] = (u64)(s * SSQ_FX + 0.5f);
                }
            }
        }
        if (l == 0) GRID_SYNC(); else XSYNC();
        {
            PHASE_BEGIN();
            pg8::Gemm g{XB, Win, SEQ, IN_PAD, DM, DM, nullptr, 0.f}; pg8::StaticOrder S; S.init(SEQ, IN_PAD, G, bid);
            pg8::EpiRowScale E{Z, IN_PAD, ssq_x, 1.0f / DM, ssq_cq, 0, 2, ssq_ckv, 2, 3};
            pg8::gemm_phase<pg8::EpiRowScale>(L, g, S, E, wave_s);
        }
        XSYNC();
        DBG_DUMP(1, bf2f(Z[(size_t)m * IN_PAD + c]) + bf2f(Z[(size_t)m * IN_PAD + 2048 + c]));
        {
            PHASE_BEGIN();
            { pg8::Gemm g{Z + C_CQ, Wuq, SEQ, QW, QLORA, IN_PAD, nullptr, 0.f}; pg8::StaticOrder S; S.init(SEQ, QW, G, bid);
              pg8::EpiRowScale E{Qb, QW, ssq_cq, 1.0f / QLORA, nullptr, 0, 0, nullptr, 0, 0};
              pg8::gemm_phase<pg8::EpiRowScale>(L, g, S, E, wave_s); }
            { pg8::Gemm g{Z + C_CKV, Wukv, SEQ, KVW, KVLORA, IN_PAD, nullptr, 0.f}; pg8::StaticOrder S; S.init(SEQ, KVW, G, bid);
              pg8::EpiUkv E{Kb, Vt, ssq_ckv, 1.0f / KVLORA};
              pg8::gemm_phase<pg8::EpiUkv>(L, g, S, E, wave_s); }
            const float* wgate = kap->in[10] + (size_t)l * 16 * (GH * GDK); const float* bgate = kap->in[11] + (size_t)l * (GH * GDK);
            for (int u = bid; u < NCHUNK * GH; u += G) gla_chunk_unit(L, Z, wgate, bgate, ST, DEC, u >> 2, u & 3, wave_s);
        }
        XSYNC();
        DBG_DUMP(2, (c < QW ? bf2f(Qb[(size_t)m * QW + c]) + bf2f(Kb[(size_t)m * QW + c]) : bf2f(Vt[(size_t)(c - QW) * SEQ + m])) + bf2f(ST[(size_t)m * 8192 + c]) + bf2f(ST[(size_t)m * 8192 + 4096 + c]));
        {
            PHASE_BEGIN();
            const int* pos = (const int*)kap->in[1];
            const float* kn = kap->in[9] + l * QKD;
            for (int m = gw; m < SEQ; m += NGW) {
                const int i = lane & 31;
                const float ang = (float)G_(pos)[m] * kap->inv_freq[i];
                double rev = (double)ang * 0.15915494309189535; rev -= __builtin_rint(rev);
                const float sn = __builtin_amdgcn_sinf((float)rev), cs = __builtin_amdgcn_cosf((float)rev);
                const float krv = bf2f(G_(Z)[(size_t)m * IN_PAD + C_KR + lane]);
                GAS bf16_t* kp = G_(Kb) + (size_t)m * QW;
                float ka[NH][2], ks[NH];
#pragma unroll
                for (int h = 0; h < NH; ++h) { ka[h][0] = bf2f(kp[h * QKD + lane]); ka[h][1] = bf2f(kp[h * QKD + 64 + lane]); }
#pragma unroll
                for (int h = 0; h < NH; ++h) ks[h] = ka[h][0] * ka[h][0] + ka[h][1] * ka[h][1] + krv * krv;
#pragma unroll
                for (int o = 1; o < 64; o <<= 1)
#pragma unroll
                    for (int h = 0; h < NH; ++h) ks[h] += __shfl_xor(ks[h], o);
                const float kg0 = G_(kn)[lane], kg1 = G_(kn)[64 + lane], kg2 = G_(kn)[128 + lane];
#pragma unroll
                for (int h = 0; h < NH; ++h) {
                    const float rstd = rsqrtf(ks[h] * (1.0f / QKD) + EPS);
                    const float n2 = krv * rstd * kg2, pr = __shfl_xor(n2, 32);
                    const float r2 = (lane < 32) ? n2 * cs - pr * sn : n2 * cs + pr * sn;
                    kp[h * QKD + lane] = (bf16_t)f2bf(ka[h][0] * rstd * kg0); kp[h * QKD + 64 + lane] = (bf16_t)f2bf(ka[h][1] * rstd * kg1); kp[h * QKD + 128 + lane] = (bf16_t)f2bf(r2);
                }
            }
            constexpr int NE = GH * GDV * GDK;
            for (int e = bid * 512 + tid; e < NE; e += G * 512) {
                const int hd = (e >> 15) * GDK + (e & 127);
                float s = 0.f;
                for (int c0 = 0; c0 < NCHUNK; c0 += 8) {
                    float uu[8], dd[8];
#pragma unroll
                    for (int i = 0; i < 8; ++i) { uu[i] = bf2f(G_(ST)[(size_t)(c0 + i) * NE + e]); dd[i] = G_(DEC)[(size_t)(c0 + i) * (GH * GDK) + hd]; }
#pragma unroll
                    for (int i = 0; i < 8; ++i) { s = s * dd[i] + uu[i]; G_(ST)[(size_t)(c0 + i) * NE + e] = (bf16_t)f2bf(s); }
                }
            }
        }
        XSYNC();
        DBG_DUMP(3, (c < QW ? bf2f(Qb[(size_t)m * QW + c]) + bf2f(Kb[(size_t)m * QW + c]) : 0.f) + bf2f(ST[(size_t)m * 8192 + c]) + bf2f(ST[(size_t)m * 8192 + 4096 + c]));
        {
            PHASE_BEGIN();
            for (int p = bid; p < 256; p += G) {
                const int h = p & 7, s = p >> 3;
                attn_unit(L, Qb, Kb, Vt, MIX, ssq_a, h, 63 - s, wave_s, (const int*)kap->in[1], kap->in[8] + l * QKD, kap);
                attn_unit(L, Qb, Kb, Vt, MIX, ssq_a, h, s, wave_s, (const int*)kap->in[1], kap->in[8] + l * QKD, kap);
            }
            const float* gnorm = kap->in[12] + l * GDV;
            for (int u = bid; u < NCHUNK * GH; u += G) gla_out_unit(L, Z, ST, gnorm, MIX, u >> 2, u & 3, wave_s);
        }
        XSYNC();
        DBG_DUMP(4, bf2f(MIX[(size_t)m * DM + c]));
        DBG_DUMP(5, bf2f(MIX[(size_t)m * DM + c]));
        {
            PHASE_BEGIN();
            pg8::Gemm g{MIX, Wout, SEQ, DM, DM, DM, ssq_a, 1.0f / 1024.0f}; pg8::StaticOrder S; S.init(SEQ, DM, G, bid);
            pg8::EpiRes E{l == 0 ? xin : out, out, XB, ssq_x1};
            pg8::gemm_phase<pg8::EpiRes, true>(L, g, S, E, wave_s);
        }
        XSYNC();
        DBG_DUMP(6, out[(size_t)m * DM + c] + bf2f(XB[(size_t)m * DM + c]));
        {
            PHASE_BEGIN();
            const float* cw = kap->in[17] + (size_t)l * 3 * DFF2; const float* cb = kap->in[18] + (size_t)l * DFF2;
            pg8::Gemm g{XB, Wup, SEQ, DFF2, DM, DM, nullptr, 0.f}; pg8::StaticOrder S; S.init(SEQ, DFF2, G, bid);
            pg8::EpiUpConv E{ACT, EDGE, ssq_x1, cw, cb, (LAS float*)(L + RING_BYTES)};
            pg8::gemm_phase<pg8::EpiUpConv>(L, g, S, E, wave_s);
        }
        XSYNC();
        {
            PHASE_BEGIN();
            const float* cw = kap->in[17] + (size_t)l * 3 * DFF2; const float* cb = kap->in[18] + (size_t)l * DFF2;
            for (int idx = bid * 512 + tid; idx < 63 * DFF; idx += G * 512) {
                const int pm = 1 + idx / DFF, gcol = idx % DFF;
                float y0[2], y1[2];
#pragma unroll
                for (int q = 0; q < 2; ++q) { const int c = q * DFF + gcol;
                    const float um2 = G_(EDGE)[(size_t)((pm - 1) * 4 + 2) * DFF2 + c], um1 = G_(EDGE)[(size_t)((pm - 1) * 4 + 3) * DFF2 + c], u0 = G_(EDGE)[(size_t)(pm * 4 + 0) * DFF2 + c], u1 = G_(EDGE)[(size_t)(pm * 4 + 1) * DFF2 + c];
                    const float w0 = G_(cw)[c], w1 = G_(cw)[DFF2 + c], w2 = G_(cw)[2 * DFF2 + c], bb = G_(cb)[c];
                    y0[q] = bb + w0 * um2 + w1 * um1 + w2 * u0; y1[q] = bb + w0 * um1 + w1 * u0 + w2 * u1; }
                G_(ACT)[(size_t)(pm * 256) * DFF + gcol] = (bf16_t)f2bf(silu_f(y0[0]) * y0[1]);
                G_(ACT)[(size_t)(pm * 256 + 1) * DFF + gcol] = (bf16_t)f2bf(silu_f(y1[0]) * y1[1]);
            }
        }
        XSYNC();
        DBG_DUMP(8, bf2f(ACT[(size_t)m * DFF + c]) + bf2f(ACT[(size_t)m * DFF + 3000 + c]));
        {
            PHASE_BEGIN();
            pg8::Gemm g{ACT, Wdn, SEQ, DM, DFF, DFF, nullptr, 0.f}; pg8::StaticOrder S; S.init(SEQ, DM, G, bid);
            pg8::EpiRes E{out, out, XB, ssq_xn};
            pg8::gemm_phase<pg8::EpiRes>(L, g, S, E, wave_s);
        }
        XSYNC();
        if (DBG_STOP == 9) return;
    }
}

extern "C" void kernel_launch(void* const* d_in, const int* in_sizes, int n_in, void* d_out, int out_size, void* d_ws, size_t ws_size, hipStream_t stream) {
    static int grid = 0;
    if (grid == 0) {
        if (n_in != 20 || out_size != SEQ * DM || ws_size < WS_END) { fprintf(stderr, "kernel_launch: unexpected shapes: n_in %d out %d ws %zu (need %zu)\n", n_in, out_size, ws_size, (size_t)WS_END); grid = -1; return; }
        int dev = 0, cus = 0, per_cu = 0;
        hipGetDevice(&dev); hipDeviceGetAttribute(&cus, hipDeviceAttributeMultiprocessorCount, dev);
        hipFuncSetAttribute((const void*)mk_fwd, hipFuncAttributeMaxDynamicSharedMemorySize, LDS_BYTES);
        hipOccupancyMaxActiveBlocksPerMultiprocessor(&per_cu, (const void*)mk_fwd, 512, LDS_BYTES);
        (void)hipGetLastError();
        if (per_cu < 1) per_cu = 1;
        grid = cus * 1;
    }
    if (grid < 0) return;
    hipMemsetAsync((char*)d_ws + WS_CTL, 0, CTL_BYTES, stream);
    Args a{};
    for (int i = 0; i < 20; ++i) a.in[i] = (const float*)d_in[i];
    a.out = (float*)d_out; a.ws = (unsigned char*)d_ws;
    for (int i = 0; i < 32; ++i) a.inv_freq[i] = (float)pow(10000.0, -(double)i / 32.0);
    void* args[] = {&a};
    hipError_t e = hipLaunchCooperativeKernel((const void*)mk_fwd, dim3(grid), dim3(512), args, LDS_BYTES, stream);
    if (e != hipSuccess) fprintf(stderr, "cooperative launch failed: %s (grid %d)\n", hipGetErrorString(e), grid);
}
```

```cpp
#include <hip/hip_runtime.h>
#include <hip/hip_cooperative_groups.h>
#include <cstdio>
#include <cstdint>
#include <cmath>
namespace cg = cooperative_groups;

#define LAS __attribute__((address_space(3)))
typedef unsigned short bf16_t;
typedef unsigned long long u64;
typedef short bf16x8 __attribute__((ext_vector_type(8)));
typedef short s16x4 __attribute__((ext_vector_type(4)));
typedef float f32x4 __attribute__((ext_vector_type(4)));
typedef float f32x16 __attribute__((ext_vector_type(16)));
typedef unsigned u32x4 __attribute__((ext_vector_type(4)));
typedef unsigned u32x2 __attribute__((ext_vector_type(2)));
typedef float f32x2_t __attribute__((ext_vector_type(2)));
typedef __bf16 bf16x2_t __attribute__((ext_vector_type(2)));

constexpr int SEQ = 16384, DM = 2048, NLAYER = 2;
constexpr int IN_DIM = 3920, IN_PAD = 4096;
constexpr int C_CQ = 0, C_CKV = 512, C_KR = 768, C_GQ = 832, C_GK = 1344, C_GV = 1856, C_GA = 2880, C_GG = 2896;
constexpr int QLORA = 512, KVLORA = 256, NH = 8, QKD = 192, NOPE = 128, VD = 128, QW = NH * QKD  , KVW = NH * 256  ;
constexpr int GH = 4, GDK = 128, GDV = 256, NCHUNK = SEQ / 64;
constexpr int DFF = 5632, DFF2 = 11264;
constexpr float EPS = 1e-6f;

constexpr size_t MiB = 1u << 20;
constexpr size_t WS_CTL = 0, CTL_BYTES = 2 * MiB;
constexpr size_t WS_BAR = 0;
constexpr size_t WS_SSQ = 65536;
constexpr size_t WS_WIN = 2 * MiB, WS_WUQ = 18 * MiB, WS_WUKV = WS_WUQ + 3 * MiB / 2, WS_WOUT = WS_WUKV + 1 * MiB, WS_WUP = WS_WOUT + 8 * MiB, WS_WDN = WS_WUP + 44 * MiB;
constexpr size_t WS_XB = 95 * MiB;
constexpr size_t WS_R = 159 * MiB;
constexpr size_t WS_Z = WS_R, WS_Q = WS_Z + 128 * MiB, WS_K = WS_Q + 48 * MiB, WS_VT = WS_K + 48 * MiB, WS_ST = WS_VT + 32 * MiB, WS_DEC = WS_ST + 128 * MiB, WS_MIX = WS_DEC + 1 * MiB;
constexpr size_t WS_ACT = WS_R, WS_EDGE = WS_ACT + 176 * MiB, WS_END = WS_MIX + 64 * MiB;
static_assert(WS_EDGE + 12 * MiB <= WS_END, "ws map");

#define GAS __attribute__((address_space(1)))
template <class T> __device__ __forceinline__ GAS T* G_(T* p) { return (GAS T*)p; }
__device__ __forceinline__ int lane_id_() { unsigned z = 0u; asm volatile("" : "+v"(z)); return (int)__builtin_amdgcn_mbcnt_hi(~0u, __builtin_amdgcn_mbcnt_lo(~0u, z)); }
#define LAUNDER_V(x) asm volatile("" : "+v"(x))
#define LAUNDER_S(x) asm volatile("" : "+s"(x))
__device__ __forceinline__ unsigned f2bf(float f) { unsigned u = __builtin_bit_cast(unsigned, f); return (u + 0x7fffu + ((u >> 16) & 1u)) >> 16; }
__device__ __forceinline__ unsigned pk2(float lo, float hi) { f32x2_t v = {lo, hi}; bf16x2_t b = __builtin_convertvector(v, bf16x2_t); return __builtin_bit_cast(unsigned, b); }
__device__ __forceinline__ float bf2f(unsigned b) { return __builtin_bit_cast(float, b << 16); }
__device__ __forceinline__ float bflo(unsigned w) { return __builtin_bit_cast(float, w << 16); }
__device__ __forceinline__ float bfhi(unsigned w) { return __builtin_bit_cast(float, w & 0xffff0000u); }
__device__ __forceinline__ float wave_sum(float v) {
#pragma unroll
    for (int o = 1; o < 64; o <<= 1) v += __shfl_xor(v, o);
    return v;
}
constexpr float SSQ_FX = 1048576.0f, SSQ_INV = 1.0f / 1048576.0f;
__device__ __forceinline__ void ssq_add(u64* p, float v) { __hip_atomic_fetch_add((GAS u64*)p, (u64)(v * SSQ_FX + 0.5f), __ATOMIC_RELAXED, __HIP_MEMORY_SCOPE_AGENT); }
__device__ __forceinline__ float ssq_get(const u64* p) { return (float)(*(GAS const u64*)p) * SSQ_INV; }
__device__ __forceinline__ float silu_f(float x) { return x * __builtin_amdgcn_rcpf(1.0f + __expf(-x)); }

namespace pg8 {
constexpr int BM = 256, BK = 64, HALF = 128, HTB = HALF * BK * 2, STAGE_BYTES = 8 * HTB, NXCD = 8, WGM = 8;
__host__ __device__ __forceinline__ int lds_byte(int r, int c) { const int st = (r >> 4) * 2 + (c >> 5), rr = r & 15, cc = c & 31, ob = rr * 64 + cc * 2; return st * 1024 + (ob ^ (((ob >> 9) & 1) << 5)); }
__host__ __device__ __forceinline__ void stage_rc(int b, int& R, int& C) { const int st = b / 1024, sb = b % 1024, swz = sb ^ (((sb >> 9) & 1) << 5); R = (st >> 1) * 16 + swz / 64; C = (st & 1) * 32 + (swz % 64) / 2; }
__host__ __device__ __forceinline__ int perm32(int rho) { const int n = rho >> 4, i = rho & 15; return 8 * (i >> 2) + 4 * n + (i & 3); }

struct Unit { int pm, pn; };
struct Gemm { const bf16_t* A; const bf16_t* Bt; int M, N, K, lda; const u64* mid_ssq; float mid_inv; };

struct StaticOrder {
    int nM, nN, nwg, G, c;
    __device__ void init(int M, int N, int G_, int c_) { nM = M / BM; nN = N / BM; nwg = nM * nN; G = G_; c = c_; }
    __device__ bool next(int i, Unit& u) const {
        const long L = (long)i * G + c; if (L >= nwg) return false;
        int wgid = (int)L; { const int q = nwg / NXCD, r = nwg % NXCD, xcd = wgid % NXCD, off = wgid / NXCD; wgid = (xcd < r ? xcd * (q + 1) : r * (q + 1) + (xcd - r) * q) + off; }
        const int nig = WGM * nN, gid = wgid / nig, fm = gid * WGM, gsz = (nM - fm) < WGM ? (nM - fm) : WGM;
        u.pm = fm + ((wgid % nig) % gsz); u.pn = (wgid % nig) / gsz; return true;
    }
};

struct EpiRowScale {
    static constexpr bool PERM = true;
    bf16_t* O; int ldc; const u64* ssq_in; float inv_dim; u64* ssq_a; int a_lo, a_hi; u64* ssq_b; int b_lo, b_hi;
    __device__ __forceinline__ void operator()(const f32x4 (&acc)[2][2][4][2], const Unit& u, int wr, int wc, int fr, int fq) const {
        const int row0 = u.pm * BM + wr * 64 + fr, col0 = u.pn * BM + wc * 32 + 8 * fq;
        u64* sacc = (u.pn >= a_lo && u.pn < a_hi) ? ssq_a : ((u.pn >= b_lo && u.pn < b_hi) ? ssq_b : nullptr);
        float scv[2][4];
#pragma unroll
        for (int ai = 0; ai < 2; ++ai)
#pragma unroll
            for (int m = 0; m < 4; ++m) scv[ai][m] = ssq_in ? ssq_get(ssq_in + row0 + ai * HALF + m * 16) : 0.f;
        asm volatile("" ::: "memory");
#pragma unroll
        for (int ai = 0; ai < 2; ++ai)
#pragma unroll
            for (int m = 0; m < 4; ++m) {
                const int row = row0 + ai * HALF + m * 16;
                const float sc = ssq_in ? rsqrtf(scv[ai][m] * inv_dim + EPS) : 1.0f;
                float ss = 0.f;
#pragma unroll
                for (int bj = 0; bj < 2; ++bj) {
                    const f32x4 v0 = acc[ai][bj][m][0] * sc, v1 = acc[ai][bj][m][1] * sc;
                    ss += (v0[0] * v0[0] + v0[1] * v0[1]) + (v0[2] * v0[2] + v0[3] * v0[3]) + (v1[0] * v1[0] + v1[1] * v1[1]) + (v1[2] * v1[2] + v1[3] * v1[3]);
                    u32x4 w; w.x = pk2(v0[0], v0[1]); w.y = pk2(v0[2], v0[3]); w.z = pk2(v1[0], v1[1]); w.w = pk2(v1[2], v1[3]);
                    *(GAS u32x4*)(G_(O) + (size_t)row * ldc + col0 + bj * HALF) = w;
                }
                if (sacc) { ss += __shfl_xor(ss, 16); ss += __shfl_xor(ss, 32); if (fq == 0) ssq_add(sacc + row, ss); }
            }
    }
};
struct EpiUkv {
    static constexpr bool PERM = true;
    bf16_t* Kb; bf16_t* Vt; const u64* ssq_in; float inv_dim; const bf16_t* Z; const int* pos; const float* kn; const __attribute__((address_space(4))) float* invf; LAS float* lx;
    __device__ __forceinline__ void operator()(f32x4 (&acc)[2][2][4][2], const Unit& u, int wr, int wc, int fr, int fq) const {
        const int row0 = u.pm * BM + wr * 64 + fr, c0 = wc * 32 + 8 * fq;
        const int lt = (wr * 4 + wc) * 64 + fq * 16 + fr, rr = lt >> 1, hf = lt & 1, rrow = u.pm * BM + rr;
        GAS const bf16_t* zr = G_(Z) + (size_t)rrow * IN_PAD + C_KR + 16 * hf;
        const u32x4 ra0 = *(GAS const u32x4*)(zr), ra1 = *(GAS const u32x4*)(zr + 8), rb0 = *(GAS const u32x4*)(zr + 32), rb1 = *(GAS const u32x4*)(zr + 40);
        const float posf = (float)G_(pos)[rrow];
        float scv[2][4];
#pragma unroll
        for (int ai = 0; ai < 2; ++ai)
#pragma unroll
            for (int m = 0; m < 4; ++m) scv[ai][m] = ssq_get(ssq_in + row0 + ai * HALF + m * 16);
        asm volatile("" ::: "memory");
        float x1[16], x2[16], sk = 0.f;
#pragma unroll
        for (int jj = 0; jj < 4; ++jj) { x1[2 * jj] = bflo(ra0[jj]); x1[2 * jj + 1] = bfhi(ra0[jj]); x1[8 + 2 * jj] = bflo(ra1[jj]); x1[8 + 2 * jj + 1] = bfhi(ra1[jj]);
                                         x2[2 * jj] = bflo(rb0[jj]); x2[2 * jj + 1] = bfhi(rb0[jj]); x2[8 + 2 * jj] = bflo(rb1[jj]); x2[8 + 2 * jj + 1] = bfhi(rb1[jj]); }
#pragma unroll
        for (int j = 0; j < 16; ++j) sk += x1[j] * x1[j] + x2[j] * x2[j];
        sk += __shfl_xor(sk, 1);
        if (hf == 0) lx[1024 + rr] = sk;
#pragma unroll
        for (int ai = 0; ai < 2; ++ai)
#pragma unroll
            for (int m = 0; m < 4; ++m) {
                const float sc = rsqrtf(scv[ai][m] * inv_dim + EPS);
#pragma unroll
                for (int bj = 0; bj < 2; ++bj)
#pragma unroll
                    for (int n = 0; n < 2; ++n) acc[ai][bj][m][n] = acc[ai][bj][m][n] * sc;
                const f32x4 v0 = acc[ai][0][m][0], v1 = acc[ai][0][m][1];
                float ss = (v0[0] * v0[0] + v0[1] * v0[1]) + (v0[2] * v0[2] + v0[3] * v0[3]) + (v1[0] * v1[0] + v1[1] * v1[1]) + (v1[2] * v1[2] + v1[3] * v1[3]);
                ss += __shfl_xor(ss, 16); ss += __shfl_xor(ss, 32);
                if (fq == 0) lx[(ai * HALF + wr * 64 + m * 16 + fr) * 4 + wc] = ss;
            }
        asm volatile("s_waitcnt lgkmcnt(0)" ::: "memory"); __builtin_amdgcn_s_barrier(); asm volatile("" ::: "memory");
        const f32x4 g0 = *(GAS const f32x4*)(G_(kn) + c0), g1 = *(GAS const f32x4*)(G_(kn) + c0 + 4);
#pragma unroll
        for (int ai = 0; ai < 2; ++ai)
#pragma unroll
            for (int m = 0; m < 4; ++m) {
                const int rt = ai * HALF + wr * 64 + m * 16 + fr, row = u.pm * BM + rt;
                const int prow = (row & ~15) | (row & 3) | ((row & 4) << 1) | ((row & 8) >> 1);
                const f32x4 pp = *(const LAS f32x4*)(lx + rt * 4);
                const float rk = rsqrtf(((pp[0] + pp[1]) + (pp[2] + pp[3]) + lx[1024 + rt]) * (1.0f / QKD) + EPS);
                { const f32x4 v0 = acc[ai][0][m][0] * rk * g0, v1 = acc[ai][0][m][1] * rk * g1;
                  u32x4 w; w.x = pk2(v0[0], v0[1]); w.y = pk2(v0[2], v0[3]); w.z = pk2(v1[0], v1[1]); w.w = pk2(v1[2], v1[3]);
                  *(GAS u32x4*)(G_(Kb) + (size_t)row * QW + u.pn * QKD + c0) = w; }
#pragma unroll
                for (int n = 0; n < 2; ++n)
#pragma unroll
                    for (int j = 0; j < 4; ++j) G_(Vt)[(size_t)(u.pn * VD + c0 + 4 * n + j) * SEQ + prow] = (bf16_t)f2bf(acc[ai][1][m][n][j]);
            }
        {
            const f32x4 pp = *(const LAS f32x4*)(lx + rr * 4);
            const float rk = rsqrtf(((pp[0] + pp[1]) + (pp[2] + pp[3]) + lx[1024 + rr]) * (1.0f / QKD) + EPS);
            GAS const float* g1p = G_(kn) + 128 + 16 * hf; GAS const float* g2p = G_(kn) + 160 + 16 * hf;
            float y1[16], y2[16];
#pragma unroll
            for (int j = 0; j < 16; ++j) {
                const float ang = posf * invf[16 * hf + j];
                double rev = (double)ang * 0.15915494309189535; rev -= __builtin_rint(rev);
                const float sn = __builtin_amdgcn_sinf((float)rev), cs = __builtin_amdgcn_cosf((float)rev);
                const float n1 = x1[j] * rk * g1p[j], n2 = x2[j] * rk * g2p[j];
                y1[j] = n1 * cs - n2 * sn; y2[j] = n2 * cs + n1 * sn;
            }
            GAS bf16_t* kp = G_(Kb) + (size_t)rrow * QW + u.pn * QKD + 128 + 16 * hf;
            *(GAS u32x4*)(kp) = (u32x4){pk2(y1[0], y1[1]), pk2(y1[2], y1[3]), pk2(y1[4], y1[5]), pk2(y1[6], y1[7])};
            *(GAS u32x4*)(kp + 8) = (u32x4){pk2(y1[8], y1[9]), pk2(y1[10], y1[11]), pk2(y1[12], y1[13]), pk2(y1[14], y1[15])};
            *(GAS u32x4*)(kp + 32) = (u32x4){pk2(y2[0], y2[1]), pk2(y2[2], y2[3]), pk2(y2[4], y2[5]), pk2(y2[6], y2[7])};
            *(GAS u32x4*)(kp + 40) = (u32x4){pk2(y2[8], y2[9]), pk2(y2[10], y2[11]), pk2(y2[12], y2[13]), pk2(y2[14], y2[15])};
        }
    }
};
struct EpiRes {
    static constexpr bool PERM = true;
    const float* base; float* out; bf16_t* xb; u64* ssq_out;
    __device__ __forceinline__ void operator()(const f32x4 (&acc)[2][2][4][2], const Unit& u, int wr, int wc, int fr, int fq) const {
        const int row0 = u.pm * BM + wr * 64 + fr, col0 = u.pn * BM + wc * 32 + 8 * fq;
#pragma unroll
        for (int ai = 0; ai < 2; ++ai) {
            f32x4 bv[4][2][2];
#pragma unroll
            for (int m = 0; m < 4; ++m)
#pragma unroll
                for (int bj = 0; bj < 2; ++bj) { const size_t off = (size_t)(row0 + ai * HALF + m * 16) * DM + col0 + bj * HALF;
                    bv[m][bj][0] = *(GAS const f32x4*)(G_(base) + off); bv[m][bj][1] = *(GAS const f32x4*)(G_(base) + off + 4); }
            asm volatile("" ::: "memory");
#pragma unroll
            for (int m = 0; m < 4; ++m) {
                const int row = row0 + ai * HALF + m * 16; float ss = 0.f;
#pragma unroll
                for (int bj = 0; bj < 2; ++bj) {
                    const size_t off = (size_t)row * DM + col0 + bj * HALF;
                    const f32x4 v0 = acc[ai][bj][m][0] + bv[m][bj][0], v1 = acc[ai][bj][m][1] + bv[m][bj][1];
                    ss += (v0[0] * v0[0] + v0[1] * v0[1]) + (v0[2] * v0[2] + v0[3] * v0[3]) + (v1[0] * v1[0] + v1[1] * v1[1]) + (v1[2] * v1[2] + v1[3] * v1[3]);
                    *(GAS f32x4*)(G_(out) + off) = v0; *(GAS f32x4*)(G_(out) + off + 4) = v1;
                    u32x4 w; w.x = pk2(v0[0], v0[1]); w.y = pk2(v0[2], v0[3]); w.z = pk2(v1[0], v1[1]); w.w = pk2(v1[2], v1[3]);
                    *(GAS u32x4*)(G_(xb) + off) = w;
                }
                ss += __shfl_xor(ss, 16); ss += __shfl_xor(ss, 32); if (fq == 0) ssq_add(ssq_out + row, ss);
            }
        }
    }
};


#define DPP_SHR1(old, src) __builtin_bit_cast(float, __builtin_amdgcn_update_dpp(__builtin_bit_cast(int, (float)(old)), __builtin_bit_cast(int, (float)(src)), 0x111, 0xf, 0xf, false))
#define DPP_SHR2(old, src) __builtin_bit_cast(float, __builtin_amdgcn_update_dpp(__builtin_bit_cast(int, (float)(old)), __builtin_bit_cast(int, (float)(src)), 0x112, 0xf, 0xf, false))
#define DPP_ROR1(src) __builtin_bit_cast(float, __builtin_amdgcn_update_dpp(0, __builtin_bit_cast(int, (float)(src)), 0x121, 0xf, 0xf, false))
#define DPP_ROR2(src) __builtin_bit_cast(float, __builtin_amdgcn_update_dpp(0, __builtin_bit_cast(int, (float)(src)), 0x122, 0xf, 0xf, false))
struct EpiUpConv {
    static constexpr bool PERM = true;
    bf16_t* ACT; float* EDGE; const u64* ssq_in; const float* cw; const float* cb; LAS float* halo;
    __device__ __forceinline__ void operator()(f32x4 (&acc)[2][2][4][2], const Unit& u, int wr, int wc, int fr, int fq) const {
        const int row0 = u.pm * BM + wr * 64 + fr;
        const int g0 = u.pn * 128 + wc * 32 + 8 * fq;
#pragma unroll
        for (int ai = 0; ai < 2; ++ai)
#pragma unroll
            for (int m = 0; m < 4; ++m) {
                const float sc = rsqrtf(ssq_get(ssq_in + row0 + ai * HALF + m * 16) * (1.0f / DM) + EPS);
#pragma unroll
                for (int bj = 0; bj < 2; ++bj)
#pragma unroll
                    for (int n = 0; n < 2; ++n) acc[ai][bj][m][n] = acc[ai][bj][m][n] * sc;
            }
        if (fr >= 14) {
#pragma unroll
            for (int ai = 0; ai < 2; ++ai) { LAS float* hp = halo + ((((2 * ai + wr) * 4 + wc) * 2 + (fr - 14)) * 4 + fq) * 16;
#pragma unroll
                for (int bj = 0; bj < 2; ++bj)
#pragma unroll
                    for (int n = 0; n < 2; ++n) *(LAS f32x4*)(hp + bj * 8 + n * 4) = acc[ai][bj][3][n]; }
            if (wr == 1) { GAS float* ep = G_(EDGE) + (size_t)(u.pm * 4 + 2 + fr - 14) * DFF2 + g0;
#pragma unroll
                for (int bj = 0; bj < 2; ++bj)
#pragma unroll
                    for (int n = 0; n < 2; ++n) *(GAS f32x4*)(ep + bj * DFF + 4 * n) = acc[1][bj][3][n]; }
        }
        if (fr < 2 && wr == 0) { GAS float* ep = G_(EDGE) + (size_t)(u.pm * 4 + fr) * DFF2 + g0;
#pragma unroll
            for (int bj = 0; bj < 2; ++bj)
#pragma unroll
                for (int n = 0; n < 2; ++n) *(GAS f32x4*)(ep + bj * DFF + 4 * n) = acc[0][bj][0][n]; }
        asm volatile("s_waitcnt lgkmcnt(0)" ::: "memory"); __builtin_amdgcn_s_barrier(); asm volatile("" ::: "memory");
#pragma unroll
        for (int n = 0; n < 2; ++n) {
            const int gc = g0 + 4 * n;
            GAS const float* cwg = G_(cw); GAS const float* cbg = G_(cb);
            const f32x4 wg0 = *(GAS const f32x4*)(cwg + gc), wg1 = *(GAS const f32x4*)(cwg + DFF2 + gc), wg2 = *(GAS const f32x4*)(cwg + 2 * DFF2 + gc), bgv = *(GAS const f32x4*)(cbg + gc);
            const f32x4 wu0 = *(GAS const f32x4*)(cwg + DFF + gc), wu1 = *(GAS const f32x4*)(cwg + DFF2 + DFF + gc), wu2 = *(GAS const f32x4*)(cwg + 2 * DFF2 + DFF + gc), buv = *(GAS const f32x4*)(cbg + DFF + gc);
#pragma unroll
            for (int ai = 0; ai < 2; ++ai) {
                const int band = 2 * ai + wr;
                f32x4 pg = (f32x4){0.f, 0.f, 0.f, 0.f}, pu = pg;
                if (band > 0) { const LAS float* hp = halo + ((((band - 1) * 4 + wc) * 2 + (fr & 1)) * 4 + fq) * 16; pg = *(const LAS f32x4*)(hp + n * 4); pu = *(const LAS f32x4*)(hp + 8 + n * 4); }
#pragma unroll
                for (int m = 0; m < 4; ++m) {
                    const f32x4 cg = acc[ai][0][m][n], cu = acc[ai][1][m][n];
                    float av[4];
#pragma unroll
                    for (int j = 0; j < 4; ++j) {
                        const float g1 = DPP_SHR1(DPP_ROR1(pg[j]), cg[j]), g2 = DPP_SHR2(DPP_ROR2(pg[j]), cg[j]);
                        const float u1 = DPP_SHR1(DPP_ROR1(pu[j]), cu[j]), u2 = DPP_SHR2(DPP_ROR2(pu[j]), cu[j]);
                        const float yg = bgv[j] + wg0[j] * g2 + wg1[j] * g1 + wg2[j] * cg[j];
                        const float yu = buv[j] + wu0[j] * u2 + wu1[j] * u1 + wu2[j] * cu[j];
                        av[j] = silu_f(yg) * yu;
                    }
                    *(GAS u32x2*)(G_(ACT) + (size_t)(row0 + ai * HALF + m * 16) * DFF + gc) = (u32x2){pk2(av[0], av[1]), pk2(av[2], av[3])};
                    pg = cg; pu = cu;
                }
            }
        }
    }
};

template <class Epi, bool MIDSCALE = false>
__device__ __forceinline__ void gemm_phase(LAS unsigned char* lds, const Gemm g, const StaticOrder& S, const Epi& E, int wv) {
    int tid_ = wv * 64 + lane_id_(); LAUNDER_V(tid_);
    const int tid = tid_, wid = __builtin_amdgcn_readfirstlane(tid >> 6), lane = tid & 63, wr = wid >> 2, wc = wid & 3, fr = lane & 15, fq = lane >> 4;
    const int K = g.K, nt = K / BK;
    unsigned voffA[2], voffB[2];
#pragma unroll
    for (int i = 0; i < 2; ++i) { int R, C; stage_rc(tid * 16 + i * 8192, R, C); const int Rb = Epi::PERM ? ((R & ~31) + perm32(R & 31)) : R;
        voffA[i] = (unsigned)(R * g.lda + C) * 2u; voffB[i] = (unsigned)(Rb * K + C) * 2u; }
    const size_t kstep = (size_t)(BK * 2);
    const size_t hstepA = (size_t)HALF * g.lda * 2, hstepB = (size_t)HALF * K * 2;
    const size_t tstepA = 2 * hstepA, tstepB = 2 * hstepB;
    const unsigned ldsw = (unsigned)wid * 1024u;
    const int aoff = lds_byte(wr * 64 + fr, fq * 8), boff = lds_byte(wc * 32 + fr, fq * 8);
#define PG8_SA(b, h) (((b) * 2 + (h)) * HTB)
#define PG8_SB(b, h) ((4 + (b) * 2 + (h)) * HTB)
#define PG8_STAGE(bufoff, gbase, voff) do { _Pragma("unroll") for (int _i = 0; _i < 2; ++_i) \
        __builtin_amdgcn_global_load_lds((const unsigned*)((const char*)(gbase) + (voff)[_i]), (LAS unsigned*)(lds + (bufoff) + ldsw + _i * 8192), 16, 0, 0); } while (0)
#define PG8_LDA(dst, b, h) do { _Pragma("unroll") for (int m = 0; m < 4; ++m) _Pragma("unroll") for (int k = 0; k < 2; ++k) dst[m][k] = *(const LAS bf16x8*)(lds + PG8_SA(b, h) + aoff + m * 2048 + k * 1024); } while (0)
#define PG8_LDB(dst, b, h) do { _Pragma("unroll") for (int n = 0; n < 2; ++n) _Pragma("unroll") for (int k = 0; k < 2; ++k) dst[n][k] = *(const LAS bf16x8*)(lds + PG8_SB(b, h) + boff + n * 2048 + k * 1024); } while (0)
#define PG8_MMA(ai, bj, At, Bt) do { __builtin_amdgcn_s_setprio(1); _Pragma("unroll") for (int m = 0; m < 4; ++m) _Pragma("unroll") for (int n = 0; n < 2; ++n) _Pragma("unroll") for (int k = 0; k < 2; ++k) \
        acc[ai][bj][m][n] = __builtin_amdgcn_mfma_f32_16x16x32_bf16(Bt[n][k], At[m][k], acc[ai][bj][m][n], 0, 0, 0); __builtin_amdgcn_s_setprio(0); } while (0)
#define PG8_WAIT_V(n) asm volatile("s_waitcnt vmcnt(" #n ")" ::: "memory")
#define PG8_WAIT_L(n) asm volatile("s_waitcnt lgkmcnt(" #n ")" ::: "memory")
#define PG8_BAR __builtin_amdgcn_s_barrier()
#define PG8_SCHED __builtin_amdgcn_sched_barrier(0)
    Unit cur, nxt; int ui = 0;
    if (!S.next(0, cur)) return;
    f32x4 acc[2][2][4][2];
#pragma unroll
    for (int a = 0; a < 2; ++a)
#pragma unroll
        for (int b = 0; b < 2; ++b)
#pragma unroll
            for (int m = 0; m < 4; ++m)
#pragma unroll
                for (int n = 0; n < 2; ++n) acc[a][b][m][n] = (f32x4){0.f, 0.f, 0.f, 0.f};
    bf16x8 At[4][2], B0[2][2], B1[2][2];
    const char* cA = (const char*)g.A + (size_t)cur.pm * tstepA; const char* cB = (const char*)g.Bt + (size_t)cur.pn * tstepB;
    PG8_STAGE(PG8_SB(0, 0), cB, voffB); PG8_STAGE(PG8_SB(0, 1), cB + hstepB, voffB); PG8_STAGE(PG8_SA(0, 0), cA, voffA); PG8_STAGE(PG8_SA(0, 1), cA + hstepA, voffA);
    if (wr == 1) PG8_BAR;
    PG8_WAIT_V(2); PG8_BAR;
    PG8_STAGE(PG8_SB(1, 0), cB + kstep, voffB); PG8_STAGE(PG8_SA(1, 0), cA + kstep, voffA); PG8_STAGE(PG8_SB(1, 1), cB + hstepB + kstep, voffB);
    PG8_WAIT_V(6); PG8_BAR;
    for (;;) {
        const bool has_next = S.next(ui + 1, nxt);
        const char* nA = has_next ? (const char*)g.A + (size_t)nxt.pm * tstepA : cA; const char* nB = has_next ? (const char*)g.Bt + (size_t)nxt.pn * tstepB : cB;
        for (int t = 0; t < nt; t += 2) {
            const bool last = (t == nt - 2);
            const char* a1 = cA + (size_t)(t + 1) * kstep;
            const char* a2 = last ? nA : cA + (size_t)(t + 2) * kstep; const char* b2 = last ? nB : cB + (size_t)(t + 2) * kstep;
            const char* a3 = a2 + kstep; const char* b3 = b2 + kstep;
            if constexpr (MIDSCALE) { if (t == nt / 2) {
#pragma unroll
                for (int ai = 0; ai < 2; ++ai)
#pragma unroll
                    for (int m = 0; m < 4; ++m) { const float sc = rsqrtf(ssq_get(g.mid_ssq + cur.pm * BM + ai * HALF + wr * 64 + m * 16 + fr) * g.mid_inv + EPS);
#pragma unroll
                        for (int bj = 0; bj < 2; ++bj)
#pragma unroll
                            for (int n = 0; n < 2; ++n) acc[ai][bj][m][n] = acc[ai][bj][m][n] * sc; } } }
            PG8_LDB(B0, 0, 0); PG8_LDB(B1, 0, 1); PG8_SCHED; PG8_LDA(At, 0, 0); PG8_STAGE(PG8_SA(1, 1), a1 + hstepA, voffA);
            PG8_WAIT_V(8); PG8_WAIT_L(0); PG8_BAR; PG8_MMA(0, 0, At, B0); PG8_MMA(0, 1, At, B1); PG8_BAR; PG8_SCHED;
            PG8_LDA(At, 0, 1); PG8_STAGE(PG8_SB(0, 0), b2, voffB); PG8_STAGE(PG8_SB(0, 1), b2 + hstepB, voffB); PG8_STAGE(PG8_SA(0, 0), a2, voffA);
            PG8_WAIT_V(8); PG8_WAIT_L(0); PG8_BAR; PG8_MMA(1, 0, At, B0); PG8_MMA(1, 1, At, B1); PG8_BAR; PG8_SCHED;
            PG8_LDB(B0, 1, 0); PG8_LDB(B1, 1, 1); PG8_SCHED; PG8_LDA(At, 1, 0); PG8_STAGE(PG8_SA(0, 1), a2 + hstepA, voffA);
            PG8_WAIT_V(8); PG8_WAIT_L(0); PG8_BAR; PG8_MMA(0, 0, At, B0); PG8_MMA(0, 1, At, B1); PG8_BAR; PG8_SCHED;
            PG8_LDA(At, 1, 1); PG8_STAGE(PG8_SB(1, 0), b3, voffB); PG8_STAGE(PG8_SB(1, 1), b3 + hstepB, voffB); PG8_STAGE(PG8_SA(1, 0), a3, voffA);
            PG8_WAIT_V(8); PG8_WAIT_L(0); PG8_BAR; PG8_MMA(1, 0, At, B0); PG8_MMA(1, 1, At, B1); PG8_BAR; PG8_SCHED;
        }
        if (wr == 0) PG8_BAR;
        { int frE = fr, fqE = fq; LAUNDER_V(frE); LAUNDER_V(fqE); E(acc, cur, wr, wc, frE, fqE); }
        if (!has_next) break;
#pragma unroll
        for (int a = 0; a < 2; ++a)
#pragma unroll
            for (int b = 0; b < 2; ++b)
#pragma unroll
                for (int m = 0; m < 4; ++m)
#pragma unroll
                    for (int n = 0; n < 2; ++n) acc[a][b][m][n] = (f32x4){0.f, 0.f, 0.f, 0.f};
        cur = nxt; cA = nA; cB = nB; ++ui;
        if (wr == 1) PG8_BAR;
    }
    PG8_WAIT_V(0);
    PG8_BAR;
#undef PG8_SA
#undef PG8_SB
#undef PG8_STAGE
#undef PG8_LDA
#undef PG8_LDB
#undef PG8_MMA
#undef PG8_WAIT_V
#undef PG8_WAIT_L
#undef PG8_BAR
#undef PG8_SCHED
}
}

constexpr int RING_BYTES = 131072;
constexpr int LDS_BYTES = 147456;

struct Args { const float* in[20]; float* out; unsigned char* ws; float inv_freq[32]; };
typedef const __attribute__((address_space(4))) Args* KAP_T;

#define DS_READ4(r0, r1, r2, r3, addr, o0, o1, o2, o3) asm volatile("ds_read_b128 %0, %4 offset:%5\n\tds_read_b128 %1, %4 offset:%6\n\tds_read_b128 %2, %4 offset:%7\n\tds_read_b128 %3, %4 offset:%8" \
    : "=&v"(r0), "=&v"(r1), "=&v"(r2), "=&v"(r3) : "v"(addr), "i"(o0), "i"(o1), "i"(o2), "i"(o3) : "memory")
#define LGKM_WAIT4(n, r0, r1, r2, r3) asm volatile("s_waitcnt lgkmcnt(" #n ")" : "+v"(r0), "+v"(r1), "+v"(r2), "+v"(r3) :: "memory")
#define MFMA32(a, b, c) __builtin_amdgcn_mfma_f32_32x32x16_bf16((a), (b), (c), 0, 0, 0)
__device__ __forceinline__ int crow(int r, int hi) { return (r & 3) + 8 * (r >> 2) + 4 * hi; }

__device__ __forceinline__ void wt_item(const float* __restrict__ W, int K, int N, const float* __restrict__ gain, int gainK, bf16_t* WT, LAS float* scr, int item, int nblk, int lane, bool remap_up = false) {
    const int kb = item / nblk, nb = item % nblk, k0 = 64 * kb, n0 = 32 * nb;
    const int ns0 = remap_up ? (((n0 & 255) < 128) ? 128 * (n0 >> 8) + (n0 & 255) : DFF + 128 * (n0 >> 8) + (n0 & 255) - 128) : n0;
    const int n = ns0 + (lane & 31);
    float wv[32];
#pragma unroll
    for (int i = 0; i < 32; ++i) { const int kk = 2 * i + (lane >> 5); wv[i] = (n < N) ? G_(W)[(size_t)(k0 + kk) * N + n] : 0.f; }
#pragma unroll
    for (int i = 0; i < 32; ++i) { const int kk = 2 * i + (lane >> 5); scr[kk * 33 + (lane & 31)] = wv[i]; }
    asm volatile("s_waitcnt lgkmcnt(0)" ::: "memory");
    const int c = lane & 7;
    f32x4 g0 = (f32x4){1.f, 1.f, 1.f, 1.f}, g1 = g0;
    if (k0 < gainK) { g0 = *(GAS const f32x4*)(G_(gain) + k0 + 8 * c); g1 = *(GAS const f32x4*)(G_(gain) + k0 + 8 * c + 4); }
#pragma unroll
    for (int j = 0; j < 4; ++j) { const int nn = (lane >> 3) + 8 * j; const LAS float* s = scr + (8 * c) * 33 + nn;
        u32x4 o; o.x = pk2(s[0 * 33] * g0[0], s[1 * 33] * g0[1]); o.y = pk2(s[2 * 33] * g0[2], s[3 * 33] * g0[3]); o.z = pk2(s[4 * 33] * g1[0], s[5 * 33] * g1[1]); o.w = pk2(s[6 * 33] * g1[2], s[7 * 33] * g1[3]);
        *(GAS u32x4*)(G_(WT) + (size_t)(n0 + nn) * K + k0 + 8 * c) = o; }
    asm volatile("s_waitcnt lgkmcnt(0)" ::: "memory");
}

constexpr int AT_KB = 3 * 8192, AT_VB = 16384, AT_NBUF = 3, AT_BUF = AT_KB + AT_VB  , AT_WSF = AT_NBUF * AT_BUF;
static_assert(AT_WSF + 8 * 128 <= RING_BYTES, "attn lds");
#define DS_READ4X(r0, r1, r2, r3, a0, a1, a2, a3, o0, o1, o2, o3) asm volatile("ds_read_b128 %0, %4 offset:%8\n\tds_read_b128 %1, %5 offset:%9\n\tds_read_b128 %2, %6 offset:%10\n\tds_read_b128 %3, %7 offset:%11" \
    : "=&v"(r0), "=&v"(r1), "=&v"(r2), "=&v"(r3) : "v"(a0), "v"(a1), "v"(a2), "v"(a3), "i"(o0), "i"(o1), "i"(o2), "i"(o3) : "memory")

__device__ __forceinline__ void attn_unit(LAS unsigned char* L, const bf16_t* Q_, const bf16_t* Kg_, const bf16_t* Vt_, bf16_t* mix_, u64* ssq_a, int h, int qb, int wv, const int* pos_, const float* qn_, KAP_T kap) {
    GAS const bf16_t* Q = G_(Q_); GAS const bf16_t* Kg = G_(Kg_); GAS const bf16_t* Vt = G_(Vt_); GAS bf16_t* mix = G_(mix_);
    int tid_ = wv * 64 + lane_id_(); LAUNDER_V(tid_);
    const int tid = tid_, lane = tid & 63, w = __builtin_amdgcn_readfirstlane(tid >> 6), r32 = lane & 31, hh = lane >> 5;
    const int q0 = qb * 256;
    bf16x8 qf[12];
    {
        const int qrow_i = q0 + 32 * w + r32;
        GAS const bf16_t* qrow = Q + (size_t)qrow_i * QW + h * QKD + 8 * hh;
        u32x4 raw[12];
#pragma unroll
        for (int ks = 0; ks < 12; ++ks) raw[ks] = *(GAS const u32x4*)(qrow + 16 * ks);
        const float posf = (float)G_(pos_)[qrow_i];
        float ss = 0.f;
#pragma unroll
        for (int ks = 0; ks < 12; ++ks)
#pragma unroll
            for (int jj = 0; jj < 4; ++jj) { const float lo = bflo(raw[ks][jj]), hi = bfhi(raw[ks][jj]); ss += lo * lo + hi * hi; }
        ss += __shfl_xor(ss, 32);
        const float rs = rsqrtf(ss * (1.0f / QKD) + EPS) * (0.07216878364870322f * 1.4426950408889634f);
        GAS const float* qn = G_(qn_) + 8 * hh;
#pragma unroll
        for (int ks = 0; ks < 8; ++ks) { const f32x4 g0 = *(GAS const f32x4*)(qn + 16 * ks), g1 = *(GAS const f32x4*)(qn + 16 * ks + 4);
            u32x4 o_; o_.x = pk2(bflo(raw[ks].x) * rs * g0[0], bfhi(raw[ks].x) * rs * g0[1]); o_.y = pk2(bflo(raw[ks].y) * rs * g0[2], bfhi(raw[ks].y) * rs * g0[3]);
            o_.z = pk2(bflo(raw[ks].z) * rs * g1[0], bfhi(raw[ks].z) * rs * g1[1]); o_.w = pk2(bflo(raw[ks].w) * rs * g1[2], bfhi(raw[ks].w) * rs * g1[3]);
            qf[ks] = __builtin_bit_cast(bf16x8, o_); }
#pragma unroll
        for (int a = 0; a < 2; ++a) {
            const f32x4 ga0 = *(GAS const f32x4*)(qn + 16 * (8 + a)), ga1 = *(GAS const f32x4*)(qn + 16 * (8 + a) + 4), gb0 = *(GAS const f32x4*)(qn + 16 * (10 + a)), gb1 = *(GAS const f32x4*)(qn + 16 * (10 + a) + 4);
            float x1[8], x2[8], y1[8], y2[8];
#pragma unroll
            for (int jj = 0; jj < 4; ++jj) { x1[2 * jj] = bflo(raw[8 + a][jj]); x1[2 * jj + 1] = bfhi(raw[8 + a][jj]); x2[2 * jj] = bflo(raw[10 + a][jj]); x2[2 * jj + 1] = bfhi(raw[10 + a][jj]); }
#pragma unroll
            for (int j = 0; j < 8; ++j) {
                const float ang = posf * kap->inv_freq[16 * a + 8 * hh + j];
                double rev = (double)ang * 0.15915494309189535; rev -= __builtin_rint(rev);
                const float sn = __builtin_amdgcn_sinf((float)rev), cs = __builtin_amdgcn_cosf((float)rev);
                const float n1 = x1[j] * rs * (j < 4 ? ga0[j & 3] : ga1[j & 3]), n2 = x2[j] * rs * (j < 4 ? gb0[j & 3] : gb1[j & 3]);
                y1[j] = n1 * cs - n2 * sn; y2[j] = n2 * cs + n1 * sn;
            }
            qf[8 + a] = __builtin_bit_cast(bf16x8, (u32x4){pk2(y1[0], y1[1]), pk2(y1[2], y1[3]), pk2(y1[4], y1[5]), pk2(y1[6], y1[7])});
            qf[10 + a] = __builtin_bit_cast(bf16x8, (u32x4){pk2(y2[0], y2[1]), pk2(y2[2], y2[3]), pk2(y2[4], y2[5]), pk2(y2[6], y2[7])});
        }
    }
    f32x16 o[4];
#pragma unroll
    for (int d = 0; d < 4; ++d)
#pragma unroll
        for (int i = 0; i < 16; ++i) o[d][i] = 0.f;
    float l_run = 0.f;
    const int NT = 4 * qb + 4, my_last = 4 * qb + (w >> 1);
    volatile LAS float* wsf = (volatile LAS float*)(L + AT_WSF) + w * 32;
    const unsigned lds_base = (unsigned)(uintptr_t)L;
#define AT_FOFF(j, lz, bo) (lds_base + (bo) + (unsigned)((((lz) & 31) >> 1) * 256 + ((((((lz) & 31) & 1) * 8) + 2 * (j) + ((lz) >> 5)) ^ ((((lz) & 31) >> 1) & 7)) * 16))
    const int du = 4 * w + (lane >> 4), dsl = lane & 15, drb = dsl >> 3, dc = (dsl & 7) ^ (du & 7);
    GAS const bf16_t* ksrc = Kg + (size_t)(2 * du + drb) * QW + h * QKD + dc * 8;
    GAS const bf16_t* vsrc = Vt + (size_t)(h * VD + 2 * du + drb) * SEQ + dc * 8;
#define AT_DMA(t, bi) do { const int kv0_ = (t) * 64; \
    _Pragma("unroll") for (int i = 0; i < 3; ++i) __builtin_amdgcn_global_load_lds((const unsigned*)(ksrc + (size_t)kv0_ * QW + i * 64), (LAS unsigned*)(L + (bi) * AT_BUF + (8 * i + w) * 1024), 16, 0, 0); \
    _Pragma("unroll") for (int i = 0; i < 2; ++i) __builtin_amdgcn_global_load_lds((const unsigned*)(vsrc + (size_t)i * 64 * SEQ + kv0_), (LAS unsigned*)(L + (bi) * AT_BUF + AT_KB + (8 * i + w) * 1024), 16, 0, 0); } while (0)
    AT_DMA(0, 0); AT_DMA(1, 1);
    asm volatile("s_waitcnt vmcnt(5)" ::: "memory"); __builtin_amdgcn_s_barrier(); asm volatile("" ::: "memory");
    int bcur = 0, bnx2 = 2;
    for (int t = 0; t < NT; ++t) {
        if (t + 2 < NT) AT_DMA(t + 2, bnx2);
        if (t <= my_last) {
            int lz_ = lane; LAUNDER_V(lz_); const unsigned bo_ = (unsigned)bcur * AT_BUF;
            const unsigned ka0 = AT_FOFF(0, lz_, bo_), ka1 = AT_FOFF(1, lz_, bo_), ka2 = AT_FOFF(2, lz_, bo_), ka3 = AT_FOFF(3, lz_, bo_);
            f32x16 p0, p1;
#pragma unroll
            for (int i = 0; i < 16; ++i) { p0[i] = 0.f; p1[i] = 0.f; }
            bf16x8 fa0, fa1, fa2, fa3, fb0, fb1, fb2, fb3, fc0, fc1, fc2, fc3;
#define QK_RD(s0, s1, s2, s3, kb, g) DS_READ4X(s0, s1, s2, s3, ka0, ka1, ka2, ka3, (g) * 8192 + (kb) * 4096, (g) * 8192 + (kb) * 4096, (g) * 8192 + (kb) * 4096, (g) * 8192 + (kb) * 4096)
#define QK_MM(s0, s1, s2, s3, P, g) do { P = MFMA32(s0, qf[4 * (g)], P); P = MFMA32(s1, qf[4 * (g) + 1], P); P = MFMA32(s2, qf[4 * (g) + 2], P); P = MFMA32(s3, qf[4 * (g) + 3], P); } while (0)
#define PV_RD(s0, s1, s2, s3, va) DS_READ4(s0, s1, s2, s3, va, AT_KB, AT_KB + 4096, AT_KB + 8192, AT_KB + 12288)
#define PV_PK(P, ss) __builtin_bit_cast(bf16x8, (u32x4){pk2(P[8 * (ss) + 0], P[8 * (ss) + 1]), pk2(P[8 * (ss) + 2], P[8 * (ss) + 3]), pk2(P[8 * (ss) + 4], P[8 * (ss) + 5]), pk2(P[8 * (ss) + 6], P[8 * (ss) + 7])})
#define PV_MM(s0, s1, s2, s3, xs) do { o[0] = MFMA32(xs, s0, o[0]); o[1] = MFMA32(xs, s1, o[1]); o[2] = MFMA32(xs, s2, o[2]); o[3] = MFMA32(xs, s3, o[3]); } while (0)
            QK_RD(fa0, fa1, fa2, fa3, 0, 0);
            QK_RD(fb0, fb1, fb2, fb3, 0, 1);
            QK_RD(fc0, fc1, fc2, fc3, 0, 2); LGKM_WAIT4(8, fa0, fa1, fa2, fa3); QK_MM(fa0, fa1, fa2, fa3, p0, 0);
            QK_RD(fa0, fa1, fa2, fa3, 1, 0); LGKM_WAIT4(8, fb0, fb1, fb2, fb3); QK_MM(fb0, fb1, fb2, fb3, p0, 1);
            QK_RD(fb0, fb1, fb2, fb3, 1, 1); LGKM_WAIT4(8, fc0, fc1, fc2, fc3); QK_MM(fc0, fc1, fc2, fc3, p0, 2);
            float ls0 = 0.f, ls1 = 0.f;
#pragma unroll
            for (int i = 0; i < 16; ++i) { p0[i] = __builtin_amdgcn_exp2f(__builtin_amdgcn_fmed3f(p0[i], -1000.f, 100.f)); ls0 += p0[i]; }
            QK_RD(fc0, fc1, fc2, fc3, 1, 2); LGKM_WAIT4(8, fa0, fa1, fa2, fa3); QK_MM(fa0, fa1, fa2, fa3, p1, 0);
            PV_RD(fa0, fa1, fa2, fa3, ka0);  LGKM_WAIT4(8, fb0, fb1, fb2, fb3); QK_MM(fb0, fb1, fb2, fb3, p1, 1);
            PV_RD(fb0, fb1, fb2, fb3, ka1);  LGKM_WAIT4(8, fc0, fc1, fc2, fc3); QK_MM(fc0, fc1, fc2, fc3, p1, 2);
            { const bf16x8 x00 = PV_PK(p0, 0), x01 = PV_PK(p0, 1);
#pragma unroll
              for (int i = 0; i < 16; ++i) { p1[i] = __builtin_amdgcn_exp2f(__builtin_amdgcn_fmed3f(p1[i], -1000.f, 100.f)); ls1 += p1[i]; }
              PV_RD(fc0, fc1, fc2, fc3, ka2); LGKM_WAIT4(8, fa0, fa1, fa2, fa3); PV_MM(fa0, fa1, fa2, fa3, x00);
              PV_RD(fa0, fa1, fa2, fa3, ka3); LGKM_WAIT4(8, fb0, fb1, fb2, fb3); PV_MM(fb0, fb1, fb2, fb3, x01);
              const bf16x8 x10 = PV_PK(p1, 0), x11 = PV_PK(p1, 1);
              LGKM_WAIT4(4, fc0, fc1, fc2, fc3); PV_MM(fc0, fc1, fc2, fc3, x10);
              LGKM_WAIT4(0, fa0, fa1, fa2, fa3); PV_MM(fa0, fa1, fa2, fa3, x11); }
            l_run += ls0 + ls1;
#undef QK_RD
#undef QK_MM
#undef PV_RD
#undef PV_PK
#undef PV_MM
        }
        if (t + 2 < NT) asm volatile("s_waitcnt vmcnt(5) lgkmcnt(0)" ::: "memory"); else asm volatile("s_waitcnt vmcnt(0) lgkmcnt(0)" ::: "memory");
        __builtin_amdgcn_s_barrier(); asm volatile("" ::: "memory");
        bcur = (bcur == 2) ? 0 : bcur + 1; bnx2 = (bnx2 == 2) ? 0 : bnx2 + 1;
    }
#undef AT_DMA
#undef AT_FOFF
    const float lt = l_run + __shfl_xor(l_run, 32);
    wsf[r32] = 1.0f / lt;
    asm volatile("s_waitcnt lgkmcnt(0)" ::: "memory");
    GAS bf16_t* orow = mix + (size_t)(q0 + 32 * w) * DM + h * VD + r32;
#pragma unroll
    for (int i = 0; i < 16; ++i) { const int qr = crow(i, hh); const float a = wsf[qr]; float ss = 0.f;
#pragma unroll
        for (int d = 0; d < 4; ++d) { const float v = o[d][i] * a; ss += v * v; orow[(size_t)qr * DM + 32 * d] = (bf16_t)f2bf(v); }
        ss += __shfl_xor(ss, 1); ss += __shfl_xor(ss, 2); ss += __shfl_xor(ss, 4); ss += __shfl_xor(ss, 8); ss += __shfl_xor(ss, 16);
        if (r32 == 0) ssq_add(ssq_a + q0 + 32 * w + qr, ss); }
    __syncthreads();
}

constexpr int GL_V = 0  , GL_KD = 32768  , GL_TOT = GL_KD + 18432  , GL_ZA = GL_TOT + 2048  ;
__device__ __forceinline__ void gla_chunk_unit(LAS unsigned char* L, const bf16_t* Z_, const float* wgate_, const float* bgate_, bf16_t* ST_, float* DEC_, int c, int h, int wv) {
    GAS const bf16_t* Z = G_(Z_); GAS const float* wgate = G_(wgate_); GAS const float* bgate = G_(bgate_); GAS bf16_t* ST = G_(ST_); GAS float* DEC = G_(DEC_);
    int tid_ = wv * 64 + lane_id_(); LAUNDER_V(tid_);
    const int tid = tid_, lane = tid & 63, w = __builtin_amdgcn_readfirstlane(tid >> 6), r32 = lane & 31, hh = lane >> 5;
    const size_t row0 = (size_t)c * 64;
#pragma unroll
    for (int i = 0; i < 4; ++i) { const int id = tid + 512 * i, r = id >> 5, cc = id & 31;
        *(LAS u32x4*)(L + GL_V + r * 512 + cc * 16) = *(GAS const u32x4*)(Z + (row0 + r) * IN_PAD + C_GV + h * GDV + cc * 8); }
#pragma unroll
    for (int i = 0; i < 2; ++i) { const int id = tid + 512 * i, r = id >> 4, cc = id & 15;
        ((LAS float*)(L + GL_ZA))[id] = bf2f(Z[(row0 + r) * IN_PAD + C_GA + cc]); }
    __syncthreads();
    const int tq = tid >> 7, col = tid & 127;
    float wg[16];
#pragma unroll
    for (int r = 0; r < 16; ++r) wg[r] = wgate[r * (GH * GDK) + h * GDK + col];
    const float bg = bgate[h * GDK + col];
    float pre[16]; float run = 0.f;
#pragma unroll
    for (int i = 0; i < 16; ++i) {
        const LAS float* za = (const LAS float*)(L + GL_ZA) + (16 * tq + i) * 16;
        float ga = bg;
#pragma unroll
        for (int r = 0; r < 16; ++r) ga += za[r] * wg[r];
        const float ls = fminf(ga, 0.f) - __logf(1.0f + __expf(-fabsf(ga)));
        run += ls * (1.0f / 16.0f); pre[i] = run;
    }
    ((LAS float*)(L + GL_TOT))[tq * 128 + col] = run;
    __syncthreads();
    float off = 0.f, bend = 0.f;
#pragma unroll
    for (int t = 0; t < 4; ++t) { const float v = ((LAS float*)(L + GL_TOT))[t * 128 + col]; bend += v; if (t < tq) off += v; }
    {
        unsigned pkv[8];
#pragma unroll
        for (int i = 0; i < 16; i += 2) {
            const float k0 = bf2f(Z[(row0 + 16 * tq + i) * IN_PAD + C_GK + h * GDK + col]), k1 = bf2f(Z[(row0 + 16 * tq + i + 1) * IN_PAD + C_GK + h * GDK + col]);
            pkv[i >> 1] = pk2(k0 * __expf(bend - off - pre[i]), k1 * __expf(bend - off - pre[i + 1]));
        }
        LAS u32x4* dst = (LAS u32x4*)(L + GL_KD + col * 144 + tq * 32);
        dst[0] = (u32x4){pkv[0], pkv[1], pkv[2], pkv[3]}; dst[1] = (u32x4){pkv[4], pkv[5], pkv[6], pkv[7]};
    }
    if (tq == 0) DEC[(size_t)(c * GH + h) * GDK + col] = __expf(bend);
    __syncthreads();
    f32x16 acc[4];
#pragma unroll
    for (int d = 0; d < 4; ++d)
#pragma unroll
        for (int i = 0; i < 16; ++i) acc[d][i] = 0.f;
#pragma unroll
    for (int ks = 0; ks < 4; ++ks) {
        bf16x8 a;
#pragma unroll
        for (int j = 0; j < 8; ++j) a[j] = (short)*(const LAS unsigned short*)(L + GL_V + (16 * ks + 8 * hh + j) * 512 + (32 * w + r32) * 2);
#pragma unroll
        for (int db = 0; db < 4; ++db) {
            const bf16x8 b = *(const LAS bf16x8*)(L + GL_KD + (32 * db + r32) * 144 + (16 * ks + 8 * hh) * 2);
            acc[db] = MFMA32(a, b, acc[db]);
        }
    }
    GAS bf16_t* stp = ST + ((size_t)(c * GH + h) * GDV + 32 * w) * GDK + r32;
#pragma unroll
    for (int db = 0; db < 4; ++db)
#pragma unroll
        for (int i = 0; i < 16; ++i) stp[(size_t)crow(i, hh) * GDK + 32 * db] = (bf16_t)f2bf(acc[db][i]);
    __syncthreads();
}

constexpr int GO_STR = 260;
__device__ __forceinline__ void gla_out_unit(LAS unsigned char* L, const bf16_t* Z_, const bf16_t* ST_, const float* gnorm_, bf16_t* mix_, int c, int h, int wv) {
    GAS const bf16_t* Z = G_(Z_); GAS const bf16_t* ST = G_(ST_); GAS const float* gnorm = G_(gnorm_); GAS bf16_t* mix = G_(mix_);
    int tid_ = wv * 64 + lane_id_(); LAUNDER_V(tid_);
    const int tid = tid_, lane = tid & 63, w = __builtin_amdgcn_readfirstlane(tid >> 6), r32 = lane & 31, hh = lane >> 5;
    const size_t row0 = (size_t)c * 64;
    f32x16 acc[2];
#pragma unroll
    for (int d = 0; d < 2; ++d)
#pragma unroll
        for (int i = 0; i < 16; ++i) acc[d][i] = 0.f;
    GAS const bf16_t* sp = ST + ((size_t)(c * GH + h) * GDV + 32 * w + r32) * GDK + 8 * hh;
#pragma unroll
    for (int ks = 0; ks < 8; ++ks) {
        const bf16x8 b = *(GAS const bf16x8*)(sp + 16 * ks);
#pragma unroll
        for (int tb = 0; tb < 2; ++tb) {
            const bf16x8 a = *(GAS const bf16x8*)(Z + (row0 + 32 * tb + r32) * IN_PAD + C_GQ + h * GDK + 16 * ks + 8 * hh);
            acc[tb] = MFMA32(a, b, acc[tb]);
        }
    }
    LAS float* of = (LAS float*)L;
#pragma unroll
    for (int tb = 0; tb < 2; ++tb)
#pragma unroll
        for (int i = 0; i < 16; ++i) of[(32 * tb + crow(i, hh)) * GO_STR + 32 * w + r32] = acc[tb][i] * 0.08838834764831845f;
    __syncthreads();
    const int tok = tid >> 3, part = tid & 7;
    f32x4 v[4][2]; float ss = 0.f;
#pragma unroll
    for (int j = 0; j < 4; ++j)
#pragma unroll
        for (int q = 0; q < 2; ++q) { v[j][q] = *(const LAS f32x4*)(of + tok * GO_STR + part * 8 + 64 * j + 4 * q); ss += (v[j][q][0] * v[j][q][0] + v[j][q][1] * v[j][q][1]) + (v[j][q][2] * v[j][q][2] + v[j][q][3] * v[j][q][3]); }
    ss += __shfl_xor(ss, 1); ss += __shfl_xor(ss, 2); ss += __shfl_xor(ss, 4);
    const float rstd = rsqrtf(ss * (1.0f / GDV) + EPS);
    GAS const bf16_t* zg = Z + (row0 + tok) * IN_PAD + C_GG + h * GDV + part * 8;
    GAS bf16_t* op = mix + (row0 + tok) * DM + 1024 + h * GDV + part * 8;
#pragma unroll
    for (int j = 0; j < 4; ++j) {
        const u32x4 gw_ = *(GAS const u32x4*)(zg + 64 * j);
        const f32x4 n0 = *(GAS const f32x4*)(gnorm + part * 8 + 64 * j), n1 = *(GAS const f32x4*)(gnorm + part * 8 + 64 * j + 4);
        u32x4 ow;
        ow.x = pk2(v[j][0][0] * rstd * n0[0] * silu_f(bflo(gw_.x)), v[j][0][1] * rstd * n0[1] * silu_f(bfhi(gw_.x)));
        ow.y = pk2(v[j][0][2] * rstd * n0[2] * silu_f(bflo(gw_.y)), v[j][0][3] * rstd * n0[3] * silu_f(bfhi(gw_.y)));
        ow.z = pk2(v[j][1][0] * rstd * n1[0] * silu_f(bflo(gw_.z)), v[j][1][1] * rstd * n1[1] * silu_f(bfhi(gw_.z)));
        ow.w = pk2(v[j][1][2] * rstd * n1[2] * silu_f(bflo(gw_.w)), v[j][1][3] * rstd * n1[3] * silu_f(bfhi(gw_.w)));
        *(GAS u32x4*)(op + 64 * j) = ow;
    }
    __syncthreads();
}


#define XB_TMO      128
#define XB_XCNT(j)  (256  + 64 * (j))
#define XB_XSUB(j)  (1280 + 64 * (j))
#define XB_XGEN(j)  (2304 + 64 * (j))
#define XB_TOP      3328
#define XB_TOPGEN   3392
#define XCD_BAR_WORDS 3456
#define XB_SPIN_CAP (1u << 22)
__device__ __forceinline__ unsigned xb_ld(unsigned* p)              { return __hip_atomic_load(p, __ATOMIC_RELAXED, __HIP_MEMORY_SCOPE_AGENT); }
__device__ __forceinline__ unsigned xb_add(unsigned* p, unsigned v) { return __hip_atomic_fetch_add(p, v, __ATOMIC_RELAXED, __HIP_MEMORY_SCOPE_AGENT); }
__device__ __forceinline__ unsigned xb_xcc_id() { return (unsigned)__builtin_amdgcn_s_getreg((3 << 11) | 20) & 0xFu; }
#define XB_SPIN(cond, bar) do { unsigned _sp = 0; while (cond) { __builtin_amdgcn_s_sleep(1); \
    if ((++_sp & 255u) == 0u) { if (xb_ld(&(bar)[XB_TMO])) break; if (_sp > XB_SPIN_CAP) { atomicAdd(&(bar)[XB_TMO], 1u); break; } } } } while (0)
struct XcdBarrier { unsigned* bar; unsigned x; volatile LAS unsigned* st; };
__device__ __forceinline__ XcdBarrier xcd_barrier_post(unsigned* bar, volatile LAS unsigned* st, bool t0) {
    XcdBarrier b; b.bar = bar; b.x = xb_xcc_id(); b.st = st;
    if (t0) (void)xb_add(&bar[XB_XCNT(b.x)], 1u);
    return b;
}
__device__ __forceinline__ void xcd_barrier_complete(unsigned* bar, unsigned x, unsigned& nloc, unsigned& nx) {
    const unsigned G = gridDim.x * gridDim.y * gridDim.z;
    unsigned sum, cnt, mine, sp = 0u;
    for (;;) {
        sum = 0u; cnt = 0u; mine = 0u;
#pragma unroll
        for (unsigned j = 0; j < 16; ++j) { const unsigned c = xb_ld(&bar[XB_XCNT(j)]); sum += c; cnt += (c > 0u) ? 1u : 0u; mine = (j == x) ? c : mine; }
        if (sum == G) break;
        __builtin_amdgcn_s_sleep(1);
        if ((++sp & 255u) == 0u) { if (xb_ld(&bar[XB_TMO])) break; if (sp > XB_SPIN_CAP) { atomicAdd(&bar[XB_TMO], 1u); break; } }
    }
    nloc = mine > 0u ? mine : 1u; nx = cnt > 0u ? cnt : 1u;
}
__device__ __forceinline__ void xcd_barrier(const XcdBarrier& b, bool t0) {
    asm volatile("s_waitcnt vmcnt(0)" ::: "memory");
    __syncthreads();
    if (t0) {
        unsigned* bar = b.bar;
        __builtin_amdgcn_s_waitcnt(0);
        unsigned nloc = b.st[0], nx = b.st[1];
        if (nloc == 0u) { xcd_barrier_complete(bar, b.x, nloc, nx); b.st[0] = nloc; b.st[1] = nx; }
        const unsigned old = xb_add(&bar[XB_XSUB(b.x)], 1u);
        const unsigned gen = old / nloc;
        if (old + 1u == (gen + 1u) * nloc) {
            __builtin_amdgcn_fence(__ATOMIC_RELEASE, "agent");
            asm volatile("s_waitcnt vmcnt(0)" ::: "memory");
            const unsigned og = xb_add(&bar[XB_TOP], 1u);
            const unsigned tg = og / nx;
            if (og + 1u == (tg + 1u) * nx) xb_add(&bar[XB_TOPGEN], 1u);
            else XB_SPIN(xb_ld(&bar[XB_TOPGEN]) == tg, bar);
            __builtin_amdgcn_fence(__ATOMIC_ACQUIRE, "agent");
            xb_add(&bar[XB_XGEN(b.x)], 1u);
            asm volatile("s_waitcnt vmcnt(0)" ::: "memory");
        } else {
            XB_SPIN(xb_ld(&bar[XB_XGEN(b.x)]) == gen, bar);
            __builtin_amdgcn_fence(__ATOMIC_ACQUIRE, "agent");
            asm volatile("s_waitcnt vmcnt(0)" ::: "memory");
        }
    }
    __syncthreads();
}

__global__ void __launch_bounds__(512, 2) mk_fwd(Args a) {
    extern __shared__ __attribute__((aligned(16))) unsigned char lds[];
    cg::grid_group grid = cg::this_grid();
    LAS unsigned char* L = (LAS unsigned char*)lds;
    const int G = gridDim.x, bid = blockIdx.x, NGW = G * 8;
    volatile LAS unsigned* MISC = (volatile LAS unsigned*)(L + RING_BYTES + 8192);
    const int wave_s = __builtin_amdgcn_readfirstlane(threadIdx.x >> 6);
    if (wave_s == 0 && lane_id_() < 4) MISC[lane_id_()] = 0u;
    __syncthreads();
    { KAP_T kap0 = (KAP_T)__builtin_amdgcn_kernarg_segment_ptr(); (void)xcd_barrier_post((unsigned*)(kap0->ws + WS_BAR), MISC, wave_s == 0 && lane_id_() == 0); }
#define XSYNC() do { KAP_T kap_ = (KAP_T)__builtin_amdgcn_kernarg_segment_ptr(); LAUNDER_S(kap_); XcdBarrier xb_; xb_.bar = (unsigned*)(kap_->ws + WS_BAR); xb_.x = xb_xcc_id(); xb_.st = (volatile LAS unsigned*)(L + RING_BYTES + 8192); xcd_barrier(xb_, wave_s == 0 && lane_id_() == 0); } while (0)
#define GRID_SYNC() do { asm volatile("s_waitcnt vmcnt(0) lgkmcnt(0)" ::: "memory"); __syncthreads(); grid.sync(); \
    __builtin_amdgcn_fence(__ATOMIC_ACQUIRE, "agent"); asm volatile("s_waitcnt vmcnt(0)" ::: "memory"); __syncthreads(); } while (0)
#ifndef DBG_STOP
#define DBG_STOP 0
#endif
#define DBG_DUMP(k, EXPR) do { if (DBG_STOP == (k)) { PHASE_BEGIN(); for (int m = gw; m < SEQ; m += NGW) for (int c = lane; c < DM; c += 64) out[(size_t)m * DM + c] = (EXPR); return; } } while (0)
#define PHASE_BEGIN() KAP_T kap = (KAP_T)__builtin_amdgcn_kernarg_segment_ptr(); LAUNDER_S(kap); unsigned char* ws = kap->ws; LAUNDER_S(ws); int tid_ = wave_s * 64 + lane_id_(); LAUNDER_V(tid_); const int tid = tid_, lane = tid & 63, wave = __builtin_amdgcn_readfirstlane(tid >> 6), gw = bid * 8 + wave; \
    u64* ssq = (u64*)(ws + WS_SSQ); (void)lane; (void)gw; (void)ssq; \
    u64* ssq_x = ssq + (size_t)l * SEQ; u64* ssq_xn = ssq + (size_t)(l + 1) * SEQ; u64* ssq_cq = ssq + (size_t)(3 + l) * SEQ; u64* ssq_ckv = ssq + (size_t)(5 + l) * SEQ; u64* ssq_x1 = ssq + (size_t)(7 + l) * SEQ; u64* ssq_a = ssq + (size_t)(9 + l) * SEQ; (void)ssq_a; \
    (void)ssq_x; (void)ssq_xn; (void)ssq_cq; (void)ssq_ckv; (void)ssq_x1; \
    bf16_t* Win = (bf16_t*)(ws + WS_WIN); bf16_t* Wuq = (bf16_t*)(ws + WS_WUQ); bf16_t* Wukv = (bf16_t*)(ws + WS_WUKV); \
    bf16_t* Wout = (bf16_t*)(ws + WS_WOUT); bf16_t* Wup = (bf16_t*)(ws + WS_WUP); bf16_t* Wdn = (bf16_t*)(ws + WS_WDN); \
    bf16_t* XB = (bf16_t*)(ws + WS_XB); bf16_t* Z = (bf16_t*)(ws + WS_Z); bf16_t* Qb = (bf16_t*)(ws + WS_Q); bf16_t* Kb = (bf16_t*)(ws + WS_K); bf16_t* Vt = (bf16_t*)(ws + WS_VT); \
    bf16_t* ST = (bf16_t*)(ws + WS_ST); float* DEC = (float*)(ws + WS_DEC); bf16_t* MIX = (bf16_t*)(ws + WS_MIX); \
    bf16_t* ACT = (bf16_t*)(ws + WS_ACT); float* EDGE = (float*)(ws + WS_EDGE); \
    const float* xin = kap->in[0]; float* out = kap->out; \
    (void)Win; (void)Wuq; (void)Wukv; (void)Wout; (void)Wup; (void)Wdn; (void)XB; (void)Z; (void)Qb; (void)Kb; (void)Vt; (void)ST; (void)DEC; (void)MIX; (void)EDGE; (void)ACT; (void)xin; (void)out;

    for (int l = 0; l < NLAYER; ++l) {
        {
            PHASE_BEGIN();
            LAS float* scr = (LAS float*)(L + wave * 16384);
            const float* w_in = kap->in[3] + (size_t)l * DM * IN_DIM; const float* w_uq = kap->in[5] + (size_t)l * QLORA * QW; const float* w_ukv = kap->in[7] + (size_t)l * KVLORA * KVW;
            const float* w_out = kap->in[14] + (size_t)l * DM * DM; const float* w_up = kap->in[16] + (size_t)l * DM * DFF2; const float* w_dn = kap->in[19] + (size_t)l * DFF * DM;
            const float* g_attn = kap->in[2] + l * DM; const float* g_cq = kap->in[4] + l * QLORA; const float* g_ckv = kap->in[6] + l * KVLORA; const float* g_mla = kap->in[13] + l * 1024; const float* g_ffn = kap->in[15] + l * DM;
            constexpr int I_IN = (DM / 64) * (IN_PAD / 32), I_UQ = (QLORA / 64) * (QW / 32), I_UKV = (KVLORA / 64) * (KVW / 32), I_OUT = (DM / 64) * (DM / 32), I_UP = (DM / 64) * (DFF2 / 32), I_DN = (DFF / 64) * (DM / 32);
            constexpr int NITEMS = I_IN + I_UQ + I_UKV + I_OUT + I_UP + I_DN;
            for (int it = gw; it < NITEMS; it += NGW) {
                int r = it;
                if (r < I_IN) { wt_item(w_in, DM, IN_DIM, g_attn, DM, Win, scr, r, IN_PAD / 32, lane); continue; } r -= I_IN;
                if (r < I_UQ) { wt_item(w_uq, QLORA, QW, g_cq, QLORA, Wuq, scr, r, QW / 32, lane); continue; } r -= I_UQ;
                if (r < I_UKV) { wt_item(w_ukv, KVLORA, KVW, g_ckv, KVLORA, Wukv, scr, r, KVW / 32, lane); continue; } r -= I_UKV;
                if (r < I_OUT) { wt_item(w_out, DM, DM, g_mla, 1024, Wout, scr, r, DM / 32, lane); continue; } r -= I_OUT;
                if (r < I_UP) { wt_item(w_up, DM, DFF2, g_ffn, DM, Wup, scr, r, DFF2 / 32, lane, true); continue; } r -= I_UP;
                wt_item(w_dn, DFF, DM, g_ffn, 0, Wdn, scr, r, DM / 32, lane);
            }
            if (l == 0) {
                for (int m = gw; m < SEQ; m += NGW) {
                    GAS const f32x4* xr = (GAS const f32x4*)(G_(xin) + (size_t)m * DM) + lane; float s = 0.f;
                    GAS u32x2* o8 = (GAS u32x2*)(G_(XB) + (size_t)m * DM) + lane;
#pragma unroll
                    for (int j = 0; j < 8; ++j) { const f32x4 v = xr[64 * j]; s += (v[0] * v[0] + v[1] * v[1]) + (v[2] * v[2] + v[3] * v[3]); o8[64 * j] = (u32x2){pk2(v[0], v[1]), pk2(v[2], v[3])}; }
                    s = wave_sum(s); if (lane == 0) G_(ssq_x)[m] = (u64)(s * SSQ_FX + 0.5f);
                }
            }
        }
        if (l == 0) GRID_SYNC(); else XSYNC();
        {
            PHASE_BEGIN();
            pg8::Gemm g{XB, Win, SEQ, IN_PAD, DM, DM, nullptr, 0.f}; pg8::StaticOrder S; S.init(SEQ, IN_PAD, G, bid);
            pg8::EpiRowScale E{Z, IN_PAD, ssq_x, 1.0f / DM, ssq_cq, 0, 2, ssq_ckv, 2, 3};
            pg8::gemm_phase<pg8::EpiRowScale>(L, g, S, E, wave_s);
        }
        XSYNC();
        DBG_DUMP(1, bf2f(Z[(size_t)m * IN_PAD + c]) + bf2f(Z[(size_t)m * IN_PAD + 2048 + c]));
        {
            PHASE_BEGIN();
            { pg8::Gemm g{Z + C_CQ, Wuq, SEQ, QW, QLORA, IN_PAD, nullptr, 0.f}; pg8::StaticOrder S; S.init(SEQ, QW, G, bid);
              pg8::EpiRowScale E{Qb, QW, ssq_cq, 1.0f / QLORA, nullptr, 0, 0, nullptr, 0, 0};
              pg8::gemm_phase<pg8::EpiRowScale>(L, g, S, E, wave_s); }
            { pg8::Gemm g{Z + C_CKV, Wukv, SEQ, KVW, KVLORA, IN_PAD, nullptr, 0.f}; pg8::StaticOrder S; S.init(SEQ, KVW, G, bid);
              pg8::EpiUkv E{Kb, Vt, ssq_ckv, 1.0f / KVLORA, Z, (const int*)kap->in[1], kap->in[9] + l * QKD, kap->inv_freq, (LAS float*)(L + RING_BYTES)};
              pg8::gemm_phase<pg8::EpiUkv>(L, g, S, E, wave_s); }
            const float* wgate = kap->in[10] + (size_t)l * 16 * (GH * GDK); const float* bgate = kap->in[11] + (size_t)l * (GH * GDK);
            for (int u = bid; u < NCHUNK * GH; u += G) gla_chunk_unit(L, Z, wgate, bgate, ST, DEC, u >> 2, u & 3, wave_s);
        }
        XSYNC();
        DBG_DUMP(2, (c < QW ? bf2f(Qb[(size_t)m * QW + c]) + bf2f(Kb[(size_t)m * QW + c]) : bf2f(Vt[(size_t)(c - QW) * SEQ + m])) + bf2f(ST[(size_t)m * 8192 + c]) + bf2f(ST[(size_t)m * 8192 + 4096 + c]));
        {
            PHASE_BEGIN();
            const int* pos = (const int*)kap->in[1];
            const float* kn = kap->in[9] + l * QKD;
            constexpr int NE = GH * GDV * GDK;
            for (int e = bid * 512 + tid; e < NE; e += G * 512) {
                const int hd = (e >> 15) * GDK + (e & 127);
                float s = 0.f;
                for (int c0 = 0; c0 < NCHUNK; c0 += 8) {
                    float uu[8], dd[8];
#pragma unroll
                    for (int i = 0; i < 8; ++i) { uu[i] = bf2f(G_(ST)[(size_t)(c0 + i) * NE + e]); dd[i] = G_(DEC)[(size_t)(c0 + i) * (GH * GDK) + hd]; }
#pragma unroll
                    for (int i = 0; i < 8; ++i) { s = s * dd[i] + uu[i]; G_(ST)[(size_t)(c0 + i) * NE + e] = (bf16_t)f2bf(s); }
                }
            }
        }
        XSYNC();
        DBG_DUMP(3, (c < QW ? bf2f(Qb[(size_t)m * QW + c]) + bf2f(Kb[(size_t)m * QW + c]) : 0.f) + bf2f(ST[(size_t)m * 8192 + c]) + bf2f(ST[(size_t)m * 8192 + 4096 + c]));
        {
            PHASE_BEGIN();
            for (int p = bid; p < 256; p += G) {
                const int h = p & 7, s = p >> 3;
                attn_unit(L, Qb, Kb, Vt, MIX, ssq_a, h, 63 - s, wave_s, (const int*)kap->in[1], kap->in[8] + l * QKD, kap);
                attn_unit(L, Qb, Kb, Vt, MIX, ssq_a, h, s, wave_s, (const int*)kap->in[1], kap->in[8] + l * QKD, kap);
            }
            const float* gnorm = kap->in[12] + l * GDV;
            for (int u = bid; u < NCHUNK * GH; u += G) gla_out_unit(L, Z, ST, gnorm, MIX, u >> 2, u & 3, wave_s);
        }
        XSYNC();
        DBG_DUMP(4, bf2f(MIX[(size_t)m * DM + c]));
        DBG_DUMP(5, bf2f(MIX[(size_t)m * DM + c]));
        {
            PHASE_BEGIN();
            pg8::Gemm g{MIX, Wout, SEQ, DM, DM, DM, ssq_a, 1.0f / 1024.0f}; pg8::StaticOrder S; S.init(SEQ, DM, G, bid);
            pg8::EpiRes E{l == 0 ? xin : out, out, XB, ssq_x1};
            pg8::gemm_phase<pg8::EpiRes, true>(L, g, S, E, wave_s);
        }
        XSYNC();
        DBG_DUMP(6, out[(size_t)m * DM + c] + bf2f(XB[(size_t)m * DM + c]));
        {
            PHASE_BEGIN();
            const float* cw = kap->in[17] + (size_t)l * 3 * DFF2; const float* cb = kap->in[18] + (size_t)l * DFF2;
            pg8::Gemm g{XB, Wup, SEQ, DFF2, DM, DM, nullptr, 0.f}; pg8::StaticOrder S; S.init(SEQ, DFF2, G, bid);
            pg8::EpiUpConv E{ACT, EDGE, ssq_x1, cw, cb, (LAS float*)(L + RING_BYTES)};
            pg8::gemm_phase<pg8::EpiUpConv>(L, g, S, E, wave_s);
        }
        XSYNC();
        {
            PHASE_BEGIN();
            const float* cw = kap->in[17] + (size_t)l * 3 * DFF2; const float* cb = kap->in[18] + (size_t)l * DFF2;
            for (int idx = bid * 512 + tid; idx < 63 * DFF; idx += G * 512) {
                const int pm = 1 + idx / DFF, gcol = idx % DFF;
                float y0[2], y1[2];
#pragma unroll
                for (int q = 0; q < 2; ++q) { const int c = q * DFF + gcol;
                    const float um2 = G_(EDGE)[(size_t)((pm - 1) * 4 + 2) * DFF2 + c], um1 = G_(EDGE)[(size_t)((pm - 1) * 4 + 3) * DFF2 + c], u0 = G_(EDGE)[(size_t)(pm * 4 + 0) * DFF2 + c], u1 = G_(EDGE)[(size_t)(pm * 4 + 1) * DFF2 + c];
                    const float w0 = G_(cw)[c], w1 = G_(cw)[DFF2 + c], w2 = G_(cw)[2 * DFF2 + c], bb = G_(cb)[c];
                    y0[q] = bb + w0 * um2 + w1 * um1 + w2 * u0; y1[q] = bb + w0 * um1 + w1 * u0 + w2 * u1; }
                G_(ACT)[(size_t)(pm * 256) * DFF + gcol] = (bf16_t)f2bf(silu_f(y0[0]) * y0[1]);
                G_(ACT)[(size_t)(pm * 256 + 1) * DFF + gcol] = (bf16_t)f2bf(silu_f(y1[0]) * y1[1]);
            }
        }
        XSYNC();
        DBG_DUMP(8, bf2f(ACT[(size_t)m * DFF + c]) + bf2f(ACT[(size_t)m * DFF + 3000 + c]));
        {
            PHASE_BEGIN();
            pg8::Gemm g{ACT, Wdn, SEQ, DM, DFF, DFF, nullptr, 0.f}; pg8::StaticOrder S; S.init(SEQ, DM, G, bid);
            pg8::EpiRes E{out, out, XB, ssq_xn};
            pg8::gemm_phase<pg8::EpiRes>(L, g, S, E, wave_s);
        }
        XSYNC();
        if (DBG_STOP == 9) return;
    }
}

extern "C" void kernel_launch(void* const* d_in, const int* in_sizes, int n_in, void* d_out, int out_size, void* d_ws, size_t ws_size, hipStream_t stream) {
    static int grid = 0;
    if (grid == 0) {
        if (n_in != 20 || out_size != SEQ * DM || ws_size < WS_END) { fprintf(stderr, "kernel_launch: unexpected shapes: n_in %d out %d ws %zu (need %zu)\n", n_in, out_size, ws_size, (size_t)WS_END); grid = -1; return; }
        int dev = 0, cus = 0, per_cu = 0;
        hipGetDevice(&dev); hipDeviceGetAttribute(&cus, hipDeviceAttributeMultiprocessorCount, dev);
        hipFuncSetAttribute((const void*)mk_fwd, hipFuncAttributeMaxDynamicSharedMemorySize, LDS_BYTES);
        hipOccupancyMaxActiveBlocksPerMultiprocessor(&per_cu, (const void*)mk_fwd, 512, LDS_BYTES);
        (void)hipGetLastError();
        if (per_cu < 1) per_cu = 1;
        grid = cus * 1;
    }
    if (grid < 0) return;
    hipMemsetAsync((char*)d_ws + WS_CTL, 0, CTL_BYTES, stream);
    Args a{};
    for (int i = 0; i < 20; ++i) a.in[i] = (const float*)d_in[i];
    a.out = (float*)d_out; a.ws = (unsigned char*)d_ws;
    for (int i = 0; i < 32; ++i) a.inv_freq[i] = (float)pow(10000.0, -(double)i / 32.0);
    void* args[] = {&a};
    hipError_t e = hipLaunchCooperativeKernel((const void*)mk_fwd, dim3(grid), dim3(512), args, LDS_BYTES, stream);
    if (e != hipSuccess) fprintf(stderr, "cooperative launch failed: %s (grid %d)\n", hipGetErrorString(e), grid);
}
```

```cpp
#include <hip/hip_runtime.h>
#include <hip/hip_cooperative_groups.h>
#include <cstdio>
#include <cstdint>
#include <cmath>
namespace cg = cooperative_groups;

#define LAS __attribute__((address_space(3)))
typedef unsigned short bf16_t;
typedef unsigned long long u64;
typedef short bf16x8 __attribute__((ext_vector_type(8)));
typedef short s16x4 __attribute__((ext_vector_type(4)));
typedef float f32x4 __attribute__((ext_vector_type(4)));
typedef float f32x16 __attribute__((ext_vector_type(16)));
typedef unsigned u32x4 __attribute__((ext_vector_type(4)));
typedef unsigned u32x2 __attribute__((ext_vector_type(2)));
typedef float f32x2_t __attribute__((ext_vector_type(2)));
typedef __bf16 bf16x2_t __attribute__((ext_vector_type(2)));

constexpr int SEQ = 16384, DM = 2048, NLAYER = 2;
constexpr int IN_DIM = 3920, IN_PAD = 4096;
constexpr int C_CQ = 0, C_CKV = 512, C_KR = 768, C_GQ = 832, C_GK = 1344, C_GV = 1856, C_GA = 2880, C_GG = 2896;
constexpr int QLORA = 512, KVLORA = 256, NH = 8, QKD = 192, NOPE = 128, VD = 128, QW = NH * QKD  , KVW = NH * 256  ;
constexpr int GH = 4, GDK = 128, GDV = 256, NCHUNK = SEQ / 64;
constexpr int DFF = 5632, DFF2 = 11264;
constexpr float EPS = 1e-6f;

constexpr size_t MiB = 1u << 20;
constexpr size_t WS_CTL = 0, CTL_BYTES = 2 * MiB;
constexpr size_t WS_BAR = 0;
constexpr size_t WS_SSQ = 65536;
constexpr size_t WS_WIN = 2 * MiB, WS_WUQ = 18 * MiB, WS_WUKV = WS_WUQ + 3 * MiB / 2, WS_WOUT = WS_WUKV + 1 * MiB, WS_WUP = WS_WOUT + 8 * MiB, WS_WDN = WS_WUP + 44 * MiB;
constexpr size_t WS_XB = 95 * MiB;
constexpr size_t WS_R = 159 * MiB;
constexpr size_t WS_Z = WS_R, WS_Q = WS_Z + 128 * MiB, WS_K = WS_Q + 48 * MiB, WS_VT = WS_K + 48 * MiB, WS_ST = WS_VT + 32 * MiB, WS_DEC = WS_ST + 128 * MiB, WS_MIX = WS_DEC + 1 * MiB;
constexpr size_t WS_ACT = WS_R, WS_EDGE = WS_ACT + 176 * MiB, WS_END = WS_MIX + 64 * MiB;
static_assert(WS_EDGE + 12 * MiB <= WS_END, "ws map");

#define GAS __attribute__((address_space(1)))
template <class T> __device__ __forceinline__ GAS T* G_(T* p) { return (GAS T*)p; }
__device__ __forceinline__ int lane_id_() { unsigned z = 0u; asm volatile("" : "+v"(z)); return (int)__builtin_amdgcn_mbcnt_hi(~0u, __builtin_amdgcn_mbcnt_lo(~0u, z)); }
#define LAUNDER_V(x) asm volatile("" : "+v"(x))
#define LAUNDER_S(x) asm volatile("" : "+s"(x))
__device__ __forceinline__ unsigned f2bf(float f) { unsigned u = __builtin_bit_cast(unsigned, f); return (u + 0x7fffu + ((u >> 16) & 1u)) >> 16; }
__device__ __forceinline__ unsigned pk2(float lo, float hi) { f32x2_t v = {lo, hi}; bf16x2_t b = __builtin_convertvector(v, bf16x2_t); return __builtin_bit_cast(unsigned, b); }
__device__ __forceinline__ float bf2f(unsigned b) { return __builtin_bit_cast(float, b << 16); }
__device__ __forceinline__ float bflo(unsigned w) { return __builtin_bit_cast(float, w << 16); }
__device__ __forceinline__ float bfhi(unsigned w) { return __builtin_bit_cast(float, w & 0xffff0000u); }
__device__ __forceinline__ float wave_sum(float v) {
#pragma unroll
    for (int o = 1; o < 64; o <<= 1) v += __shfl_xor(v, o);
    return v;
}
constexpr float SSQ_FX = 1048576.0f, SSQ_INV = 1.0f / 1048576.0f;
__device__ __forceinline__ void ssq_add(u64* p, float v) { __hip_atomic_fetch_add((GAS u64*)p, (u64)(v * SSQ_FX + 0.5f), __ATOMIC_RELAXED, __HIP_MEMORY_SCOPE_AGENT); }
__device__ __forceinline__ float ssq_get(const u64* p) { return (float)(*(GAS const u64*)p) * SSQ_INV; }
__device__ __forceinline__ float silu_f(float x) { return x * __builtin_amdgcn_rcpf(1.0f + __expf(-x)); }

namespace pg8 {
constexpr int BM = 256, BK = 64, HALF = 128, HTB = HALF * BK * 2, STAGE_BYTES = 8 * HTB, NXCD = 8, WGM = 8;
__host__ __device__ __forceinline__ int lds_byte(int r, int c) { const int st = (r >> 4) * 2 + (c >> 5), rr = r & 15, cc = c & 31, ob = rr * 64 + cc * 2; return st * 1024 + (ob ^ (((ob >> 9) & 1) << 5)); }
__host__ __device__ __forceinline__ void stage_rc(int b, int& R, int& C) { const int st = b / 1024, sb = b % 1024, swz = sb ^ (((sb >> 9) & 1) << 5); R = (st >> 1) * 16 + swz / 64; C = (st & 1) * 32 + (swz % 64) / 2; }
__host__ __device__ __forceinline__ int perm32(int rho) { const int n = rho >> 4, i = rho & 15; return 8 * (i >> 2) + 4 * n + (i & 3); }

struct Unit { int pm, pn; };
struct Gemm { const bf16_t* A; const bf16_t* Bt; int M, N, K, lda; const u64* mid_ssq; float mid_inv; };

struct StaticOrder {
    int nM, nN, nwg, G, c;
    __device__ void init(int M, int N, int G_, int c_) { nM = M / BM; nN = N / BM; nwg = nM * nN; G = G_; c = c_; }
    __device__ bool next(int i, Unit& u) const {
        const long L = (long)i * G + c; if (L >= nwg) return false;
        int wgid = (int)L; { const int q = nwg / NXCD, r = nwg % NXCD, xcd = wgid % NXCD, off = wgid / NXCD; wgid = (xcd < r ? xcd * (q + 1) : r * (q + 1) + (xcd - r) * q) + off; }
        const int nig = WGM * nN, gid = wgid / nig, fm = gid * WGM, gsz = (nM - fm) < WGM ? (nM - fm) : WGM;
        u.pm = fm + ((wgid % nig) % gsz); u.pn = (wgid % nig) / gsz; return true;
    }
};

struct EpiRowScale {
    static constexpr bool PERM = true;
    bf16_t* O; int ldc; const u64* ssq_in; float inv_dim; u64* ssq_a; int a_lo, a_hi; u64* ssq_b; int b_lo, b_hi;
    __device__ __forceinline__ void operator()(const f32x4 (&acc)[2][2][4][2], const Unit& u, int wr, int wc, int fr, int fq) const {
        const int row0 = u.pm * BM + wr * 64 + fr, col0 = u.pn * BM + wc * 32 + 8 * fq;
        u64* sacc = (u.pn >= a_lo && u.pn < a_hi) ? ssq_a : ((u.pn >= b_lo && u.pn < b_hi) ? ssq_b : nullptr);
        float scv[2][4];
#pragma unroll
        for (int ai = 0; ai < 2; ++ai)
#pragma unroll
            for (int m = 0; m < 4; ++m) scv[ai][m] = ssq_in ? ssq_get(ssq_in + row0 + ai * HALF + m * 16) : 0.f;
        asm volatile("" ::: "memory");
#pragma unroll
        for (int ai = 0; ai < 2; ++ai)
#pragma unroll
            for (int m = 0; m < 4; ++m) {
                const int row = row0 + ai * HALF + m * 16;
                const float sc = ssq_in ? rsqrtf(scv[ai][m] * inv_dim + EPS) : 1.0f;
                float ss = 0.f;
#pragma unroll
                for (int bj = 0; bj < 2; ++bj) {
                    const f32x4 v0 = acc[ai][bj][m][0] * sc, v1 = acc[ai][bj][m][1] * sc;
                    ss += (v0[0] * v0[0] + v0[1] * v0[1]) + (v0[2] * v0[2] + v0[3] * v0[3]) + (v1[0] * v1[0] + v1[1] * v1[1]) + (v1[2] * v1[2] + v1[3] * v1[3]);
                    u32x4 w; w.x = pk2(v0[0], v0[1]); w.y = pk2(v0[2], v0[3]); w.z = pk2(v1[0], v1[1]); w.w = pk2(v1[2], v1[3]);
                    *(GAS u32x4*)(G_(O) + (size_t)row * ldc + col0 + bj * HALF) = w;
                }
                if (sacc) { ss += __shfl_xor(ss, 16); ss += __shfl_xor(ss, 32); if (fq == 0) ssq_add(sacc + row, ss); }
            }
    }
};
struct EpiUkv {
    static constexpr bool PERM = true;
    bf16_t* Kb; bf16_t* Vt; const u64* ssq_in; float inv_dim; const bf16_t* Z; const int* pos; const float* kn; const __attribute__((address_space(4))) float* invf; LAS float* lx;
    __device__ __forceinline__ void operator()(f32x4 (&acc)[2][2][4][2], const Unit& u, int wr, int wc, int fr, int fq) const {
        const int row0 = u.pm * BM + wr * 64 + fr, c0 = wc * 32 + 8 * fq;
        const int lt = (wr * 4 + wc) * 64 + fq * 16 + fr, rr = lt >> 1, hf = lt & 1, rrow = u.pm * BM + rr;
        GAS const bf16_t* zr = G_(Z) + (size_t)rrow * IN_PAD + C_KR + 16 * hf;
        const u32x4 ra0 = *(GAS const u32x4*)(zr), ra1 = *(GAS const u32x4*)(zr + 8), rb0 = *(GAS const u32x4*)(zr + 32), rb1 = *(GAS const u32x4*)(zr + 40);
        const float posf = (float)G_(pos)[rrow];
        float scv[2][4];
#pragma unroll
        for (int ai = 0; ai < 2; ++ai)
#pragma unroll
            for (int m = 0; m < 4; ++m) scv[ai][m] = ssq_get(ssq_in + row0 + ai * HALF + m * 16);
        asm volatile("" ::: "memory");
        float x1[16], x2[16], sk = 0.f;
#pragma unroll
        for (int jj = 0; jj < 4; ++jj) { x1[2 * jj] = bflo(ra0[jj]); x1[2 * jj + 1] = bfhi(ra0[jj]); x1[8 + 2 * jj] = bflo(ra1[jj]); x1[8 + 2 * jj + 1] = bfhi(ra1[jj]);
                                         x2[2 * jj] = bflo(rb0[jj]); x2[2 * jj + 1] = bfhi(rb0[jj]); x2[8 + 2 * jj] = bflo(rb1[jj]); x2[8 + 2 * jj + 1] = bfhi(rb1[jj]); }
#pragma unroll
        for (int j = 0; j < 16; ++j) sk += x1[j] * x1[j] + x2[j] * x2[j];
        sk += __shfl_xor(sk, 1);
        if (hf == 0) lx[1024 + rr] = sk;
#pragma unroll
        for (int ai = 0; ai < 2; ++ai)
#pragma unroll
            for (int m = 0; m < 4; ++m) {
                const float sc = rsqrtf(scv[ai][m] * inv_dim + EPS);
#pragma unroll
                for (int bj = 0; bj < 2; ++bj)
#pragma unroll
                    for (int n = 0; n < 2; ++n) acc[ai][bj][m][n] = acc[ai][bj][m][n] * sc;
                const f32x4 v0 = acc[ai][0][m][0], v1 = acc[ai][0][m][1];
                float ss = (v0[0] * v0[0] + v0[1] * v0[1]) + (v0[2] * v0[2] + v0[3] * v0[3]) + (v1[0] * v1[0] + v1[1] * v1[1]) + (v1[2] * v1[2] + v1[3] * v1[3]);
                ss += __shfl_xor(ss, 16); ss += __shfl_xor(ss, 32);
                if (fq == 0) lx[(ai * HALF + wr * 64 + m * 16 + fr) * 4 + wc] = ss;
            }
        asm volatile("s_waitcnt lgkmcnt(0)" ::: "memory"); __builtin_amdgcn_s_barrier(); asm volatile("" ::: "memory");
        const f32x4 g0 = *(GAS const f32x4*)(G_(kn) + c0), g1 = *(GAS const f32x4*)(G_(kn) + c0 + 4);
#pragma unroll
        for (int ai = 0; ai < 2; ++ai)
#pragma unroll
            for (int m = 0; m < 4; ++m) {
                const int rt = ai * HALF + wr * 64 + m * 16 + fr, row = u.pm * BM + rt;
                const int prow = (row & ~15) | (row & 3) | ((row & 4) << 1) | ((row & 8) >> 1);
                const f32x4 pp = *(const LAS f32x4*)(lx + rt * 4);
                const float rk = rsqrtf(((pp[0] + pp[1]) + (pp[2] + pp[3]) + lx[1024 + rt]) * (1.0f / QKD) + EPS);
                { const f32x4 v0 = acc[ai][0][m][0] * rk * g0, v1 = acc[ai][0][m][1] * rk * g1;
                  u32x4 w; w.x = pk2(v0[0], v0[1]); w.y = pk2(v0[2], v0[3]); w.z = pk2(v1[0], v1[1]); w.w = pk2(v1[2], v1[3]);
                  *(GAS u32x4*)(G_(Kb) + (size_t)row * QW + u.pn * QKD + c0) = w; }
#pragma unroll
                for (int n = 0; n < 2; ++n)
#pragma unroll
                    for (int j = 0; j < 4; ++j) G_(Vt)[(size_t)(u.pn * VD + c0 + 4 * n + j) * SEQ + prow] = (bf16_t)f2bf(acc[ai][1][m][n][j]);
            }
        {
            const f32x4 pp = *(const LAS f32x4*)(lx + rr * 4);
            const float rk = rsqrtf(((pp[0] + pp[1]) + (pp[2] + pp[3]) + lx[1024 + rr]) * (1.0f / QKD) + EPS);
            GAS const float* g1p = G_(kn) + 128 + 16 * hf; GAS const float* g2p = G_(kn) + 160 + 16 * hf;
            float y1[16], y2[16];
#pragma unroll
            for (int j = 0; j < 16; ++j) {
                const float ang = posf * invf[16 * hf + j];
                double rev = (double)ang * 0.15915494309189535; rev -= __builtin_rint(rev);
                const float sn = __builtin_amdgcn_sinf((float)rev), cs = __builtin_amdgcn_cosf((float)rev);
                const float n1 = x1[j] * rk * g1p[j], n2 = x2[j] * rk * g2p[j];
                y1[j] = n1 * cs - n2 * sn; y2[j] = n2 * cs + n1 * sn;
            }
            GAS bf16_t* kp = G_(Kb) + (size_t)rrow * QW + u.pn * QKD + 128 + 16 * hf;
            *(GAS u32x4*)(kp) = (u32x4){pk2(y1[0], y1[1]), pk2(y1[2], y1[3]), pk2(y1[4], y1[5]), pk2(y1[6], y1[7])};
            *(GAS u32x4*)(kp + 8) = (u32x4){pk2(y1[8], y1[9]), pk2(y1[10], y1[11]), pk2(y1[12], y1[13]), pk2(y1[14], y1[15])};
            *(GAS u32x4*)(kp + 32) = (u32x4){pk2(y2[0], y2[1]), pk2(y2[2], y2[3]), pk2(y2[4], y2[5]), pk2(y2[6], y2[7])};
            *(GAS u32x4*)(kp + 40) = (u32x4){pk2(y2[8], y2[9]), pk2(y2[10], y2[11]), pk2(y2[12], y2[13]), pk2(y2[14], y2[15])};
        }
    }
};
struct EpiRes {
    static constexpr bool PERM = true;
    const float* base; float* out; bf16_t* xb; u64* ssq_out;
    __device__ __forceinline__ void operator()(const f32x4 (&acc)[2][2][4][2], const Unit& u, int wr, int wc, int fr, int fq) const {
        const int row0 = u.pm * BM + wr * 64 + fr, col0 = u.pn * BM + wc * 32 + 8 * fq;
#pragma unroll
        for (int ai = 0; ai < 2; ++ai) {
            f32x4 bv[4][2][2];
#pragma unroll
            for (int m = 0; m < 4; ++m)
#pragma unroll
                for (int bj = 0; bj < 2; ++bj) { const size_t off = (size_t)(row0 + ai * HALF + m * 16) * DM + col0 + bj * HALF;
                    bv[m][bj][0] = *(GAS const f32x4*)(G_(base) + off); bv[m][bj][1] = *(GAS const f32x4*)(G_(base) + off + 4); }
            asm volatile("" ::: "memory");
#pragma unroll
            for (int m = 0; m < 4; ++m) {
                const int row = row0 + ai * HALF + m * 16; float ss = 0.f;
#pragma unroll
                for (int bj = 0; bj < 2; ++bj) {
                    const size_t off = (size_t)row * DM + col0 + bj * HALF;
                    const f32x4 v0 = acc[ai][bj][m][0] + bv[m][bj][0], v1 = acc[ai][bj][m][1] + bv[m][bj][1];
                    ss += (v0[0] * v0[0] + v0[1] * v0[1]) + (v0[2] * v0[2] + v0[3] * v0[3]) + (v1[0] * v1[0] + v1[1] * v1[1]) + (v1[2] * v1[2] + v1[3] * v1[3]);
                    *(GAS f32x4*)(G_(out) + off) = v0; *(GAS f32x4*)(G_(out) + off + 4) = v1;
                    u32x4 w; w.x = pk2(v0[0], v0[1]); w.y = pk2(v0[2], v0[3]); w.z = pk2(v1[0], v1[1]); w.w = pk2(v1[2], v1[3]);
                    *(GAS u32x4*)(G_(xb) + off) = w;
                }
                ss += __shfl_xor(ss, 16); ss += __shfl_xor(ss, 32); if (fq == 0) ssq_add(ssq_out + row, ss);
            }
        }
    }
};


#define DPP_SHR1(old, src) __builtin_bit_cast(float, __builtin_amdgcn_update_dpp(__builtin_bit_cast(int, (float)(old)), __builtin_bit_cast(int, (float)(src)), 0x111, 0xf, 0xf, false))
#define DPP_SHR2(old, src) __builtin_bit_cast(float, __builtin_amdgcn_update_dpp(__builtin_bit_cast(int, (float)(old)), __builtin_bit_cast(int, (float)(src)), 0x112, 0xf, 0xf, false))
#define DPP_ROR1(src) __builtin_bit_cast(float, __builtin_amdgcn_update_dpp(0, __builtin_bit_cast(int, (float)(src)), 0x121, 0xf, 0xf, false))
#define DPP_ROR2(src) __builtin_bit_cast(float, __builtin_amdgcn_update_dpp(0, __builtin_bit_cast(int, (float)(src)), 0x122, 0xf, 0xf, false))
struct EpiUpConv {
    static constexpr bool PERM = true;
    bf16_t* ACT; float* EDGE; const u64* ssq_in; const float* cw; const float* cb; LAS float* halo;
    __device__ __forceinline__ void operator()(f32x4 (&acc)[2][2][4][2], const Unit& u, int wr, int wc, int fr, int fq) const {
        const int row0 = u.pm * BM + wr * 64 + fr;
        const int g0 = u.pn * 128 + wc * 32 + 8 * fq;
#pragma unroll
        for (int ai = 0; ai < 2; ++ai)
#pragma unroll
            for (int m = 0; m < 4; ++m) {
                const float sc = rsqrtf(ssq_get(ssq_in + row0 + ai * HALF + m * 16) * (1.0f / DM) + EPS);
#pragma unroll
                for (int bj = 0; bj < 2; ++bj)
#pragma unroll
                    for (int n = 0; n < 2; ++n) acc[ai][bj][m][n] = acc[ai][bj][m][n] * sc;
            }
        if (fr >= 14) {
#pragma unroll
            for (int ai = 0; ai < 2; ++ai) { LAS float* hp = halo + ((((2 * ai + wr) * 4 + wc) * 2 + (fr - 14)) * 4 + fq) * 16;
#pragma unroll
                for (int bj = 0; bj < 2; ++bj)
#pragma unroll
                    for (int n = 0; n < 2; ++n) *(LAS f32x4*)(hp + bj * 8 + n * 4) = acc[ai][bj][3][n]; }
            if (wr == 1) { GAS float* ep = G_(EDGE) + (size_t)(u.pm * 4 + 2 + fr - 14) * DFF2 + g0;
#pragma unroll
                for (int bj = 0; bj < 2; ++bj)
#pragma unroll
                    for (int n = 0; n < 2; ++n) *(GAS f32x4*)(ep + bj * DFF + 4 * n) = acc[1][bj][3][n]; }
        }
        if (fr < 2 && wr == 0) { GAS float* ep = G_(EDGE) + (size_t)(u.pm * 4 + fr) * DFF2 + g0;
#pragma unroll
            for (int bj = 0; bj < 2; ++bj)
#pragma unroll
                for (int n = 0; n < 2; ++n) *(GAS f32x4*)(ep + bj * DFF + 4 * n) = acc[0][bj][0][n]; }
        asm volatile("s_waitcnt lgkmcnt(0)" ::: "memory"); __builtin_amdgcn_s_barrier(); asm volatile("" ::: "memory");
#pragma unroll
        for (int n = 0; n < 2; ++n) {
            const int gc = g0 + 4 * n;
            GAS const float* cwg = G_(cw); GAS const float* cbg = G_(cb);
            const f32x4 wg0 = *(GAS const f32x4*)(cwg + gc), wg1 = *(GAS const f32x4*)(cwg + DFF2 + gc), wg2 = *(GAS const f32x4*)(cwg + 2 * DFF2 + gc), bgv = *(GAS const f32x4*)(cbg + gc);
            const f32x4 wu0 = *(GAS const f32x4*)(cwg + DFF + gc), wu1 = *(GAS const f32x4*)(cwg + DFF2 + DFF + gc), wu2 = *(GAS const f32x4*)(cwg + 2 * DFF2 + DFF + gc), buv = *(GAS const f32x4*)(cbg + DFF + gc);
#pragma unroll
            for (int ai = 0; ai < 2; ++ai) {
                const int band = 2 * ai + wr;
                f32x4 pg = (f32x4){0.f, 0.f, 0.f, 0.f}, pu = pg;
                if (band > 0) { const LAS float* hp = halo + ((((band - 1) * 4 + wc) * 2 + (fr & 1)) * 4 + fq) * 16; pg = *(const LAS f32x4*)(hp + n * 4); pu = *(const LAS f32x4*)(hp + 8 + n * 4); }
#pragma unroll
                for (int m = 0; m < 4; ++m) {
                    const f32x4 cg = acc[ai][0][m][n], cu = acc[ai][1][m][n];
                    float av[4];
#pragma unroll
                    for (int j = 0; j < 4; ++j) {
                        const float g1 = DPP_SHR1(DPP_ROR1(pg[j]), cg[j]), g2 = DPP_SHR2(DPP_ROR2(pg[j]), cg[j]);
                        const float u1 = DPP_SHR1(DPP_ROR1(pu[j]), cu[j]), u2 = DPP_SHR2(DPP_ROR2(pu[j]), cu[j]);
                        const float yg = bgv[j] + wg0[j] * g2 + wg1[j] * g1 + wg2[j] * cg[j];
                        const float yu = buv[j] + wu0[j] * u2 + wu1[j] * u1 + wu2[j] * cu[j];
                        av[j] = silu_f(yg) * yu;
                    }
                    *(GAS u32x2*)(G_(ACT) + (size_t)(row0 + ai * HALF + m * 16) * DFF + gc) = (u32x2){pk2(av[0], av[1]), pk2(av[2], av[3])};
                    pg = cg; pu = cu;
                }
            }
        }
    }
};

template <class Epi, bool MIDSCALE = false>
__device__ __forceinline__ void gemm_phase(LAS unsigned char* lds, const Gemm g, const StaticOrder& S, const Epi& E, int wv) {
    int tid_ = wv * 64 + lane_id_(); LAUNDER_V(tid_);
    const int tid = tid_, wid = __builtin_amdgcn_readfirstlane(tid >> 6), lane = tid & 63, wr = wid >> 2, wc = wid & 3, fr = lane & 15, fq = lane >> 4;
    const int K = g.K, nt = K / BK;
    unsigned voffA[2], voffB[2];
#pragma unroll
    for (int i = 0; i < 2; ++i) { int R, C; stage_rc(tid * 16 + i * 8192, R, C); const int Rb = Epi::PERM ? ((R & ~31) + perm32(R & 31)) : R;
        voffA[i] = (unsigned)(R * g.lda + C) * 2u; voffB[i] = (unsigned)(Rb * K + C) * 2u; }
    const size_t kstep = (size_t)(BK * 2);
    const size_t hstepA = (size_t)HALF * g.lda * 2, hstepB = (size_t)HALF * K * 2;
    const size_t tstepA = 2 * hstepA, tstepB = 2 * hstepB;
    const unsigned ldsw = (unsigned)wid * 1024u;
    const int aoff = lds_byte(wr * 64 + fr, fq * 8), boff = lds_byte(wc * 32 + fr, fq * 8);
#define PG8_SA(b, h) (((b) * 2 + (h)) * HTB)
#define PG8_SB(b, h) ((4 + (b) * 2 + (h)) * HTB)
#define PG8_STAGE(bufoff, gbase, voff) do { _Pragma("unroll") for (int _i = 0; _i < 2; ++_i) \
        __builtin_amdgcn_global_load_lds((const unsigned*)((const char*)(gbase) + (voff)[_i]), (LAS unsigned*)(lds + (bufoff) + ldsw + _i * 8192), 16, 0, 0); } while (0)
#define PG8_LDA(dst, b, h) do { _Pragma("unroll") for (int m = 0; m < 4; ++m) _Pragma("unroll") for (int k = 0; k < 2; ++k) dst[m][k] = *(const LAS bf16x8*)(lds + PG8_SA(b, h) + aoff + m * 2048 + k * 1024); } while (0)
#define PG8_LDB(dst, b, h) do { _Pragma("unroll") for (int n = 0; n < 2; ++n) _Pragma("unroll") for (int k = 0; k < 2; ++k) dst[n][k] = *(const LAS bf16x8*)(lds + PG8_SB(b, h) + boff + n * 2048 + k * 1024); } while (0)
#define PG8_MMA(ai, bj, At, Bt) do { __builtin_amdgcn_s_setprio(1); _Pragma("unroll") for (int m = 0; m < 4; ++m) _Pragma("unroll") for (int n = 0; n < 2; ++n) _Pragma("unroll") for (int k = 0; k < 2; ++k) \
        acc[ai][bj][m][n] = __builtin_amdgcn_mfma_f32_16x16x32_bf16(Bt[n][k], At[m][k], acc[ai][bj][m][n], 0, 0, 0); __builtin_amdgcn_s_setprio(0); } while (0)
#define PG8_WAIT_V(n) asm volatile("s_waitcnt vmcnt(" #n ")" ::: "memory")
#define PG8_WAIT_L(n) asm volatile("s_waitcnt lgkmcnt(" #n ")" ::: "memory")
#define PG8_BAR __builtin_amdgcn_s_barrier()
#define PG8_SCHED __builtin_amdgcn_sched_barrier(0)
    Unit cur, nxt; int ui = 0;
    if (!S.next(0, cur)) return;
    f32x4 acc[2][2][4][2];
#pragma unroll
    for (int a = 0; a < 2; ++a)
#pragma unroll
        for (int b = 0; b < 2; ++b)
#pragma unroll
            for (int m = 0; m < 4; ++m)
#pragma unroll
                for (int n = 0; n < 2; ++n) acc[a][b][m][n] = (f32x4){0.f, 0.f, 0.f, 0.f};
    bf16x8 At[4][2], B0[2][2], B1[2][2];
    const char* cA = (const char*)g.A + (size_t)cur.pm * tstepA; const char* cB = (const char*)g.Bt + (size_t)cur.pn * tstepB;
    PG8_STAGE(PG8_SB(0, 0), cB, voffB); PG8_STAGE(PG8_SB(0, 1), cB + hstepB, voffB); PG8_STAGE(PG8_SA(0, 0), cA, voffA); PG8_STAGE(PG8_SA(0, 1), cA + hstepA, voffA);
    if (wr == 1) PG8_BAR;
    PG8_WAIT_V(2); PG8_BAR;
    PG8_STAGE(PG8_SB(1, 0), cB + kstep, voffB); PG8_STAGE(PG8_SA(1, 0), cA + kstep, voffA); PG8_STAGE(PG8_SB(1, 1), cB + hstepB + kstep, voffB);
    PG8_WAIT_V(6); PG8_BAR;
    for (;;) {
        const bool has_next = S.next(ui + 1, nxt);
        const char* nA = has_next ? (const char*)g.A + (size_t)nxt.pm * tstepA : cA; const char* nB = has_next ? (const char*)g.Bt + (size_t)nxt.pn * tstepB : cB;
        for (int t = 0; t < nt; t += 2) {
            const bool last = (t == nt - 2);
            const char* a1 = cA + (size_t)(t + 1) * kstep;
            const char* a2 = last ? nA : cA + (size_t)(t + 2) * kstep; const char* b2 = last ? nB : cB + (size_t)(t + 2) * kstep;
            const char* a3 = a2 + kstep; const char* b3 = b2 + kstep;
            if constexpr (MIDSCALE) { if (t == nt / 2) {
#pragma unroll
                for (int ai = 0; ai < 2; ++ai)
#pragma unroll
                    for (int m = 0; m < 4; ++m) { const float sc = rsqrtf(ssq_get(g.mid_ssq + cur.pm * BM + ai * HALF + wr * 64 + m * 16 + fr) * g.mid_inv + EPS);
#pragma unroll
                        for (int bj = 0; bj < 2; ++bj)
#pragma unroll
                            for (int n = 0; n < 2; ++n) acc[ai][bj][m][n] = acc[ai][bj][m][n] * sc; } } }
            PG8_LDB(B0, 0, 0); PG8_LDB(B1, 0, 1); PG8_SCHED; PG8_LDA(At, 0, 0); PG8_STAGE(PG8_SA(1, 1), a1 + hstepA, voffA);
            PG8_WAIT_V(8); PG8_WAIT_L(0); PG8_BAR; PG8_MMA(0, 0, At, B0); PG8_MMA(0, 1, At, B1); PG8_BAR; PG8_SCHED;
            PG8_LDA(At, 0, 1); PG8_STAGE(PG8_SB(0, 0), b2, voffB); PG8_STAGE(PG8_SB(0, 1), b2 + hstepB, voffB); PG8_STAGE(PG8_SA(0, 0), a2, voffA);
            PG8_WAIT_V(8); PG8_WAIT_L(0); PG8_BAR; PG8_MMA(1, 0, At, B0); PG8_MMA(1, 1, At, B1); PG8_BAR; PG8_SCHED;
            PG8_LDB(B0, 1, 0); PG8_LDB(B1, 1, 1); PG8_SCHED; PG8_LDA(At, 1, 0); PG8_STAGE(PG8_SA(0, 1), a2 + hstepA, voffA);
            PG8_WAIT_V(8); PG8_WAIT_L(0); PG8_BAR; PG8_MMA(0, 0, At, B0); PG8_MMA(0, 1, At, B1); PG8_BAR; PG8_SCHED;
            PG8_LDA(At, 1, 1); PG8_STAGE(PG8_SB(1, 0), b3, voffB); PG8_STAGE(PG8_SB(1, 1), b3 + hstepB, voffB); PG8_STAGE(PG8_SA(1, 0), a3, voffA);
            PG8_WAIT_V(8); PG8_WAIT_L(0); PG8_BAR; PG8_MMA(1, 0, At, B0); PG8_MMA(1, 1, At, B1); PG8_BAR; PG8_SCHED;
        }
        if (wr == 0) PG8_BAR;
        { int frE = fr, fqE = fq; LAUNDER_V(frE); LAUNDER_V(fqE); E(acc, cur, wr, wc, frE, fqE); }
        if (!has_next) break;
#pragma unroll
        for (int a = 0; a < 2; ++a)
#pragma unroll
            for (int b = 0; b < 2; ++b)
#pragma unroll
                for (int m = 0; m < 4; ++m)
#pragma unroll
                    for (int n = 0; n < 2; ++n) acc[a][b][m][n] = (f32x4){0.f, 0.f, 0.f, 0.f};
        cur = nxt; cA = nA; cB = nB; ++ui;
        if (wr == 1) PG8_BAR;
    }
    PG8_WAIT_V(0);
    PG8_BAR;
#undef PG8_SA
#undef PG8_SB
#undef PG8_STAGE
#undef PG8_LDA
#undef PG8_LDB
#undef PG8_MMA
#undef PG8_WAIT_V
#undef PG8_WAIT_L
#undef PG8_BAR
#undef PG8_SCHED
}
}

constexpr int RING_BYTES = 131072;
constexpr int LDS_BYTES = 147456;

struct Args { const float* in[20]; float* out; unsigned char* ws; float inv_freq[32]; };
typedef const __attribute__((address_space(4))) Args* KAP_T;

#define DS_READ4(r0, r1, r2, r3, addr, o0, o1, o2, o3) asm volatile("ds_read_b128 %0, %4 offset:%5\n\tds_read_b128 %1, %4 offset:%6\n\tds_read_b128 %2, %4 offset:%7\n\tds_read_b128 %3, %4 offset:%8" \
    : "=&v"(r0), "=&v"(r1), "=&v"(r2), "=&v"(r3) : "v"(addr), "i"(o0), "i"(o1), "i"(o2), "i"(o3) : "memory")
#define LGKM_WAIT4(n, r0, r1, r2, r3) asm volatile("s_waitcnt lgkmcnt(" #n ")" : "+v"(r0), "+v"(r1), "+v"(r2), "+v"(r3) :: "memory")
#define MFMA32(a, b, c) __builtin_amdgcn_mfma_f32_32x32x16_bf16((a), (b), (c), 0, 0, 0)
__device__ __forceinline__ int crow(int r, int hi) { return (r & 3) + 8 * (r >> 2) + 4 * hi; }

__device__ __forceinline__ void wt_item(const float* __restrict__ W, int K, int N, const float* __restrict__ gain, int gainK, bf16_t* WT, LAS float* scr, int item, int nblk, int lane, bool remap_up = false) {
    const int kb = item / nblk, nb = item % nblk, k0 = 64 * kb, n0 = 32 * nb;
    const int ns0 = remap_up ? (((n0 & 255) < 128) ? 128 * (n0 >> 8) + (n0 & 255) : DFF + 128 * (n0 >> 8) + (n0 & 255) - 128) : n0;
    const int n = ns0 + (lane & 31);
    float wv[32];
#pragma unroll
    for (int i = 0; i < 32; ++i) { const int kk = 2 * i + (lane >> 5); wv[i] = (n < N) ? G_(W)[(size_t)(k0 + kk) * N + n] : 0.f; }
#pragma unroll
    for (int i = 0; i < 32; ++i) { const int kk = 2 * i + (lane >> 5); scr[kk * 33 + (lane & 31)] = wv[i]; }
    asm volatile("s_waitcnt lgkmcnt(0)" ::: "memory");
    const int c = lane & 7;
    f32x4 g0 = (f32x4){1.f, 1.f, 1.f, 1.f}, g1 = g0;
    if (k0 < gainK) { g0 = *(GAS const f32x4*)(G_(gain) + k0 + 8 * c); g1 = *(GAS const f32x4*)(G_(gain) + k0 + 8 * c + 4); }
#pragma unroll
    for (int j = 0; j < 4; ++j) { const int nn = (lane >> 3) + 8 * j; const LAS float* s = scr + (8 * c) * 33 + nn;
        u32x4 o; o.x = pk2(s[0 * 33] * g0[0], s[1 * 33] * g0[1]); o.y = pk2(s[2 * 33] * g0[2], s[3 * 33] * g0[3]); o.z = pk2(s[4 * 33] * g1[0], s[5 * 33] * g1[1]); o.w = pk2(s[6 * 33] * g1[2], s[7 * 33] * g1[3]);
        *(GAS u32x4*)(G_(WT) + (size_t)(n0 + nn) * K + k0 + 8 * c) = o; }
    asm volatile("s_waitcnt lgkmcnt(0)" ::: "memory");
}

constexpr int AT_KB = 3 * 8192, AT_VB = 16384, AT_NBUF = 3, AT_BUF = AT_KB + AT_VB  , AT_WSF = AT_NBUF * AT_BUF;
static_assert(AT_WSF + 8 * 128 <= RING_BYTES, "attn lds");
#define DS_READ4X(r0, r1, r2, r3, a0, a1, a2, a3, o0, o1, o2, o3) asm volatile("ds_read_b128 %0, %4 offset:%8\n\tds_read_b128 %1, %5 offset:%9\n\tds_read_b128 %2, %6 offset:%10\n\tds_read_b128 %3, %7 offset:%11" \
    : "=&v"(r0), "=&v"(r1), "=&v"(r2), "=&v"(r3) : "v"(a0), "v"(a1), "v"(a2), "v"(a3), "i"(o0), "i"(o1), "i"(o2), "i"(o3) : "memory")

__device__ __forceinline__ void attn_unit(LAS unsigned char* L, const bf16_t* Q_, const bf16_t* Kg_, const bf16_t* Vt_, bf16_t* mix_, u64* ssq_a, int h, int qb, int wv, const int* pos_, const float* qn_, KAP_T kap) {
    GAS const bf16_t* Q = G_(Q_); GAS const bf16_t* Kg = G_(Kg_); GAS const bf16_t* Vt = G_(Vt_); GAS bf16_t* mix = G_(mix_);
    int tid_ = wv * 64 + lane_id_(); LAUNDER_V(tid_);
    const int tid = tid_, lane = tid & 63, w = __builtin_amdgcn_readfirstlane(tid >> 6), r32 = lane & 31, hh = lane >> 5;
    const int q0 = qb * 256;
    bf16x8 qf[12];
    {
        const int qrow_i = q0 + 32 * w + r32;
        GAS const bf16_t* qrow = Q + (size_t)qrow_i * QW + h * QKD + 8 * hh;
        u32x4 raw[12];
#pragma unroll
        for (int ks = 0; ks < 12; ++ks) raw[ks] = *(GAS const u32x4*)(qrow + 16 * ks);
        const float posf = (float)G_(pos_)[qrow_i];
        float ss = 0.f;
#pragma unroll
        for (int ks = 0; ks < 12; ++ks)
#pragma unroll
            for (int jj = 0; jj < 4; ++jj) { const float lo = bflo(raw[ks][jj]), hi = bfhi(raw[ks][jj]); ss += lo * lo + hi * hi; }
        ss += __shfl_xor(ss, 32);
        const float rs = rsqrtf(ss * (1.0f / QKD) + EPS) * (0.07216878364870322f * 1.4426950408889634f);
        GAS const float* qn = G_(qn_) + 8 * hh;
#pragma unroll
        for (int ks = 0; ks < 8; ++ks) { const f32x4 g0 = *(GAS const f32x4*)(qn + 16 * ks), g1 = *(GAS const f32x4*)(qn + 16 * ks + 4);
            u32x4 o_; o_.x = pk2(bflo(raw[ks].x) * rs * g0[0], bfhi(raw[ks].x) * rs * g0[1]); o_.y = pk2(bflo(raw[ks].y) * rs * g0[2], bfhi(raw[ks].y) * rs * g0[3]);
            o_.z = pk2(bflo(raw[ks].z) * rs * g1[0], bfhi(raw[ks].z) * rs * g1[1]); o_.w = pk2(bflo(raw[ks].w) * rs * g1[2], bfhi(raw[ks].w) * rs * g1[3]);
            qf[ks] = __builtin_bit_cast(bf16x8, o_); }
#pragma unroll
        for (int a = 0; a < 2; ++a) {
            const f32x4 ga0 = *(GAS const f32x4*)(qn + 16 * (8 + a)), ga1 = *(GAS const f32x4*)(qn + 16 * (8 + a) + 4), gb0 = *(GAS const f32x4*)(qn + 16 * (10 + a)), gb1 = *(GAS const f32x4*)(qn + 16 * (10 + a) + 4);
            float x1[8], x2[8], y1[8], y2[8];
#pragma unroll
            for (int jj = 0; jj < 4; ++jj) { x1[2 * jj] = bflo(raw[8 + a][jj]); x1[2 * jj + 1] = bfhi(raw[8 + a][jj]); x2[2 * jj] = bflo(raw[10 + a][jj]); x2[2 * jj + 1] = bfhi(raw[10 + a][jj]); }
#pragma unroll
            for (int j = 0; j < 8; ++j) {
                const float ang = posf * kap->inv_freq[16 * a + 8 * hh + j];
                double rev = (double)ang * 0.15915494309189535; rev -= __builtin_rint(rev);
                const float sn = __builtin_amdgcn_sinf((float)rev), cs = __builtin_amdgcn_cosf((float)rev);
                const float n1 = x1[j] * rs * (j < 4 ? ga0[j & 3] : ga1[j & 3]), n2 = x2[j] * rs * (j < 4 ? gb0[j & 3] : gb1[j & 3]);
                y1[j] = n1 * cs - n2 * sn; y2[j] = n2 * cs + n1 * sn;
            }
            qf[8 + a] = __builtin_bit_cast(bf16x8, (u32x4){pk2(y1[0], y1[1]), pk2(y1[2], y1[3]), pk2(y1[4], y1[5]), pk2(y1[6], y1[7])});
            qf[10 + a] = __builtin_bit_cast(bf16x8, (u32x4){pk2(y2[0], y2[1]), pk2(y2[2], y2[3]), pk2(y2[4], y2[5]), pk2(y2[6], y2[7])});
        }
    }
    f32x16 o[4];
#pragma unroll
    for (int d = 0; d < 4; ++d)
#pragma unroll
        for (int i = 0; i < 16; ++i) o[d][i] = 0.f;
    float l_run = 0.f;
    const int NT = 4 * qb + 4, my_last = 4 * qb + (w >> 1);
    volatile LAS float* wsf = (volatile LAS float*)(L + AT_WSF) + w * 32;
    const unsigned lds_base = (unsigned)(uintptr_t)L;
#define AT_FOFF(j, lz, bo) (lds_base + (bo) + (unsigned)((((lz) & 31) >> 1) * 256 + ((((((lz) & 31) & 1) * 8) + 2 * (j) + ((lz) >> 5)) ^ ((((lz) & 31) >> 1) & 7)) * 16))
    const int du = 4 * w + (lane >> 4), dsl = lane & 15, drb = dsl >> 3, dc = (dsl & 7) ^ (du & 7);
    GAS const bf16_t* ksrc = Kg + (size_t)(2 * du + drb) * QW + h * QKD + dc * 8;
    GAS const bf16_t* vsrc = Vt + (size_t)(h * VD + 2 * du + drb) * SEQ + dc * 8;
#define AT_DMA(t, bi) do { const int kv0_ = (t) * 64; \
    _Pragma("unroll") for (int i = 0; i < 3; ++i) __builtin_amdgcn_global_load_lds((const unsigned*)(ksrc + (size_t)kv0_ * QW + i * 64), (LAS unsigned*)(L + (bi) * AT_BUF + (8 * i + w) * 1024), 16, 0, 0); \
    _Pragma("unroll") for (int i = 0; i < 2; ++i) __builtin_amdgcn_global_load_lds((const unsigned*)(vsrc + (size_t)i * 64 * SEQ + kv0_), (LAS unsigned*)(L + (bi) * AT_BUF + AT_KB + (8 * i + w) * 1024), 16, 0, 0); } while (0)
    AT_DMA(0, 0); AT_DMA(1, 1);
    asm volatile("s_waitcnt vmcnt(5)" ::: "memory"); __builtin_amdgcn_s_barrier(); asm volatile("" ::: "memory");
    int bcur = 0, bnx2 = 2;
    for (int t = 0; t < NT; ++t) {
        if (t + 2 < NT) AT_DMA(t + 2, bnx2);
        if (t <= my_last) {
            int lz_ = lane; LAUNDER_V(lz_); const unsigned bo_ = (unsigned)bcur * AT_BUF;
            const unsigned ka0 = AT_FOFF(0, lz_, bo_), ka1 = AT_FOFF(1, lz_, bo_), ka2 = AT_FOFF(2, lz_, bo_), ka3 = AT_FOFF(3, lz_, bo_);
            f32x16 p0, p1;
#pragma unroll
            for (int i = 0; i < 16; ++i) { p0[i] = 0.f; p1[i] = 0.f; }
            bf16x8 fa0, fa1, fa2, fa3, fb0, fb1, fb2, fb3, fc0, fc1, fc2, fc3;
#define QK_RD(s0, s1, s2, s3, kb, g) DS_READ4X(s0, s1, s2, s3, ka0, ka1, ka2, ka3, (g) * 8192 + (kb) * 4096, (g) * 8192 + (kb) * 4096, (g) * 8192 + (kb) * 4096, (g) * 8192 + (kb) * 4096)
#define QK_MM(s0, s1, s2, s3, P, g) do { P = MFMA32(s0, qf[4 * (g)], P); P = MFMA32(s1, qf[4 * (g) + 1], P); P = MFMA32(s2, qf[4 * (g) + 2], P); P = MFMA32(s3, qf[4 * (g) + 3], P); } while (0)
#define PV_RD(s0, s1, s2, s3, va) DS_READ4(s0, s1, s2, s3, va, AT_KB, AT_KB + 4096, AT_KB + 8192, AT_KB + 12288)
#define PV_PK(P, ss) __builtin_bit_cast(bf16x8, (u32x4){pk2(P[8 * (ss) + 0], P[8 * (ss) + 1]), pk2(P[8 * (ss) + 2], P[8 * (ss) + 3]), pk2(P[8 * (ss) + 4], P[8 * (ss) + 5]), pk2(P[8 * (ss) + 6], P[8 * (ss) + 7])})
#define PV_MM(s0, s1, s2, s3, xs) do { o[0] = MFMA32(xs, s0, o[0]); o[1] = MFMA32(xs, s1, o[1]); o[2] = MFMA32(xs, s2, o[2]); o[3] = MFMA32(xs, s3, o[3]); } while (0)
            QK_RD(fa0, fa1, fa2, fa3, 0, 0);
            QK_RD(fb0, fb1, fb2, fb3, 0, 1);
            QK_RD(fc0, fc1, fc2, fc3, 0, 2); LGKM_WAIT4(8, fa0, fa1, fa2, fa3); QK_MM(fa0, fa1, fa2, fa3, p0, 0);
            QK_RD(fa0, fa1, fa2, fa3, 1, 0); LGKM_WAIT4(8, fb0, fb1, fb2, fb3); QK_MM(fb0, fb1, fb2, fb3, p0, 1);
            QK_RD(fb0, fb1, fb2, fb3, 1, 1); LGKM_WAIT4(8, fc0, fc1, fc2, fc3); QK_MM(fc0, fc1, fc2, fc3, p0, 2);
            float ls0 = 0.f, ls1 = 0.f;
#pragma unroll
            for (int i = 0; i < 16; ++i) { p0[i] = __builtin_amdgcn_exp2f(__builtin_amdgcn_fmed3f(p0[i], -1000.f, 100.f)); ls0 += p0[i]; }
            QK_RD(fc0, fc1, fc2, fc3, 1, 2); LGKM_WAIT4(8, fa0, fa1, fa2, fa3); QK_MM(fa0, fa1, fa2, fa3, p1, 0);
            PV_RD(fa0, fa1, fa2, fa3, ka0);  LGKM_WAIT4(8, fb0, fb1, fb2, fb3); QK_MM(fb0, fb1, fb2, fb3, p1, 1);
            PV_RD(fb0, fb1, fb2, fb3, ka1);  LGKM_WAIT4(8, fc0, fc1, fc2, fc3); QK_MM(fc0, fc1, fc2, fc3, p1, 2);
            { const bf16x8 x00 = PV_PK(p0, 0), x01 = PV_PK(p0, 1);
#pragma unroll
              for (int i = 0; i < 16; ++i) { p1[i] = __builtin_amdgcn_exp2f(__builtin_amdgcn_fmed3f(p1[i], -1000.f, 100.f)); ls1 += p1[i]; }
              PV_RD(fc0, fc1, fc2, fc3, ka2); LGKM_WAIT4(8, fa0, fa1, fa2, fa3); PV_MM(fa0, fa1, fa2, fa3, x00);
              PV_RD(fa0, fa1, fa2, fa3, ka3); LGKM_WAIT4(8, fb0, fb1, fb2, fb3); PV_MM(fb0, fb1, fb2, fb3, x01);
              const bf16x8 x10 = PV_PK(p1, 0), x11 = PV_PK(p1, 1);
              LGKM_WAIT4(4, fc0, fc1, fc2, fc3); PV_MM(fc0, fc1, fc2, fc3, x10);
              LGKM_WAIT4(0, fa0, fa1, fa2, fa3); PV_MM(fa0, fa1, fa2, fa3, x11); }
            l_run += ls0 + ls1;
#undef QK_RD
#undef QK_MM
#undef PV_RD
#undef PV_PK
#undef PV_MM
        }
        if (t + 2 < NT) asm volatile("s_waitcnt vmcnt(5) lgkmcnt(0)" ::: "memory"); else asm volatile("s_waitcnt vmcnt(0) lgkmcnt(0)" ::: "memory");
        __builtin_amdgcn_s_barrier(); asm volatile("" ::: "memory");
        bcur = (bcur == 2) ? 0 : bcur + 1; bnx2 = (bnx2 == 2) ? 0 : bnx2 + 1;
    }
#undef AT_DMA
#undef AT_FOFF
    const float lt = l_run + __shfl_xor(l_run, 32);
    wsf[r32] = 1.0f / lt;
    asm volatile("s_waitcnt lgkmcnt(0)" ::: "memory");
    GAS bf16_t* orow = mix + (size_t)(q0 + 32 * w) * DM + h * VD + r32;
#pragma unroll
    for (int i = 0; i < 16; ++i) { const int qr = crow(i, hh); const float a = wsf[qr]; float ss = 0.f;
#pragma unroll
        for (int d = 0; d < 4; ++d) { const float v = o[d][i] * a; ss += v * v; orow[(size_t)qr * DM + 32 * d] = (bf16_t)f2bf(v); }
        ss += __shfl_xor(ss, 1); ss += __shfl_xor(ss, 2); ss += __shfl_xor(ss, 4); ss += __shfl_xor(ss, 8); ss += __shfl_xor(ss, 16);
        if (r32 == 0) ssq_add(ssq_a + q0 + 32 * w + qr, ss); }
    __syncthreads();
}

constexpr int GL_V = 0  , GL_KD = 32768  , GL_TOT = GL_KD + 18432  , GL_ZA = GL_TOT + 2048  ;
__device__ __forceinline__ void gla_chunk_unit(LAS unsigned char* L, const bf16_t* Z_, const float* wgate_, const float* bgate_, bf16_t* ST_, float* DEC_, int c, int h, int wv) {
    GAS const bf16_t* Z = G_(Z_); GAS const float* wgate = G_(wgate_); GAS const float* bgate = G_(bgate_); GAS bf16_t* ST = G_(ST_); GAS float* DEC = G_(DEC_);
    int tid_ = wv * 64 + lane_id_(); LAUNDER_V(tid_);
    const int tid = tid_, lane = tid & 63, w = __builtin_amdgcn_readfirstlane(tid >> 6), r32 = lane & 31, hh = lane >> 5;
    const size_t row0 = (size_t)c * 64;
#pragma unroll
    for (int i = 0; i < 4; ++i) { const int id = tid + 512 * i, r = id >> 5, cc = id & 31;
        *(LAS u32x4*)(L + GL_V + r * 512 + cc * 16) = *(GAS const u32x4*)(Z + (row0 + r) * IN_PAD + C_GV + h * GDV + cc * 8); }
#pragma unroll
    for (int i = 0; i < 2; ++i) { const int id = tid + 512 * i, r = id >> 4, cc = id & 15;
        ((LAS float*)(L + GL_ZA))[id] = bf2f(Z[(row0 + r) * IN_PAD + C_GA + cc]); }
    __syncthreads();
    const int tq = tid >> 7, col = tid & 127;
    float wg[16];
#pragma unroll
    for (int r = 0; r < 16; ++r) wg[r] = wgate[r * (GH * GDK) + h * GDK + col];
    const float bg = bgate[h * GDK + col];
    float pre[16]; float run = 0.f;
#pragma unroll
    for (int i = 0; i < 16; ++i) {
        const LAS float* za = (const LAS float*)(L + GL_ZA) + (16 * tq + i) * 16;
        float ga = bg;
#pragma unroll
        for (int r = 0; r < 16; ++r) ga += za[r] * wg[r];
        const float ls = fminf(ga, 0.f) - __logf(1.0f + __expf(-fabsf(ga)));
        run += ls * (1.0f / 16.0f); pre[i] = run;
    }
    ((LAS float*)(L + GL_TOT))[tq * 128 + col] = run;
    __syncthreads();
    float off = 0.f, bend = 0.f;
#pragma unroll
    for (int t = 0; t < 4; ++t) { const float v = ((LAS float*)(L + GL_TOT))[t * 128 + col]; bend += v; if (t < tq) off += v; }
    {
        unsigned pkv[8];
#pragma unroll
        for (int i = 0; i < 16; i += 2) {
            const float k0 = bf2f(Z[(row0 + 16 * tq + i) * IN_PAD + C_GK + h * GDK + col]), k1 = bf2f(Z[(row0 + 16 * tq + i + 1) * IN_PAD + C_GK + h * GDK + col]);
            pkv[i >> 1] = pk2(k0 * __expf(bend - off - pre[i]), k1 * __expf(bend - off - pre[i + 1]));
        }
        LAS u32x4* dst = (LAS u32x4*)(L + GL_KD + col * 144 + tq * 32);
        dst[0] = (u32x4){pkv[0], pkv[1], pkv[2], pkv[3]}; dst[1] = (u32x4){pkv[4], pkv[5], pkv[6], pkv[7]};
    }
    if (tq == 0) DEC[(size_t)(c * GH + h) * GDK + col] = __expf(bend);
    __syncthreads();
    f32x16 acc[4];
#pragma unroll
    for (int d = 0; d < 4; ++d)
#pragma unroll
        for (int i = 0; i < 16; ++i) acc[d][i] = 0.f;
#pragma unroll
    for (int ks = 0; ks < 4; ++ks) {
        bf16x8 a;
#pragma unroll
        for (int j = 0; j < 8; ++j) a[j] = (short)*(const LAS unsigned short*)(L + GL_V + (16 * ks + 8 * hh + j) * 512 + (32 * w + r32) * 2);
#pragma unroll
        for (int db = 0; db < 4; ++db) {
            const bf16x8 b = *(const LAS bf16x8*)(L + GL_KD + (32 * db + r32) * 144 + (16 * ks + 8 * hh) * 2);
            acc[db] = MFMA32(a, b, acc[db]);
        }
    }
    GAS bf16_t* stp = ST + ((size_t)(c * GH + h) * GDV + 32 * w) * GDK + r32;
#pragma unroll
    for (int db = 0; db < 4; ++db)
#pragma unroll
        for (int i = 0; i < 16; ++i) stp[(size_t)crow(i, hh) * GDK + 32 * db] = (bf16_t)f2bf(acc[db][i]);
    __syncthreads();
}

constexpr int GO_STR = 260;
__device__ __forceinline__ void gla_out_unit(LAS unsigned char* L, const bf16_t* Z_, const bf16_t* ST_, const float* gnorm_, bf16_t* mix_, int c, int h, int wv) {
    GAS const bf16_t* Z = G_(Z_); GAS const bf16_t* ST = G_(ST_); GAS const float* gnorm = G_(gnorm_); GAS bf16_t* mix = G_(mix_);
    int tid_ = wv * 64 + lane_id_(); LAUNDER_V(tid_);
    const int tid = tid_, lane = tid & 63, w = __builtin_amdgcn_readfirstlane(tid >> 6), r32 = lane & 31, hh = lane >> 5;
    const size_t row0 = (size_t)c * 64;
    f32x16 acc[2];
#pragma unroll
    for (int d = 0; d < 2; ++d)
#pragma unroll
        for (int i = 0; i < 16; ++i) acc[d][i] = 0.f;
    GAS const bf16_t* sp = ST + ((size_t)(c * GH + h) * GDV + 32 * w + r32) * GDK + 8 * hh;
#pragma unroll
    for (int ks = 0; ks < 8; ++ks) {
        const bf16x8 b = *(GAS const bf16x8*)(sp + 16 * ks);
#pragma unroll
        for (int tb = 0; tb < 2; ++tb) {
            const bf16x8 a = *(GAS const bf16x8*)(Z + (row0 + 32 * tb + r32) * IN_PAD + C_GQ + h * GDK + 16 * ks + 8 * hh);
            acc[tb] = MFMA32(a, b, acc[tb]);
        }
    }
    LAS float* of = (LAS float*)L;
#pragma unroll
    for (int tb = 0; tb < 2; ++tb)
#pragma unroll
        for (int i = 0; i < 16; ++i) of[(32 * tb + crow(i, hh)) * GO_STR + 32 * w + r32] = acc[tb][i] * 0.08838834764831845f;
    __syncthreads();
    const int tok = tid >> 3, part = tid & 7;
    f32x4 v[4][2]; float ss = 0.f;
#pragma unroll
    for (int j = 0; j < 4; ++j)
#pragma unroll
        for (int q = 0; q < 2; ++q) { v[j][q] = *(const LAS f32x4*)(of + tok * GO_STR + part * 8 + 64 * j + 4 * q); ss += (v[j][q][0] * v[j][q][0] + v[j][q][1] * v[j][q][1]) + (v[j][q][2] * v[j][q][2] + v[j][q][3] * v[j][q][3]); }
    ss += __shfl_xor(ss, 1); ss += __shfl_xor(ss, 2); ss += __shfl_xor(ss, 4);
    const float rstd = rsqrtf(ss * (1.0f / GDV) + EPS);
    GAS const bf16_t* zg = Z + (row0 + tok) * IN_PAD + C_GG + h * GDV + part * 8;
    GAS bf16_t* op = mix + (row0 + tok) * DM + 1024 + h * GDV + part * 8;
#pragma unroll
    for (int j = 0; j < 4; ++j) {
        const u32x4 gw_ = *(GAS const u32x4*)(zg + 64 * j);
        const f32x4 n0 = *(GAS const f32x4*)(gnorm + part * 8 + 64 * j), n1 = *(GAS const f32x4*)(gnorm + part * 8 + 64 * j + 4);
        u32x4 ow;
        ow.x = pk2(v[j][0][0] * rstd * n0[0] * silu_f(bflo(gw_.x)), v[j][0][1] * rstd * n0[1] * silu_f(bfhi(gw_.x)));
        ow.y = pk2(v[j][0][2] * rstd * n0[2] * silu_f(bflo(gw_.y)), v[j][0][3] * rstd * n0[3] * silu_f(bfhi(gw_.y)));
        ow.z = pk2(v[j][1][0] * rstd * n1[0] * silu_f(bflo(gw_.z)), v[j][1][1] * rstd * n1[1] * silu_f(bfhi(gw_.z)));
        ow.w = pk2(v[j][1][2] * rstd * n1[2] * silu_f(bflo(gw_.w)), v[j][1][3] * rstd * n1[3] * silu_f(bfhi(gw_.w)));
        *(GAS u32x4*)(op + 64 * j) = ow;
    }
    __syncthreads();
}


#define XB_TMO      128
#define XB_XCNT(j)  (256  + 64 * (j))
#define XB_XSUB(j)  (1280 + 64 * (j))
#define XB_XGEN(j)  (2304 + 64 * (j))
#define XB_TOP      3328
#define XB_TOPGEN   3392
#define XCD_BAR_WORDS 3456
#define XB_SPIN_CAP (1u << 22)
__device__ __forceinline__ unsigned xb_ld(unsigned* p)              { return __hip_atomic_load(p, __ATOMIC_RELAXED, __HIP_MEMORY_SCOPE_AGENT); }
__device__ __forceinline__ unsigned xb_add(unsigned* p, unsigned v) { return __hip_atomic_fetch_add(p, v, __ATOMIC_RELAXED, __HIP_MEMORY_SCOPE_AGENT); }
__device__ __forceinline__ unsigned xb_xcc_id() { return (unsigned)__builtin_amdgcn_s_getreg((3 << 11) | 20) & 0xFu; }
#define XB_SPIN(cond, bar) do { unsigned _sp = 0; while (cond) { __builtin_amdgcn_s_sleep(1); \
    if ((++_sp & 255u) == 0u) { if (xb_ld(&(bar)[XB_TMO])) break; if (_sp > XB_SPIN_CAP) { atomicAdd(&(bar)[XB_TMO], 1u); break; } } } } while (0)
struct XcdBarrier { unsigned* bar; unsigned x; volatile LAS unsigned* st; };
__device__ __forceinline__ XcdBarrier xcd_barrier_post(unsigned* bar, volatile LAS unsigned* st, bool t0) {
    XcdBarrier b; b.bar = bar; b.x = xb_xcc_id(); b.st = st;
    if (t0) (void)xb_add(&bar[XB_XCNT(b.x)], 1u);
    return b;
}
__device__ __forceinline__ void xcd_barrier_complete(unsigned* bar, unsigned x, unsigned& nloc, unsigned& nx) {
    const unsigned G = gridDim.x * gridDim.y * gridDim.z;
    unsigned sum, cnt, mine, sp = 0u;
    for (;;) {
        sum = 0u; cnt = 0u; mine = 0u;
#pragma unroll
        for (unsigned j = 0; j < 16; ++j) { const unsigned c = xb_ld(&bar[XB_XCNT(j)]); sum += c; cnt += (c > 0u) ? 1u : 0u; mine = (j == x) ? c : mine; }
        if (sum == G) break;
        __builtin_amdgcn_s_sleep(1);
        if ((++sp & 255u) == 0u) { if (xb_ld(&bar[XB_TMO])) break; if (sp > XB_SPIN_CAP) { atomicAdd(&bar[XB_TMO], 1u); break; } }
    }
    nloc = mine > 0u ? mine : 1u; nx = cnt > 0u ? cnt : 1u;
}
__device__ __forceinline__ void xcd_barrier(const XcdBarrier& b, bool t0) {
    asm volatile("s_waitcnt vmcnt(0)" ::: "memory");
    __syncthreads();
    if (t0) {
        unsigned* bar = b.bar;
        __builtin_amdgcn_s_waitcnt(0);
        unsigned nloc = b.st[0], nx = b.st[1];
        if (nloc == 0u) { xcd_barrier_complete(bar, b.x, nloc, nx); b.st[0] = nloc; b.st[1] = nx; }
        const unsigned old = xb_add(&bar[XB_XSUB(b.x)], 1u);
        const unsigned gen = old / nloc;
        if (old + 1u == (gen + 1u) * nloc) {
            __builtin_amdgcn_fence(__ATOMIC_RELEASE, "agent");
            asm volatile("s_waitcnt vmcnt(0)" ::: "memory");
            const unsigned og = xb_add(&bar[XB_TOP], 1u);
            const unsigned tg = og / nx;
            if (og + 1u == (tg + 1u) * nx) xb_add(&bar[XB_TOPGEN], 1u);
            else XB_SPIN(xb_ld(&bar[XB_TOPGEN]) == tg, bar);
            __builtin_amdgcn_fence(__ATOMIC_ACQUIRE, "agent");
            xb_add(&bar[XB_XGEN(b.x)], 1u);
            asm volatile("s_waitcnt vmcnt(0)" ::: "memory");
        } else {
            XB_SPIN(xb_ld(&bar[XB_XGEN(b.x)]) == gen, bar);
            __builtin_amdgcn_fence(__ATOMIC_ACQUIRE, "agent");
            asm volatile("s_waitcnt vmcnt(0)" ::: "memory");
        }
    }
    __syncthreads();
}

__global__ void __launch_bounds__(512, 2) mk_fwd(Args a) {
    extern __shared__ __attribute__((aligned(16))) unsigned char lds[];
    cg::grid_group grid = cg::this_grid();
    LAS unsigned char* L = (LAS unsigned char*)lds;
    const int G = gridDim.x, bid = blockIdx.x, NGW = G * 8;
    volatile LAS unsigned* MISC = (volatile LAS unsigned*)(L + RING_BYTES + 8192);
    const int wave_s = __builtin_amdgcn_readfirstlane(threadIdx.x >> 6);
    if (wave_s == 0 && lane_id_() < 4) MISC[lane_id_()] = 0u;
    __syncthreads();
    { KAP_T kap0 = (KAP_T)__builtin_amdgcn_kernarg_segment_ptr(); (void)xcd_barrier_post((unsigned*)(kap0->ws + WS_BAR), MISC, wave_s == 0 && lane_id_() == 0); }
#define XSYNC() do { KAP_T kap_ = (KAP_T)__builtin_amdgcn_kernarg_segment_ptr(); LAUNDER_S(kap_); XcdBarrier xb_; xb_.bar = (unsigned*)(kap_->ws + WS_BAR); xb_.x = xb_xcc_id(); xb_.st = (volatile LAS unsigned*)(L + RING_BYTES + 8192); xcd_barrier(xb_, wave_s == 0 && lane_id_() == 0); } while (0)
#define GRID_SYNC() do { asm volatile("s_waitcnt vmcnt(0) lgkmcnt(0)" ::: "memory"); __syncthreads(); grid.sync(); \
    __builtin_amdgcn_fence(__ATOMIC_ACQUIRE, "agent"); asm volatile("s_waitcnt vmcnt(0)" ::: "memory"); __syncthreads(); } while (0)
#ifndef DBG_STOP
#define DBG_STOP 0
#endif
#define DBG_DUMP(k, EXPR) do { if (DBG_STOP == (k)) { PHASE_BEGIN(); for (int m = gw; m < SEQ; m += NGW) for (int c = lane; c < DM; c += 64) out[(size_t)m * DM + c] = (EXPR); return; } } while (0)
#define PHASE_BEGIN() KAP_T kap = (KAP_T)__builtin_amdgcn_kernarg_segment_ptr(); LAUNDER_S(kap); unsigned char* ws = kap->ws; LAUNDER_S(ws); int tid_ = wave_s * 64 + lane_id_(); LAUNDER_V(tid_); const int tid = tid_, lane = tid & 63, wave = __builtin_amdgcn_readfirstlane(tid >> 6), gw = bid * 8 + wave; \
    u64* ssq = (u64*)(ws + WS_SSQ); (void)lane; (void)gw; (void)ssq; \
    u64* ssq_x = ssq + (size_t)l * SEQ; u64* ssq_xn = ssq + (size_t)(l + 1) * SEQ; u64* ssq_cq = ssq + (size_t)(3 + l) * SEQ; u64* ssq_ckv = ssq + (size_t)(5 + l) * SEQ; u64* ssq_x1 = ssq + (size_t)(7 + l) * SEQ; u64* ssq_a = ssq + (size_t)(9 + l) * SEQ; (void)ssq_a; \
    (void)ssq_x; (void)ssq_xn; (void)ssq_cq; (void)ssq_ckv; (void)ssq_x1; \
    bf16_t* Win = (bf16_t*)(ws + WS_WIN); bf16_t* Wuq = (bf16_t*)(ws + WS_WUQ); bf16_t* Wukv = (bf16_t*)(ws + WS_WUKV); \
    bf16_t* Wout = (bf16_t*)(ws + WS_WOUT); bf16_t* Wup = (bf16_t*)(ws + WS_WUP); bf16_t* Wdn = (bf16_t*)(ws + WS_WDN); \
    bf16_t* XB = (bf16_t*)(ws + WS_XB); bf16_t* Z = (bf16_t*)(ws + WS_Z); bf16_t* Qb = (bf16_t*)(ws + WS_Q); bf16_t* Kb = (bf16_t*)(ws + WS_K); bf16_t* Vt = (bf16_t*)(ws + WS_VT); \
    bf16_t* ST = (bf16_t*)(ws + WS_ST); float* DEC = (float*)(ws + WS_DEC); bf16_t* MIX = (bf16_t*)(ws + WS_MIX); \
    bf16_t* ACT = (bf16_t*)(ws + WS_ACT); float* EDGE = (float*)(ws + WS_EDGE); \
    const float* xin = kap->in[0]; float* out = kap->out; \
    (void)Win; (void)Wuq; (void)Wukv; (void)Wout; (void)Wup; (void)Wdn; (void)XB; (void)Z; (void)Qb; (void)Kb; (void)Vt; (void)ST; (void)DEC; (void)MIX; (void)EDGE; (void)ACT; (void)xin; (void)out;

    for (int l = 0; l < NLAYER; ++l) {
        {
            PHASE_BEGIN();
            LAS float* scr = (LAS float*)(L + wave * 16384);
            const float* w_in = kap->in[3] + (size_t)l * DM * IN_DIM; const float* w_uq = kap->in[5] + (size_t)l * QLORA * QW; const float* w_ukv = kap->in[7] + (size_t)l * KVLORA * KVW;
            const float* w_out = kap->in[14] + (size_t)l * DM * DM; const float* w_up = kap->in[16] + (size_t)l * DM * DFF2; const float* w_dn = kap->in[19] + (size_t)l * DFF * DM;
            const float* g_attn = kap->in[2] + l * DM; const float* g_cq = kap->in[4] + l * QLORA; const float* g_ckv = kap->in[6] + l * KVLORA; const float* g_mla = kap->in[13] + l * 1024; const float* g_ffn = kap->in[15] + l * DM;
            constexpr int I_IN = (DM / 64) * (IN_PAD / 32), I_UQ = (QLORA / 64) * (QW / 32), I_UKV = (KVLORA / 64) * (KVW / 32), I_OUT = (DM / 64) * (DM / 32), I_UP = (DM / 64) * (DFF2 / 32), I_DN = (DFF / 64) * (DM / 32);
            constexpr int NITEMS = I_IN + I_UQ + I_UKV + I_OUT + I_UP + I_DN;
            for (int it = gw; it < NITEMS; it += NGW) {
                int r = it;
                if (r < I_IN) { wt_item(w_in, DM, IN_DIM, g_attn, DM, Win, scr, r, IN_PAD / 32, lane); continue; } r -= I_IN;
                if (r < I_UQ) { wt_item(w_uq, QLORA, QW, g_cq, QLORA, Wuq, scr, r, QW / 32, lane); continue; } r -= I_UQ;
                if (r < I_UKV) { wt_item(w_ukv, KVLORA, KVW, g_ckv, KVLORA, Wukv, scr, r, KVW / 32, lane); continue; } r -= I_UKV;
                if (r < I_OUT) { wt_item(w_out, DM, DM, g_mla, 1024, Wout, scr, r, DM / 32, lane); continue; } r -= I_OUT;
                if (r < I_UP) { wt_item(w_up, DM, DFF2, g_ffn, DM, Wup, scr, r, DFF2 / 32, lane, true); continue; } r -= I_UP;
                wt_item(w_dn, DFF, DM, g_ffn, 0, Wdn, scr, r, DM / 32, lane);
            }
            if (l == 0) {
                for (int m = gw; m < SEQ; m += NGW) {
                    GAS const f32x4* xr = (GAS const f32x4*)(G_(xin) + (size_t)m * DM) + lane; float s = 0.f;
                    GAS u32x2* o8 = (GAS u32x2*)(G_(XB) + (size_t)m * DM) + lane;
#pragma unroll
                    for (int j = 0; j < 8; ++j) { const f32x4 v = xr[64 * j]; s += (v[0] * v[0] + v[1] * v[1]) + (v[2] * v[2] + v[3] * v[3]); o8[64 * j] = (u32x2){pk2(v[0], v[1]), pk2(v[2], v[3])}; }
                    s = wave_sum(s); if (lane == 0) G_(ssq_x)[m] = (u64)(s * SSQ_FX + 0.5f);
                }
            }
        }
        XSYNC();
        {
            PHASE_BEGIN();
            pg8::Gemm g{XB, Win, SEQ, IN_PAD, DM, DM, nullptr, 0.f}; pg8::StaticOrder S; S.init(SEQ, IN_PAD, G, bid);
            pg8::EpiRowScale E{Z, IN_PAD, ssq_x, 1.0f / DM, ssq_cq, 0, 2, ssq_ckv, 2, 3};
            pg8::gemm_phase<pg8::EpiRowScale>(L, g, S, E, wave_s);
        }
        XSYNC();
        DBG_DUMP(1, bf2f(Z[(size_t)m * IN_PAD + c]) + bf2f(Z[(size_t)m * IN_PAD + 2048 + c]));
        {
            PHASE_BEGIN();
            { pg8::Gemm g{Z + C_CQ, Wuq, SEQ, QW, QLORA, IN_PAD, nullptr, 0.f}; pg8::StaticOrder S; S.init(SEQ, QW, G, bid);
              pg8::EpiRowScale E{Qb, QW, ssq_cq, 1.0f / QLORA, nullptr, 0, 0, nullptr, 0, 0};
              pg8::gemm_phase<pg8::EpiRowScale>(L, g, S, E, wave_s); }
            { pg8::Gemm g{Z + C_CKV, Wukv, SEQ, KVW, KVLORA, IN_PAD, nullptr, 0.f}; pg8::StaticOrder S; S.init(SEQ, KVW, G, bid);
              pg8::EpiUkv E{Kb, Vt, ssq_ckv, 1.0f / KVLORA, Z, (const int*)kap->in[1], kap->in[9] + l * QKD, kap->inv_freq, (LAS float*)(L + RING_BYTES)};
              pg8::gemm_phase<pg8::EpiUkv>(L, g, S, E, wave_s); }
            const float* wgate = kap->in[10] + (size_t)l * 16 * (GH * GDK); const float* bgate = kap->in[11] + (size_t)l * (GH * GDK);
            for (int u = bid; u < NCHUNK * GH; u += G) gla_chunk_unit(L, Z, wgate, bgate, ST, DEC, u >> 2, u & 3, wave_s);
        }
        if (l == 0) GRID_SYNC(); else XSYNC();
        DBG_DUMP(2, (c < QW ? bf2f(Qb[(size_t)m * QW + c]) + bf2f(Kb[(size_t)m * QW + c]) : bf2f(Vt[(size_t)(c - QW) * SEQ + m])) + bf2f(ST[(size_t)m * 8192 + c]) + bf2f(ST[(size_t)m * 8192 + 4096 + c]));
        {
            PHASE_BEGIN();
            const int* pos = (const int*)kap->in[1];
            const float* kn = kap->in[9] + l * QKD;
            constexpr int NE = GH * GDV * GDK;
            for (int e = bid * 512 + tid; e < NE; e += G * 512) {
                const int hd = (e >> 15) * GDK + (e & 127);
                float s = 0.f;
                for (int c0 = 0; c0 < NCHUNK; c0 += 8) {
                    float uu[8], dd[8];
#pragma unroll
                    for (int i = 0; i < 8; ++i) { uu[i] = bf2f(G_(ST)[(size_t)(c0 + i) * NE + e]); dd[i] = G_(DEC)[(size_t)(c0 + i) * (GH * GDK) + hd]; }
#pragma unroll
                    for (int i = 0; i < 8; ++i) { s = s * dd[i] + uu[i]; G_(ST)[(size_t)(c0 + i) * NE + e] = (bf16_t)f2bf(s); }
                }
            }
        }
        XSYNC();
        DBG_DUMP(3, (c < QW ? bf2f(Qb[(size_t)m * QW + c]) + bf2f(Kb[(size_t)m * QW + c]) : 0.f) + bf2f(ST[(size_t)m * 8192 + c]) + bf2f(ST[(size_t)m * 8192 + 4096 + c]));
        {
            PHASE_BEGIN();
            for (int p = bid; p < 256; p += G) {
                const int h = p & 7, s = p >> 3;
                attn_unit(L, Qb, Kb, Vt, MIX, ssq_a, h, 63 - s, wave_s, (const int*)kap->in[1], kap->in[8] + l * QKD, kap);
                attn_unit(L, Qb, Kb, Vt, MIX, ssq_a, h, s, wave_s, (const int*)kap->in[1], kap->in[8] + l * QKD, kap);
            }
            const float* gnorm = kap->in[12] + l * GDV;
            for (int u = bid; u < NCHUNK * GH; u += G) gla_out_unit(L, Z, ST, gnorm, MIX, u >> 2, u & 3, wave_s);
        }
        XSYNC();
        DBG_DUMP(4, bf2f(MIX[(size_t)m * DM + c]));
        DBG_DUMP(5, bf2f(MIX[(size_t)m * DM + c]));
        {
            PHASE_BEGIN();
            pg8::Gemm g{MIX, Wout, SEQ, DM, DM, DM, ssq_a, 1.0f / 1024.0f}; pg8::StaticOrder S; S.init(SEQ, DM, G, bid);
            pg8::EpiRes E{l == 0 ? xin : out, out, XB, ssq_x1};
            pg8::gemm_phase<pg8::EpiRes, true>(L, g, S, E, wave_s);
        }
        XSYNC();
        DBG_DUMP(6, out[(size_t)m * DM + c] + bf2f(XB[(size_t)m * DM + c]));
        {
            PHASE_BEGIN();
            const float* cw = kap->in[17] + (size_t)l * 3 * DFF2; const float* cb = kap->in[18] + (size_t)l * DFF2;
            pg8::Gemm g{XB, Wup, SEQ, DFF2, DM, DM, nullptr, 0.f}; pg8::StaticOrder S; S.init(SEQ, DFF2, G, bid);
            pg8::EpiUpConv E{ACT, EDGE, ssq_x1, cw, cb, (LAS float*)(L + RING_BYTES)};
            pg8::gemm_phase<pg8::EpiUpConv>(L, g, S, E, wave_s);
        }
        XSYNC();
        {
            PHASE_BEGIN();
            const float* cw = kap->in[17] + (size_t)l * 3 * DFF2; const float* cb = kap->in[18] + (size_t)l * DFF2;
            for (int idx = bid * 512 + tid; idx < 63 * DFF; idx += G * 512) {
                const int pm = 1 + idx / DFF, gcol = idx % DFF;
                float y0[2], y1[2];
#pragma unroll
                for (int q = 0; q < 2; ++q) { const int c = q * DFF + gcol;
                    const float um2 = G_(EDGE)[(size_t)((pm - 1) * 4 + 2) * DFF2 + c], um1 = G_(EDGE)[(size_t)((pm - 1) * 4 + 3) * DFF2 + c], u0 = G_(EDGE)[(size_t)(pm * 4 + 0) * DFF2 + c], u1 = G_(EDGE)[(size_t)(pm * 4 + 1) * DFF2 + c];
                    const float w0 = G_(cw)[c], w1 = G_(cw)[DFF2 + c], w2 = G_(cw)[2 * DFF2 + c], bb = G_(cb)[c];
                    y0[q] = bb + w0 * um2 + w1 * um1 + w2 * u0; y1[q] = bb + w0 * um1 + w1 * u0 + w2 * u1; }
                G_(ACT)[(size_t)(pm * 256) * DFF + gcol] = (bf16_t)f2bf(silu_f(y0[0]) * y0[1]);
                G_(ACT)[(size_t)(pm * 256 + 1) * DFF + gcol] = (bf16_t)f2bf(silu_f(y1[0]) * y1[1]);
            }
        }
        XSYNC();
        DBG_DUMP(8, bf2f(ACT[(size_t)m * DFF + c]) + bf2f(ACT[(size_t)m * DFF + 3000 + c]));
        {
            PHASE_BEGIN();
            pg8::Gemm g{ACT, Wdn, SEQ, DM, DFF, DFF, nullptr, 0.f}; pg8::StaticOrder S; S.init(SEQ, DM, G, bid);
            pg8::EpiRes E{out, out, XB, ssq_xn};
            pg8::gemm_phase<pg8::EpiRes>(L, g, S, E, wave_s);
        }
        XSYNC();
        if (DBG_STOP == 9) return;
    }
}

extern "C" void kernel_launch(void* const* d_in, const int* in_sizes, int n_in, void* d_out, int out_size, void* d_ws, size_t ws_size, hipStream_t stream) {
    static int grid = 0;
    if (grid == 0) {
        if (n_in != 20 || out_size != SEQ * DM || ws_size < WS_END) { fprintf(stderr, "kernel_launch: unexpected shapes: n_in %d out %d ws %zu (need %zu)\n", n_in, out_size, ws_size, (size_t)WS_END); grid = -1; return; }
        int dev = 0, cus = 0, per_cu = 0;
        hipGetDevice(&dev); hipDeviceGetAttribute(&cus, hipDeviceAttributeMultiprocessorCount, dev);
        hipFuncSetAttribute((const void*)mk_fwd, hipFuncAttributeMaxDynamicSharedMemorySize, LDS_BYTES);
        hipOccupancyMaxActiveBlocksPerMultiprocessor(&per_cu, (const void*)mk_fwd, 512, LDS_BYTES);
        (void)hipGetLastError();
        if (per_cu < 1) per_cu = 1;
        grid = cus * 1;
    }
    if (grid < 0) return;
    hipMemsetAsync((char*)d_ws + WS_CTL, 0, CTL_BYTES, stream);
    Args a{};
    for (int i = 0; i < 20; ++i) a.in[i] = (const float*)d_in[i];
    a.out = (float*)d_out; a.ws = (unsigned char*)d_ws;
    for (int i = 0; i < 32; ++i) a.inv_freq[i] = (float)pow(10000.0, -(double)i / 32.0);
    void* args[] = {&a};
    hipError_t e = hipLaunchCooperativeKernel((const void*)mk_fwd, dim3(grid), dim3(512), args, LDS_BYTES, stream);
    if (e != hipSuccess) fprintf(stderr, "cooperative launch failed: %s (grid %d)\n", hipGetErrorString(e), grid);
}
```

```cpp
#include <hip/hip_runtime.h>
#include <hip/hip_cooperative_groups.h>
#include <cstdio>
#include <cstdint>
#include <cmath>
namespace cg = cooperative_groups;

#define LAS __attribute__((address_space(3)))
typedef unsigned short bf16_t;
typedef unsigned long long u64;
typedef short bf16x8 __attribute__((ext_vector_type(8)));
typedef short s16x4 __attribute__((ext_vector_type(4)));
typedef float f32x4 __attribute__((ext_vector_type(4)));
typedef float f32x16 __attribute__((ext_vector_type(16)));
typedef unsigned u32x4 __attribute__((ext_vector_type(4)));
typedef unsigned u32x2 __attribute__((ext_vector_type(2)));
typedef float f32x2_t __attribute__((ext_vector_type(2)));
typedef __bf16 bf16x2_t __attribute__((ext_vector_type(2)));

constexpr int SEQ = 16384, DM = 2048, NLAYER = 2;
constexpr int IN_DIM = 3920, IN_PAD = 4096;
constexpr int C_CQ = 0, C_CKV = 512, C_KR = 768, C_GQ = 832, C_GK = 1344, C_GV = 1856, C_GA = 2880, C_GG = 2896;
constexpr int QLORA = 512, KVLORA = 256, NH = 8, QKD = 192, NOPE = 128, VD = 128, QW = NH * QKD  , KVW = NH * 256  ;
constexpr int GH = 4, GDK = 128, GDV = 256, NCHUNK = SEQ / 64;
constexpr int DFF = 5632, DFF2 = 11264;
constexpr float EPS = 1e-6f;

constexpr size_t MiB = 1u << 20;
constexpr size_t WS_CTL = 0, CTL_BYTES = 2 * MiB;
constexpr size_t WS_BAR = 0;
constexpr size_t WS_SSQ = 65536;
constexpr size_t WS_WIN = 2 * MiB, WS_WUQ = 18 * MiB, WS_WUKV = WS_WUQ + 3 * MiB / 2, WS_WOUT = WS_WUKV + 1 * MiB, WS_WUP = WS_WOUT + 8 * MiB, WS_WDN = WS_WUP + 44 * MiB;
constexpr size_t WS_XB = 95 * MiB;
constexpr size_t WS_R = 159 * MiB;
constexpr size_t WS_Z = WS_R, WS_Q = WS_Z + 128 * MiB, WS_K = WS_Q + 48 * MiB, WS_VT = WS_K + 48 * MiB, WS_ST = WS_VT + 32 * MiB, WS_DEC = WS_ST + 128 * MiB, WS_MIX = WS_DEC + 1 * MiB;
constexpr size_t WS_ACT = WS_R, WS_EDGE = WS_ACT + 176 * MiB, WS_END = WS_MIX + 64 * MiB;
static_assert(WS_EDGE + 12 * MiB <= WS_END, "ws map");

#define GAS __attribute__((address_space(1)))
template <class T> __device__ __forceinline__ GAS T* G_(T* p) { return (GAS T*)p; }
__device__ __forceinline__ int lane_id_() { unsigned z = 0u; asm volatile("" : "+v"(z)); return (int)__builtin_amdgcn_mbcnt_hi(~0u, __builtin_amdgcn_mbcnt_lo(~0u, z)); }
#define LAUNDER_V(x) asm volatile("" : "+v"(x))
#define LAUNDER_S(x) asm volatile("" : "+s"(x))
__device__ __forceinline__ unsigned f2bf(float f) { unsigned u = __builtin_bit_cast(unsigned, f); return (u + 0x7fffu + ((u >> 16) & 1u)) >> 16; }
__device__ __forceinline__ unsigned pk2(float lo, float hi) { f32x2_t v = {lo, hi}; bf16x2_t b = __builtin_convertvector(v, bf16x2_t); return __builtin_bit_cast(unsigned, b); }
__device__ __forceinline__ float bf2f(unsigned b) { return __builtin_bit_cast(float, b << 16); }
__device__ __forceinline__ float bflo(unsigned w) { return __builtin_bit_cast(float, w << 16); }
__device__ __forceinline__ float bfhi(unsigned w) { return __builtin_bit_cast(float, w & 0xffff0000u); }
__device__ __forceinline__ float wave_sum(float v) {
#pragma unroll
    for (int o = 1; o < 64; o <<= 1) v += __shfl_xor(v, o);
    return v;
}
constexpr float SSQ_FX = 1048576.0f, SSQ_INV = 1.0f / 1048576.0f;
__device__ __forceinline__ void ssq_add(u64* p, float v) { __hip_atomic_fetch_add((GAS u64*)p, (u64)(v * SSQ_FX + 0.5f), __ATOMIC_RELAXED, __HIP_MEMORY_SCOPE_AGENT); }
__device__ __forceinline__ float ssq_get(const u64* p) { return (float)(*(GAS const u64*)p) * SSQ_INV; }
__device__ __forceinline__ float silu_f(float x) { return x * __builtin_amdgcn_rcpf(1.0f + __expf(-x)); }

namespace pg8 {
constexpr int BM = 256, BK = 64, HALF = 128, HTB = HALF * BK * 2, STAGE_BYTES = 8 * HTB, NXCD = 8, WGM = 8;
__host__ __device__ __forceinline__ int lds_byte(int r, int c) { const int st = (r >> 4) * 2 + (c >> 5), rr = r & 15, cc = c & 31, ob = rr * 64 + cc * 2; return st * 1024 + (ob ^ (((ob >> 9) & 1) << 5)); }
__host__ __device__ __forceinline__ void stage_rc(int b, int& R, int& C) { const int st = b / 1024, sb = b % 1024, swz = sb ^ (((sb >> 9) & 1) << 5); R = (st >> 1) * 16 + swz / 64; C = (st & 1) * 32 + (swz % 64) / 2; }
__host__ __device__ __forceinline__ int perm32(int rho) { const int n = rho >> 4, i = rho & 15; return 8 * (i >> 2) + 4 * n + (i & 3); }

struct Unit { int pm, pn; };
struct Gemm { const bf16_t* A; const bf16_t* Bt; int M, N, K, lda; const u64* mid_ssq; float mid_inv; };

struct StaticOrder {
    int nM, nN, nwg, G, c;
    __device__ void init(int M, int N, int G_, int c_) { nM = M / BM; nN = N / BM; nwg = nM * nN; G = G_; c = c_; }
    __device__ bool next(int i, Unit& u) const {
        const long L = (long)i * G + c; if (L >= nwg) return false;
        int wgid = (int)L; { const int q = nwg / NXCD, r = nwg % NXCD, xcd = wgid % NXCD, off = wgid / NXCD; wgid = (xcd < r ? xcd * (q + 1) : r * (q + 1) + (xcd - r) * q) + off; }
        const int nig = WGM * nN, gid = wgid / nig, fm = gid * WGM, gsz = (nM - fm) < WGM ? (nM - fm) : WGM;
        u.pm = fm + ((wgid % nig) % gsz); u.pn = (wgid % nig) / gsz; return true;
    }
};

struct EpiRowScale {
    static constexpr bool PERM = true;
    bf16_t* O; int ldc; const u64* ssq_in; float inv_dim; u64* ssq_a; int a_lo, a_hi; u64* ssq_b; int b_lo, b_hi;
    __device__ __forceinline__ void operator()(const f32x4 (&acc)[2][2][4][2], const Unit& u, int wr, int wc, int fr, int fq) const {
        const int row0 = u.pm * BM + wr * 64 + fr, col0 = u.pn * BM + wc * 32 + 8 * fq;
        u64* sacc = (u.pn >= a_lo && u.pn < a_hi) ? ssq_a : ((u.pn >= b_lo && u.pn < b_hi) ? ssq_b : nullptr);
        float scv[2][4];
#pragma unroll
        for (int ai = 0; ai < 2; ++ai)
#pragma unroll
            for (int m = 0; m < 4; ++m) scv[ai][m] = ssq_in ? ssq_get(ssq_in + row0 + ai * HALF + m * 16) : 0.f;
        asm volatile("" ::: "memory");
#pragma unroll
        for (int ai = 0; ai < 2; ++ai)
#pragma unroll
            for (int m = 0; m < 4; ++m) {
                const int row = row0 + ai * HALF + m * 16;
                const float sc = ssq_in ? rsqrtf(scv[ai][m] * inv_dim + EPS) : 1.0f;
                float ss = 0.f;
#pragma unroll
                for (int bj = 0; bj < 2; ++bj) {
                    const f32x4 v0 = acc[ai][bj][m][0] * sc, v1 = acc[ai][bj][m][1] * sc;
                    ss += (v0[0] * v0[0] + v0[1] * v0[1]) + (v0[2] * v0[2] + v0[3] * v0[3]) + (v1[0] * v1[0] + v1[1] * v1[1]) + (v1[2] * v1[2] + v1[3] * v1[3]);
                    u32x4 w; w.x = pk2(v0[0], v0[1]); w.y = pk2(v0[2], v0[3]); w.z = pk2(v1[0], v1[1]); w.w = pk2(v1[2], v1[3]);
                    *(GAS u32x4*)(G_(O) + (size_t)row * ldc + col0 + bj * HALF) = w;
                }
                if (sacc) { ss += __shfl_xor(ss, 16); ss += __shfl_xor(ss, 32); if (fq == 0) ssq_add(sacc + row, ss); }
            }
    }
};
struct EpiUkv {
    static constexpr bool PERM = true;
    bf16_t* Kb; bf16_t* Vt; const u64* ssq_in; float inv_dim; const bf16_t* Z; const int* pos; const float* kn; const __attribute__((address_space(4))) float* invf; LAS float* lx;
    __device__ __forceinline__ void operator()(f32x4 (&acc)[2][2][4][2], const Unit& u, int wr, int wc, int fr, int fq) const {
        const int row0 = u.pm * BM + wr * 64 + fr, c0 = wc * 32 + 8 * fq;
        const int lt = (wr * 4 + wc) * 64 + fq * 16 + fr, rr = lt >> 1, hf = lt & 1, rrow = u.pm * BM + rr;
        GAS const bf16_t* zr = G_(Z) + (size_t)rrow * IN_PAD + C_KR + 16 * hf;
        const u32x4 ra0 = *(GAS const u32x4*)(zr), ra1 = *(GAS const u32x4*)(zr + 8), rb0 = *(GAS const u32x4*)(zr + 32), rb1 = *(GAS const u32x4*)(zr + 40);
        const float posf = (float)G_(pos)[rrow];
        float scv[2][4];
#pragma unroll
        for (int ai = 0; ai < 2; ++ai)
#pragma unroll
            for (int m = 0; m < 4; ++m) scv[ai][m] = ssq_get(ssq_in + row0 + ai * HALF + m * 16);
        asm volatile("" ::: "memory");
        float x1[16], x2[16], sk = 0.f;
#pragma unroll
        for (int jj = 0; jj < 4; ++jj) { x1[2 * jj] = bflo(ra0[jj]); x1[2 * jj + 1] = bfhi(ra0[jj]); x1[8 + 2 * jj] = bflo(ra1[jj]); x1[8 + 2 * jj + 1] = bfhi(ra1[jj]);
                                         x2[2 * jj] = bflo(rb0[jj]); x2[2 * jj + 1] = bfhi(rb0[jj]); x2[8 + 2 * jj] = bflo(rb1[jj]); x2[8 + 2 * jj + 1] = bfhi(rb1[jj]); }
#pragma unroll
        for (int j = 0; j < 16; ++j) sk += x1[j] * x1[j] + x2[j] * x2[j];
        sk += __shfl_xor(sk, 1);
        if (hf == 0) lx[1024 + rr] = sk;
#pragma unroll
        for (int ai = 0; ai < 2; ++ai)
#pragma unroll
            for (int m = 0; m < 4; ++m) {
                const float sc = rsqrtf(scv[ai][m] * inv_dim + EPS);
#pragma unroll
                for (int bj = 0; bj < 2; ++bj)
#pragma unroll
                    for (int n = 0; n < 2; ++n) acc[ai][bj][m][n] = acc[ai][bj][m][n] * sc;
                const f32x4 v0 = acc[ai][0][m][0], v1 = acc[ai][0][m][1];
                float ss = (v0[0] * v0[0] + v0[1] * v0[1]) + (v0[2] * v0[2] + v0[3] * v0[3]) + (v1[0] * v1[0] + v1[1] * v1[1]) + (v1[2] * v1[2] + v1[3] * v1[3]);
                ss += __shfl_xor(ss, 16); ss += __shfl_xor(ss, 32);
                if (fq == 0) lx[(ai * HALF + wr * 64 + m * 16 + fr) * 4 + wc] = ss;
            }
        asm volatile("s_waitcnt lgkmcnt(0)" ::: "memory"); __builtin_amdgcn_s_barrier(); asm volatile("" ::: "memory");
        const f32x4 g0 = *(GAS const f32x4*)(G_(kn) + c0), g1 = *(GAS const f32x4*)(G_(kn) + c0 + 4);
#pragma unroll
        for (int ai = 0; ai < 2; ++ai)
#pragma unroll
            for (int m = 0; m < 4; ++m) {
                const int rt = ai * HALF + wr * 64 + m * 16 + fr, row = u.pm * BM + rt;
                const int prow = (row & ~15) | (row & 3) | ((row & 4) << 1) | ((row & 8) >> 1);
                const f32x4 pp = *(const LAS f32x4*)(lx + rt * 4);
                const float rk = rsqrtf(((pp[0] + pp[1]) + (pp[2] + pp[3]) + lx[1024 + rt]) * (1.0f / QKD) + EPS);
                { const f32x4 v0 = acc[ai][0][m][0] * rk * g0, v1 = acc[ai][0][m][1] * rk * g1;
                  u32x4 w; w.x = pk2(v0[0], v0[1]); w.y = pk2(v0[2], v0[3]); w.z = pk2(v1[0], v1[1]); w.w = pk2(v1[2], v1[3]);
                  *(GAS u32x4*)(G_(Kb) + (size_t)row * QW + u.pn * QKD + c0) = w; }
#pragma unroll
                for (int n = 0; n < 2; ++n)
#pragma unroll
                    for (int j = 0; j < 4; ++j) G_(Vt)[(size_t)(u.pn * VD + c0 + 4 * n + j) * SEQ + prow] = (bf16_t)f2bf(acc[ai][1][m][n][j]);
            }
        {
            const f32x4 pp = *(const LAS f32x4*)(lx + rr * 4);
            const float rk = rsqrtf(((pp[0] + pp[1]) + (pp[2] + pp[3]) + lx[1024 + rr]) * (1.0f / QKD) + EPS);
            GAS const float* g1p = G_(kn) + 128 + 16 * hf; GAS const float* g2p = G_(kn) + 160 + 16 * hf;
            float y1[16], y2[16];
#pragma unroll
            for (int j = 0; j < 16; ++j) {
                const float ang = posf * invf[16 * hf + j];
                double rev = (double)ang * 0.15915494309189535; rev -= __builtin_rint(rev);
                const float sn = __builtin_amdgcn_sinf((float)rev), cs = __builtin_amdgcn_cosf((float)rev);
                const float n1 = x1[j] * rk * g1p[j], n2 = x2[j] * rk * g2p[j];
                y1[j] = n1 * cs - n2 * sn; y2[j] = n2 * cs + n1 * sn;
            }
            GAS bf16_t* kp = G_(Kb) + (size_t)rrow * QW + u.pn * QKD + 128 + 16 * hf;
            *(GAS u32x4*)(kp) = (u32x4){pk2(y1[0], y1[1]), pk2(y1[2], y1[3]), pk2(y1[4], y1[5]), pk2(y1[6], y1[7])};
            *(GAS u32x4*)(kp + 8) = (u32x4){pk2(y1[8], y1[9]), pk2(y1[10], y1[11]), pk2(y1[12], y1[13]), pk2(y1[14], y1[15])};
            *(GAS u32x4*)(kp + 32) = (u32x4){pk2(y2[0], y2[1]), pk2(y2[2], y2[3]), pk2(y2[4], y2[5]), pk2(y2[6], y2[7])};
            *(GAS u32x4*)(kp + 40) = (u32x4){pk2(y2[8], y2[9]), pk2(y2[10], y2[11]), pk2(y2[12], y2[13]), pk2(y2[14], y2[15])};
        }
    }
};
struct EpiRes {
    static constexpr bool PERM = true;
    const float* base; float* out; bf16_t* xb; u64* ssq_out;
    __device__ __forceinline__ void operator()(const f32x4 (&acc)[2][2][4][2], const Unit& u, int wr, int wc, int fr, int fq) const {
        const int row0 = u.pm * BM + wr * 64 + fr, col0 = u.pn * BM + wc * 32 + 8 * fq;
#pragma unroll
        for (int ai = 0; ai < 2; ++ai) {
            f32x4 bv[4][2][2];
#pragma unroll
            for (int m = 0; m < 4; ++m)
#pragma unroll
                for (int bj = 0; bj < 2; ++bj) { const size_t off = (size_t)(row0 + ai * HALF + m * 16) * DM + col0 + bj * HALF;
                    bv[m][bj][0] = *(GAS const f32x4*)(G_(base) + off); bv[m][bj][1] = *(GAS const f32x4*)(G_(base) + off + 4); }
            asm volatile("" ::: "memory");
#pragma unroll
            for (int m = 0; m < 4; ++m) {
                const int row = row0 + ai * HALF + m * 16; float ss = 0.f;
#pragma unroll
                for (int bj = 0; bj < 2; ++bj) {
                    const size_t off = (size_t)row * DM + col0 + bj * HALF;
                    const f32x4 v0 = acc[ai][bj][m][0] + bv[m][bj][0], v1 = acc[ai][bj][m][1] + bv[m][bj][1];
                    ss += (v0[0] * v0[0] + v0[1] * v0[1]) + (v0[2] * v0[2] + v0[3] * v0[3]) + (v1[0] * v1[0] + v1[1] * v1[1]) + (v1[2] * v1[2] + v1[3] * v1[3]);
                    *(GAS f32x4*)(G_(out) + off) = v0; *(GAS f32x4*)(G_(out) + off + 4) = v1;
                    u32x4 w; w.x = pk2(v0[0], v0[1]); w.y = pk2(v0[2], v0[3]); w.z = pk2(v1[0], v1[1]); w.w = pk2(v1[2], v1[3]);
                    *(GAS u32x4*)(G_(xb) + off) = w;
                }
                ss += __shfl_xor(ss, 16); ss += __shfl_xor(ss, 32); if (fq == 0) ssq_add(ssq_out + row, ss);
            }
        }
    }
};


#define DPP_SHR1(old, src) __builtin_bit_cast(float, __builtin_amdgcn_update_dpp(__builtin_bit_cast(int, (float)(old)), __builtin_bit_cast(int, (float)(src)), 0x111, 0xf, 0xf, false))
#define DPP_SHR2(old, src) __builtin_bit_cast(float, __builtin_amdgcn_update_dpp(__builtin_bit_cast(int, (float)(old)), __builtin_bit_cast(int, (float)(src)), 0x112, 0xf, 0xf, false))
#define DPP_ROR1(src) __builtin_bit_cast(float, __builtin_amdgcn_update_dpp(0, __builtin_bit_cast(int, (float)(src)), 0x121, 0xf, 0xf, false))
#define DPP_ROR2(src) __builtin_bit_cast(float, __builtin_amdgcn_update_dpp(0, __builtin_bit_cast(int, (float)(src)), 0x122, 0xf, 0xf, false))
struct EpiUpConv {
    static constexpr bool PERM = true;
    bf16_t* ACT; float* EDGE; const u64* ssq_in; const float* cw; const float* cb; LAS float* halo;
    __device__ __forceinline__ void operator()(f32x4 (&acc)[2][2][4][2], const Unit& u, int wr, int wc, int fr, int fq) const {
        const int row0 = u.pm * BM + wr * 64 + fr;
        const int g0 = u.pn * 128 + wc * 32 + 8 * fq;
#pragma unroll
        for (int ai = 0; ai < 2; ++ai)
#pragma unroll
            for (int m = 0; m < 4; ++m) {
                const float sc = rsqrtf(ssq_get(ssq_in + row0 + ai * HALF + m * 16) * (1.0f / DM) + EPS);
#pragma unroll
                for (int bj = 0; bj < 2; ++bj)
#pragma unroll
                    for (int n = 0; n < 2; ++n) acc[ai][bj][m][n] = acc[ai][bj][m][n] * sc;
            }
        if (fr >= 14) {
#pragma unroll
            for (int ai = 0; ai < 2; ++ai) { LAS float* hp = halo + ((((2 * ai + wr) * 4 + wc) * 2 + (fr - 14)) * 4 + fq) * 16;
#pragma unroll
                for (int bj = 0; bj < 2; ++bj)
#pragma unroll
                    for (int n = 0; n < 2; ++n) *(LAS f32x4*)(hp + bj * 8 + n * 4) = acc[ai][bj][3][n]; }
            if (wr == 1) { GAS float* ep = G_(EDGE) + (size_t)(u.pm * 4 + 2 + fr - 14) * DFF2 + g0;
#pragma unroll
                for (int bj = 0; bj < 2; ++bj)
#pragma unroll
                    for (int n = 0; n < 2; ++n) *(GAS f32x4*)(ep + bj * DFF + 4 * n) = acc[1][bj][3][n]; }
        }
        if (fr < 2 && wr == 0) { GAS float* ep = G_(EDGE) + (size_t)(u.pm * 4 + fr) * DFF2 + g0;
#pragma unroll
            for (int bj = 0; bj < 2; ++bj)
#pragma unroll
                for (int n = 0; n < 2; ++n) *(GAS f32x4*)(ep + bj * DFF + 4 * n) = acc[0][bj][0][n]; }
        asm volatile("s_waitcnt lgkmcnt(0)" ::: "memory"); __builtin_amdgcn_s_barrier(); asm volatile("" ::: "memory");
#pragma unroll
        for (int n = 0; n < 2; ++n) {
            const int gc = g0 + 4 * n;
            GAS const float* cwg = G_(cw); GAS const float* cbg = G_(cb);
            const f32x4 wg0 = *(GAS const f32x4*)(cwg + gc), wg1 = *(GAS const f32x4*)(cwg + DFF2 + gc), wg2 = *(GAS const f32x4*)(cwg + 2 * DFF2 + gc), bgv = *(GAS const f32x4*)(cbg + gc);
            const f32x4 wu0 = *(GAS const f32x4*)(cwg + DFF + gc), wu1 = *(GAS const f32x4*)(cwg + DFF2 + DFF + gc), wu2 = *(GAS const f32x4*)(cwg + 2 * DFF2 + DFF + gc), buv = *(GAS const f32x4*)(cbg + DFF + gc);
#pragma unroll
            for (int ai = 0; ai < 2; ++ai) {
                const int band = 2 * ai + wr;
                f32x4 pg = (f32x4){0.f, 0.f, 0.f, 0.f}, pu = pg;
                if (band > 0) { const LAS float* hp = halo + ((((band - 1) * 4 + wc) * 2 + (fr & 1)) * 4 + fq) * 16; pg = *(const LAS f32x4*)(hp + n * 4); pu = *(const LAS f32x4*)(hp + 8 + n * 4); }
#pragma unroll
                for (int m = 0; m < 4; ++m) {
                    const f32x4 cg = acc[ai][0][m][n], cu = acc[ai][1][m][n];
                    float av[4];
#pragma unroll
                    for (int j = 0; j < 4; ++j) {
                        const float g1 = DPP_SHR1(DPP_ROR1(pg[j]), cg[j]), g2 = DPP_SHR2(DPP_ROR2(pg[j]), cg[j]);
                        const float u1 = DPP_SHR1(DPP_ROR1(pu[j]), cu[j]), u2 = DPP_SHR2(DPP_ROR2(pu[j]), cu[j]);
                        const float yg = bgv[j] + wg0[j] * g2 + wg1[j] * g1 + wg2[j] * cg[j];
                        const float yu = buv[j] + wu0[j] * u2 + wu1[j] * u1 + wu2[j] * cu[j];
                        av[j] = silu_f(yg) * yu;
                    }
                    *(GAS u32x2*)(G_(ACT) + (size_t)(row0 + ai * HALF + m * 16) * DFF + gc) = (u32x2){pk2(av[0], av[1]), pk2(av[2], av[3])};
                    pg = cg; pu = cu;
                }
            }
        }
    }
};

template <class Epi, bool MIDSCALE = false>
__device__ __forceinline__ void gemm_phase(LAS unsigned char* lds, const Gemm g, const StaticOrder& S, const Epi& E, int wv) {
    int tid_ = wv * 64 + lane_id_(); LAUNDER_V(tid_);
    const int tid = tid_, wid = __builtin_amdgcn_readfirstlane(tid >> 6), lane = tid & 63, wr = wid >> 2, wc = wid & 3, fr = lane & 15, fq = lane >> 4;
    const int K = g.K, nt = K / BK;
    unsigned voffA[2], voffB[2];
#pragma unroll
    for (int i = 0; i < 2; ++i) { int R, C; stage_rc(tid * 16 + i * 8192, R, C); const int Rb = Epi::PERM ? ((R & ~31) + perm32(R & 31)) : R;
        voffA[i] = (unsigned)(R * g.lda + C) * 2u; voffB[i] = (unsigned)(Rb * K + C) * 2u; }
    const size_t kstep = (size_t)(BK * 2);
    const size_t hstepA = (size_t)HALF * g.lda * 2, hstepB = (size_t)HALF * K * 2;
    const size_t tstepA = 2 * hstepA, tstepB = 2 * hstepB;
    const unsigned ldsw = (unsigned)wid * 1024u;
    const int aoff = lds_byte(wr * 64 + fr, fq * 8), boff = lds_byte(wc * 32 + fr, fq * 8);
#define PG8_SA(b, h) (((b) * 2 + (h)) * HTB)
#define PG8_SB(b, h) ((4 + (b) * 2 + (h)) * HTB)
#define PG8_STAGE(bufoff, gbase, voff) do { _Pragma("unroll") for (int _i = 0; _i < 2; ++_i) \
        __builtin_amdgcn_global_load_lds((const unsigned*)((const char*)(gbase) + (voff)[_i]), (LAS unsigned*)(lds + (bufoff) + ldsw + _i * 8192), 16, 0, 0); } while (0)
#define PG8_LDA(dst, b, h) do { _Pragma("unroll") for (int m = 0; m < 4; ++m) _Pragma("unroll") for (int k = 0; k < 2; ++k) dst[m][k] = *(const LAS bf16x8*)(lds + PG8_SA(b, h) + aoff + m * 2048 + k * 1024); } while (0)
#define PG8_LDB(dst, b, h) do { _Pragma("unroll") for (int n = 0; n < 2; ++n) _Pragma("unroll") for (int k = 0; k < 2; ++k) dst[n][k] = *(const LAS bf16x8*)(lds + PG8_SB(b, h) + boff + n * 2048 + k * 1024); } while (0)
#define PG8_MMA(ai, bj, At, Bt) do { __builtin_amdgcn_s_setprio(1); _Pragma("unroll") for (int m = 0; m < 4; ++m) _Pragma("unroll") for (int n = 0; n < 2; ++n) _Pragma("unroll") for (int k = 0; k < 2; ++k) \
        acc[ai][bj][m][n] = __builtin_amdgcn_mfma_f32_16x16x32_bf16(Bt[n][k], At[m][k], acc[ai][bj][m][n], 0, 0, 0); __builtin_amdgcn_s_setprio(0); } while (0)
#define PG8_WAIT_V(n) asm volatile("s_waitcnt vmcnt(" #n ")" ::: "memory")
#define PG8_WAIT_L(n) asm volatile("s_waitcnt lgkmcnt(" #n ")" ::: "memory")
#define PG8_BAR __builtin_amdgcn_s_barrier()
#define PG8_SCHED __builtin_amdgcn_sched_barrier(0)
    Unit cur, nxt; int ui = 0;
    if (!S.next(0, cur)) return;
    f32x4 acc[2][2][4][2];
#pragma unroll
    for (int a = 0; a < 2; ++a)
#pragma unroll
        for (int b = 0; b < 2; ++b)
#pragma unroll
            for (int m = 0; m < 4; ++m)
#pragma unroll
                for (int n = 0; n < 2; ++n) acc[a][b][m][n] = (f32x4){0.f, 0.f, 0.f, 0.f};
    bf16x8 At[4][2], B0[2][2], B1[2][2];
    const char* cA = (const char*)g.A + (size_t)cur.pm * tstepA; const char* cB = (const char*)g.Bt + (size_t)cur.pn * tstepB;
    PG8_STAGE(PG8_SB(0, 0), cB, voffB); PG8_STAGE(PG8_SB(0, 1), cB + hstepB, voffB); PG8_STAGE(PG8_SA(0, 0), cA, voffA); PG8_STAGE(PG8_SA(0, 1), cA + hstepA, voffA);
    if (wr == 1) PG8_BAR;
    PG8_WAIT_V(2); PG8_BAR;
    PG8_STAGE(PG8_SB(1, 0), cB + kstep, voffB); PG8_STAGE(PG8_SA(1, 0), cA + kstep, voffA); PG8_STAGE(PG8_SB(1, 1), cB + hstepB + kstep, voffB);
    PG8_WAIT_V(6); PG8_BAR;
    for (;;) {
        const bool has_next = S.next(ui + 1, nxt);
        const char* nA = has_next ? (const char*)g.A + (size_t)nxt.pm * tstepA : cA; const char* nB = has_next ? (const char*)g.Bt + (size_t)nxt.pn * tstepB : cB;
        for (int t = 0; t < nt; t += 2) {
            const bool last = (t == nt - 2);
            const char* a1 = cA + (size_t)(t + 1) * kstep;
            const char* a2 = last ? nA : cA + (size_t)(t + 2) * kstep; const char* b2 = last ? nB : cB + (size_t)(t + 2) * kstep;
            const char* a3 = a2 + kstep; const char* b3 = b2 + kstep;
            if constexpr (MIDSCALE) { if (t == nt / 2) {
#pragma unroll
                for (int ai = 0; ai < 2; ++ai)
#pragma unroll
                    for (int m = 0; m < 4; ++m) { const float sc = rsqrtf(ssq_get(g.mid_ssq + cur.pm * BM + ai * HALF + wr * 64 + m * 16 + fr) * g.mid_inv + EPS);
#pragma unroll
                        for (int bj = 0; bj < 2; ++bj)
#pragma unroll
                            for (int n = 0; n < 2; ++n) acc[ai][bj][m][n] = acc[ai][bj][m][n] * sc; } } }
            PG8_LDB(B0, 0, 0); PG8_LDB(B1, 0, 1); PG8_SCHED; PG8_LDA(At, 0, 0); PG8_STAGE(PG8_SA(1, 1), a1 + hstepA, voffA);
            PG8_WAIT_V(8); PG8_WAIT_L(0); PG8_BAR; PG8_MMA(0, 0, At, B0); PG8_MMA(0, 1, At, B1); PG8_BAR; PG8_SCHED;
            PG8_LDA(At, 0, 1); PG8_STAGE(PG8_SB(0, 0), b2, voffB); PG8_STAGE(PG8_SB(0, 1), b2 + hstepB, voffB); PG8_STAGE(PG8_SA(0, 0), a2, voffA);
            PG8_WAIT_V(8); PG8_WAIT_L(0); PG8_BAR; PG8_MMA(1, 0, At, B0); PG8_MMA(1, 1, At, B1); PG8_BAR; PG8_SCHED;
            PG8_LDB(B0, 1, 0); PG8_LDB(B1, 1, 1); PG8_SCHED; PG8_LDA(At, 1, 0); PG8_STAGE(PG8_SA(0, 1), a2 + hstepA, voffA);
            PG8_WAIT_V(8); PG8_WAIT_L(0); PG8_BAR; PG8_MMA(0, 0, At, B0); PG8_MMA(0, 1, At, B1); PG8_BAR; PG8_SCHED;
            PG8_LDA(At, 1, 1); PG8_STAGE(PG8_SB(1, 0), b3, voffB); PG8_STAGE(PG8_SB(1, 1), b3 + hstepB, voffB); PG8_STAGE(PG8_SA(1, 0), a3, voffA);
            PG8_WAIT_V(8); PG8_WAIT_L(0); PG8_BAR; PG8_MMA(1, 0, At, B0); PG8_MMA(1, 1, At, B1); PG8_BAR; PG8_SCHED;
        }
        if (wr == 0) PG8_BAR;
        { int frE = fr, fqE = fq; LAUNDER_V(frE); LAUNDER_V(fqE); E(acc, cur, wr, wc, frE, fqE); }
        if (!has_next) break;
#pragma unroll
        for (int a = 0; a < 2; ++a)
#pragma unroll
            for (int b = 0; b < 2; ++b)
#pragma unroll
                for (int m = 0; m < 4; ++m)
#pragma unroll
                    for (int n = 0; n < 2; ++n) acc[a][b][m][n] = (f32x4){0.f, 0.f, 0.f, 0.f};
        cur = nxt; cA = nA; cB = nB; ++ui;
        if (wr == 1) PG8_BAR;
    }
    PG8_WAIT_V(0);
    PG8_BAR;
#undef PG8_SA
#undef PG8_SB
#undef PG8_STAGE
#undef PG8_LDA
#undef PG8_LDB
#undef PG8_MMA
#undef PG8_WAIT_V
#undef PG8_WAIT_L
#undef PG8_BAR
#undef PG8_SCHED
}
}

constexpr int RING_BYTES = 131072;
constexpr int LDS_BYTES = 147456;

struct Args { const float* in[20]; float* out; unsigned char* ws; float inv_freq[32]; };
typedef const __attribute__((address_space(4))) Args* KAP_T;

#define DS_READ4(r0, r1, r2, r3, addr, o0, o1, o2, o3) asm volatile("ds_read_b128 %0, %4 offset:%5\n\tds_read_b128 %1, %4 offset:%6\n\tds_read_b128 %2, %4 offset:%7\n\tds_read_b128 %3, %4 offset:%8" \
    : "=&v"(r0), "=&v"(r1), "=&v"(r2), "=&v"(r3) : "v"(addr), "i"(o0), "i"(o1), "i"(o2), "i"(o3) : "memory")
#define LGKM_WAIT4(n, r0, r1, r2, r3) asm volatile("s_waitcnt lgkmcnt(" #n ")" : "+v"(r0), "+v"(r1), "+v"(r2), "+v"(r3) :: "memory")
#define MFMA32(a, b, c) __builtin_amdgcn_mfma_f32_32x32x16_bf16((a), (b), (c), 0, 0, 0)
__device__ __forceinline__ int crow(int r, int hi) { return (r & 3) + 8 * (r >> 2) + 4 * hi; }

__device__ __forceinline__ void wt_item(const float* __restrict__ W, int K, int N, const float* __restrict__ gain, int gainK, bf16_t* WT, LAS float* scr, int item, int nblk, int lane, bool remap_up = false) {
    const int kb = item / nblk, nb = item % nblk, k0 = 64 * kb, n0 = 32 * nb;
    const int ns0 = remap_up ? (((n0 & 255) < 128) ? 128 * (n0 >> 8) + (n0 & 255) : DFF + 128 * (n0 >> 8) + (n0 & 255) - 128) : n0;
    const int n = ns0 + (lane & 31);
    float wv[32];
#pragma unroll
    for (int i = 0; i < 32; ++i) { const int kk = 2 * i + (lane >> 5); wv[i] = (n < N) ? G_(W)[(size_t)(k0 + kk) * N + n] : 0.f; }
#pragma unroll
    for (int i = 0; i < 32; ++i) { const int kk = 2 * i + (lane >> 5); scr[kk * 33 + (lane & 31)] = wv[i]; }
    asm volatile("s_waitcnt lgkmcnt(0)" ::: "memory");
    const int c = lane & 7;
    f32x4 g0 = (f32x4){1.f, 1.f, 1.f, 1.f}, g1 = g0;
    if (k0 < gainK) { g0 = *(GAS const f32x4*)(G_(gain) + k0 + 8 * c); g1 = *(GAS const f32x4*)(G_(gain) + k0 + 8 * c + 4); }
#pragma unroll
    for (int j = 0; j < 4; ++j) { const int nn = (lane >> 3) + 8 * j; const LAS float* s = scr + (8 * c) * 33 + nn;
        u32x4 o; o.x = pk2(s[0 * 33] * g0[0], s[1 * 33] * g0[1]); o.y = pk2(s[2 * 33] * g0[2], s[3 * 33] * g0[3]); o.z = pk2(s[4 * 33] * g1[0], s[5 * 33] * g1[1]); o.w = pk2(s[6 * 33] * g1[2], s[7 * 33] * g1[3]);
        *(GAS u32x4*)(G_(WT) + (size_t)(n0 + nn) * K + k0 + 8 * c) = o; }
    asm volatile("s_waitcnt lgkmcnt(0)" ::: "memory");
}

constexpr int AT_KB = 3 * 8192, AT_VB = 16384, AT_NBUF = 3, AT_BUF = AT_KB + AT_VB  , AT_WSF = AT_NBUF * AT_BUF;
static_assert(AT_WSF + 8 * 128 <= RING_BYTES, "attn lds");
#define DS_READ4X(r0, r1, r2, r3, a0, a1, a2, a3, o0, o1, o2, o3) asm volatile("ds_read_b128 %0, %4 offset:%8\n\tds_read_b128 %1, %5 offset:%9\n\tds_read_b128 %2, %6 offset:%10\n\tds_read_b128 %3, %7 offset:%11" \
    : "=&v"(r0), "=&v"(r1), "=&v"(r2), "=&v"(r3) : "v"(a0), "v"(a1), "v"(a2), "v"(a3), "i"(o0), "i"(o1), "i"(o2), "i"(o3) : "memory")

__device__ __forceinline__ void attn_unit(LAS unsigned char* L, const bf16_t* Q_, const bf16_t* Kg_, const bf16_t* Vt_, bf16_t* mix_, u64* ssq_a, int h, int qb, int wv, const int* pos_, const float* qn_, KAP_T kap) {
    GAS const bf16_t* Q = G_(Q_); GAS const bf16_t* Kg = G_(Kg_); GAS const bf16_t* Vt = G_(Vt_); GAS bf16_t* mix = G_(mix_);
    int tid_ = wv * 64 + lane_id_(); LAUNDER_V(tid_);
    const int tid = tid_, lane = tid & 63, w = __builtin_amdgcn_readfirstlane(tid >> 6), r32 = lane & 31, hh = lane >> 5;
    const int q0 = qb * 256;
    bf16x8 qf[12];
    {
        const int qrow_i = q0 + 32 * w + r32;
        GAS const bf16_t* qrow = Q + (size_t)qrow_i * QW + h * QKD + 8 * hh;
        u32x4 raw[12];
#pragma unroll
        for (int ks = 0; ks < 12; ++ks) raw[ks] = *(GAS const u32x4*)(qrow + 16 * ks);
        const float posf = (float)G_(pos_)[qrow_i];
        float ss = 0.f;
#pragma unroll
        for (int ks = 0; ks < 12; ++ks)
#pragma unroll
            for (int jj = 0; jj < 4; ++jj) { const float lo = bflo(raw[ks][jj]), hi = bfhi(raw[ks][jj]); ss += lo * lo + hi * hi; }
        ss += __shfl_xor(ss, 32);
        const float rs = rsqrtf(ss * (1.0f / QKD) + EPS) * (0.07216878364870322f * 1.4426950408889634f);
        GAS const float* qn = G_(qn_) + 8 * hh;
#pragma unroll
        for (int ks = 0; ks < 8; ++ks) { const f32x4 g0 = *(GAS const f32x4*)(qn + 16 * ks), g1 = *(GAS const f32x4*)(qn + 16 * ks + 4);
            u32x4 o_; o_.x = pk2(bflo(raw[ks].x) * rs * g0[0], bfhi(raw[ks].x) * rs * g0[1]); o_.y = pk2(bflo(raw[ks].y) * rs * g0[2], bfhi(raw[ks].y) * rs * g0[3]);
            o_.z = pk2(bflo(raw[ks].z) * rs * g1[0], bfhi(raw[ks].z) * rs * g1[1]); o_.w = pk2(bflo(raw[ks].w) * rs * g1[2], bfhi(raw[ks].w) * rs * g1[3]);
            qf[ks] = __builtin_bit_cast(bf16x8, o_); }
#pragma unroll
        for (int a = 0; a < 2; ++a) {
            const f32x4 ga0 = *(GAS const f32x4*)(qn + 16 * (8 + a)), ga1 = *(GAS const f32x4*)(qn + 16 * (8 + a) + 4), gb0 = *(GAS const f32x4*)(qn + 16 * (10 + a)), gb1 = *(GAS const f32x4*)(qn + 16 * (10 + a) + 4);
            float x1[8], x2[8], y1[8], y2[8];
#pragma unroll
            for (int jj = 0; jj < 4; ++jj) { x1[2 * jj] = bflo(raw[8 + a][jj]); x1[2 * jj + 1] = bfhi(raw[8 + a][jj]); x2[2 * jj] = bflo(raw[10 + a][jj]); x2[2 * jj + 1] = bfhi(raw[10 + a][jj]); }
#pragma unroll
            for (int j = 0; j < 8; ++j) {
                const float ang = posf * kap->inv_freq[16 * a + 8 * hh + j];
                double rev = (double)ang * 0.15915494309189535; rev -= __builtin_rint(rev);
                const float sn = __builtin_amdgcn_sinf((float)rev), cs = __builtin_amdgcn_cosf((float)rev);
                const float n1 = x1[j] * rs * (j < 4 ? ga0[j & 3] : ga1[j & 3]), n2 = x2[j] * rs * (j < 4 ? gb0[j & 3] : gb1[j & 3]);
                y1[j] = n1 * cs - n2 * sn; y2[j] = n2 * cs + n1 * sn;
            }
            qf[8 + a] = __builtin_bit_cast(bf16x8, (u32x4){pk2(y1[0], y1[1]), pk2(y1[2], y1[3]), pk2(y1[4], y1[5]), pk2(y1[6], y1[7])});
            qf[10 + a] = __builtin_bit_cast(bf16x8, (u32x4){pk2(y2[0], y2[1]), pk2(y2[2], y2[3]), pk2(y2[4], y2[5]), pk2(y2[6], y2[7])});
        }
    }
    f32x16 o[4];
#pragma unroll
    for (int d = 0; d < 4; ++d)
#pragma unroll
        for (int i = 0; i < 16; ++i) o[d][i] = 0.f;
    float l_run = 0.f;
    const int NT = 4 * qb + 4, my_last = 4 * qb + (w >> 1);
    volatile LAS float* wsf = (volatile LAS float*)(L + AT_WSF) + w * 32;
    const unsigned lds_base = (unsigned)(uintptr_t)L;
#define AT_FOFF(j, lz, bo) (lds_base + (bo) + (unsigned)((((lz) & 31) >> 1) * 256 + ((((((lz) & 31) & 1) * 8) + 2 * (j) + ((lz) >> 5)) ^ ((((lz) & 31) >> 1) & 7)) * 16))
    const int du = 4 * w + (lane >> 4), dsl = lane & 15, drb = dsl >> 3, dc = (dsl & 7) ^ (du & 7);
    GAS const bf16_t* ksrc = Kg + (size_t)(2 * du + drb) * QW + h * QKD + dc * 8;
    GAS const bf16_t* vsrc = Vt + (size_t)(h * VD + 2 * du + drb) * SEQ + dc * 8;
#define AT_DMA(t, bi) do { const int kv0_ = (t) * 64; \
    _Pragma("unroll") for (int i = 0; i < 3; ++i) __builtin_amdgcn_global_load_lds((const unsigned*)(ksrc + (size_t)kv0_ * QW + i * 64), (LAS unsigned*)(L + (bi) * AT_BUF + (8 * i + w) * 1024), 16, 0, 0); \
    _Pragma("unroll") for (int i = 0; i < 2; ++i) __builtin_amdgcn_global_load_lds((const unsigned*)(vsrc + (size_t)i * 64 * SEQ + kv0_), (LAS unsigned*)(L + (bi) * AT_BUF + AT_KB + (8 * i + w) * 1024), 16, 0, 0); } while (0)
    AT_DMA(0, 0); AT_DMA(1, 1);
    asm volatile("s_waitcnt vmcnt(5)" ::: "memory"); __builtin_amdgcn_s_barrier(); asm volatile("" ::: "memory");
    int bcur = 0, bnx2 = 2;
    for (int t = 0; t < NT; ++t) {
        if (t + 2 < NT) AT_DMA(t + 2, bnx2);
        if (t <= my_last) {
            int lz_ = lane; LAUNDER_V(lz_); const unsigned bo_ = (unsigned)bcur * AT_BUF;
            const unsigned ka0 = AT_FOFF(0, lz_, bo_), ka1 = AT_FOFF(1, lz_, bo_), ka2 = AT_FOFF(2, lz_, bo_), ka3 = AT_FOFF(3, lz_, bo_);
            f32x16 p0, p1;
#pragma unroll
            for (int i = 0; i < 16; ++i) { p0[i] = 0.f; p1[i] = 0.f; }
            bf16x8 fa0, fa1, fa2, fa3, fb0, fb1, fb2, fb3, fc0, fc1, fc2, fc3;
#define QK_RD(s0, s1, s2, s3, kb, g) DS_READ4X(s0, s1, s2, s3, ka0, ka1, ka2, ka3, (g) * 8192 + (kb) * 4096, (g) * 8192 + (kb) * 4096, (g) * 8192 + (kb) * 4096, (g) * 8192 + (kb) * 4096)
#define QK_MM(s0, s1, s2, s3, P, g) do { P = MFMA32(s0, qf[4 * (g)], P); P = MFMA32(s1, qf[4 * (g) + 1], P); P = MFMA32(s2, qf[4 * (g) + 2], P); P = MFMA32(s3, qf[4 * (g) + 3], P); } while (0)
#define PV_RD(s0, s1, s2, s3, va) DS_READ4(s0, s1, s2, s3, va, AT_KB, AT_KB + 4096, AT_KB + 8192, AT_KB + 12288)
#define PV_PK(P, ss) __builtin_bit_cast(bf16x8, (u32x4){pk2(P[8 * (ss) + 0], P[8 * (ss) + 1]), pk2(P[8 * (ss) + 2], P[8 * (ss) + 3]), pk2(P[8 * (ss) + 4], P[8 * (ss) + 5]), pk2(P[8 * (ss) + 6], P[8 * (ss) + 7])})
#define PV_MM(s0, s1, s2, s3, xs) do { o[0] = MFMA32(xs, s0, o[0]); o[1] = MFMA32(xs, s1, o[1]); o[2] = MFMA32(xs, s2, o[2]); o[3] = MFMA32(xs, s3, o[3]); } while (0)
            QK_RD(fa0, fa1, fa2, fa3, 0, 0);
            QK_RD(fb0, fb1, fb2, fb3, 0, 1);
            QK_RD(fc0, fc1, fc2, fc3, 0, 2); LGKM_WAIT4(8, fa0, fa1, fa2, fa3); QK_MM(fa0, fa1, fa2, fa3, p0, 0);
            QK_RD(fa0, fa1, fa2, fa3, 1, 0); LGKM_WAIT4(8, fb0, fb1, fb2, fb3); QK_MM(fb0, fb1, fb2, fb3, p0, 1);
            QK_RD(fb0, fb1, fb2, fb3, 1, 1); LGKM_WAIT4(8, fc0, fc1, fc2, fc3); QK_MM(fc0, fc1, fc2, fc3, p0, 2);
            float ls0 = 0.f, ls1 = 0.f;
#pragma unroll
            for (int i = 0; i < 16; ++i) { p0[i] = __builtin_amdgcn_exp2f(__builtin_amdgcn_fmed3f(p0[i], -1000.f, 100.f)); ls0 += p0[i]; }
            QK_RD(fc0, fc1, fc2, fc3, 1, 2); LGKM_WAIT4(8, fa0, fa1, fa2, fa3); QK_MM(fa0, fa1, fa2, fa3, p1, 0);
            PV_RD(fa0, fa1, fa2, fa3, ka0);  LGKM_WAIT4(8, fb0, fb1, fb2, fb3); QK_MM(fb0, fb1, fb2, fb3, p1, 1);
            PV_RD(fb0, fb1, fb2, fb3, ka1);  LGKM_WAIT4(8, fc0, fc1, fc2, fc3); QK_MM(fc0, fc1, fc2, fc3, p1, 2);
            { const bf16x8 x00 = PV_PK(p0, 0), x01 = PV_PK(p0, 1);
#pragma unroll
              for (int i = 0; i < 16; ++i) { p1[i] = __builtin_amdgcn_exp2f(__builtin_amdgcn_fmed3f(p1[i], -1000.f, 100.f)); ls1 += p1[i]; }
              PV_RD(fc0, fc1, fc2, fc3, ka2); LGKM_WAIT4(8, fa0, fa1, fa2, fa3); PV_MM(fa0, fa1, fa2, fa3, x00);
              PV_RD(fa0, fa1, fa2, fa3, ka3); LGKM_WAIT4(8, fb0, fb1, fb2, fb3); PV_MM(fb0, fb1, fb2, fb3, x01);
              const bf16x8 x10 = PV_PK(p1, 0), x11 = PV_PK(p1, 1);
              LGKM_WAIT4(4, fc0, fc1, fc2, fc3); PV_MM(fc0, fc1, fc2, fc3, x10);
              LGKM_WAIT4(0, fa0, fa1, fa2, fa3); PV_MM(fa0, fa1, fa2, fa3, x11); }
            l_run += ls0 + ls1;
#undef QK_RD
#undef QK_MM
#undef PV_RD
#undef PV_PK
#undef PV_MM
        }
        if (t + 2 < NT) asm volatile("s_waitcnt vmcnt(5) lgkmcnt(0)" ::: "memory"); else asm volatile("s_waitcnt vmcnt(0) lgkmcnt(0)" ::: "memory");
        __builtin_amdgcn_s_barrier(); asm volatile("" ::: "memory");
        bcur = (bcur == 2) ? 0 : bcur + 1; bnx2 = (bnx2 == 2) ? 0 : bnx2 + 1;
    }
#undef AT_DMA
#undef AT_FOFF
    const float lt = l_run + __shfl_xor(l_run, 32);
    wsf[r32] = 1.0f / lt;
    asm volatile("s_waitcnt lgkmcnt(0)" ::: "memory");
    GAS bf16_t* orow = mix + (size_t)(q0 + 32 * w) * DM + h * VD + r32;
#pragma unroll
    for (int i = 0; i < 16; ++i) { const int qr = crow(i, hh); const float a = wsf[qr]; float ss = 0.f;
#pragma unroll
        for (int d = 0; d < 4; ++d) { const float v = o[d][i] * a; ss += v * v; orow[(size_t)qr * DM + 32 * d] = (bf16_t)f2bf(v); }
        ss += __shfl_xor(ss, 1); ss += __shfl_xor(ss, 2); ss += __shfl_xor(ss, 4); ss += __shfl_xor(ss, 8); ss += __shfl_xor(ss, 16);
        if (r32 == 0) ssq_add(ssq_a + q0 + 32 * w + qr, ss); }
    __syncthreads();
}

constexpr int GL_V = 0  , GL_KD = 32768  , GL_TOT = GL_KD + 18432  , GL_ZA = GL_TOT + 2048  ;
__device__ __forceinline__ void gla_chunk_unit(LAS unsigned char* L, const bf16_t* Z_, const float* wgate_, const float* bgate_, bf16_t* ST_, float* DEC_, int c, int h, int wv) {
    GAS const bf16_t* Z = G_(Z_); GAS const float* wgate = G_(wgate_); GAS const float* bgate = G_(bgate_); GAS bf16_t* ST = G_(ST_); GAS float* DEC = G_(DEC_);
    int tid_ = wv * 64 + lane_id_(); LAUNDER_V(tid_);
    const int tid = tid_, lane = tid & 63, w = __builtin_amdgcn_readfirstlane(tid >> 6), r32 = lane & 31, hh = lane >> 5;
    const size_t row0 = (size_t)c * 64;
#pragma unroll
    for (int i = 0; i < 4; ++i) { const int id = tid + 512 * i, r = id >> 5, cc = id & 31;
        *(LAS u32x4*)(L + GL_V + r * 512 + cc * 16) = *(GAS const u32x4*)(Z + (row0 + r) * IN_PAD + C_GV + h * GDV + cc * 8); }
#pragma unroll
    for (int i = 0; i < 2; ++i) { const int id = tid + 512 * i, r = id >> 4, cc = id & 15;
        ((LAS float*)(L + GL_ZA))[id] = bf2f(Z[(row0 + r) * IN_PAD + C_GA + cc]); }
    __syncthreads();
    const int tq = tid >> 7, col = tid & 127;
    float wg[16];
#pragma unroll
    for (int r = 0; r < 16; ++r) wg[r] = wgate[r * (GH * GDK) + h * GDK + col];
    const float bg = bgate[h * GDK + col];
    float pre[16]; float run = 0.f;
#pragma unroll
    for (int i = 0; i < 16; ++i) {
        const LAS float* za = (const LAS float*)(L + GL_ZA) + (16 * tq + i) * 16;
        float ga = bg;
#pragma unroll
        for (int r = 0; r < 16; ++r) ga += za[r] * wg[r];
        const float ls = fminf(ga, 0.f) - __logf(1.0f + __expf(-fabsf(ga)));
        run += ls * (1.0f / 16.0f); pre[i] = run;
    }
    ((LAS float*)(L + GL_TOT))[tq * 128 + col] = run;
    __syncthreads();
    float off = 0.f, bend = 0.f;
#pragma unroll
    for (int t = 0; t < 4; ++t) { const float v = ((LAS float*)(L + GL_TOT))[t * 128 + col]; bend += v; if (t < tq) off += v; }
    {
        unsigned pkv[8];
#pragma unroll
        for (int i = 0; i < 16; i += 2) {
            const float k0 = bf2f(Z[(row0 + 16 * tq + i) * IN_PAD + C_GK + h * GDK + col]), k1 = bf2f(Z[(row0 + 16 * tq + i + 1) * IN_PAD + C_GK + h * GDK + col]);
            pkv[i >> 1] = pk2(k0 * __expf(bend - off - pre[i]), k1 * __expf(bend - off - pre[i + 1]));
        }
        LAS u32x4* dst = (LAS u32x4*)(L + GL_KD + col * 144 + tq * 32);
        dst[0] = (u32x4){pkv[0], pkv[1], pkv[2], pkv[3]}; dst[1] = (u32x4){pkv[4], pkv[5], pkv[6], pkv[7]};
    }
    if (tq == 0) DEC[(size_t)(c * GH + h) * GDK + col] = __expf(bend);
    __syncthreads();
    f32x16 acc[4];
#pragma unroll
    for (int d = 0; d < 4; ++d)
#pragma unroll
        for (int i = 0; i < 16; ++i) acc[d][i] = 0.f;
#pragma unroll
    for (int ks = 0; ks < 4; ++ks) {
        bf16x8 a;
#pragma unroll
        for (int j = 0; j < 8; ++j) a[j] = (short)*(const LAS unsigned short*)(L + GL_V + (16 * ks + 8 * hh + j) * 512 + (32 * w + r32) * 2);
#pragma unroll
        for (int db = 0; db < 4; ++db) {
            const bf16x8 b = *(const LAS bf16x8*)(L + GL_KD + (32 * db + r32) * 144 + (16 * ks + 8 * hh) * 2);
            acc[db] = MFMA32(a, b, acc[db]);
        }
    }
    GAS bf16_t* stp = ST + ((size_t)(c * GH + h) * GDV + 32 * w) * GDK + r32;
#pragma unroll
    for (int db = 0; db < 4; ++db)
#pragma unroll
        for (int i = 0; i < 16; ++i) stp[(size_t)crow(i, hh) * GDK + 32 * db] = (bf16_t)f2bf(acc[db][i]);
    __syncthreads();
}

constexpr int GO_STR = 260;
__device__ __forceinline__ void gla_out_unit(LAS unsigned char* L, const bf16_t* Z_, const bf16_t* ST_, const float* gnorm_, bf16_t* mix_, int c, int h, int wv) {
    GAS const bf16_t* Z = G_(Z_); GAS const bf16_t* ST = G_(ST_); GAS const float* gnorm = G_(gnorm_); GAS bf16_t* mix = G_(mix_);
    int tid_ = wv * 64 + lane_id_(); LAUNDER_V(tid_);
    const int tid = tid_, lane = tid & 63, w = __builtin_amdgcn_readfirstlane(tid >> 6), r32 = lane & 31, hh = lane >> 5;
    const size_t row0 = (size_t)c * 64;
    f32x16 acc[2];
#pragma unroll
    for (int d = 0; d < 2; ++d)
#pragma unroll
        for (int i = 0; i < 16; ++i) acc[d][i] = 0.f;
    GAS const bf16_t* sp = ST + ((size_t)(c * GH + h) * GDV + 32 * w + r32) * GDK + 8 * hh;
    bf16x8 bfr[8], afr[2][8];
#pragma unroll
    for (int ks = 0; ks < 8; ++ks) bfr[ks] = *(GAS const bf16x8*)(sp + 16 * ks);
#pragma unroll
    for (int tb = 0; tb < 2; ++tb)
#pragma unroll
        for (int ks = 0; ks < 8; ++ks) afr[tb][ks] = *(GAS const bf16x8*)(Z + (row0 + 32 * tb + r32) * IN_PAD + C_GQ + h * GDK + 16 * ks + 8 * hh);
    asm volatile("" ::: "memory");
#pragma unroll
    for (int ks = 0; ks < 8; ++ks)
#pragma unroll
        for (int tb = 0; tb < 2; ++tb) acc[tb] = MFMA32(afr[tb][ks], bfr[ks], acc[tb]);
    LAS float* of = (LAS float*)L;
#pragma unroll
    for (int tb = 0; tb < 2; ++tb)
#pragma unroll
        for (int i = 0; i < 16; ++i) of[(32 * tb + crow(i, hh)) * GO_STR + 32 * w + r32] = acc[tb][i] * 0.08838834764831845f;
    __syncthreads();
    const int tok = tid >> 3, part = tid & 7;
    f32x4 v[4][2]; float ss = 0.f;
#pragma unroll
    for (int j = 0; j < 4; ++j)
#pragma unroll
        for (int q = 0; q < 2; ++q) { v[j][q] = *(const LAS f32x4*)(of + tok * GO_STR + part * 8 + 64 * j + 4 * q); ss += (v[j][q][0] * v[j][q][0] + v[j][q][1] * v[j][q][1]) + (v[j][q][2] * v[j][q][2] + v[j][q][3] * v[j][q][3]); }
    ss += __shfl_xor(ss, 1); ss += __shfl_xor(ss, 2); ss += __shfl_xor(ss, 4);
    const float rstd = rsqrtf(ss * (1.0f / GDV) + EPS);
    GAS const bf16_t* zg = Z + (row0 + tok) * IN_PAD + C_GG + h * GDV + part * 8;
    GAS bf16_t* op = mix + (row0 + tok) * DM + 1024 + h * GDV + part * 8;
#pragma unroll
    for (int j = 0; j < 4; ++j) {
        const u32x4 gw_ = *(GAS const u32x4*)(zg + 64 * j);
        const f32x4 n0 = *(GAS const f32x4*)(gnorm + part * 8 + 64 * j), n1 = *(GAS const f32x4*)(gnorm + part * 8 + 64 * j + 4);
        u32x4 ow;
        ow.x = pk2(v[j][0][0] * rstd * n0[0] * silu_f(bflo(gw_.x)), v[j][0][1] * rstd * n0[1] * silu_f(bfhi(gw_.x)));
        ow.y = pk2(v[j][0][2] * rstd * n0[2] * silu_f(bflo(gw_.y)), v[j][0][3] * rstd * n0[3] * silu_f(bfhi(gw_.y)));
        ow.z = pk2(v[j][1][0] * rstd * n1[0] * silu_f(bflo(gw_.z)), v[j][1][1] * rstd * n1[1] * silu_f(bfhi(gw_.z)));
        ow.w = pk2(v[j][1][2] * rstd * n1[2] * silu_f(bflo(gw_.w)), v[j][1][3] * rstd * n1[3] * silu_f(bfhi(gw_.w)));
        *(GAS u32x4*)(op + 64 * j) = ow;
    }
    __syncthreads();
}


#define XB_TMO      128
#define XB_XCNT(j)  (256  + 64 * (j))
#define XB_XSUB(j)  (1280 + 64 * (j))
#define XB_XGEN(j)  (2304 + 64 * (j))
#define XB_TOP      3328
#define XB_TOPGEN   3392
#define XCD_BAR_WORDS 3456
#define XB_SPIN_CAP (1u << 22)
__device__ __forceinline__ unsigned xb_ld(unsigned* p)              { return __hip_atomic_load(p, __ATOMIC_RELAXED, __HIP_MEMORY_SCOPE_AGENT); }
__device__ __forceinline__ unsigned xb_add(unsigned* p, unsigned v) { return __hip_atomic_fetch_add(p, v, __ATOMIC_RELAXED, __HIP_MEMORY_SCOPE_AGENT); }
__device__ __forceinline__ unsigned xb_xcc_id() { return (unsigned)__builtin_amdgcn_s_getreg((3 << 11) | 20) & 0xFu; }
#define XB_SPIN(cond, bar) do { unsigned _sp = 0; while (cond) { __builtin_amdgcn_s_sleep(1); \
    if ((++_sp & 255u) == 0u) { if (xb_ld(&(bar)[XB_TMO])) break; if (_sp > XB_SPIN_CAP) { atomicAdd(&(bar)[XB_TMO], 1u); break; } } } } while (0)
struct XcdBarrier { unsigned* bar; unsigned x; volatile LAS unsigned* st; };
__device__ __forceinline__ XcdBarrier xcd_barrier_post(unsigned* bar, volatile LAS unsigned* st, bool t0) {
    XcdBarrier b; b.bar = bar; b.x = xb_xcc_id(); b.st = st;
    if (t0) (void)xb_add(&bar[XB_XCNT(b.x)], 1u);
    return b;
}
__device__ __forceinline__ void xcd_barrier_complete(unsigned* bar, unsigned x, unsigned& nloc, unsigned& nx) {
    const unsigned G = gridDim.x * gridDim.y * gridDim.z;
    unsigned sum, cnt, mine, sp = 0u;
    for (;;) {
        sum = 0u; cnt = 0u; mine = 0u;
#pragma unroll
        for (unsigned j = 0; j < 16; ++j) { const unsigned c = xb_ld(&bar[XB_XCNT(j)]); sum += c; cnt += (c > 0u) ? 1u : 0u; mine = (j == x) ? c : mine; }
        if (sum == G) break;
        __builtin_amdgcn_s_sleep(1);
        if ((++sp & 255u) == 0u) { if (xb_ld(&bar[XB_TMO])) break; if (sp > XB_SPIN_CAP) { atomicAdd(&bar[XB_TMO], 1u); break; } }
    }
    nloc = mine > 0u ? mine : 1u; nx = cnt > 0u ? cnt : 1u;
}
__device__ __forceinline__ void xcd_barrier(const XcdBarrier& b, bool t0) {
    asm volatile("s_waitcnt vmcnt(0)" ::: "memory");
    __syncthreads();
    if (t0) {
        unsigned* bar = b.bar;
        __builtin_amdgcn_s_waitcnt(0);
        unsigned nloc = b.st[0], nx = b.st[1];
        if (nloc == 0u) { xcd_barrier_complete(bar, b.x, nloc, nx); b.st[0] = nloc; b.st[1] = nx; }
        const unsigned old = xb_add(&bar[XB_XSUB(b.x)], 1u);
        const unsigned gen = old / nloc;
        if (old + 1u == (gen + 1u) * nloc) {
            __builtin_amdgcn_fence(__ATOMIC_RELEASE, "agent");
            asm volatile("s_waitcnt vmcnt(0)" ::: "memory");
            const unsigned og = xb_add(&bar[XB_TOP], 1u);
            const unsigned tg = og / nx;
            if (og + 1u == (tg + 1u) * nx) xb_add(&bar[XB_TOPGEN], 1u);
            else XB_SPIN(xb_ld(&bar[XB_TOPGEN]) == tg, bar);
            __builtin_amdgcn_fence(__ATOMIC_ACQUIRE, "agent");
            xb_add(&bar[XB_XGEN(b.x)], 1u);
            asm volatile("s_waitcnt vmcnt(0)" ::: "memory");
        } else {
            XB_SPIN(xb_ld(&bar[XB_XGEN(b.x)]) == gen, bar);
            __builtin_amdgcn_fence(__ATOMIC_ACQUIRE, "agent");
            asm volatile("s_waitcnt vmcnt(0)" ::: "memory");
        }
    }
    __syncthreads();
}

__global__ void __launch_bounds__(512, 2) mk_fwd(Args a) {
    extern __shared__ __attribute__((aligned(16))) unsigned char lds[];
    cg::grid_group grid = cg::this_grid();
    LAS unsigned char* L = (LAS unsigned char*)lds;
    const int G = gridDim.x, bid = blockIdx.x, NGW = G * 8;
    volatile LAS unsigned* MISC = (volatile LAS unsigned*)(L + RING_BYTES + 8192);
    const int wave_s = __builtin_amdgcn_readfirstlane(threadIdx.x >> 6);
    if (wave_s == 0 && lane_id_() < 4) MISC[lane_id_()] = 0u;
    __syncthreads();
    { KAP_T kap0 = (KAP_T)__builtin_amdgcn_kernarg_segment_ptr(); (void)xcd_barrier_post((unsigned*)(kap0->ws + WS_BAR), MISC, wave_s == 0 && lane_id_() == 0); }
#define XSYNC() do { KAP_T kap_ = (KAP_T)__builtin_amdgcn_kernarg_segment_ptr(); LAUNDER_S(kap_); XcdBarrier xb_; xb_.bar = (unsigned*)(kap_->ws + WS_BAR); xb_.x = xb_xcc_id(); xb_.st = (volatile LAS unsigned*)(L + RING_BYTES + 8192); xcd_barrier(xb_, wave_s == 0 && lane_id_() == 0); } while (0)
#define GRID_SYNC() do { asm volatile("s_waitcnt vmcnt(0) lgkmcnt(0)" ::: "memory"); __syncthreads(); grid.sync(); \
    __builtin_amdgcn_fence(__ATOMIC_ACQUIRE, "agent"); asm volatile("s_waitcnt vmcnt(0)" ::: "memory"); __syncthreads(); } while (0)
#ifndef DBG_STOP
#define DBG_STOP 0
#endif
#define DBG_DUMP(k, EXPR) do { if (DBG_STOP == (k)) { PHASE_BEGIN(); for (int m = gw; m < SEQ; m += NGW) for (int c = lane; c < DM; c += 64) out[(size_t)m * DM + c] = (EXPR); return; } } while (0)
#define PHASE_BEGIN() KAP_T kap = (KAP_T)__builtin_amdgcn_kernarg_segment_ptr(); LAUNDER_S(kap); unsigned char* ws = kap->ws; LAUNDER_S(ws); int tid_ = wave_s * 64 + lane_id_(); LAUNDER_V(tid_); const int tid = tid_, lane = tid & 63, wave = __builtin_amdgcn_readfirstlane(tid >> 6), gw = bid * 8 + wave; \
    u64* ssq = (u64*)(ws + WS_SSQ); (void)lane; (void)gw; (void)ssq; \
    u64* ssq_x = ssq + (size_t)l * SEQ; u64* ssq_xn = ssq + (size_t)(l + 1) * SEQ; u64* ssq_cq = ssq + (size_t)(3 + l) * SEQ; u64* ssq_ckv = ssq + (size_t)(5 + l) * SEQ; u64* ssq_x1 = ssq + (size_t)(7 + l) * SEQ; u64* ssq_a = ssq + (size_t)(9 + l) * SEQ; (void)ssq_a; \
    (void)ssq_x; (void)ssq_xn; (void)ssq_cq; (void)ssq_ckv; (void)ssq_x1; \
    bf16_t* Win = (bf16_t*)(ws + WS_WIN); bf16_t* Wuq = (bf16_t*)(ws + WS_WUQ); bf16_t* Wukv = (bf16_t*)(ws + WS_WUKV); \
    bf16_t* Wout = (bf16_t*)(ws + WS_WOUT); bf16_t* Wup = (bf16_t*)(ws + WS_WUP); bf16_t* Wdn = (bf16_t*)(ws + WS_WDN); \
    bf16_t* XB = (bf16_t*)(ws + WS_XB); bf16_t* Z = (bf16_t*)(ws + WS_Z); bf16_t* Qb = (bf16_t*)(ws + WS_Q); bf16_t* Kb = (bf16_t*)(ws + WS_K); bf16_t* Vt = (bf16_t*)(ws + WS_VT); \
    bf16_t* ST = (bf16_t*)(ws + WS_ST); float* DEC = (float*)(ws + WS_DEC); bf16_t* MIX = (bf16_t*)(ws + WS_MIX); \
    bf16_t* ACT = (bf16_t*)(ws + WS_ACT); float* EDGE = (float*)(ws + WS_EDGE); \
    const float* xin = kap->in[0]; float* out = kap->out; \
    (void)Win; (void)Wuq; (void)Wukv; (void)Wout; (void)Wup; (void)Wdn; (void)XB; (void)Z; (void)Qb; (void)Kb; (void)Vt; (void)ST; (void)DEC; (void)MIX; (void)EDGE; (void)ACT; (void)xin; (void)out;

    for (int l = 0; l < NLAYER; ++l) {
        {
            PHASE_BEGIN();
            LAS float* scr = (LAS float*)(L + wave * 16384);
            const float* w_in = kap->in[3] + (size_t)l * DM * IN_DIM; const float* w_uq = kap->in[5] + (size_t)l * QLORA * QW; const float* w_ukv = kap->in[7] + (size_t)l * KVLORA * KVW;
            const float* w_out = kap->in[14] + (size_t)l * DM * DM; const float* w_up = kap->in[16] + (size_t)l * DM * DFF2; const float* w_dn = kap->in[19] + (size_t)l * DFF * DM;
            const float* g_attn = kap->in[2] + l * DM; const float* g_cq = kap->in[4] + l * QLORA; const float* g_ckv = kap->in[6] + l * KVLORA; const float* g_mla = kap->in[13] + l * 1024; const float* g_ffn = kap->in[15] + l * DM;
            constexpr int I_IN = (DM / 64) * (IN_PAD / 32), I_UQ = (QLORA / 64) * (QW / 32), I_UKV = (KVLORA / 64) * (KVW / 32), I_OUT = (DM / 64) * (DM / 32), I_UP = (DM / 64) * (DFF2 / 32), I_DN = (DFF / 64) * (DM / 32);
            constexpr int NITEMS = I_IN + I_UQ + I_UKV + I_OUT + I_UP + I_DN;
            for (int it = gw; it < NITEMS; it += NGW) {
                int r = it;
                if (r < I_IN) { wt_item(w_in, DM, IN_DIM, g_attn, DM, Win, scr, r, IN_PAD / 32, lane); continue; } r -= I_IN;
                if (r < I_UQ) { wt_item(w_uq, QLORA, QW, g_cq, QLORA, Wuq, scr, r, QW / 32, lane); continue; } r -= I_UQ;
                if (r < I_UKV) { wt_item(w_ukv, KVLORA, KVW, g_ckv, KVLORA, Wukv, scr, r, KVW / 32, lane); continue; } r -= I_UKV;
                if (r < I_OUT) { wt_item(w_out, DM, DM, g_mla, 1024, Wout, scr, r, DM / 32, lane); continue; } r -= I_OUT;
                if (r < I_UP) { wt_item(w_up, DM, DFF2, g_ffn, DM, Wup, scr, r, DFF2 / 32, lane, true); continue; } r -= I_UP;
                wt_item(w_dn, DFF, DM, g_ffn, 0, Wdn, scr, r, DM / 32, lane);
            }
            if (l == 0) {
                for (int m = gw; m < SEQ; m += NGW) {
                    GAS const f32x4* xr = (GAS const f32x4*)(G_(xin) + (size_t)m * DM) + lane; float s = 0.f;
                    GAS u32x2* o8 = (GAS u32x2*)(G_(XB) + (size_t)m * DM) + lane;
#pragma unroll
                    for (int j = 0; j < 8; ++j) { const f32x4 v = xr[64 * j]; s += (v[0] * v[0] + v[1] * v[1]) + (v[2] * v[2] + v[3] * v[3]); o8[64 * j] = (u32x2){pk2(v[0], v[1]), pk2(v[2], v[3])}; }
                    s = wave_sum(s); if (lane == 0) G_(ssq_x)[m] = (u64)(s * SSQ_FX + 0.5f);
                }
            }
        }
        XSYNC();
        {
            PHASE_BEGIN();
            pg8::Gemm g{XB, Win, SEQ, IN_PAD, DM, DM, nullptr, 0.f}; pg8::StaticOrder S; S.init(SEQ, IN_PAD, G, bid);
            pg8::EpiRowScale E{Z, IN_PAD, ssq_x, 1.0f / DM, ssq_cq, 0, 2, ssq_ckv, 2, 3};
            pg8::gemm_phase<pg8::EpiRowScale>(L, g, S, E, wave_s);
        }
        XSYNC();
        DBG_DUMP(1, bf2f(Z[(size_t)m * IN_PAD + c]) + bf2f(Z[(size_t)m * IN_PAD + 2048 + c]));
        {
            PHASE_BEGIN();
            { pg8::Gemm g{Z + C_CQ, Wuq, SEQ, QW, QLORA, IN_PAD, nullptr, 0.f}; pg8::StaticOrder S; S.init(SEQ, QW, G, bid);
              pg8::EpiRowScale E{Qb, QW, ssq_cq, 1.0f / QLORA, nullptr, 0, 0, nullptr, 0, 0};
              pg8::gemm_phase<pg8::EpiRowScale>(L, g, S, E, wave_s); }
            { pg8::Gemm g{Z + C_CKV, Wukv, SEQ, KVW, KVLORA, IN_PAD, nullptr, 0.f}; pg8::StaticOrder S; S.init(SEQ, KVW, G, bid);
              pg8::EpiUkv E{Kb, Vt, ssq_ckv, 1.0f / KVLORA, Z, (const int*)kap->in[1], kap->in[9] + l * QKD, kap->inv_freq, (LAS float*)(L + RING_BYTES)};
              pg8::gemm_phase<pg8::EpiUkv>(L, g, S, E, wave_s); }
            const float* wgate = kap->in[10] + (size_t)l * 16 * (GH * GDK); const float* bgate = kap->in[11] + (size_t)l * (GH * GDK);
            for (int u = bid; u < NCHUNK * GH; u += G) gla_chunk_unit(L, Z, wgate, bgate, ST, DEC, u >> 2, u & 3, wave_s);
        }
        if (l == 0) GRID_SYNC(); else XSYNC();
        DBG_DUMP(2, (c < QW ? bf2f(Qb[(size_t)m * QW + c]) + bf2f(Kb[(size_t)m * QW + c]) : bf2f(Vt[(size_t)(c - QW) * SEQ + m])) + bf2f(ST[(size_t)m * 8192 + c]) + bf2f(ST[(size_t)m * 8192 + 4096 + c]));
        {
            PHASE_BEGIN();
            const int* pos = (const int*)kap->in[1];
            const float* kn = kap->in[9] + l * QKD;
            constexpr int NE = GH * GDV * GDK;
            for (int e = bid * 512 + tid; e < NE; e += G * 512) {
                const int hd = (e >> 15) * GDK + (e & 127);
                float s = 0.f;
                for (int c0 = 0; c0 < NCHUNK; c0 += 8) {
                    float uu[8], dd[8];
#pragma unroll
                    for (int i = 0; i < 8; ++i) { uu[i] = bf2f(G_(ST)[(size_t)(c0 + i) * NE + e]); dd[i] = G_(DEC)[(size_t)(c0 + i) * (GH * GDK) + hd]; }
#pragma unroll
                    for (int i = 0; i < 8; ++i) { s = s * dd[i] + uu[i]; G_(ST)[(size_t)(c0 + i) * NE + e] = (bf16_t)f2bf(s); }
                }
            }
        }
        XSYNC();
        DBG_DUMP(3, (c < QW ? bf2f(Qb[(size_t)m * QW + c]) + bf2f(Kb[(size_t)m * QW + c]) : 0.f) + bf2f(ST[(size_t)m * 8192 + c]) + bf2f(ST[(size_t)m * 8192 + 4096 + c]));
        {
            PHASE_BEGIN();
            for (int p = bid; p < 256; p += G) {
                const int h = p & 7, s = p >> 3;
                attn_unit(L, Qb, Kb, Vt, MIX, ssq_a, h, 63 - s, wave_s, (const int*)kap->in[1], kap->in[8] + l * QKD, kap);
                attn_unit(L, Qb, Kb, Vt, MIX, ssq_a, h, s, wave_s, (const int*)kap->in[1], kap->in[8] + l * QKD, kap);
            }
            const float* gnorm = kap->in[12] + l * GDV;
            for (int u = bid; u < NCHUNK * GH; u += G) gla_out_unit(L, Z, ST, gnorm, MIX, u >> 2, u & 3, wave_s);
        }
        XSYNC();
        DBG_DUMP(4, bf2f(MIX[(size_t)m * DM + c]));
        DBG_DUMP(5, bf2f(MIX[(size_t)m * DM + c]));
        {
            PHASE_BEGIN();
            pg8::Gemm g{MIX, Wout, SEQ, DM, DM, DM, ssq_a, 1.0f / 1024.0f}; pg8::StaticOrder S; S.init(SEQ, DM, G, bid);
            pg8::EpiRes E{l == 0 ? xin : out, out, XB, ssq_x1};
            pg8::gemm_phase<pg8::EpiRes, true>(L, g, S, E, wave_s);
        }
        XSYNC();
        DBG_DUMP(6, out[(size_t)m * DM + c] + bf2f(XB[(size_t)m * DM + c]));
        {
            PHASE_BEGIN();
            const float* cw = kap->in[17] + (size_t)l * 3 * DFF2; const float* cb = kap->in[18] + (size_t)l * DFF2;
            pg8::Gemm g{XB, Wup, SEQ, DFF2, DM, DM, nullptr, 0.f}; pg8::StaticOrder S; S.init(SEQ, DFF2, G, bid);
            pg8::EpiUpConv E{ACT, EDGE, ssq_x1, cw, cb, (LAS float*)(L + RING_BYTES)};
            pg8::gemm_phase<pg8::EpiUpConv>(L, g, S, E, wave_s);
        }
        XSYNC();
        {
            PHASE_BEGIN();
            const float* cw = kap->in[17] + (size_t)l * 3 * DFF2; const float* cb = kap->in[18] + (size_t)l * DFF2;
            for (int idx = bid * 512 + tid; idx < 63 * DFF; idx += G * 512) {
                const int pm = 1 + idx / DFF, gcol = idx % DFF;
                float y0[2], y1[2];
#pragma unroll
                for (int q = 0; q < 2; ++q) { const int c = q * DFF + gcol;
                    const float um2 = G_(EDGE)[(size_t)((pm - 1) * 4 + 2) * DFF2 + c], um1 = G_(EDGE)[(size_t)((pm - 1) * 4 + 3) * DFF2 + c], u0 = G_(EDGE)[(size_t)(pm * 4 + 0) * DFF2 + c], u1 = G_(EDGE)[(size_t)(pm * 4 + 1) * DFF2 + c];
                    const float w0 = G_(cw)[c], w1 = G_(cw)[DFF2 + c], w2 = G_(cw)[2 * DFF2 + c], bb = G_(cb)[c];
                    y0[q] = bb + w0 * um2 + w1 * um1 + w2 * u0; y1[q] = bb + w0 * um1 + w1 * u0 + w2 * u1; }
                G_(ACT)[(size_t)(pm * 256) * DFF + gcol] = (bf16_t)f2bf(silu_f(y0[0]) * y0[1]);
                G_(ACT)[(size_t)(pm * 256 + 1) * DFF + gcol] = (bf16_t)f2bf(silu_f(y1[0]) * y1[1]);
            }
        }
        XSYNC();
        DBG_DUMP(8, bf2f(ACT[(size_t)m * DFF + c]) + bf2f(ACT[(size_t)m * DFF + 3000 + c]));
        {
            PHASE_BEGIN();
            pg8::Gemm g{ACT, Wdn, SEQ, DM, DFF, DFF, nullptr, 0.f}; pg8::StaticOrder S; S.init(SEQ, DM, G, bid);
            pg8::EpiRes E{out, out, XB, ssq_xn};
            pg8::gemm_phase<pg8::EpiRes>(L, g, S, E, wave_s);
        }
        XSYNC();
        if (DBG_STOP == 9) return;
    }
}

extern "C" void kernel_launch(void* const* d_in, const int* in_sizes, int n_in, void* d_out, int out_size, void* d_ws, size_t ws_size, hipStream_t stream) {
    static int grid = 0;
    if (grid == 0) {
        if (n_in != 20 || out_size != SEQ * DM || ws_size < WS_END) { fprintf(stderr, "kernel_launch: unexpected shapes: n_in %d out %d ws %zu (need %zu)\n", n_in, out_size, ws_size, (size_t)WS_END); grid = -1; return; }
        int dev = 0, cus = 0, per_cu = 0;
        hipGetDevice(&dev); hipDeviceGetAttribute(&cus, hipDeviceAttributeMultiprocessorCount, dev);
        hipFuncSetAttribute((const void*)mk_fwd, hipFuncAttributeMaxDynamicSharedMemorySize, LDS_BYTES);
        hipOccupancyMaxActiveBlocksPerMultiprocessor(&per_cu, (const void*)mk_fwd, 512, LDS_BYTES);
        (void)hipGetLastError();
        if (per_cu < 1) per_cu = 1;
        grid = cus * 1;
    }
    if (grid < 0) return;
    hipMemsetAsync((char*)d_ws + WS_CTL, 0, CTL_BYTES, stream);
    Args a{};
    for (int i = 0; i < 20; ++i) a.in[i] = (const float*)d_in[i];
    a.out = (float*)d_out; a.ws = (unsigned char*)d_ws;
    for (int i = 0; i < 32; ++i) a.inv_freq[i] = (float)pow(10000.0, -(double)i / 32.0);
    void* args[] = {&a};
    hipError_t e = hipLaunchCooperativeKernel((const void*)mk_fwd, dim3(grid), dim3(512), args, LDS_BYTES, stream);
    if (e != hipSuccess) fprintf(stderr, "cooperative launch failed: %s (grid %d)\n", hipGetErrorString(e), grid);
}
```

```cpp
#include <hip/hip_runtime.h>
#include <hip/hip_cooperative_groups.h>
#include <cstdio>
#include <cstdint>
#include <cmath>
namespace cg = cooperative_groups;

#define LAS __attribute__((address_space(3)))
typedef unsigned short bf16_t;
typedef unsigned long long u64;
typedef short bf16x8 __attribute__((ext_vector_type(8)));
typedef short s16x4 __attribute__((ext_vector_type(4)));
typedef float f32x4 __attribute__((ext_vector_type(4)));
typedef float f32x16 __attribute__((ext_vector_type(16)));
typedef unsigned u32x4 __attribute__((ext_vector_type(4)));
typedef unsigned u32x2 __attribute__((ext_vector_type(2)));
typedef float f32x2_t __attribute__((ext_vector_type(2)));
typedef __bf16 bf16x2_t __attribute__((ext_vector_type(2)));

constexpr int SEQ = 16384, DM = 2048, NLAYER = 2;
constexpr int IN_DIM = 3920, IN_PAD = 4096;
constexpr int C_CQ = 0, C_CKV = 512, C_KR = 768, C_GQ = 832, C_GK = 1344, C_GV = 1856, C_GA = 2880, C_GG = 2896;
constexpr int QLORA = 512, KVLORA = 256, NH = 8, QKD = 192, NOPE = 128, VD = 128, QW = NH * QKD  , KVW = NH * 256  ;
constexpr int GH = 4, GDK = 128, GDV = 256, NCHUNK = SEQ / 64;
constexpr int DFF = 5632, DFF2 = 11264;
constexpr float EPS = 1e-6f;

constexpr size_t MiB = 1u << 20;
constexpr size_t WS_CTL = 0, CTL_BYTES = 2 * MiB;
constexpr size_t WS_BAR = 0;
constexpr size_t WS_SSQ = 65536;
constexpr size_t WS_WIN = 2 * MiB, WS_WUQ = 18 * MiB, WS_WUKV = WS_WUQ + 3 * MiB / 2, WS_WOUT = WS_WUKV + 1 * MiB, WS_WUP = WS_WOUT + 8 * MiB, WS_WDN = WS_WUP + 44 * MiB;
constexpr size_t WS_XB = 95 * MiB;
constexpr size_t WS_R = 159 * MiB;
constexpr size_t WS_Z = WS_R, WS_Q = WS_Z + 128 * MiB, WS_K = WS_Q + 48 * MiB, WS_VT = WS_K + 48 * MiB, WS_ST = WS_VT + 32 * MiB, WS_DEC = WS_ST + 128 * MiB, WS_MIX = WS_DEC + 1 * MiB;
constexpr size_t WS_ACT = WS_R, WS_EDGE = WS_ACT + 176 * MiB, WS_END = WS_MIX + 64 * MiB;
static_assert(WS_EDGE + 12 * MiB <= WS_END, "ws map");

#define GAS __attribute__((address_space(1)))
template <class T> __device__ __forceinline__ GAS T* G_(T* p) { return (GAS T*)p; }
__device__ __forceinline__ int lane_id_() { unsigned z = 0u; asm volatile("" : "+v"(z)); return (int)__builtin_amdgcn_mbcnt_hi(~0u, __builtin_amdgcn_mbcnt_lo(~0u, z)); }
#define LAUNDER_V(x) asm volatile("" : "+v"(x))
#define LAUNDER_S(x) asm volatile("" : "+s"(x))
__device__ __forceinline__ unsigned f2bf(float f) { unsigned u = __builtin_bit_cast(unsigned, f); return (u + 0x7fffu + ((u >> 16) & 1u)) >> 16; }
__device__ __forceinline__ unsigned pk2(float lo, float hi) { f32x2_t v = {lo, hi}; bf16x2_t b = __builtin_convertvector(v, bf16x2_t); return __builtin_bit_cast(unsigned, b); }
__device__ __forceinline__ float bf2f(unsigned b) { return __builtin_bit_cast(float, b << 16); }
__device__ __forceinline__ float bflo(unsigned w) { return __builtin_bit_cast(float, w << 16); }
__device__ __forceinline__ float bfhi(unsigned w) { return __builtin_bit_cast(float, w & 0xffff0000u); }
__device__ __forceinline__ float wave_sum(float v) {
#pragma unroll
    for (int o = 1; o < 64; o <<= 1) v += __shfl_xor(v, o);
    return v;
}
constexpr float SSQ_FX = 1048576.0f, SSQ_INV = 1.0f / 1048576.0f;
__device__ __forceinline__ void ssq_add(u64* p, float v) { __hip_atomic_fetch_add((GAS u64*)p, (u64)(v * SSQ_FX + 0.5f), __ATOMIC_RELAXED, __HIP_MEMORY_SCOPE_AGENT); }
__device__ __forceinline__ float ssq_get(const u64* p) { return (float)(*(GAS const u64*)p) * SSQ_INV; }
__device__ __forceinline__ float silu_f(float x) { return x * __builtin_amdgcn_rcpf(1.0f + __expf(-x)); }

namespace pg8 {
constexpr int BM = 256, BK = 64, HALF = 128, HTB = HALF * BK * 2, STAGE_BYTES = 8 * HTB, NXCD = 8, WGM = 8;
__host__ __device__ __forceinline__ int lds_byte(int r, int c) { const int st = (r >> 4) * 2 + (c >> 5), rr = r & 15, cc = c & 31, ob = rr * 64 + cc * 2; return st * 1024 + (ob ^ (((ob >> 9) & 1) << 5)); }
__host__ __device__ __forceinline__ void stage_rc(int b, int& R, int& C) { const int st = b / 1024, sb = b % 1024, swz = sb ^ (((sb >> 9) & 1) << 5); R = (st >> 1) * 16 + swz / 64; C = (st & 1) * 32 + (swz % 64) / 2; }
__host__ __device__ __forceinline__ int perm32(int rho) { const int n = rho >> 4, i = rho & 15; return 8 * (i >> 2) + 4 * n + (i & 3); }

struct Unit { int pm, pn; };
struct Gemm { const bf16_t* A; const bf16_t* Bt; int M, N, K, lda; const u64* mid_ssq; float mid_inv; };

struct StaticOrder {
    int nM, nN, nwg, G, c;
    __device__ void init(int M, int N, int G_, int c_) { nM = M / BM; nN = N / BM; nwg = nM * nN; G = G_; c = c_; }
    __device__ bool next(int i, Unit& u) const {
        const long L = (long)i * G + c; if (L >= nwg) return false;
        int wgid = (int)L; { const int q = nwg / NXCD, r = nwg % NXCD, xcd = wgid % NXCD, off = wgid / NXCD; wgid = (xcd < r ? xcd * (q + 1) : r * (q + 1) + (xcd - r) * q) + off; }
        const int nig = WGM * nN, gid = wgid / nig, fm = gid * WGM, gsz = (nM - fm) < WGM ? (nM - fm) : WGM;
        u.pm = fm + ((wgid % nig) % gsz); u.pn = (wgid % nig) / gsz; return true;
    }
};

struct EpiRowScale {
    static constexpr bool PERM = true;
    bf16_t* O; int ldc; const u64* ssq_in; float inv_dim; u64* ssq_a; int a_lo, a_hi; u64* ssq_b; int b_lo, b_hi;
    __device__ __forceinline__ void operator()(const f32x4 (&acc)[2][2][4][2], const Unit& u, int wr, int wc, int fr, int fq) const {
        const int row0 = u.pm * BM + wr * 64 + fr, col0 = u.pn * BM + wc * 32 + 8 * fq;
        u64* sacc = (u.pn >= a_lo && u.pn < a_hi) ? ssq_a : ((u.pn >= b_lo && u.pn < b_hi) ? ssq_b : nullptr);
        float scv[2][4];
#pragma unroll
        for (int ai = 0; ai < 2; ++ai)
#pragma unroll
            for (int m = 0; m < 4; ++m) scv[ai][m] = ssq_in ? ssq_get(ssq_in + row0 + ai * HALF + m * 16) : 0.f;
        asm volatile("" ::: "memory");
#pragma unroll
        for (int ai = 0; ai < 2; ++ai)
#pragma unroll
            for (int m = 0; m < 4; ++m) {
                const int row = row0 + ai * HALF + m * 16;
                const float sc = ssq_in ? rsqrtf(scv[ai][m] * inv_dim + EPS) : 1.0f;
                float ss = 0.f;
#pragma unroll
                for (int bj = 0; bj < 2; ++bj) {
                    const f32x4 v0 = acc[ai][bj][m][0] * sc, v1 = acc[ai][bj][m][1] * sc;
                    ss += (v0[0] * v0[0] + v0[1] * v0[1]) + (v0[2] * v0[2] + v0[3] * v0[3]) + (v1[0] * v1[0] + v1[1] * v1[1]) + (v1[2] * v1[2] + v1[3] * v1[3]);
                    u32x4 w; w.x = pk2(v0[0], v0[1]); w.y = pk2(v0[2], v0[3]); w.z = pk2(v1[0], v1[1]); w.w = pk2(v1[2], v1[3]);
                    *(GAS u32x4*)(G_(O) + (size_t)row * ldc + col0 + bj * HALF) = w;
                }
                if (sacc) { ss += __shfl_xor(ss, 16); ss += __shfl_xor(ss, 32); if (fq == 0) ssq_add(sacc + row, ss); }
            }
    }
};
struct EpiUkv {
    static constexpr bool PERM = true;
    bf16_t* Kb; bf16_t* Vt; const u64* ssq_in; float inv_dim; const bf16_t* Z; const int* pos; const float* kn; const __attribute__((address_space(4))) float* invf; LAS float* lx;
    __device__ __forceinline__ void operator()(f32x4 (&acc)[2][2][4][2], const Unit& u, int wr, int wc, int fr, int fq) const {
        const int row0 = u.pm * BM + wr * 64 + fr, c0 = wc * 32 + 8 * fq;
        const int lt = (wr * 4 + wc) * 64 + fq * 16 + fr, rr = lt >> 1, hf = lt & 1, rrow = u.pm * BM + rr;
        GAS const bf16_t* zr = G_(Z) + (size_t)rrow * IN_PAD + C_KR + 16 * hf;
        const u32x4 ra0 = *(GAS const u32x4*)(zr), ra1 = *(GAS const u32x4*)(zr + 8), rb0 = *(GAS const u32x4*)(zr + 32), rb1 = *(GAS const u32x4*)(zr + 40);
        const float posf = (float)G_(pos)[rrow];
        float scv[2][4];
#pragma unroll
        for (int ai = 0; ai < 2; ++ai)
#pragma unroll
            for (int m = 0; m < 4; ++m) scv[ai][m] = ssq_get(ssq_in + row0 + ai * HALF + m * 16);
        asm volatile("" ::: "memory");
        float x1[16], x2[16], sk = 0.f;
#pragma unroll
        for (int jj = 0; jj < 4; ++jj) { x1[2 * jj] = bflo(ra0[jj]); x1[2 * jj + 1] = bfhi(ra0[jj]); x1[8 + 2 * jj] = bflo(ra1[jj]); x1[8 + 2 * jj + 1] = bfhi(ra1[jj]);
                                         x2[2 * jj] = bflo(rb0[jj]); x2[2 * jj + 1] = bfhi(rb0[jj]); x2[8 + 2 * jj] = bflo(rb1[jj]); x2[8 + 2 * jj + 1] = bfhi(rb1[jj]); }
#pragma unroll
        for (int j = 0; j < 16; ++j) sk += x1[j] * x1[j] + x2[j] * x2[j];
        sk += __shfl_xor(sk, 1);
        if (hf == 0) lx[1024 + rr] = sk;
#pragma unroll
        for (int ai = 0; ai < 2; ++ai)
#pragma unroll
            for (int m = 0; m < 4; ++m) {
                const float sc = rsqrtf(scv[ai][m] * inv_dim + EPS);
#pragma unroll
                for (int bj = 0; bj < 2; ++bj)
#pragma unroll
                    for (int n = 0; n < 2; ++n) acc[ai][bj][m][n] = acc[ai][bj][m][n] * sc;
                const f32x4 v0 = acc[ai][0][m][0], v1 = acc[ai][0][m][1];
                float ss = (v0[0] * v0[0] + v0[1] * v0[1]) + (v0[2] * v0[2] + v0[3] * v0[3]) + (v1[0] * v1[0] + v1[1] * v1[1]) + (v1[2] * v1[2] + v1[3] * v1[3]);
                ss += __shfl_xor(ss, 16); ss += __shfl_xor(ss, 32);
                if (fq == 0) lx[(ai * HALF + wr * 64 + m * 16 + fr) * 4 + wc] = ss;
            }
        asm volatile("s_waitcnt lgkmcnt(0)" ::: "memory"); __builtin_amdgcn_s_barrier(); asm volatile("" ::: "memory");
        const f32x4 g0 = *(GAS const f32x4*)(G_(kn) + c0), g1 = *(GAS const f32x4*)(G_(kn) + c0 + 4);
#pragma unroll
        for (int ai = 0; ai < 2; ++ai)
#pragma unroll
            for (int m = 0; m < 4; ++m) {
                const int rt = ai * HALF + wr * 64 + m * 16 + fr, row = u.pm * BM + rt;
                const int prow = (row & ~15) | (row & 3) | ((row & 4) << 1) | ((row & 8) >> 1);
                const f32x4 pp = *(const LAS f32x4*)(lx + rt * 4);
                const float rk = rsqrtf(((pp[0] + pp[1]) + (pp[2] + pp[3]) + lx[1024 + rt]) * (1.0f / QKD) + EPS);
                { const f32x4 v0 = acc[ai][0][m][0] * rk * g0, v1 = acc[ai][0][m][1] * rk * g1;
                  u32x4 w; w.x = pk2(v0[0], v0[1]); w.y = pk2(v0[2], v0[3]); w.z = pk2(v1[0], v1[1]); w.w = pk2(v1[2], v1[3]);
                  *(GAS u32x4*)(G_(Kb) + (size_t)row * QW + u.pn * QKD + c0) = w; }
#pragma unroll
                for (int n = 0; n < 2; ++n)
#pragma unroll
                    for (int j = 0; j < 4; ++j) G_(Vt)[(size_t)(u.pn * VD + c0 + 4 * n + j) * SEQ + prow] = (bf16_t)f2bf(acc[ai][1][m][n][j]);
            }
        {
            const f32x4 pp = *(const LAS f32x4*)(lx + rr * 4);
            const float rk = rsqrtf(((pp[0] + pp[1]) + (pp[2] + pp[3]) + lx[1024 + rr]) * (1.0f / QKD) + EPS);
            GAS const float* g1p = G_(kn) + 128 + 16 * hf; GAS const float* g2p = G_(kn) + 160 + 16 * hf;
            float y1[16], y2[16];
#pragma unroll
            for (int j = 0; j < 16; ++j) {
                const float ang = posf * invf[16 * hf + j];
                double rev = (double)ang * 0.15915494309189535; rev -= __builtin_rint(rev);
                const float sn = __builtin_amdgcn_sinf((float)rev), cs = __builtin_amdgcn_cosf((float)rev);
                const float n1 = x1[j] * rk * g1p[j], n2 = x2[j] * rk * g2p[j];
                y1[j] = n1 * cs - n2 * sn; y2[j] = n2 * cs + n1 * sn;
            }
            GAS bf16_t* kp = G_(Kb) + (size_t)rrow * QW + u.pn * QKD + 128 + 16 * hf;
            *(GAS u32x4*)(kp) = (u32x4){pk2(y1[0], y1[1]), pk2(y1[2], y1[3]), pk2(y1[4], y1[5]), pk2(y1[6], y1[7])};
            *(GAS u32x4*)(kp + 8) = (u32x4){pk2(y1[8], y1[9]), pk2(y1[10], y1[11]), pk2(y1[12], y1[13]), pk2(y1[14], y1[15])};
            *(GAS u32x4*)(kp + 32) = (u32x4){pk2(y2[0], y2[1]), pk2(y2[2], y2[3]), pk2(y2[4], y2[5]), pk2(y2[6], y2[7])};
            *(GAS u32x4*)(kp + 40) = (u32x4){pk2(y2[8], y2[9]), pk2(y2[10], y2[11]), pk2(y2[12], y2[13]), pk2(y2[14], y2[15])};
        }
    }
};
struct EpiRes {
    static constexpr bool PERM = true;
    const bf16_t* base; float* out_f32; bf16_t* xb; u64* ssq_out;
    __device__ __forceinline__ void operator()(const f32x4 (&acc)[2][2][4][2], const Unit& u, int wr, int wc, int fr, int fq) const {
        const int row0 = u.pm * BM + wr * 64 + fr, col0 = u.pn * BM + wc * 32 + 8 * fq;
#pragma unroll
        for (int ai = 0; ai < 2; ++ai) {
            u32x4 bv[4][2];
#pragma unroll
            for (int m = 0; m < 4; ++m)
#pragma unroll
                for (int bj = 0; bj < 2; ++bj) bv[m][bj] = *(GAS const u32x4*)(G_(base) + (size_t)(row0 + ai * HALF + m * 16) * DM + col0 + bj * HALF);
            asm volatile("" ::: "memory");
#pragma unroll
            for (int m = 0; m < 4; ++m) {
                const int row = row0 + ai * HALF + m * 16; float ss = 0.f;
#pragma unroll
                for (int bj = 0; bj < 2; ++bj) {
                    const size_t off = (size_t)row * DM + col0 + bj * HALF;
                    const u32x4 b = bv[m][bj];
                    const f32x4 v0 = acc[ai][bj][m][0] + (f32x4){bflo(b.x), bfhi(b.x), bflo(b.y), bfhi(b.y)}, v1 = acc[ai][bj][m][1] + (f32x4){bflo(b.z), bfhi(b.z), bflo(b.w), bfhi(b.w)};
                    if (out_f32) { *(GAS f32x4*)(G_(out_f32) + off) = v0; *(GAS f32x4*)(G_(out_f32) + off + 4) = v1; }
                    else {
                        ss += (v0[0] * v0[0] + v0[1] * v0[1]) + (v0[2] * v0[2] + v0[3] * v0[3]) + (v1[0] * v1[0] + v1[1] * v1[1]) + (v1[2] * v1[2] + v1[3] * v1[3]);
                        u32x4 w; w.x = pk2(v0[0], v0[1]); w.y = pk2(v0[2], v0[3]); w.z = pk2(v1[0], v1[1]); w.w = pk2(v1[2], v1[3]);
                        *(GAS u32x4*)(G_(xb) + off) = w;
                    }
                }
                if (!out_f32) { ss += __shfl_xor(ss, 16); ss += __shfl_xor(ss, 32); if (fq == 0) ssq_add(ssq_out + row, ss); }
            }
        }
    }
};


#define DPP_SHR1(old, src) __builtin_bit_cast(float, __builtin_amdgcn_update_dpp(__builtin_bit_cast(int, (float)(old)), __builtin_bit_cast(int, (float)(src)), 0x111, 0xf, 0xf, false))
#define DPP_SHR2(old, src) __builtin_bit_cast(float, __builtin_amdgcn_update_dpp(__builtin_bit_cast(int, (float)(old)), __builtin_bit_cast(int, (float)(src)), 0x112, 0xf, 0xf, false))
#define DPP_ROR1(src) __builtin_bit_cast(float, __builtin_amdgcn_update_dpp(0, __builtin_bit_cast(int, (float)(src)), 0x121, 0xf, 0xf, false))
#define DPP_ROR2(src) __builtin_bit_cast(float, __builtin_amdgcn_update_dpp(0, __builtin_bit_cast(int, (float)(src)), 0x122, 0xf, 0xf, false))
struct EpiUpConv {
    static constexpr bool PERM = true;
    bf16_t* ACT; float* EDGE; const u64* ssq_in; const float* cw; const float* cb; LAS float* halo;
    __device__ __forceinline__ void operator()(f32x4 (&acc)[2][2][4][2], const Unit& u, int wr, int wc, int fr, int fq) const {
        const int row0 = u.pm * BM + wr * 64 + fr;
        const int g0 = u.pn * 128 + wc * 32 + 8 * fq;
#pragma unroll
        for (int ai = 0; ai < 2; ++ai)
#pragma unroll
            for (int m = 0; m < 4; ++m) {
                const float sc = rsqrtf(ssq_get(ssq_in + row0 + ai * HALF + m * 16) * (1.0f / DM) + EPS);
#pragma unroll
                for (int bj = 0; bj < 2; ++bj)
#pragma unroll
                    for (int n = 0; n < 2; ++n) acc[ai][bj][m][n] = acc[ai][bj][m][n] * sc;
            }
        if (fr >= 14) {
#pragma unroll
            for (int ai = 0; ai < 2; ++ai) { LAS float* hp = halo + ((((2 * ai + wr) * 4 + wc) * 2 + (fr - 14)) * 4 + fq) * 16;
#pragma unroll
                for (int bj = 0; bj < 2; ++bj)
#pragma unroll
                    for (int n = 0; n < 2; ++n) *(LAS f32x4*)(hp + bj * 8 + n * 4) = acc[ai][bj][3][n]; }
            if (wr == 1) { GAS float* ep = G_(EDGE) + (size_t)(u.pm * 4 + 2 + fr - 14) * DFF2 + g0;
#pragma unroll
                for (int bj = 0; bj < 2; ++bj)
#pragma unroll
                    for (int n = 0; n < 2; ++n) *(GAS f32x4*)(ep + bj * DFF + 4 * n) = acc[1][bj][3][n]; }
        }
        if (fr < 2 && wr == 0) { GAS float* ep = G_(EDGE) + (size_t)(u.pm * 4 + fr) * DFF2 + g0;
#pragma unroll
            for (int bj = 0; bj < 2; ++bj)
#pragma unroll
                for (int n = 0; n < 2; ++n) *(GAS f32x4*)(ep + bj * DFF + 4 * n) = acc[0][bj][0][n]; }
        asm volatile("s_waitcnt lgkmcnt(0)" ::: "memory"); __builtin_amdgcn_s_barrier(); asm volatile("" ::: "memory");
#pragma unroll
        for (int n = 0; n < 2; ++n) {
            const int gc = g0 + 4 * n;
            GAS const float* cwg = G_(cw); GAS const float* cbg = G_(cb);
            const f32x4 wg0 = *(GAS const f32x4*)(cwg + gc), wg1 = *(GAS const f32x4*)(cwg + DFF2 + gc), wg2 = *(GAS const f32x4*)(cwg + 2 * DFF2 + gc), bgv = *(GAS const f32x4*)(cbg + gc);
            const f32x4 wu0 = *(GAS const f32x4*)(cwg + DFF + gc), wu1 = *(GAS const f32x4*)(cwg + DFF2 + DFF + gc), wu2 = *(GAS const f32x4*)(cwg + 2 * DFF2 + DFF + gc), buv = *(GAS const f32x4*)(cbg + DFF + gc);
#pragma unroll
            for (int ai = 0; ai < 2; ++ai) {
                const int band = 2 * ai + wr;
                f32x4 pg = (f32x4){0.f, 0.f, 0.f, 0.f}, pu = pg;
                if (band > 0) { const LAS float* hp = halo + ((((band - 1) * 4 + wc) * 2 + (fr & 1)) * 4 + fq) * 16; pg = *(const LAS f32x4*)(hp + n * 4); pu = *(const LAS f32x4*)(hp + 8 + n * 4); }
#pragma unroll
                for (int m = 0; m < 4; ++m) {
                    const f32x4 cg = acc[ai][0][m][n], cu = acc[ai][1][m][n];
                    float av[4];
#pragma unroll
                    for (int j = 0; j < 4; ++j) {
                        const float g1 = DPP_SHR1(DPP_ROR1(pg[j]), cg[j]), g2 = DPP_SHR2(DPP_ROR2(pg[j]), cg[j]);
                        const float u1 = DPP_SHR1(DPP_ROR1(pu[j]), cu[j]), u2 = DPP_SHR2(DPP_ROR2(pu[j]), cu[j]);
                        const float yg = bgv[j] + wg0[j] * g2 + wg1[j] * g1 + wg2[j] * cg[j];
                        const float yu = buv[j] + wu0[j] * u2 + wu1[j] * u1 + wu2[j] * cu[j];
                        av[j] = silu_f(yg) * yu;
                    }
                    *(GAS u32x2*)(G_(ACT) + (size_t)(row0 + ai * HALF + m * 16) * DFF + gc) = (u32x2){pk2(av[0], av[1]), pk2(av[2], av[3])};
                    pg = cg; pu = cu;
                }
            }
        }
    }
};

template <class Epi, bool MIDSCALE = false>
__device__ __forceinline__ void gemm_phase(LAS unsigned char* lds, const Gemm g, const StaticOrder& S, const Epi& E, int wv) {
    int tid_ = wv * 64 + lane_id_(); LAUNDER_V(tid_);
    const int tid = tid_, wid = __builtin_amdgcn_readfirstlane(tid >> 6), lane = tid & 63, wr = wid >> 2, wc = wid & 3, fr = lane & 15, fq = lane >> 4;
    const int K = g.K, nt = K / BK;
    unsigned voffA[2], voffB[2];
#pragma unroll
    for (int i = 0; i < 2; ++i) { int R, C; stage_rc(tid * 16 + i * 8192, R, C); const int Rb = Epi::PERM ? ((R & ~31) + perm32(R & 31)) : R;
        voffA[i] = (unsigned)(R * g.lda + C) * 2u; voffB[i] = (unsigned)(Rb * K + C) * 2u; }
    const size_t kstep = (size_t)(BK * 2);
    const size_t hstepA = (size_t)HALF * g.lda * 2, hstepB = (size_t)HALF * K * 2;
    const size_t tstepA = 2 * hstepA, tstepB = 2 * hstepB;
    const unsigned ldsw = (unsigned)wid * 1024u;
    const int aoff = lds_byte(wr * 64 + fr, fq * 8), boff = lds_byte(wc * 32 + fr, fq * 8);
#define PG8_SA(b, h) (((b) * 2 + (h)) * HTB)
#define PG8_SB(b, h) ((4 + (b) * 2 + (h)) * HTB)
#define PG8_STAGE(bufoff, gbase, voff) do { _Pragma("unroll") for (int _i = 0; _i < 2; ++_i) \
        __builtin_amdgcn_global_load_lds((const unsigned*)((const char*)(gbase) + (voff)[_i]), (LAS unsigned*)(lds + (bufoff) + ldsw + _i * 8192), 16, 0, 0); } while (0)
#define PG8_LDA(dst, b, h) do { _Pragma("unroll") for (int m = 0; m < 4; ++m) _Pragma("unroll") for (int k = 0; k < 2; ++k) dst[m][k] = *(const LAS bf16x8*)(lds + PG8_SA(b, h) + aoff + m * 2048 + k * 1024); } while (0)
#define PG8_LDB(dst, b, h) do { _Pragma("unroll") for (int n = 0; n < 2; ++n) _Pragma("unroll") for (int k = 0; k < 2; ++k) dst[n][k] = *(const LAS bf16x8*)(lds + PG8_SB(b, h) + boff + n * 2048 + k * 1024); } while (0)
#define PG8_MMA(ai, bj, At, Bt) do { __builtin_amdgcn_s_setprio(1); _Pragma("unroll") for (int m = 0; m < 4; ++m) _Pragma("unroll") for (int n = 0; n < 2; ++n) _Pragma("unroll") for (int k = 0; k < 2; ++k) \
        acc[ai][bj][m][n] = __builtin_amdgcn_mfma_f32_16x16x32_bf16(Bt[n][k], At[m][k], acc[ai][bj][m][n], 0, 0, 0); __builtin_amdgcn_s_setprio(0); } while (0)
#define PG8_WAIT_V(n) asm volatile("s_waitcnt vmcnt(" #n ")" ::: "memory")
#define PG8_WAIT_L(n) asm volatile("s_waitcnt lgkmcnt(" #n ")" ::: "memory")
#define PG8_BAR __builtin_amdgcn_s_barrier()
#define PG8_SCHED __builtin_amdgcn_sched_barrier(0)
    Unit cur, nxt; int ui = 0;
    if (!S.next(0, cur)) return;
    f32x4 acc[2][2][4][2];
#pragma unroll
    for (int a = 0; a < 2; ++a)
#pragma unroll
        for (int b = 0; b < 2; ++b)
#pragma unroll
            for (int m = 0; m < 4; ++m)
#pragma unroll
                for (int n = 0; n < 2; ++n) acc[a][b][m][n] = (f32x4){0.f, 0.f, 0.f, 0.f};
    bf16x8 At[4][2], B0[2][2], B1[2][2];
    const char* cA = (const char*)g.A + (size_t)cur.pm * tstepA; const char* cB = (const char*)g.Bt + (size_t)cur.pn * tstepB;
    PG8_STAGE(PG8_SB(0, 0), cB, voffB); PG8_STAGE(PG8_SB(0, 1), cB + hstepB, voffB); PG8_STAGE(PG8_SA(0, 0), cA, voffA); PG8_STAGE(PG8_SA(0, 1), cA + hstepA, voffA);
    if (wr == 1) PG8_BAR;
    PG8_WAIT_V(2); PG8_BAR;
    PG8_STAGE(PG8_SB(1, 0), cB + kstep, voffB); PG8_STAGE(PG8_SA(1, 0), cA + kstep, voffA); PG8_STAGE(PG8_SB(1, 1), cB + hstepB + kstep, voffB);
    PG8_WAIT_V(6); PG8_BAR;
    for (;;) {
        const bool has_next = S.next(ui + 1, nxt);
        const char* nA = has_next ? (const char*)g.A + (size_t)nxt.pm * tstepA : cA; const char* nB = has_next ? (const char*)g.Bt + (size_t)nxt.pn * tstepB : cB;
        for (int t = 0; t < nt; t += 2) {
            const bool last = (t == nt - 2);
            const char* a1 = cA + (size_t)(t + 1) * kstep;
            const char* a2 = last ? nA : cA + (size_t)(t + 2) * kstep; const char* b2 = last ? nB : cB + (size_t)(t + 2) * kstep;
            const char* a3 = a2 + kstep; const char* b3 = b2 + kstep;
            if constexpr (MIDSCALE) { if (t == nt / 2) {
#pragma unroll
                for (int ai = 0; ai < 2; ++ai)
#pragma unroll
                    for (int m = 0; m < 4; ++m) { const float sc = rsqrtf(ssq_get(g.mid_ssq + cur.pm * BM + ai * HALF + wr * 64 + m * 16 + fr) * g.mid_inv + EPS);
#pragma unroll
                        for (int bj = 0; bj < 2; ++bj)
#pragma unroll
                            for (int n = 0; n < 2; ++n) acc[ai][bj][m][n] = acc[ai][bj][m][n] * sc; } } }
            PG8_LDB(B0, 0, 0); PG8_LDB(B1, 0, 1); PG8_SCHED; PG8_LDA(At, 0, 0); PG8_STAGE(PG8_SA(1, 1), a1 + hstepA, voffA);
            PG8_WAIT_V(8); PG8_WAIT_L(0); PG8_BAR; PG8_MMA(0, 0, At, B0); PG8_MMA(0, 1, At, B1); PG8_BAR; PG8_SCHED;
            PG8_LDA(At, 0, 1); PG8_STAGE(PG8_SB(0, 0), b2, voffB); PG8_STAGE(PG8_SB(0, 1), b2 + hstepB, voffB); PG8_STAGE(PG8_SA(0, 0), a2, voffA);
            PG8_WAIT_V(8); PG8_WAIT_L(0); PG8_BAR; PG8_MMA(1, 0, At, B0); PG8_MMA(1, 1, At, B1); PG8_BAR; PG8_SCHED;
            PG8_LDB(B0, 1, 0); PG8_LDB(B1, 1, 1); PG8_SCHED; PG8_LDA(At, 1, 0); PG8_STAGE(PG8_SA(0, 1), a2 + hstepA, voffA);
            PG8_WAIT_V(8); PG8_WAIT_L(0); PG8_BAR; PG8_MMA(0, 0, At, B0); PG8_MMA(0, 1, At, B1); PG8_BAR; PG8_SCHED;
            PG8_LDA(At, 1, 1); PG8_STAGE(PG8_SB(1, 0), b3, voffB); PG8_STAGE(PG8_SB(1, 1), b3 + hstepB, voffB); PG8_STAGE(PG8_SA(1, 0), a3, voffA);
            PG8_WAIT_V(8); PG8_WAIT_L(0); PG8_BAR; PG8_MMA(1, 0, At, B0); PG8_MMA(1, 1, At, B1); PG8_BAR; PG8_SCHED;
        }
        if (wr == 0) PG8_BAR;
        { int frE = fr, fqE = fq; LAUNDER_V(frE); LAUNDER_V(fqE); E(acc, cur, wr, wc, frE, fqE); }
        if (!has_next) break;
#pragma unroll
        for (int a = 0; a < 2; ++a)
#pragma unroll
            for (int b = 0; b < 2; ++b)
#pragma unroll
                for (int m = 0; m < 4; ++m)
#pragma unroll
                    for (int n = 0; n < 2; ++n) acc[a][b][m][n] = (f32x4){0.f, 0.f, 0.f, 0.f};
        cur = nxt; cA = nA; cB = nB; ++ui;
        if (wr == 1) PG8_BAR;
    }
    PG8_WAIT_V(0);
    PG8_BAR;
#undef PG8_SA
#undef PG8_SB
#undef PG8_STAGE
#undef PG8_LDA
#undef PG8_LDB
#undef PG8_MMA
#undef PG8_WAIT_V
#undef PG8_WAIT_L
#undef PG8_BAR
#undef PG8_SCHED
}
}

constexpr int RING_BYTES = 131072;
constexpr int LDS_BYTES = 147456;

struct Args { const float* in[20]; float* out; unsigned char* ws; float inv_freq[32]; };
typedef const __attribute__((address_space(4))) Args* KAP_T;

#define DS_READ4(r0, r1, r2, r3, addr, o0, o1, o2, o3) asm volatile("ds_read_b128 %0, %4 offset:%5\n\tds_read_b128 %1, %4 offset:%6\n\tds_read_b128 %2, %4 offset:%7\n\tds_read_b128 %3, %4 offset:%8" \
    : "=&v"(r0), "=&v"(r1), "=&v"(r2), "=&v"(r3) : "v"(addr), "i"(o0), "i"(o1), "i"(o2), "i"(o3) : "memory")
#define LGKM_WAIT4(n, r0, r1, r2, r3) asm volatile("s_waitcnt lgkmcnt(" #n ")" : "+v"(r0), "+v"(r1), "+v"(r2), "+v"(r3) :: "memory")
#define MFMA32(a, b, c) __builtin_amdgcn_mfma_f32_32x32x16_bf16((a), (b), (c), 0, 0, 0)
__device__ __forceinline__ int crow(int r, int hi) { return (r & 3) + 8 * (r >> 2) + 4 * hi; }

__device__ __forceinline__ void wt_item(const float* __restrict__ W, int K, int N, const float* __restrict__ gain, int gainK, bf16_t* WT, LAS float* scr, int item, int nblk, int lane, bool remap_up = false) {
    const int kb = item / nblk, nb = item % nblk, k0 = 64 * kb, n0 = 32 * nb;
    const int ns0 = remap_up ? (((n0 & 255) < 128) ? 128 * (n0 >> 8) + (n0 & 255) : DFF + 128 * (n0 >> 8) + (n0 & 255) - 128) : n0;
    const int n = ns0 + (lane & 31);
    float wv[32];
#pragma unroll
    for (int i = 0; i < 32; ++i) { const int kk = 2 * i + (lane >> 5); wv[i] = (n < N) ? G_(W)[(size_t)(k0 + kk) * N + n] : 0.f; }
#pragma unroll
    for (int i = 0; i < 32; ++i) { const int kk = 2 * i + (lane >> 5); scr[kk * 33 + (lane & 31)] = wv[i]; }
    asm volatile("s_waitcnt lgkmcnt(0)" ::: "memory");
    const int c = lane & 7;
    f32x4 g0 = (f32x4){1.f, 1.f, 1.f, 1.f}, g1 = g0;
    if (k0 < gainK) { g0 = *(GAS const f32x4*)(G_(gain) + k0 + 8 * c); g1 = *(GAS const f32x4*)(G_(gain) + k0 + 8 * c + 4); }
#pragma unroll
    for (int j = 0; j < 4; ++j) { const int nn = (lane >> 3) + 8 * j; const LAS float* s = scr + (8 * c) * 33 + nn;
        u32x4 o; o.x = pk2(s[0 * 33] * g0[0], s[1 * 33] * g0[1]); o.y = pk2(s[2 * 33] * g0[2], s[3 * 33] * g0[3]); o.z = pk2(s[4 * 33] * g1[0], s[5 * 33] * g1[1]); o.w = pk2(s[6 * 33] * g1[2], s[7 * 33] * g1[3]);
        *(GAS u32x4*)(G_(WT) + (size_t)(n0 + nn) * K + k0 + 8 * c) = o; }
    asm volatile("s_waitcnt lgkmcnt(0)" ::: "memory");
}

constexpr int AT_KB = 3 * 8192, AT_VB = 16384, AT_NBUF = 3, AT_BUF = AT_KB + AT_VB  , AT_WSF = AT_NBUF * AT_BUF;
static_assert(AT_WSF + 8 * 128 <= RING_BYTES, "attn lds");
#define DS_READ4X(r0, r1, r2, r3, a0, a1, a2, a3, o0, o1, o2, o3) asm volatile("ds_read_b128 %0, %4 offset:%8\n\tds_read_b128 %1, %5 offset:%9\n\tds_read_b128 %2, %6 offset:%10\n\tds_read_b128 %3, %7 offset:%11" \
    : "=&v"(r0), "=&v"(r1), "=&v"(r2), "=&v"(r3) : "v"(a0), "v"(a1), "v"(a2), "v"(a3), "i"(o0), "i"(o1), "i"(o2), "i"(o3) : "memory")

__device__ __forceinline__ void attn_unit(LAS unsigned char* L, const bf16_t* Q_, const bf16_t* Kg_, const bf16_t* Vt_, bf16_t* mix_, u64* ssq_a, int h, int qb, int wv, const int* pos_, const float* qn_, KAP_T kap) {
    GAS const bf16_t* Q = G_(Q_); GAS const bf16_t* Kg = G_(Kg_); GAS const bf16_t* Vt = G_(Vt_); GAS bf16_t* mix = G_(mix_);
    int tid_ = wv * 64 + lane_id_(); LAUNDER_V(tid_);
    const int tid = tid_, lane = tid & 63, w = __builtin_amdgcn_readfirstlane(tid >> 6), r32 = lane & 31, hh = lane >> 5;
    const int q0 = qb * 256;
    bf16x8 qf[12];
    {
        const int qrow_i = q0 + 32 * w + r32;
        GAS const bf16_t* qrow = Q + (size_t)qrow_i * QW + h * QKD + 8 * hh;
        u32x4 raw[12];
#pragma unroll
        for (int ks = 0; ks < 12; ++ks) raw[ks] = *(GAS const u32x4*)(qrow + 16 * ks);
        const float posf = (float)G_(pos_)[qrow_i];
        float ss = 0.f;
#pragma unroll
        for (int ks = 0; ks < 12; ++ks)
#pragma unroll
            for (int jj = 0; jj < 4; ++jj) { const float lo = bflo(raw[ks][jj]), hi = bfhi(raw[ks][jj]); ss += lo * lo + hi * hi; }
        ss += __shfl_xor(ss, 32);
        const float rs = rsqrtf(ss * (1.0f / QKD) + EPS) * (0.07216878364870322f * 1.4426950408889634f);
        GAS const float* qn = G_(qn_) + 8 * hh;
#pragma unroll
        for (int ks = 0; ks < 8; ++ks) { const f32x4 g0 = *(GAS const f32x4*)(qn + 16 * ks), g1 = *(GAS const f32x4*)(qn + 16 * ks + 4);
            u32x4 o_; o_.x = pk2(bflo(raw[ks].x) * rs * g0[0], bfhi(raw[ks].x) * rs * g0[1]); o_.y = pk2(bflo(raw[ks].y) * rs * g0[2], bfhi(raw[ks].y) * rs * g0[3]);
            o_.z = pk2(bflo(raw[ks].z) * rs * g1[0], bfhi(raw[ks].z) * rs * g1[1]); o_.w = pk2(bflo(raw[ks].w) * rs * g1[2], bfhi(raw[ks].w) * rs * g1[3]);
            qf[ks] = __builtin_bit_cast(bf16x8, o_); }
#pragma unroll
        for (int a = 0; a < 2; ++a) {
            const f32x4 ga0 = *(GAS const f32x4*)(qn + 16 * (8 + a)), ga1 = *(GAS const f32x4*)(qn + 16 * (8 + a) + 4), gb0 = *(GAS const f32x4*)(qn + 16 * (10 + a)), gb1 = *(GAS const f32x4*)(qn + 16 * (10 + a) + 4);
            float x1[8], x2[8], y1[8], y2[8];
#pragma unroll
            for (int jj = 0; jj < 4; ++jj) { x1[2 * jj] = bflo(raw[8 + a][jj]); x1[2 * jj + 1] = bfhi(raw[8 + a][jj]); x2[2 * jj] = bflo(raw[10 + a][jj]); x2[2 * jj + 1] = bfhi(raw[10 + a][jj]); }
#pragma unroll
            for (int j = 0; j < 8; ++j) {
                const float ang = posf * kap->inv_freq[16 * a + 8 * hh + j];
                double rev = (double)ang * 0.15915494309189535; rev -= __builtin_rint(rev);
                const float sn = __builtin_amdgcn_sinf((float)rev), cs = __builtin_amdgcn_cosf((float)rev);
                const float n1 = x1[j] * rs * (j < 4 ? ga0[j & 3] : ga1[j & 3]), n2 = x2[j] * rs * (j < 4 ? gb0[j & 3] : gb1[j & 3]);
                y1[j] = n1 * cs - n2 * sn; y2[j] = n2 * cs + n1 * sn;
            }
            qf[8 + a] = __builtin_bit_cast(bf16x8, (u32x4){pk2(y1[0], y1[1]), pk2(y1[2], y1[3]), pk2(y1[4], y1[5]), pk2(y1[6], y1[7])});
            qf[10 + a] = __builtin_bit_cast(bf16x8, (u32x4){pk2(y2[0], y2[1]), pk2(y2[2], y2[3]), pk2(y2[4], y2[5]), pk2(y2[6], y2[7])});
        }
    }
    f32x16 o[4];
#pragma unroll
    for (int d = 0; d < 4; ++d)
#pragma unroll
        for (int i = 0; i < 16; ++i) o[d][i] = 0.f;
    float l_run = 0.f;
    const int NT = 4 * qb + 4, my_last = 4 * qb + (w >> 1);
    volatile LAS float* wsf = (volatile LAS float*)(L + AT_WSF) + w * 32;
    const unsigned lds_base = (unsigned)(uintptr_t)L;
#define AT_FOFF(j, lz, bo) (lds_base + (bo) + (unsigned)((((lz) & 31) >> 1) * 256 + ((((((lz) & 31) & 1) * 8) + 2 * (j) + ((lz) >> 5)) ^ ((((lz) & 31) >> 1) & 7)) * 16))
    const int du = 4 * w + (lane >> 4), dsl = lane & 15, drb = dsl >> 3, dc = (dsl & 7) ^ (du & 7);
    GAS const bf16_t* ksrc = Kg + (size_t)(2 * du + drb) * QW + h * QKD + dc * 8;
    GAS const bf16_t* vsrc = Vt + (size_t)(h * VD + 2 * du + drb) * SEQ + dc * 8;
#define AT_DMA(t, bi) do { const int kv0_ = (t) * 64; \
    _Pragma("unroll") for (int i = 0; i < 3; ++i) __builtin_amdgcn_global_load_lds((const unsigned*)(ksrc + (size_t)kv0_ * QW + i * 64), (LAS unsigned*)(L + (bi) * AT_BUF + (8 * i + w) * 1024), 16, 0, 0); \
    _Pragma("unroll") for (int i = 0; i < 2; ++i) __builtin_amdgcn_global_load_lds((const unsigned*)(vsrc + (size_t)i * 64 * SEQ + kv0_), (LAS unsigned*)(L + (bi) * AT_BUF + AT_KB + (8 * i + w) * 1024), 16, 0, 0); } while (0)
    AT_DMA(0, 0); AT_DMA(1, 1);
    asm volatile("s_waitcnt vmcnt(5)" ::: "memory"); __builtin_amdgcn_s_barrier(); asm volatile("" ::: "memory");
    int bcur = 0, bnx2 = 2;
    for (int t = 0; t < NT; ++t) {
        if (t + 2 < NT) AT_DMA(t + 2, bnx2);
        if (t <= my_last) {
            int lz_ = lane; LAUNDER_V(lz_); const unsigned bo_ = (unsigned)bcur * AT_BUF;
            const unsigned ka0 = AT_FOFF(0, lz_, bo_), ka1 = AT_FOFF(1, lz_, bo_), ka2 = AT_FOFF(2, lz_, bo_), ka3 = AT_FOFF(3, lz_, bo_);
            f32x16 p0, p1;
#pragma unroll
            for (int i = 0; i < 16; ++i) { p0[i] = 0.f; p1[i] = 0.f; }
            bf16x8 fa0, fa1, fa2, fa3, fb0, fb1, fb2, fb3, fc0, fc1, fc2, fc3;
#define QK_RD(s0, s1, s2, s3, kb, g) DS_READ4X(s0, s1, s2, s3, ka0, ka1, ka2, ka3, (g) * 8192 + (kb) * 4096, (g) * 8192 + (kb) * 4096, (g) * 8192 + (kb) * 4096, (g) * 8192 + (kb) * 4096)
#define QK_MM(s0, s1, s2, s3, P, g) do { P = MFMA32(s0, qf[4 * (g)], P); P = MFMA32(s1, qf[4 * (g) + 1], P); P = MFMA32(s2, qf[4 * (g) + 2], P); P = MFMA32(s3, qf[4 * (g) + 3], P); } while (0)
#define PV_RD(s0, s1, s2, s3, va) DS_READ4(s0, s1, s2, s3, va, AT_KB, AT_KB + 4096, AT_KB + 8192, AT_KB + 12288)
#define PV_PK(P, ss) __builtin_bit_cast(bf16x8, (u32x4){pk2(P[8 * (ss) + 0], P[8 * (ss) + 1]), pk2(P[8 * (ss) + 2], P[8 * (ss) + 3]), pk2(P[8 * (ss) + 4], P[8 * (ss) + 5]), pk2(P[8 * (ss) + 6], P[8 * (ss) + 7])})
#define PV_MM(s0, s1, s2, s3, xs) do { o[0] = MFMA32(xs, s0, o[0]); o[1] = MFMA32(xs, s1, o[1]); o[2] = MFMA32(xs, s2, o[2]); o[3] = MFMA32(xs, s3, o[3]); } while (0)
            QK_RD(fa0, fa1, fa2, fa3, 0, 0);
            QK_RD(fb0, fb1, fb2, fb3, 0, 1);
            QK_RD(fc0, fc1, fc2, fc3, 0, 2); LGKM_WAIT4(8, fa0, fa1, fa2, fa3); QK_MM(fa0, fa1, fa2, fa3, p0, 0);
            QK_RD(fa0, fa1, fa2, fa3, 1, 0); LGKM_WAIT4(8, fb0, fb1, fb2, fb3); QK_MM(fb0, fb1, fb2, fb3, p0, 1);
            QK_RD(fb0, fb1, fb2, fb3, 1, 1); LGKM_WAIT4(8, fc0, fc1, fc2, fc3); QK_MM(fc0, fc1, fc2, fc3, p0, 2);
            float ls0 = 0.f, ls1 = 0.f;
#pragma unroll
            for (int i = 0; i < 16; ++i) { p0[i] = __builtin_amdgcn_exp2f(__builtin_amdgcn_fmed3f(p0[i], -1000.f, 100.f)); ls0 += p0[i]; }
            QK_RD(fc0, fc1, fc2, fc3, 1, 2); LGKM_WAIT4(8, fa0, fa1, fa2, fa3); QK_MM(fa0, fa1, fa2, fa3, p1, 0);
            PV_RD(fa0, fa1, fa2, fa3, ka0);  LGKM_WAIT4(8, fb0, fb1, fb2, fb3); QK_MM(fb0, fb1, fb2, fb3, p1, 1);
            PV_RD(fb0, fb1, fb2, fb3, ka1);  LGKM_WAIT4(8, fc0, fc1, fc2, fc3); QK_MM(fc0, fc1, fc2, fc3, p1, 2);
            { const bf16x8 x00 = PV_PK(p0, 0), x01 = PV_PK(p0, 1);
#pragma unroll
              for (int i = 0; i < 16; ++i) { p1[i] = __builtin_amdgcn_exp2f(__builtin_amdgcn_fmed3f(p1[i], -1000.f, 100.f)); ls1 += p1[i]; }
              PV_RD(fc0, fc1, fc2, fc3, ka2); LGKM_WAIT4(8, fa0, fa1, fa2, fa3); PV_MM(fa0, fa1, fa2, fa3, x00);
              PV_RD(fa0, fa1, fa2, fa3, ka3); LGKM_WAIT4(8, fb0, fb1, fb2, fb3); PV_MM(fb0, fb1, fb2, fb3, x01);
              const bf16x8 x10 = PV_PK(p1, 0), x11 = PV_PK(p1, 1);
              LGKM_WAIT4(4, fc0, fc1, fc2, fc3); PV_MM(fc0, fc1, fc2, fc3, x10);
              LGKM_WAIT4(0, fa0, fa1, fa2, fa3); PV_MM(fa0, fa1, fa2, fa3, x11); }
            l_run += ls0 + ls1;
#undef QK_RD
#undef QK_MM
#undef PV_RD
#undef PV_PK
#undef PV_MM
        }
        if (t + 2 < NT) asm volatile("s_waitcnt vmcnt(5) lgkmcnt(0)" ::: "memory"); else asm volatile("s_waitcnt vmcnt(0) lgkmcnt(0)" ::: "memory");
        __builtin_amdgcn_s_barrier(); asm volatile("" ::: "memory");
        bcur = (bcur == 2) ? 0 : bcur + 1; bnx2 = (bnx2 == 2) ? 0 : bnx2 + 1;
    }
#undef AT_DMA
#undef AT_FOFF
    const float lt = l_run + __shfl_xor(l_run, 32);
    wsf[r32] = 1.0f / lt;
    asm volatile("s_waitcnt lgkmcnt(0)" ::: "memory");
    GAS bf16_t* orow = mix + (size_t)(q0 + 32 * w) * DM + h * VD + r32;
#pragma unroll
    for (int i = 0; i < 16; ++i) { const int qr = crow(i, hh); const float a = wsf[qr]; float ss = 0.f;
#pragma unroll
        for (int d = 0; d < 4; ++d) { const float v = o[d][i] * a; ss += v * v; orow[(size_t)qr * DM + 32 * d] = (bf16_t)f2bf(v); }
        ss += __shfl_xor(ss, 1); ss += __shfl_xor(ss, 2); ss += __shfl_xor(ss, 4); ss += __shfl_xor(ss, 8); ss += __shfl_xor(ss, 16);
        if (r32 == 0) ssq_add(ssq_a + q0 + 32 * w + qr, ss); }
    __syncthreads();
}

constexpr int GL_V = 0  , GL_KD = 32768  , GL_TOT = GL_KD + 18432  , GL_ZA = GL_TOT + 2048  ;
__device__ __forceinline__ void gla_chunk_unit(LAS unsigned char* L, const bf16_t* Z_, const float* wgate_, const float* bgate_, bf16_t* ST_, float* DEC_, int c, int h, int wv) {
    GAS const bf16_t* Z = G_(Z_); GAS const float* wgate = G_(wgate_); GAS const float* bgate = G_(bgate_); GAS bf16_t* ST = G_(ST_); GAS float* DEC = G_(DEC_);
    int tid_ = wv * 64 + lane_id_(); LAUNDER_V(tid_);
    const int tid = tid_, lane = tid & 63, w = __builtin_amdgcn_readfirstlane(tid >> 6), r32 = lane & 31, hh = lane >> 5;
    const size_t row0 = (size_t)c * 64;
#pragma unroll
    for (int i = 0; i < 4; ++i) { const int id = tid + 512 * i, r = id >> 5, cc = id & 31;
        *(LAS u32x4*)(L + GL_V + r * 512 + cc * 16) = *(GAS const u32x4*)(Z + (row0 + r) * IN_PAD + C_GV + h * GDV + cc * 8); }
#pragma unroll
    for (int i = 0; i < 2; ++i) { const int id = tid + 512 * i, r = id >> 4, cc = id & 15;
        ((LAS float*)(L + GL_ZA))[id] = bf2f(Z[(row0 + r) * IN_PAD + C_GA + cc]); }
    __syncthreads();
    const int tq = tid >> 7, col = tid & 127;
    float wg[16];
#pragma unroll
    for (int r = 0; r < 16; ++r) wg[r] = wgate[r * (GH * GDK) + h * GDK + col];
    const float bg = bgate[h * GDK + col];
    float pre[16]; float run = 0.f;
#pragma unroll
    for (int i = 0; i < 16; ++i) {
        const LAS float* za = (const LAS float*)(L + GL_ZA) + (16 * tq + i) * 16;
        float ga = bg;
#pragma unroll
        for (int r = 0; r < 16; ++r) ga += za[r] * wg[r];
        const float ls = fminf(ga, 0.f) - __logf(1.0f + __expf(-fabsf(ga)));
        run += ls * (1.0f / 16.0f); pre[i] = run;
    }
    ((LAS float*)(L + GL_TOT))[tq * 128 + col] = run;
    __syncthreads();
    float off = 0.f, bend = 0.f;
#pragma unroll
    for (int t = 0; t < 4; ++t) { const float v = ((LAS float*)(L + GL_TOT))[t * 128 + col]; bend += v; if (t < tq) off += v; }
    {
        unsigned pkv[8];
#pragma unroll
        for (int i = 0; i < 16; i += 2) {
            const float k0 = bf2f(Z[(row0 + 16 * tq + i) * IN_PAD + C_GK + h * GDK + col]), k1 = bf2f(Z[(row0 + 16 * tq + i + 1) * IN_PAD + C_GK + h * GDK + col]);
            pkv[i >> 1] = pk2(k0 * __expf(bend - off - pre[i]), k1 * __expf(bend - off - pre[i + 1]));
        }
        LAS u32x4* dst = (LAS u32x4*)(L + GL_KD + col * 144 + tq * 32);
        dst[0] = (u32x4){pkv[0], pkv[1], pkv[2], pkv[3]}; dst[1] = (u32x4){pkv[4], pkv[5], pkv[6], pkv[7]};
    }
    if (tq == 0) DEC[(size_t)(c * GH + h) * GDK + col] = __expf(bend);
    __syncthreads();
    f32x16 acc[4];
#pragma unroll
    for (int d = 0; d < 4; ++d)
#pragma unroll
        for (int i = 0; i < 16; ++i) acc[d][i] = 0.f;
#pragma unroll
    for (int ks = 0; ks < 4; ++ks) {
        bf16x8 a;
#pragma unroll
        for (int j = 0; j < 8; ++j) a[j] = (short)*(const LAS unsigned short*)(L + GL_V + (16 * ks + 8 * hh + j) * 512 + (32 * w + r32) * 2);
#pragma unroll
        for (int db = 0; db < 4; ++db) {
            const bf16x8 b = *(const LAS bf16x8*)(L + GL_KD + (32 * db + r32) * 144 + (16 * ks + 8 * hh) * 2);
            acc[db] = MFMA32(a, b, acc[db]);
        }
    }
    GAS bf16_t* stp = ST + ((size_t)(c * GH + h) * GDV + 32 * w) * GDK + r32;
#pragma unroll
    for (int db = 0; db < 4; ++db)
#pragma unroll
        for (int i = 0; i < 16; ++i) stp[(size_t)crow(i, hh) * GDK + 32 * db] = (bf16_t)f2bf(acc[db][i]);
    __syncthreads();
}

constexpr int GO_STR = 260;
__device__ __forceinline__ void gla_out_unit(LAS unsigned char* L, const bf16_t* Z_, const bf16_t* ST_, const float* gnorm_, bf16_t* mix_, int c, int h, int wv) {
    GAS const bf16_t* Z = G_(Z_); GAS const bf16_t* ST = G_(ST_); GAS const float* gnorm = G_(gnorm_); GAS bf16_t* mix = G_(mix_);
    int tid_ = wv * 64 + lane_id_(); LAUNDER_V(tid_);
    const int tid = tid_, lane = tid & 63, w = __builtin_amdgcn_readfirstlane(tid >> 6), r32 = lane & 31, hh = lane >> 5;
    const size_t row0 = (size_t)c * 64;
    f32x16 acc[2];
#pragma unroll
    for (int d = 0; d < 2; ++d)
#pragma unroll
        for (int i = 0; i < 16; ++i) acc[d][i] = 0.f;
    GAS const bf16_t* sp = ST + ((size_t)(c * GH + h) * GDV + 32 * w + r32) * GDK + 8 * hh;
    bf16x8 bfr[8], afr[2][8];
#pragma unroll
    for (int ks = 0; ks < 8; ++ks) bfr[ks] = *(GAS const bf16x8*)(sp + 16 * ks);
#pragma unroll
    for (int tb = 0; tb < 2; ++tb)
#pragma unroll
        for (int ks = 0; ks < 8; ++ks) afr[tb][ks] = *(GAS const bf16x8*)(Z + (row0 + 32 * tb + r32) * IN_PAD + C_GQ + h * GDK + 16 * ks + 8 * hh);
    asm volatile("" ::: "memory");
#pragma unroll
    for (int ks = 0; ks < 8; ++ks)
#pragma unroll
        for (int tb = 0; tb < 2; ++tb) acc[tb] = MFMA32(afr[tb][ks], bfr[ks], acc[tb]);
    LAS float* of = (LAS float*)L;
#pragma unroll
    for (int tb = 0; tb < 2; ++tb)
#pragma unroll
        for (int i = 0; i < 16; ++i) of[(32 * tb + crow(i, hh)) * GO_STR + 32 * w + r32] = acc[tb][i] * 0.08838834764831845f;
    __syncthreads();
    const int tok = tid >> 3, part = tid & 7;
    f32x4 v[4][2]; float ss = 0.f;
#pragma unroll
    for (int j = 0; j < 4; ++j)
#pragma unroll
        for (int q = 0; q < 2; ++q) { v[j][q] = *(const LAS f32x4*)(of + tok * GO_STR + part * 8 + 64 * j + 4 * q); ss += (v[j][q][0] * v[j][q][0] + v[j][q][1] * v[j][q][1]) + (v[j][q][2] * v[j][q][2] + v[j][q][3] * v[j][q][3]); }
    ss += __shfl_xor(ss, 1); ss += __shfl_xor(ss, 2); ss += __shfl_xor(ss, 4);
    const float rstd = rsqrtf(ss * (1.0f / GDV) + EPS);
    GAS const bf16_t* zg = Z + (row0 + tok) * IN_PAD + C_GG + h * GDV + part * 8;
    GAS bf16_t* op = mix + (row0 + tok) * DM + 1024 + h * GDV + part * 8;
#pragma unroll
    for (int j = 0; j < 4; ++j) {
        const u32x4 gw_ = *(GAS const u32x4*)(zg + 64 * j);
        const f32x4 n0 = *(GAS const f32x4*)(gnorm + part * 8 + 64 * j), n1 = *(GAS const f32x4*)(gnorm + part * 8 + 64 * j + 4);
        u32x4 ow;
        ow.x = pk2(v[j][0][0] * rstd * n0[0] * silu_f(bflo(gw_.x)), v[j][0][1] * rstd * n0[1] * silu_f(bfhi(gw_.x)));
        ow.y = pk2(v[j][0][2] * rstd * n0[2] * silu_f(bflo(gw_.y)), v[j][0][3] * rstd * n0[3] * silu_f(bfhi(gw_.y)));
        ow.z = pk2(v[j][1][0] * rstd * n1[0] * silu_f(bflo(gw_.z)), v[j][1][1] * rstd * n1[1] * silu_f(bfhi(gw_.z)));
        ow.w = pk2(v[j][1][2] * rstd * n1[2] * silu_f(bflo(gw_.w)), v[j][1][3] * rstd * n1[3] * silu_f(bfhi(gw_.w)));
        *(GAS u32x4*)(op + 64 * j) = ow;
    }
    __syncthreads();
}


#define XB_TMO      128
#define XB_XCNT(j)  (256  + 64 * (j))
#define XB_XSUB(j)  (1280 + 64 * (j))
#define XB_XGEN(j)  (2304 + 64 * (j))
#define XB_TOP      3328
#define XB_TOPGEN   3392
#define XCD_BAR_WORDS 3456
#define XB_SPIN_CAP (1u << 22)
__device__ __forceinline__ unsigned xb_ld(unsigned* p)              { return __hip_atomic_load(p, __ATOMIC_RELAXED, __HIP_MEMORY_SCOPE_AGENT); }
__device__ __forceinline__ unsigned xb_add(unsigned* p, unsigned v) { return __hip_atomic_fetch_add(p, v, __ATOMIC_RELAXED, __HIP_MEMORY_SCOPE_AGENT); }
__device__ __forceinline__ unsigned xb_xcc_id() { return (unsigned)__builtin_amdgcn_s_getreg((3 << 11) | 20) & 0xFu; }
#define XB_SPIN(cond, bar) do { unsigned _sp = 0; while (cond) { __builtin_amdgcn_s_sleep(1); \
    if ((++_sp & 255u) == 0u) { if (xb_ld(&(bar)[XB_TMO])) break; if (_sp > XB_SPIN_CAP) { atomicAdd(&(bar)[XB_TMO], 1u); break; } } } } while (0)
struct XcdBarrier { unsigned* bar; unsigned x; volatile LAS unsigned* st; };
__device__ __forceinline__ XcdBarrier xcd_barrier_post(unsigned* bar, volatile LAS unsigned* st, bool t0) {
    XcdBarrier b; b.bar = bar; b.x = xb_xcc_id(); b.st = st;
    if (t0) (void)xb_add(&bar[XB_XCNT(b.x)], 1u);
    return b;
}
__device__ __forceinline__ void xcd_barrier_complete(unsigned* bar, unsigned x, unsigned& nloc, unsigned& nx) {
    const unsigned G = gridDim.x * gridDim.y * gridDim.z;
    unsigned sum, cnt, mine, sp = 0u;
    for (;;) {
        sum = 0u; cnt = 0u; mine = 0u;
#pragma unroll
        for (unsigned j = 0; j < 16; ++j) { const unsigned c = xb_ld(&bar[XB_XCNT(j)]); sum += c; cnt += (c > 0u) ? 1u : 0u; mine = (j == x) ? c : mine; }
        if (sum == G) break;
        __builtin_amdgcn_s_sleep(1);
        if ((++sp & 255u) == 0u) { if (xb_ld(&bar[XB_TMO])) break; if (sp > XB_SPIN_CAP) { atomicAdd(&bar[XB_TMO], 1u); break; } }
    }
    nloc = mine > 0u ? mine : 1u; nx = cnt > 0u ? cnt : 1u;
}
__device__ __forceinline__ void xcd_barrier(const XcdBarrier& b, bool t0) {
    asm volatile("s_waitcnt vmcnt(0)" ::: "memory");
    __syncthreads();
    if (t0) {
        unsigned* bar = b.bar;
        __builtin_amdgcn_s_waitcnt(0);
        unsigned nloc = b.st[0], nx = b.st[1];
        if (nloc == 0u) { xcd_barrier_complete(bar, b.x, nloc, nx); b.st[0] = nloc; b.st[1] = nx; }
        const unsigned old = xb_add(&bar[XB_XSUB(b.x)], 1u);
        const unsigned gen = old / nloc;
        if (old + 1u == (gen + 1u) * nloc) {
            __builtin_amdgcn_fence(__ATOMIC_RELEASE, "agent");
            asm volatile("s_waitcnt vmcnt(0)" ::: "memory");
            const unsigned og = xb_add(&bar[XB_TOP], 1u);
            const unsigned tg = og / nx;
            if (og + 1u == (tg + 1u) * nx) xb_add(&bar[XB_TOPGEN], 1u);
            else XB_SPIN(xb_ld(&bar[XB_TOPGEN]) == tg, bar);
            __builtin_amdgcn_fence(__ATOMIC_ACQUIRE, "agent");
            xb_add(&bar[XB_XGEN(b.x)], 1u);
            asm volatile("s_waitcnt vmcnt(0)" ::: "memory");
        } else {
            XB_SPIN(xb_ld(&bar[XB_XGEN(b.x)]) == gen, bar);
            __builtin_amdgcn_fence(__ATOMIC_ACQUIRE, "agent");
            asm volatile("s_waitcnt vmcnt(0)" ::: "memory");
        }
    }
    __syncthreads();
}

__global__ void __launch_bounds__(512, 2) mk_fwd(Args a) {
    extern __shared__ __attribute__((aligned(16))) unsigned char lds[];
    cg::grid_group grid = cg::this_grid();
    LAS unsigned char* L = (LAS unsigned char*)lds;
    const int G = gridDim.x, bid = blockIdx.x, NGW = G * 8;
    volatile LAS unsigned* MISC = (volatile LAS unsigned*)(L + RING_BYTES + 8192);
    const int wave_s = __builtin_amdgcn_readfirstlane(threadIdx.x >> 6);
    if (wave_s == 0 && lane_id_() < 4) MISC[lane_id_()] = 0u;
    __syncthreads();
    { KAP_T kap0 = (KAP_T)__builtin_amdgcn_kernarg_segment_ptr(); (void)xcd_barrier_post((unsigned*)(kap0->ws + WS_BAR), MISC, wave_s == 0 && lane_id_() == 0); }
#define XSYNC() do { KAP_T kap_ = (KAP_T)__builtin_amdgcn_kernarg_segment_ptr(); LAUNDER_S(kap_); XcdBarrier xb_; xb_.bar = (unsigned*)(kap_->ws + WS_BAR); xb_.x = xb_xcc_id(); xb_.st = (volatile LAS unsigned*)(L + RING_BYTES + 8192); xcd_barrier(xb_, wave_s == 0 && lane_id_() == 0); } while (0)
#define GRID_SYNC() do { asm volatile("s_waitcnt vmcnt(0) lgkmcnt(0)" ::: "memory"); __syncthreads(); grid.sync(); \
    __builtin_amdgcn_fence(__ATOMIC_ACQUIRE, "agent"); asm volatile("s_waitcnt vmcnt(0)" ::: "memory"); __syncthreads(); } while (0)
#ifndef DBG_STOP
#define DBG_STOP 0
#endif
#define DBG_DUMP(k, EXPR) do { if (DBG_STOP == (k)) { PHASE_BEGIN(); for (int m = gw; m < SEQ; m += NGW) for (int c = lane; c < DM; c += 64) out[(size_t)m * DM + c] = (EXPR); return; } } while (0)
#define PHASE_BEGIN() KAP_T kap = (KAP_T)__builtin_amdgcn_kernarg_segment_ptr(); LAUNDER_S(kap); unsigned char* ws = kap->ws; LAUNDER_S(ws); int tid_ = wave_s * 64 + lane_id_(); LAUNDER_V(tid_); const int tid = tid_, lane = tid & 63, wave = __builtin_amdgcn_readfirstlane(tid >> 6), gw = bid * 8 + wave; \
    u64* ssq = (u64*)(ws + WS_SSQ); (void)lane; (void)gw; (void)ssq; \
    u64* ssq_x = ssq + (size_t)l * SEQ; u64* ssq_xn = ssq + (size_t)(l + 1) * SEQ; u64* ssq_cq = ssq + (size_t)(3 + l) * SEQ; u64* ssq_ckv = ssq + (size_t)(5 + l) * SEQ; u64* ssq_x1 = ssq + (size_t)(7 + l) * SEQ; u64* ssq_a = ssq + (size_t)(9 + l) * SEQ; (void)ssq_a; \
    (void)ssq_x; (void)ssq_xn; (void)ssq_cq; (void)ssq_ckv; (void)ssq_x1; \
    bf16_t* Win = (bf16_t*)(ws + WS_WIN); bf16_t* Wuq = (bf16_t*)(ws + WS_WUQ); bf16_t* Wukv = (bf16_t*)(ws + WS_WUKV); \
    bf16_t* Wout = (bf16_t*)(ws + WS_WOUT); bf16_t* Wup = (bf16_t*)(ws + WS_WUP); bf16_t* Wdn = (bf16_t*)(ws + WS_WDN); \
    bf16_t* XB = (bf16_t*)(ws + WS_XB); bf16_t* Z = (bf16_t*)(ws + WS_Z); bf16_t* Qb = (bf16_t*)(ws + WS_Q); bf16_t* Kb = (bf16_t*)(ws + WS_K); bf16_t* Vt = (bf16_t*)(ws + WS_VT); \
    bf16_t* ST = (bf16_t*)(ws + WS_ST); float* DEC = (float*)(ws + WS_DEC); bf16_t* MIX = (bf16_t*)(ws + WS_MIX); \
    bf16_t* ACT = (bf16_t*)(ws + WS_ACT); float* EDGE = (float*)(ws + WS_EDGE); \
    const float* xin = kap->in[0]; float* out = kap->out; \
    (void)Win; (void)Wuq; (void)Wukv; (void)Wout; (void)Wup; (void)Wdn; (void)XB; (void)Z; (void)Qb; (void)Kb; (void)Vt; (void)ST; (void)DEC; (void)MIX; (void)EDGE; (void)ACT; (void)xin; (void)out;

    for (int l = 0; l < NLAYER; ++l) {
        {
            PHASE_BEGIN();
            LAS float* scr = (LAS float*)(L + wave * 16384);
            const float* w_in = kap->in[3] + (size_t)l * DM * IN_DIM; const float* w_uq = kap->in[5] + (size_t)l * QLORA * QW; const float* w_ukv = kap->in[7] + (size_t)l * KVLORA * KVW;
            const float* w_out = kap->in[14] + (size_t)l * DM * DM; const float* w_up = kap->in[16] + (size_t)l * DM * DFF2; const float* w_dn = kap->in[19] + (size_t)l * DFF * DM;
            const float* g_attn = kap->in[2] + l * DM; const float* g_cq = kap->in[4] + l * QLORA; const float* g_ckv = kap->in[6] + l * KVLORA; const float* g_mla = kap->in[13] + l * 1024; const float* g_ffn = kap->in[15] + l * DM;
            constexpr int I_IN = (DM / 64) * (IN_PAD / 32), I_UQ = (QLORA / 64) * (QW / 32), I_UKV = (KVLORA / 64) * (KVW / 32), I_OUT = (DM / 64) * (DM / 32), I_UP = (DM / 64) * (DFF2 / 32), I_DN = (DFF / 64) * (DM / 32);
            constexpr int NITEMS = I_IN + I_UQ + I_UKV + I_OUT + I_UP + I_DN;
            for (int it = gw; it < NITEMS; it += NGW) {
                int r = it;
                if (r < I_IN) { wt_item(w_in, DM, IN_DIM, g_attn, DM, Win, scr, r, IN_PAD / 32, lane); continue; } r -= I_IN;
                if (r < I_UQ) { wt_item(w_uq, QLORA, QW, g_cq, QLORA, Wuq, scr, r, QW / 32, lane); continue; } r -= I_UQ;
                if (r < I_UKV) { wt_item(w_ukv, KVLORA, KVW, g_ckv, KVLORA, Wukv, scr, r, KVW / 32, lane); continue; } r -= I_UKV;
                if (r < I_OUT) { wt_item(w_out, DM, DM, g_mla, 1024, Wout, scr, r, DM / 32, lane); continue; } r -= I_OUT;
                if (r < I_UP) { wt_item(w_up, DM, DFF2, g_ffn, DM, Wup, scr, r, DFF2 / 32, lane, true); continue; } r -= I_UP;
                wt_item(w_dn, DFF, DM, g_ffn, 0, Wdn, scr, r, DM / 32, lane);
            }
            if (l == 0) {
                for (int m = gw; m < SEQ; m += NGW) {
                    GAS const f32x4* xr = (GAS const f32x4*)(G_(xin) + (size_t)m * DM) + lane; float s = 0.f;
                    GAS u32x2* o8 = (GAS u32x2*)(G_(XB) + (size_t)m * DM) + lane;
#pragma unroll
                    for (int j = 0; j < 8; ++j) { const f32x4 v = xr[64 * j]; s += (v[0] * v[0] + v[1] * v[1]) + (v[2] * v[2] + v[3] * v[3]); o8[64 * j] = (u32x2){pk2(v[0], v[1]), pk2(v[2], v[3])}; }
                    s = wave_sum(s); if (lane == 0) G_(ssq_x)[m] = (u64)(s * SSQ_FX + 0.5f);
                }
            }
        }
        XSYNC();
        {
            PHASE_BEGIN();
            pg8::Gemm g{XB, Win, SEQ, IN_PAD, DM, DM, nullptr, 0.f}; pg8::StaticOrder S; S.init(SEQ, IN_PAD, G, bid);
            pg8::EpiRowScale E{Z, IN_PAD, ssq_x, 1.0f / DM, ssq_cq, 0, 2, ssq_ckv, 2, 3};
            pg8::gemm_phase<pg8::EpiRowScale>(L, g, S, E, wave_s);
        }
        XSYNC();
        DBG_DUMP(1, bf2f(Z[(size_t)m * IN_PAD + c]) + bf2f(Z[(size_t)m * IN_PAD + 2048 + c]));
        {
            PHASE_BEGIN();
            { pg8::Gemm g{Z + C_CQ, Wuq, SEQ, QW, QLORA, IN_PAD, nullptr, 0.f}; pg8::StaticOrder S; S.init(SEQ, QW, G, bid);
              pg8::EpiRowScale E{Qb, QW, ssq_cq, 1.0f / QLORA, nullptr, 0, 0, nullptr, 0, 0};
              pg8::gemm_phase<pg8::EpiRowScale>(L, g, S, E, wave_s); }
            { pg8::Gemm g{Z + C_CKV, Wukv, SEQ, KVW, KVLORA, IN_PAD, nullptr, 0.f}; pg8::StaticOrder S; S.init(SEQ, KVW, G, bid);
              pg8::EpiUkv E{Kb, Vt, ssq_ckv, 1.0f / KVLORA, Z, (const int*)kap->in[1], kap->in[9] + l * QKD, kap->inv_freq, (LAS float*)(L + RING_BYTES)};
              pg8::gemm_phase<pg8::EpiUkv>(L, g, S, E, wave_s); }
            const float* wgate = kap->in[10] + (size_t)l * 16 * (GH * GDK); const float* bgate = kap->in[11] + (size_t)l * (GH * GDK);
            for (int u = bid; u < NCHUNK * GH; u += G) gla_chunk_unit(L, Z, wgate, bgate, ST, DEC, u >> 2, u & 3, wave_s);
        }
        if (l == 0) GRID_SYNC(); else XSYNC();
        DBG_DUMP(2, (c < QW ? bf2f(Qb[(size_t)m * QW + c]) + bf2f(Kb[(size_t)m * QW + c]) : bf2f(Vt[(size_t)(c - QW) * SEQ + m])) + bf2f(ST[(size_t)m * 8192 + c]) + bf2f(ST[(size_t)m * 8192 + 4096 + c]));
        {
            PHASE_BEGIN();
            const int* pos = (const int*)kap->in[1];
            const float* kn = kap->in[9] + l * QKD;
            constexpr int NE = GH * GDV * GDK;
            for (int e = bid * 512 + tid; e < NE; e += G * 512) {
                const int hd = (e >> 15) * GDK + (e & 127);
                float s = 0.f;
                for (int c0 = 0; c0 < NCHUNK; c0 += 8) {
                    float uu[8], dd[8];
#pragma unroll
                    for (int i = 0; i < 8; ++i) { uu[i] = bf2f(G_(ST)[(size_t)(c0 + i) * NE + e]); dd[i] = G_(DEC)[(size_t)(c0 + i) * (GH * GDK) + hd]; }
#pragma unroll
                    for (int i = 0; i < 8; ++i) { s = s * dd[i] + uu[i]; G_(ST)[(size_t)(c0 + i) * NE + e] = (bf16_t)f2bf(s); }
                }
            }
        }
        XSYNC();
        DBG_DUMP(3, (c < QW ? bf2f(Qb[(size_t)m * QW + c]) + bf2f(Kb[(size_t)m * QW + c]) : 0.f) + bf2f(ST[(size_t)m * 8192 + c]) + bf2f(ST[(size_t)m * 8192 + 4096 + c]));
        {
            PHASE_BEGIN();
            for (int p = bid; p < 256; p += G) {
                const int h = p & 7, s = p >> 3;
                attn_unit(L, Qb, Kb, Vt, MIX, ssq_a, h, 63 - s, wave_s, (const int*)kap->in[1], kap->in[8] + l * QKD, kap);
                attn_unit(L, Qb, Kb, Vt, MIX, ssq_a, h, s, wave_s, (const int*)kap->in[1], kap->in[8] + l * QKD, kap);
            }
            const float* gnorm = kap->in[12] + l * GDV;
            for (int u = bid; u < NCHUNK * GH; u += G) gla_out_unit(L, Z, ST, gnorm, MIX, u >> 2, u & 3, wave_s);
        }
        XSYNC();
        DBG_DUMP(4, bf2f(MIX[(size_t)m * DM + c]));
        DBG_DUMP(5, bf2f(MIX[(size_t)m * DM + c]));
        {
            PHASE_BEGIN();
            pg8::Gemm g{MIX, Wout, SEQ, DM, DM, DM, ssq_a, 1.0f / 1024.0f}; pg8::StaticOrder S; S.init(SEQ, DM, G, bid);
            pg8::EpiRes E{XB, nullptr, XB, ssq_x1};
            pg8::gemm_phase<pg8::EpiRes, true>(L, g, S, E, wave_s);
        }
        XSYNC();
        DBG_DUMP(6, out[(size_t)m * DM + c] + bf2f(XB[(size_t)m * DM + c]));
        {
            PHASE_BEGIN();
            const float* cw = kap->in[17] + (size_t)l * 3 * DFF2; const float* cb = kap->in[18] + (size_t)l * DFF2;
            pg8::Gemm g{XB, Wup, SEQ, DFF2, DM, DM, nullptr, 0.f}; pg8::StaticOrder S; S.init(SEQ, DFF2, G, bid);
            pg8::EpiUpConv E{ACT, EDGE, ssq_x1, cw, cb, (LAS float*)(L + RING_BYTES)};
            pg8::gemm_phase<pg8::EpiUpConv>(L, g, S, E, wave_s);
        }
        XSYNC();
        {
            PHASE_BEGIN();
            const float* cw = kap->in[17] + (size_t)l * 3 * DFF2; const float* cb = kap->in[18] + (size_t)l * DFF2;
            for (int idx = bid * 512 + tid; idx < 63 * DFF; idx += G * 512) {
                const int pm = 1 + idx / DFF, gcol = idx % DFF;
                float y0[2], y1[2];
#pragma unroll
                for (int q = 0; q < 2; ++q) { const int c = q * DFF + gcol;
                    const float um2 = G_(EDGE)[(size_t)((pm - 1) * 4 + 2) * DFF2 + c], um1 = G_(EDGE)[(size_t)((pm - 1) * 4 + 3) * DFF2 + c], u0 = G_(EDGE)[(size_t)(pm * 4 + 0) * DFF2 + c], u1 = G_(EDGE)[(size_t)(pm * 4 + 1) * DFF2 + c];
                    const float w0 = G_(cw)[c], w1 = G_(cw)[DFF2 + c], w2 = G_(cw)[2 * DFF2 + c], bb = G_(cb)[c];
                    y0[q] = bb + w0 * um2 + w1 * um1 + w2 * u0; y1[q] = bb + w0 * um1 + w1 * u0 + w2 * u1; }
                G_(ACT)[(size_t)(pm * 256) * DFF + gcol] = (bf16_t)f2bf(silu_f(y0[0]) * y0[1]);
                G_(ACT)[(size_t)(pm * 256 + 1) * DFF + gcol] = (bf16_t)f2bf(silu_f(y1[0]) * y1[1]);
            }
        }
        XSYNC();
        DBG_DUMP(8, bf2f(ACT[(size_t)m * DFF + c]) + bf2f(ACT[(size_t)m * DFF + 3000 + c]));
        {
            PHASE_BEGIN();
            pg8::Gemm g{ACT, Wdn, SEQ, DM, DFF, DFF, nullptr, 0.f}; pg8::StaticOrder S; S.init(SEQ, DM, G, bid);
            pg8::EpiRes E{XB, (l + 1 < NLAYER) ? nullptr : out, XB, ssq_xn};
            pg8::gemm_phase<pg8::EpiRes>(L, g, S, E, wave_s);
        }
        XSYNC();
        if (DBG_STOP == 9) return;
    }
}

extern "C" void kernel_launch(void* const* d_in, const int* in_sizes, int n_in, void* d_out, int out_size, void* d_ws, size_t ws_size, hipStream_t stream) {
    static int grid = 0;
    if (grid == 0) {
        if (n_in != 20 || out_size != SEQ * DM || ws_size < WS_END) { fprintf(stderr, "kernel_launch: unexpected shapes: n_in %d out %d ws %zu (need %zu)\n", n_in, out_size, ws_size, (size_t)WS_END); grid = -1; return; }
        int dev = 0, cus = 0, per_cu = 0;
        hipGetDevice(&dev); hipDeviceGetAttribute(&cus, hipDeviceAttributeMultiprocessorCount, dev);
        hipFuncSetAttribute((const void*)mk_fwd, hipFuncAttributeMaxDynamicSharedMemorySize, LDS_BYTES);
        hipOccupancyMaxActiveBlocksPerMultiprocessor(&per_cu, (const void*)mk_fwd, 512, LDS_BYTES);
        (void)hipGetLastError();
        if (per_cu < 1) per_cu = 1;
        grid = cus * 1;
    }
    if (grid < 0) return;
    hipMemsetAsync((char*)d_ws + WS_CTL, 0, CTL_BYTES, stream);
    Args a{};
    for (int i = 0; i < 20; ++i) a.in[i] = (const float*)d_in[i];
    a.out = (float*)d_out; a.ws = (unsigned char*)d_ws;
    for (int i = 0; i < 32; ++i) a.inv_freq[i] = (float)pow(10000.0, -(double)i / 32.0);
    void* args[] = {&a};
    hipError_t e = hipLaunchCooperativeKernel((const void*)mk_fwd, dim3(grid), dim3(512), args, LDS_BYTES, stream);
    if (e != hipSuccess) fprintf(stderr, "cooperative launch failed: %s (grid %d)\n", hipGetErrorString(e), grid);
}
```
